# Optimizing an MI355X kernel written in HIP

```python
import math
import jax, jax.numpy as jnp
from jax import lax
import numpy as np

D_MODEL = 2048
BATCH = 4
SEQ = 2048
DEPTH = 2

N_MIXERS = 2
N_HEADS = 16
HEAD_DIM = D_MODEL // N_HEADS
DSA_KV_HEADS = 4
DSA_GROUP = N_HEADS // DSA_KV_HEADS
IDX_HEADS = 16
IDX_DIM = 128
TOPK_MAX = 256
Q_BLOCK = 128
D_FF = 5632
CONV_WIDTH = 3
ROPE_THETA = 10000.0
NORM_EPS = 1e-6
N_A_LAYERS = (DEPTH + 1) // 2
N_B_LAYERS = DEPTH // 2

DSA_Q_COLS = N_HEADS * HEAD_DIM
DSA_KV_COLS = DSA_KV_HEADS * HEAD_DIM
DSA_QI_COLS = IDX_HEADS * IDX_DIM
DSA_KI_COLS = IDX_DIM
DSA_WI_COLS = IDX_HEADS
DSA_IN_COLS = DSA_Q_COLS + 2 * DSA_KV_COLS + DSA_QI_COLS + DSA_KI_COLS + DSA_WI_COLS

kernel_name = "hybrid_stickbreaking_dsa_convffn"


def _rmsnorm(x, g):
    xf = x.astype(jnp.float32)
    y = xf * lax.rsqrt(jnp.mean(xf * xf, axis=-1, keepdims=True) + NORM_EPS)
    return (y * g.astype(jnp.float32)).astype(x.dtype)


def _rope_tables(seq_len, dim):
    inv_freq = 1.0 / (ROPE_THETA ** (jnp.arange(0, dim, 2, dtype=jnp.float32) / dim))
    ang = jnp.arange(seq_len, dtype=jnp.float32)[:, None] * inv_freq[None, :]
    return jnp.cos(ang), jnp.sin(ang)


def _rope(x, cos, sin):
    half = x.shape[-1] // 2
    shp = (x.shape[1],) + (1,) * (x.ndim - 3) + (half,)
    c = cos.reshape(shp).astype(x.dtype)
    s = sin.reshape(shp).astype(x.dtype)
    x1, x2 = x[..., :half], x[..., half:]
    return jnp.concatenate([x1 * c - x2 * s, x2 * c + x1 * s], axis=-1)


def _stick_breaking_attention(h, w_qkv, w_o):
    B, S, _ = h.shape
    qkv = (h @ w_qkv).reshape(B, S, 3, N_HEADS, HEAD_DIM)
    q = qkv[:, :, 0].transpose(0, 2, 1, 3)
    k = qkv[:, :, 1].transpose(0, 2, 1, 3)
    v = qkv[:, :, 2].transpose(0, 2, 1, 3)
    nb = S // Q_BLOCK
    q_blocks = q.reshape(B, N_HEADS, nb, Q_BLOCK, HEAD_DIM).transpose(2, 0, 1, 3, 4)
    s_pos = jnp.arange(S)
    scale = 1.0 / math.sqrt(HEAD_DIM)

    def one_block(args):
        qb, bi = args
        t_pos = bi * Q_BLOCK + jnp.arange(Q_BLOCK)
        z = jnp.einsum('bhtd,bhsd->bhts', qb, k).astype(jnp.float32) * scale
        mask = (s_pos[None, :] < t_pos[:, None])[None, None]
        neg_log_1m_beta = jnp.where(mask, jax.nn.softplus(z), 0.0)
        between = lax.cumsum(neg_log_1m_beta, axis=3, reverse=True) - neg_log_1m_beta
        log_a = jax.nn.log_sigmoid(z) - between
        a = jnp.where(mask, jnp.exp(log_a), 0.0)
        return jnp.einsum('bhts,bhsd->bhtd', a.astype(v.dtype), v)

    out = lax.map(one_block, (q_blocks, jnp.arange(nb)))
    out = out.transpose(1, 0, 3, 2, 4).reshape(B, S, N_HEADS * HEAD_DIM)
    return out @ w_o


def _dsa_attention(h, w_in, q_norm_g, k_norm_g, ik_norm_g, w_o):
    B, S, _ = h.shape
    proj = h @ w_in
    o0 = DSA_Q_COLS
    o1 = o0 + DSA_KV_COLS
    o2 = o1 + DSA_KV_COLS
    o3 = o2 + DSA_QI_COLS
    o4 = o3 + DSA_KI_COLS
    q = proj[..., :o0].reshape(B, S, N_HEADS, HEAD_DIM)
    k = proj[..., o0:o1].reshape(B, S, DSA_KV_HEADS, HEAD_DIM)
    v = proj[..., o1:o2].reshape(B, S, DSA_KV_HEADS, HEAD_DIM)
    qi = proj[..., o2:o3].reshape(B, S, IDX_HEADS, IDX_DIM)
    ki = proj[..., o3:o4]
    wi = proj[..., o4:]

    cos, sin = _rope_tables(S, HEAD_DIM)
    q = _rope(_rmsnorm(q, q_norm_g), cos, sin)
    k = _rope(_rmsnorm(k, k_norm_g), cos, sin)
    cos_i, sin_i = _rope_tables(S, IDX_DIM)
    qi = _rope(qi, cos_i, sin_i)
    ki = _rope(_rmsnorm(ki, ik_norm_g), cos_i, sin_i)

    topk = min(TOPK_MAX, S // 4)
    nb = S // Q_BLOCK
    q_b = q.reshape(B, nb, Q_BLOCK, N_HEADS, HEAD_DIM).swapaxes(0, 1)
    qi_b = qi.reshape(B, nb, Q_BLOCK, IDX_HEADS, IDX_DIM).swapaxes(0, 1)
    wi_b = wi.reshape(B, nb, Q_BLOCK, IDX_HEADS).swapaxes(0, 1)
    s_pos = jnp.arange(S)
    b_idx = jnp.arange(B)[:, None, None]
    idx_scale = 1.0 / math.sqrt(IDX_DIM)
    head_w_scale = 1.0 / math.sqrt(IDX_HEADS)
    attn_scale = 1.0 / math.sqrt(HEAD_DIM)

    def one_block(args):
        qb, qib, wib, bi = args
        t_pos = bi * Q_BLOCK + jnp.arange(Q_BLOCK)
        logits = jnp.einsum('bthe,bse->bths', qib, ki).astype(jnp.float32) * idx_scale
        score = jnp.einsum('bths,bth->bts', jax.nn.relu(logits),
                           wib.astype(jnp.float32)) * head_w_scale
        admissible = (s_pos[None, :] <= t_pos[:, None])[None]
        score = jnp.where(admissible, score, -jnp.inf)
        _, sel = lax.top_k(score, topk)
        k_sel = k[b_idx, sel]
        v_sel = v[b_idx, sel]
        valid = sel <= t_pos[None, :, None]
        qg = qb.reshape(B, Q_BLOCK, DSA_KV_HEADS, DSA_GROUP, HEAD_DIM)
        s = jnp.einsum('btgrd,btkgd->btgrk', qg, k_sel).astype(jnp.float32) * attn_scale
        s = jnp.where(valid[:, :, None, None, :], s, -jnp.inf)
        p = jax.nn.softmax(s, axis=-1)
        o = jnp.einsum('btgrk,btkgd->btgrd', p.astype(v.dtype), v_sel)
        return o.reshape(B, Q_BLOCK, N_HEADS * HEAD_DIM)

    out = lax.map(one_block, (q_b, qi_b, wi_b, jnp.arange(nb)))
    out = out.swapaxes(0, 1).reshape(B, S, N_HEADS * HEAD_DIM)
    return out @ w_o


def _conv_ffn(h, w_up, conv_w, conv_b, w_down):
    u = h @ w_up
    S = u.shape[1]
    up = jnp.pad(u, ((0, 0), (CONV_WIDTH - 1, 0), (0, 0)))
    c = conv_b
    for j in range(CONV_WIDTH):
        c = c + up[:, j:j + S] * conv_w[j]
    gate, val = jnp.split(c, 2, axis=-1)
    return (jax.nn.silu(gate) * val) @ w_down


def setup_inputs(seed: int = 0) -> dict:
    key = jax.random.key(seed)
    ks = jax.random.split(key, 16)
    f32 = jnp.float32

    def nrm(k, shape, fan_in):
        return jax.random.normal(k, shape, f32) * (fan_in ** -0.5)

    def gain(k, shape):
        return 1.0 + 0.02 * jax.random.normal(k, shape, f32)

    return {
        "x": jax.random.normal(ks[0], (BATCH, SEQ, D_MODEL), f32),
        "attn_norm_g": gain(ks[1], (DEPTH, D_MODEL)),
        "ffn_norm_g": gain(ks[2], (DEPTH, D_MODEL)),
        "sb_w_qkv": nrm(ks[3], (N_A_LAYERS, D_MODEL, 3 * N_HEADS * HEAD_DIM), D_MODEL),
        "sb_w_o": nrm(ks[4], (N_A_LAYERS, N_HEADS * HEAD_DIM, D_MODEL), N_HEADS * HEAD_DIM),
        "dsa_w_in": nrm(ks[5], (N_B_LAYERS, D_MODEL, DSA_IN_COLS), D_MODEL),
        "dsa_q_norm_g": gain(ks[6], (N_B_LAYERS, HEAD_DIM)),
        "dsa_k_norm_g": gain(ks[7], (N_B_LAYERS, HEAD_DIM)),
        "dsa_ik_norm_g": gain(ks[8], (N_B_LAYERS, IDX_DIM)),
        "dsa_w_o": nrm(ks[9], (N_B_LAYERS, N_HEADS * HEAD_DIM, D_MODEL), N_HEADS * HEAD_DIM),
        "ffn_w_up": nrm(ks[10], (DEPTH, D_MODEL, 2 * D_FF), D_MODEL),
        "ffn_conv_w": nrm(ks[11], (DEPTH, CONV_WIDTH, 2 * D_FF), CONV_WIDTH),
        "ffn_conv_b": 0.01 * jax.random.normal(ks[12], (DEPTH, 2 * D_FF), f32),
        "ffn_w_down": nrm(ks[13], (DEPTH, D_FF, D_MODEL), D_FF),
    }


def reference(x, attn_norm_g, ffn_norm_g, sb_w_qkv, sb_w_o, dsa_w_in, dsa_q_norm_g,
              dsa_k_norm_g, dsa_ik_norm_g, dsa_w_o, ffn_w_up, ffn_conv_w, ffn_conv_b,
              ffn_w_down):
    for i in range(DEPTH):
        h = _rmsnorm(x, attn_norm_g[i])
        j = i // N_MIXERS
        if i % N_MIXERS == 0:
            mix = _stick_breaking_attention(h, sb_w_qkv[j], sb_w_o[j])
        else:
            mix = _dsa_attention(h, dsa_w_in[j], dsa_q_norm_g[j], dsa_k_norm_g[j],
                                 dsa_ik_norm_g[j], dsa_w_o[j])
        x = x + mix
        h = _rmsnorm(x, ffn_norm_g[i])
        x = x + _conv_ffn(h, ffn_w_up[i], ffn_conv_w[i], ffn_conv_b[i], ffn_w_down[i])
    return x
```

```cpp
#include <hip/hip_runtime.h>
#include <hip/hip_cooperative_groups.h>
#include <cstdio>
#include <cstdint>
namespace cg = cooperative_groups;

#ifndef MK_ONE_LAUNCH
#define MK_ONE_LAUNCH 0
#endif

#define LAS __attribute__((address_space(3)))
typedef unsigned short bf16_t;
typedef short bf16x8 __attribute__((ext_vector_type(8)));
typedef short s16x4 __attribute__((ext_vector_type(4)));
typedef float f32x4 __attribute__((ext_vector_type(4)));
typedef float f32x2 __attribute__((ext_vector_type(2)));
typedef float f32x16 __attribute__((ext_vector_type(16)));
typedef unsigned u32x4 __attribute__((ext_vector_type(4)));
typedef unsigned u32x2 __attribute__((ext_vector_type(2)));
typedef __bf16 bf16x2_t __attribute__((ext_vector_type(2)));

constexpr int BATCH = 4, SEQ = 2048, DM = 2048, NH = 16, HD = 128, MTOK = BATCH * SEQ;
constexpr int FF = 5632, NUP = 2 * FF, NQKV = 3 * DM;
constexpr int KVH = 4, NIN = 5264, NINP = 5376;
constexpr int TOPK = 256;
constexpr float NORM_EPS = 1e-6f;
constexpr float LOG2E = 1.4426950408889634f;
constexpr float QSCALE = 0.08838834764831845f * LOG2E;

constexpr size_t MiB = 1u << 20;
constexpr size_t WS_WQKV = 0, WS_WO0 = 24 * MiB, WS_WIN = 32 * MiB, WS_WO1 = 53 * MiB, WS_WUP = 61 * MiB  , WS_WDN = 149 * MiB  ;
constexpr size_t WS_GAIN = 197 * MiB + 512 * 1024  ;
constexpr size_t WS_ROPE = 193 * MiB  , WS_PART = 194 * MiB, WS_MASK = 195 * MiB, WS_WI = 197 * MiB, WS_KI = 198 * MiB;
constexpr size_t WS_XB = 200 * MiB, WS_X1 = 232 * MiB, WS_X2 = 296 * MiB;
constexpr size_t WS_SCR = 360 * MiB;
constexpr size_t WS_U = WS_SCR, WS_ACT = WS_SCR + 176 * MiB;
constexpr size_t WS_Q = WS_SCR, WS_K = WS_SCR + 32 * MiB, WS_VT = WS_SCR + 64 * MiB, WS_O = WS_SCR + 96 * MiB, WS_QI = WS_SCR + 128 * MiB, WS_KD = WS_SCR + 160 * MiB, WS_VTD = WS_SCR + 168 * MiB;
constexpr size_t WS_END = WS_ACT + 88 * MiB;

constexpr int LDS_EPI = 131072;
constexpr int LDS_BYTES = 147456;

__device__ __forceinline__ unsigned pk2(float lo, float hi) { f32x2 v = {lo, hi}; bf16x2_t b = __builtin_convertvector(v, bf16x2_t); return __builtin_bit_cast(unsigned, b); }
__device__ __forceinline__ bf16_t f2bf(float f) { return (bf16_t)(pk2(f, 0.f) & 0xffffu); }
__device__ __forceinline__ int crow(int r, int hi) { return (r & 3) + 8 * (r >> 2) + 4 * hi; }
__device__ __forceinline__ bf16x8 pack8(const f32x16& p, int b) {
    u32x4 w; w.x = pk2(p[b], p[b + 1]); w.y = pk2(p[b + 2], p[b + 3]); w.z = pk2(p[b + 4], p[b + 5]); w.w = pk2(p[b + 6], p[b + 7]);
    return __builtin_bit_cast(bf16x8, w);
}
__device__ __forceinline__ float swap_sum(float v) { auto rr = __builtin_amdgcn_permlane32_swap(__float_as_uint(v), __float_as_uint(v), false, false); return __uint_as_float(rr[0]) + __uint_as_float(rr[1]); }
__device__ __forceinline__ float swap_max(float v) { auto rr = __builtin_amdgcn_permlane32_swap(__float_as_uint(v), __float_as_uint(v), false, false); return fmaxf(__uint_as_float(rr[0]), __uint_as_float(rr[1])); }
__device__ __forceinline__ float wave_sum(float v) {
#pragma unroll
    for (int o = 1; o < 64; o <<= 1) v += __shfl_xor(v, o);
    return v;
}
__device__ __forceinline__ float row_rstd(const float* part, int row, int fq) {
    const f32x4* p = (const f32x4*)(part + (size_t)row * 32 + 8 * fq);
    const f32x4 a = p[0], b = p[1]; float s = ((a.x + a.y) + (a.z + a.w)) + ((b.x + b.y) + (b.z + b.w));
    s += __shfl_xor(s, 16); s += __shfl_xor(s, 32);
    return 1.0f / sqrtf(s * (1.0f / DM) + NORM_EPS);
}

namespace pg8 {
constexpr int BM = 256, BK = 64, HALF = 128, HTB = HALF * BK * 2, STAGE_BYTES = 8 * HTB, NXCD = 8, WGM = 8;
__host__ __device__ __forceinline__ int lds_byte(int r, int c) { const int st = (r >> 4) * 2 + (c >> 5), rr = r & 15, cc = c & 31, ob = rr * 64 + cc * 2; return st * 1024 + (ob ^ (((ob >> 9) & 1) << 5)); }
__host__ __device__ __forceinline__ void stage_rc(int b, int& R, int& C) { const int st = b / 1024, sb = b % 1024, swz = sb ^ (((sb >> 9) & 1) << 5); R = (st >> 1) * 16 + swz / 64; C = (st & 1) * 32 + (swz % 64) / 2; }
__host__ __device__ __forceinline__ int perm32(int rho) { const int n = rho >> 4, i = rho & 15; return 8 * (i >> 2) + 4 * n + (i & 3); }
struct Unit { int pm, pn; };
struct Gemm { const bf16_t* A; const bf16_t* Bt; int M, N, K; };
struct StaticOrder {
    int nM, nN, nwg, G, c;
    __host__ __device__ void init(int M, int N, int G_, int c_) { nM = M / BM; nN = N / BM; nwg = nM * nN; G = G_; c = c_; }
    __host__ __device__ bool next(int i, Unit& u) const {
        const long L = (long)i * G + c; if (L >= nwg) return false;
        int wgid = (int)L; { const int q = nwg / NXCD, r = nwg % NXCD, xcd = wgid % NXCD, off = wgid / NXCD; wgid = (xcd < r ? xcd * (q + 1) : r * (q + 1) + (xcd - r) * q) + off; }
        const int nig = WGM * nN, gid = wgid / nig, fm = gid * WGM, gsz = (nM - fm) < WGM ? (nM - fm) : WGM;
        u.pm = fm + ((wgid % nig) % gsz); u.pn = (wgid % nig) / gsz; return true;
    }
};
template <class Epi, class Sched, bool ALIGN_EPI, bool SP2>
__device__ __forceinline__ void gemm_phase(LAS unsigned char* lds, const Gemm g, const Sched& S, const Epi& E) {
    const int tid = threadIdx.x, wid = __builtin_amdgcn_readfirstlane(tid >> 6), lane = tid & 63, wr = wid >> 2, wc = wid & 3, fr = lane & 15, fq = lane >> 4;
    const int K = g.K, nt = K / BK;
    unsigned voffA[2], voffB[2];
#pragma unroll
    for (int i = 0; i < 2; ++i) { int R, C; stage_rc(tid * 16 + i * 8192, R, C); const int Rb = Epi::PERM ? ((R & ~31) + perm32(R & 31)) : R;
        voffA[i] = (unsigned)(R * K + C) * 2u; voffB[i] = (unsigned)(Rb * K + C) * 2u; }
    const size_t kstep = (size_t)(BK * 2);
    const size_t hstep = (size_t)HALF * K * 2;
    const size_t tstep = 2 * hstep;
    const unsigned ldsw = (unsigned)wid * 1024u;
    const int aoff = lds_byte(wr * 64 + fr, fq * 8), boff = lds_byte(wc * 32 + fr, fq * 8);
#define PG8_SA(b, h) (((b) * 2 + (h)) * HTB)
#define PG8_SB(b, h) ((4 + (b) * 2 + (h)) * HTB)
#define PG8_STAGE(bufoff, gbase, voff) do { _Pragma("unroll") for (int _i = 0; _i < 2; ++_i) \
        __builtin_amdgcn_global_load_lds((const unsigned*)((const char*)(gbase) + (voff)[_i]), (LAS unsigned*)(lds + (bufoff) + ldsw + _i * 8192), 16, 0, 0); } while (0)
#define PG8_LDA(dst, b, h) do { _Pragma("unroll") for (int m = 0; m < 4; ++m) _Pragma("unroll") for (int k = 0; k < 2; ++k) dst[m][k] = *(const LAS bf16x8*)(lds + PG8_SA(b, h) + aoff + m * 2048 + k * 1024); } while (0)
#define PG8_LDB(dst, b, h) do { _Pragma("unroll") for (int n = 0; n < 2; ++n) _Pragma("unroll") for (int k = 0; k < 2; ++k) dst[n][k] = *(const LAS bf16x8*)(lds + PG8_SB(b, h) + boff + n * 2048 + k * 1024); } while (0)
#define PG8_MMA(ai, bj, At, Bt) do { __builtin_amdgcn_s_setprio(1); _Pragma("unroll") for (int m = 0; m < 4; ++m) _Pragma("unroll") for (int n = 0; n < 2; ++n) _Pragma("unroll") for (int k = 0; k < 2; ++k) \
        acc[ai][bj][m][n] = __builtin_amdgcn_mfma_f32_16x16x32_bf16(Bt[n][k], At[m][k], acc[ai][bj][m][n], 0, 0, 0); __builtin_amdgcn_s_setprio(0); } while (0)
#define PG8_WAIT_V(n) asm volatile("s_waitcnt vmcnt(" #n ")" ::: "memory")
#define PG8_WAIT_L(n) asm volatile("s_waitcnt lgkmcnt(" #n ")" ::: "memory")
#define PG8_BAR __builtin_amdgcn_s_barrier()
#define PG8_SCHED __builtin_amdgcn_sched_barrier(0)
    Unit cur, nxt; int ui = 0;
    if (!S.next(0, cur)) return;
    f32x4 acc[2][2][4][2];
#pragma unroll
    for (int a = 0; a < 2; ++a)
#pragma unroll
        for (int b = 0; b < 2; ++b)
#pragma unroll
            for (int m = 0; m < 4; ++m)
#pragma unroll
                for (int n = 0; n < 2; ++n) acc[a][b][m][n] = (f32x4){0.f, 0.f, 0.f, 0.f};
    bf16x8 At[4][2], B0[2][2], B1[2][2];
    const char* cA = (const char*)g.A + (size_t)cur.pm * tstep; const char* cB = (const char*)g.Bt + (size_t)cur.pn * tstep;
    if constexpr (SP2) {
        PG8_STAGE(PG8_SB(0, 0), cB, voffB); PG8_STAGE(PG8_SB(0, 1), cB + hstep, voffB); PG8_STAGE(PG8_SA(0, 0), cA, voffA); PG8_STAGE(PG8_SA(0, 1), cA + hstep, voffA);
        if (wr == 1) PG8_BAR;
        PG8_WAIT_V(2); PG8_BAR;
        PG8_STAGE(PG8_SB(1, 0), cB + kstep, voffB); PG8_STAGE(PG8_SA(1, 0), cA + kstep, voffA); PG8_STAGE(PG8_SB(1, 1), cB + hstep + kstep, voffB);
        PG8_WAIT_V(6); PG8_BAR;
    } else {
        PG8_STAGE(PG8_SB(0, 0), cB, voffB); PG8_STAGE(PG8_SA(0, 0), cA, voffA); PG8_STAGE(PG8_SB(0, 1), cB + hstep, voffB); PG8_STAGE(PG8_SA(0, 1), cA + hstep, voffA);
        if (wr == 1) PG8_BAR;
        PG8_WAIT_V(4); PG8_BAR;
        PG8_STAGE(PG8_SB(1, 0), cB + kstep, voffB); PG8_STAGE(PG8_SA(1, 0), cA + kstep, voffA); PG8_STAGE(PG8_SB(1, 1), cB + hstep + kstep, voffB);
        PG8_WAIT_V(6); PG8_BAR;
    }
    for (;;) {
        const bool has_next = S.next(ui + 1, nxt);
        const char* nA = has_next ? (const char*)g.A + (size_t)nxt.pm * tstep : cA; const char* nB = has_next ? (const char*)g.Bt + (size_t)nxt.pn * tstep : cB;
        for (int t = 0; t < nt; t += 2) {
            const bool last = (t == nt - 2);
            const char* a1 = cA + (size_t)(t + 1) * kstep;
            const char* a2 = last ? nA : cA + (size_t)(t + 2) * kstep; const char* b2 = last ? nB : cB + (size_t)(t + 2) * kstep;
            const char* a3 = a2 + kstep; const char* b3 = b2 + kstep;
            if constexpr (SP2) {
            PG8_LDB(B0, 0, 0); PG8_LDB(B1, 0, 1); PG8_SCHED; PG8_LDA(At, 0, 0); PG8_STAGE(PG8_SA(1, 1), a1 + hstep, voffA);
            PG8_WAIT_V(8); PG8_WAIT_L(0); PG8_BAR; PG8_MMA(0, 0, At, B0); PG8_MMA(0, 1, At, B1); PG8_BAR; PG8_SCHED;
            PG8_LDA(At, 0, 1); PG8_STAGE(PG8_SB(0, 0), b2, voffB); PG8_STAGE(PG8_SB(0, 1), b2 + hstep, voffB); PG8_STAGE(PG8_SA(0, 0), a2, voffA);
            PG8_WAIT_V(8); PG8_WAIT_L(0); PG8_BAR; PG8_MMA(1, 0, At, B0); PG8_MMA(1, 1, At, B1); PG8_BAR; PG8_SCHED;
            PG8_LDB(B0, 1, 0); PG8_LDB(B1, 1, 1); PG8_SCHED; PG8_LDA(At, 1, 0); PG8_STAGE(PG8_SA(0, 1), a2 + hstep, voffA);
            PG8_WAIT_V(8); PG8_WAIT_L(0); PG8_BAR; PG8_MMA(0, 0, At, B0); PG8_MMA(0, 1, At, B1); PG8_BAR; PG8_SCHED;
            PG8_LDA(At, 1, 1); PG8_STAGE(PG8_SB(1, 0), b3, voffB); PG8_STAGE(PG8_SB(1, 1), b3 + hstep, voffB); PG8_STAGE(PG8_SA(1, 0), a3, voffA);
            PG8_WAIT_V(8); PG8_WAIT_L(0); PG8_BAR; PG8_MMA(1, 0, At, B0); PG8_MMA(1, 1, At, B1); PG8_BAR; PG8_SCHED;
            } else {
            PG8_LDB(B0, 0, 0); PG8_SCHED; PG8_LDA(At, 0, 0); PG8_STAGE(PG8_SA(1, 1), a1 + hstep, voffA);
            PG8_WAIT_L(8); PG8_BAR; PG8_WAIT_L(0); PG8_MMA(0, 0, At, B0); PG8_BAR; PG8_SCHED;
            PG8_LDB(B1, 0, 1); PG8_STAGE(PG8_SB(0, 0), b2, voffB);
            PG8_BAR; PG8_WAIT_L(0); PG8_MMA(0, 1, At, B1); PG8_BAR;
            PG8_LDA(At, 0, 1); PG8_STAGE(PG8_SA(0, 0), a2, voffA);
            PG8_BAR; PG8_WAIT_L(0); PG8_MMA(1, 0, At, B0); PG8_BAR; PG8_SCHED;
            PG8_STAGE(PG8_SB(0, 1), b2 + hstep, voffB);
            PG8_WAIT_V(6); PG8_BAR; PG8_MMA(1, 1, At, B1); PG8_BAR;
            PG8_LDB(B0, 1, 0); PG8_SCHED; PG8_LDA(At, 1, 0); PG8_STAGE(PG8_SA(0, 1), a2 + hstep, voffA);
            PG8_WAIT_L(8); PG8_BAR; PG8_WAIT_L(0); PG8_MMA(0, 0, At, B0); PG8_BAR; PG8_SCHED;
            PG8_LDB(B1, 1, 1); PG8_STAGE(PG8_SB(1, 0), b3, voffB);
            PG8_BAR; PG8_WAIT_L(0); PG8_MMA(0, 1, At, B1); PG8_BAR;
            PG8_LDA(At, 1, 1); PG8_STAGE(PG8_SA(1, 0), a3, voffA);
            PG8_BAR; PG8_WAIT_L(0); PG8_MMA(1, 0, At, B0); PG8_BAR; PG8_SCHED;
            PG8_STAGE(PG8_SB(1, 1), b3 + hstep, voffB);
            PG8_WAIT_V(6); PG8_BAR; PG8_MMA(1, 1, At, B1); PG8_BAR;
            }
        }
        if constexpr (ALIGN_EPI) { if (wr == 0) PG8_BAR; }
        { int fr_ = fr, fq_ = fq; asm volatile("" : "+v"(fr_), "+v"(fq_)); E(acc, cur, wr, wc, fr_, fq_); }
        if (!has_next) break;
#pragma unroll
        for (int a = 0; a < 2; ++a)
#pragma unroll
            for (int b = 0; b < 2; ++b)
#pragma unroll
                for (int m = 0; m < 4; ++m)
#pragma unroll
                    for (int n = 0; n < 2; ++n) acc[a][b][m][n] = (f32x4){0.f, 0.f, 0.f, 0.f};
        cur = nxt; cA = nA; cB = nB; ++ui;
        if constexpr (ALIGN_EPI) { if (wr == 1) PG8_BAR; }
    }
    PG8_WAIT_V(0);
    if constexpr (!ALIGN_EPI) { if (wr == 0) PG8_BAR; }
    PG8_BAR;
#undef PG8_SA
#undef PG8_SB
#undef PG8_STAGE
#undef PG8_LDA
#undef PG8_LDB
#undef PG8_MMA
#undef PG8_WAIT_V
#undef PG8_WAIT_L
#undef PG8_BAR
#undef PG8_SCHED
}
}
using pg8::Unit;
typedef f32x4 AccT[2][2][4][2];

struct EpiQKV {
    static constexpr bool PERM = true;
    unsigned char* ws;
    __device__ __forceinline__ void operator()(const AccT& acc, const Unit& u, int wr, int wc, int fr, int fq) const {
        const int row0 = u.pm * 256 + wr * 64 + fr, kind = u.pn >> 3, colt = (u.pn & 7) * 256 + wc * 32 + 8 * fq;
        bf16_t* Vt = (bf16_t*)(ws + WS_VT);
        if (kind < 2) {
            bf16_t* base = (bf16_t*)(ws + (kind == 0 ? WS_Q : WS_K)); const float sc = kind == 0 ? QSCALE : 1.0f;
#pragma unroll
            for (int ai = 0; ai < 2; ++ai)
#pragma unroll
                for (int m = 0; m < 4; ++m) { bf16_t* rowp = base + (size_t)(row0 + ai * 128 + m * 16) * DM + colt;
#pragma unroll
                    for (int bj = 0; bj < 2; ++bj) { const f32x4 v0 = acc[ai][bj][m][0] * sc, v1 = acc[ai][bj][m][1] * sc;
                        u32x4 w; w.x = pk2(v0[0], v0[1]); w.y = pk2(v0[2], v0[3]); w.z = pk2(v1[0], v1[1]); w.w = pk2(v1[2], v1[3]);
                        *(u32x4*)(rowp + bj * 128) = w; } }
        } else {
#pragma unroll
            for (int ai = 0; ai < 2; ++ai)
#pragma unroll
                for (int m = 0; m < 4; ++m) { const int row = row0 + ai * 128 + m * 16, b = row >> 11, s = row & 2047;
#pragma unroll
                    for (int bj = 0; bj < 2; ++bj) { const int c0 = colt + bj * 128, h = c0 >> 7, d0 = c0 & 127;
                        bf16_t* p = Vt + ((size_t)(b * NH + h) * HD + d0) * SEQ + s;
#pragma unroll
                        for (int n = 0; n < 2; ++n)
#pragma unroll
                            for (int j = 0; j < 4; ++j) p[(size_t)(4 * n + j) * SEQ] = f2bf(acc[ai][bj][m][n][j]); } }
        }
    }
};
struct EpiRes {
    static constexpr bool PERM = true;
    const float* res; float* out; bf16_t* outb; float* part;
    __device__ __forceinline__ void operator()(const AccT& acc, const Unit& u, int wr, int wc, int fr, int fq) const {
        const int row0 = u.pm * 256 + wr * 64 + fr, col0 = u.pn * 256 + wc * 32 + 8 * fq;
#pragma unroll
        for (int ai = 0; ai < 2; ++ai)
#pragma unroll
            for (int m = 0; m < 4; ++m) { const int row = row0 + ai * 128 + m * 16; const size_t off = (size_t)row * DM + col0; float ss = 0.f;
#pragma unroll
                for (int bj = 0; bj < 2; ++bj) {
                    const f32x4 r0 = *(const f32x4*)(res + off + bj * 128), r1 = *(const f32x4*)(res + off + bj * 128 + 4);
                    const f32x4 v0 = acc[ai][bj][m][0] + r0, v1 = acc[ai][bj][m][1] + r1;
                    *(f32x4*)(out + off + bj * 128) = v0; *(f32x4*)(out + off + bj * 128 + 4) = v1;
                    if (outb) { u32x4 w; w.x = pk2(v0[0], v0[1]); w.y = pk2(v0[2], v0[3]); w.z = pk2(v1[0], v1[1]); w.w = pk2(v1[2], v1[3]); *(u32x4*)(outb + off + bj * 128) = w; }
                    ss += (v0[0] * v0[0] + v0[1] * v0[1]) + (v0[2] * v0[2] + v0[3] * v0[3]) + (v1[0] * v1[0] + v1[1] * v1[1]) + (v1[2] * v1[2] + v1[3] * v1[3]); }
                if (part) { ss += __shfl_xor(ss, 16); ss += __shfl_xor(ss, 32); if (fq == 0) part[(size_t)row * 32 + u.pn * 4 + wc] = ss; } }
    }
};
struct EpiUp {
    static constexpr bool PERM = true;
    bf16_t* U; const float* part;
    __device__ __forceinline__ void operator()(const AccT& acc, const Unit& u, int wr, int wc, int fr, int fq) const {
        const int row0 = u.pm * 256 + wr * 64 + fr, col0 = u.pn * 256 + wc * 32 + 8 * fq;
#pragma unroll
        for (int ai = 0; ai < 2; ++ai)
#pragma unroll
            for (int m = 0; m < 4; ++m) { const int row = row0 + ai * 128 + m * 16; const float rs = row_rstd(part, row, fq); bf16_t* rowp = U + (size_t)row * NUP + col0;
#pragma unroll
                for (int bj = 0; bj < 2; ++bj) { const f32x4 v0 = acc[ai][bj][m][0] * rs, v1 = acc[ai][bj][m][1] * rs;
                    u32x4 w; w.x = pk2(v0[0], v0[1]); w.y = pk2(v0[2], v0[3]); w.z = pk2(v1[0], v1[1]); w.w = pk2(v1[2], v1[3]);
                    *(u32x4*)(rowp + bj * 128) = w; } }
    }
};
struct EpiDsaIn {
    static constexpr bool PERM = false;
    unsigned char* ws; LAS float* scr;
    __device__ __forceinline__ void operator()(const AccT& acc_in, const Unit& u, int wr, int wc, int fr, int fq) const {
        const int row0 = u.pm * 256 + wr * 64 + fr;
        const float* part = (const float*)(ws + WS_PART); const float* ropeC = (const float*)(ws + WS_ROPE); const float* ropeS = ropeC + SEQ * 64;
        bf16_t* VTD = (bf16_t*)(ws + WS_VTD); float* WI = (float*)(ws + WS_WI);
        const bool need_norm = (u.pn < 10) || (u.pn == 20);
        float rs[2][4];
#pragma unroll
        for (int ai = 0; ai < 2; ++ai)
#pragma unroll
            for (int m = 0; m < 4; ++m) rs[ai][m] = row_rstd(part, row0 + ai * 128 + m * 16, fq);
        if (need_norm) {
#pragma unroll
            for (int ai = 0; ai < 2; ++ai)
#pragma unroll
                for (int m = 0; m < 4; ++m)
#pragma unroll
                    for (int bj = 0; bj < 2; ++bj) { const f32x4 a = acc_in[ai][bj][m][0], b = acc_in[ai][bj][m][1];
                        float ss = ((a[0] * a[0] + a[1] * a[1]) + (a[2] * a[2] + a[3] * a[3])) + ((b[0] * b[0] + b[1] * b[1]) + (b[2] * b[2] + b[3] * b[3]));
                        ss += __shfl_xor(ss, 16); ss += __shfl_xor(ss, 32);
                        if (fq == 0) scr[(ai * 128 + wr * 64 + m * 16 + fr) * 8 + bj * 4 + wc] = ss * rs[ai][m] * rs[ai][m]; }
            asm volatile("s_waitcnt lgkmcnt(0)" ::: "memory"); __builtin_amdgcn_s_barrier(); asm volatile("" ::: "memory");
        }
        const int dl = 16 * wc + 4 * fq;
#pragma unroll
        for (int bj = 0; bj < 2; ++bj) {
            const int hh = 2 * u.pn + bj;
            if (hh >= 20 && hh < 24) {
#pragma unroll
                for (int ai = 0; ai < 2; ++ai)
#pragma unroll
                    for (int m = 0; m < 4; ++m) { const int row = row0 + ai * 128 + m * 16, b = row >> 11, s = row & 2047; const float r = rs[ai][m];
                        bf16_t* p = VTD + ((size_t)(b * KVH + (hh - 20)) * HD + dl) * SEQ + s;
#pragma unroll
                        for (int n = 0; n < 2; ++n)
#pragma unroll
                            for (int e = 0; e < 4; ++e) p[(size_t)(64 * n + e) * SEQ] = f2bf(acc_in[ai][bj][m][n][e] * r); }
            } else if (hh == 41) {
                if (wc == 0) {
#pragma unroll
                    for (int ai = 0; ai < 2; ++ai)
#pragma unroll
                        for (int m = 0; m < 4; ++m) { const int row = row0 + ai * 128 + m * 16; *(f32x4*)(WI + (size_t)row * 16 + 4 * fq) = acc_in[ai][bj][m][0] * rs[ai][m]; } }
            } else {
                const bool norm = (hh < 20) || (hh == 40);
                const float* g = (const float*)(ws + WS_GAIN) + (hh < 16 ? 0 : (hh < 20 ? 128 : 256));
                f32x4 g0 = (f32x4){1.f, 1.f, 1.f, 1.f}, g1 = g0;
                if (norm) { g0 = *(const f32x4*)(g + dl); g1 = *(const f32x4*)(g + dl + 64); }
                size_t boff; int ld, cb;
                if (hh < 16) { boff = WS_Q; ld = DM; cb = hh * HD; } else if (hh < 20) { boff = WS_KD; ld = KVH * HD; cb = (hh - 16) * HD; }
                else if (hh < 40) { boff = WS_QI; ld = DM; cb = (hh - 24) * HD; } else { boff = WS_KI; ld = HD; cb = 0; }
                bf16_t* base = (bf16_t*)(ws + boff);
                const float osc = hh < 16 ? QSCALE : 1.0f;
#pragma unroll
                for (int ai = 0; ai < 2; ++ai)
#pragma unroll
                    for (int m = 0; m < 4; ++m) { const int lrow = ai * 128 + wr * 64 + m * 16 + fr, row = u.pm * 256 + lrow, pos = row & 2047;
                        float sc = rs[ai][m];
                        if (norm) { const f32x4 t = *(const LAS f32x4*)(scr + lrow * 8 + bj * 4); sc *= 1.0f / sqrtf(((t[0] + t[1]) + (t[2] + t[3])) * (1.0f / HD) + NORM_EPS); }
                        sc *= osc;
                        const f32x4 c = *(const f32x4*)(ropeC + pos * 64 + dl), sn = *(const f32x4*)(ropeS + pos * 64 + dl);
                        const f32x4 y0 = acc_in[ai][bj][m][0] * g0 * sc, y1 = acc_in[ai][bj][m][1] * g1 * sc;
                        const f32x4 o0 = y0 * c - y1 * sn, o1 = y1 * c + y0 * sn;
                        bf16_t* rp = base + (size_t)row * ld + cb + dl;
                        u32x2 w0, w1; w0.x = pk2(o0[0], o0[1]); w0.y = pk2(o0[2], o0[3]); w1.x = pk2(o1[0], o1[1]); w1.y = pk2(o1[2], o1[3]);
                        *(u32x2*)rp = w0; *(u32x2*)(rp + 64) = w1; }
            }
        }
    }
};

enum { WM_PLAIN = 0, WM_UP = 1, WM_IN = 2 };
__device__ __forceinline__ int colmap(int kind, int np) {
    if (kind == WM_UP) { const int pn = np >> 8, bj = (np >> 7) & 1, q = np & 127; return bj * FF + 128 * pn + q; }
    if (kind == WM_IN) { const int hh = np >> 7, p = np & 127, d = 16 * (p >> 5) + (p & 15) + 64 * ((p >> 4) & 1);
        if (hh < 41) return hh * 128 + d; return (p < 16) ? (5248 + p) : -1; }
    return np;
}
__device__ __forceinline__ void transpose_item(const float* W, int K, int N, int NP, const float* gain, int kind, bf16_t* WT, LAS float* scr, int item, int lane) {
    const int nblk = NP / 64, kb = item / nblk, nb = item % nblk, k0 = 64 * kb, n0 = 64 * nb;
    const int src = colmap(kind, n0 + lane);
#pragma unroll 8
    for (int kk = 0; kk < 64; ++kk) { float v = 0.f; if (src >= 0) { v = W[(size_t)(k0 + kk) * N + src]; if (gain) v *= gain[k0 + kk]; } scr[kk * 65 + lane] = v; }
    asm volatile("s_waitcnt lgkmcnt(0)" ::: "memory");
    const int c = lane & 7;
#pragma unroll
    for (int j = 0; j < 8; ++j) { const int n = (lane >> 3) + 8 * j; const LAS float* s = scr + (8 * c) * 65 + n;
        u32x4 o; o.x = pk2(s[0 * 65], s[1 * 65]); o.y = pk2(s[2 * 65], s[3 * 65]); o.z = pk2(s[4 * 65], s[5 * 65]); o.w = pk2(s[6 * 65], s[7 * 65]);
        *(u32x4*)(WT + (size_t)(n0 + n) * K + k0 + 8 * c) = o; }
    asm volatile("s_waitcnt lgkmcnt(0)" ::: "memory");
}

struct Args {
    const float* x; const float* attn_g; const float* ffn_g; const float* w_qkv; const float* w_o0; const float* w_in;
    const float* qn_g; const float* kn_g; const float* ikn_g; const float* w_o1; const float* w_up; const float* conv_w; const float* conv_b; const float* w_down;
    float* out; unsigned char* ws; int ph_lo, ph_hi;
};

__device__ __forceinline__ void weight_job(const float* W, int K, int N, int NP, const float* gain, int kind, bf16_t* WT, LAS float* scr, int gw, int ngw, int lane) {
    const int items = (K / 64) * (NP / 64);
    for (int it = gw; it < items; it += ngw) transpose_item(W, K, N, NP, gain, kind, WT, scr, it, lane);
}
__device__ __forceinline__ void prologue_phase(const Args& a, LAS unsigned char* lds, int gw, int ngw, int wave, int lane) {
    unsigned char* ws = a.ws;
    LAS float* scr = (LAS float*)(lds + wave * 16640);
    weight_job(a.w_qkv, DM, NQKV, NQKV, nullptr, WM_PLAIN, (bf16_t*)(ws + WS_WQKV), scr, gw, ngw, lane);
    weight_job(a.w_o0, DM, DM, DM, nullptr, WM_PLAIN, (bf16_t*)(ws + WS_WO0), scr, gw, ngw, lane);
    weight_job(a.w_in, DM, NIN, NINP, a.attn_g + DM, WM_IN, (bf16_t*)(ws + WS_WIN), scr, gw, ngw, lane);
    weight_job(a.w_o1, DM, DM, DM, nullptr, WM_PLAIN, (bf16_t*)(ws + WS_WO1), scr, gw, ngw, lane);
    weight_job(a.w_up, DM, NUP, NUP, a.ffn_g, WM_UP, (bf16_t*)(ws + WS_WUP), scr, gw, ngw, lane);
    weight_job(a.w_up + (size_t)DM * NUP, DM, NUP, NUP, a.ffn_g + DM, WM_UP, (bf16_t*)(ws + WS_WUP + 44 * MiB), scr, gw, ngw, lane);
    weight_job(a.w_down, FF, DM, DM, nullptr, WM_PLAIN, (bf16_t*)(ws + WS_WDN), scr, gw, ngw, lane);
    weight_job(a.w_down + (size_t)FF * DM, FF, DM, DM, nullptr, WM_PLAIN, (bf16_t*)(ws + WS_WDN + 22 * MiB), scr, gw, ngw, lane);
    bf16_t* XB = (bf16_t*)(ws + WS_XB);
    for (int m = gw; m < MTOK; m += ngw) {
        const f32x4* xr = (const f32x4*)(a.x + (size_t)m * DM) + lane;
        f32x4 v[8]; float s = 0.f;
#pragma unroll
        for (int j = 0; j < 8; ++j) { v[j] = xr[64 * j]; s += (v[j].x * v[j].x + v[j].y * v[j].y) + (v[j].z * v[j].z + v[j].w * v[j].w); }
        const float rstd = 1.0f / sqrtf(wave_sum(s) * (1.0f / DM) + NORM_EPS);
        u32x2* o8 = (u32x2*)(XB + (size_t)m * DM) + lane;
#pragma unroll
        for (int j = 0; j < 8; ++j) { const f32x4 g = ((const f32x4*)a.attn_g)[lane + 64 * j]; u32x2 w; w.x = pk2(v[j].x * rstd * g.x, v[j].y * rstd * g.y); w.y = pk2(v[j].z * rstd * g.z, v[j].w * rstd * g.w); o8[64 * j] = w; }
    }
    if (gw == 0) { float* gn = (float*)(ws + WS_GAIN); for (int i = lane; i < 128; i += 64) { gn[i] = a.qn_g[i]; gn[128 + i] = a.kn_g[i]; gn[256 + i] = a.ikn_g[i]; } }
    float* rc = (float*)(ws + WS_ROPE); float* rsn = rc + SEQ * 64;
    for (int i = gw * 64 + lane; i < SEQ * 64; i += ngw * 64) {
        const int pos = i >> 6, fi = i & 63;
        const float inv_freq = (float)(1.0 / exp2((double)fi * (2.0 / 128.0) * 13.287712379549449));
        const float ang = (float)pos * inv_freq;
        const double x = (double)ang; const double kq = rint(x * 0.63661977236758134308);
        double r = __builtin_fma(-kq, 1.57079632679489655800e+00, x); r = __builtin_fma(-kq, 6.12323399573676603587e-17, r);
        const double r2 = r * r;
        double sp = -1.0 / 6227020800.0; sp = sp * r2 + 1.0 / 39916800.0; sp = sp * r2 - 1.0 / 362880.0; sp = sp * r2 + 1.0 / 5040.0; sp = sp * r2 - 1.0 / 120.0; sp = sp * r2 + 1.0 / 6.0; const double sv = r - r * r2 * sp;
        double cp = 1.0 / 87178291200.0; cp = cp * r2 - 1.0 / 479001600.0; cp = cp * r2 + 1.0 / 3628800.0; cp = cp * r2 - 1.0 / 40320.0; cp = cp * r2 + 1.0 / 720.0; cp = cp * r2 - 1.0 / 24.0; cp = cp * r2 + 0.5; const double cv = 1.0 - r2 * cp;
        const int q = ((int)kq) & 3;
        const double cs = (q == 0) ? cv : (q == 1) ? -sv : (q == 2) ? -cv : sv;
        const double sn = (q == 0) ? sv : (q == 1) ? cv : (q == 2) ? -sv : -cv;
        rc[i] = (float)cs; rsn[i] = (float)sn;
    }
}

constexpr float SB_EXIT = 220.0f;
__device__ __forceinline__ void sb_attn_phase(const bf16_t* __restrict__ Q, const bf16_t* __restrict__ K, const bf16_t* __restrict__ Vt, bf16_t* __restrict__ O, int gw, int ngw, int lane) {
    const int r = lane & 31, hh = lane >> 5;
    bf16x8 uf[2];
#pragma unroll
    for (int s2 = 0; s2 < 2; ++s2) { u32x4 w;
        unsigned e[8];
#pragma unroll
        for (int j = 0; j < 8; ++j) { const int key = 16 * s2 + 8 * (j >> 2) + 4 * hh + (j & 3); e[j] = (key >= r) ? 0x3f80u : 0u; }
        w.x = e[0] | (e[1] << 16); w.y = e[2] | (e[3] << 16); w.z = e[4] | (e[5] << 16); w.w = e[6] | (e[7] << 16); uf[s2] = __builtin_bit_cast(bf16x8, w); }
    for (int unit = gw; unit < BATCH * NH * 64; unit += ngw) {
        const int bh = unit >> 6, qt = 63 - (unit & 63), b = bh >> 4, h = bh & 15, q0 = qt * 32;
        const bf16_t* qp = Q + (size_t)(b * SEQ + q0 + r) * DM + h * HD + 8 * hh;
        bf16x8 qf[8];
#pragma unroll
        for (int s = 0; s < 8; ++s) qf[s] = *(const bf16x8*)(qp + 16 * s);
        f32x16 o[4];
#pragma unroll
        for (int d = 0; d < 4; ++d) o[d] = f32x16{};
        float carry = 0.f;
        const bf16_t* kbase = K + (size_t)(b * SEQ + r) * DM + h * HD + 8 * hh;
        const bf16_t* vbase = Vt + ((size_t)bh * HD + r) * SEQ + 4 * hh;
        for (int kt = qt; kt >= 0; --kt) {
            const int key0 = kt * 32;
            const bf16_t* kp = kbase + (size_t)key0 * DM;
            bf16x8 kf[8];
#pragma unroll
            for (int s = 0; s < 8; ++s) kf[s] = *(const bf16x8*)(kp + 16 * s);
            bf16x8 vf[4][2];
#pragma unroll
            for (int d = 0; d < 4; ++d)
#pragma unroll
                for (int s2 = 0; s2 < 2; ++s2) { const bf16_t* vp = vbase + (size_t)(32 * d) * SEQ + key0 + 16 * s2;
                    const s16x4 lo = *(const s16x4*)vp, hi = *(const s16x4*)(vp + 8);
                    vf[d][s2] = (bf16x8){lo[0], lo[1], lo[2], lo[3], hi[0], hi[1], hi[2], hi[3]}; }
            f32x16 p = f32x16{};
#pragma unroll
            for (int s = 0; s < 8; ++s) p = __builtin_amdgcn_mfma_f32_32x32x16_bf16(kf[s], qf[s], p, 0, 0, 0);
            const bool diag = (kt == qt);
            f32x16 sp;
#pragma unroll
            for (int i = 0; i < 16; ++i) { const float z = p[i]; float v = fmaxf(z, 0.f) + __builtin_amdgcn_logf(1.0f + __builtin_amdgcn_exp2f(-fabsf(z)));
                if (diag && crow(i, hh) >= r) v = 0.f; sp[i] = v; }
            f32x16 c;
#pragma unroll
            for (int i = 0; i < 16; ++i) c[i] = carry;
            c = __builtin_amdgcn_mfma_f32_32x32x16_bf16(uf[0], pack8(sp, 0), c, 0, 0, 0);
            c = __builtin_amdgcn_mfma_f32_32x32x16_bf16(uf[1], pack8(sp, 8), c, 0, 0, 0);
            f32x16 av;
#pragma unroll
            for (int i = 0; i < 16; ++i) { float v = __builtin_amdgcn_exp2f(p[i] - c[i]); if (diag && crow(i, hh) >= r) v = 0.f; av[i] = v; }
            carry = swap_max(c[0]);
            const bf16x8 pa0 = pack8(av, 0), pa1 = pack8(av, 8);
#pragma unroll
            for (int d = 0; d < 4; ++d) { o[d] = __builtin_amdgcn_mfma_f32_32x32x16_bf16(vf[d][0], pa0, o[d], 0, 0, 0); o[d] = __builtin_amdgcn_mfma_f32_32x32x16_bf16(vf[d][1], pa1, o[d], 0, 0, 0); }
            if (__all(carry > SB_EXIT)) break;
        }
        bf16_t* op = O + (size_t)(b * SEQ + q0 + r) * DM + h * HD + 4 * hh;
#pragma unroll
        for (int d = 0; d < 4; ++d)
#pragma unroll
            for (int g = 0; g < 4; ++g) { u32x2 w; w.x = pk2(o[d][4 * g], o[d][4 * g + 1]); w.y = pk2(o[d][4 * g + 2], o[d][4 * g + 3]); *(u32x2*)(op + 32 * d + 8 * g) = w; }
    }
}

__device__ __forceinline__ void conv_phase(const bf16_t* __restrict__ U, const float* __restrict__ cw, const float* __restrict__ cb, bf16_t* __restrict__ ACT, int gtid, int nthreads) {
    constexpr int C8 = FF / 8;
    for (int it = gtid; it < MTOK * C8; it += nthreads) {
        const int row = it / C8, c8 = it - row * C8, j0 = c8 * 8, pn = j0 >> 7, q = j0 & 127, s = row & 2047;
        const bf16_t* ug = U + (size_t)row * NUP + 256 * pn + q;
        float cgv[2][8];
#pragma unroll
        for (int half = 0; half < 2; ++half) {
            const bf16_t* up = ug + half * 128; const int cc = half * FF + j0;
            const f32x4 b0 = *(const f32x4*)(cb + cc), b1 = *(const f32x4*)(cb + cc + 4);
            float accv[8] = {b0[0], b0[1], b0[2], b0[3], b1[0], b1[1], b1[2], b1[3]};
#pragma unroll
            for (int tap = 0; tap < 3; ++tap) { const int back = 2 - tap;
                if (s >= back) { const u32x4 w = *(const u32x4*)(up - (size_t)back * NUP);
                    const f32x4 w0 = *(const f32x4*)(cw + (size_t)tap * NUP + cc), w1 = *(const f32x4*)(cw + (size_t)tap * NUP + cc + 4);
                    accv[0] += __uint_as_float(w.x << 16) * w0[0]; accv[1] += __uint_as_float(w.x & 0xffff0000u) * w0[1];
                    accv[2] += __uint_as_float(w.y << 16) * w0[2]; accv[3] += __uint_as_float(w.y & 0xffff0000u) * w0[3];
                    accv[4] += __uint_as_float(w.z << 16) * w1[0]; accv[5] += __uint_as_float(w.z & 0xffff0000u) * w1[1];
                    accv[6] += __uint_as_float(w.w << 16) * w1[2]; accv[7] += __uint_as_float(w.w & 0xffff0000u) * w1[3]; } }
#pragma unroll
            for (int e = 0; e < 8; ++e) cgv[half][e] = accv[e];
        }
        float a8[8];
#pragma unroll
        for (int e = 0; e < 8; ++e) { const float gx = cgv[0][e]; a8[e] = gx / (1.0f + __expf(-gx)) * cgv[1][e]; }
        u32x4 w; w.x = pk2(a8[0], a8[1]); w.y = pk2(a8[2], a8[3]); w.z = pk2(a8[4], a8[5]); w.w = pk2(a8[6], a8[7]);
        *(u32x4*)(ACT + (size_t)row * FF + j0) = w;
    }
}

__device__ __forceinline__ unsigned fmap(float f) { const unsigned u = __float_as_uint(f); return (u & 0x80000000u) ? ~u : (u | 0x80000000u); }
__device__ __forceinline__ void indexer_unit(const bf16_t* __restrict__ QI, const bf16_t* __restrict__ KI, const float* __restrict__ WI, unsigned* __restrict__ MASK, LAS float* sc, int b, int t0, int wave, int lane) {
    const int r = lane & 31, hh = lane >> 5, ql_r = r >> 4, head_r = r & 15;
    const int tw = t0 + 2 * wave;
    const bf16_t* ap = QI + (size_t)(b * SEQ + tw + ql_r) * DM + head_r * HD + 8 * hh;
    bf16x8 af[8];
#pragma unroll
    for (int s = 0; s < 8; ++s) af[s] = *(const bf16x8*)(ap + 16 * s);
    float wv[16];
#pragma unroll
    for (int i = 0; i < 16; ++i) { const int rw = crow(i, hh); wv[i] = WI[(size_t)(b * SEQ + tw + (rw >> 4)) * 16 + (rw & 15)]; }
    const int nkt = (t0 + 16 + 31) >> 5;
    const bf16_t* kb = KI + (size_t)(b * SEQ + r) * HD + 8 * hh;
    LAS float* myrow = sc + (2 * wave + hh) * SEQ;
    const int tq = tw + hh;
    for (int kt = 0; kt < nkt; ++kt) {
        const bf16_t* kp = kb + (size_t)kt * 32 * HD;
        bf16x8 bfr[8];
#pragma unroll
        for (int s = 0; s < 8; ++s) bfr[s] = *(const bf16x8*)(kp + 16 * s);
        f32x16 c = f32x16{};
#pragma unroll
        for (int s = 0; s < 8; ++s) c = __builtin_amdgcn_mfma_f32_32x32x16_bf16(af[s], bfr[s], c, 0, 0, 0);
        float s0 = 0.f, s1 = 0.f;
#pragma unroll
        for (int i = 0; i < 8; ++i) { s0 += wv[i] * fmaxf(c[i], 0.f); s1 += wv[i + 8] * fmaxf(c[i + 8], 0.f); }
        const float t0s = swap_sum(s0), t1s = swap_sum(s1);
        const int key = kt * 32 + r;
        float v = (hh ? t1s : t0s) + 0.0f;
        if (key > tq) v = -INFINITY;
        myrow[key] = v;
    }
    asm volatile("s_waitcnt lgkmcnt(0)" ::: "memory");
    for (int ql = 0; ql < 2; ++ql) {
        const int t = tw + ql, n = t + 1;
        unsigned* mrow = MASK + (size_t)(b * SEQ + t) * 64;
        if (n <= TOPK) {
            const int key0 = 32 * lane; unsigned w;
            if (key0 + 31 <= t) w = 0xffffffffu; else if (key0 > t) w = 0u; else w = (1u << (t - key0 + 1)) - 1u;
            mrow[lane] = w;
        } else {
            const LAS float* row = sc + (2 * wave + ql) * SEQ;
            unsigned uv[32];
#pragma unroll
            for (int e = 0; e < 32; ++e) { const int key = e * 64 + lane; uv[e] = (key < n) ? fmap(row[key]) : 0x007fffffu; }
            unsigned prefix = 0u;
            for (int bit = 31; bit >= 0; --bit) {
                const unsigned cand = prefix | (1u << bit); int cnt = 0;
#pragma unroll
                for (int e = 0; e < 32; ++e) cnt += __popcll(__ballot(uv[e] >= cand));
                if (cnt >= TOPK) prefix = cand;
            }
            int cgt = 0;
#pragma unroll
            for (int e = 0; e < 32; ++e) cgt += __popcll(__ballot(uv[e] > prefix));
            const int need = TOPK - cgt; int running = 0;
            const unsigned long long ltm = (1ull << lane) - 1ull;
            unsigned long long keep = 0ull;
#pragma unroll
            for (int e = 0; e < 32; ++e) {
                const unsigned long long eq = __ballot(uv[e] == prefix);
                const bool sel = (uv[e] > prefix) || (uv[e] == prefix && (running + __popcll(eq & ltm)) < need);
                const unsigned long long m64 = __ballot(sel);
                running += __popcll(eq);
                if (lane == e) keep = m64;
            }
            if (lane < 32) *(unsigned long long*)(mrow + 2 * lane) = keep;
        }
    }
    asm volatile("s_waitcnt lgkmcnt(0)" ::: "memory");
}

__device__ __forceinline__ void dsa_attn_unit(const bf16_t* __restrict__ QD, const bf16_t* __restrict__ KD, const bf16_t* __restrict__ VTD, const unsigned* __restrict__ MASK, bf16_t* __restrict__ O,
                                              int b, int g, int h, int q0, int lane) {
    const int r = lane & 31, hh = lane >> 5;
    const bf16_t* qp = QD + (size_t)(b * SEQ + q0 + r) * DM + h * HD + 8 * hh;
    bf16x8 qf[8];
#pragma unroll
    for (int s = 0; s < 8; ++s) qf[s] = *(const bf16x8*)(qp + 16 * s);
    f32x16 o[4];
#pragma unroll
    for (int d = 0; d < 4; ++d) o[d] = f32x16{};
    float mrun = -1e30f, lrun = 0.f;
    const bf16_t* kbase = KD + (size_t)(b * SEQ + r) * (KVH * HD) + g * HD + 8 * hh;
    const bf16_t* vbase = VTD + ((size_t)(b * KVH + g) * HD + r) * SEQ + 4 * hh;
    const unsigned* mrow = MASK + (size_t)(b * SEQ + q0 + r) * 64;
    const int nkt = (q0 + 32) >> 5;
    for (int kt = 0; kt < nkt; ++kt) {
        const int key0 = kt * 32;
        const bf16_t* kp = kbase + (size_t)key0 * (KVH * HD);
        bf16x8 kf[8];
#pragma unroll
        for (int s = 0; s < 8; ++s) kf[s] = *(const bf16x8*)(kp + 16 * s);
        const unsigned mw = mrow[kt];
        bf16x8 vf[4][2];
#pragma unroll
        for (int d = 0; d < 4; ++d)
#pragma unroll
            for (int s2 = 0; s2 < 2; ++s2) { const bf16_t* vp = vbase + (size_t)(32 * d) * SEQ + key0 + 16 * s2;
                const s16x4 lo = *(const s16x4*)vp, hi = *(const s16x4*)(vp + 8);
                vf[d][s2] = (bf16x8){lo[0], lo[1], lo[2], lo[3], hi[0], hi[1], hi[2], hi[3]}; }
        f32x16 p = f32x16{};
#pragma unroll
        for (int s = 0; s < 8; ++s) p = __builtin_amdgcn_mfma_f32_32x32x16_bf16(kf[s], qf[s], p, 0, 0, 0);
        float tmax = -1e30f;
#pragma unroll
        for (int i = 0; i < 16; ++i) { const bool valid = (mw >> crow(i, hh)) & 1u; tmax = fmaxf(tmax, valid ? p[i] : -1e30f); }
        tmax = swap_max(tmax);
        const float mnew = fmaxf(mrun, tmax), alpha = __builtin_amdgcn_exp2f(mrun - mnew);
        float ls = 0.f; f32x16 pe;
#pragma unroll
        for (int i = 0; i < 16; ++i) { const bool valid = (mw >> crow(i, hh)) & 1u; const float e = valid ? __builtin_amdgcn_exp2f(p[i] - mnew) : 0.f; pe[i] = e; ls += e; }
        lrun = lrun * alpha + ls; mrun = mnew;
#pragma unroll
        for (int d = 0; d < 4; ++d)
#pragma unroll
            for (int i = 0; i < 16; ++i) o[d][i] *= alpha;
        const bf16x8 pa0 = pack8(pe, 0), pa1 = pack8(pe, 8);
#pragma unroll
        for (int d = 0; d < 4; ++d) { o[d] = __builtin_amdgcn_mfma_f32_32x32x16_bf16(vf[d][0], pa0, o[d], 0, 0, 0); o[d] = __builtin_amdgcn_mfma_f32_32x32x16_bf16(vf[d][1], pa1, o[d], 0, 0, 0); }
    }
    const float linv = 1.0f / swap_sum(lrun);
    bf16_t* op = O + (size_t)(b * SEQ + q0 + r) * DM + h * HD + 4 * hh;
#pragma unroll
    for (int d = 0; d < 4; ++d)
#pragma unroll
        for (int gq = 0; gq < 4; ++gq) { u32x2 w; w.x = pk2(o[d][4 * gq] * linv, o[d][4 * gq + 1] * linv); w.y = pk2(o[d][4 * gq + 2] * linv, o[d][4 * gq + 3] * linv); *(u32x2*)(op + 32 * d + 8 * gq) = w; }
}

constexpr int N_PHASES = 14;
__global__ void __launch_bounds__(512, 2) fwd_kernel(Args a) {
    extern __shared__ __attribute__((aligned(16))) unsigned char lds_raw[];
    LAS unsigned char* lds = (LAS unsigned char*)lds_raw;
    cg::grid_group grid = cg::this_grid();
    const int tid = threadIdx.x, lane = tid & 63, wave = __builtin_amdgcn_readfirstlane(tid >> 6);
    const int G = gridDim.x, bx = blockIdx.x;
    const int gw = bx * 8 + wave, ngw = G * 8;
    unsigned char* ws = a.ws;
    const int lo = a.ph_lo, hi = a.ph_hi;
#define IN(k) (lo <= (k) && (k) < hi)
#define SEAM(k) do { if (IN(k) && IN((k) + 1)) grid.sync(); } while (0)
    bf16_t* XB = (bf16_t*)(ws + WS_XB); float* X1 = (float*)(ws + WS_X1); float* X2 = (float*)(ws + WS_X2); float* PART = (float*)(ws + WS_PART);
    bf16_t* Qb = (bf16_t*)(ws + WS_Q); bf16_t* Kb = (bf16_t*)(ws + WS_K); bf16_t* Vtb = (bf16_t*)(ws + WS_VT); bf16_t* Ob = (bf16_t*)(ws + WS_O);
    bf16_t* QIb = (bf16_t*)(ws + WS_QI); bf16_t* KDb = (bf16_t*)(ws + WS_KD); bf16_t* VTDb = (bf16_t*)(ws + WS_VTD); bf16_t* KIb = (bf16_t*)(ws + WS_KI);
    float* WIb = (float*)(ws + WS_WI); unsigned* MASKb = (unsigned*)(ws + WS_MASK);
    bf16_t* Ub = (bf16_t*)(ws + WS_U); bf16_t* ACTb = (bf16_t*)(ws + WS_ACT);
    const float* ropeC = (const float*)(ws + WS_ROPE); const float* ropeS = ropeC + SEQ * 64;

    if (IN(0)) { prologue_phase(a, lds, gw, ngw, wave, lane); }
    SEAM(0);
    if (IN(1)) {
        pg8::Gemm g{XB, (const bf16_t*)(ws + WS_WQKV), MTOK, NQKV, DM}; pg8::StaticOrder S; S.init(MTOK, NQKV, G, bx);
        EpiQKV E{ws};
        pg8::gemm_phase<EpiQKV, pg8::StaticOrder, true, true>(lds, g, S, E);
    }
    SEAM(1);
    if (IN(2)) { sb_attn_phase(Qb, Kb, Vtb, Ob, gw, ngw, lane); }
    SEAM(2);
    if (IN(3)) {
        pg8::Gemm g{Ob, (const bf16_t*)(ws + WS_WO0), MTOK, DM, DM}; pg8::StaticOrder S; S.init(MTOK, DM, G, bx);
        EpiRes E{a.x, X1, XB, PART};
        pg8::gemm_phase<EpiRes, pg8::StaticOrder, true, true>(lds, g, S, E);
    }
    SEAM(3);
    if (IN(4)) {
        pg8::Gemm g{XB, (const bf16_t*)(ws + WS_WUP), MTOK, NUP, DM}; pg8::StaticOrder S; S.init(MTOK, NUP, G, bx);
        EpiUp E{Ub, PART};
        pg8::gemm_phase<EpiUp, pg8::StaticOrder, true, true>(lds, g, S, E);
    }
    SEAM(4);
    if (IN(5)) { conv_phase(Ub, a.conv_w, a.conv_b, ACTb, bx * 512 + tid, G * 512); }
    SEAM(5);
    if (IN(6)) {
        pg8::Gemm g{ACTb, (const bf16_t*)(ws + WS_WDN), MTOK, DM, FF}; pg8::StaticOrder S; S.init(MTOK, DM, G, bx);
        EpiRes E{X1, X2, XB, PART};
        pg8::gemm_phase<EpiRes, pg8::StaticOrder, true, true>(lds, g, S, E);
    }
    SEAM(6);
    if (IN(7)) {
        pg8::Gemm g{XB, (const bf16_t*)(ws + WS_WIN), MTOK, NINP, DM}; pg8::StaticOrder S; S.init(MTOK, NINP, G, bx);
        EpiDsaIn E{ws, (LAS float*)(lds + LDS_EPI)};
        pg8::gemm_phase<EpiDsaIn, pg8::StaticOrder, true, true>(lds, g, S, E);
    }
    SEAM(7);
    if (IN(8)) {
        for (int pr = bx; pr < 256; pr += G) { const int b = pr >> 6, p = pr & 63;
            indexer_unit(QIb, KIb, WIb, MASKb, (LAS float*)lds, b, 16 * (127 - p), wave, lane);
            indexer_unit(QIb, KIb, WIb, MASKb, (LAS float*)lds, b, 16 * p, wave, lane); }
    }
    SEAM(8);
    if (IN(9)) {
        for (int pr = bx; pr < 256; pr += G) { const int b = pr >> 6, g = (pr >> 4) & 3, p = pr & 15;
            const int hl = wave & 3, sub = wave >> 2;
            dsa_attn_unit(Qb, KDb, VTDb, MASKb, Ob, b, g, 4 * g + hl, 64 * (31 - p) + 32 * sub, lane);
            dsa_attn_unit(Qb, KDb, VTDb, MASKb, Ob, b, g, 4 * g + hl, 64 * p + 32 * sub, lane); }
    }
    SEAM(9);
    if (IN(10)) {
        pg8::Gemm g{Ob, (const bf16_t*)(ws + WS_WO1), MTOK, DM, DM}; pg8::StaticOrder S; S.init(MTOK, DM, G, bx);
        EpiRes E{X2, X1, XB, PART};
        pg8::gemm_phase<EpiRes, pg8::StaticOrder, true, true>(lds, g, S, E);
    }
    SEAM(10);
    if (IN(11)) {
        pg8::Gemm g{XB, (const bf16_t*)(ws + WS_WUP + 44 * MiB), MTOK, NUP, DM}; pg8::StaticOrder S; S.init(MTOK, NUP, G, bx);
        EpiUp E{Ub, PART};
        pg8::gemm_phase<EpiUp, pg8::StaticOrder, true, true>(lds, g, S, E);
    }
    SEAM(11);
    if (IN(12)) { conv_phase(Ub, a.conv_w + 3 * NUP, a.conv_b + NUP, ACTb, bx * 512 + tid, G * 512); }
    SEAM(12);
    if (IN(13)) {
        pg8::Gemm g{ACTb, (const bf16_t*)(ws + WS_WDN + 22 * MiB), MTOK, DM, FF}; pg8::StaticOrder S; S.init(MTOK, DM, G, bx);
        EpiRes E{X1, a.out, nullptr, nullptr};
        pg8::gemm_phase<EpiRes, pg8::StaticOrder, true, true>(lds, g, S, E);
    }
#undef IN
#undef SEAM
}

extern "C" void kernel_launch(void* const* d_in, const int* in_sizes, int n_in, void* d_out, int out_size, void* d_ws, size_t ws_size, hipStream_t stream) {
    static int grid = 0;
    if (grid == 0) {
        if (n_in != 14 || out_size != MTOK * DM || ws_size < WS_END) { fprintf(stderr, "kernel_launch: unexpected shapes (n_in %d out %d ws %zu)\n", n_in, out_size, ws_size); grid = -1; return; }
        int dev = 0, cus = 0, per_cu = 0;
        hipGetDevice(&dev); hipDeviceGetAttribute(&cus, hipDeviceAttributeMultiprocessorCount, dev);
        if (hipFuncSetAttribute((const void*)fwd_kernel, hipFuncAttributeMaxDynamicSharedMemorySize, LDS_BYTES) != hipSuccess) { fprintf(stderr, "kernel_launch: hipFuncSetAttribute failed\n"); grid = -1; return; }
        if (hipOccupancyMaxActiveBlocksPerMultiprocessor(&per_cu, (const void*)fwd_kernel, 512, LDS_BYTES) != hipSuccess || per_cu < 1) { fprintf(stderr, "kernel_launch: occupancy query says %d\n", per_cu); per_cu = 1; }
        (void)hipGetLastError();
        grid = cus;
    }
    if (grid < 0) return;
    Args a{};
    a.x = (const float*)d_in[0]; a.attn_g = (const float*)d_in[1]; a.ffn_g = (const float*)d_in[2]; a.w_qkv = (const float*)d_in[3]; a.w_o0 = (const float*)d_in[4]; a.w_in = (const float*)d_in[5];
    a.qn_g = (const float*)d_in[6]; a.kn_g = (const float*)d_in[7]; a.ikn_g = (const float*)d_in[8]; a.w_o1 = (const float*)d_in[9]; a.w_up = (const float*)d_in[10]; a.conv_w = (const float*)d_in[11];
    a.conv_b = (const float*)d_in[12]; a.w_down = (const float*)d_in[13]; a.out = (float*)d_out; a.ws = (unsigned char*)d_ws;
#if MK_ONE_LAUNCH
    a.ph_lo = 0; a.ph_hi = N_PHASES;
    void* args[] = {&a};
    hipError_t e = hipLaunchCooperativeKernel((const void*)fwd_kernel, dim3(grid), dim3(512), args, LDS_BYTES, stream);
    if (e != hipSuccess) fprintf(stderr, "cooperative launch failed: %s (grid %d)\n", hipGetErrorString(e), grid);
#else
    for (int p = 0; p < N_PHASES; ++p) {
        a.ph_lo = p; a.ph_hi = p + 1;
        void* args[] = {&a};
        hipError_t e = hipLaunchCooperativeKernel((const void*)fwd_kernel, dim3(grid), dim3(512), args, LDS_BYTES, stream);
        if (e != hipSuccess) { fprintf(stderr, "launch %d failed: %s (grid %d)\n", p, hipGetErrorString(e), grid); break; }
    }
#endif
}
```

```cpp
#include <hip/hip_runtime.h>
#include <hip/hip_cooperative_groups.h>
#include <cstdio>
#include <cstdint>
namespace cg = cooperative_groups;

#ifndef MK_ONE_LAUNCH
#define MK_ONE_LAUNCH 1
#endif

#define LAS __attribute__((address_space(3)))
typedef unsigned short bf16_t;
typedef short bf16x8 __attribute__((ext_vector_type(8)));
typedef short s16x4 __attribute__((ext_vector_type(4)));
typedef float f32x4 __attribute__((ext_vector_type(4)));
typedef float f32x2 __attribute__((ext_vector_type(2)));
typedef float f32x16 __attribute__((ext_vector_type(16)));
typedef unsigned u32x4 __attribute__((ext_vector_type(4)));
typedef unsigned u32x2 __attribute__((ext_vector_type(2)));
typedef __bf16 bf16x2_t __attribute__((ext_vector_type(2)));

constexpr int BATCH = 4, SEQ = 2048, DM = 2048, NH = 16, HD = 128, MTOK = BATCH * SEQ;
constexpr int FF = 5632, NUP = 2 * FF, NQKV = 3 * DM;
constexpr int KVH = 4, NIN = 5264, NINP = 5376;
constexpr int TOPK = 256;
constexpr float NORM_EPS = 1e-6f;
constexpr float LOG2E = 1.4426950408889634f;
constexpr float QSCALE = 0.08838834764831845f * LOG2E;

constexpr size_t MiB = 1u << 20;
constexpr size_t WS_WQKV = 0, WS_WO0 = 24 * MiB, WS_WIN = 32 * MiB, WS_WO1 = 53 * MiB, WS_WUP = 61 * MiB  , WS_WDN = 149 * MiB  ;
constexpr size_t WS_GAIN = 197 * MiB + 512 * 1024  ;
constexpr size_t WS_ROPE = 193 * MiB  , WS_PART = 194 * MiB, WS_MASK = 195 * MiB, WS_WI = 197 * MiB, WS_KI = 198 * MiB;
constexpr size_t WS_XB = 200 * MiB, WS_X1 = 232 * MiB, WS_X2 = 296 * MiB;
constexpr size_t WS_SCR = 360 * MiB;
constexpr size_t WS_U = WS_SCR, WS_ACT = WS_SCR + 176 * MiB;
constexpr size_t WS_Q = WS_SCR, WS_K = WS_SCR + 32 * MiB, WS_VT = WS_SCR + 64 * MiB, WS_O = WS_SCR + 96 * MiB, WS_QI = WS_SCR + 128 * MiB, WS_KD = WS_SCR + 160 * MiB, WS_VTD = WS_SCR + 168 * MiB;
constexpr size_t WS_END = WS_ACT + 88 * MiB;

constexpr int LDS_EPI = 131072;
constexpr int LDS_BYTES = 147456;

__device__ __forceinline__ unsigned pk2(float lo, float hi) { f32x2 v = {lo, hi}; bf16x2_t b = __builtin_convertvector(v, bf16x2_t); return __builtin_bit_cast(unsigned, b); }
__device__ __forceinline__ bf16_t f2bf(float f) { return (bf16_t)(pk2(f, 0.f) & 0xffffu); }
__device__ __forceinline__ int crow(int r, int hi) { return (r & 3) + 8 * (r >> 2) + 4 * hi; }
__device__ __forceinline__ bf16x8 pack8(const f32x16& p, int b) {
    u32x4 w; w.x = pk2(p[b], p[b + 1]); w.y = pk2(p[b + 2], p[b + 3]); w.z = pk2(p[b + 4], p[b + 5]); w.w = pk2(p[b + 6], p[b + 7]);
    return __builtin_bit_cast(bf16x8, w);
}
__device__ __forceinline__ float swap_sum(float v) { auto rr = __builtin_amdgcn_permlane32_swap(__float_as_uint(v), __float_as_uint(v), false, false); return __uint_as_float(rr[0]) + __uint_as_float(rr[1]); }
__device__ __forceinline__ float swap_max(float v) { auto rr = __builtin_amdgcn_permlane32_swap(__float_as_uint(v), __float_as_uint(v), false, false); return fmaxf(__uint_as_float(rr[0]), __uint_as_float(rr[1])); }
__device__ __forceinline__ float wave_sum(float v) {
#pragma unroll
    for (int o = 1; o < 64; o <<= 1) v += __shfl_xor(v, o);
    return v;
}
__device__ __forceinline__ float row_rstd(const float* part, int row, int fq) {
    const f32x4* p = (const f32x4*)(part + (size_t)row * 32 + 8 * fq);
    const f32x4 a = p[0], b = p[1]; float s = ((a.x + a.y) + (a.z + a.w)) + ((b.x + b.y) + (b.z + b.w));
    s += __shfl_xor(s, 16); s += __shfl_xor(s, 32);
    return 1.0f / sqrtf(s * (1.0f / DM) + NORM_EPS);
}

namespace pg8 {
constexpr int BM = 256, BK = 64, HALF = 128, HTB = HALF * BK * 2, STAGE_BYTES = 8 * HTB, NXCD = 8, WGM = 8;
__host__ __device__ __forceinline__ int lds_byte(int r, int c) { const int st = (r >> 4) * 2 + (c >> 5), rr = r & 15, cc = c & 31, ob = rr * 64 + cc * 2; return st * 1024 + (ob ^ (((ob >> 9) & 1) << 5)); }
__host__ __device__ __forceinline__ void stage_rc(int b, int& R, int& C) { const int st = b / 1024, sb = b % 1024, swz = sb ^ (((sb >> 9) & 1) << 5); R = (st >> 1) * 16 + swz / 64; C = (st & 1) * 32 + (swz % 64) / 2; }
__host__ __device__ __forceinline__ int perm32(int rho) { const int n = rho >> 4, i = rho & 15; return 8 * (i >> 2) + 4 * n + (i & 3); }
struct Unit { int pm, pn; };
struct Gemm { const bf16_t* A; const bf16_t* Bt; int M, N, K; };
struct StaticOrder {
    int nM, nN, nwg, G, c;
    __host__ __device__ void init(int M, int N, int G_, int c_) { nM = M / BM; nN = N / BM; nwg = nM * nN; G = G_; c = c_; }
    __host__ __device__ bool next(int i, Unit& u) const {
        const long L = (long)i * G + c; if (L >= nwg) return false;
        int wgid = (int)L; { const int q = nwg / NXCD, r = nwg % NXCD, xcd = wgid % NXCD, off = wgid / NXCD; wgid = (xcd < r ? xcd * (q + 1) : r * (q + 1) + (xcd - r) * q) + off; }
        const int nig = WGM * nN, gid = wgid / nig, fm = gid * WGM, gsz = (nM - fm) < WGM ? (nM - fm) : WGM;
        u.pm = fm + ((wgid % nig) % gsz); u.pn = (wgid % nig) / gsz; return true;
    }
};
template <class Epi, class Sched, bool ALIGN_EPI, bool SP2>
__device__ __forceinline__ void gemm_phase(LAS unsigned char* lds, const Gemm g, const Sched& S, const Epi& E) {
    const int tid = threadIdx.x, wid = __builtin_amdgcn_readfirstlane(tid >> 6), lane = tid & 63, wr = wid >> 2, wc = wid & 3, fr = lane & 15, fq = lane >> 4;
    const int K = g.K, nt = K / BK;
    unsigned voffA[2], voffB[2];
#pragma unroll
    for (int i = 0; i < 2; ++i) { int R, C; stage_rc(tid * 16 + i * 8192, R, C); const int Rb = Epi::PERM ? ((R & ~31) + perm32(R & 31)) : R;
        voffA[i] = (unsigned)(R * K + C) * 2u; voffB[i] = (unsigned)(Rb * K + C) * 2u; }
    const size_t kstep = (size_t)(BK * 2);
    const size_t hstep = (size_t)HALF * K * 2;
    const size_t tstep = 2 * hstep;
    const unsigned ldsw = (unsigned)wid * 1024u;
    const int aoff = lds_byte(wr * 64 + fr, fq * 8), boff = lds_byte(wc * 32 + fr, fq * 8);
#define PG8_SA(b, h) (((b) * 2 + (h)) * HTB)
#define PG8_SB(b, h) ((4 + (b) * 2 + (h)) * HTB)
#define PG8_STAGE(bufoff, gbase, voff) do { _Pragma("unroll") for (int _i = 0; _i < 2; ++_i) \
        __builtin_amdgcn_global_load_lds((const unsigned*)((const char*)(gbase) + (voff)[_i]), (LAS unsigned*)(lds + (bufoff) + ldsw + _i * 8192), 16, 0, 0); } while (0)
#define PG8_LDA(dst, b, h) do { _Pragma("unroll") for (int m = 0; m < 4; ++m) _Pragma("unroll") for (int k = 0; k < 2; ++k) dst[m][k] = *(const LAS bf16x8*)(lds + PG8_SA(b, h) + aoff + m * 2048 + k * 1024); } while (0)
#define PG8_LDB(dst, b, h) do { _Pragma("unroll") for (int n = 0; n < 2; ++n) _Pragma("unroll") for (int k = 0; k < 2; ++k) dst[n][k] = *(const LAS bf16x8*)(lds + PG8_SB(b, h) + boff + n * 2048 + k * 1024); } while (0)
#define PG8_MMA(ai, bj, At, Bt) do { __builtin_amdgcn_s_setprio(1); _Pragma("unroll") for (int m = 0; m < 4; ++m) _Pragma("unroll") for (int n = 0; n < 2; ++n) _Pragma("unroll") for (int k = 0; k < 2; ++k) \
        acc[ai][bj][m][n] = __builtin_amdgcn_mfma_f32_16x16x32_bf16(Bt[n][k], At[m][k], acc[ai][bj][m][n], 0, 0, 0); __builtin_amdgcn_s_setprio(0); } while (0)
#define PG8_WAIT_V(n) asm volatile("s_waitcnt vmcnt(" #n ")" ::: "memory")
#define PG8_WAIT_L(n) asm volatile("s_waitcnt lgkmcnt(" #n ")" ::: "memory")
#define PG8_BAR __builtin_amdgcn_s_barrier()
#define PG8_SCHED __builtin_amdgcn_sched_barrier(0)
    Unit cur, nxt; int ui = 0;
    if (!S.next(0, cur)) return;
    f32x4 acc[2][2][4][2];
#pragma unroll
    for (int a = 0; a < 2; ++a)
#pragma unroll
        for (int b = 0; b < 2; ++b)
#pragma unroll
            for (int m = 0; m < 4; ++m)
#pragma unroll
                for (int n = 0; n < 2; ++n) acc[a][b][m][n] = (f32x4){0.f, 0.f, 0.f, 0.f};
    bf16x8 At[4][2], B0[2][2], B1[2][2];
    const char* cA = (const char*)g.A + (size_t)cur.pm * tstep; const char* cB = (const char*)g.Bt + (size_t)cur.pn * tstep;
    if constexpr (SP2) {
        PG8_STAGE(PG8_SB(0, 0), cB, voffB); PG8_STAGE(PG8_SB(0, 1), cB + hstep, voffB); PG8_STAGE(PG8_SA(0, 0), cA, voffA); PG8_STAGE(PG8_SA(0, 1), cA + hstep, voffA);
        if (wr == 1) PG8_BAR;
        PG8_WAIT_V(2); PG8_BAR;
        PG8_STAGE(PG8_SB(1, 0), cB + kstep, voffB); PG8_STAGE(PG8_SA(1, 0), cA + kstep, voffA); PG8_STAGE(PG8_SB(1, 1), cB + hstep + kstep, voffB);
        PG8_WAIT_V(6); PG8_BAR;
    } else {
        PG8_STAGE(PG8_SB(0, 0), cB, voffB); PG8_STAGE(PG8_SA(0, 0), cA, voffA); PG8_STAGE(PG8_SB(0, 1), cB + hstep, voffB); PG8_STAGE(PG8_SA(0, 1), cA + hstep, voffA);
        if (wr == 1) PG8_BAR;
        PG8_WAIT_V(4); PG8_BAR;
        PG8_STAGE(PG8_SB(1, 0), cB + kstep, voffB); PG8_STAGE(PG8_SA(1, 0), cA + kstep, voffA); PG8_STAGE(PG8_SB(1, 1), cB + hstep + kstep, voffB);
        PG8_WAIT_V(6); PG8_BAR;
    }
    for (;;) {
        const bool has_next = S.next(ui + 1, nxt);
        const char* nA = has_next ? (const char*)g.A + (size_t)nxt.pm * tstep : cA; const char* nB = has_next ? (const char*)g.Bt + (size_t)nxt.pn * tstep : cB;
        for (int t = 0; t < nt; t += 2) {
            const bool last = (t == nt - 2);
            const char* a1 = cA + (size_t)(t + 1) * kstep;
            const char* a2 = last ? nA : cA + (size_t)(t + 2) * kstep; const char* b2 = last ? nB : cB + (size_t)(t + 2) * kstep;
            const char* a3 = a2 + kstep; const char* b3 = b2 + kstep;
            if constexpr (SP2) {
            PG8_LDB(B0, 0, 0); PG8_LDB(B1, 0, 1); PG8_SCHED; PG8_LDA(At, 0, 0); PG8_STAGE(PG8_SA(1, 1), a1 + hstep, voffA);
            PG8_WAIT_V(8); PG8_WAIT_L(0); PG8_BAR; PG8_MMA(0, 0, At, B0); PG8_MMA(0, 1, At, B1); PG8_BAR; PG8_SCHED;
            PG8_LDA(At, 0, 1); PG8_STAGE(PG8_SB(0, 0), b2, voffB); PG8_STAGE(PG8_SB(0, 1), b2 + hstep, voffB); PG8_STAGE(PG8_SA(0, 0), a2, voffA);
            PG8_WAIT_V(8); PG8_WAIT_L(0); PG8_BAR; PG8_MMA(1, 0, At, B0); PG8_MMA(1, 1, At, B1); PG8_BAR; PG8_SCHED;
            PG8_LDB(B0, 1, 0); PG8_LDB(B1, 1, 1); PG8_SCHED; PG8_LDA(At, 1, 0); PG8_STAGE(PG8_SA(0, 1), a2 + hstep, voffA);
            PG8_WAIT_V(8); PG8_WAIT_L(0); PG8_BAR; PG8_MMA(0, 0, At, B0); PG8_MMA(0, 1, At, B1); PG8_BAR; PG8_SCHED;
            PG8_LDA(At, 1, 1); PG8_STAGE(PG8_SB(1, 0), b3, voffB); PG8_STAGE(PG8_SB(1, 1), b3 + hstep, voffB); PG8_STAGE(PG8_SA(1, 0), a3, voffA);
            PG8_WAIT_V(8); PG8_WAIT_L(0); PG8_BAR; PG8_MMA(1, 0, At, B0); PG8_MMA(1, 1, At, B1); PG8_BAR; PG8_SCHED;
            } else {
            PG8_LDB(B0, 0, 0); PG8_SCHED; PG8_LDA(At, 0, 0); PG8_STAGE(PG8_SA(1, 1), a1 + hstep, voffA);
            PG8_WAIT_L(8); PG8_BAR; PG8_WAIT_L(0); PG8_MMA(0, 0, At, B0); PG8_BAR; PG8_SCHED;
            PG8_LDB(B1, 0, 1); PG8_STAGE(PG8_SB(0, 0), b2, voffB);
            PG8_BAR; PG8_WAIT_L(0); PG8_MMA(0, 1, At, B1); PG8_BAR;
            PG8_LDA(At, 0, 1); PG8_STAGE(PG8_SA(0, 0), a2, voffA);
            PG8_BAR; PG8_WAIT_L(0); PG8_MMA(1, 0, At, B0); PG8_BAR; PG8_SCHED;
            PG8_STAGE(PG8_SB(0, 1), b2 + hstep, voffB);
            PG8_WAIT_V(6); PG8_BAR; PG8_MMA(1, 1, At, B1); PG8_BAR;
            PG8_LDB(B0, 1, 0); PG8_SCHED; PG8_LDA(At, 1, 0); PG8_STAGE(PG8_SA(0, 1), a2 + hstep, voffA);
            PG8_WAIT_L(8); PG8_BAR; PG8_WAIT_L(0); PG8_MMA(0, 0, At, B0); PG8_BAR; PG8_SCHED;
            PG8_LDB(B1, 1, 1); PG8_STAGE(PG8_SB(1, 0), b3, voffB);
            PG8_BAR; PG8_WAIT_L(0); PG8_MMA(0, 1, At, B1); PG8_BAR;
            PG8_LDA(At, 1, 1); PG8_STAGE(PG8_SA(1, 0), a3, voffA);
            PG8_BAR; PG8_WAIT_L(0); PG8_MMA(1, 0, At, B0); PG8_BAR; PG8_SCHED;
            PG8_STAGE(PG8_SB(1, 1), b3 + hstep, voffB);
            PG8_WAIT_V(6); PG8_BAR; PG8_MMA(1, 1, At, B1); PG8_BAR;
            }
        }
        if constexpr (ALIGN_EPI) { if (wr == 0) PG8_BAR; }
        { int fr_ = fr, fq_ = fq; asm volatile("" : "+v"(fr_), "+v"(fq_)); E(acc, cur, wr, wc, fr_, fq_); }
        if (!has_next) break;
#pragma unroll
        for (int a = 0; a < 2; ++a)
#pragma unroll
            for (int b = 0; b < 2; ++b)
#pragma unroll
                for (int m = 0; m < 4; ++m)
#pragma unroll
                    for (int n = 0; n < 2; ++n) acc[a][b][m][n] = (f32x4){0.f, 0.f, 0.f, 0.f};
        cur = nxt; cA = nA; cB = nB; ++ui;
        if constexpr (ALIGN_EPI) { if (wr == 1) PG8_BAR; }
    }
    PG8_WAIT_V(0);
    if constexpr (!ALIGN_EPI) { if (wr == 0) PG8_BAR; }
    PG8_BAR;
#undef PG8_SA
#undef PG8_SB
#undef PG8_STAGE
#undef PG8_LDA
#undef PG8_LDB
#undef PG8_MMA
#undef PG8_WAIT_V
#undef PG8_WAIT_L
#undef PG8_BAR
#undef PG8_SCHED
}
}
using pg8::Unit;
typedef f32x4 AccT[2][2][4][2];

struct EpiQKV {
    static constexpr bool PERM = true;
    unsigned char* ws;
    __device__ __forceinline__ void operator()(const AccT& acc, const Unit& u, int wr, int wc, int fr, int fq) const {
        const int row0 = u.pm * 256 + wr * 64 + fr, kind = u.pn >> 3, colt = (u.pn & 7) * 256 + wc * 32 + 8 * fq;
        bf16_t* Vt = (bf16_t*)(ws + WS_VT);
        if (kind < 2) {
            bf16_t* base = (bf16_t*)(ws + (kind == 0 ? WS_Q : WS_K)); const float sc = kind == 0 ? QSCALE : 1.0f;
#pragma unroll
            for (int ai = 0; ai < 2; ++ai)
#pragma unroll
                for (int m = 0; m < 4; ++m) { bf16_t* rowp = base + (size_t)(row0 + ai * 128 + m * 16) * DM + colt;
#pragma unroll
                    for (int bj = 0; bj < 2; ++bj) { const f32x4 v0 = acc[ai][bj][m][0] * sc, v1 = acc[ai][bj][m][1] * sc;
                        u32x4 w; w.x = pk2(v0[0], v0[1]); w.y = pk2(v0[2], v0[3]); w.z = pk2(v1[0], v1[1]); w.w = pk2(v1[2], v1[3]);
                        *(u32x4*)(rowp + bj * 128) = w; } }
        } else {
#pragma unroll
            for (int ai = 0; ai < 2; ++ai)
#pragma unroll
                for (int m = 0; m < 4; ++m) { const int row = row0 + ai * 128 + m * 16, b = row >> 11, s = row & 2047;
#pragma unroll
                    for (int bj = 0; bj < 2; ++bj) { const int c0 = colt + bj * 128, h = c0 >> 7, d0 = c0 & 127;
                        bf16_t* p = Vt + ((size_t)(b * NH + h) * HD + d0) * SEQ + s;
#pragma unroll
                        for (int n = 0; n < 2; ++n)
#pragma unroll
                            for (int j = 0; j < 4; ++j) p[(size_t)(4 * n + j) * SEQ] = f2bf(acc[ai][bj][m][n][j]); } }
        }
    }
};
struct EpiRes {
    static constexpr bool PERM = true;
    const float* res; float* out; bf16_t* outb; float* part;
    __device__ __forceinline__ void operator()(const AccT& acc, const Unit& u, int wr, int wc, int fr, int fq) const {
        const int row0 = u.pm * 256 + wr * 64 + fr, col0 = u.pn * 256 + wc * 32 + 8 * fq;
#pragma unroll
        for (int ai = 0; ai < 2; ++ai)
#pragma unroll
            for (int m = 0; m < 4; ++m) { const int row = row0 + ai * 128 + m * 16; const size_t off = (size_t)row * DM + col0; float ss = 0.f;
#pragma unroll
                for (int bj = 0; bj < 2; ++bj) {
                    const f32x4 r0 = *(const f32x4*)(res + off + bj * 128), r1 = *(const f32x4*)(res + off + bj * 128 + 4);
                    const f32x4 v0 = acc[ai][bj][m][0] + r0, v1 = acc[ai][bj][m][1] + r1;
                    *(f32x4*)(out + off + bj * 128) = v0; *(f32x4*)(out + off + bj * 128 + 4) = v1;
                    if (outb) { u32x4 w; w.x = pk2(v0[0], v0[1]); w.y = pk2(v0[2], v0[3]); w.z = pk2(v1[0], v1[1]); w.w = pk2(v1[2], v1[3]); *(u32x4*)(outb + off + bj * 128) = w; }
                    ss += (v0[0] * v0[0] + v0[1] * v0[1]) + (v0[2] * v0[2] + v0[3] * v0[3]) + (v1[0] * v1[0] + v1[1] * v1[1]) + (v1[2] * v1[2] + v1[3] * v1[3]); }
                if (part) { ss += __shfl_xor(ss, 16); ss += __shfl_xor(ss, 32); if (fq == 0) part[(size_t)row * 32 + u.pn * 4 + wc] = ss; } }
    }
};
struct EpiUp {
    static constexpr bool PERM = true;
    bf16_t* U; const float* part;
    __device__ __forceinline__ void operator()(const AccT& acc, const Unit& u, int wr, int wc, int fr, int fq) const {
        const int row0 = u.pm * 256 + wr * 64 + fr, col0 = u.pn * 256 + wc * 32 + 8 * fq;
#pragma unroll
        for (int ai = 0; ai < 2; ++ai)
#pragma unroll
            for (int m = 0; m < 4; ++m) { const int row = row0 + ai * 128 + m * 16; const float rs = row_rstd(part, row, fq); bf16_t* rowp = U + (size_t)row * NUP + col0;
#pragma unroll
                for (int bj = 0; bj < 2; ++bj) { const f32x4 v0 = acc[ai][bj][m][0] * rs, v1 = acc[ai][bj][m][1] * rs;
                    u32x4 w; w.x = pk2(v0[0], v0[1]); w.y = pk2(v0[2], v0[3]); w.z = pk2(v1[0], v1[1]); w.w = pk2(v1[2], v1[3]);
                    *(u32x4*)(rowp + bj * 128) = w; } }
    }
};
struct EpiDsaIn {
    static constexpr bool PERM = false;
    unsigned char* ws; LAS float* scr;
    __device__ __forceinline__ void operator()(const AccT& acc_in, const Unit& u, int wr, int wc, int fr, int fq) const {
        const int row0 = u.pm * 256 + wr * 64 + fr;
        const float* part = (const float*)(ws + WS_PART); const float* ropeC = (const float*)(ws + WS_ROPE); const float* ropeS = ropeC + SEQ * 64;
        bf16_t* VTD = (bf16_t*)(ws + WS_VTD); float* WI = (float*)(ws + WS_WI);
        const bool need_norm = (u.pn < 10) || (u.pn == 20);
        float rs[2][4];
#pragma unroll
        for (int ai = 0; ai < 2; ++ai)
#pragma unroll
            for (int m = 0; m < 4; ++m) rs[ai][m] = row_rstd(part, row0 + ai * 128 + m * 16, fq);
        if (need_norm) {
#pragma unroll
            for (int ai = 0; ai < 2; ++ai)
#pragma unroll
                for (int m = 0; m < 4; ++m)
#pragma unroll
                    for (int bj = 0; bj < 2; ++bj) { const f32x4 a = acc_in[ai][bj][m][0], b = acc_in[ai][bj][m][1];
                        float ss = ((a[0] * a[0] + a[1] * a[1]) + (a[2] * a[2] + a[3] * a[3])) + ((b[0] * b[0] + b[1] * b[1]) + (b[2] * b[2] + b[3] * b[3]));
                        ss += __shfl_xor(ss, 16); ss += __shfl_xor(ss, 32);
                        if (fq == 0) scr[(ai * 128 + wr * 64 + m * 16 + fr) * 8 + bj * 4 + wc] = ss * rs[ai][m] * rs[ai][m]; }
            asm volatile("s_waitcnt lgkmcnt(0)" ::: "memory"); __builtin_amdgcn_s_barrier(); asm volatile("" ::: "memory");
        }
        const int dl = 16 * wc + 4 * fq;
#pragma unroll
        for (int bj = 0; bj < 2; ++bj) {
            const int hh = 2 * u.pn + bj;
            if (hh >= 20 && hh < 24) {
#pragma unroll
                for (int ai = 0; ai < 2; ++ai)
#pragma unroll
                    for (int m = 0; m < 4; ++m) { const int row = row0 + ai * 128 + m * 16, b = row >> 11, s = row & 2047; const float r = rs[ai][m];
                        bf16_t* p = VTD + ((size_t)(b * KVH + (hh - 20)) * HD + dl) * SEQ + s;
#pragma unroll
                        for (int n = 0; n < 2; ++n)
#pragma unroll
                            for (int e = 0; e < 4; ++e) p[(size_t)(64 * n + e) * SEQ] = f2bf(acc_in[ai][bj][m][n][e] * r); }
            } else if (hh == 41) {
                if (wc == 0) {
#pragma unroll
                    for (int ai = 0; ai < 2; ++ai)
#pragma unroll
                        for (int m = 0; m < 4; ++m) { const int row = row0 + ai * 128 + m * 16; *(f32x4*)(WI + (size_t)row * 16 + 4 * fq) = acc_in[ai][bj][m][0] * rs[ai][m]; } }
            } else {
                const bool norm = (hh < 20) || (hh == 40);
                const float* g = (const float*)(ws + WS_GAIN) + (hh < 16 ? 0 : (hh < 20 ? 128 : 256));
                f32x4 g0 = (f32x4){1.f, 1.f, 1.f, 1.f}, g1 = g0;
                if (norm) { g0 = *(const f32x4*)(g + dl); g1 = *(const f32x4*)(g + dl + 64); }
                size_t boff; int ld, cb;
                if (hh < 16) { boff = WS_Q; ld = DM; cb = hh * HD; } else if (hh < 20) { boff = WS_KD; ld = KVH * HD; cb = (hh - 16) * HD; }
                else if (hh < 40) { boff = WS_QI; ld = DM; cb = (hh - 24) * HD; } else { boff = WS_KI; ld = HD; cb = 0; }
                bf16_t* base = (bf16_t*)(ws + boff);
                const float osc = hh < 16 ? QSCALE : 1.0f;
#pragma unroll
                for (int ai = 0; ai < 2; ++ai)
#pragma unroll
                    for (int m = 0; m < 4; ++m) { const int lrow = ai * 128 + wr * 64 + m * 16 + fr, row = u.pm * 256 + lrow, pos = row & 2047;
                        float sc = rs[ai][m];
                        if (norm) { const f32x4 t = *(const LAS f32x4*)(scr + lrow * 8 + bj * 4); sc *= 1.0f / sqrtf(((t[0] + t[1]) + (t[2] + t[3])) * (1.0f / HD) + NORM_EPS); }
                        sc *= osc;
                        const f32x4 c = *(const f32x4*)(ropeC + pos * 64 + dl), sn = *(const f32x4*)(ropeS + pos * 64 + dl);
                        const f32x4 y0 = acc_in[ai][bj][m][0] * g0 * sc, y1 = acc_in[ai][bj][m][1] * g1 * sc;
                        const f32x4 o0 = y0 * c - y1 * sn, o1 = y1 * c + y0 * sn;
                        bf16_t* rp = base + (size_t)row * ld + cb + dl;
                        u32x2 w0, w1; w0.x = pk2(o0[0], o0[1]); w0.y = pk2(o0[2], o0[3]); w1.x = pk2(o1[0], o1[1]); w1.y = pk2(o1[2], o1[3]);
                        *(u32x2*)rp = w0; *(u32x2*)(rp + 64) = w1; }
            }
        }
    }
};

enum { WM_PLAIN = 0, WM_UP = 1, WM_IN = 2 };
__device__ __forceinline__ int colmap(int kind, int np) {
    if (kind == WM_UP) { const int pn = np >> 8, bj = (np >> 7) & 1, q = np & 127; return bj * FF + 128 * pn + q; }
    if (kind == WM_IN) { const int hh = np >> 7, p = np & 127, d = 16 * (p >> 5) + (p & 15) + 64 * ((p >> 4) & 1);
        if (hh < 41) return hh * 128 + d; return (p < 16) ? (5248 + p) : -1; }
    return np;
}
__device__ __forceinline__ void transpose_item(const float* W, int K, int N, int NP, const float* gain, int kind, bf16_t* WT, LAS float* scr, int item, int lane) {
    const int nblk = NP / 64, kb = item / nblk, nb = item % nblk, k0 = 64 * kb, n0 = 64 * nb;
    const int src = colmap(kind, n0 + lane);
#pragma unroll 8
    for (int kk = 0; kk < 64; ++kk) { float v = 0.f; if (src >= 0) { v = W[(size_t)(k0 + kk) * N + src]; if (gain) v *= gain[k0 + kk]; } scr[kk * 65 + lane] = v; }
    asm volatile("s_waitcnt lgkmcnt(0)" ::: "memory");
    const int c = lane & 7;
#pragma unroll
    for (int j = 0; j < 8; ++j) { const int n = (lane >> 3) + 8 * j; const LAS float* s = scr + (8 * c) * 65 + n;
        u32x4 o; o.x = pk2(s[0 * 65], s[1 * 65]); o.y = pk2(s[2 * 65], s[3 * 65]); o.z = pk2(s[4 * 65], s[5 * 65]); o.w = pk2(s[6 * 65], s[7 * 65]);
        *(u32x4*)(WT + (size_t)(n0 + n) * K + k0 + 8 * c) = o; }
    asm volatile("s_waitcnt lgkmcnt(0)" ::: "memory");
}

struct Args {
    const float* x; const float* attn_g; const float* ffn_g; const float* w_qkv; const float* w_o0; const float* w_in;
    const float* qn_g; const float* kn_g; const float* ikn_g; const float* w_o1; const float* w_up; const float* conv_w; const float* conv_b; const float* w_down;
    float* out; unsigned char* ws; int ph_lo, ph_hi;
};

__device__ __forceinline__ void weight_job(const float* W, int K, int N, int NP, const float* gain, int kind, bf16_t* WT, LAS float* scr, int gw, int ngw, int lane) {
    const int items = (K / 64) * (NP / 64);
    for (int it = gw; it < items; it += ngw) transpose_item(W, K, N, NP, gain, kind, WT, scr, it, lane);
}
__device__ __forceinline__ void prologue_phase(const Args& a, LAS unsigned char* lds, int gw, int ngw, int wave, int lane) {
    unsigned char* ws = a.ws;
    LAS float* scr = (LAS float*)(lds + wave * 16640);
    weight_job(a.w_qkv, DM, NQKV, NQKV, nullptr, WM_PLAIN, (bf16_t*)(ws + WS_WQKV), scr, gw, ngw, lane);
    weight_job(a.w_o0, DM, DM, DM, nullptr, WM_PLAIN, (bf16_t*)(ws + WS_WO0), scr, gw, ngw, lane);
    weight_job(a.w_in, DM, NIN, NINP, a.attn_g + DM, WM_IN, (bf16_t*)(ws + WS_WIN), scr, gw, ngw, lane);
    weight_job(a.w_o1, DM, DM, DM, nullptr, WM_PLAIN, (bf16_t*)(ws + WS_WO1), scr, gw, ngw, lane);
    weight_job(a.w_up, DM, NUP, NUP, a.ffn_g, WM_UP, (bf16_t*)(ws + WS_WUP), scr, gw, ngw, lane);
    weight_job(a.w_up + (size_t)DM * NUP, DM, NUP, NUP, a.ffn_g + DM, WM_UP, (bf16_t*)(ws + WS_WUP + 44 * MiB), scr, gw, ngw, lane);
    weight_job(a.w_down, FF, DM, DM, nullptr, WM_PLAIN, (bf16_t*)(ws + WS_WDN), scr, gw, ngw, lane);
    weight_job(a.w_down + (size_t)FF * DM, FF, DM, DM, nullptr, WM_PLAIN, (bf16_t*)(ws + WS_WDN + 22 * MiB), scr, gw, ngw, lane);
    bf16_t* XB = (bf16_t*)(ws + WS_XB);
    for (int m = gw; m < MTOK; m += ngw) {
        const f32x4* xr = (const f32x4*)(a.x + (size_t)m * DM) + lane;
        f32x4 v[8]; float s = 0.f;
#pragma unroll
        for (int j = 0; j < 8; ++j) { v[j] = xr[64 * j]; s += (v[j].x * v[j].x + v[j].y * v[j].y) + (v[j].z * v[j].z + v[j].w * v[j].w); }
        const float rstd = 1.0f / sqrtf(wave_sum(s) * (1.0f / DM) + NORM_EPS);
        u32x2* o8 = (u32x2*)(XB + (size_t)m * DM) + lane;
#pragma unroll
        for (int j = 0; j < 8; ++j) { const f32x4 g = ((const f32x4*)a.attn_g)[lane + 64 * j]; u32x2 w; w.x = pk2(v[j].x * rstd * g.x, v[j].y * rstd * g.y); w.y = pk2(v[j].z * rstd * g.z, v[j].w * rstd * g.w); o8[64 * j] = w; }
    }
    if (gw == 0) { float* gn = (float*)(ws + WS_GAIN); for (int i = lane; i < 128; i += 64) { gn[i] = a.qn_g[i]; gn[128 + i] = a.kn_g[i]; gn[256 + i] = a.ikn_g[i]; } }
    float* rc = (float*)(ws + WS_ROPE); float* rsn = rc + SEQ * 64;
    for (int i = gw * 64 + lane; i < SEQ * 64; i += ngw * 64) {
        const int pos = i >> 6, fi = i & 63;
        const float inv_freq = (float)(1.0 / exp2((double)fi * (2.0 / 128.0) * 13.287712379549449));
        const float ang = (float)pos * inv_freq;
        const double x = (double)ang; const double kq = rint(x * 0.63661977236758134308);
        double r = __builtin_fma(-kq, 1.57079632679489655800e+00, x); r = __builtin_fma(-kq, 6.12323399573676603587e-17, r);
        const double r2 = r * r;
        double sp = -1.0 / 6227020800.0; sp = sp * r2 + 1.0 / 39916800.0; sp = sp * r2 - 1.0 / 362880.0; sp = sp * r2 + 1.0 / 5040.0; sp = sp * r2 - 1.0 / 120.0; sp = sp * r2 + 1.0 / 6.0; const double sv = r - r * r2 * sp;
        double cp = 1.0 / 87178291200.0; cp = cp * r2 - 1.0 / 479001600.0; cp = cp * r2 + 1.0 / 3628800.0; cp = cp * r2 - 1.0 / 40320.0; cp = cp * r2 + 1.0 / 720.0; cp = cp * r2 - 1.0 / 24.0; cp = cp * r2 + 0.5; const double cv = 1.0 - r2 * cp;
        const int q = ((int)kq) & 3;
        const double cs = (q == 0) ? cv : (q == 1) ? -sv : (q == 2) ? -cv : sv;
        const double sn = (q == 0) ? sv : (q == 1) ? cv : (q == 2) ? -sv : -cv;
        rc[i] = (float)cs; rsn[i] = (float)sn;
    }
}

constexpr float SB_EXIT = 220.0f;
__device__ __forceinline__ void sb_attn_phase(const bf16_t* __restrict__ Q, const bf16_t* __restrict__ K, const bf16_t* __restrict__ Vt, bf16_t* __restrict__ O, int gw, int ngw, int lane) {
    const int r = lane & 31, hh = lane >> 5;
    bf16x8 uf[2];
#pragma unroll
    for (int s2 = 0; s2 < 2; ++s2) { u32x4 w;
        unsigned e[8];
#pragma unroll
        for (int j = 0; j < 8; ++j) { const int key = 16 * s2 + 8 * (j >> 2) + 4 * hh + (j & 3); e[j] = (key >= r) ? 0x3f80u : 0u; }
        w.x = e[0] | (e[1] << 16); w.y = e[2] | (e[3] << 16); w.z = e[4] | (e[5] << 16); w.w = e[6] | (e[7] << 16); uf[s2] = __builtin_bit_cast(bf16x8, w); }
    for (int unit = gw; unit < BATCH * NH * 64; unit += ngw) {
        const int bh = unit >> 6, qt = 63 - (unit & 63), b = bh >> 4, h = bh & 15, q0 = qt * 32;
        const bf16_t* qp = Q + (size_t)(b * SEQ + q0 + r) * DM + h * HD + 8 * hh;
        bf16x8 qf[8];
#pragma unroll
        for (int s = 0; s < 8; ++s) qf[s] = *(const bf16x8*)(qp + 16 * s);
        f32x16 o[4];
#pragma unroll
        for (int d = 0; d < 4; ++d) o[d] = f32x16{};
        float carry = 0.f;
        const bf16_t* kbase = K + (size_t)(b * SEQ + r) * DM + h * HD + 8 * hh;
        const bf16_t* vbase = Vt + ((size_t)bh * HD + r) * SEQ + 4 * hh;
        for (int kt = qt; kt >= 0; --kt) {
            const int key0 = kt * 32;
            const bf16_t* kp = kbase + (size_t)key0 * DM;
            bf16x8 kf[8];
#pragma unroll
            for (int s = 0; s < 8; ++s) kf[s] = *(const bf16x8*)(kp + 16 * s);
            bf16x8 vf[4][2];
#pragma unroll
            for (int d = 0; d < 4; ++d)
#pragma unroll
                for (int s2 = 0; s2 < 2; ++s2) { const bf16_t* vp = vbase + (size_t)(32 * d) * SEQ + key0 + 16 * s2;
                    const s16x4 lo = *(const s16x4*)vp, hi = *(const s16x4*)(vp + 8);
                    vf[d][s2] = (bf16x8){lo[0], lo[1], lo[2], lo[3], hi[0], hi[1], hi[2], hi[3]}; }
            f32x16 p = f32x16{};
#pragma unroll
            for (int s = 0; s < 8; ++s) p = __builtin_amdgcn_mfma_f32_32x32x16_bf16(kf[s], qf[s], p, 0, 0, 0);
            const bool diag = (kt == qt);
            f32x16 sp;
#pragma unroll
            for (int i = 0; i < 16; ++i) { const float z = p[i]; float v = fmaxf(z, 0.f) + __builtin_amdgcn_logf(1.0f + __builtin_amdgcn_exp2f(-fabsf(z)));
                if (diag && crow(i, hh) >= r) v = 0.f; sp[i] = v; }
            f32x16 c;
#pragma unroll
            for (int i = 0; i < 16; ++i) c[i] = carry;
            c = __builtin_amdgcn_mfma_f32_32x32x16_bf16(uf[0], pack8(sp, 0), c, 0, 0, 0);
            c = __builtin_amdgcn_mfma_f32_32x32x16_bf16(uf[1], pack8(sp, 8), c, 0, 0, 0);
            f32x16 av;
#pragma unroll
            for (int i = 0; i < 16; ++i) { float v = __builtin_amdgcn_exp2f(p[i] - c[i]); if (diag && crow(i, hh) >= r) v = 0.f; av[i] = v; }
            carry = swap_max(c[0]);
            const bf16x8 pa0 = pack8(av, 0), pa1 = pack8(av, 8);
#pragma unroll
            for (int d = 0; d < 4; ++d) { o[d] = __builtin_amdgcn_mfma_f32_32x32x16_bf16(vf[d][0], pa0, o[d], 0, 0, 0); o[d] = __builtin_amdgcn_mfma_f32_32x32x16_bf16(vf[d][1], pa1, o[d], 0, 0, 0); }
            if (__all(carry > SB_EXIT)) break;
        }
        bf16_t* op = O + (size_t)(b * SEQ + q0 + r) * DM + h * HD + 4 * hh;
#pragma unroll
        for (int d = 0; d < 4; ++d)
#pragma unroll
            for (int g = 0; g < 4; ++g) { u32x2 w; w.x = pk2(o[d][4 * g], o[d][4 * g + 1]); w.y = pk2(o[d][4 * g + 2], o[d][4 * g + 3]); *(u32x2*)(op + 32 * d + 8 * g) = w; }
    }
}

__device__ __forceinline__ void conv_phase(const bf16_t* __restrict__ U, const float* __restrict__ cw, const float* __restrict__ cb, bf16_t* __restrict__ ACT, int gtid, int nthreads) {
    constexpr int C8 = FF / 8;
    for (int it = gtid; it < MTOK * C8; it += nthreads) {
        const int row = it / C8, c8 = it - row * C8, j0 = c8 * 8, pn = j0 >> 7, q = j0 & 127, s = row & 2047;
        const bf16_t* ug = U + (size_t)row * NUP + 256 * pn + q;
        float cgv[2][8];
#pragma unroll
        for (int half = 0; half < 2; ++half) {
            const bf16_t* up = ug + half * 128; const int cc = half * FF + j0;
            const f32x4 b0 = *(const f32x4*)(cb + cc), b1 = *(const f32x4*)(cb + cc + 4);
            float accv[8] = {b0[0], b0[1], b0[2], b0[3], b1[0], b1[1], b1[2], b1[3]};
#pragma unroll
            for (int tap = 0; tap < 3; ++tap) { const int back = 2 - tap;
                if (s >= back) { const u32x4 w = *(const u32x4*)(up - (size_t)back * NUP);
                    const f32x4 w0 = *(const f32x4*)(cw + (size_t)tap * NUP + cc), w1 = *(const f32x4*)(cw + (size_t)tap * NUP + cc + 4);
                    accv[0] += __uint_as_float(w.x << 16) * w0[0]; accv[1] += __uint_as_float(w.x & 0xffff0000u) * w0[1];
                    accv[2] += __uint_as_float(w.y << 16) * w0[2]; accv[3] += __uint_as_float(w.y & 0xffff0000u) * w0[3];
                    accv[4] += __uint_as_float(w.z << 16) * w1[0]; accv[5] += __uint_as_float(w.z & 0xffff0000u) * w1[1];
                    accv[6] += __uint_as_float(w.w << 16) * w1[2]; accv[7] += __uint_as_float(w.w & 0xffff0000u) * w1[3]; } }
#pragma unroll
            for (int e = 0; e < 8; ++e) cgv[half][e] = accv[e];
        }
        float a8[8];
#pragma unroll
        for (int e = 0; e < 8; ++e) { const float gx = cgv[0][e]; a8[e] = gx / (1.0f + __expf(-gx)) * cgv[1][e]; }
        u32x4 w; w.x = pk2(a8[0], a8[1]); w.y = pk2(a8[2], a8[3]); w.z = pk2(a8[4], a8[5]); w.w = pk2(a8[6], a8[7]);
        *(u32x4*)(ACT + (size_t)row * FF + j0) = w;
    }
}

__device__ __forceinline__ unsigned fmap(float f) { const unsigned u = __float_as_uint(f); return (u & 0x80000000u) ? ~u : (u | 0x80000000u); }
__device__ __forceinline__ void indexer_unit(const bf16_t* __restrict__ QI, const bf16_t* __restrict__ KI, const float* __restrict__ WI, unsigned* __restrict__ MASK, LAS float* sc, int b, int t0, int wave, int lane) {
    const int r = lane & 31, hh = lane >> 5, ql_r = r >> 4, head_r = r & 15;
    const int tw = t0 + 2 * wave;
    const bf16_t* ap = QI + (size_t)(b * SEQ + tw + ql_r) * DM + head_r * HD + 8 * hh;
    bf16x8 af[8];
#pragma unroll
    for (int s = 0; s < 8; ++s) af[s] = *(const bf16x8*)(ap + 16 * s);
    float wv[16];
#pragma unroll
    for (int i = 0; i < 16; ++i) { const int rw = crow(i, hh); wv[i] = WI[(size_t)(b * SEQ + tw + (rw >> 4)) * 16 + (rw & 15)]; }
    const int nkt = (t0 + 16 + 31) >> 5;
    const bf16_t* kb = KI + (size_t)(b * SEQ + r) * HD + 8 * hh;
    LAS float* myrow = sc + (2 * wave + hh) * SEQ;
    const int tq = tw + hh;
    for (int kt = 0; kt < nkt; ++kt) {
        const bf16_t* kp = kb + (size_t)kt * 32 * HD;
        bf16x8 bfr[8];
#pragma unroll
        for (int s = 0; s < 8; ++s) bfr[s] = *(const bf16x8*)(kp + 16 * s);
        f32x16 c = f32x16{};
#pragma unroll
        for (int s = 0; s < 8; ++s) c = __builtin_amdgcn_mfma_f32_32x32x16_bf16(af[s], bfr[s], c, 0, 0, 0);
        float s0 = 0.f, s1 = 0.f;
#pragma unroll
        for (int i = 0; i < 8; ++i) { s0 += wv[i] * fmaxf(c[i], 0.f); s1 += wv[i + 8] * fmaxf(c[i + 8], 0.f); }
        const float t0s = swap_sum(s0), t1s = swap_sum(s1);
        const int key = kt * 32 + r;
        float v = (hh ? t1s : t0s) + 0.0f;
        if (key > tq) v = -INFINITY;
        myrow[key] = v;
    }
    asm volatile("s_waitcnt lgkmcnt(0)" ::: "memory");
    for (int ql = 0; ql < 2; ++ql) {
        const int t = tw + ql, n = t + 1;
        unsigned* mrow = MASK + (size_t)(b * SEQ + t) * 64;
        if (n <= TOPK) {
            const int key0 = 32 * lane; unsigned w;
            if (key0 + 31 <= t) w = 0xffffffffu; else if (key0 > t) w = 0u; else w = (1u << (t - key0 + 1)) - 1u;
            mrow[lane] = w;
        } else {
            const LAS float* row = sc + (2 * wave + ql) * SEQ;
            unsigned uv[32];
#pragma unroll
            for (int e = 0; e < 32; ++e) { const int key = e * 64 + lane; uv[e] = (key < n) ? fmap(row[key]) : 0x007fffffu; }
            unsigned prefix = 0u;
            for (int bit = 31; bit >= 0; --bit) {
                const unsigned cand = prefix | (1u << bit); int cnt = 0;
#pragma unroll
                for (int e = 0; e < 32; ++e) cnt += __popcll(__ballot(uv[e] >= cand));
                if (cnt >= TOPK) prefix = cand;
            }
            int cgt = 0;
#pragma unroll
            for (int e = 0; e < 32; ++e) cgt += __popcll(__ballot(uv[e] > prefix));
            const int need = TOPK - cgt; int running = 0;
            const unsigned long long ltm = (1ull << lane) - 1ull;
            unsigned long long keep = 0ull;
#pragma unroll
            for (int e = 0; e < 32; ++e) {
                const unsigned long long eq = __ballot(uv[e] == prefix);
                const bool sel = (uv[e] > prefix) || (uv[e] == prefix && (running + __popcll(eq & ltm)) < need);
                const unsigned long long m64 = __ballot(sel);
                running += __popcll(eq);
                if (lane == e) keep = m64;
            }
            if (lane < 32) *(unsigned long long*)(mrow + 2 * lane) = keep;
        }
    }
    asm volatile("s_waitcnt lgkmcnt(0)" ::: "memory");
}

__device__ __forceinline__ void dsa_attn_unit(const bf16_t* __restrict__ QD, const bf16_t* __restrict__ KD, const bf16_t* __restrict__ VTD, const unsigned* __restrict__ MASK, bf16_t* __restrict__ O,
                                              int b, int g, int h, int q0, int lane) {
    const int r = lane & 31, hh = lane >> 5;
    const bf16_t* qp = QD + (size_t)(b * SEQ + q0 + r) * DM + h * HD + 8 * hh;
    bf16x8 qf[8];
#pragma unroll
    for (int s = 0; s < 8; ++s) qf[s] = *(const bf16x8*)(qp + 16 * s);
    f32x16 o[4];
#pragma unroll
    for (int d = 0; d < 4; ++d) o[d] = f32x16{};
    float mrun = -1e30f, lrun = 0.f;
    const bf16_t* kbase = KD + (size_t)(b * SEQ + r) * (KVH * HD) + g * HD + 8 * hh;
    const bf16_t* vbase = VTD + ((size_t)(b * KVH + g) * HD + r) * SEQ + 4 * hh;
    const unsigned* mrow = MASK + (size_t)(b * SEQ + q0 + r) * 64;
    const int nkt = (q0 + 32) >> 5;
    for (int kt = 0; kt < nkt; ++kt) {
        const int key0 = kt * 32;
        const bf16_t* kp = kbase + (size_t)key0 * (KVH * HD);
        bf16x8 kf[8];
#pragma unroll
        for (int s = 0; s < 8; ++s) kf[s] = *(const bf16x8*)(kp + 16 * s);
        const unsigned mw = mrow[kt];
        bf16x8 vf[4][2];
#pragma unroll
        for (int d = 0; d < 4; ++d)
#pragma unroll
            for (int s2 = 0; s2 < 2; ++s2) { const bf16_t* vp = vbase + (size_t)(32 * d) * SEQ + key0 + 16 * s2;
                const s16x4 lo = *(const s16x4*)vp, hi = *(const s16x4*)(vp + 8);
                vf[d][s2] = (bf16x8){lo[0], lo[1], lo[2], lo[3], hi[0], hi[1], hi[2], hi[3]}; }
        f32x16 p = f32x16{};
#pragma unroll
        for (int s = 0; s < 8; ++s) p = __builtin_amdgcn_mfma_f32_32x32x16_bf16(kf[s], qf[s], p, 0, 0, 0);
        float tmax = -1e30f;
#pragma unroll
        for (int i = 0; i < 16; ++i) { const bool valid = (mw >> crow(i, hh)) & 1u; tmax = fmaxf(tmax, valid ? p[i] : -1e30f); }
        tmax = swap_max(tmax);
        const float mnew = fmaxf(mrun, tmax), alpha = __builtin_amdgcn_exp2f(mrun - mnew);
        float ls = 0.f; f32x16 pe;
#pragma unroll
        for (int i = 0; i < 16; ++i) { const bool valid = (mw >> crow(i, hh)) & 1u; const float e = valid ? __builtin_amdgcn_exp2f(p[i] - mnew) : 0.f; pe[i] = e; ls += e; }
        lrun = lrun * alpha + ls; mrun = mnew;
#pragma unroll
        for (int d = 0; d < 4; ++d)
#pragma unroll
            for (int i = 0; i < 16; ++i) o[d][i] *= alpha;
        const bf16x8 pa0 = pack8(pe, 0), pa1 = pack8(pe, 8);
#pragma unroll
        for (int d = 0; d < 4; ++d) { o[d] = __builtin_amdgcn_mfma_f32_32x32x16_bf16(vf[d][0], pa0, o[d], 0, 0, 0); o[d] = __builtin_amdgcn_mfma_f32_32x32x16_bf16(vf[d][1], pa1, o[d], 0, 0, 0); }
    }
    const float linv = 1.0f / swap_sum(lrun);
    bf16_t* op = O + (size_t)(b * SEQ + q0 + r) * DM + h * HD + 4 * hh;
#pragma unroll
    for (int d = 0; d < 4; ++d)
#pragma unroll
        for (int gq = 0; gq < 4; ++gq) { u32x2 w; w.x = pk2(o[d][4 * gq] * linv, o[d][4 * gq + 1] * linv); w.y = pk2(o[d][4 * gq + 2] * linv, o[d][4 * gq + 3] * linv); *(u32x2*)(op + 32 * d + 8 * gq) = w; }
}

constexpr int N_PHASES = 14;
__global__ void __launch_bounds__(512, 2) fwd_kernel(Args a) {
    extern __shared__ __attribute__((aligned(16))) unsigned char lds_raw[];
    LAS unsigned char* lds = (LAS unsigned char*)lds_raw;
    cg::grid_group grid = cg::this_grid();
    const int tid = threadIdx.x, lane = tid & 63, wave = __builtin_amdgcn_readfirstlane(tid >> 6);
    const int G = gridDim.x, bx = blockIdx.x;
    const int gw = bx * 8 + wave, ngw = G * 8;
    unsigned char* ws = a.ws;
    const int lo = a.ph_lo, hi = a.ph_hi;
#define IN(k) (lo <= (k) && (k) < hi)
#define SEAM(k) do { if (IN(k) && IN((k) + 1)) grid.sync(); } while (0)
    bf16_t* XB = (bf16_t*)(ws + WS_XB); float* X1 = (float*)(ws + WS_X1); float* X2 = (float*)(ws + WS_X2); float* PART = (float*)(ws + WS_PART);
    bf16_t* Qb = (bf16_t*)(ws + WS_Q); bf16_t* Kb = (bf16_t*)(ws + WS_K); bf16_t* Vtb = (bf16_t*)(ws + WS_VT); bf16_t* Ob = (bf16_t*)(ws + WS_O);
    bf16_t* QIb = (bf16_t*)(ws + WS_QI); bf16_t* KDb = (bf16_t*)(ws + WS_KD); bf16_t* VTDb = (bf16_t*)(ws + WS_VTD); bf16_t* KIb = (bf16_t*)(ws + WS_KI);
    float* WIb = (float*)(ws + WS_WI); unsigned* MASKb = (unsigned*)(ws + WS_MASK);
    bf16_t* Ub = (bf16_t*)(ws + WS_U); bf16_t* ACTb = (bf16_t*)(ws + WS_ACT);
    const float* ropeC = (const float*)(ws + WS_ROPE); const float* ropeS = ropeC + SEQ * 64;

    if (IN(0)) { prologue_phase(a, lds, gw, ngw, wave, lane); }
    SEAM(0);
    if (IN(1)) {
        pg8::Gemm g{XB, (const bf16_t*)(ws + WS_WQKV), MTOK, NQKV, DM}; pg8::StaticOrder S; S.init(MTOK, NQKV, G, bx);
        EpiQKV E{ws};
        pg8::gemm_phase<EpiQKV, pg8::StaticOrder, true, true>(lds, g, S, E);
    }
    SEAM(1);
    if (IN(2)) { sb_attn_phase(Qb, Kb, Vtb, Ob, gw, ngw, lane); }
    SEAM(2);
    if (IN(3)) {
        pg8::Gemm g{Ob, (const bf16_t*)(ws + WS_WO0), MTOK, DM, DM}; pg8::StaticOrder S; S.init(MTOK, DM, G, bx);
        EpiRes E{a.x, X1, XB, PART};
        pg8::gemm_phase<EpiRes, pg8::StaticOrder, true, true>(lds, g, S, E);
    }
    SEAM(3);
    if (IN(4)) {
        pg8::Gemm g{XB, (const bf16_t*)(ws + WS_WUP), MTOK, NUP, DM}; pg8::StaticOrder S; S.init(MTOK, NUP, G, bx);
        EpiUp E{Ub, PART};
        pg8::gemm_phase<EpiUp, pg8::StaticOrder, true, true>(lds, g, S, E);
    }
    SEAM(4);
    if (IN(5)) { conv_phase(Ub, a.conv_w, a.conv_b, ACTb, bx * 512 + tid, G * 512); }
    SEAM(5);
    if (IN(6)) {
        pg8::Gemm g{ACTb, (const bf16_t*)(ws + WS_WDN), MTOK, DM, FF}; pg8::StaticOrder S; S.init(MTOK, DM, G, bx);
        EpiRes E{X1, X2, XB, PART};
        pg8::gemm_phase<EpiRes, pg8::StaticOrder, true, true>(lds, g, S, E);
    }
    SEAM(6);
    if (IN(7)) {
        pg8::Gemm g{XB, (const bf16_t*)(ws + WS_WIN), MTOK, NINP, DM}; pg8::StaticOrder S; S.init(MTOK, NINP, G, bx);
        EpiDsaIn E{ws, (LAS float*)(lds + LDS_EPI)};
        pg8::gemm_phase<EpiDsaIn, pg8::StaticOrder, true, true>(lds, g, S, E);
    }
    SEAM(7);
    if (IN(8)) {
        for (int pr = bx; pr < 256; pr += G) { const int b = pr >> 6, p = pr & 63;
            indexer_unit(QIb, KIb, WIb, MASKb, (LAS float*)lds, b, 16 * (127 - p), wave, lane);
            indexer_unit(QIb, KIb, WIb, MASKb, (LAS float*)lds, b, 16 * p, wave, lane); }
    }
    SEAM(8);
    if (IN(9)) {
        for (int pr = bx; pr < 256; pr += G) { const int b = pr >> 6, g = (pr >> 4) & 3, p = pr & 15;
            const int hl = wave & 3, sub = wave >> 2;
            dsa_attn_unit(Qb, KDb, VTDb, MASKb, Ob, b, g, 4 * g + hl, 64 * (31 - p) + 32 * sub, lane);
            dsa_attn_unit(Qb, KDb, VTDb, MASKb, Ob, b, g, 4 * g + hl, 64 * p + 32 * sub, lane); }
    }
    SEAM(9);
    if (IN(10)) {
        pg8::Gemm g{Ob, (const bf16_t*)(ws + WS_WO1), MTOK, DM, DM}; pg8::StaticOrder S; S.init(MTOK, DM, G, bx);
        EpiRes E{X2, X1, XB, PART};
        pg8::gemm_phase<EpiRes, pg8::StaticOrder, true, true>(lds, g, S, E);
    }
    SEAM(10);
    if (IN(11)) {
        pg8::Gemm g{XB, (const bf16_t*)(ws + WS_WUP + 44 * MiB), MTOK, NUP, DM}; pg8::StaticOrder S; S.init(MTOK, NUP, G, bx);
        EpiUp E{Ub, PART};
        pg8::gemm_phase<EpiUp, pg8::StaticOrder, true, true>(lds, g, S, E);
    }
    SEAM(11);
    if (IN(12)) { conv_phase(Ub, a.conv_w + 3 * NUP, a.conv_b + NUP, ACTb, bx * 512 + tid, G * 512); }
    SEAM(12);
    if (IN(13)) {
        pg8::Gemm g{ACTb, (const bf16_t*)(ws + WS_WDN + 22 * MiB), MTOK, DM, FF}; pg8::StaticOrder S; S.init(MTOK, DM, G, bx);
        EpiRes E{X1, a.out, nullptr, nullptr};
        pg8::gemm_phase<EpiRes, pg8::StaticOrder, true, true>(lds, g, S, E);
    }
#undef IN
#undef SEAM
}

extern "C" void kernel_launch(void* const* d_in, const int* in_sizes, int n_in, void* d_out, int out_size, void* d_ws, size_t ws_size, hipStream_t stream) {
    static int grid = 0;
    if (grid == 0) {
        if (n_in != 14 || out_size != MTOK * DM || ws_size < WS_END) { fprintf(stderr, "kernel_launch: unexpected shapes (n_in %d out %d ws %zu)\n", n_in, out_size, ws_size); grid = -1; return; }
        int dev = 0, cus = 0, per_cu = 0;
        hipGetDevice(&dev); hipDeviceGetAttribute(&cus, hipDeviceAttributeMultiprocessorCount, dev);
        if (hipFuncSetAttribute((const void*)fwd_kernel, hipFuncAttributeMaxDynamicSharedMemorySize, LDS_BYTES) != hipSuccess) { fprintf(stderr, "kernel_launch: hipFuncSetAttribute failed\n"); grid = -1; return; }
        if (hipOccupancyMaxActiveBlocksPerMultiprocessor(&per_cu, (const void*)fwd_kernel, 512, LDS_BYTES) != hipSuccess || per_cu < 1) { fprintf(stderr, "kernel_launch: occupancy query says %d\n", per_cu); per_cu = 1; }
        (void)hipGetLastError();
        grid = cus;
    }
    if (grid < 0) return;
    Args a{};
    a.x = (const float*)d_in[0]; a.attn_g = (const float*)d_in[1]; a.ffn_g = (const float*)d_in[2]; a.w_qkv = (const float*)d_in[3]; a.w_o0 = (const float*)d_in[4]; a.w_in = (const float*)d_in[5];
    a.qn_g = (const float*)d_in[6]; a.kn_g = (const float*)d_in[7]; a.ikn_g = (const float*)d_in[8]; a.w_o1 = (const float*)d_in[9]; a.w_up = (const float*)d_in[10]; a.conv_w = (const float*)d_in[11];
    a.conv_b = (const float*)d_in[12]; a.w_down = (const float*)d_in[13]; a.out = (float*)d_out; a.ws = (unsigned char*)d_ws;
#if MK_ONE_LAUNCH
    a.ph_lo = 0; a.ph_hi = N_PHASES;
    void* args[] = {&a};
    hipError_t e = hipLaunchCooperativeKernel((const void*)fwd_kernel, dim3(grid), dim3(512), args, LDS_BYTES, stream);
    if (e != hipSuccess) fprintf(stderr, "cooperative launch failed: %s (grid %d)\n", hipGetErrorString(e), grid);
#else
    for (int p = 0; p < N_PHASES; ++p) {
        a.ph_lo = p; a.ph_hi = p + 1;
        void* args[] = {&a};
        hipError_t e = hipLaunchCooperativeKernel((const void*)fwd_kernel, dim3(grid), dim3(512), args, LDS_BYTES, stream);
        if (e != hipSuccess) { fprintf(stderr, "launch %d failed: %s (grid %d)\n", p, hipGetErrorString(e), grid); break; }
    }
#endif
}
```

```cpp
#include <hip/hip_runtime.h>
#include <hip/hip_cooperative_groups.h>
#include <cstdio>
#include <cstdint>
namespace cg = cooperative_groups;

#ifndef MK_ONE_LAUNCH
#define MK_ONE_LAUNCH 1
#endif

#define LAS __attribute__((address_space(3)))
typedef unsigned short bf16_t;
typedef short bf16x8 __attribute__((ext_vector_type(8)));
typedef short s16x4 __attribute__((ext_vector_type(4)));
typedef float f32x4 __attribute__((ext_vector_type(4)));
typedef float f32x2 __attribute__((ext_vector_type(2)));
typedef float f32x16 __attribute__((ext_vector_type(16)));
typedef unsigned u32x4 __attribute__((ext_vector_type(4)));
typedef unsigned u32x2 __attribute__((ext_vector_type(2)));
typedef __bf16 bf16x2_t __attribute__((ext_vector_type(2)));

constexpr int BATCH = 4, SEQ = 2048, DM = 2048, NH = 16, HD = 128, MTOK = BATCH * SEQ;
constexpr int FF = 5632, NUP = 2 * FF, NQKV = 3 * DM;
constexpr int KVH = 4, NIN = 5264, NINP = 5376;
constexpr int TOPK = 256;
constexpr float NORM_EPS = 1e-6f;
constexpr float LOG2E = 1.4426950408889634f;
constexpr float QSCALE = 0.08838834764831845f * LOG2E;

constexpr size_t MiB = 1u << 20;
constexpr size_t WS_WQKV = 0, WS_WO0 = 24 * MiB, WS_WIN = 32 * MiB, WS_WO1 = 53 * MiB, WS_WUP = 61 * MiB  , WS_WDN = 149 * MiB  ;
constexpr size_t WS_GAIN = 197 * MiB + 512 * 1024  ;
constexpr size_t WS_ROPE = 193 * MiB  , WS_PART = 194 * MiB, WS_MASK = 195 * MiB, WS_WI = 197 * MiB, WS_KI = 198 * MiB;
constexpr size_t WS_XB = 200 * MiB, WS_X1 = 232 * MiB, WS_X2 = 296 * MiB;
constexpr size_t WS_SCR = 360 * MiB;
constexpr size_t WS_U = WS_SCR, WS_ACT = WS_SCR + 176 * MiB;
constexpr size_t WS_Q = WS_SCR, WS_K = WS_SCR + 32 * MiB, WS_VT = WS_SCR + 64 * MiB, WS_O = WS_SCR + 96 * MiB, WS_QI = WS_SCR + 128 * MiB, WS_KD = WS_SCR + 160 * MiB, WS_VTD = WS_SCR + 168 * MiB;
constexpr size_t WS_CTL = WS_ACT + 88 * MiB, CTL_BYTES = 65536;
constexpr size_t WS_END = WS_CTL + CTL_BYTES;

constexpr int LDS_EPI = 131072;
constexpr int LDS_MISC = LDS_EPI + 8192;
constexpr int LDS_BYTES = 147456;

__device__ __forceinline__ unsigned pk2(float lo, float hi) { f32x2 v = {lo, hi}; bf16x2_t b = __builtin_convertvector(v, bf16x2_t); return __builtin_bit_cast(unsigned, b); }
__device__ __forceinline__ bf16_t f2bf(float f) { return (bf16_t)(pk2(f, 0.f) & 0xffffu); }
__device__ __forceinline__ int crow(int r, int hi) { return (r & 3) + 8 * (r >> 2) + 4 * hi; }
__device__ __forceinline__ bf16x8 pack8(const f32x16& p, int b) {
    u32x4 w; w.x = pk2(p[b], p[b + 1]); w.y = pk2(p[b + 2], p[b + 3]); w.z = pk2(p[b + 4], p[b + 5]); w.w = pk2(p[b + 6], p[b + 7]);
    return __builtin_bit_cast(bf16x8, w);
}
__device__ __forceinline__ float swap_sum(float v) { auto rr = __builtin_amdgcn_permlane32_swap(__float_as_uint(v), __float_as_uint(v), false, false); return __uint_as_float(rr[0]) + __uint_as_float(rr[1]); }
__device__ __forceinline__ float swap_max(float v) { auto rr = __builtin_amdgcn_permlane32_swap(__float_as_uint(v), __float_as_uint(v), false, false); return fmaxf(__uint_as_float(rr[0]), __uint_as_float(rr[1])); }
__device__ __forceinline__ float wave_sum(float v) {
#pragma unroll
    for (int o = 1; o < 64; o <<= 1) v += __shfl_xor(v, o);
    return v;
}
__device__ __forceinline__ float row_rstd(const float* part, int row, int fq) {
    const f32x4* p = (const f32x4*)(part + (size_t)row * 32 + 8 * fq);
    const f32x4 a = p[0], b = p[1]; float s = ((a.x + a.y) + (a.z + a.w)) + ((b.x + b.y) + (b.z + b.w));
    s += __shfl_xor(s, 16); s += __shfl_xor(s, 32);
    return 1.0f / sqrtf(s * (1.0f / DM) + NORM_EPS);
}


#define XB_TMO      128
#define XB_XCNT(j)  (256  + 64 * (j))
#define XB_XSUB(j)  (1280 + 64 * (j))
#define XB_XGEN(j)  (2304 + 64 * (j))
#define XB_TOP      3328
#define XB_TOPGEN   3392
#define XCD_BAR_WORDS 3456
#define XB_SPIN_CAP (1u << 18)
__device__ __forceinline__ unsigned xb_ld(unsigned* p)              { return __hip_atomic_load(p, __ATOMIC_RELAXED, __HIP_MEMORY_SCOPE_AGENT); }
__device__ __forceinline__ unsigned xb_add(unsigned* p, unsigned v) { return __hip_atomic_fetch_add(p, v, __ATOMIC_RELAXED, __HIP_MEMORY_SCOPE_AGENT); }
__device__ __forceinline__ unsigned xb_xcc_id() { return (unsigned)__builtin_amdgcn_s_getreg((3 << 11) | 20) & 0xFu; }
#define XB_SPIN(cond, bar) do { unsigned _sp = 0; while (cond) { __builtin_amdgcn_s_sleep(1); \
    if ((++_sp & 255u) == 0u) { if (xb_ld(&(bar)[XB_TMO])) break; if (_sp > XB_SPIN_CAP) { atomicAdd(&(bar)[XB_TMO], 1u); break; } } } } while (0)
struct XcdBarrier { unsigned* bar; unsigned x; volatile LAS unsigned* st; };
__device__ __forceinline__ XcdBarrier xcd_barrier_post(unsigned* bar, volatile LAS unsigned* st) {
    XcdBarrier b; b.bar = bar; b.x = xb_xcc_id(); b.st = st;
    if (threadIdx.x == 0) (void)xb_add(&bar[XB_XCNT(b.x)], 1u);
    return b;
}
__device__ __forceinline__ void xcd_barrier_complete(unsigned* bar, unsigned x, unsigned& nloc, unsigned& nx) {
    const unsigned G = gridDim.x * gridDim.y * gridDim.z;
    unsigned sum, cnt, mine, sp = 0u;
    for (;;) {
        sum = 0u; cnt = 0u; mine = 0u;
#pragma unroll
        for (unsigned j = 0; j < 16; ++j) { const unsigned c = xb_ld(&bar[XB_XCNT(j)]); sum += c; cnt += (c > 0u) ? 1u : 0u; mine = (j == x) ? c : mine; }
        if (sum == G) break;
        __builtin_amdgcn_s_sleep(1);
        if ((++sp & 255u) == 0u) { if (xb_ld(&bar[XB_TMO])) break; if (sp > XB_SPIN_CAP) { atomicAdd(&bar[XB_TMO], 1u); break; } }
    }
    nloc = mine > 0u ? mine : 1u; nx = cnt > 0u ? cnt : 1u;
}
__device__ __forceinline__ void xcd_barrier(const XcdBarrier& b) {
    asm volatile("s_waitcnt vmcnt(0)" ::: "memory");
    __syncthreads();
    if (threadIdx.x == 0) {
        unsigned* bar = b.bar;
        __builtin_amdgcn_s_waitcnt(0);
        unsigned nloc = b.st[0], nx = b.st[1];
        if (nloc == 0u) { xcd_barrier_complete(bar, b.x, nloc, nx); b.st[0] = nloc; b.st[1] = nx; }
        const unsigned old = xb_add(&bar[XB_XSUB(b.x)], 1u);
        const unsigned gen = old / nloc;
        if (old + 1u == (gen + 1u) * nloc) {
            __builtin_amdgcn_fence(__ATOMIC_RELEASE, "agent");
            asm volatile("s_waitcnt vmcnt(0)" ::: "memory");
            const unsigned og = xb_add(&bar[XB_TOP], 1u);
            const unsigned tg = og / nx;
            if (og + 1u == (tg + 1u) * nx) xb_add(&bar[XB_TOPGEN], 1u);
            else XB_SPIN(xb_ld(&bar[XB_TOPGEN]) == tg, bar);
            __builtin_amdgcn_fence(__ATOMIC_ACQUIRE, "agent");
            xb_add(&bar[XB_XGEN(b.x)], 1u);
            asm volatile("s_waitcnt vmcnt(0)" ::: "memory");
        } else {
            XB_SPIN(xb_ld(&bar[XB_XGEN(b.x)]) == gen, bar);
            __builtin_amdgcn_fence(__ATOMIC_ACQUIRE, "agent");
            asm volatile("s_waitcnt vmcnt(0)" ::: "memory");
        }
    }
    __syncthreads();
}

namespace pg8 {
constexpr int BM = 256, BK = 64, HALF = 128, HTB = HALF * BK * 2, STAGE_BYTES = 8 * HTB, NXCD = 8, WGM = 8;
__host__ __device__ __forceinline__ int lds_byte(int r, int c) { const int st = (r >> 4) * 2 + (c >> 5), rr = r & 15, cc = c & 31, ob = rr * 64 + cc * 2; return st * 1024 + (ob ^ (((ob >> 9) & 1) << 5)); }
__host__ __device__ __forceinline__ void stage_rc(int b, int& R, int& C) { const int st = b / 1024, sb = b % 1024, swz = sb ^ (((sb >> 9) & 1) << 5); R = (st >> 1) * 16 + swz / 64; C = (st & 1) * 32 + (swz % 64) / 2; }
__host__ __device__ __forceinline__ int perm32(int rho) { const int n = rho >> 4, i = rho & 15; return 8 * (i >> 2) + 4 * n + (i & 3); }
struct Unit { int pm, pn; };
struct Gemm { const bf16_t* A; const bf16_t* Bt; int M, N, K; };
struct StaticOrder {
    int nM, nN, nwg, G, c;
    __host__ __device__ void init(int M, int N, int G_, int c_) { nM = M / BM; nN = N / BM; nwg = nM * nN; G = G_; c = c_; }
    __host__ __device__ bool next(int i, Unit& u) const {
        const long L = (long)i * G + c; if (L >= nwg) return false;
        int wgid = (int)L; { const int q = nwg / NXCD, r = nwg % NXCD, xcd = wgid % NXCD, off = wgid / NXCD; wgid = (xcd < r ? xcd * (q + 1) : r * (q + 1) + (xcd - r) * q) + off; }
        const int nig = WGM * nN, gid = wgid / nig, fm = gid * WGM, gsz = (nM - fm) < WGM ? (nM - fm) : WGM;
        u.pm = fm + ((wgid % nig) % gsz); u.pn = (wgid % nig) / gsz; return true;
    }
};
template <class Epi, class Sched, bool ALIGN_EPI, bool SP2>
__device__ __forceinline__ void gemm_phase(LAS unsigned char* lds, const Gemm g, const Sched& S, const Epi& E) {
    const int tid = threadIdx.x, wid = __builtin_amdgcn_readfirstlane(tid >> 6), lane = tid & 63, wr = wid >> 2, wc = wid & 3, fr = lane & 15, fq = lane >> 4;
    const int K = g.K, nt = K / BK;
    unsigned voffA[2], voffB[2];
#pragma unroll
    for (int i = 0; i < 2; ++i) { int R, C; stage_rc(tid * 16 + i * 8192, R, C); const int Rb = Epi::PERM ? ((R & ~31) + perm32(R & 31)) : R;
        voffA[i] = (unsigned)(R * K + C) * 2u; voffB[i] = (unsigned)(Rb * K + C) * 2u; }
    const size_t kstep = (size_t)(BK * 2);
    const size_t hstep = (size_t)HALF * K * 2;
    const size_t tstep = 2 * hstep;
    const unsigned ldsw = (unsigned)wid * 1024u;
    const int aoff = lds_byte(wr * 64 + fr, fq * 8), boff = lds_byte(wc * 32 + fr, fq * 8);
#define PG8_SA(b, h) (((b) * 2 + (h)) * HTB)
#define PG8_SB(b, h) ((4 + (b) * 2 + (h)) * HTB)
#define PG8_STAGE(bufoff, gbase, voff) do { _Pragma("unroll") for (int _i = 0; _i < 2; ++_i) \
        __builtin_amdgcn_global_load_lds((const unsigned*)((const char*)(gbase) + (voff)[_i]), (LAS unsigned*)(lds + (bufoff) + ldsw + _i * 8192), 16, 0, 0); } while (0)
#define PG8_LDA(dst, b, h) do { _Pragma("unroll") for (int m = 0; m < 4; ++m) _Pragma("unroll") for (int k = 0; k < 2; ++k) dst[m][k] = *(const LAS bf16x8*)(lds + PG8_SA(b, h) + aoff + m * 2048 + k * 1024); } while (0)
#define PG8_LDB(dst, b, h) do { _Pragma("unroll") for (int n = 0; n < 2; ++n) _Pragma("unroll") for (int k = 0; k < 2; ++k) dst[n][k] = *(const LAS bf16x8*)(lds + PG8_SB(b, h) + boff + n * 2048 + k * 1024); } while (0)
#define PG8_MMA(ai, bj, At, Bt) do { __builtin_amdgcn_s_setprio(1); _Pragma("unroll") for (int m = 0; m < 4; ++m) _Pragma("unroll") for (int n = 0; n < 2; ++n) _Pragma("unroll") for (int k = 0; k < 2; ++k) \
        acc[ai][bj][m][n] = __builtin_amdgcn_mfma_f32_16x16x32_bf16(Bt[n][k], At[m][k], acc[ai][bj][m][n], 0, 0, 0); __builtin_amdgcn_s_setprio(0); } while (0)
#define PG8_WAIT_V(n) asm volatile("s_waitcnt vmcnt(" #n ")" ::: "memory")
#define PG8_WAIT_L(n) asm volatile("s_waitcnt lgkmcnt(" #n ")" ::: "memory")
#define PG8_BAR __builtin_amdgcn_s_barrier()
#define PG8_SCHED __builtin_amdgcn_sched_barrier(0)
    Unit cur, nxt; int ui = 0;
    if (!S.next(0, cur)) return;
    f32x4 acc[2][2][4][2];
#pragma unroll
    for (int a = 0; a < 2; ++a)
#pragma unroll
        for (int b = 0; b < 2; ++b)
#pragma unroll
            for (int m = 0; m < 4; ++m)
#pragma unroll
                for (int n = 0; n < 2; ++n) acc[a][b][m][n] = (f32x4){0.f, 0.f, 0.f, 0.f};
    bf16x8 At[4][2], B0[2][2], B1[2][2];
    const char* cA = (const char*)g.A + (size_t)cur.pm * tstep; const char* cB = (const char*)g.Bt + (size_t)cur.pn * tstep;
    if constexpr (SP2) {
        PG8_STAGE(PG8_SB(0, 0), cB, voffB); PG8_STAGE(PG8_SB(0, 1), cB + hstep, voffB); PG8_STAGE(PG8_SA(0, 0), cA, voffA); PG8_STAGE(PG8_SA(0, 1), cA + hstep, voffA);
        if (wr == 1) PG8_BAR;
        PG8_WAIT_V(2); PG8_BAR;
        PG8_STAGE(PG8_SB(1, 0), cB + kstep, voffB); PG8_STAGE(PG8_SA(1, 0), cA + kstep, voffA); PG8_STAGE(PG8_SB(1, 1), cB + hstep + kstep, voffB);
        PG8_WAIT_V(6); PG8_BAR;
    } else {
        PG8_STAGE(PG8_SB(0, 0), cB, voffB); PG8_STAGE(PG8_SA(0, 0), cA, voffA); PG8_STAGE(PG8_SB(0, 1), cB + hstep, voffB); PG8_STAGE(PG8_SA(0, 1), cA + hstep, voffA);
        if (wr == 1) PG8_BAR;
        PG8_WAIT_V(4); PG8_BAR;
        PG8_STAGE(PG8_SB(1, 0), cB + kstep, voffB); PG8_STAGE(PG8_SA(1, 0), cA + kstep, voffA); PG8_STAGE(PG8_SB(1, 1), cB + hstep + kstep, voffB);
        PG8_WAIT_V(6); PG8_BAR;
    }
    for (;;) {
        const bool has_next = S.next(ui + 1, nxt);
        const char* nA = has_next ? (const char*)g.A + (size_t)nxt.pm * tstep : cA; const char* nB = has_next ? (const char*)g.Bt + (size_t)nxt.pn * tstep : cB;
        for (int t = 0; t < nt; t += 2) {
            const bool last = (t == nt - 2);
            const char* a1 = cA + (size_t)(t + 1) * kstep;
            const char* a2 = last ? nA : cA + (size_t)(t + 2) * kstep; const char* b2 = last ? nB : cB + (size_t)(t + 2) * kstep;
            const char* a3 = a2 + kstep; const char* b3 = b2 + kstep;
            if constexpr (SP2) {
            PG8_LDB(B0, 0, 0); PG8_LDB(B1, 0, 1); PG8_SCHED; PG8_LDA(At, 0, 0); PG8_STAGE(PG8_SA(1, 1), a1 + hstep, voffA);
            PG8_WAIT_V(8); PG8_WAIT_L(0); PG8_BAR; PG8_MMA(0, 0, At, B0); PG8_MMA(0, 1, At, B1); PG8_BAR; PG8_SCHED;
            PG8_LDA(At, 0, 1); PG8_STAGE(PG8_SB(0, 0), b2, voffB); PG8_STAGE(PG8_SB(0, 1), b2 + hstep, voffB); PG8_STAGE(PG8_SA(0, 0), a2, voffA);
            PG8_WAIT_V(8); PG8_WAIT_L(0); PG8_BAR; PG8_MMA(1, 0, At, B0); PG8_MMA(1, 1, At, B1); PG8_BAR; PG8_SCHED;
            PG8_LDB(B0, 1, 0); PG8_LDB(B1, 1, 1); PG8_SCHED; PG8_LDA(At, 1, 0); PG8_STAGE(PG8_SA(0, 1), a2 + hstep, voffA);
            PG8_WAIT_V(8); PG8_WAIT_L(0); PG8_BAR; PG8_MMA(0, 0, At, B0); PG8_MMA(0, 1, At, B1); PG8_BAR; PG8_SCHED;
            PG8_LDA(At, 1, 1); PG8_STAGE(PG8_SB(1, 0), b3, voffB); PG8_STAGE(PG8_SB(1, 1), b3 + hstep, voffB); PG8_STAGE(PG8_SA(1, 0), a3, voffA);
            PG8_WAIT_V(8); PG8_WAIT_L(0); PG8_BAR; PG8_MMA(1, 0, At, B0); PG8_MMA(1, 1, At, B1); PG8_BAR; PG8_SCHED;
            } else {
            PG8_LDB(B0, 0, 0); PG8_SCHED; PG8_LDA(At, 0, 0); PG8_STAGE(PG8_SA(1, 1), a1 + hstep, voffA);
            PG8_WAIT_L(8); PG8_BAR; PG8_WAIT_L(0); PG8_MMA(0, 0, At, B0); PG8_BAR; PG8_SCHED;
            PG8_LDB(B1, 0, 1); PG8_STAGE(PG8_SB(0, 0), b2, voffB);
            PG8_BAR; PG8_WAIT_L(0); PG8_MMA(0, 1, At, B1); PG8_BAR;
            PG8_LDA(At, 0, 1); PG8_STAGE(PG8_SA(0, 0), a2, voffA);
            PG8_BAR; PG8_WAIT_L(0); PG8_MMA(1, 0, At, B0); PG8_BAR; PG8_SCHED;
            PG8_STAGE(PG8_SB(0, 1), b2 + hstep, voffB);
            PG8_WAIT_V(6); PG8_BAR; PG8_MMA(1, 1, At, B1); PG8_BAR;
            PG8_LDB(B0, 1, 0); PG8_SCHED; PG8_LDA(At, 1, 0); PG8_STAGE(PG8_SA(0, 1), a2 + hstep, voffA);
            PG8_WAIT_L(8); PG8_BAR; PG8_WAIT_L(0); PG8_MMA(0, 0, At, B0); PG8_BAR; PG8_SCHED;
            PG8_LDB(B1, 1, 1); PG8_STAGE(PG8_SB(1, 0), b3, voffB);
            PG8_BAR; PG8_WAIT_L(0); PG8_MMA(0, 1, At, B1); PG8_BAR;
            PG8_LDA(At, 1, 1); PG8_STAGE(PG8_SA(1, 0), a3, voffA);
            PG8_BAR; PG8_WAIT_L(0); PG8_MMA(1, 0, At, B0); PG8_BAR; PG8_SCHED;
            PG8_STAGE(PG8_SB(1, 1), b3 + hstep, voffB);
            PG8_WAIT_V(6); PG8_BAR; PG8_MMA(1, 1, At, B1); PG8_BAR;
            }
        }
        if constexpr (ALIGN_EPI) { if (wr == 0) PG8_BAR; }
        { int fr_ = fr, fq_ = fq; asm volatile("" : "+v"(fr_), "+v"(fq_)); E(acc, cur, wr, wc, fr_, fq_); }
        if (!has_next) break;
#pragma unroll
        for (int a = 0; a < 2; ++a)
#pragma unroll
            for (int b = 0; b < 2; ++b)
#pragma unroll
                for (int m = 0; m < 4; ++m)
#pragma unroll
                    for (int n = 0; n < 2; ++n) acc[a][b][m][n] = (f32x4){0.f, 0.f, 0.f, 0.f};
        cur = nxt; cA = nA; cB = nB; ++ui;
        if constexpr (ALIGN_EPI) { if (wr == 1) PG8_BAR; }
    }
    PG8_WAIT_V(0);
    if constexpr (!ALIGN_EPI) { if (wr == 0) PG8_BAR; }
    PG8_BAR;
#undef PG8_SA
#undef PG8_SB
#undef PG8_STAGE
#undef PG8_LDA
#undef PG8_LDB
#undef PG8_MMA
#undef PG8_WAIT_V
#undef PG8_WAIT_L
#undef PG8_BAR
#undef PG8_SCHED
}
}
using pg8::Unit;
typedef f32x4 AccT[2][2][4][2];

struct EpiQKV {
    static constexpr bool PERM = true;
    unsigned char* ws;
    __device__ __forceinline__ void operator()(const AccT& acc, const Unit& u, int wr, int wc, int fr, int fq) const {
        const int row0 = u.pm * 256 + wr * 64 + fr, kind = u.pn >> 3, colt = (u.pn & 7) * 256 + wc * 32 + 8 * fq;
        bf16_t* Vt = (bf16_t*)(ws + WS_VT);
        if (kind < 2) {
            bf16_t* base = (bf16_t*)(ws + (kind == 0 ? WS_Q : WS_K)); const float sc = kind == 0 ? QSCALE : 1.0f;
#pragma unroll
            for (int ai = 0; ai < 2; ++ai)
#pragma unroll
                for (int m = 0; m < 4; ++m) { bf16_t* rowp = base + (size_t)(row0 + ai * 128 + m * 16) * DM + colt;
#pragma unroll
                    for (int bj = 0; bj < 2; ++bj) { const f32x4 v0 = acc[ai][bj][m][0] * sc, v1 = acc[ai][bj][m][1] * sc;
                        u32x4 w; w.x = pk2(v0[0], v0[1]); w.y = pk2(v0[2], v0[3]); w.z = pk2(v1[0], v1[1]); w.w = pk2(v1[2], v1[3]);
                        *(u32x4*)(rowp + bj * 128) = w; } }
        } else {
#pragma unroll
            for (int ai = 0; ai < 2; ++ai)
#pragma unroll
                for (int m = 0; m < 4; ++m) { const int row = row0 + ai * 128 + m * 16, b = row >> 11, s = row & 2047;
#pragma unroll
                    for (int bj = 0; bj < 2; ++bj) { const int c0 = colt + bj * 128, h = c0 >> 7, d0 = c0 & 127;
                        bf16_t* p = Vt + ((size_t)(b * NH + h) * HD + d0) * SEQ + s;
#pragma unroll
                        for (int n = 0; n < 2; ++n)
#pragma unroll
                            for (int j = 0; j < 4; ++j) p[(size_t)(4 * n + j) * SEQ] = f2bf(acc[ai][bj][m][n][j]); } }
        }
    }
};
struct EpiRes {
    static constexpr bool PERM = true;
    const float* res; float* out; bf16_t* outb; float* part;
    __device__ __forceinline__ void operator()(const AccT& acc, const Unit& u, int wr, int wc, int fr, int fq) const {
        const int row0 = u.pm * 256 + wr * 64 + fr, col0 = u.pn * 256 + wc * 32 + 8 * fq;
#pragma unroll
        for (int ai = 0; ai < 2; ++ai)
#pragma unroll
            for (int m = 0; m < 4; ++m) { const int row = row0 + ai * 128 + m * 16; const size_t off = (size_t)row * DM + col0; float ss = 0.f;
#pragma unroll
                for (int bj = 0; bj < 2; ++bj) {
                    const f32x4 r0 = *(const f32x4*)(res + off + bj * 128), r1 = *(const f32x4*)(res + off + bj * 128 + 4);
                    const f32x4 v0 = acc[ai][bj][m][0] + r0, v1 = acc[ai][bj][m][1] + r1;
                    *(f32x4*)(out + off + bj * 128) = v0; *(f32x4*)(out + off + bj * 128 + 4) = v1;
                    if (outb) { u32x4 w; w.x = pk2(v0[0], v0[1]); w.y = pk2(v0[2], v0[3]); w.z = pk2(v1[0], v1[1]); w.w = pk2(v1[2], v1[3]); *(u32x4*)(outb + off + bj * 128) = w; }
                    ss += (v0[0] * v0[0] + v0[1] * v0[1]) + (v0[2] * v0[2] + v0[3] * v0[3]) + (v1[0] * v1[0] + v1[1] * v1[1]) + (v1[2] * v1[2] + v1[3] * v1[3]); }
                if (part) { ss += __shfl_xor(ss, 16); ss += __shfl_xor(ss, 32); if (fq == 0) part[(size_t)row * 32 + u.pn * 4 + wc] = ss; } }
    }
};
struct EpiUp {
    static constexpr bool PERM = true;
    bf16_t* U; const float* part;
    __device__ __forceinline__ void operator()(const AccT& acc, const Unit& u, int wr, int wc, int fr, int fq) const {
        const int row0 = u.pm * 256 + wr * 64 + fr, col0 = u.pn * 256 + wc * 32 + 8 * fq;
#pragma unroll
        for (int ai = 0; ai < 2; ++ai)
#pragma unroll
            for (int m = 0; m < 4; ++m) { const int row = row0 + ai * 128 + m * 16; const float rs = row_rstd(part, row, fq); bf16_t* rowp = U + (size_t)row * NUP + col0;
#pragma unroll
                for (int bj = 0; bj < 2; ++bj) { const f32x4 v0 = acc[ai][bj][m][0] * rs, v1 = acc[ai][bj][m][1] * rs;
                    u32x4 w; w.x = pk2(v0[0], v0[1]); w.y = pk2(v0[2], v0[3]); w.z = pk2(v1[0], v1[1]); w.w = pk2(v1[2], v1[3]);
                    *(u32x4*)(rowp + bj * 128) = w; } }
    }
};
struct EpiDsaIn {
    static constexpr bool PERM = false;
    unsigned char* ws; LAS float* scr;
    __device__ __forceinline__ void operator()(const AccT& acc_in, const Unit& u, int wr, int wc, int fr, int fq) const {
        const int row0 = u.pm * 256 + wr * 64 + fr;
        const float* part = (const float*)(ws + WS_PART); const float* ropeC = (const float*)(ws + WS_ROPE); const float* ropeS = ropeC + SEQ * 64;
        bf16_t* VTD = (bf16_t*)(ws + WS_VTD); float* WI = (float*)(ws + WS_WI);
        const bool need_norm = (u.pn < 10) || (u.pn == 20);
        float rs[2][4];
#pragma unroll
        for (int ai = 0; ai < 2; ++ai)
#pragma unroll
            for (int m = 0; m < 4; ++m) rs[ai][m] = row_rstd(part, row0 + ai * 128 + m * 16, fq);
        if (need_norm) {
#pragma unroll
            for (int ai = 0; ai < 2; ++ai)
#pragma unroll
                for (int m = 0; m < 4; ++m)
#pragma unroll
                    for (int bj = 0; bj < 2; ++bj) { const f32x4 a = acc_in[ai][bj][m][0], b = acc_in[ai][bj][m][1];
                        float ss = ((a[0] * a[0] + a[1] * a[1]) + (a[2] * a[2] + a[3] * a[3])) + ((b[0] * b[0] + b[1] * b[1]) + (b[2] * b[2] + b[3] * b[3]));
                        ss += __shfl_xor(ss, 16); ss += __shfl_xor(ss, 32);
                        if (fq == 0) scr[(ai * 128 + wr * 64 + m * 16 + fr) * 8 + bj * 4 + wc] = ss * rs[ai][m] * rs[ai][m]; }
            asm volatile("s_waitcnt lgkmcnt(0)" ::: "memory"); __builtin_amdgcn_s_barrier(); asm volatile("" ::: "memory");
        }
        const int dl = 16 * wc + 4 * fq;
#pragma unroll
        for (int bj = 0; bj < 2; ++bj) {
            const int hh = 2 * u.pn + bj;
            if (hh >= 20 && hh < 24) {
#pragma unroll
                for (int ai = 0; ai < 2; ++ai)
#pragma unroll
                    for (int m = 0; m < 4; ++m) { const int row = row0 + ai * 128 + m * 16, b = row >> 11, s = row & 2047; const float r = rs[ai][m];
                        bf16_t* p = VTD + ((size_t)(b * KVH + (hh - 20)) * HD + dl) * SEQ + s;
#pragma unroll
                        for (int n = 0; n < 2; ++n)
#pragma unroll
                            for (int e = 0; e < 4; ++e) p[(size_t)(64 * n + e) * SEQ] = f2bf(acc_in[ai][bj][m][n][e] * r); }
            } else if (hh == 41) {
                if (wc == 0) {
#pragma unroll
                    for (int ai = 0; ai < 2; ++ai)
#pragma unroll
                        for (int m = 0; m < 4; ++m) { const int row = row0 + ai * 128 + m * 16; *(f32x4*)(WI + (size_t)row * 16 + 4 * fq) = acc_in[ai][bj][m][0] * rs[ai][m]; } }
            } else {
                const bool norm = (hh < 20) || (hh == 40);
                const float* g = (const float*)(ws + WS_GAIN) + (hh < 16 ? 0 : (hh < 20 ? 128 : 256));
                f32x4 g0 = (f32x4){1.f, 1.f, 1.f, 1.f}, g1 = g0;
                if (norm) { g0 = *(const f32x4*)(g + dl); g1 = *(const f32x4*)(g + dl + 64); }
                size_t boff; int ld, cb;
                if (hh < 16) { boff = WS_Q; ld = DM; cb = hh * HD; } else if (hh < 20) { boff = WS_KD; ld = KVH * HD; cb = (hh - 16) * HD; }
                else if (hh < 40) { boff = WS_QI; ld = DM; cb = (hh - 24) * HD; } else { boff = WS_KI; ld = HD; cb = 0; }
                bf16_t* base = (bf16_t*)(ws + boff);
                const float osc = hh < 16 ? QSCALE : 1.0f;
#pragma unroll
                for (int ai = 0; ai < 2; ++ai)
#pragma unroll
                    for (int m = 0; m < 4; ++m) { const int lrow = ai * 128 + wr * 64 + m * 16 + fr, row = u.pm * 256 + lrow, pos = row & 2047;
                        float sc = rs[ai][m];
                        if (norm) { const f32x4 t = *(const LAS f32x4*)(scr + lrow * 8 + bj * 4); sc *= 1.0f / sqrtf(((t[0] + t[1]) + (t[2] + t[3])) * (1.0f / HD) + NORM_EPS); }
                        sc *= osc;
                        const f32x4 c = *(const f32x4*)(ropeC + pos * 64 + dl), sn = *(const f32x4*)(ropeS + pos * 64 + dl);
                        const f32x4 y0 = acc_in[ai][bj][m][0] * g0 * sc, y1 = acc_in[ai][bj][m][1] * g1 * sc;
                        const f32x4 o0 = y0 * c - y1 * sn, o1 = y1 * c + y0 * sn;
                        bf16_t* rp = base + (size_t)row * ld + cb + dl;
                        u32x2 w0, w1; w0.x = pk2(o0[0], o0[1]); w0.y = pk2(o0[2], o0[3]); w1.x = pk2(o1[0], o1[1]); w1.y = pk2(o1[2], o1[3]);
                        *(u32x2*)rp = w0; *(u32x2*)(rp + 64) = w1; }
            }
        }
    }
};

enum { WM_PLAIN = 0, WM_UP = 1, WM_IN = 2 };
__device__ __forceinline__ int colmap(int kind, int np) {
    if (kind == WM_UP) { const int pn = np >> 8, bj = (np >> 7) & 1, q = np & 127; return bj * FF + 128 * pn + q; }
    if (kind == WM_IN) { const int hh = np >> 7, p = np & 127, d = 16 * (p >> 5) + (p & 15) + 64 * ((p >> 4) & 1);
        if (hh < 41) return hh * 128 + d; return (p < 16) ? (5248 + p) : -1; }
    return np;
}
struct WJ { const float* W; const float* gain; bf16_t* WT; int K, N, NP, kind, local; };
__device__ __forceinline__ void tr_load(const WJ& j, int lane, f32x4 (&v)[16]) {
    const int nblk = j.NP / 64, kb = j.local / nblk, nb = j.local - kb * nblk, k0 = 64 * kb, n0 = 64 * nb;
    const int src = colmap(j.kind, n0 + 4 * (lane & 15)), rg = lane >> 4;
    const float* p = j.W + (size_t)(k0 + rg) * j.N + (src >= 0 ? src : 0);
#pragma unroll
    for (int i = 0; i < 16; ++i) { v[i] = *(const f32x4*)(p + (size_t)(4 * i) * j.N); if (src < 0) v[i] = (f32x4){0.f, 0.f, 0.f, 0.f}; }
}
__device__ __forceinline__ void tr_process(const WJ& j, int lane, const f32x4 (&v)[16], LAS float* scr) {
    const int nblk = j.NP / 64, kb = j.local / nblk, nb = j.local - kb * nblk, k0 = 64 * kb, n0 = 64 * nb;
    const int rg = lane >> 4, cg = lane & 15;
    float gl = 1.0f; if (j.gain) gl = j.gain[k0 + lane];
#pragma unroll
    for (int i = 0; i < 16; ++i) { const int kk = 4 * i + rg; const float g = __shfl(gl, kk); LAS float* d = scr + kk * 65 + 4 * cg;
        d[0] = v[i][0] * g; d[1] = v[i][1] * g; d[2] = v[i][2] * g; d[3] = v[i][3] * g; }
    asm volatile("s_waitcnt lgkmcnt(0)" ::: "memory");
    const int c = lane & 7;
#pragma unroll
    for (int jj = 0; jj < 8; ++jj) { const int n = (lane >> 3) + 8 * jj; const LAS float* s = scr + (8 * c) * 65 + n;
        u32x4 o; o.x = pk2(s[0 * 65], s[1 * 65]); o.y = pk2(s[2 * 65], s[3 * 65]); o.z = pk2(s[4 * 65], s[5 * 65]); o.w = pk2(s[6 * 65], s[7 * 65]);
        *(u32x4*)(j.WT + (size_t)(n0 + n) * j.K + k0 + 8 * c) = o; }
    asm volatile("s_waitcnt lgkmcnt(0)" ::: "memory");
}

struct Args {
    const float* x; const float* attn_g; const float* ffn_g; const float* w_qkv; const float* w_o0; const float* w_in;
    const float* qn_g; const float* kn_g; const float* ikn_g; const float* w_o1; const float* w_up; const float* conv_w; const float* conv_b; const float* w_down;
    float* out; unsigned char* ws; int ph_lo, ph_hi;
};

constexpr int WI0 = 32 * 96, WI1 = WI0 + 32 * 32, WI2 = WI1 + 32 * 84, WI3 = WI2 + 32 * 32, WI4 = WI3 + 32 * 176, WI5 = WI4 + 32 * 176, WI6 = WI5 + 88 * 32, WI7 = WI6 + 88 * 32;
__device__ __forceinline__ WJ wj_decode(const Args& a, int it) {
    unsigned char* ws = a.ws; WJ j;
    if (it < WI0)      j = WJ{a.w_qkv, nullptr, (bf16_t*)(ws + WS_WQKV), DM, NQKV, NQKV, WM_PLAIN, it};
    else if (it < WI1) j = WJ{a.w_o0, nullptr, (bf16_t*)(ws + WS_WO0), DM, DM, DM, WM_PLAIN, it - WI0};
    else if (it < WI2) j = WJ{a.w_in, a.attn_g + DM, (bf16_t*)(ws + WS_WIN), DM, NIN, NINP, WM_IN, it - WI1};
    else if (it < WI3) j = WJ{a.w_o1, nullptr, (bf16_t*)(ws + WS_WO1), DM, DM, DM, WM_PLAIN, it - WI2};
    else if (it < WI4) j = WJ{a.w_up, a.ffn_g, (bf16_t*)(ws + WS_WUP), DM, NUP, NUP, WM_UP, it - WI3};
    else if (it < WI5) j = WJ{a.w_up + (size_t)DM * NUP, a.ffn_g + DM, (bf16_t*)(ws + WS_WUP + 44 * MiB), DM, NUP, NUP, WM_UP, it - WI4};
    else if (it < WI6) j = WJ{a.w_down, nullptr, (bf16_t*)(ws + WS_WDN), FF, DM, DM, WM_PLAIN, it - WI5};
    else               j = WJ{a.w_down + (size_t)FF * DM, nullptr, (bf16_t*)(ws + WS_WDN + 22 * MiB), FF, DM, DM, WM_PLAIN, it - WI6};
    return j;
}
__device__ __forceinline__ void prologue_phase(const Args& a, LAS unsigned char* lds, int gw, int ngw, int wave, int lane) {
    unsigned char* ws = a.ws;
    LAS float* scr = (LAS float*)(lds + wave * 16640);
    {
        int it = gw;
        if (it < WI7) {
            f32x4 va[16], vb[16];
            WJ ja = wj_decode(a, it), jb = ja;
            tr_load(ja, lane, va);
            for (;;) {
                int nx = it + ngw; bool hn = nx < WI7;
                if (hn) { jb = wj_decode(a, nx); tr_load(jb, lane, vb); }
                tr_process(ja, lane, va, scr);
                if (!hn) break;
                it = nx; nx = it + ngw; hn = nx < WI7;
                if (hn) { ja = wj_decode(a, nx); tr_load(ja, lane, va); }
                tr_process(jb, lane, vb, scr);
                if (!hn) break;
                it = nx;
            }
        }
    }
    bf16_t* XB = (bf16_t*)(ws + WS_XB);
    for (int m = gw; m < MTOK; m += ngw) {
        const f32x4* xr = (const f32x4*)(a.x + (size_t)m * DM) + lane;
        f32x4 v[8]; float s = 0.f;
#pragma unroll
        for (int j = 0; j < 8; ++j) { v[j] = xr[64 * j]; s += (v[j].x * v[j].x + v[j].y * v[j].y) + (v[j].z * v[j].z + v[j].w * v[j].w); }
        const float rstd = 1.0f / sqrtf(wave_sum(s) * (1.0f / DM) + NORM_EPS);
        u32x2* o8 = (u32x2*)(XB + (size_t)m * DM) + lane;
#pragma unroll
        for (int j = 0; j < 8; ++j) { const f32x4 g = ((const f32x4*)a.attn_g)[lane + 64 * j]; u32x2 w; w.x = pk2(v[j].x * rstd * g.x, v[j].y * rstd * g.y); w.y = pk2(v[j].z * rstd * g.z, v[j].w * rstd * g.w); o8[64 * j] = w; }
    }
    if (gw == 0) { float* gn = (float*)(ws + WS_GAIN); for (int i = lane; i < 128; i += 64) { gn[i] = a.qn_g[i]; gn[128 + i] = a.kn_g[i]; gn[256 + i] = a.ikn_g[i]; } }
    float* rc = (float*)(ws + WS_ROPE); float* rsn = rc + SEQ * 64;
    for (int i = gw * 64 + lane; i < SEQ * 64; i += ngw * 64) {
        const int pos = i >> 6, fi = i & 63;
        const float inv_freq = (float)(1.0 / exp2((double)fi * (2.0 / 128.0) * 13.287712379549449));
        const float ang = (float)pos * inv_freq;
        const double x = (double)ang; const double kq = rint(x * 0.63661977236758134308);
        double r = __builtin_fma(-kq, 1.57079632679489655800e+00, x); r = __builtin_fma(-kq, 6.12323399573676603587e-17, r);
        const double r2 = r * r;
        double sp = -1.0 / 6227020800.0; sp = sp * r2 + 1.0 / 39916800.0; sp = sp * r2 - 1.0 / 362880.0; sp = sp * r2 + 1.0 / 5040.0; sp = sp * r2 - 1.0 / 120.0; sp = sp * r2 + 1.0 / 6.0; const double sv = r - r * r2 * sp;
        double cp = 1.0 / 87178291200.0; cp = cp * r2 - 1.0 / 479001600.0; cp = cp * r2 + 1.0 / 3628800.0; cp = cp * r2 - 1.0 / 40320.0; cp = cp * r2 + 1.0 / 720.0; cp = cp * r2 - 1.0 / 24.0; cp = cp * r2 + 0.5; const double cv = 1.0 - r2 * cp;
        const int q = ((int)kq) & 3;
        const double cs = (q == 0) ? cv : (q == 1) ? -sv : (q == 2) ? -cv : sv;
        const double sn = (q == 0) ? sv : (q == 1) ? cv : (q == 2) ? -sv : -cv;
        rc[i] = (float)cs; rsn[i] = (float)sn;
    }
}

constexpr float SB_EXIT = 220.0f;
__device__ __forceinline__ void sb_attn_phase(const bf16_t* __restrict__ Q, const bf16_t* __restrict__ K, const bf16_t* __restrict__ Vt, bf16_t* __restrict__ O, int gw, int ngw, int lane) {
    const int r = lane & 31, hh = lane >> 5;
    bf16x8 uf[2];
#pragma unroll
    for (int s2 = 0; s2 < 2; ++s2) { u32x4 w;
        unsigned e[8];
#pragma unroll
        for (int j = 0; j < 8; ++j) { const int key = 16 * s2 + 8 * (j >> 2) + 4 * hh + (j & 3); e[j] = (key >= r) ? 0x3f80u : 0u; }
        w.x = e[0] | (e[1] << 16); w.y = e[2] | (e[3] << 16); w.z = e[4] | (e[5] << 16); w.w = e[6] | (e[7] << 16); uf[s2] = __builtin_bit_cast(bf16x8, w); }
    for (int unit = gw; unit < BATCH * NH * 64; unit += ngw) {
        const int bh = unit >> 6, qt = 63 - (unit & 63), b = bh >> 4, h = bh & 15, q0 = qt * 32;
        const bf16_t* qp = Q + (size_t)(b * SEQ + q0 + r) * DM + h * HD + 8 * hh;
        bf16x8 qf[8];
#pragma unroll
        for (int s = 0; s < 8; ++s) qf[s] = *(const bf16x8*)(qp + 16 * s);
        f32x16 o[4];
#pragma unroll
        for (int d = 0; d < 4; ++d) o[d] = f32x16{};
        float carry = 0.f;
        const bf16_t* kbase = K + (size_t)(b * SEQ + r) * DM + h * HD + 8 * hh;
        const bf16_t* vbase = Vt + ((size_t)bh * HD + r) * SEQ + 4 * hh;
        for (int kt = qt; kt >= 0; --kt) {
            const int key0 = kt * 32;
            const bf16_t* kp = kbase + (size_t)key0 * DM;
            bf16x8 kf[8];
#pragma unroll
            for (int s = 0; s < 8; ++s) kf[s] = *(const bf16x8*)(kp + 16 * s);
            bf16x8 vf[4][2];
#pragma unroll
            for (int d = 0; d < 4; ++d)
#pragma unroll
                for (int s2 = 0; s2 < 2; ++s2) { const bf16_t* vp = vbase + (size_t)(32 * d) * SEQ + key0 + 16 * s2;
                    const s16x4 lo = *(const s16x4*)vp, hi = *(const s16x4*)(vp + 8);
                    vf[d][s2] = (bf16x8){lo[0], lo[1], lo[2], lo[3], hi[0], hi[1], hi[2], hi[3]}; }
            f32x16 p = f32x16{};
#pragma unroll
            for (int s = 0; s < 8; ++s) p = __builtin_amdgcn_mfma_f32_32x32x16_bf16(kf[s], qf[s], p, 0, 0, 0);
            const bool diag = (kt == qt);
            f32x16 sp;
#pragma unroll
            for (int i = 0; i < 16; ++i) { const float z = p[i]; float v = fmaxf(z, 0.f) + __builtin_amdgcn_logf(1.0f + __builtin_amdgcn_exp2f(-fabsf(z)));
                if (diag && crow(i, hh) >= r) v = 0.f; sp[i] = v; }
            f32x16 c;
#pragma unroll
            for (int i = 0; i < 16; ++i) c[i] = carry;
            c = __builtin_amdgcn_mfma_f32_32x32x16_bf16(uf[0], pack8(sp, 0), c, 0, 0, 0);
            c = __builtin_amdgcn_mfma_f32_32x32x16_bf16(uf[1], pack8(sp, 8), c, 0, 0, 0);
            f32x16 av;
#pragma unroll
            for (int i = 0; i < 16; ++i) { float v = __builtin_amdgcn_exp2f(p[i] - c[i]); if (diag && crow(i, hh) >= r) v = 0.f; av[i] = v; }
            carry = swap_max(c[0]);
            const bf16x8 pa0 = pack8(av, 0), pa1 = pack8(av, 8);
#pragma unroll
            for (int d = 0; d < 4; ++d) { o[d] = __builtin_amdgcn_mfma_f32_32x32x16_bf16(vf[d][0], pa0, o[d], 0, 0, 0); o[d] = __builtin_amdgcn_mfma_f32_32x32x16_bf16(vf[d][1], pa1, o[d], 0, 0, 0); }
            if (__all(carry > SB_EXIT)) break;
        }
        bf16_t* op = O + (size_t)(b * SEQ + q0 + r) * DM + h * HD + 4 * hh;
#pragma unroll
        for (int d = 0; d < 4; ++d)
#pragma unroll
            for (int g = 0; g < 4; ++g) { u32x2 w; w.x = pk2(o[d][4 * g], o[d][4 * g + 1]); w.y = pk2(o[d][4 * g + 2], o[d][4 * g + 3]); *(u32x2*)(op + 32 * d + 8 * g) = w; }
    }
}

__device__ __forceinline__ void conv_phase(const bf16_t* __restrict__ U, const float* __restrict__ cw, const float* __restrict__ cb, bf16_t* __restrict__ ACT, int gtid, int nthreads) {
    constexpr int C8 = FF / 8;
    for (int it = gtid; it < MTOK * C8; it += nthreads) {
        const int row = it / C8, c8 = it - row * C8, j0 = c8 * 8, pn = j0 >> 7, q = j0 & 127, s = row & 2047;
        const bf16_t* ug = U + (size_t)row * NUP + 256 * pn + q;
        float cgv[2][8];
#pragma unroll
        for (int half = 0; half < 2; ++half) {
            const bf16_t* up = ug + half * 128; const int cc = half * FF + j0;
            const f32x4 b0 = *(const f32x4*)(cb + cc), b1 = *(const f32x4*)(cb + cc + 4);
            float accv[8] = {b0[0], b0[1], b0[2], b0[3], b1[0], b1[1], b1[2], b1[3]};
#pragma unroll
            for (int tap = 0; tap < 3; ++tap) { const int back = 2 - tap;
                if (s >= back) { const u32x4 w = *(const u32x4*)(up - (size_t)back * NUP);
                    const f32x4 w0 = *(const f32x4*)(cw + (size_t)tap * NUP + cc), w1 = *(const f32x4*)(cw + (size_t)tap * NUP + cc + 4);
                    accv[0] += __uint_as_float(w.x << 16) * w0[0]; accv[1] += __uint_as_float(w.x & 0xffff0000u) * w0[1];
                    accv[2] += __uint_as_float(w.y << 16) * w0[2]; accv[3] += __uint_as_float(w.y & 0xffff0000u) * w0[3];
                    accv[4] += __uint_as_float(w.z << 16) * w1[0]; accv[5] += __uint_as_float(w.z & 0xffff0000u) * w1[1];
                    accv[6] += __uint_as_float(w.w << 16) * w1[2]; accv[7] += __uint_as_float(w.w & 0xffff0000u) * w1[3]; } }
#pragma unroll
            for (int e = 0; e < 8; ++e) cgv[half][e] = accv[e];
        }
        float a8[8];
#pragma unroll
        for (int e = 0; e < 8; ++e) { const float gx = cgv[0][e]; a8[e] = gx / (1.0f + __expf(-gx)) * cgv[1][e]; }
        u32x4 w; w.x = pk2(a8[0], a8[1]); w.y = pk2(a8[2], a8[3]); w.z = pk2(a8[4], a8[5]); w.w = pk2(a8[6], a8[7]);
        *(u32x4*)(ACT + (size_t)row * FF + j0) = w;
    }
}

__device__ __forceinline__ unsigned fmap(float f) { const unsigned u = __float_as_uint(f); return (u & 0x80000000u) ? ~u : (u | 0x80000000u); }
__device__ __forceinline__ void indexer_unit(const bf16_t* __restrict__ QI, const bf16_t* __restrict__ KI, const float* __restrict__ WI, unsigned* __restrict__ MASK, LAS float* sc, int b, int t0, int wave, int lane) {
    const int r = lane & 31, hh = lane >> 5, ql_r = r >> 4, head_r = r & 15;
    const int tw = t0 + 2 * wave;
    const bf16_t* ap = QI + (size_t)(b * SEQ + tw + ql_r) * DM + head_r * HD + 8 * hh;
    bf16x8 af[8];
#pragma unroll
    for (int s = 0; s < 8; ++s) af[s] = *(const bf16x8*)(ap + 16 * s);
    float wv[16];
#pragma unroll
    for (int i = 0; i < 16; ++i) { const int rw = crow(i, hh); wv[i] = WI[(size_t)(b * SEQ + tw + (rw >> 4)) * 16 + (rw & 15)]; }
    const int nkt = (t0 + 16 + 31) >> 5;
    const bf16_t* kb = KI + (size_t)(b * SEQ + r) * HD + 8 * hh;
    LAS float* myrow = sc + (2 * wave + hh) * SEQ;
    const int tq = tw + hh;
    for (int kt = 0; kt < nkt; ++kt) {
        const bf16_t* kp = kb + (size_t)kt * 32 * HD;
        bf16x8 bfr[8];
#pragma unroll
        for (int s = 0; s < 8; ++s) bfr[s] = *(const bf16x8*)(kp + 16 * s);
        f32x16 c = f32x16{};
#pragma unroll
        for (int s = 0; s < 8; ++s) c = __builtin_amdgcn_mfma_f32_32x32x16_bf16(af[s], bfr[s], c, 0, 0, 0);
        float s0 = 0.f, s1 = 0.f;
#pragma unroll
        for (int i = 0; i < 8; ++i) { s0 += wv[i] * fmaxf(c[i], 0.f); s1 += wv[i + 8] * fmaxf(c[i + 8], 0.f); }
        const float t0s = swap_sum(s0), t1s = swap_sum(s1);
        const int key = kt * 32 + r;
        float v = (hh ? t1s : t0s) + 0.0f;
        if (key > tq) v = -INFINITY;
        myrow[key] = v;
    }
    asm volatile("s_waitcnt lgkmcnt(0)" ::: "memory");
    for (int ql = 0; ql < 2; ++ql) {
        const int t = tw + ql, n = t + 1;
        unsigned* mrow = MASK + (size_t)(b * SEQ + t) * 64;
        if (n <= TOPK) {
            const int key0 = 32 * lane; unsigned w;
            if (key0 + 31 <= t) w = 0xffffffffu; else if (key0 > t) w = 0u; else w = (1u << (t - key0 + 1)) - 1u;
            mrow[lane] = w;
        } else {
            const LAS float* row = sc + (2 * wave + ql) * SEQ;
            unsigned uv[32];
#pragma unroll
            for (int e = 0; e < 32; ++e) { const int key = e * 64 + lane; uv[e] = (key < n) ? fmap(row[key]) : 0x007fffffu; }
            unsigned prefix = 0u;
            for (int bit = 31; bit >= 0; --bit) {
                const unsigned cand = prefix | (1u << bit); int cnt = 0;
#pragma unroll
                for (int e = 0; e < 32; ++e) cnt += __popcll(__ballot(uv[e] >= cand));
                if (cnt >= TOPK) prefix = cand;
            }
            int cgt = 0;
#pragma unroll
            for (int e = 0; e < 32; ++e) cgt += __popcll(__ballot(uv[e] > prefix));
            const int need = TOPK - cgt; int running = 0;
            const unsigned long long ltm = (1ull << lane) - 1ull;
            unsigned long long keep = 0ull;
#pragma unroll
            for (int e = 0; e < 32; ++e) {
                const unsigned long long eq = __ballot(uv[e] == prefix);
                const bool sel = (uv[e] > prefix) || (uv[e] == prefix && (running + __popcll(eq & ltm)) < need);
                const unsigned long long m64 = __ballot(sel);
                running += __popcll(eq);
                if (lane == e) keep = m64;
            }
            if (lane < 32) *(unsigned long long*)(mrow + 2 * lane) = keep;
        }
    }
    asm volatile("s_waitcnt lgkmcnt(0)" ::: "memory");
}

__device__ __forceinline__ void dsa_attn_unit(const bf16_t* __restrict__ QD, const bf16_t* __restrict__ KD, const bf16_t* __restrict__ VTD, const unsigned* __restrict__ MASK, bf16_t* __restrict__ O,
                                              int b, int g, int h, int q0, int lane) {
    const int r = lane & 31, hh = lane >> 5;
    const bf16_t* qp = QD + (size_t)(b * SEQ + q0 + r) * DM + h * HD + 8 * hh;
    bf16x8 qf[8];
#pragma unroll
    for (int s = 0; s < 8; ++s) qf[s] = *(const bf16x8*)(qp + 16 * s);
    f32x16 o[4];
#pragma unroll
    for (int d = 0; d < 4; ++d) o[d] = f32x16{};
    float mrun = -1e30f, lrun = 0.f;
    const bf16_t* kbase = KD + (size_t)(b * SEQ + r) * (KVH * HD) + g * HD + 8 * hh;
    const bf16_t* vbase = VTD + ((size_t)(b * KVH + g) * HD + r) * SEQ + 4 * hh;
    const unsigned* mrow = MASK + (size_t)(b * SEQ + q0 + r) * 64;
    const int nkt = (q0 + 32) >> 5;
    for (int kt = 0; kt < nkt; ++kt) {
        const int key0 = kt * 32;
        const bf16_t* kp = kbase + (size_t)key0 * (KVH * HD);
        bf16x8 kf[8];
#pragma unroll
        for (int s = 0; s < 8; ++s) kf[s] = *(const bf16x8*)(kp + 16 * s);
        const unsigned mw = mrow[kt];
        bf16x8 vf[4][2];
#pragma unroll
        for (int d = 0; d < 4; ++d)
#pragma unroll
            for (int s2 = 0; s2 < 2; ++s2) { const bf16_t* vp = vbase + (size_t)(32 * d) * SEQ + key0 + 16 * s2;
                const s16x4 lo = *(const s16x4*)vp, hi = *(const s16x4*)(vp + 8);
                vf[d][s2] = (bf16x8){lo[0], lo[1], lo[2], lo[3], hi[0], hi[1], hi[2], hi[3]}; }
        f32x16 p = f32x16{};
#pragma unroll
        for (int s = 0; s < 8; ++s) p = __builtin_amdgcn_mfma_f32_32x32x16_bf16(kf[s], qf[s], p, 0, 0, 0);
        float tmax = -1e30f;
#pragma unroll
        for (int i = 0; i < 16; ++i) { const bool valid = (mw >> crow(i, hh)) & 1u; tmax = fmaxf(tmax, valid ? p[i] : -1e30f); }
        tmax = swap_max(tmax);
        const float mnew = fmaxf(mrun, tmax), alpha = __builtin_amdgcn_exp2f(mrun - mnew);
        float ls = 0.f; f32x16 pe;
#pragma unroll
        for (int i = 0; i < 16; ++i) { const bool valid = (mw >> crow(i, hh)) & 1u; const float e = valid ? __builtin_amdgcn_exp2f(p[i] - mnew) : 0.f; pe[i] = e; ls += e; }
        lrun = lrun * alpha + ls; mrun = mnew;
#pragma unroll
        for (int d = 0; d < 4; ++d)
#pragma unroll
            for (int i = 0; i < 16; ++i) o[d][i] *= alpha;
        const bf16x8 pa0 = pack8(pe, 0), pa1 = pack8(pe, 8);
#pragma unroll
        for (int d = 0; d < 4; ++d) { o[d] = __builtin_amdgcn_mfma_f32_32x32x16_bf16(vf[d][0], pa0, o[d], 0, 0, 0); o[d] = __builtin_amdgcn_mfma_f32_32x32x16_bf16(vf[d][1], pa1, o[d], 0, 0, 0); }
    }
    const float linv = 1.0f / swap_sum(lrun);
    bf16_t* op = O + (size_t)(b * SEQ + q0 + r) * DM + h * HD + 4 * hh;
#pragma unroll
    for (int d = 0; d < 4; ++d)
#pragma unroll
        for (int gq = 0; gq < 4; ++gq) { u32x2 w; w.x = pk2(o[d][4 * gq] * linv, o[d][4 * gq + 1] * linv); w.y = pk2(o[d][4 * gq + 2] * linv, o[d][4 * gq + 3] * linv); *(u32x2*)(op + 32 * d + 8 * gq) = w; }
}

constexpr int N_PHASES = 14;
__global__ void __launch_bounds__(512, 2) fwd_kernel(Args a) {
    extern __shared__ __attribute__((aligned(16))) unsigned char lds_raw[];
    LAS unsigned char* lds = (LAS unsigned char*)lds_raw;
    cg::grid_group grid = cg::this_grid();
    const int tid = threadIdx.x, lane = tid & 63, wave = __builtin_amdgcn_readfirstlane(tid >> 6);
    const int G = gridDim.x, bx = blockIdx.x;
    const int gw = bx * 8 + wave, ngw = G * 8;
    unsigned char* ws = a.ws;
    const int lo = a.ph_lo, hi = a.ph_hi;
#ifndef REP_PHASE
#define REP_PHASE -1
#endif
#ifndef REP_COUNT
#define REP_COUNT 1
#endif
#define IN(k) (lo <= (k) && (k) < hi)
#define GSYNC(k) do { if ((k) == 0) grid.sync(); else xcd_barrier(xbar); } while (0)
#define SEAM(k) do { if (IN(k) && IN((k) + 1)) GSYNC(k); } while (0)
#define REPS(k) for (int rep_ = 0; rep_ < ((k) == REP_PHASE ? REP_COUNT : 1); ++rep_, (void)(((k) == REP_PHASE && rep_ < REP_COUNT) ? (xcd_barrier(xbar), 0) : 0))
    bf16_t* XB = (bf16_t*)(ws + WS_XB); float* X1 = (float*)(ws + WS_X1); float* X2 = (float*)(ws + WS_X2); float* PART = (float*)(ws + WS_PART);
    bf16_t* Qb = (bf16_t*)(ws + WS_Q); bf16_t* Kb = (bf16_t*)(ws + WS_K); bf16_t* Vtb = (bf16_t*)(ws + WS_VT); bf16_t* Ob = (bf16_t*)(ws + WS_O);
    bf16_t* QIb = (bf16_t*)(ws + WS_QI); bf16_t* KDb = (bf16_t*)(ws + WS_KD); bf16_t* VTDb = (bf16_t*)(ws + WS_VTD); bf16_t* KIb = (bf16_t*)(ws + WS_KI);
    float* WIb = (float*)(ws + WS_WI); unsigned* MASKb = (unsigned*)(ws + WS_MASK);
    bf16_t* Ub = (bf16_t*)(ws + WS_U); bf16_t* ACTb = (bf16_t*)(ws + WS_ACT);
    const float* ropeC = (const float*)(ws + WS_ROPE); const float* ropeS = ropeC + SEQ * 64;

    if (tid < 16) ((volatile LAS unsigned*)(lds + LDS_MISC))[tid] = 0u;
    __syncthreads();
    XcdBarrier xbar = xcd_barrier_post((unsigned*)(ws + WS_CTL), (volatile LAS unsigned*)(lds + LDS_MISC) + 8);
    if (IN(0)) REPS(0) { prologue_phase(a, lds, gw, ngw, wave, lane); }
    SEAM(0);
    if (IN(1)) REPS(1) {
        pg8::Gemm g{XB, (const bf16_t*)(ws + WS_WQKV), MTOK, NQKV, DM}; pg8::StaticOrder S; S.init(MTOK, NQKV, G, bx);
        EpiQKV E{ws};
        pg8::gemm_phase<EpiQKV, pg8::StaticOrder, true, true>(lds, g, S, E);
    }
    SEAM(1);
    if (IN(2)) REPS(2) { sb_attn_phase(Qb, Kb, Vtb, Ob, gw, ngw, lane); }
    SEAM(2);
    if (IN(3)) REPS(3) {
        pg8::Gemm g{Ob, (const bf16_t*)(ws + WS_WO0), MTOK, DM, DM}; pg8::StaticOrder S; S.init(MTOK, DM, G, bx);
        EpiRes E{a.x, X1, XB, PART};
        pg8::gemm_phase<EpiRes, pg8::StaticOrder, true, true>(lds, g, S, E);
    }
    SEAM(3);
    if (IN(4)) REPS(4) {
        pg8::Gemm g{XB, (const bf16_t*)(ws + WS_WUP), MTOK, NUP, DM}; pg8::StaticOrder S; S.init(MTOK, NUP, G, bx);
        EpiUp E{Ub, PART};
        pg8::gemm_phase<EpiUp, pg8::StaticOrder, true, true>(lds, g, S, E);
    }
    SEAM(4);
    if (IN(5)) REPS(5) { conv_phase(Ub, a.conv_w, a.conv_b, ACTb, bx * 512 + tid, G * 512); }
    SEAM(5);
    if (IN(6)) REPS(6) {
        pg8::Gemm g{ACTb, (const bf16_t*)(ws + WS_WDN), MTOK, DM, FF}; pg8::StaticOrder S; S.init(MTOK, DM, G, bx);
        EpiRes E{X1, X2, XB, PART};
        pg8::gemm_phase<EpiRes, pg8::StaticOrder, true, true>(lds, g, S, E);
    }
    SEAM(6);
    if (IN(7)) REPS(7) {
        pg8::Gemm g{XB, (const bf16_t*)(ws + WS_WIN), MTOK, NINP, DM}; pg8::StaticOrder S; S.init(MTOK, NINP, G, bx);
        EpiDsaIn E{ws, (LAS float*)(lds + LDS_EPI)};
        pg8::gemm_phase<EpiDsaIn, pg8::StaticOrder, true, true>(lds, g, S, E);
    }
    SEAM(7);
    if (IN(8)) REPS(8) {
        for (int pr = bx; pr < 256; pr += G) { const int b = pr >> 6, p = pr & 63;
            indexer_unit(QIb, KIb, WIb, MASKb, (LAS float*)lds, b, 16 * (127 - p), wave, lane);
            indexer_unit(QIb, KIb, WIb, MASKb, (LAS float*)lds, b, 16 * p, wave, lane); }
    }
    SEAM(8);
    if (IN(9)) REPS(9) {
        for (int pr = bx; pr < 256; pr += G) { const int b = pr >> 6, g = (pr >> 4) & 3, p = pr & 15;
            const int hl = wave & 3, sub = wave >> 2;
            dsa_attn_unit(Qb, KDb, VTDb, MASKb, Ob, b, g, 4 * g + hl, 64 * (31 - p) + 32 * sub, lane);
            dsa_attn_unit(Qb, KDb, VTDb, MASKb, Ob, b, g, 4 * g + hl, 64 * p + 32 * sub, lane); }
    }
    SEAM(9);
    if (IN(10)) REPS(10) {
        pg8::Gemm g{Ob, (const bf16_t*)(ws + WS_WO1), MTOK, DM, DM}; pg8::StaticOrder S; S.init(MTOK, DM, G, bx);
        EpiRes E{X2, X1, XB, PART};
        pg8::gemm_phase<EpiRes, pg8::StaticOrder, true, true>(lds, g, S, E);
    }
    SEAM(10);
    if (IN(11)) REPS(11) {
        pg8::Gemm g{XB, (const bf16_t*)(ws + WS_WUP + 44 * MiB), MTOK, NUP, DM}; pg8::StaticOrder S; S.init(MTOK, NUP, G, bx);
        EpiUp E{Ub, PART};
        pg8::gemm_phase<EpiUp, pg8::StaticOrder, true, true>(lds, g, S, E);
    }
    SEAM(11);
    if (IN(12)) REPS(12) { conv_phase(Ub, a.conv_w + 3 * NUP, a.conv_b + NUP, ACTb, bx * 512 + tid, G * 512); }
    SEAM(12);
    if (IN(13)) REPS(13) {
        pg8::Gemm g{ACTb, (const bf16_t*)(ws + WS_WDN + 22 * MiB), MTOK, DM, FF}; pg8::StaticOrder S; S.init(MTOK, DM, G, bx);
        EpiRes E{X1, a.out, nullptr, nullptr};
        pg8::gemm_phase<EpiRes, pg8::StaticOrder, true, true>(lds, g, S, E);
    }
#undef IN
#undef SEAM
}

extern "C" void kernel_launch(void* const* d_in, const int* in_sizes, int n_in, void* d_out, int out_size, void* d_ws, size_t ws_size, hipStream_t stream) {
    static int grid = 0;
    if (grid == 0) {
        if (n_in != 14 || out_size != MTOK * DM || ws_size < WS_END) { fprintf(stderr, "kernel_launch: unexpected shapes (n_in %d out %d ws %zu)\n", n_in, out_size, ws_size); grid = -1; return; }
        int dev = 0, cus = 0, per_cu = 0;
        hipGetDevice(&dev); hipDeviceGetAttribute(&cus, hipDeviceAttributeMultiprocessorCount, dev);
        if (hipFuncSetAttribute((const void*)fwd_kernel, hipFuncAttributeMaxDynamicSharedMemorySize, LDS_BYTES) != hipSuccess) { fprintf(stderr, "kernel_launch: hipFuncSetAttribute failed\n"); grid = -1; return; }
        if (hipOccupancyMaxActiveBlocksPerMultiprocessor(&per_cu, (const void*)fwd_kernel, 512, LDS_BYTES) != hipSuccess || per_cu < 1) { fprintf(stderr, "kernel_launch: occupancy query says %d\n", per_cu); per_cu = 1; }
        (void)hipGetLastError();
        grid = cus;
    }
    if (grid < 0) return;
    Args a{};
    a.x = (const float*)d_in[0]; a.attn_g = (const float*)d_in[1]; a.ffn_g = (const float*)d_in[2]; a.w_qkv = (const float*)d_in[3]; a.w_o0 = (const float*)d_in[4]; a.w_in = (const float*)d_in[5];
    a.qn_g = (const float*)d_in[6]; a.kn_g = (const float*)d_in[7]; a.ikn_g = (const float*)d_in[8]; a.w_o1 = (const float*)d_in[9]; a.w_up = (const float*)d_in[10]; a.conv_w = (const float*)d_in[11];
    a.conv_b = (const float*)d_in[12]; a.w_down = (const float*)d_in[13]; a.out = (float*)d_out; a.ws = (unsigned char*)d_ws;
    if (hipMemsetAsync((char*)d_ws + WS_CTL, 0, CTL_BYTES, stream) != hipSuccess) { fprintf(stderr, "kernel_launch: hipMemsetAsync failed\n"); return; }
#if MK_ONE_LAUNCH
    a.ph_lo = 0; a.ph_hi = N_PHASES;
    void* args[] = {&a};
    hipError_t e = hipLaunchCooperativeKernel((const void*)fwd_kernel, dim3(grid), dim3(512), args, LDS_BYTES, stream);
    if (e != hipSuccess) fprintf(stderr, "cooperative launch failed: %s (grid %d)\n", hipGetErrorString(e), grid);
#else
    for (int p = 0; p < N_PHASES; ++p) {
        a.ph_lo = p; a.ph_hi = p + 1;
        void* args[] = {&a};
        hipError_t e = hipLaunchCooperativeKernel((const void*)fwd_kernel, dim3(grid), dim3(512), args, LDS_BYTES, stream);
        if (e != hipSuccess) { fprintf(stderr, "launch %d failed: %s (grid %d)\n", p, hipGetErrorString(e), grid); break; }
    }
#endif
}
```

```cpp
#include <hip/hip_runtime.h>
#include <hip/hip_cooperative_groups.h>
#include <cstdio>
#include <cstdint>
namespace cg = cooperative_groups;

#ifndef MK_ONE_LAUNCH
#define MK_ONE_LAUNCH 1
#endif

#define LAS __attribute__((address_space(3)))
typedef unsigned short bf16_t;
typedef short bf16x8 __attribute__((ext_vector_type(8)));
typedef short s16x4 __attribute__((ext_vector_type(4)));
typedef float f32x4 __attribute__((ext_vector_type(4)));
typedef float f32x2 __attribute__((ext_vector_type(2)));
typedef float f32x16 __attribute__((ext_vector_type(16)));
typedef unsigned u32x4 __attribute__((ext_vector_type(4)));
typedef unsigned u32x2 __attribute__((ext_vector_type(2)));
typedef __bf16 bf16x2_t __attribute__((ext_vector_type(2)));

constexpr int BATCH = 4, SEQ = 2048, DM = 2048, NH = 16, HD = 128, MTOK = BATCH * SEQ;
constexpr int FF = 5632, NUP = 2 * FF, NQKV = 3 * DM;
constexpr int KVH = 4, NIN = 5264, NINP = 5376;
constexpr int TOPK = 256;
constexpr float NORM_EPS = 1e-6f;
constexpr float LOG2E = 1.4426950408889634f;
constexpr float QSCALE = 0.08838834764831845f * LOG2E;

constexpr size_t MiB = 1u << 20;
constexpr size_t WS_WQKV = 0, WS_WO0 = 24 * MiB, WS_WIN = 32 * MiB, WS_WO1 = 53 * MiB, WS_WUP = 61 * MiB  , WS_WDN = 149 * MiB  ;
constexpr size_t WS_GAIN = 197 * MiB + 512 * 1024  ;
constexpr size_t WS_ROPE = 193 * MiB  , WS_PART = 194 * MiB, WS_MASK = 195 * MiB, WS_WI = 197 * MiB, WS_KI = 198 * MiB;
constexpr size_t WS_XB = 200 * MiB, WS_X1 = 232 * MiB, WS_X2 = 296 * MiB;
constexpr size_t WS_SCR = 360 * MiB;
constexpr size_t WS_U = WS_SCR, WS_ACT = WS_SCR + 176 * MiB;
constexpr size_t WS_Q = WS_SCR, WS_K = WS_SCR + 32 * MiB, WS_VT = WS_SCR + 64 * MiB, WS_O = WS_SCR + 96 * MiB, WS_QI = WS_SCR + 128 * MiB, WS_KD = WS_SCR + 160 * MiB, WS_VTD = WS_SCR + 168 * MiB;
constexpr size_t WS_CTL = WS_ACT + 88 * MiB, CTL_BYTES = 65536;
constexpr size_t WS_END = WS_CTL + CTL_BYTES;

constexpr int LDS_EPI = 131072;
constexpr int LDS_MISC = LDS_EPI + 8192;
constexpr int LDS_BYTES = 147456;

__device__ __forceinline__ unsigned pk2(float lo, float hi) { f32x2 v = {lo, hi}; bf16x2_t b = __builtin_convertvector(v, bf16x2_t); return __builtin_bit_cast(unsigned, b); }
__device__ __forceinline__ bf16_t f2bf(float f) { return (bf16_t)(pk2(f, 0.f) & 0xffffu); }
__device__ __forceinline__ int crow(int r, int hi) { return (r & 3) + 8 * (r >> 2) + 4 * hi; }
__device__ __forceinline__ bf16x8 pack8(const f32x16& p, int b) {
    u32x4 w; w.x = pk2(p[b], p[b + 1]); w.y = pk2(p[b + 2], p[b + 3]); w.z = pk2(p[b + 4], p[b + 5]); w.w = pk2(p[b + 6], p[b + 7]);
    return __builtin_bit_cast(bf16x8, w);
}
__device__ __forceinline__ float swap_sum(float v) { auto rr = __builtin_amdgcn_permlane32_swap(__float_as_uint(v), __float_as_uint(v), false, false); return __uint_as_float(rr[0]) + __uint_as_float(rr[1]); }
__device__ __forceinline__ float swap_max(float v) { auto rr = __builtin_amdgcn_permlane32_swap(__float_as_uint(v), __float_as_uint(v), false, false); return fmaxf(__uint_as_float(rr[0]), __uint_as_float(rr[1])); }
__device__ __forceinline__ float wave_sum(float v) {
#pragma unroll
    for (int o = 1; o < 64; o <<= 1) v += __shfl_xor(v, o);
    return v;
}
__device__ __forceinline__ float row_rstd(const float* part, int row, int fq) {
    const f32x4* p = (const f32x4*)(part + (size_t)row * 32 + 8 * fq);
    const f32x4 a = p[0], b = p[1]; float s = ((a.x + a.y) + (a.z + a.w)) + ((b.x + b.y) + (b.z + b.w));
    s += __shfl_xor(s, 16); s += __shfl_xor(s, 32);
    return 1.0f / sqrtf(s * (1.0f / DM) + NORM_EPS);
}


#define XB_TMO      128
#define XB_XCNT(j)  (256  + 64 * (j))
#define XB_XSUB(j)  (1280 + 64 * (j))
#define XB_XGEN(j)  (2304 + 64 * (j))
#define XB_TOP      3328
#define XB_TOPGEN   3392
#define XCD_BAR_WORDS 3456
#define XB_SPIN_CAP (1u << 18)
__device__ __forceinline__ unsigned xb_ld(unsigned* p)              { return __hip_atomic_load(p, __ATOMIC_RELAXED, __HIP_MEMORY_SCOPE_AGENT); }
__device__ __forceinline__ unsigned xb_add(unsigned* p, unsigned v) { return __hip_atomic_fetch_add(p, v, __ATOMIC_RELAXED, __HIP_MEMORY_SCOPE_AGENT); }
__device__ __forceinline__ unsigned xb_xcc_id() { return (unsigned)__builtin_amdgcn_s_getreg((3 << 11) | 20) & 0xFu; }
#define XB_SPIN(cond, bar) do { unsigned _sp = 0; while (cond) { __builtin_amdgcn_s_sleep(1); \
    if ((++_sp & 255u) == 0u) { if (xb_ld(&(bar)[XB_TMO])) break; if (_sp > XB_SPIN_CAP) { atomicAdd(&(bar)[XB_TMO], 1u); break; } } } } while (0)
struct XcdBarrier { unsigned* bar; unsigned x; volatile LAS unsigned* st; };
__device__ __forceinline__ XcdBarrier xcd_barrier_post(unsigned* bar, volatile LAS unsigned* st) {
    XcdBarrier b; b.bar = bar; b.x = xb_xcc_id(); b.st = st;
    if (threadIdx.x == 0) (void)xb_add(&bar[XB_XCNT(b.x)], 1u);
    return b;
}
__device__ __forceinline__ void xcd_barrier_complete(unsigned* bar, unsigned x, unsigned& nloc, unsigned& nx) {
    const unsigned G = gridDim.x * gridDim.y * gridDim.z;
    unsigned sum, cnt, mine, sp = 0u;
    for (;;) {
        sum = 0u; cnt = 0u; mine = 0u;
#pragma unroll
        for (unsigned j = 0; j < 16; ++j) { const unsigned c = xb_ld(&bar[XB_XCNT(j)]); sum += c; cnt += (c > 0u) ? 1u : 0u; mine = (j == x) ? c : mine; }
        if (sum == G) break;
        __builtin_amdgcn_s_sleep(1);
        if ((++sp & 255u) == 0u) { if (xb_ld(&bar[XB_TMO])) break; if (sp > XB_SPIN_CAP) { atomicAdd(&bar[XB_TMO], 1u); break; } }
    }
    nloc = mine > 0u ? mine : 1u; nx = cnt > 0u ? cnt : 1u;
}
__device__ __forceinline__ void xcd_barrier(const XcdBarrier& b) {
    asm volatile("s_waitcnt vmcnt(0)" ::: "memory");
    __syncthreads();
    if (threadIdx.x == 0) {
        unsigned* bar = b.bar;
        __builtin_amdgcn_s_waitcnt(0);
        unsigned nloc = b.st[0], nx = b.st[1];
        if (nloc == 0u) { xcd_barrier_complete(bar, b.x, nloc, nx); b.st[0] = nloc; b.st[1] = nx; }
        const unsigned old = xb_add(&bar[XB_XSUB(b.x)], 1u);
        const unsigned gen = old / nloc;
        if (old + 1u == (gen + 1u) * nloc) {
            __builtin_amdgcn_fence(__ATOMIC_RELEASE, "agent");
            asm volatile("s_waitcnt vmcnt(0)" ::: "memory");
            const unsigned og = xb_add(&bar[XB_TOP], 1u);
            const unsigned tg = og / nx;
            if (og + 1u == (tg + 1u) * nx) xb_add(&bar[XB_TOPGEN], 1u);
            else XB_SPIN(xb_ld(&bar[XB_TOPGEN]) == tg, bar);
            __builtin_amdgcn_fence(__ATOMIC_ACQUIRE, "agent");
            xb_add(&bar[XB_XGEN(b.x)], 1u);
            asm volatile("s_waitcnt vmcnt(0)" ::: "memory");
        } else {
            XB_SPIN(xb_ld(&bar[XB_XGEN(b.x)]) == gen, bar);
            __builtin_amdgcn_fence(__ATOMIC_ACQUIRE, "agent");
            asm volatile("s_waitcnt vmcnt(0)" ::: "memory");
        }
    }
    __syncthreads();
}

namespace pg8 {
constexpr int BM = 256, BK = 64, HALF = 128, HTB = HALF * BK * 2, STAGE_BYTES = 8 * HTB, NXCD = 8, WGM = 8;
__host__ __device__ __forceinline__ int lds_byte(int r, int c) { const int st = (r >> 4) * 2 + (c >> 5), rr = r & 15, cc = c & 31, ob = rr * 64 + cc * 2; return st * 1024 + (ob ^ (((ob >> 9) & 1) << 5)); }
__host__ __device__ __forceinline__ void stage_rc(int b, int& R, int& C) { const int st = b / 1024, sb = b % 1024, swz = sb ^ (((sb >> 9) & 1) << 5); R = (st >> 1) * 16 + swz / 64; C = (st & 1) * 32 + (swz % 64) / 2; }
__host__ __device__ __forceinline__ int perm32(int rho) { const int n = rho >> 4, i = rho & 15; return 8 * (i >> 2) + 4 * n + (i & 3); }
struct Unit { int pm, pn; };
struct Gemm { const bf16_t* A; const bf16_t* Bt; int M, N, K; int a_rows = 256, a_row0 = 0; };
struct StaticOrder {
    int nM, nN, nwg, G, c;
    __host__ __device__ void init(int M, int N, int G_, int c_) { nM = M / BM; nN = N / BM; nwg = nM * nN; G = G_; c = c_; }
    __host__ __device__ void init_tiles(int nM_, int nN_, int G_, int c_) { nM = nM_; nN = nN_; nwg = nM * nN; G = G_; c = c_; }
    __host__ __device__ bool next(int i, Unit& u) const {
        const long L = (long)i * G + c; if (L >= nwg) return false;
        int wgid = (int)L; { const int q = nwg / NXCD, r = nwg % NXCD, xcd = wgid % NXCD, off = wgid / NXCD; wgid = (xcd < r ? xcd * (q + 1) : r * (q + 1) + (xcd - r) * q) + off; }
        const int nig = WGM * nN, gid = wgid / nig, fm = gid * WGM, gsz = (nM - fm) < WGM ? (nM - fm) : WGM;
        u.pm = fm + ((wgid % nig) % gsz); u.pn = (wgid % nig) / gsz; return true;
    }
};
template <class Epi, class Sched, bool ALIGN_EPI, bool SP2>
__device__ __forceinline__ void gemm_phase(LAS unsigned char* lds, const Gemm g, const Sched& S, const Epi& E) {
    const int tid = threadIdx.x, wid = __builtin_amdgcn_readfirstlane(tid >> 6), lane = tid & 63, wr = wid >> 2, wc = wid & 3, fr = lane & 15, fq = lane >> 4;
    const int K = g.K, nt = K / BK;
    unsigned voffA[2], voffB[2];
#pragma unroll
    for (int i = 0; i < 2; ++i) { int R, C; stage_rc(tid * 16 + i * 8192, R, C); const int Rb = Epi::PERM ? ((R & ~31) + perm32(R & 31)) : R;
        voffA[i] = (unsigned)(R * K + C) * 2u; voffB[i] = (unsigned)(Rb * K + C) * 2u; }
    const size_t kstep = (size_t)(BK * 2);
    const size_t hstep = (size_t)HALF * K * 2;
    const size_t tstep = 2 * hstep;
    const unsigned ldsw = (unsigned)wid * 1024u;
    const int aoff = lds_byte(wr * 64 + fr, fq * 8), boff = lds_byte(wc * 32 + fr, fq * 8);
#define PG8_SA(b, h) (((b) * 2 + (h)) * HTB)
#define PG8_SB(b, h) ((4 + (b) * 2 + (h)) * HTB)
#define PG8_STAGE(bufoff, gbase, voff) do { _Pragma("unroll") for (int _i = 0; _i < 2; ++_i) \
        __builtin_amdgcn_global_load_lds((const unsigned*)((const char*)(gbase) + (voff)[_i]), (LAS unsigned*)(lds + (bufoff) + ldsw + _i * 8192), 16, 0, 0); } while (0)
#define PG8_LDA(dst, b, h) do { _Pragma("unroll") for (int m = 0; m < 4; ++m) _Pragma("unroll") for (int k = 0; k < 2; ++k) dst[m][k] = *(const LAS bf16x8*)(lds + PG8_SA(b, h) + aoff + m * 2048 + k * 1024); } while (0)
#define PG8_LDB(dst, b, h) do { _Pragma("unroll") for (int n = 0; n < 2; ++n) _Pragma("unroll") for (int k = 0; k < 2; ++k) dst[n][k] = *(const LAS bf16x8*)(lds + PG8_SB(b, h) + boff + n * 2048 + k * 1024); } while (0)
#define PG8_MMA(ai, bj, At, Bt) do { __builtin_amdgcn_s_setprio(1); _Pragma("unroll") for (int m = 0; m < 4; ++m) _Pragma("unroll") for (int n = 0; n < 2; ++n) _Pragma("unroll") for (int k = 0; k < 2; ++k) \
        acc[ai][bj][m][n] = __builtin_amdgcn_mfma_f32_16x16x32_bf16(Bt[n][k], At[m][k], acc[ai][bj][m][n], 0, 0, 0); __builtin_amdgcn_s_setprio(0); } while (0)
#define PG8_WAIT_V(n) asm volatile("s_waitcnt vmcnt(" #n ")" ::: "memory")
#define PG8_WAIT_L(n) asm volatile("s_waitcnt lgkmcnt(" #n ")" ::: "memory")
#define PG8_BAR __builtin_amdgcn_s_barrier()
#define PG8_SCHED __builtin_amdgcn_sched_barrier(0)
    Unit cur, nxt; int ui = 0;
    if (!S.next(0, cur)) return;
    f32x4 acc[2][2][4][2];
#pragma unroll
    for (int a = 0; a < 2; ++a)
#pragma unroll
        for (int b = 0; b < 2; ++b)
#pragma unroll
            for (int m = 0; m < 4; ++m)
#pragma unroll
                for (int n = 0; n < 2; ++n) acc[a][b][m][n] = (f32x4){0.f, 0.f, 0.f, 0.f};
    bf16x8 At[4][2], B0[2][2], B1[2][2];
    const long atstep = (long)g.a_rows * K * 2, aorg = (long)g.a_row0 * K * 2;
    const char* cA = (const char*)g.A + aorg + (long)cur.pm * atstep; const char* cB = (const char*)g.Bt + (size_t)cur.pn * tstep;
    if constexpr (SP2) {
        PG8_STAGE(PG8_SB(0, 0), cB, voffB); PG8_STAGE(PG8_SB(0, 1), cB + hstep, voffB); PG8_STAGE(PG8_SA(0, 0), cA, voffA); PG8_STAGE(PG8_SA(0, 1), cA + hstep, voffA);
        if (wr == 1) PG8_BAR;
        PG8_WAIT_V(2); PG8_BAR;
        PG8_STAGE(PG8_SB(1, 0), cB + kstep, voffB); PG8_STAGE(PG8_SA(1, 0), cA + kstep, voffA); PG8_STAGE(PG8_SB(1, 1), cB + hstep + kstep, voffB);
        PG8_WAIT_V(6); PG8_BAR;
    } else {
        PG8_STAGE(PG8_SB(0, 0), cB, voffB); PG8_STAGE(PG8_SA(0, 0), cA, voffA); PG8_STAGE(PG8_SB(0, 1), cB + hstep, voffB); PG8_STAGE(PG8_SA(0, 1), cA + hstep, voffA);
        if (wr == 1) PG8_BAR;
        PG8_WAIT_V(4); PG8_BAR;
        PG8_STAGE(PG8_SB(1, 0), cB + kstep, voffB); PG8_STAGE(PG8_SA(1, 0), cA + kstep, voffA); PG8_STAGE(PG8_SB(1, 1), cB + hstep + kstep, voffB);
        PG8_WAIT_V(6); PG8_BAR;
    }
    for (;;) {
        const bool has_next = S.next(ui + 1, nxt);
        const char* nA = has_next ? (const char*)g.A + aorg + (long)nxt.pm * atstep : cA; const char* nB = has_next ? (const char*)g.Bt + (size_t)nxt.pn * tstep : cB;
        for (int t = 0; t < nt; t += 2) {
            const bool last = (t == nt - 2);
            const char* a1 = cA + (size_t)(t + 1) * kstep;
            const char* a2 = last ? nA : cA + (size_t)(t + 2) * kstep; const char* b2 = last ? nB : cB + (size_t)(t + 2) * kstep;
            const char* a3 = a2 + kstep; const char* b3 = b2 + kstep;
            if constexpr (SP2) {
            PG8_LDB(B0, 0, 0); PG8_LDB(B1, 0, 1); PG8_SCHED; PG8_LDA(At, 0, 0); PG8_STAGE(PG8_SA(1, 1), a1 + hstep, voffA);
            PG8_WAIT_V(8); PG8_WAIT_L(0); PG8_BAR; PG8_MMA(0, 0, At, B0); PG8_MMA(0, 1, At, B1); PG8_BAR; PG8_SCHED;
            PG8_LDA(At, 0, 1); PG8_STAGE(PG8_SB(0, 0), b2, voffB); PG8_STAGE(PG8_SB(0, 1), b2 + hstep, voffB); PG8_STAGE(PG8_SA(0, 0), a2, voffA);
            PG8_WAIT_V(8); PG8_WAIT_L(0); PG8_BAR; PG8_MMA(1, 0, At, B0); PG8_MMA(1, 1, At, B1); PG8_BAR; PG8_SCHED;
            PG8_LDB(B0, 1, 0); PG8_LDB(B1, 1, 1); PG8_SCHED; PG8_LDA(At, 1, 0); PG8_STAGE(PG8_SA(0, 1), a2 + hstep, voffA);
            PG8_WAIT_V(8); PG8_WAIT_L(0); PG8_BAR; PG8_MMA(0, 0, At, B0); PG8_MMA(0, 1, At, B1); PG8_BAR; PG8_SCHED;
            PG8_LDA(At, 1, 1); PG8_STAGE(PG8_SB(1, 0), b3, voffB); PG8_STAGE(PG8_SB(1, 1), b3 + hstep, voffB); PG8_STAGE(PG8_SA(1, 0), a3, voffA);
            PG8_WAIT_V(8); PG8_WAIT_L(0); PG8_BAR; PG8_MMA(1, 0, At, B0); PG8_MMA(1, 1, At, B1); PG8_BAR; PG8_SCHED;
            } else {
            PG8_LDB(B0, 0, 0); PG8_SCHED; PG8_LDA(At, 0, 0); PG8_STAGE(PG8_SA(1, 1), a1 + hstep, voffA);
            PG8_WAIT_L(8); PG8_BAR; PG8_WAIT_L(0); PG8_MMA(0, 0, At, B0); PG8_BAR; PG8_SCHED;
            PG8_LDB(B1, 0, 1); PG8_STAGE(PG8_SB(0, 0), b2, voffB);
            PG8_BAR; PG8_WAIT_L(0); PG8_MMA(0, 1, At, B1); PG8_BAR;
            PG8_LDA(At, 0, 1); PG8_STAGE(PG8_SA(0, 0), a2, voffA);
            PG8_BAR; PG8_WAIT_L(0); PG8_MMA(1, 0, At, B0); PG8_BAR; PG8_SCHED;
            PG8_STAGE(PG8_SB(0, 1), b2 + hstep, voffB);
            PG8_WAIT_V(6); PG8_BAR; PG8_MMA(1, 1, At, B1); PG8_BAR;
            PG8_LDB(B0, 1, 0); PG8_SCHED; PG8_LDA(At, 1, 0); PG8_STAGE(PG8_SA(0, 1), a2 + hstep, voffA);
            PG8_WAIT_L(8); PG8_BAR; PG8_WAIT_L(0); PG8_MMA(0, 0, At, B0); PG8_BAR; PG8_SCHED;
            PG8_LDB(B1, 1, 1); PG8_STAGE(PG8_SB(1, 0), b3, voffB);
            PG8_BAR; PG8_WAIT_L(0); PG8_MMA(0, 1, At, B1); PG8_BAR;
            PG8_LDA(At, 1, 1); PG8_STAGE(PG8_SA(1, 0), a3, voffA);
            PG8_BAR; PG8_WAIT_L(0); PG8_MMA(1, 0, At, B0); PG8_BAR; PG8_SCHED;
            PG8_STAGE(PG8_SB(1, 1), b3 + hstep, voffB);
            PG8_WAIT_V(6); PG8_BAR; PG8_MMA(1, 1, At, B1); PG8_BAR;
            }
        }
        if constexpr (ALIGN_EPI) { if (wr == 0) PG8_BAR; }
        { int fr_ = fr, fq_ = fq; asm volatile("" : "+v"(fr_), "+v"(fq_)); E(acc, cur, wr, wc, fr_, fq_); }
        if (!has_next) break;
#pragma unroll
        for (int a = 0; a < 2; ++a)
#pragma unroll
            for (int b = 0; b < 2; ++b)
#pragma unroll
                for (int m = 0; m < 4; ++m)
#pragma unroll
                    for (int n = 0; n < 2; ++n) acc[a][b][m][n] = (f32x4){0.f, 0.f, 0.f, 0.f};
        cur = nxt; cA = nA; cB = nB; ++ui;
        if constexpr (ALIGN_EPI) { if (wr == 1) PG8_BAR; }
    }
    PG8_WAIT_V(0);
    if constexpr (!ALIGN_EPI) { if (wr == 0) PG8_BAR; }
    PG8_BAR;
#undef PG8_SA
#undef PG8_SB
#undef PG8_STAGE
#undef PG8_LDA
#undef PG8_LDB
#undef PG8_MMA
#undef PG8_WAIT_V
#undef PG8_WAIT_L
#undef PG8_BAR
#undef PG8_SCHED
}
}
using pg8::Unit;
typedef f32x4 AccT[2][2][4][2];

struct EpiQKV {
    static constexpr bool PERM = true;
    unsigned char* ws;
    __device__ __forceinline__ void operator()(const AccT& acc, const Unit& u, int wr, int wc, int fr, int fq) const {
        const int row0 = u.pm * 256 + wr * 64 + fr, kind = u.pn >> 3, colt = (u.pn & 7) * 256 + wc * 32 + 8 * fq;
        bf16_t* Vt = (bf16_t*)(ws + WS_VT);
        if (kind < 2) {
            bf16_t* base = (bf16_t*)(ws + (kind == 0 ? WS_Q : WS_K)); const float sc = kind == 0 ? QSCALE : 1.0f;
#pragma unroll
            for (int ai = 0; ai < 2; ++ai)
#pragma unroll
                for (int m = 0; m < 4; ++m) { bf16_t* rowp = base + (size_t)(row0 + ai * 128 + m * 16) * DM + colt;
#pragma unroll
                    for (int bj = 0; bj < 2; ++bj) { const f32x4 v0 = acc[ai][bj][m][0] * sc, v1 = acc[ai][bj][m][1] * sc;
                        u32x4 w; w.x = pk2(v0[0], v0[1]); w.y = pk2(v0[2], v0[3]); w.z = pk2(v1[0], v1[1]); w.w = pk2(v1[2], v1[3]);
                        *(u32x4*)(rowp + bj * 128) = w; } }
        } else {
#pragma unroll
            for (int ai = 0; ai < 2; ++ai)
#pragma unroll
                for (int m = 0; m < 4; ++m) { const int row = row0 + ai * 128 + m * 16, b = row >> 11, s = row & 2047;
#pragma unroll
                    for (int bj = 0; bj < 2; ++bj) { const int c0 = colt + bj * 128, h = c0 >> 7, d0 = c0 & 127;
                        bf16_t* p = Vt + ((size_t)(b * NH + h) * HD + d0) * SEQ + s;
#pragma unroll
                        for (int n = 0; n < 2; ++n)
#pragma unroll
                            for (int j = 0; j < 4; ++j) p[(size_t)(4 * n + j) * SEQ] = f2bf(acc[ai][bj][m][n][j]); } }
        }
    }
};
struct EpiRes {
    static constexpr bool PERM = true;
    const float* res; float* out; bf16_t* outb; float* part;
    __device__ __forceinline__ void operator()(const AccT& acc, const Unit& u, int wr, int wc, int fr, int fq) const {
        const int row0 = u.pm * 256 + wr * 64 + fr, col0 = u.pn * 256 + wc * 32 + 8 * fq;
#pragma unroll
        for (int ai = 0; ai < 2; ++ai)
#pragma unroll
            for (int m = 0; m < 4; ++m) { const int row = row0 + ai * 128 + m * 16; const size_t off = (size_t)row * DM + col0; float ss = 0.f;
#pragma unroll
                for (int bj = 0; bj < 2; ++bj) {
                    const f32x4 r0 = *(const f32x4*)(res + off + bj * 128), r1 = *(const f32x4*)(res + off + bj * 128 + 4);
                    const f32x4 v0 = acc[ai][bj][m][0] + r0, v1 = acc[ai][bj][m][1] + r1;
                    *(f32x4*)(out + off + bj * 128) = v0; *(f32x4*)(out + off + bj * 128 + 4) = v1;
                    if (outb) { u32x4 w; w.x = pk2(v0[0], v0[1]); w.y = pk2(v0[2], v0[3]); w.z = pk2(v1[0], v1[1]); w.w = pk2(v1[2], v1[3]); *(u32x4*)(outb + off + bj * 128) = w; }
                    ss += (v0[0] * v0[0] + v0[1] * v0[1]) + (v0[2] * v0[2] + v0[3] * v0[3]) + (v1[0] * v1[0] + v1[1] * v1[1]) + (v1[2] * v1[2] + v1[3] * v1[3]); }
                if (part) { ss += __shfl_xor(ss, 16); ss += __shfl_xor(ss, 32); if (fq == 0) part[(size_t)row * 32 + u.pn * 4 + wc] = ss; } }
    }
};
struct EpiUp {
    static constexpr bool PERM = true;
    bf16_t* U; const float* part;
    __device__ __forceinline__ void operator()(const AccT& acc, const Unit& u, int wr, int wc, int fr, int fq) const {
        const int row0 = u.pm * 256 + wr * 64 + fr, col0 = u.pn * 256 + wc * 32 + 8 * fq;
#pragma unroll
        for (int ai = 0; ai < 2; ++ai)
#pragma unroll
            for (int m = 0; m < 4; ++m) { const int row = row0 + ai * 128 + m * 16; const float rs = row_rstd(part, row, fq); bf16_t* rowp = U + (size_t)row * NUP + col0;
#pragma unroll
                for (int bj = 0; bj < 2; ++bj) { const f32x4 v0 = acc[ai][bj][m][0] * rs, v1 = acc[ai][bj][m][1] * rs;
                    u32x4 w; w.x = pk2(v0[0], v0[1]); w.y = pk2(v0[2], v0[3]); w.z = pk2(v1[0], v1[1]); w.w = pk2(v1[2], v1[3]);
                    *(u32x4*)(rowp + bj * 128) = w; } }
    }
};
__device__ __forceinline__ float dpp_ror1(float v) { return __int_as_float(__builtin_amdgcn_update_dpp(0, __float_as_int(v), 0x121, 0xf, 0xf, false)); }
__device__ __forceinline__ float dpp_ror2(float v) { return __int_as_float(__builtin_amdgcn_update_dpp(0, __float_as_int(v), 0x122, 0xf, 0xf, false)); }
struct EpiUpConv {
    static constexpr bool PERM = true;
    bf16_t* ACT; const float* part; const float* cw; const float* cb; LAS float* hal;
    __device__ __forceinline__ void operator()(AccT& acc, const Unit& u, int wr, int wc, int fr, int fq) const {
        const int grow0 = 254 * u.pm - 2 + wr * 64 + fr;
#pragma unroll
        for (int ai = 0; ai < 2; ++ai)
#pragma unroll
            for (int m = 0; m < 4; ++m) { const int grow = grow0 + ai * 128 + m * 16; const int rowc = grow < 0 ? 0 : (grow >= MTOK ? MTOK - 1 : grow);
                const float rs = row_rstd(part, rowc, fq);
#pragma unroll
                for (int bj = 0; bj < 2; ++bj) { acc[ai][bj][m][0] *= rs; acc[ai][bj][m][1] *= rs; } }
        const int colw = wc * 32 + 8 * fq;
        if (fr >= 14) {
#pragma unroll
            for (int ai = 0; ai < 2; ++ai)
#pragma unroll
                for (int bj = 0; bj < 2; ++bj)
#pragma unroll
                    for (int n = 0; n < 2; ++n) *(LAS f32x4*)(hal + ((ai * 2 + wr) * 2 + (fr - 14)) * 256 + bj * 128 + colw + 4 * n) = acc[ai][bj][3][n];
        }
        asm volatile("s_waitcnt lgkmcnt(0)" ::: "memory"); __builtin_amdgcn_s_barrier(); asm volatile("" ::: "memory");
#pragma unroll
        for (int n = 0; n < 2; ++n) {
            const int ch = u.pn * 128 + colw + 4 * n;
            f32x4 w[2][3], bb[2];
#pragma unroll
            for (int bj = 0; bj < 2; ++bj) { bb[bj] = *(const f32x4*)(cb + bj * FF + ch);
#pragma unroll
                for (int t = 0; t < 3; ++t) w[bj][t] = *(const f32x4*)(cw + (size_t)t * NUP + bj * FF + ch); }
#pragma unroll
            for (int ai = 0; ai < 2; ++ai)
#pragma unroll
                for (int m = 0; m < 4; ++m) {
                    const int lrow = ai * 128 + wr * 64 + m * 16 + fr, grow = 254 * u.pm - 2 + lrow, pos = grow & 2047;
                    f32x4 cv[2];
#pragma unroll
                    for (int bj = 0; bj < 2; ++bj) {
                        const f32x4 cur = acc[ai][bj][m][n];
                        f32x4 q1, q2;
                        if (m > 0) { const f32x4 pv = acc[ai][bj][m - 1][n];
#pragma unroll
                            for (int e = 0; e < 4; ++e) { q1[e] = dpp_ror1(pv[e]); q2[e] = dpp_ror2(pv[e]); } }
                        else { const int slab = ai * 2 + wr - 1; f32x4 h1 = (f32x4){0.f, 0.f, 0.f, 0.f}, h2 = h1;
                            if (slab >= 0) { h1 = *(const LAS f32x4*)(hal + (slab * 2 + 1) * 256 + bj * 128 + colw + 4 * n); h2 = *(const LAS f32x4*)(hal + (slab * 2) * 256 + bj * 128 + colw + 4 * n); }
                            q1 = h1; q2 = (fr == 1) ? h1 : h2; }
                        f32x4 c = bb[bj];
#pragma unroll
                        for (int e = 0; e < 4; ++e) { const float r1 = dpp_ror1(cur[e]), r2 = dpp_ror2(cur[e]);
                            const float p1 = fr >= 1 ? r1 : q1[e], p2 = fr >= 2 ? r2 : q2[e];
                            float v = c[e] + w[bj][2][e] * cur[e];
                            if (pos >= 1) v += w[bj][1][e] * p1;
                            if (pos >= 2) v += w[bj][0][e] * p2;
                            c[e] = v; }
                        cv[bj] = c;
                    }
                    float a4[4];
#pragma unroll
                    for (int e = 0; e < 4; ++e) { const float gx = cv[0][e]; a4[e] = gx * __builtin_amdgcn_rcpf(1.0f + __expf(-gx)) * cv[1][e]; }
                    if (lrow >= 2 && grow < MTOK) { u32x2 o; o.x = pk2(a4[0], a4[1]); o.y = pk2(a4[2], a4[3]); *(u32x2*)(ACT + (size_t)grow * FF + ch) = o; }
                }
        }
    }
};
struct EpiDsaIn {
    static constexpr bool PERM = false;
    unsigned char* ws; LAS float* scr;
    __device__ __forceinline__ void operator()(const AccT& acc_in, const Unit& u, int wr, int wc, int fr, int fq) const {
        const int row0 = u.pm * 256 + wr * 64 + fr;
        const float* part = (const float*)(ws + WS_PART); const float* ropeC = (const float*)(ws + WS_ROPE); const float* ropeS = ropeC + SEQ * 64;
        bf16_t* VTD = (bf16_t*)(ws + WS_VTD); float* WI = (float*)(ws + WS_WI);
        const bool need_norm = (u.pn < 10) || (u.pn == 20);
        float rs[2][4];
#pragma unroll
        for (int ai = 0; ai < 2; ++ai)
#pragma unroll
            for (int m = 0; m < 4; ++m) rs[ai][m] = row_rstd(part, row0 + ai * 128 + m * 16, fq);
        if (need_norm) {
#pragma unroll
            for (int ai = 0; ai < 2; ++ai)
#pragma unroll
                for (int m = 0; m < 4; ++m)
#pragma unroll
                    for (int bj = 0; bj < 2; ++bj) { const f32x4 a = acc_in[ai][bj][m][0], b = acc_in[ai][bj][m][1];
                        float ss = ((a[0] * a[0] + a[1] * a[1]) + (a[2] * a[2] + a[3] * a[3])) + ((b[0] * b[0] + b[1] * b[1]) + (b[2] * b[2] + b[3] * b[3]));
                        ss += __shfl_xor(ss, 16); ss += __shfl_xor(ss, 32);
                        if (fq == 0) scr[(ai * 128 + wr * 64 + m * 16 + fr) * 8 + bj * 4 + wc] = ss * rs[ai][m] * rs[ai][m]; }
            asm volatile("s_waitcnt lgkmcnt(0)" ::: "memory"); __builtin_amdgcn_s_barrier(); asm volatile("" ::: "memory");
        }
        const int dl = 16 * wc + 4 * fq;
#pragma unroll
        for (int bj = 0; bj < 2; ++bj) {
            const int hh = 2 * u.pn + bj;
            if (hh >= 20 && hh < 24) {
#pragma unroll
                for (int ai = 0; ai < 2; ++ai)
#pragma unroll
                    for (int m = 0; m < 4; ++m) { const int row = row0 + ai * 128 + m * 16, b = row >> 11, s = row & 2047; const float r = rs[ai][m];
                        bf16_t* p = VTD + ((size_t)(b * KVH + (hh - 20)) * HD + dl) * SEQ + s;
#pragma unroll
                        for (int n = 0; n < 2; ++n)
#pragma unroll
                            for (int e = 0; e < 4; ++e) p[(size_t)(64 * n + e) * SEQ] = f2bf(acc_in[ai][bj][m][n][e] * r); }
            } else if (hh == 41) {
                if (wc == 0) {
#pragma unroll
                    for (int ai = 0; ai < 2; ++ai)
#pragma unroll
                        for (int m = 0; m < 4; ++m) { const int row = row0 + ai * 128 + m * 16; *(f32x4*)(WI + (size_t)row * 16 + 4 * fq) = acc_in[ai][bj][m][0] * rs[ai][m]; } }
            } else {
                const bool norm = (hh < 20) || (hh == 40);
                const float* g = (const float*)(ws + WS_GAIN) + (hh < 16 ? 0 : (hh < 20 ? 128 : 256));
                f32x4 g0 = (f32x4){1.f, 1.f, 1.f, 1.f}, g1 = g0;
                if (norm) { g0 = *(const f32x4*)(g + dl); g1 = *(const f32x4*)(g + dl + 64); }
                size_t boff; int ld, cb;
                if (hh < 16) { boff = WS_Q; ld = DM; cb = hh * HD; } else if (hh < 20) { boff = WS_KD; ld = KVH * HD; cb = (hh - 16) * HD; }
                else if (hh < 40) { boff = WS_QI; ld = DM; cb = (hh - 24) * HD; } else { boff = WS_KI; ld = HD; cb = 0; }
                bf16_t* base = (bf16_t*)(ws + boff);
                const float osc = hh < 16 ? QSCALE : 1.0f;
#pragma unroll
                for (int ai = 0; ai < 2; ++ai)
#pragma unroll
                    for (int m = 0; m < 4; ++m) { const int lrow = ai * 128 + wr * 64 + m * 16 + fr, row = u.pm * 256 + lrow, pos = row & 2047;
                        float sc = rs[ai][m];
                        if (norm) { const f32x4 t = *(const LAS f32x4*)(scr + lrow * 8 + bj * 4); sc *= 1.0f / sqrtf(((t[0] + t[1]) + (t[2] + t[3])) * (1.0f / HD) + NORM_EPS); }
                        sc *= osc;
                        const f32x4 c = *(const f32x4*)(ropeC + pos * 64 + dl), sn = *(const f32x4*)(ropeS + pos * 64 + dl);
                        const f32x4 y0 = acc_in[ai][bj][m][0] * g0 * sc, y1 = acc_in[ai][bj][m][1] * g1 * sc;
                        const f32x4 o0 = y0 * c - y1 * sn, o1 = y1 * c + y0 * sn;
                        bf16_t* rp = base + (size_t)row * ld + cb + dl;
                        u32x2 w0, w1; w0.x = pk2(o0[0], o0[1]); w0.y = pk2(o0[2], o0[3]); w1.x = pk2(o1[0], o1[1]); w1.y = pk2(o1[2], o1[3]);
                        *(u32x2*)rp = w0; *(u32x2*)(rp + 64) = w1; }
            }
        }
    }
};

enum { WM_PLAIN = 0, WM_UP = 1, WM_IN = 2 };
__device__ __forceinline__ int colmap(int kind, int np) {
    if (kind == WM_UP) { const int pn = np >> 8, bj = (np >> 7) & 1, q = np & 127; return bj * FF + 128 * pn + q; }
    if (kind == WM_IN) { const int hh = np >> 7, p = np & 127, d = 16 * (p >> 5) + (p & 15) + 64 * ((p >> 4) & 1);
        if (hh < 41) return hh * 128 + d; return (p < 16) ? (5248 + p) : -1; }
    return np;
}
struct WJ { const float* W; const float* gain; bf16_t* WT; int K, N, NP, kind, local; };
__device__ __forceinline__ void tr_load(const WJ& j, int lane, f32x4 (&v)[16]) {
    const int nblk = j.NP / 64, kb = j.local / nblk, nb = j.local - kb * nblk, k0 = 64 * kb, n0 = 64 * nb;
    const int src = colmap(j.kind, n0 + 4 * (lane & 15)), rg = lane >> 4;
    const float* p = j.W + (size_t)(k0 + rg) * j.N + (src >= 0 ? src : 0);
#pragma unroll
    for (int i = 0; i < 16; ++i) { v[i] = *(const f32x4*)(p + (size_t)(4 * i) * j.N); if (src < 0) v[i] = (f32x4){0.f, 0.f, 0.f, 0.f}; }
}
__device__ __forceinline__ void tr_process(const WJ& j, int lane, const f32x4 (&v)[16], LAS float* scr) {
    const int nblk = j.NP / 64, kb = j.local / nblk, nb = j.local - kb * nblk, k0 = 64 * kb, n0 = 64 * nb;
    const int rg = lane >> 4, cg = lane & 15;
    float gl = 1.0f; if (j.gain) gl = j.gain[k0 + lane];
#pragma unroll
    for (int i = 0; i < 16; ++i) { const int kk = 4 * i + rg; const float g = __shfl(gl, kk); LAS float* d = scr + kk * 65 + 4 * cg;
        d[0] = v[i][0] * g; d[1] = v[i][1] * g; d[2] = v[i][2] * g; d[3] = v[i][3] * g; }
    asm volatile("s_waitcnt lgkmcnt(0)" ::: "memory");
    const int c = lane & 7;
#pragma unroll
    for (int jj = 0; jj < 8; ++jj) { const int n = (lane >> 3) + 8 * jj; const LAS float* s = scr + (8 * c) * 65 + n;
        u32x4 o; o.x = pk2(s[0 * 65], s[1 * 65]); o.y = pk2(s[2 * 65], s[3 * 65]); o.z = pk2(s[4 * 65], s[5 * 65]); o.w = pk2(s[6 * 65], s[7 * 65]);
        *(u32x4*)(j.WT + (size_t)(n0 + n) * j.K + k0 + 8 * c) = o; }
    asm volatile("s_waitcnt lgkmcnt(0)" ::: "memory");
}

struct Args {
    const float* x; const float* attn_g; const float* ffn_g; const float* w_qkv; const float* w_o0; const float* w_in;
    const float* qn_g; const float* kn_g; const float* ikn_g; const float* w_o1; const float* w_up; const float* conv_w; const float* conv_b; const float* w_down;
    float* out; unsigned char* ws; int ph_lo, ph_hi;
};

constexpr int WI0 = 32 * 96, WI1 = WI0 + 32 * 32, WI2 = WI1 + 32 * 84, WI3 = WI2 + 32 * 32, WI4 = WI3 + 32 * 176, WI5 = WI4 + 32 * 176, WI6 = WI5 + 88 * 32, WI7 = WI6 + 88 * 32;
__device__ __forceinline__ WJ wj_decode(const Args& a, int it) {
    unsigned char* ws = a.ws; WJ j;
    if (it < WI0)      j = WJ{a.w_qkv, nullptr, (bf16_t*)(ws + WS_WQKV), DM, NQKV, NQKV, WM_PLAIN, it};
    else if (it < WI1) j = WJ{a.w_o0, nullptr, (bf16_t*)(ws + WS_WO0), DM, DM, DM, WM_PLAIN, it - WI0};
    else if (it < WI2) j = WJ{a.w_in, a.attn_g + DM, (bf16_t*)(ws + WS_WIN), DM, NIN, NINP, WM_IN, it - WI1};
    else if (it < WI3) j = WJ{a.w_o1, nullptr, (bf16_t*)(ws + WS_WO1), DM, DM, DM, WM_PLAIN, it - WI2};
    else if (it < WI4) j = WJ{a.w_up, a.ffn_g, (bf16_t*)(ws + WS_WUP), DM, NUP, NUP, WM_UP, it - WI3};
    else if (it < WI5) j = WJ{a.w_up + (size_t)DM * NUP, a.ffn_g + DM, (bf16_t*)(ws + WS_WUP + 44 * MiB), DM, NUP, NUP, WM_UP, it - WI4};
    else if (it < WI6) j = WJ{a.w_down, nullptr, (bf16_t*)(ws + WS_WDN), FF, DM, DM, WM_PLAIN, it - WI5};
    else               j = WJ{a.w_down + (size_t)FF * DM, nullptr, (bf16_t*)(ws + WS_WDN + 22 * MiB), FF, DM, DM, WM_PLAIN, it - WI6};
    return j;
}
__device__ __forceinline__ void prologue_phase(const Args& a, LAS unsigned char* lds, int gw, int ngw, int wave, int lane) {
    unsigned char* ws = a.ws;
    LAS float* scr = (LAS float*)(lds + wave * 16640);
    {
        int it = gw;
        if (it < WI7) {
            f32x4 va[16], vb[16];
            WJ ja = wj_decode(a, it), jb = ja;
            tr_load(ja, lane, va);
            for (;;) {
                int nx = it + ngw; bool hn = nx < WI7;
                if (hn) { jb = wj_decode(a, nx); tr_load(jb, lane, vb); }
                tr_process(ja, lane, va, scr);
                if (!hn) break;
                it = nx; nx = it + ngw; hn = nx < WI7;
                if (hn) { ja = wj_decode(a, nx); tr_load(ja, lane, va); }
                tr_process(jb, lane, vb, scr);
                if (!hn) break;
                it = nx;
            }
        }
    }
    bf16_t* XB = (bf16_t*)(ws + WS_XB);
    for (int m = gw; m < MTOK; m += ngw) {
        const f32x4* xr = (const f32x4*)(a.x + (size_t)m * DM) + lane;
        f32x4 v[8]; float s = 0.f;
#pragma unroll
        for (int j = 0; j < 8; ++j) { v[j] = xr[64 * j]; s += (v[j].x * v[j].x + v[j].y * v[j].y) + (v[j].z * v[j].z + v[j].w * v[j].w); }
        const float rstd = 1.0f / sqrtf(wave_sum(s) * (1.0f / DM) + NORM_EPS);
        u32x2* o8 = (u32x2*)(XB + (size_t)m * DM) + lane;
#pragma unroll
        for (int j = 0; j < 8; ++j) { const f32x4 g = ((const f32x4*)a.attn_g)[lane + 64 * j]; u32x2 w; w.x = pk2(v[j].x * rstd * g.x, v[j].y * rstd * g.y); w.y = pk2(v[j].z * rstd * g.z, v[j].w * rstd * g.w); o8[64 * j] = w; }
    }
    if (gw == 0) { float* gn = (float*)(ws + WS_GAIN); for (int i = lane; i < 128; i += 64) { gn[i] = a.qn_g[i]; gn[128 + i] = a.kn_g[i]; gn[256 + i] = a.ikn_g[i]; } }
    float* rc = (float*)(ws + WS_ROPE); float* rsn = rc + SEQ * 64;
    for (int i = gw * 64 + lane; i < SEQ * 64; i += ngw * 64) {
        const int pos = i >> 6, fi = i & 63;
        const float inv_freq = (float)(1.0 / exp2((double)fi * (2.0 / 128.0) * 13.287712379549449));
        const float ang = (float)pos * inv_freq;
        const double x = (double)ang; const double kq = rint(x * 0.63661977236758134308);
        double r = __builtin_fma(-kq, 1.57079632679489655800e+00, x); r = __builtin_fma(-kq, 6.12323399573676603587e-17, r);
        const double r2 = r * r;
        double sp = -1.0 / 6227020800.0; sp = sp * r2 + 1.0 / 39916800.0; sp = sp * r2 - 1.0 / 362880.0; sp = sp * r2 + 1.0 / 5040.0; sp = sp * r2 - 1.0 / 120.0; sp = sp * r2 + 1.0 / 6.0; const double sv = r - r * r2 * sp;
        double cp = 1.0 / 87178291200.0; cp = cp * r2 - 1.0 / 479001600.0; cp = cp * r2 + 1.0 / 3628800.0; cp = cp * r2 - 1.0 / 40320.0; cp = cp * r2 + 1.0 / 720.0; cp = cp * r2 - 1.0 / 24.0; cp = cp * r2 + 0.5; const double cv = 1.0 - r2 * cp;
        const int q = ((int)kq) & 3;
        const double cs = (q == 0) ? cv : (q == 1) ? -sv : (q == 2) ? -cv : sv;
        const double sn = (q == 0) ? sv : (q == 1) ? cv : (q == 2) ? -sv : -cv;
        rc[i] = (float)cs; rsn[i] = (float)sn;
    }
}

constexpr float SB_EXIT = 220.0f;
__device__ __forceinline__ void sb_attn_phase(const bf16_t* __restrict__ Q, const bf16_t* __restrict__ K, const bf16_t* __restrict__ Vt, bf16_t* __restrict__ O, int gw, int ngw, int lane) {
    const int r = lane & 31, hh = lane >> 5;
    bf16x8 uf[2];
#pragma unroll
    for (int s2 = 0; s2 < 2; ++s2) { u32x4 w;
        unsigned e[8];
#pragma unroll
        for (int j = 0; j < 8; ++j) { const int key = 16 * s2 + 8 * (j >> 2) + 4 * hh + (j & 3); e[j] = (key >= r) ? 0x3f80u : 0u; }
        w.x = e[0] | (e[1] << 16); w.y = e[2] | (e[3] << 16); w.z = e[4] | (e[5] << 16); w.w = e[6] | (e[7] << 16); uf[s2] = __builtin_bit_cast(bf16x8, w); }
    for (int unit = gw; unit < BATCH * NH * 64; unit += ngw) {
        const int bh = unit >> 6, qt = 63 - (unit & 63), b = bh >> 4, h = bh & 15, q0 = qt * 32;
        const bf16_t* qp = Q + (size_t)(b * SEQ + q0 + r) * DM + h * HD + 8 * hh;
        bf16x8 qf[8];
#pragma unroll
        for (int s = 0; s < 8; ++s) qf[s] = *(const bf16x8*)(qp + 16 * s);
        f32x16 o[4];
#pragma unroll
        for (int d = 0; d < 4; ++d) o[d] = f32x16{};
        float carry = 0.f;
        const bf16_t* kbase = K + (size_t)(b * SEQ + r) * DM + h * HD + 8 * hh;
        const bf16_t* vbase = Vt + ((size_t)bh * HD + r) * SEQ + 4 * hh;
        for (int kt = qt; kt >= 0; --kt) {
            const int key0 = kt * 32;
            const bf16_t* kp = kbase + (size_t)key0 * DM;
            bf16x8 kf[8];
#pragma unroll
            for (int s = 0; s < 8; ++s) kf[s] = *(const bf16x8*)(kp + 16 * s);
            bf16x8 vf[4][2];
#pragma unroll
            for (int d = 0; d < 4; ++d)
#pragma unroll
                for (int s2 = 0; s2 < 2; ++s2) { const bf16_t* vp = vbase + (size_t)(32 * d) * SEQ + key0 + 16 * s2;
                    const s16x4 lo = *(const s16x4*)vp, hi = *(const s16x4*)(vp + 8);
                    vf[d][s2] = (bf16x8){lo[0], lo[1], lo[2], lo[3], hi[0], hi[1], hi[2], hi[3]}; }
            f32x16 p = f32x16{};
#pragma unroll
            for (int s = 0; s < 8; ++s) p = __builtin_amdgcn_mfma_f32_32x32x16_bf16(kf[s], qf[s], p, 0, 0, 0);
            const bool diag = (kt == qt);
            f32x16 sp;
#pragma unroll
            for (int i = 0; i < 16; ++i) { const float z = p[i]; float v = fmaxf(z, 0.f) + __builtin_amdgcn_logf(1.0f + __builtin_amdgcn_exp2f(-fabsf(z)));
                if (diag && crow(i, hh) >= r) v = 0.f; sp[i] = v; }
            f32x16 c;
#pragma unroll
            for (int i = 0; i < 16; ++i) c[i] = carry;
            c = __builtin_amdgcn_mfma_f32_32x32x16_bf16(uf[0], pack8(sp, 0), c, 0, 0, 0);
            c = __builtin_amdgcn_mfma_f32_32x32x16_bf16(uf[1], pack8(sp, 8), c, 0, 0, 0);
            f32x16 av;
#pragma unroll
            for (int i = 0; i < 16; ++i) { float v = __builtin_amdgcn_exp2f(p[i] - c[i]); if (diag && crow(i, hh) >= r) v = 0.f; av[i] = v; }
            carry = swap_max(c[0]);
            const bf16x8 pa0 = pack8(av, 0), pa1 = pack8(av, 8);
#pragma unroll
            for (int d = 0; d < 4; ++d) { o[d] = __builtin_amdgcn_mfma_f32_32x32x16_bf16(vf[d][0], pa0, o[d], 0, 0, 0); o[d] = __builtin_amdgcn_mfma_f32_32x32x16_bf16(vf[d][1], pa1, o[d], 0, 0, 0); }
            if (__all(carry > SB_EXIT)) break;
        }
        bf16_t* op = O + (size_t)(b * SEQ + q0 + r) * DM + h * HD + 4 * hh;
#pragma unroll
        for (int d = 0; d < 4; ++d)
#pragma unroll
            for (int g = 0; g < 4; ++g) { u32x2 w; w.x = pk2(o[d][4 * g], o[d][4 * g + 1]); w.y = pk2(o[d][4 * g + 2], o[d][4 * g + 3]); *(u32x2*)(op + 32 * d + 8 * g) = w; }
    }
}

__device__ __forceinline__ void conv_phase(const bf16_t* __restrict__ U, const float* __restrict__ cw, const float* __restrict__ cb, bf16_t* __restrict__ ACT, int gtid, int nthreads) {
    constexpr int C8 = FF / 8;
    for (int it = gtid; it < MTOK * C8; it += nthreads) {
        const int row = it / C8, c8 = it - row * C8, j0 = c8 * 8, pn = j0 >> 7, q = j0 & 127, s = row & 2047;
        const bf16_t* ug = U + (size_t)row * NUP + 256 * pn + q;
        float cgv[2][8];
#pragma unroll
        for (int half = 0; half < 2; ++half) {
            const bf16_t* up = ug + half * 128; const int cc = half * FF + j0;
            const f32x4 b0 = *(const f32x4*)(cb + cc), b1 = *(const f32x4*)(cb + cc + 4);
            float accv[8] = {b0[0], b0[1], b0[2], b0[3], b1[0], b1[1], b1[2], b1[3]};
#pragma unroll
            for (int tap = 0; tap < 3; ++tap) { const int back = 2 - tap;
                if (s >= back) { const u32x4 w = *(const u32x4*)(up - (size_t)back * NUP);
                    const f32x4 w0 = *(const f32x4*)(cw + (size_t)tap * NUP + cc), w1 = *(const f32x4*)(cw + (size_t)tap * NUP + cc + 4);
                    accv[0] += __uint_as_float(w.x << 16) * w0[0]; accv[1] += __uint_as_float(w.x & 0xffff0000u) * w0[1];
                    accv[2] += __uint_as_float(w.y << 16) * w0[2]; accv[3] += __uint_as_float(w.y & 0xffff0000u) * w0[3];
                    accv[4] += __uint_as_float(w.z << 16) * w1[0]; accv[5] += __uint_as_float(w.z & 0xffff0000u) * w1[1];
                    accv[6] += __uint_as_float(w.w << 16) * w1[2]; accv[7] += __uint_as_float(w.w & 0xffff0000u) * w1[3]; } }
#pragma unroll
            for (int e = 0; e < 8; ++e) cgv[half][e] = accv[e];
        }
        float a8[8];
#pragma unroll
        for (int e = 0; e < 8; ++e) { const float gx = cgv[0][e]; a8[e] = gx / (1.0f + __expf(-gx)) * cgv[1][e]; }
        u32x4 w; w.x = pk2(a8[0], a8[1]); w.y = pk2(a8[2], a8[3]); w.z = pk2(a8[4], a8[5]); w.w = pk2(a8[6], a8[7]);
        *(u32x4*)(ACT + (size_t)row * FF + j0) = w;
    }
}

__device__ __forceinline__ unsigned fmap(float f) { const unsigned u = __float_as_uint(f); return (u & 0x80000000u) ? ~u : (u | 0x80000000u); }
__device__ __forceinline__ void indexer_unit(const bf16_t* __restrict__ QI, const bf16_t* __restrict__ KI, const float* __restrict__ WI, unsigned* __restrict__ MASK, LAS float* sc, int b, int t0, int wave, int lane) {
    const int r = lane & 31, hh = lane >> 5, ql_r = r >> 4, head_r = r & 15;
    const int tw = t0 + 2 * wave;
    const bf16_t* ap = QI + (size_t)(b * SEQ + tw + ql_r) * DM + head_r * HD + 8 * hh;
    bf16x8 af[8];
#pragma unroll
    for (int s = 0; s < 8; ++s) af[s] = *(const bf16x8*)(ap + 16 * s);
    float wv[16];
#pragma unroll
    for (int i = 0; i < 16; ++i) { const int rw = crow(i, hh); wv[i] = WI[(size_t)(b * SEQ + tw + (rw >> 4)) * 16 + (rw & 15)]; }
    const int nkt = (t0 + 16 + 31) >> 5;
    const bf16_t* kb = KI + (size_t)(b * SEQ + r) * HD + 8 * hh;
    LAS float* myrow = sc + (2 * wave + hh) * SEQ;
    const int tq = tw + hh;
    for (int kt = 0; kt < nkt; ++kt) {
        const bf16_t* kp = kb + (size_t)kt * 32 * HD;
        bf16x8 bfr[8];
#pragma unroll
        for (int s = 0; s < 8; ++s) bfr[s] = *(const bf16x8*)(kp + 16 * s);
        f32x16 c = f32x16{};
#pragma unroll
        for (int s = 0; s < 8; ++s) c = __builtin_amdgcn_mfma_f32_32x32x16_bf16(af[s], bfr[s], c, 0, 0, 0);
        float s0 = 0.f, s1 = 0.f;
#pragma unroll
        for (int i = 0; i < 8; ++i) { s0 += wv[i] * fmaxf(c[i], 0.f); s1 += wv[i + 8] * fmaxf(c[i + 8], 0.f); }
        const float t0s = swap_sum(s0), t1s = swap_sum(s1);
        const int key = kt * 32 + r;
        float v = (hh ? t1s : t0s) + 0.0f;
        if (key > tq) v = -INFINITY;
        myrow[key] = v;
    }
    asm volatile("s_waitcnt lgkmcnt(0)" ::: "memory");
    for (int ql = 0; ql < 2; ++ql) {
        const int t = tw + ql, n = t + 1;
        unsigned* mrow = MASK + (size_t)(b * SEQ + t) * 64;
        if (n <= TOPK) {
            const int key0 = 32 * lane; unsigned w;
            if (key0 + 31 <= t) w = 0xffffffffu; else if (key0 > t) w = 0u; else w = (1u << (t - key0 + 1)) - 1u;
            mrow[lane] = w;
        } else {
            const LAS float* row = sc + (2 * wave + ql) * SEQ;
            unsigned uv[32];
#pragma unroll
            for (int e = 0; e < 32; ++e) { const int key = e * 64 + lane; uv[e] = (key < n) ? fmap(row[key]) : 0x007fffffu; }
            unsigned prefix = 0u;
            for (int bit = 31; bit >= 0; --bit) {
                const unsigned cand = prefix | (1u << bit); int cnt = 0;
#pragma unroll
                for (int e = 0; e < 32; ++e) cnt += __popcll(__ballot(uv[e] >= cand));
                if (cnt >= TOPK) prefix = cand;
            }
            int cgt = 0;
#pragma unroll
            for (int e = 0; e < 32; ++e) cgt += __popcll(__ballot(uv[e] > prefix));
            const int need = TOPK - cgt; int running = 0;
            const unsigned long long ltm = (1ull << lane) - 1ull;
            unsigned long long keep = 0ull;
#pragma unroll
            for (int e = 0; e < 32; ++e) {
                const unsigned long long eq = __ballot(uv[e] == prefix);
                const bool sel = (uv[e] > prefix) || (uv[e] == prefix && (running + __popcll(eq & ltm)) < need);
                const unsigned long long m64 = __ballot(sel);
                running += __popcll(eq);
                if (lane == e) keep = m64;
            }
            if (lane < 32) *(unsigned long long*)(mrow + 2 * lane) = keep;
        }
    }
    asm volatile("s_waitcnt lgkmcnt(0)" ::: "memory");
}

__device__ __forceinline__ void dsa_attn_unit(const bf16_t* __restrict__ QD, const bf16_t* __restrict__ KD, const bf16_t* __restrict__ VTD, const unsigned* __restrict__ MASK, bf16_t* __restrict__ O,
                                              int b, int g, int h, int q0, int lane) {
    const int r = lane & 31, hh = lane >> 5;
    const bf16_t* qp = QD + (size_t)(b * SEQ + q0 + r) * DM + h * HD + 8 * hh;
    bf16x8 qf[8];
#pragma unroll
    for (int s = 0; s < 8; ++s) qf[s] = *(const bf16x8*)(qp + 16 * s);
    f32x16 o[4];
#pragma unroll
    for (int d = 0; d < 4; ++d) o[d] = f32x16{};
    float mrun = -1e30f, lrun = 0.f;
    const bf16_t* kbase = KD + (size_t)(b * SEQ + r) * (KVH * HD) + g * HD + 8 * hh;
    const bf16_t* vbase = VTD + ((size_t)(b * KVH + g) * HD + r) * SEQ + 4 * hh;
    const unsigned* mrow = MASK + (size_t)(b * SEQ + q0 + r) * 64;
    const int nkt = (q0 + 32) >> 5;
    for (int kt = 0; kt < nkt; ++kt) {
        const int key0 = kt * 32;
        const bf16_t* kp = kbase + (size_t)key0 * (KVH * HD);
        bf16x8 kf[8];
#pragma unroll
        for (int s = 0; s < 8; ++s) kf[s] = *(const bf16x8*)(kp + 16 * s);
        const unsigned mw = mrow[kt];
        bf16x8 vf[4][2];
#pragma unroll
        for (int d = 0; d < 4; ++d)
#pragma unroll
            for (int s2 = 0; s2 < 2; ++s2) { const bf16_t* vp = vbase + (size_t)(32 * d) * SEQ + key0 + 16 * s2;
                const s16x4 lo = *(const s16x4*)vp, hi = *(const s16x4*)(vp + 8);
                vf[d][s2] = (bf16x8){lo[0], lo[1], lo[2], lo[3], hi[0], hi[1], hi[2], hi[3]}; }
        f32x16 p = f32x16{};
#pragma unroll
        for (int s = 0; s < 8; ++s) p = __builtin_amdgcn_mfma_f32_32x32x16_bf16(kf[s], qf[s], p, 0, 0, 0);
        float tmax = -1e30f;
#pragma unroll
        for (int i = 0; i < 16; ++i) { const bool valid = (mw >> crow(i, hh)) & 1u; tmax = fmaxf(tmax, valid ? p[i] : -1e30f); }
        tmax = swap_max(tmax);
        const float mnew = fmaxf(mrun, tmax), alpha = __builtin_amdgcn_exp2f(mrun - mnew);
        float ls = 0.f; f32x16 pe;
#pragma unroll
        for (int i = 0; i < 16; ++i) { const bool valid = (mw >> crow(i, hh)) & 1u; const float e = valid ? __builtin_amdgcn_exp2f(p[i] - mnew) : 0.f; pe[i] = e; ls += e; }
        lrun = lrun * alpha + ls; mrun = mnew;
#pragma unroll
        for (int d = 0; d < 4; ++d)
#pragma unroll
            for (int i = 0; i < 16; ++i) o[d][i] *= alpha;
        const bf16x8 pa0 = pack8(pe, 0), pa1 = pack8(pe, 8);
#pragma unroll
        for (int d = 0; d < 4; ++d) { o[d] = __builtin_amdgcn_mfma_f32_32x32x16_bf16(vf[d][0], pa0, o[d], 0, 0, 0); o[d] = __builtin_amdgcn_mfma_f32_32x32x16_bf16(vf[d][1], pa1, o[d], 0, 0, 0); }
    }
    const float linv = 1.0f / swap_sum(lrun);
    bf16_t* op = O + (size_t)(b * SEQ + q0 + r) * DM + h * HD + 4 * hh;
#pragma unroll
    for (int d = 0; d < 4; ++d)
#pragma unroll
        for (int gq = 0; gq < 4; ++gq) { u32x2 w; w.x = pk2(o[d][4 * gq] * linv, o[d][4 * gq + 1] * linv); w.y = pk2(o[d][4 * gq + 2] * linv, o[d][4 * gq + 3] * linv); *(u32x2*)(op + 32 * d + 8 * gq) = w; }
}

constexpr int N_PHASES = 12;
__global__ void __launch_bounds__(512, 2) fwd_kernel(Args a) {
    extern __shared__ __attribute__((aligned(16))) unsigned char lds_raw[];
    LAS unsigned char* lds = (LAS unsigned char*)lds_raw;
    cg::grid_group grid = cg::this_grid();
    const int tid = threadIdx.x, lane = tid & 63, wave = __builtin_amdgcn_readfirstlane(tid >> 6);
    const int G = gridDim.x, bx = blockIdx.x;
    const int gw = bx * 8 + wave, ngw = G * 8;
    unsigned char* ws = a.ws;
    const int lo = a.ph_lo, hi = a.ph_hi;
#ifndef REP_PHASE
#define REP_PHASE -1
#endif
#ifndef REP_COUNT
#define REP_COUNT 1
#endif
#define IN(k) (lo <= (k) && (k) < hi)
#define GSYNC(k) do { if ((k) == 0) grid.sync(); else xcd_barrier(xbar); } while (0)
#define SEAM(k) do { if (IN(k) && IN((k) + 1)) GSYNC(k); } while (0)
#define REPS(k) for (int rep_ = 0; rep_ < ((k) == REP_PHASE ? REP_COUNT : 1); ++rep_, (void)(((k) == REP_PHASE && rep_ < REP_COUNT) ? (xcd_barrier(xbar), 0) : 0))
    bf16_t* XB = (bf16_t*)(ws + WS_XB); float* X1 = (float*)(ws + WS_X1); float* X2 = (float*)(ws + WS_X2); float* PART = (float*)(ws + WS_PART);
    bf16_t* Qb = (bf16_t*)(ws + WS_Q); bf16_t* Kb = (bf16_t*)(ws + WS_K); bf16_t* Vtb = (bf16_t*)(ws + WS_VT); bf16_t* Ob = (bf16_t*)(ws + WS_O);
    bf16_t* QIb = (bf16_t*)(ws + WS_QI); bf16_t* KDb = (bf16_t*)(ws + WS_KD); bf16_t* VTDb = (bf16_t*)(ws + WS_VTD); bf16_t* KIb = (bf16_t*)(ws + WS_KI);
    float* WIb = (float*)(ws + WS_WI); unsigned* MASKb = (unsigned*)(ws + WS_MASK);
    bf16_t* ACTb = (bf16_t*)(ws + WS_ACT);
    const float* ropeC = (const float*)(ws + WS_ROPE); const float* ropeS = ropeC + SEQ * 64;

    if (tid < 16) ((volatile LAS unsigned*)(lds + LDS_MISC))[tid] = 0u;
    __syncthreads();
    XcdBarrier xbar = xcd_barrier_post((unsigned*)(ws + WS_CTL), (volatile LAS unsigned*)(lds + LDS_MISC) + 8);
    if (IN(0)) REPS(0) { prologue_phase(a, lds, gw, ngw, wave, lane); }
    SEAM(0);
    if (IN(1)) REPS(1) {
        pg8::Gemm g{XB, (const bf16_t*)(ws + WS_WQKV), MTOK, NQKV, DM}; pg8::StaticOrder S; S.init(MTOK, NQKV, G, bx);
        EpiQKV E{ws};
        pg8::gemm_phase<EpiQKV, pg8::StaticOrder, true, true>(lds, g, S, E);
    }
    SEAM(1);
    if (IN(2)) REPS(2) { sb_attn_phase(Qb, Kb, Vtb, Ob, gw, ngw, lane); }
    SEAM(2);
    if (IN(3)) REPS(3) {
        pg8::Gemm g{Ob, (const bf16_t*)(ws + WS_WO0), MTOK, DM, DM}; pg8::StaticOrder S; S.init(MTOK, DM, G, bx);
        EpiRes E{a.x, X1, XB, PART};
        pg8::gemm_phase<EpiRes, pg8::StaticOrder, true, true>(lds, g, S, E);
    }
    SEAM(3);
    if (IN(4)) REPS(4) {
        pg8::Gemm g{XB, (const bf16_t*)(ws + WS_WUP), MTOK, NUP, DM, 254, -2}; pg8::StaticOrder S; S.init_tiles(33, NUP / 256, G, bx);
        EpiUpConv E{ACTb, PART, a.conv_w, a.conv_b, (LAS float*)(lds + LDS_EPI)};
        pg8::gemm_phase<EpiUpConv, pg8::StaticOrder, true, true>(lds, g, S, E);
    }
    SEAM(4);
    if (IN(5)) REPS(5) {
        pg8::Gemm g{ACTb, (const bf16_t*)(ws + WS_WDN), MTOK, DM, FF}; pg8::StaticOrder S; S.init(MTOK, DM, G, bx);
        EpiRes E{X1, X2, XB, PART};
        pg8::gemm_phase<EpiRes, pg8::StaticOrder, true, true>(lds, g, S, E);
    }
    SEAM(5);
    if (IN(6)) REPS(6) {
        pg8::Gemm g{XB, (const bf16_t*)(ws + WS_WIN), MTOK, NINP, DM}; pg8::StaticOrder S; S.init(MTOK, NINP, G, bx);
        EpiDsaIn E{ws, (LAS float*)(lds + LDS_EPI)};
        pg8::gemm_phase<EpiDsaIn, pg8::StaticOrder, true, true>(lds, g, S, E);
    }
    SEAM(6);
    if (IN(7)) REPS(7) {
        for (int pr = bx; pr < 256; pr += G) { const int b = pr >> 6, p = pr & 63;
            indexer_unit(QIb, KIb, WIb, MASKb, (LAS float*)lds, b, 16 * (127 - p), wave, lane);
            indexer_unit(QIb, KIb, WIb, MASKb, (LAS float*)lds, b, 16 * p, wave, lane); }
    }
    SEAM(7);
    if (IN(8)) REPS(8) {
        for (int pr = bx; pr < 256; pr += G) { const int b = pr >> 6, g = (pr >> 4) & 3, p = pr & 15;
            const int hl = wave & 3, sub = wave >> 2;
            dsa_attn_unit(Qb, KDb, VTDb, MASKb, Ob, b, g, 4 * g + hl, 64 * (31 - p) + 32 * sub, lane);
            dsa_attn_unit(Qb, KDb, VTDb, MASKb, Ob, b, g, 4 * g + hl, 64 * p + 32 * sub, lane); }
    }
    SEAM(8);
    if (IN(9)) REPS(9) {
        pg8::Gemm g{Ob, (const bf16_t*)(ws + WS_WO1), MTOK, DM, DM}; pg8::StaticOrder S; S.init(MTOK, DM, G, bx);
        EpiRes E{X2, X1, XB, PART};
        pg8::gemm_phase<EpiRes, pg8::StaticOrder, true, true>(lds, g, S, E);
    }
    SEAM(9);
    if (IN(10)) REPS(10) {
        pg8::Gemm g{XB, (const bf16_t*)(ws + WS_WUP + 44 * MiB), MTOK, NUP, DM, 254, -2}; pg8::StaticOrder S; S.init_tiles(33, NUP / 256, G, bx);
        EpiUpConv E{ACTb, PART, a.conv_w + 3 * NUP, a.conv_b + NUP, (LAS float*)(lds + LDS_EPI)};
        pg8::gemm_phase<EpiUpConv, pg8::StaticOrder, true, true>(lds, g, S, E);
    }
    SEAM(10);
    if (IN(11)) REPS(11) {
        pg8::Gemm g{ACTb, (const bf16_t*)(ws + WS_WDN + 22 * MiB), MTOK, DM, FF}; pg8::StaticOrder S; S.init(MTOK, DM, G, bx);
        EpiRes E{X1, a.out, nullptr, nullptr};
        pg8::gemm_phase<EpiRes, pg8::StaticOrder, true, true>(lds, g, S, E);
    }
#undef IN
#undef SEAM
}

extern "C" void kernel_launch(void* const* d_in, const int* in_sizes, int n_in, void* d_out, int out_size, void* d_ws, size_t ws_size, hipStream_t stream) {
    static int grid = 0;
    if (grid == 0) {
        if (n_in != 14 || out_size != MTOK * DM || ws_size < WS_END) { fprintf(stderr, "kernel_launch: unexpected shapes (n_in %d out %d ws %zu)\n", n_in, out_size, ws_size); grid = -1; return; }
        int dev = 0, cus = 0, per_cu = 0;
        hipGetDevice(&dev); hipDeviceGetAttribute(&cus, hipDeviceAttributeMultiprocessorCount, dev);
        if (hipFuncSetAttribute((const void*)fwd_kernel, hipFuncAttributeMaxDynamicSharedMemorySize, LDS_BYTES) != hipSuccess) { fprintf(stderr, "kernel_launch: hipFuncSetAttribute failed\n"); grid = -1; return; }
        if (hipOccupancyMaxActiveBlocksPerMultiprocessor(&per_cu, (const void*)fwd_kernel, 512, LDS_BYTES) != hipSuccess || per_cu < 1) { fprintf(stderr, "kernel_launch: occupancy query says %d\n", per_cu); per_cu = 1; }
        (void)hipGetLastError();
        grid = cus;
    }
    if (grid < 0) return;
    Args a{};
    a.x = (const float*)d_in[0]; a.attn_g = (const float*)d_in[1]; a.ffn_g = (const float*)d_in[2]; a.w_qkv = (const float*)d_in[3]; a.w_o0 = (const float*)d_in[4]; a.w_in = (const float*)d_in[5];
    a.qn_g = (const float*)d_in[6]; a.kn_g = (const float*)d_in[7]; a.ikn_g = (const float*)d_in[8]; a.w_o1 = (const float*)d_in[9]; a.w_up = (const float*)d_in[10]; a.conv_w = (const float*)d_in[11];
    a.conv_b = (const float*)d_in[12]; a.w_down = (const float*)d_in[13]; a.out = (float*)d_out; a.ws = (unsigned char*)d_ws;
    if (hipMemsetAsync((char*)d_ws + WS_CTL, 0, CTL_BYTES, stream) != hipSuccess) { fprintf(stderr, "kernel_launch: hipMemsetAsync failed\n"); return; }
#if MK_ONE_LAUNCH
    a.ph_lo = 0; a.ph_hi = N_PHASES;
    void* args[] = {&a};
    hipError_t e = hipLaunchCooperativeKernel((const void*)fwd_kernel, dim3(grid), dim3(512), args, LDS_BYTES, stream);
    if (e != hipSuccess) fprintf(stderr, "cooperative launch failed: %s (grid %d)\n", hipGetErrorString(e), grid);
#else
    for (int p = 0; p < N_PHASES; ++p) {
        a.ph_lo = p; a.ph_hi = p + 1;
        void* args[] = {&a};
        hipError_t e = hipLaunchCooperativeKernel((const void*)fwd_kernel, dim3(grid), dim3(512), args, LDS_BYTES, stream);
        if (e != hipSuccess) { fprintf(stderr, "launch %d failed: %s (grid %d)\n", p, hipGetErrorString(e), grid); break; }
    }
#endif
}
```

```cpp
#include <hip/hip_runtime.h>
#include <hip/hip_cooperative_groups.h>
#include <cstdio>
#include <cstdint>
namespace cg = cooperative_groups;

#ifndef MK_ONE_LAUNCH
#define MK_ONE_LAUNCH 1
#endif

#define LAS __attribute__((address_space(3)))
typedef unsigned short bf16_t;
typedef short bf16x8 __attribute__((ext_vector_type(8)));
typedef short s16x4 __attribute__((ext_vector_type(4)));
typedef float f32x4 __attribute__((ext_vector_type(4)));
typedef float f32x2 __attribute__((ext_vector_type(2)));
typedef float f32x16 __attribute__((ext_vector_type(16)));
typedef unsigned u32x4 __attribute__((ext_vector_type(4)));
typedef unsigned u32x2 __attribute__((ext_vector_type(2)));
typedef __bf16 bf16x2_t __attribute__((ext_vector_type(2)));

constexpr int BATCH = 4, SEQ = 2048, DM = 2048, NH = 16, HD = 128, MTOK = BATCH * SEQ;
constexpr int FF = 5632, NUP = 2 * FF, NQKV = 3 * DM;
constexpr int KVH = 4, NIN = 5264, NINP = 5376;
constexpr int TOPK = 256;
constexpr float NORM_EPS = 1e-6f;
constexpr float LOG2E = 1.4426950408889634f;
constexpr float QSCALE = 0.08838834764831845f * LOG2E;

constexpr size_t MiB = 1u << 20;
constexpr size_t WS_WQKV = 0, WS_WO0 = 24 * MiB, WS_WIN = 32 * MiB, WS_WO1 = 53 * MiB, WS_WUP = 61 * MiB  , WS_WDN = 149 * MiB  ;
constexpr size_t WS_GAIN = 197 * MiB + 512 * 1024  ;
constexpr size_t WS_ROPE = 193 * MiB  , WS_PART = 194 * MiB, WS_MASK = 195 * MiB, WS_WI = 197 * MiB, WS_KI = 198 * MiB;
constexpr size_t WS_XB = 200 * MiB, WS_X1 = 232 * MiB, WS_X2 = 296 * MiB;
constexpr size_t WS_SCR = 360 * MiB;
constexpr size_t WS_U = WS_SCR, WS_ACT = WS_SCR + 176 * MiB;
constexpr size_t WS_Q = WS_SCR, WS_K = WS_SCR + 32 * MiB, WS_VT = WS_SCR + 64 * MiB, WS_O = WS_SCR + 96 * MiB, WS_QI = WS_SCR + 128 * MiB, WS_KD = WS_SCR + 160 * MiB, WS_VTD = WS_SCR + 168 * MiB;
constexpr size_t WS_CTL = WS_ACT + 88 * MiB, CTL_BYTES = 65536;
constexpr size_t WS_END = WS_CTL + CTL_BYTES;

constexpr int LDS_EPI = 131072;
constexpr int LDS_MISC = LDS_EPI + 8192;
constexpr int LDS_BYTES = 147456;

__device__ __forceinline__ unsigned pk2(float lo, float hi) { f32x2 v = {lo, hi}; bf16x2_t b = __builtin_convertvector(v, bf16x2_t); return __builtin_bit_cast(unsigned, b); }
__device__ __forceinline__ bf16_t f2bf(float f) { return (bf16_t)(pk2(f, 0.f) & 0xffffu); }
__device__ __forceinline__ int crow(int r, int hi) { return (r & 3) + 8 * (r >> 2) + 4 * hi; }
__device__ __forceinline__ bf16x8 pack8(const f32x16& p, int b) {
    u32x4 w; w.x = pk2(p[b], p[b + 1]); w.y = pk2(p[b + 2], p[b + 3]); w.z = pk2(p[b + 4], p[b + 5]); w.w = pk2(p[b + 6], p[b + 7]);
    return __builtin_bit_cast(bf16x8, w);
}
__device__ __forceinline__ float swap_sum(float v) { auto rr = __builtin_amdgcn_permlane32_swap(__float_as_uint(v), __float_as_uint(v), false, false); return __uint_as_float(rr[0]) + __uint_as_float(rr[1]); }
__device__ __forceinline__ float swap_max(float v) { auto rr = __builtin_amdgcn_permlane32_swap(__float_as_uint(v), __float_as_uint(v), false, false); return fmaxf(__uint_as_float(rr[0]), __uint_as_float(rr[1])); }
__device__ __forceinline__ float wave_sum(float v) {
#pragma unroll
    for (int o = 1; o < 64; o <<= 1) v += __shfl_xor(v, o);
    return v;
}
__device__ __forceinline__ float row_rstd(const float* part, int row, int fq) {
    const f32x4* p = (const f32x4*)(part + (size_t)row * 32 + 8 * fq);
    const f32x4 a = p[0], b = p[1]; float s = ((a.x + a.y) + (a.z + a.w)) + ((b.x + b.y) + (b.z + b.w));
    s += __shfl_xor(s, 16); s += __shfl_xor(s, 32);
    return 1.0f / sqrtf(s * (1.0f / DM) + NORM_EPS);
}


#define XB_TMO      128
#define XB_XCNT(j)  (256  + 64 * (j))
#define XB_XSUB(j)  (1280 + 64 * (j))
#define XB_XGEN(j)  (2304 + 64 * (j))
#define XB_TOP      3328
#define XB_TOPGEN   3392
#define XCD_BAR_WORDS 3456
#define XB_SPIN_CAP (1u << 18)
__device__ __forceinline__ unsigned xb_ld(unsigned* p)              { return __hip_atomic_load(p, __ATOMIC_RELAXED, __HIP_MEMORY_SCOPE_AGENT); }
__device__ __forceinline__ unsigned xb_add(unsigned* p, unsigned v) { return __hip_atomic_fetch_add(p, v, __ATOMIC_RELAXED, __HIP_MEMORY_SCOPE_AGENT); }
__device__ __forceinline__ unsigned xb_xcc_id() { return (unsigned)__builtin_amdgcn_s_getreg((3 << 11) | 20) & 0xFu; }
#define XB_SPIN(cond, bar) do { unsigned _sp = 0; while (cond) { __builtin_amdgcn_s_sleep(1); \
    if ((++_sp & 255u) == 0u) { if (xb_ld(&(bar)[XB_TMO])) break; if (_sp > XB_SPIN_CAP) { atomicAdd(&(bar)[XB_TMO], 1u); break; } } } } while (0)
struct XcdBarrier { unsigned* bar; unsigned x; volatile LAS unsigned* st; };
__device__ __forceinline__ XcdBarrier xcd_barrier_post(unsigned* bar, volatile LAS unsigned* st) {
    XcdBarrier b; b.bar = bar; b.x = xb_xcc_id(); b.st = st;
    if (threadIdx.x == 0) (void)xb_add(&bar[XB_XCNT(b.x)], 1u);
    return b;
}
__device__ __forceinline__ void xcd_barrier_complete(unsigned* bar, unsigned x, unsigned& nloc, unsigned& nx) {
    const unsigned G = gridDim.x * gridDim.y * gridDim.z;
    unsigned sum, cnt, mine, sp = 0u;
    for (;;) {
        sum = 0u; cnt = 0u; mine = 0u;
#pragma unroll
        for (unsigned j = 0; j < 16; ++j) { const unsigned c = xb_ld(&bar[XB_XCNT(j)]); sum += c; cnt += (c > 0u) ? 1u : 0u; mine = (j == x) ? c : mine; }
        if (sum == G) break;
        __builtin_amdgcn_s_sleep(1);
        if ((++sp & 255u) == 0u) { if (xb_ld(&bar[XB_TMO])) break; if (sp > XB_SPIN_CAP) { atomicAdd(&bar[XB_TMO], 1u); break; } }
    }
    nloc = mine > 0u ? mine : 1u; nx = cnt > 0u ? cnt : 1u;
}
__device__ __forceinline__ void xcd_barrier(const XcdBarrier& b) {
    asm volatile("s_waitcnt vmcnt(0)" ::: "memory");
    __syncthreads();
    if (threadIdx.x == 0) {
        unsigned* bar = b.bar;
        __builtin_amdgcn_s_waitcnt(0);
        unsigned nloc = b.st[0], nx = b.st[1];
        if (nloc == 0u) { xcd_barrier_complete(bar, b.x, nloc, nx); b.st[0] = nloc; b.st[1] = nx; }
        const unsigned old = xb_add(&bar[XB_XSUB(b.x)], 1u);
        const unsigned gen = old / nloc;
        if (old + 1u == (gen + 1u) * nloc) {
            __builtin_amdgcn_fence(__ATOMIC_RELEASE, "agent");
            asm volatile("s_waitcnt vmcnt(0)" ::: "memory");
            const unsigned og = xb_add(&bar[XB_TOP], 1u);
            const unsigned tg = og / nx;
            if (og + 1u == (tg + 1u) * nx) xb_add(&bar[XB_TOPGEN], 1u);
            else XB_SPIN(xb_ld(&bar[XB_TOPGEN]) == tg, bar);
            __builtin_amdgcn_fence(__ATOMIC_ACQUIRE, "agent");
            xb_add(&bar[XB_XGEN(b.x)], 1u);
            asm volatile("s_waitcnt vmcnt(0)" ::: "memory");
        } else {
            XB_SPIN(xb_ld(&bar[XB_XGEN(b.x)]) == gen, bar);
            __builtin_amdgcn_fence(__ATOMIC_ACQUIRE, "agent");
            asm volatile("s_waitcnt vmcnt(0)" ::: "memory");
        }
    }
    __syncthreads();
}

namespace pg8 {
constexpr int BM = 256, BK = 64, HALF = 128, HTB = HALF * BK * 2, STAGE_BYTES = 8 * HTB, NXCD = 8, WGM = 8;
__host__ __device__ __forceinline__ int lds_byte(int r, int c) { const int st = (r >> 4) * 2 + (c >> 5), rr = r & 15, cc = c & 31, ob = rr * 64 + cc * 2; return st * 1024 + (ob ^ (((ob >> 9) & 1) << 5)); }
__host__ __device__ __forceinline__ void stage_rc(int b, int& R, int& C) { const int st = b / 1024, sb = b % 1024, swz = sb ^ (((sb >> 9) & 1) << 5); R = (st >> 1) * 16 + swz / 64; C = (st & 1) * 32 + (swz % 64) / 2; }
__host__ __device__ __forceinline__ int perm32(int rho) { const int n = rho >> 4, i = rho & 15; return 8 * (i >> 2) + 4 * n + (i & 3); }
struct Unit { int pm, pn; };
struct Gemm { const bf16_t* A; const bf16_t* Bt; int M, N, K; int a_rows = 256, a_row0 = 0; };
struct StaticOrder {
    int nM, nN, nwg, G, c;
    __host__ __device__ void init(int M, int N, int G_, int c_) { nM = M / BM; nN = N / BM; nwg = nM * nN; G = G_; c = c_; }
    __host__ __device__ void init_tiles(int nM_, int nN_, int G_, int c_) { nM = nM_; nN = nN_; nwg = nM * nN; G = G_; c = c_; }
    __host__ __device__ bool next(int i, Unit& u) const {
        const long L = (long)i * G + c; if (L >= nwg) return false;
        int wgid = (int)L; { const int q = nwg / NXCD, r = nwg % NXCD, xcd = wgid % NXCD, off = wgid / NXCD; wgid = (xcd < r ? xcd * (q + 1) : r * (q + 1) + (xcd - r) * q) + off; }
        const int nig = WGM * nN, gid = wgid / nig, fm = gid * WGM, gsz = (nM - fm) < WGM ? (nM - fm) : WGM;
        u.pm = fm + ((wgid % nig) % gsz); u.pn = (wgid % nig) / gsz; return true;
    }
};
template <class Epi, class Sched, bool ALIGN_EPI, bool SP2>
__device__ __forceinline__ void gemm_phase(LAS unsigned char* lds, const Gemm g, const Sched& S, const Epi& E) {
    const int tid = threadIdx.x, wid = __builtin_amdgcn_readfirstlane(tid >> 6), lane = tid & 63, wr = wid >> 2, wc = wid & 3, fr = lane & 15, fq = lane >> 4;
    const int K = g.K, nt = K / BK;
    unsigned voffA[2], voffB[2];
#pragma unroll
    for (int i = 0; i < 2; ++i) { int R, C; stage_rc(tid * 16 + i * 8192, R, C); const int Rb = Epi::PERM ? ((R & ~31) + perm32(R & 31)) : R;
        voffA[i] = (unsigned)(R * K + C) * 2u; voffB[i] = (unsigned)(Rb * K + C) * 2u; }
    const size_t kstep = (size_t)(BK * 2);
    const size_t hstep = (size_t)HALF * K * 2;
    const size_t tstep = 2 * hstep;
    const unsigned ldsw = (unsigned)wid * 1024u;
    const int aoff = lds_byte(wr * 64 + fr, fq * 8), boff = lds_byte(wc * 32 + fr, fq * 8);
#define PG8_SA(b, h) (((b) * 2 + (h)) * HTB)
#define PG8_SB(b, h) ((4 + (b) * 2 + (h)) * HTB)
#define PG8_STAGE(bufoff, gbase, voff) do { _Pragma("unroll") for (int _i = 0; _i < 2; ++_i) \
        __builtin_amdgcn_global_load_lds((const unsigned*)((const char*)(gbase) + (voff)[_i]), (LAS unsigned*)(lds + (bufoff) + ldsw + _i * 8192), 16, 0, 0); } while (0)
#define PG8_LDA(dst, b, h) do { _Pragma("unroll") for (int m = 0; m < 4; ++m) _Pragma("unroll") for (int k = 0; k < 2; ++k) dst[m][k] = *(const LAS bf16x8*)(lds + PG8_SA(b, h) + aoff + m * 2048 + k * 1024); } while (0)
#define PG8_LDB(dst, b, h) do { _Pragma("unroll") for (int n = 0; n < 2; ++n) _Pragma("unroll") for (int k = 0; k < 2; ++k) dst[n][k] = *(const LAS bf16x8*)(lds + PG8_SB(b, h) + boff + n * 2048 + k * 1024); } while (0)
#define PG8_MMA(ai, bj, At, Bt) do { __builtin_amdgcn_s_setprio(1); _Pragma("unroll") for (int m = 0; m < 4; ++m) _Pragma("unroll") for (int n = 0; n < 2; ++n) _Pragma("unroll") for (int k = 0; k < 2; ++k) \
        acc[ai][bj][m][n] = __builtin_amdgcn_mfma_f32_16x16x32_bf16(Bt[n][k], At[m][k], acc[ai][bj][m][n], 0, 0, 0); __builtin_amdgcn_s_setprio(0); } while (0)
#define PG8_WAIT_V(n) asm volatile("s_waitcnt vmcnt(" #n ")" ::: "memory")
#define PG8_WAIT_L(n) asm volatile("s_waitcnt lgkmcnt(" #n ")" ::: "memory")
#define PG8_BAR __builtin_amdgcn_s_barrier()
#define PG8_SCHED __builtin_amdgcn_sched_barrier(0)
    Unit cur, nxt; int ui = 0;
    if (!S.next(0, cur)) return;
    f32x4 acc[2][2][4][2];
#pragma unroll
    for (int a = 0; a < 2; ++a)
#pragma unroll
        for (int b = 0; b < 2; ++b)
#pragma unroll
            for (int m = 0; m < 4; ++m)
#pragma unroll
                for (int n = 0; n < 2; ++n) acc[a][b][m][n] = (f32x4){0.f, 0.f, 0.f, 0.f};
    bf16x8 At[4][2], B0[2][2], B1[2][2];
    const long atstep = (long)g.a_rows * K * 2, aorg = (long)g.a_row0 * K * 2;
    const char* cA = (const char*)g.A + aorg + (long)cur.pm * atstep; const char* cB = (const char*)g.Bt + (size_t)cur.pn * tstep;
    if constexpr (SP2) {
        PG8_STAGE(PG8_SB(0, 0), cB, voffB); PG8_STAGE(PG8_SB(0, 1), cB + hstep, voffB); PG8_STAGE(PG8_SA(0, 0), cA, voffA); PG8_STAGE(PG8_SA(0, 1), cA + hstep, voffA);
        if (wr == 1) PG8_BAR;
        PG8_WAIT_V(2); PG8_BAR;
        PG8_STAGE(PG8_SB(1, 0), cB + kstep, voffB); PG8_STAGE(PG8_SA(1, 0), cA + kstep, voffA); PG8_STAGE(PG8_SB(1, 1), cB + hstep + kstep, voffB);
        PG8_WAIT_V(6); PG8_BAR;
    } else {
        PG8_STAGE(PG8_SB(0, 0), cB, voffB); PG8_STAGE(PG8_SA(0, 0), cA, voffA); PG8_STAGE(PG8_SB(0, 1), cB + hstep, voffB); PG8_STAGE(PG8_SA(0, 1), cA + hstep, voffA);
        if (wr == 1) PG8_BAR;
        PG8_WAIT_V(4); PG8_BAR;
        PG8_STAGE(PG8_SB(1, 0), cB + kstep, voffB); PG8_STAGE(PG8_SA(1, 0), cA + kstep, voffA); PG8_STAGE(PG8_SB(1, 1), cB + hstep + kstep, voffB);
        PG8_WAIT_V(6); PG8_BAR;
    }
    for (;;) {
        const bool has_next = S.next(ui + 1, nxt);
        const char* nA = has_next ? (const char*)g.A + aorg + (long)nxt.pm * atstep : cA; const char* nB = has_next ? (const char*)g.Bt + (size_t)nxt.pn * tstep : cB;
        for (int t = 0; t < nt; t += 2) {
            const bool last = (t == nt - 2);
            const char* a1 = cA + (size_t)(t + 1) * kstep;
            const char* a2 = last ? nA : cA + (size_t)(t + 2) * kstep; const char* b2 = last ? nB : cB + (size_t)(t + 2) * kstep;
            const char* a3 = a2 + kstep; const char* b3 = b2 + kstep;
            if constexpr (SP2) {
            PG8_LDB(B0, 0, 0); PG8_LDB(B1, 0, 1); PG8_SCHED; PG8_LDA(At, 0, 0); PG8_STAGE(PG8_SA(1, 1), a1 + hstep, voffA);
            PG8_WAIT_V(8); PG8_WAIT_L(0); PG8_BAR; PG8_MMA(0, 0, At, B0); PG8_MMA(0, 1, At, B1); PG8_BAR; PG8_SCHED;
            PG8_LDA(At, 0, 1); PG8_STAGE(PG8_SB(0, 0), b2, voffB); PG8_STAGE(PG8_SB(0, 1), b2 + hstep, voffB); PG8_STAGE(PG8_SA(0, 0), a2, voffA);
            PG8_WAIT_V(8); PG8_WAIT_L(0); PG8_BAR; PG8_MMA(1, 0, At, B0); PG8_MMA(1, 1, At, B1); PG8_BAR; PG8_SCHED;
            PG8_LDB(B0, 1, 0); PG8_LDB(B1, 1, 1); PG8_SCHED; PG8_LDA(At, 1, 0); PG8_STAGE(PG8_SA(0, 1), a2 + hstep, voffA);
            PG8_WAIT_V(8); PG8_WAIT_L(0); PG8_BAR; PG8_MMA(0, 0, At, B0); PG8_MMA(0, 1, At, B1); PG8_BAR; PG8_SCHED;
            PG8_LDA(At, 1, 1); PG8_STAGE(PG8_SB(1, 0), b3, voffB); PG8_STAGE(PG8_SB(1, 1), b3 + hstep, voffB); PG8_STAGE(PG8_SA(1, 0), a3, voffA);
            PG8_WAIT_V(8); PG8_WAIT_L(0); PG8_BAR; PG8_MMA(1, 0, At, B0); PG8_MMA(1, 1, At, B1); PG8_BAR; PG8_SCHED;
            } else {
            PG8_LDB(B0, 0, 0); PG8_SCHED; PG8_LDA(At, 0, 0); PG8_STAGE(PG8_SA(1, 1), a1 + hstep, voffA);
            PG8_WAIT_L(8); PG8_BAR; PG8_WAIT_L(0); PG8_MMA(0, 0, At, B0); PG8_BAR; PG8_SCHED;
            PG8_LDB(B1, 0, 1); PG8_STAGE(PG8_SB(0, 0), b2, voffB);
            PG8_BAR; PG8_WAIT_L(0); PG8_MMA(0, 1, At, B1); PG8_BAR;
            PG8_LDA(At, 0, 1); PG8_STAGE(PG8_SA(0, 0), a2, voffA);
            PG8_BAR; PG8_WAIT_L(0); PG8_MMA(1, 0, At, B0); PG8_BAR; PG8_SCHED;
            PG8_STAGE(PG8_SB(0, 1), b2 + hstep, voffB);
            PG8_WAIT_V(6); PG8_BAR; PG8_MMA(1, 1, At, B1); PG8_BAR;
            PG8_LDB(B0, 1, 0); PG8_SCHED; PG8_LDA(At, 1, 0); PG8_STAGE(PG8_SA(0, 1), a2 + hstep, voffA);
            PG8_WAIT_L(8); PG8_BAR; PG8_WAIT_L(0); PG8_MMA(0, 0, At, B0); PG8_BAR; PG8_SCHED;
            PG8_LDB(B1, 1, 1); PG8_STAGE(PG8_SB(1, 0), b3, voffB);
            PG8_BAR; PG8_WAIT_L(0); PG8_MMA(0, 1, At, B1); PG8_BAR;
            PG8_LDA(At, 1, 1); PG8_STAGE(PG8_SA(1, 0), a3, voffA);
            PG8_BAR; PG8_WAIT_L(0); PG8_MMA(1, 0, At, B0); PG8_BAR; PG8_SCHED;
            PG8_STAGE(PG8_SB(1, 1), b3 + hstep, voffB);
            PG8_WAIT_V(6); PG8_BAR; PG8_MMA(1, 1, At, B1); PG8_BAR;
            }
        }
        if constexpr (ALIGN_EPI) { if (wr == 0) PG8_BAR; }
        { int fr_ = fr, fq_ = fq; asm volatile("" : "+v"(fr_), "+v"(fq_)); E(acc, cur, wr, wc, fr_, fq_); }
        if (!has_next) break;
#pragma unroll
        for (int a = 0; a < 2; ++a)
#pragma unroll
            for (int b = 0; b < 2; ++b)
#pragma unroll
                for (int m = 0; m < 4; ++m)
#pragma unroll
                    for (int n = 0; n < 2; ++n) acc[a][b][m][n] = (f32x4){0.f, 0.f, 0.f, 0.f};
        cur = nxt; cA = nA; cB = nB; ++ui;
        if constexpr (ALIGN_EPI) { if (wr == 1) PG8_BAR; }
    }
    PG8_WAIT_V(0);
    if constexpr (!ALIGN_EPI) { if (wr == 0) PG8_BAR; }
    PG8_BAR;
#undef PG8_SA
#undef PG8_SB
#undef PG8_STAGE
#undef PG8_LDA
#undef PG8_LDB
#undef PG8_MMA
#undef PG8_WAIT_V
#undef PG8_WAIT_L
#undef PG8_BAR
#undef PG8_SCHED
}
}
using pg8::Unit;
typedef f32x4 AccT[2][2][4][2];

struct EpiQKV {
    static constexpr bool PERM = true;
    unsigned char* ws;
    __device__ __forceinline__ void operator()(const AccT& acc, const Unit& u, int wr, int wc, int fr, int fq) const {
        const int row0 = u.pm * 256 + wr * 64 + fr, kind = u.pn >> 3, colt = (u.pn & 7) * 256 + wc * 32 + 8 * fq;
        bf16_t* Vt = (bf16_t*)(ws + WS_VT);
        if (kind < 2) {
            bf16_t* base = (bf16_t*)(ws + (kind == 0 ? WS_Q : WS_K)); const float sc = kind == 0 ? QSCALE : 1.0f;
#pragma unroll
            for (int ai = 0; ai < 2; ++ai)
#pragma unroll
                for (int m = 0; m < 4; ++m) { bf16_t* rowp = base + (size_t)(row0 + ai * 128 + m * 16) * DM + colt;
#pragma unroll
                    for (int bj = 0; bj < 2; ++bj) { const f32x4 v0 = acc[ai][bj][m][0] * sc, v1 = acc[ai][bj][m][1] * sc;
                        u32x4 w; w.x = pk2(v0[0], v0[1]); w.y = pk2(v0[2], v0[3]); w.z = pk2(v1[0], v1[1]); w.w = pk2(v1[2], v1[3]);
                        *(u32x4*)(rowp + bj * 128) = w; } }
        } else {
#pragma unroll
            for (int ai = 0; ai < 2; ++ai)
#pragma unroll
                for (int m = 0; m < 4; ++m) { const int row = row0 + ai * 128 + m * 16, b = row >> 11, s = row & 2047;
#pragma unroll
                    for (int bj = 0; bj < 2; ++bj) { const int c0 = colt + bj * 128, h = c0 >> 7, d0 = c0 & 127;
                        bf16_t* p = Vt + ((size_t)(b * NH + h) * HD + d0) * SEQ + s;
#pragma unroll
                        for (int n = 0; n < 2; ++n)
#pragma unroll
                            for (int j = 0; j < 4; ++j) p[(size_t)(4 * n + j) * SEQ] = f2bf(acc[ai][bj][m][n][j]); } }
        }
    }
};
struct EpiRes {
    static constexpr bool PERM = true;
    const float* res; float* out; bf16_t* outb; float* part;
    __device__ __forceinline__ void operator()(const AccT& acc, const Unit& u, int wr, int wc, int fr, int fq) const {
        const int row0 = u.pm * 256 + wr * 64 + fr, col0 = u.pn * 256 + wc * 32 + 8 * fq;
#pragma unroll
        for (int ai = 0; ai < 2; ++ai)
#pragma unroll
            for (int m = 0; m < 4; ++m) { const int row = row0 + ai * 128 + m * 16; const size_t off = (size_t)row * DM + col0; float ss = 0.f;
#pragma unroll
                for (int bj = 0; bj < 2; ++bj) {
                    const f32x4 r0 = *(const f32x4*)(res + off + bj * 128), r1 = *(const f32x4*)(res + off + bj * 128 + 4);
                    const f32x4 v0 = acc[ai][bj][m][0] + r0, v1 = acc[ai][bj][m][1] + r1;
                    *(f32x4*)(out + off + bj * 128) = v0; *(f32x4*)(out + off + bj * 128 + 4) = v1;
                    if (outb) { u32x4 w; w.x = pk2(v0[0], v0[1]); w.y = pk2(v0[2], v0[3]); w.z = pk2(v1[0], v1[1]); w.w = pk2(v1[2], v1[3]); *(u32x4*)(outb + off + bj * 128) = w; }
                    ss += (v0[0] * v0[0] + v0[1] * v0[1]) + (v0[2] * v0[2] + v0[3] * v0[3]) + (v1[0] * v1[0] + v1[1] * v1[1]) + (v1[2] * v1[2] + v1[3] * v1[3]); }
                if (part) { ss += __shfl_xor(ss, 16); ss += __shfl_xor(ss, 32); if (fq == 0) part[(size_t)row * 32 + u.pn * 4 + wc] = ss; } }
    }
};
struct EpiUp {
    static constexpr bool PERM = true;
    bf16_t* U; const float* part;
    __device__ __forceinline__ void operator()(const AccT& acc, const Unit& u, int wr, int wc, int fr, int fq) const {
        const int row0 = u.pm * 256 + wr * 64 + fr, col0 = u.pn * 256 + wc * 32 + 8 * fq;
#pragma unroll
        for (int ai = 0; ai < 2; ++ai)
#pragma unroll
            for (int m = 0; m < 4; ++m) { const int row = row0 + ai * 128 + m * 16; const float rs = row_rstd(part, row, fq); bf16_t* rowp = U + (size_t)row * NUP + col0;
#pragma unroll
                for (int bj = 0; bj < 2; ++bj) { const f32x4 v0 = acc[ai][bj][m][0] * rs, v1 = acc[ai][bj][m][1] * rs;
                    u32x4 w; w.x = pk2(v0[0], v0[1]); w.y = pk2(v0[2], v0[3]); w.z = pk2(v1[0], v1[1]); w.w = pk2(v1[2], v1[3]);
                    *(u32x4*)(rowp + bj * 128) = w; } }
    }
};
__device__ __forceinline__ float dpp_ror1(float v) { return __int_as_float(__builtin_amdgcn_update_dpp(0, __float_as_int(v), 0x121, 0xf, 0xf, false)); }
__device__ __forceinline__ float dpp_ror2(float v) { return __int_as_float(__builtin_amdgcn_update_dpp(0, __float_as_int(v), 0x122, 0xf, 0xf, false)); }
struct EpiUpConv {
    static constexpr bool PERM = true;
    bf16_t* ACT; const float* part; const float* cw; const float* cb; LAS float* hal;
    __device__ __forceinline__ void operator()(AccT& acc, const Unit& u, int wr, int wc, int fr, int fq) const {
        const int grow0 = 254 * u.pm - 2 + wr * 64 + fr;
#pragma unroll
        for (int ai = 0; ai < 2; ++ai)
#pragma unroll
            for (int m = 0; m < 4; ++m) { const int grow = grow0 + ai * 128 + m * 16; const int rowc = grow < 0 ? 0 : (grow >= MTOK ? MTOK - 1 : grow);
                const float rs = row_rstd(part, rowc, fq);
#pragma unroll
                for (int bj = 0; bj < 2; ++bj) { acc[ai][bj][m][0] *= rs; acc[ai][bj][m][1] *= rs; } }
        const int colw = wc * 32 + 8 * fq;
        if (fr >= 14) {
#pragma unroll
            for (int ai = 0; ai < 2; ++ai)
#pragma unroll
                for (int bj = 0; bj < 2; ++bj)
#pragma unroll
                    for (int n = 0; n < 2; ++n) *(LAS f32x4*)(hal + ((ai * 2 + wr) * 2 + (fr - 14)) * 256 + bj * 128 + colw + 4 * n) = acc[ai][bj][3][n];
        }
        asm volatile("s_waitcnt lgkmcnt(0)" ::: "memory"); __builtin_amdgcn_s_barrier(); asm volatile("" ::: "memory");
#pragma unroll
        for (int n = 0; n < 2; ++n) {
            const int ch = u.pn * 128 + colw + 4 * n;
            f32x4 w[2][3], bb[2];
#pragma unroll
            for (int bj = 0; bj < 2; ++bj) { bb[bj] = *(const f32x4*)(cb + bj * FF + ch);
#pragma unroll
                for (int t = 0; t < 3; ++t) w[bj][t] = *(const f32x4*)(cw + (size_t)t * NUP + bj * FF + ch); }
#pragma unroll
            for (int ai = 0; ai < 2; ++ai)
#pragma unroll
                for (int m = 0; m < 4; ++m) {
                    const int lrow = ai * 128 + wr * 64 + m * 16 + fr, grow = 254 * u.pm - 2 + lrow, pos = grow & 2047;
                    f32x4 cv[2];
#pragma unroll
                    for (int bj = 0; bj < 2; ++bj) {
                        const f32x4 cur = acc[ai][bj][m][n];
                        f32x4 q1, q2;
                        if (m > 0) { const f32x4 pv = acc[ai][bj][m - 1][n];
#pragma unroll
                            for (int e = 0; e < 4; ++e) { q1[e] = dpp_ror1(pv[e]); q2[e] = dpp_ror2(pv[e]); } }
                        else { const int slab = ai * 2 + wr - 1; f32x4 h1 = (f32x4){0.f, 0.f, 0.f, 0.f}, h2 = h1;
                            if (slab >= 0) { h1 = *(const LAS f32x4*)(hal + (slab * 2 + 1) * 256 + bj * 128 + colw + 4 * n); h2 = *(const LAS f32x4*)(hal + (slab * 2) * 256 + bj * 128 + colw + 4 * n); }
                            q1 = h1; q2 = (fr == 1) ? h1 : h2; }
                        f32x4 c = bb[bj];
#pragma unroll
                        for (int e = 0; e < 4; ++e) { const float r1 = dpp_ror1(cur[e]), r2 = dpp_ror2(cur[e]);
                            const float p1 = fr >= 1 ? r1 : q1[e], p2 = fr >= 2 ? r2 : q2[e];
                            float v = c[e] + w[bj][2][e] * cur[e];
                            if (pos >= 1) v += w[bj][1][e] * p1;
                            if (pos >= 2) v += w[bj][0][e] * p2;
                            c[e] = v; }
                        cv[bj] = c;
                    }
                    float a4[4];
#pragma unroll
                    for (int e = 0; e < 4; ++e) { const float gx = cv[0][e]; a4[e] = gx * __builtin_amdgcn_rcpf(1.0f + __expf(-gx)) * cv[1][e]; }
                    if (lrow >= 2 && grow < MTOK) { u32x2 o; o.x = pk2(a4[0], a4[1]); o.y = pk2(a4[2], a4[3]); *(u32x2*)(ACT + (size_t)grow * FF + ch) = o; }
                }
        }
    }
};
struct EpiDsaIn {
    static constexpr bool PERM = false;
    unsigned char* ws; LAS float* scr;
    __device__ __forceinline__ void operator()(const AccT& acc_in, const Unit& u, int wr, int wc, int fr, int fq) const {
        const int row0 = u.pm * 256 + wr * 64 + fr;
        const float* part = (const float*)(ws + WS_PART); const float* ropeC = (const float*)(ws + WS_ROPE); const float* ropeS = ropeC + SEQ * 64;
        bf16_t* VTD = (bf16_t*)(ws + WS_VTD); float* WI = (float*)(ws + WS_WI);
        const bool need_norm = (u.pn < 10) || (u.pn == 20);
        float rs[2][4];
#pragma unroll
        for (int ai = 0; ai < 2; ++ai)
#pragma unroll
            for (int m = 0; m < 4; ++m) rs[ai][m] = row_rstd(part, row0 + ai * 128 + m * 16, fq);
        if (need_norm) {
#pragma unroll
            for (int ai = 0; ai < 2; ++ai)
#pragma unroll
                for (int m = 0; m < 4; ++m)
#pragma unroll
                    for (int bj = 0; bj < 2; ++bj) { const f32x4 a = acc_in[ai][bj][m][0], b = acc_in[ai][bj][m][1];
                        float ss = ((a[0] * a[0] + a[1] * a[1]) + (a[2] * a[2] + a[3] * a[3])) + ((b[0] * b[0] + b[1] * b[1]) + (b[2] * b[2] + b[3] * b[3]));
                        ss += __shfl_xor(ss, 16); ss += __shfl_xor(ss, 32);
                        if (fq == 0) scr[(ai * 128 + wr * 64 + m * 16 + fr) * 8 + bj * 4 + wc] = ss * rs[ai][m] * rs[ai][m]; }
            asm volatile("s_waitcnt lgkmcnt(0)" ::: "memory"); __builtin_amdgcn_s_barrier(); asm volatile("" ::: "memory");
        }
        const int dl = 16 * wc + 4 * fq;
#pragma unroll
        for (int bj = 0; bj < 2; ++bj) {
            const int hh = 2 * u.pn + bj;
            if (hh >= 20 && hh < 24) {
#pragma unroll
                for (int ai = 0; ai < 2; ++ai)
#pragma unroll
                    for (int m = 0; m < 4; ++m) { const int row = row0 + ai * 128 + m * 16, b = row >> 11, s = row & 2047; const float r = rs[ai][m];
                        bf16_t* p = VTD + ((size_t)(b * KVH + (hh - 20)) * HD + dl) * SEQ + s;
#pragma unroll
                        for (int n = 0; n < 2; ++n)
#pragma unroll
                            for (int e = 0; e < 4; ++e) p[(size_t)(64 * n + e) * SEQ] = f2bf(acc_in[ai][bj][m][n][e] * r); }
            } else if (hh == 41) {
                if (wc == 0) {
#pragma unroll
                    for (int ai = 0; ai < 2; ++ai)
#pragma unroll
                        for (int m = 0; m < 4; ++m) { const int row = row0 + ai * 128 + m * 16; *(f32x4*)(WI + (size_t)row * 16 + 4 * fq) = acc_in[ai][bj][m][0] * rs[ai][m]; } }
            } else {
                const bool norm = (hh < 20) || (hh == 40);
                const float* g = (const float*)(ws + WS_GAIN) + (hh < 16 ? 0 : (hh < 20 ? 128 : 256));
                f32x4 g0 = (f32x4){1.f, 1.f, 1.f, 1.f}, g1 = g0;
                if (norm) { g0 = *(const f32x4*)(g + dl); g1 = *(const f32x4*)(g + dl + 64); }
                size_t boff; int ld, cb;
                if (hh < 16) { boff = WS_Q; ld = DM; cb = hh * HD; } else if (hh < 20) { boff = WS_KD; ld = KVH * HD; cb = (hh - 16) * HD; }
                else if (hh < 40) { boff = WS_QI; ld = DM; cb = (hh - 24) * HD; } else { boff = WS_KI; ld = HD; cb = 0; }
                bf16_t* base = (bf16_t*)(ws + boff);
                const float osc = hh < 16 ? QSCALE : 1.0f;
#pragma unroll
                for (int ai = 0; ai < 2; ++ai)
#pragma unroll
                    for (int m = 0; m < 4; ++m) { const int lrow = ai * 128 + wr * 64 + m * 16 + fr, row = u.pm * 256 + lrow, pos = row & 2047;
                        float sc = rs[ai][m];
                        if (norm) { const f32x4 t = *(const LAS f32x4*)(scr + lrow * 8 + bj * 4); sc *= 1.0f / sqrtf(((t[0] + t[1]) + (t[2] + t[3])) * (1.0f / HD) + NORM_EPS); }
                        sc *= osc;
                        const f32x4 c = *(const f32x4*)(ropeC + pos * 64 + dl), sn = *(const f32x4*)(ropeS + pos * 64 + dl);
                        const f32x4 y0 = acc_in[ai][bj][m][0] * g0 * sc, y1 = acc_in[ai][bj][m][1] * g1 * sc;
                        const f32x4 o0 = y0 * c - y1 * sn, o1 = y1 * c + y0 * sn;
                        bf16_t* rp = base + (size_t)row * ld + cb + dl;
                        u32x2 w0, w1; w0.x = pk2(o0[0], o0[1]); w0.y = pk2(o0[2], o0[3]); w1.x = pk2(o1[0], o1[1]); w1.y = pk2(o1[2], o1[3]);
                        *(u32x2*)rp = w0; *(u32x2*)(rp + 64) = w1; }
            }
        }
    }
};

enum { WM_PLAIN = 0, WM_UP = 1, WM_IN = 2 };
__device__ __forceinline__ int colmap(int kind, int np) {
    if (kind == WM_UP) { const int pn = np >> 8, bj = (np >> 7) & 1, q = np & 127; return bj * FF + 128 * pn + q; }
    if (kind == WM_IN) { const int hh = np >> 7, p = np & 127, d = 16 * (p >> 5) + (p & 15) + 64 * ((p >> 4) & 1);
        if (hh < 41) return hh * 128 + d; return (p < 16) ? (5248 + p) : -1; }
    return np;
}
struct WJ { const float* W; const float* gain; bf16_t* WT; int K, N, NP, kind, local; };
__device__ __forceinline__ void tr_load(const WJ& j, int lane, f32x4 (&v)[16]) {
    const int nblk = j.NP / 64, kb = j.local / nblk, nb = j.local - kb * nblk, k0 = 64 * kb, n0 = 64 * nb;
    const int src = colmap(j.kind, n0 + 4 * (lane & 15)), rg = lane >> 4;
    const float* p = j.W + (size_t)(k0 + rg) * j.N + (src >= 0 ? src : 0);
#pragma unroll
    for (int i = 0; i < 16; ++i) { v[i] = *(const f32x4*)(p + (size_t)(4 * i) * j.N); if (src < 0) v[i] = (f32x4){0.f, 0.f, 0.f, 0.f}; }
}
__device__ __forceinline__ void tr_process(const WJ& j, int lane, const f32x4 (&v)[16], LAS float* scr) {
    const int nblk = j.NP / 64, kb = j.local / nblk, nb = j.local - kb * nblk, k0 = 64 * kb, n0 = 64 * nb;
    const int rg = lane >> 4, cg = lane & 15;
    float gl = 1.0f; if (j.gain) gl = j.gain[k0 + lane];
#pragma unroll
    for (int i = 0; i < 16; ++i) { const int kk = 4 * i + rg; const float g = __shfl(gl, kk); LAS float* d = scr + kk * 65 + 4 * cg;
        d[0] = v[i][0] * g; d[1] = v[i][1] * g; d[2] = v[i][2] * g; d[3] = v[i][3] * g; }
    asm volatile("s_waitcnt lgkmcnt(0)" ::: "memory");
    const int c = lane & 7;
#pragma unroll
    for (int jj = 0; jj < 8; ++jj) { const int n = (lane >> 3) + 8 * jj; const LAS float* s = scr + (8 * c) * 65 + n;
        u32x4 o; o.x = pk2(s[0 * 65], s[1 * 65]); o.y = pk2(s[2 * 65], s[3 * 65]); o.z = pk2(s[4 * 65], s[5 * 65]); o.w = pk2(s[6 * 65], s[7 * 65]);
        *(u32x4*)(j.WT + (size_t)(n0 + n) * j.K + k0 + 8 * c) = o; }
    asm volatile("s_waitcnt lgkmcnt(0)" ::: "memory");
}

struct Args {
    const float* x; const float* attn_g; const float* ffn_g; const float* w_qkv; const float* w_o0; const float* w_in;
    const float* qn_g; const float* kn_g; const float* ikn_g; const float* w_o1; const float* w_up; const float* conv_w; const float* conv_b; const float* w_down;
    float* out; unsigned char* ws; int ph_lo, ph_hi;
};

constexpr int WI0 = 32 * 96, WI1 = WI0 + 32 * 32, WI2 = WI1 + 32 * 84, WI3 = WI2 + 32 * 32, WI4 = WI3 + 32 * 176, WI5 = WI4 + 32 * 176, WI6 = WI5 + 88 * 32, WI7 = WI6 + 88 * 32;
__device__ __forceinline__ WJ wj_decode(const Args& a, int it) {
    unsigned char* ws = a.ws; WJ j;
    if (it < WI0)      j = WJ{a.w_qkv, nullptr, (bf16_t*)(ws + WS_WQKV), DM, NQKV, NQKV, WM_PLAIN, it};
    else if (it < WI1) j = WJ{a.w_o0, nullptr, (bf16_t*)(ws + WS_WO0), DM, DM, DM, WM_PLAIN, it - WI0};
    else if (it < WI2) j = WJ{a.w_in, a.attn_g + DM, (bf16_t*)(ws + WS_WIN), DM, NIN, NINP, WM_IN, it - WI1};
    else if (it < WI3) j = WJ{a.w_o1, nullptr, (bf16_t*)(ws + WS_WO1), DM, DM, DM, WM_PLAIN, it - WI2};
    else if (it < WI4) j = WJ{a.w_up, a.ffn_g, (bf16_t*)(ws + WS_WUP), DM, NUP, NUP, WM_UP, it - WI3};
    else if (it < WI5) j = WJ{a.w_up + (size_t)DM * NUP, a.ffn_g + DM, (bf16_t*)(ws + WS_WUP + 44 * MiB), DM, NUP, NUP, WM_UP, it - WI4};
    else if (it < WI6) j = WJ{a.w_down, nullptr, (bf16_t*)(ws + WS_WDN), FF, DM, DM, WM_PLAIN, it - WI5};
    else               j = WJ{a.w_down + (size_t)FF * DM, nullptr, (bf16_t*)(ws + WS_WDN + 22 * MiB), FF, DM, DM, WM_PLAIN, it - WI6};
    return j;
}
__device__ __forceinline__ void prologue_phase(const Args& a, LAS unsigned char* lds, int gw, int ngw, int wave, int lane) {
    unsigned char* ws = a.ws;
    LAS float* scr = (LAS float*)(lds + wave * 16640);
    {
        int it = gw;
        if (it < WI7) {
            f32x4 va[16], vb[16];
            WJ ja = wj_decode(a, it), jb = ja;
            tr_load(ja, lane, va);
            for (;;) {
                int nx = it + ngw; bool hn = nx < WI7;
                if (hn) { jb = wj_decode(a, nx); tr_load(jb, lane, vb); }
                tr_process(ja, lane, va, scr);
                if (!hn) break;
                it = nx; nx = it + ngw; hn = nx < WI7;
                if (hn) { ja = wj_decode(a, nx); tr_load(ja, lane, va); }
                tr_process(jb, lane, vb, scr);
                if (!hn) break;
                it = nx;
            }
        }
    }
    bf16_t* XB = (bf16_t*)(ws + WS_XB);
    for (int m = gw; m < MTOK; m += ngw) {
        const f32x4* xr = (const f32x4*)(a.x + (size_t)m * DM) + lane;
        f32x4 v[8]; float s = 0.f;
#pragma unroll
        for (int j = 0; j < 8; ++j) { v[j] = xr[64 * j]; s += (v[j].x * v[j].x + v[j].y * v[j].y) + (v[j].z * v[j].z + v[j].w * v[j].w); }
        const float rstd = 1.0f / sqrtf(wave_sum(s) * (1.0f / DM) + NORM_EPS);
        u32x2* o8 = (u32x2*)(XB + (size_t)m * DM) + lane;
#pragma unroll
        for (int j = 0; j < 8; ++j) { const f32x4 g = ((const f32x4*)a.attn_g)[lane + 64 * j]; u32x2 w; w.x = pk2(v[j].x * rstd * g.x, v[j].y * rstd * g.y); w.y = pk2(v[j].z * rstd * g.z, v[j].w * rstd * g.w); o8[64 * j] = w; }
    }
    if (gw == 0) { float* gn = (float*)(ws + WS_GAIN); for (int i = lane; i < 128; i += 64) { gn[i] = a.qn_g[i]; gn[128 + i] = a.kn_g[i]; gn[256 + i] = a.ikn_g[i]; } }
    float* rc = (float*)(ws + WS_ROPE); float* rsn = rc + SEQ * 64;
    for (int i = gw * 64 + lane; i < SEQ * 64; i += ngw * 64) {
        const int pos = i >> 6, fi = i & 63;
        const float inv_freq = (float)(1.0 / exp2((double)fi * (2.0 / 128.0) * 13.287712379549449));
        const float ang = (float)pos * inv_freq;
        const double x = (double)ang; const double kq = rint(x * 0.63661977236758134308);
        double r = __builtin_fma(-kq, 1.57079632679489655800e+00, x); r = __builtin_fma(-kq, 6.12323399573676603587e-17, r);
        const double r2 = r * r;
        double sp = -1.0 / 6227020800.0; sp = sp * r2 + 1.0 / 39916800.0; sp = sp * r2 - 1.0 / 362880.0; sp = sp * r2 + 1.0 / 5040.0; sp = sp * r2 - 1.0 / 120.0; sp = sp * r2 + 1.0 / 6.0; const double sv = r - r * r2 * sp;
        double cp = 1.0 / 87178291200.0; cp = cp * r2 - 1.0 / 479001600.0; cp = cp * r2 + 1.0 / 3628800.0; cp = cp * r2 - 1.0 / 40320.0; cp = cp * r2 + 1.0 / 720.0; cp = cp * r2 - 1.0 / 24.0; cp = cp * r2 + 0.5; const double cv = 1.0 - r2 * cp;
        const int q = ((int)kq) & 3;
        const double cs = (q == 0) ? cv : (q == 1) ? -sv : (q == 2) ? -cv : sv;
        const double sn = (q == 0) ? sv : (q == 1) ? cv : (q == 2) ? -sv : -cv;
        rc[i] = (float)cs; rsn[i] = (float)sn;
    }
}

constexpr float SB_EXIT = 220.0f;
__device__ __forceinline__ void sb_attn_phase(const bf16_t* __restrict__ Q, const bf16_t* __restrict__ K, const bf16_t* __restrict__ Vt, bf16_t* __restrict__ O, int gw, int ngw, int lane) {
    const int r = lane & 31, hh = lane >> 5;
    bf16x8 uf[2];
#pragma unroll
    for (int s2 = 0; s2 < 2; ++s2) { u32x4 w;
        unsigned e[8];
#pragma unroll
        for (int j = 0; j < 8; ++j) { const int key = 16 * s2 + 8 * (j >> 2) + 4 * hh + (j & 3); e[j] = (key >= r) ? 0x3f80u : 0u; }
        w.x = e[0] | (e[1] << 16); w.y = e[2] | (e[3] << 16); w.z = e[4] | (e[5] << 16); w.w = e[6] | (e[7] << 16); uf[s2] = __builtin_bit_cast(bf16x8, w); }
    for (int unit = gw; unit < BATCH * NH * 64; unit += ngw) {
        const int bh = unit >> 6, qt = 63 - (unit & 63), b = bh >> 4, h = bh & 15, q0 = qt * 32;
        const bf16_t* qp = Q + (size_t)(b * SEQ + q0 + r) * DM + h * HD + 8 * hh;
        bf16x8 qf[8];
#pragma unroll
        for (int s = 0; s < 8; ++s) qf[s] = *(const bf16x8*)(qp + 16 * s);
        f32x16 o[4];
#pragma unroll
        for (int d = 0; d < 4; ++d) o[d] = f32x16{};
        float carry = 0.f;
        const bf16_t* kbase = K + (size_t)(b * SEQ + r) * DM + h * HD + 8 * hh;
        const bf16_t* vbase = Vt + ((size_t)bh * HD + r) * SEQ + 4 * hh;
        for (int kt = qt; kt >= 0; --kt) {
            const int key0 = kt * 32;
            const bf16_t* kp = kbase + (size_t)key0 * DM;
            bf16x8 kf[8];
#pragma unroll
            for (int s = 0; s < 8; ++s) kf[s] = *(const bf16x8*)(kp + 16 * s);
            bf16x8 vf[4][2];
#pragma unroll
            for (int d = 0; d < 4; ++d)
#pragma unroll
                for (int s2 = 0; s2 < 2; ++s2) { const bf16_t* vp = vbase + (size_t)(32 * d) * SEQ + key0 + 16 * s2;
                    const s16x4 lo = *(const s16x4*)vp, hi = *(const s16x4*)(vp + 8);
                    vf[d][s2] = (bf16x8){lo[0], lo[1], lo[2], lo[3], hi[0], hi[1], hi[2], hi[3]}; }
            f32x16 p = f32x16{};
#pragma unroll
            for (int s = 0; s < 8; ++s) p = __builtin_amdgcn_mfma_f32_32x32x16_bf16(kf[s], qf[s], p, 0, 0, 0);
            const bool diag = (kt == qt);
            f32x16 sp;
#pragma unroll
            for (int i = 0; i < 16; ++i) { const float z = p[i]; float v = fmaxf(z, 0.f) + __builtin_amdgcn_logf(1.0f + __builtin_amdgcn_exp2f(-fabsf(z)));
                if (diag && crow(i, hh) >= r) v = 0.f; sp[i] = v; }
            f32x16 c;
#pragma unroll
            for (int i = 0; i < 16; ++i) c[i] = carry;
            c = __builtin_amdgcn_mfma_f32_32x32x16_bf16(uf[0], pack8(sp, 0), c, 0, 0, 0);
            c = __builtin_amdgcn_mfma_f32_32x32x16_bf16(uf[1], pack8(sp, 8), c, 0, 0, 0);
            f32x16 av;
#pragma unroll
            for (int i = 0; i < 16; ++i) { float v = __builtin_amdgcn_exp2f(p[i] - c[i]); if (diag && crow(i, hh) >= r) v = 0.f; av[i] = v; }
            carry = swap_max(c[0]);
            const bf16x8 pa0 = pack8(av, 0), pa1 = pack8(av, 8);
#pragma unroll
            for (int d = 0; d < 4; ++d) { o[d] = __builtin_amdgcn_mfma_f32_32x32x16_bf16(vf[d][0], pa0, o[d], 0, 0, 0); o[d] = __builtin_amdgcn_mfma_f32_32x32x16_bf16(vf[d][1], pa1, o[d], 0, 0, 0); }
            if (__all(carry > SB_EXIT)) break;
        }
        bf16_t* op = O + (size_t)(b * SEQ + q0 + r) * DM + h * HD + 4 * hh;
#pragma unroll
        for (int d = 0; d < 4; ++d)
#pragma unroll
            for (int g = 0; g < 4; ++g) { u32x2 w; w.x = pk2(o[d][4 * g], o[d][4 * g + 1]); w.y = pk2(o[d][4 * g + 2], o[d][4 * g + 3]); *(u32x2*)(op + 32 * d + 8 * g) = w; }
    }
}

__device__ __forceinline__ void conv_phase(const bf16_t* __restrict__ U, const float* __restrict__ cw, const float* __restrict__ cb, bf16_t* __restrict__ ACT, int gtid, int nthreads) {
    constexpr int C8 = FF / 8;
    for (int it = gtid; it < MTOK * C8; it += nthreads) {
        const int row = it / C8, c8 = it - row * C8, j0 = c8 * 8, pn = j0 >> 7, q = j0 & 127, s = row & 2047;
        const bf16_t* ug = U + (size_t)row * NUP + 256 * pn + q;
        float cgv[2][8];
#pragma unroll
        for (int half = 0; half < 2; ++half) {
            const bf16_t* up = ug + half * 128; const int cc = half * FF + j0;
            const f32x4 b0 = *(const f32x4*)(cb + cc), b1 = *(const f32x4*)(cb + cc + 4);
            float accv[8] = {b0[0], b0[1], b0[2], b0[3], b1[0], b1[1], b1[2], b1[3]};
#pragma unroll
            for (int tap = 0; tap < 3; ++tap) { const int back = 2 - tap;
                if (s >= back) { const u32x4 w = *(const u32x4*)(up - (size_t)back * NUP);
                    const f32x4 w0 = *(const f32x4*)(cw + (size_t)tap * NUP + cc), w1 = *(const f32x4*)(cw + (size_t)tap * NUP + cc + 4);
                    accv[0] += __uint_as_float(w.x << 16) * w0[0]; accv[1] += __uint_as_float(w.x & 0xffff0000u) * w0[1];
                    accv[2] += __uint_as_float(w.y << 16) * w0[2]; accv[3] += __uint_as_float(w.y & 0xffff0000u) * w0[3];
                    accv[4] += __uint_as_float(w.z << 16) * w1[0]; accv[5] += __uint_as_float(w.z & 0xffff0000u) * w1[1];
                    accv[6] += __uint_as_float(w.w << 16) * w1[2]; accv[7] += __uint_as_float(w.w & 0xffff0000u) * w1[3]; } }
#pragma unroll
            for (int e = 0; e < 8; ++e) cgv[half][e] = accv[e];
        }
        float a8[8];
#pragma unroll
        for (int e = 0; e < 8; ++e) { const float gx = cgv[0][e]; a8[e] = gx / (1.0f + __expf(-gx)) * cgv[1][e]; }
        u32x4 w; w.x = pk2(a8[0], a8[1]); w.y = pk2(a8[2], a8[3]); w.z = pk2(a8[4], a8[5]); w.w = pk2(a8[6], a8[7]);
        *(u32x4*)(ACT + (size_t)row * FF + j0) = w;
    }
}

__device__ __forceinline__ unsigned fmap(float f) { const unsigned u = __float_as_uint(f); return (u & 0x80000000u) ? ~u : (u | 0x80000000u); }
__device__ __forceinline__ void indexer_unit(const bf16_t* __restrict__ QI, const bf16_t* __restrict__ KI, const float* __restrict__ WI, unsigned* __restrict__ MASK, LAS float* sc, int b, int t0, int wave, int lane) {
    const int r = lane & 31, hh = lane >> 5, ql_r = r >> 4, head_r = r & 15;
    const int tw = t0 + 2 * wave;
    const bf16_t* ap = QI + (size_t)(b * SEQ + tw + ql_r) * DM + head_r * HD + 8 * hh;
    bf16x8 af[8];
#pragma unroll
    for (int s = 0; s < 8; ++s) af[s] = *(const bf16x8*)(ap + 16 * s);
    float wv[16];
#pragma unroll
    for (int i = 0; i < 16; ++i) { const int rw = crow(i, hh); wv[i] = WI[(size_t)(b * SEQ + tw + (rw >> 4)) * 16 + (rw & 15)]; }
    const int nkt = (t0 + 16 + 31) >> 5;
    const bf16_t* kb = KI + (size_t)(b * SEQ + r) * HD + 8 * hh;
    LAS float* myrow = sc + (2 * wave + hh) * SEQ;
    const int tq = tw + hh;
    for (int kt = 0; kt < nkt; ++kt) {
        const bf16_t* kp = kb + (size_t)kt * 32 * HD;
        bf16x8 bfr[8];
#pragma unroll
        for (int s = 0; s < 8; ++s) bfr[s] = *(const bf16x8*)(kp + 16 * s);
        f32x16 c = f32x16{};
#pragma unroll
        for (int s = 0; s < 8; ++s) c = __builtin_amdgcn_mfma_f32_32x32x16_bf16(af[s], bfr[s], c, 0, 0, 0);
        float s0 = 0.f, s1 = 0.f;
#pragma unroll
        for (int i = 0; i < 8; ++i) { s0 += wv[i] * fmaxf(c[i], 0.f); s1 += wv[i + 8] * fmaxf(c[i + 8], 0.f); }
        const float t0s = swap_sum(s0), t1s = swap_sum(s1);
        const int key = kt * 32 + r;
        float v = (hh ? t1s : t0s) + 0.0f;
        if (key > tq) v = -INFINITY;
        myrow[key] = v;
    }
    asm volatile("s_waitcnt lgkmcnt(0)" ::: "memory");
    for (int ql = 0; ql < 2; ++ql) {
        const int t = tw + ql, n = t + 1;
        unsigned* mrow = MASK + (size_t)(b * SEQ + t) * 64;
        if (n <= TOPK) {
            const int key0 = 32 * lane; unsigned w;
            if (key0 + 31 <= t) w = 0xffffffffu; else if (key0 > t) w = 0u; else w = (1u << (t - key0 + 1)) - 1u;
            mrow[lane] = w;
        } else {
            const LAS float* row = sc + (2 * wave + ql) * SEQ;
            unsigned uv[32];
#pragma unroll
            for (int e = 0; e < 32; ++e) { const int key = e * 64 + lane; uv[e] = (key < n) ? fmap(row[key]) : 0x007fffffu; }
            unsigned prefix = 0u;
            for (int bit = 31; bit >= 0; --bit) {
                const unsigned cand = prefix | (1u << bit); int cnt = 0;
#pragma unroll
                for (int e = 0; e < 32; ++e) cnt += __popcll(__ballot(uv[e] >= cand));
                if (cnt >= TOPK) prefix = cand;
            }
            int cgt = 0;
#pragma unroll
            for (int e = 0; e < 32; ++e) cgt += __popcll(__ballot(uv[e] > prefix));
            const int need = TOPK - cgt; int running = 0;
            const unsigned long long ltm = (1ull << lane) - 1ull;
            unsigned long long keep = 0ull;
#pragma unroll
            for (int e = 0; e < 32; ++e) {
                const unsigned long long eq = __ballot(uv[e] == prefix);
                const bool sel = (uv[e] > prefix) || (uv[e] == prefix && (running + __popcll(eq & ltm)) < need);
                const unsigned long long m64 = __ballot(sel);
                running += __popcll(eq);
                if (lane == e) keep = m64;
            }
            if (lane < 32) *(unsigned long long*)(mrow + 2 * lane) = keep;
        }
    }
    asm volatile("s_waitcnt lgkmcnt(0)" ::: "memory");
}

__device__ __forceinline__ void dsa_attn_unit(const bf16_t* __restrict__ QD, const bf16_t* __restrict__ KD, const bf16_t* __restrict__ VTD, const unsigned* __restrict__ MASK, bf16_t* __restrict__ O,
                                              int b, int g, int h, int q0, int lane) {
    const int r = lane & 31, hh = lane >> 5;
    const bf16_t* qp = QD + (size_t)(b * SEQ + q0 + r) * DM + h * HD + 8 * hh;
    bf16x8 qf[8];
#pragma unroll
    for (int s = 0; s < 8; ++s) qf[s] = *(const bf16x8*)(qp + 16 * s);
    f32x16 o[4];
#pragma unroll
    for (int d = 0; d < 4; ++d) o[d] = f32x16{};
    float mrun = -1e30f, lrun = 0.f;
    const bf16_t* kbase = KD + (size_t)(b * SEQ + r) * (KVH * HD) + g * HD + 8 * hh;
    const bf16_t* vbase = VTD + ((size_t)(b * KVH + g) * HD + r) * SEQ + 4 * hh;
    const unsigned* mrow = MASK + (size_t)(b * SEQ + q0 + r) * 64;
    const int nkt = (q0 + 32) >> 5;
    for (int kt = 0; kt < nkt; ++kt) {
        const int key0 = kt * 32;
        const bf16_t* kp = kbase + (size_t)key0 * (KVH * HD);
        bf16x8 kf[8];
#pragma unroll
        for (int s = 0; s < 8; ++s) kf[s] = *(const bf16x8*)(kp + 16 * s);
        const unsigned mw = mrow[kt];
        bf16x8 vf[4][2];
#pragma unroll
        for (int d = 0; d < 4; ++d)
#pragma unroll
            for (int s2 = 0; s2 < 2; ++s2) { const bf16_t* vp = vbase + (size_t)(32 * d) * SEQ + key0 + 16 * s2;
                const s16x4 lo = *(const s16x4*)vp, hi = *(const s16x4*)(vp + 8);
                vf[d][s2] = (bf16x8){lo[0], lo[1], lo[2], lo[3], hi[0], hi[1], hi[2], hi[3]}; }
        f32x16 p = f32x16{};
#pragma unroll
        for (int s = 0; s < 8; ++s) p = __builtin_amdgcn_mfma_f32_32x32x16_bf16(kf[s], qf[s], p, 0, 0, 0);
        float tmax = -1e30f;
#pragma unroll
        for (int i = 0; i < 16; ++i) { const bool valid = (mw >> crow(i, hh)) & 1u; tmax = fmaxf(tmax, valid ? p[i] : -1e30f); }
        tmax = swap_max(tmax);
        const float mnew = fmaxf(mrun, tmax), alpha = __builtin_amdgcn_exp2f(mrun - mnew);
        float ls = 0.f; f32x16 pe;
#pragma unroll
        for (int i = 0; i < 16; ++i) { const bool valid = (mw >> crow(i, hh)) & 1u; const float e = valid ? __builtin_amdgcn_exp2f(p[i] - mnew) : 0.f; pe[i] = e; ls += e; }
        lrun = lrun * alpha + ls; mrun = mnew;
#pragma unroll
        for (int d = 0; d < 4; ++d)
#pragma unroll
            for (int i = 0; i < 16; ++i) o[d][i] *= alpha;
        const bf16x8 pa0 = pack8(pe, 0), pa1 = pack8(pe, 8);
#pragma unroll
        for (int d = 0; d < 4; ++d) { o[d] = __builtin_amdgcn_mfma_f32_32x32x16_bf16(vf[d][0], pa0, o[d], 0, 0, 0); o[d] = __builtin_amdgcn_mfma_f32_32x32x16_bf16(vf[d][1], pa1, o[d], 0, 0, 0); }
    }
    const float linv = 1.0f / swap_sum(lrun);
    bf16_t* op = O + (size_t)(b * SEQ + q0 + r) * DM + h * HD + 4 * hh;
#pragma unroll
    for (int d = 0; d < 4; ++d)
#pragma unroll
        for (int gq = 0; gq < 4; ++gq) { u32x2 w; w.x = pk2(o[d][4 * gq] * linv, o[d][4 * gq + 1] * linv); w.y = pk2(o[d][4 * gq + 2] * linv, o[d][4 * gq + 3] * linv); *(u32x2*)(op + 32 * d + 8 * gq) = w; }
}


constexpr int KSTR = 272, VSTR = 136, KTILE_B = 64 * KSTR, VTILE_B = 128 * VSTR, KVBUF_B = KTILE_B + VTILE_B;
struct KVStage {
    u32x4 k[2], v[2];
    __device__ __forceinline__ void load(const unsigned char* kg, size_t kstride, const unsigned char* vg, size_t vstride, int tid) {
#pragma unroll
        for (int i = 0; i < 2; ++i) { const int c = tid + 512 * i; k[i] = *(const u32x4*)(kg + (size_t)(c >> 4) * kstride + (c & 15) * 16); v[i] = *(const u32x4*)(vg + (size_t)(c >> 3) * vstride + (c & 7) * 16); }
    }
    __device__ __forceinline__ void store(LAS unsigned char* buf, int tid) const {
#pragma unroll
        for (int i = 0; i < 2; ++i) { const int c = tid + 512 * i;
            *(LAS u32x4*)(buf + (c >> 4) * KSTR + (c & 15) * 16) = k[i];
            LAS unsigned char* vp = buf + KTILE_B + (c >> 3) * VSTR + (c & 7) * 16;
            *(LAS u32x2*)vp = (u32x2){v[i].x, v[i].y}; *(LAS u32x2*)(vp + 8) = (u32x2){v[i].z, v[i].w}; }
    }
};

__device__ __forceinline__ void dsa_attn_block(const bf16_t* __restrict__ QD, const bf16_t* __restrict__ KD, const bf16_t* __restrict__ VTD, const unsigned* __restrict__ MASK, bf16_t* __restrict__ O,
                                               LAS unsigned char* lds, int b, int g, int qb64, int wave, int lane, int tid) {
    const int r = lane & 31, hh = lane >> 5, h = 4 * g + (wave & 3), q0 = 64 * qb64 + 32 * (wave >> 2);
    const bf16_t* qp = QD + (size_t)(b * SEQ + q0 + r) * DM + h * HD + 8 * hh;
    bf16x8 qf[8];
#pragma unroll
    for (int s = 0; s < 8; ++s) qf[s] = *(const bf16x8*)(qp + 16 * s);
    f32x16 o[4];
#pragma unroll
    for (int d = 0; d < 4; ++d) o[d] = f32x16{};
    float mrun = -1e30f, lrun = 0.f;
    const unsigned char* kg = (const unsigned char*)(KD + (size_t)(b * SEQ) * (KVH * HD) + g * HD);
    const unsigned char* vg = (const unsigned char*)(VTD + (size_t)(b * KVH + g) * HD * SEQ);
    const unsigned long long* mrow = (const unsigned long long*)(MASK + (size_t)(b * SEQ + q0 + r) * 64);
    KVStage st;
    st.load(kg, KVH * HD * 2, vg, SEQ * 2, tid);
    st.store(lds, tid);
    asm volatile("s_waitcnt lgkmcnt(0)" ::: "memory"); __builtin_amdgcn_s_barrier(); asm volatile("" ::: "memory");
    for (int kt = 0; kt <= qb64; ++kt) {
        LAS unsigned char* buf = lds + (kt & 1) * KVBUF_B;
        const bool hn = kt < qb64;
        if (hn) st.load(kg + (size_t)(kt + 1) * 64 * (KVH * HD * 2), KVH * HD * 2, vg + (size_t)(kt + 1) * 64 * 2, SEQ * 2, tid);
        const unsigned long long mw = mrow[kt];
        const bool two = (64 * kt + 32) <= q0 + 31;
        f32x16 p0 = f32x16{}, p1 = f32x16{};
        { const LAS unsigned char* kp = buf + r * KSTR + 16 * hh;
#pragma unroll
            for (int s = 0; s < 8; ++s) p0 = __builtin_amdgcn_mfma_f32_32x32x16_bf16(*(const LAS bf16x8*)(kp + 32 * s), qf[s], p0, 0, 0, 0);
            if (two) {
#pragma unroll
                for (int s = 0; s < 8; ++s) p1 = __builtin_amdgcn_mfma_f32_32x32x16_bf16(*(const LAS bf16x8*)(kp + 32 * KSTR + 32 * s), qf[s], p1, 0, 0, 0); } }
        const unsigned m0 = ((unsigned)mw) >> (4 * hh), m1 = two ? (((unsigned)(mw >> 32)) >> (4 * hh)) : 0u;
        float tmax = -1e30f;
#pragma unroll
        for (int i = 0; i < 16; ++i) { const int kb = crow(i, 0); tmax = fmaxf(tmax, ((m0 >> kb) & 1u) ? p0[i] : -1e30f); tmax = fmaxf(tmax, ((m1 >> kb) & 1u) ? p1[i] : -1e30f); }
        tmax = swap_max(tmax);
        const float mnew = fmaxf(mrun, tmax), alpha = __builtin_amdgcn_exp2f(mrun - mnew);
        float ls = 0.f;
#pragma unroll
        for (int i = 0; i < 16; ++i) { const int kb = crow(i, 0);
            const float e0 = ((m0 >> kb) & 1u) ? __builtin_amdgcn_exp2f(p0[i] - mnew) : 0.f, e1 = ((m1 >> kb) & 1u) ? __builtin_amdgcn_exp2f(p1[i] - mnew) : 0.f;
            p0[i] = e0; p1[i] = e1; ls += e0 + e1; }
        lrun = lrun * alpha + ls; mrun = mnew;
#pragma unroll
        for (int d = 0; d < 4; ++d)
#pragma unroll
            for (int i = 0; i < 16; ++i) o[d][i] *= alpha;
        const bf16x8 pa0 = pack8(p0, 0), pa1 = pack8(p0, 8), pa2 = pack8(p1, 0), pa3 = pack8(p1, 8);
        const LAS unsigned char* vb = buf + KTILE_B + r * VSTR + 8 * hh;
#pragma unroll
        for (int d = 0; d < 4; ++d) {
            const LAS unsigned char* vp = vb + 32 * d * VSTR;
#define VFRAG(ks) ({ const s16x4 lo_ = *(const LAS s16x4*)(vp + 32 * (ks)), hi_ = *(const LAS s16x4*)(vp + 32 * (ks) + 16); (bf16x8){lo_[0], lo_[1], lo_[2], lo_[3], hi_[0], hi_[1], hi_[2], hi_[3]}; })
            o[d] = __builtin_amdgcn_mfma_f32_32x32x16_bf16(VFRAG(0), pa0, o[d], 0, 0, 0);
            o[d] = __builtin_amdgcn_mfma_f32_32x32x16_bf16(VFRAG(1), pa1, o[d], 0, 0, 0);
            if (two) { o[d] = __builtin_amdgcn_mfma_f32_32x32x16_bf16(VFRAG(2), pa2, o[d], 0, 0, 0);
                       o[d] = __builtin_amdgcn_mfma_f32_32x32x16_bf16(VFRAG(3), pa3, o[d], 0, 0, 0); }
#undef VFRAG
        }
        if (hn) st.store(lds + ((kt + 1) & 1) * KVBUF_B, tid);
        asm volatile("s_waitcnt lgkmcnt(0)" ::: "memory"); __builtin_amdgcn_s_barrier(); asm volatile("" ::: "memory");
    }
    const float linv = 1.0f / swap_sum(lrun);
    bf16_t* op = O + (size_t)(b * SEQ + q0 + r) * DM + h * HD + 4 * hh;
#pragma unroll
    for (int d = 0; d < 4; ++d)
#pragma unroll
        for (int gq = 0; gq < 4; ++gq) { u32x2 w; w.x = pk2(o[d][4 * gq] * linv, o[d][4 * gq + 1] * linv); w.y = pk2(o[d][4 * gq + 2] * linv, o[d][4 * gq + 3] * linv); *(u32x2*)(op + 32 * d + 8 * gq) = w; }
}

constexpr int N_PHASES = 12;
__global__ void __launch_bounds__(512, 2) fwd_kernel(Args a) {
    extern __shared__ __attribute__((aligned(16))) unsigned char lds_raw[];
    LAS unsigned char* lds = (LAS unsigned char*)lds_raw;
    cg::grid_group grid = cg::this_grid();
    const int tid = threadIdx.x, lane = tid & 63, wave = __builtin_amdgcn_readfirstlane(tid >> 6);
    const int G = gridDim.x, bx = blockIdx.x;
    const int gw = bx * 8 + wave, ngw = G * 8;
    unsigned char* ws = a.ws;
    const int lo = a.ph_lo, hi = a.ph_hi;
#ifndef REP_PHASE
#define REP_PHASE -1
#endif
#ifndef REP_COUNT
#define REP_COUNT 1
#endif
#define IN(k) (lo <= (k) && (k) < hi)
#define GSYNC(k) do { if ((k) == 0) grid.sync(); else xcd_barrier(xbar); } while (0)
#define SEAM(k) do { if (IN(k) && IN((k) + 1)) GSYNC(k); } while (0)
#define REPS(k) for (int rep_ = 0; rep_ < ((k) == REP_PHASE ? REP_COUNT : 1); ++rep_, (void)(((k) == REP_PHASE && rep_ < REP_COUNT) ? (xcd_barrier(xbar), 0) : 0))
    bf16_t* XB = (bf16_t*)(ws + WS_XB); float* X1 = (float*)(ws + WS_X1); float* X2 = (float*)(ws + WS_X2); float* PART = (float*)(ws + WS_PART);
    bf16_t* Qb = (bf16_t*)(ws + WS_Q); bf16_t* Kb = (bf16_t*)(ws + WS_K); bf16_t* Vtb = (bf16_t*)(ws + WS_VT); bf16_t* Ob = (bf16_t*)(ws + WS_O);
    bf16_t* QIb = (bf16_t*)(ws + WS_QI); bf16_t* KDb = (bf16_t*)(ws + WS_KD); bf16_t* VTDb = (bf16_t*)(ws + WS_VTD); bf16_t* KIb = (bf16_t*)(ws + WS_KI);
    float* WIb = (float*)(ws + WS_WI); unsigned* MASKb = (unsigned*)(ws + WS_MASK);
    bf16_t* ACTb = (bf16_t*)(ws + WS_ACT);
    const float* ropeC = (const float*)(ws + WS_ROPE); const float* ropeS = ropeC + SEQ * 64;

    if (tid < 16) ((volatile LAS unsigned*)(lds + LDS_MISC))[tid] = 0u;
    __syncthreads();
    XcdBarrier xbar = xcd_barrier_post((unsigned*)(ws + WS_CTL), (volatile LAS unsigned*)(lds + LDS_MISC) + 8);
    if (IN(0)) REPS(0) { prologue_phase(a, lds, gw, ngw, wave, lane); }
    SEAM(0);
    if (IN(1)) REPS(1) {
        pg8::Gemm g{XB, (const bf16_t*)(ws + WS_WQKV), MTOK, NQKV, DM}; pg8::StaticOrder S; S.init(MTOK, NQKV, G, bx);
        EpiQKV E{ws};
        pg8::gemm_phase<EpiQKV, pg8::StaticOrder, true, true>(lds, g, S, E);
    }
    SEAM(1);
    if (IN(2)) REPS(2) { sb_attn_phase(Qb, Kb, Vtb, Ob, gw, ngw, lane); }
    SEAM(2);
    if (IN(3)) REPS(3) {
        pg8::Gemm g{Ob, (const bf16_t*)(ws + WS_WO0), MTOK, DM, DM}; pg8::StaticOrder S; S.init(MTOK, DM, G, bx);
        EpiRes E{a.x, X1, XB, PART};
        pg8::gemm_phase<EpiRes, pg8::StaticOrder, true, true>(lds, g, S, E);
    }
    SEAM(3);
    if (IN(4)) REPS(4) {
        pg8::Gemm g{XB, (const bf16_t*)(ws + WS_WUP), MTOK, NUP, DM, 254, -2}; pg8::StaticOrder S; S.init_tiles(33, NUP / 256, G, bx);
        EpiUpConv E{ACTb, PART, a.conv_w, a.conv_b, (LAS float*)(lds + LDS_EPI)};
        pg8::gemm_phase<EpiUpConv, pg8::StaticOrder, true, true>(lds, g, S, E);
    }
    SEAM(4);
    if (IN(5)) REPS(5) {
        pg8::Gemm g{ACTb, (const bf16_t*)(ws + WS_WDN), MTOK, DM, FF}; pg8::StaticOrder S; S.init(MTOK, DM, G, bx);
        EpiRes E{X1, X2, XB, PART};
        pg8::gemm_phase<EpiRes, pg8::StaticOrder, true, true>(lds, g, S, E);
    }
    SEAM(5);
    if (IN(6)) REPS(6) {
        pg8::Gemm g{XB, (const bf16_t*)(ws + WS_WIN), MTOK, NINP, DM}; pg8::StaticOrder S; S.init(MTOK, NINP, G, bx);
        EpiDsaIn E{ws, (LAS float*)(lds + LDS_EPI)};
        pg8::gemm_phase<EpiDsaIn, pg8::StaticOrder, true, true>(lds, g, S, E);
    }
    SEAM(6);
    if (IN(7)) REPS(7) {
        for (int pr = bx; pr < 256; pr += G) { const int b = pr >> 6, p = pr & 63;
            indexer_unit(QIb, KIb, WIb, MASKb, (LAS float*)lds, b, 16 * (127 - p), wave, lane);
            indexer_unit(QIb, KIb, WIb, MASKb, (LAS float*)lds, b, 16 * p, wave, lane); }
    }
    SEAM(7);
    if (IN(8)) REPS(8) {
        for (int pr = bx; pr < 256; pr += G) { const int b = pr >> 6, g = (pr >> 4) & 3, p = pr & 15;
            for (int half = 0; half < 2; ++half) dsa_attn_block(Qb, KDb, VTDb, MASKb, Ob, lds, b, g, half ? p : 31 - p, wave, lane, tid); }
    }
    SEAM(8);
    if (IN(9)) REPS(9) {
        pg8::Gemm g{Ob, (const bf16_t*)(ws + WS_WO1), MTOK, DM, DM}; pg8::StaticOrder S; S.init(MTOK, DM, G, bx);
        EpiRes E{X2, X1, XB, PART};
        pg8::gemm_phase<EpiRes, pg8::StaticOrder, true, true>(lds, g, S, E);
    }
    SEAM(9);
    if (IN(10)) REPS(10) {
        pg8::Gemm g{XB, (const bf16_t*)(ws + WS_WUP + 44 * MiB), MTOK, NUP, DM, 254, -2}; pg8::StaticOrder S; S.init_tiles(33, NUP / 256, G, bx);
        EpiUpConv E{ACTb, PART, a.conv_w + 3 * NUP, a.conv_b + NUP, (LAS float*)(lds + LDS_EPI)};
        pg8::gemm_phase<EpiUpConv, pg8::StaticOrder, true, true>(lds, g, S, E);
    }
    SEAM(10);
    if (IN(11)) REPS(11) {
        pg8::Gemm g{ACTb, (const bf16_t*)(ws + WS_WDN + 22 * MiB), MTOK, DM, FF}; pg8::StaticOrder S; S.init(MTOK, DM, G, bx);
        EpiRes E{X1, a.out, nullptr, nullptr};
        pg8::gemm_phase<EpiRes, pg8::StaticOrder, true, true>(lds, g, S, E);
    }
#undef IN
#undef SEAM
}

extern "C" void kernel_launch(void* const* d_in, const int* in_sizes, int n_in, void* d_out, int out_size, void* d_ws, size_t ws_size, hipStream_t stream) {
    static int grid = 0;
    if (grid == 0) {
        if (n_in != 14 || out_size != MTOK * DM || ws_size < WS_END) { fprintf(stderr, "kernel_launch: unexpected shapes (n_in %d out %d ws %zu)\n", n_in, out_size, ws_size); grid = -1; return; }
        int dev = 0, cus = 0, per_cu = 0;
        hipGetDevice(&dev); hipDeviceGetAttribute(&cus, hipDeviceAttributeMultiprocessorCount, dev);
        if (hipFuncSetAttribute((const void*)fwd_kernel, hipFuncAttributeMaxDynamicSharedMemorySize, LDS_BYTES) != hipSuccess) { fprintf(stderr, "kernel_launch: hipFuncSetAttribute failed\n"); grid = -1; return; }
        if (hipOccupancyMaxActiveBlocksPerMultiprocessor(&per_cu, (const void*)fwd_kernel, 512, LDS_BYTES) != hipSuccess || per_cu < 1) { fprintf(stderr, "kernel_launch: occupancy query says %d\n", per_cu); per_cu = 1; }
        (void)hipGetLastError();
        grid = cus;
    }
    if (grid < 0) return;
    Args a{};
    a.x = (const float*)d_in[0]; a.attn_g = (const float*)d_in[1]; a.ffn_g = (const float*)d_in[2]; a.w_qkv = (const float*)d_in[3]; a.w_o0 = (const float*)d_in[4]; a.w_in = (const float*)d_in[5];
    a.qn_g = (const float*)d_in[6]; a.kn_g = (const float*)d_in[7]; a.ikn_g = (const float*)d_in[8]; a.w_o1 = (const float*)d_in[9]; a.w_up = (const float*)d_in[10]; a.conv_w = (const float*)d_in[11];
    a.conv_b = (const float*)d_in[12]; a.w_down = (const float*)d_in[13]; a.out = (float*)d_out; a.ws = (unsigned char*)d_ws;
    if (hipMemsetAsync((char*)d_ws + WS_CTL, 0, CTL_BYTES, stream) != hipSuccess) { fprintf(stderr, "kernel_launch: hipMemsetAsync failed\n"); return; }
#if MK_ONE_LAUNCH
    a.ph_lo = 0; a.ph_hi = N_PHASES;
    void* args[] = {&a};
    hipError_t e = hipLaunchCooperativeKernel((const void*)fwd_kernel, dim3(grid), dim3(512), args, LDS_BYTES, stream);
    if (e != hipSuccess) fprintf(stderr, "cooperative launch failed: %s (grid %d)\n", hipGetErrorString(e), grid);
#else
    for (int p = 0; p < N_PHASES; ++p) {
        a.ph_lo = p; a.ph_hi = p + 1;
        void* args[] = {&a};
        hipError_t e = hipLaunchCooperativeKernel((const void*)fwd_kernel, dim3(grid), dim3(512), args, LDS_BYTES, stream);
        if (e != hipSuccess) { fprintf(stderr, "launch %d failed: %s (grid %d)\n", p, hipGetErrorString(e), grid); break; }
    }
#endif
}
```

```cpp
#include <hip/hip_runtime.h>
#include <hip/hip_cooperative_groups.h>
#include <cstdio>
#include <cstdint>
namespace cg = cooperative_groups;

#ifndef MK_ONE_LAUNCH
#define MK_ONE_LAUNCH 1
#endif

#define LAS __attribute__((address_space(3)))
typedef unsigned short bf16_t;
typedef short bf16x8 __attribute__((ext_vector_type(8)));
typedef short s16x4 __attribute__((ext_vector_type(4)));
typedef float f32x4 __attribute__((ext_vector_type(4)));
typedef float f32x2 __attribute__((ext_vector_type(2)));
typedef float f32x16 __attribute__((ext_vector_type(16)));
typedef unsigned u32x4 __attribute__((ext_vector_type(4)));
typedef unsigned u32x2 __attribute__((ext_vector_type(2)));
typedef __bf16 bf16x2_t __attribute__((ext_vector_type(2)));

constexpr int BATCH = 4, SEQ = 2048, DM = 2048, NH = 16, HD = 128, MTOK = BATCH * SEQ;
constexpr int FF = 5632, NUP = 2 * FF, NQKV = 3 * DM;
constexpr int KVH = 4, NIN = 5264, NINP = 5376;
constexpr int TOPK = 256;
constexpr float NORM_EPS = 1e-6f;
constexpr float LOG2E = 1.4426950408889634f;
constexpr float QSCALE = 0.08838834764831845f * LOG2E;

constexpr size_t MiB = 1u << 20;
constexpr size_t WS_WQKV = 0, WS_WO0 = 24 * MiB, WS_WIN = 32 * MiB, WS_WO1 = 53 * MiB, WS_WUP = 61 * MiB  , WS_WDN = 149 * MiB  ;
constexpr size_t WS_GAIN = 197 * MiB + 512 * 1024  ;
constexpr size_t WS_ROPE = 193 * MiB  , WS_PART = 194 * MiB, WS_MASK = 195 * MiB, WS_WI = 197 * MiB, WS_KI = 198 * MiB;
constexpr size_t WS_XB = 200 * MiB, WS_X1 = 232 * MiB, WS_X2 = 296 * MiB;
constexpr size_t WS_SCR = 360 * MiB;
constexpr size_t WS_U = WS_SCR, WS_ACT = WS_SCR + 176 * MiB;
constexpr size_t WS_Q = WS_SCR, WS_K = WS_SCR + 32 * MiB, WS_VT = WS_SCR + 64 * MiB, WS_O = WS_SCR + 96 * MiB, WS_QI = WS_SCR + 128 * MiB, WS_KD = WS_SCR + 160 * MiB, WS_VTD = WS_SCR + 168 * MiB;
constexpr size_t WS_CTL = WS_ACT + 88 * MiB, CTL_BYTES = 65536;
constexpr size_t WS_END = WS_CTL + CTL_BYTES;

constexpr int LDS_EPI = 131072;
constexpr int LDS_MISC = LDS_EPI + 8192;
constexpr int LDS_BYTES = 147456;

__device__ __forceinline__ unsigned pk2(float lo, float hi) { f32x2 v = {lo, hi}; bf16x2_t b = __builtin_convertvector(v, bf16x2_t); return __builtin_bit_cast(unsigned, b); }
__device__ __forceinline__ bf16_t f2bf(float f) { return (bf16_t)(pk2(f, 0.f) & 0xffffu); }
__device__ __forceinline__ int crow(int r, int hi) { return (r & 3) + 8 * (r >> 2) + 4 * hi; }
__device__ __forceinline__ bf16x8 pack8(const f32x16& p, int b) {
    u32x4 w; w.x = pk2(p[b], p[b + 1]); w.y = pk2(p[b + 2], p[b + 3]); w.z = pk2(p[b + 4], p[b + 5]); w.w = pk2(p[b + 6], p[b + 7]);
    return __builtin_bit_cast(bf16x8, w);
}
__device__ __forceinline__ float swap_sum(float v) { auto rr = __builtin_amdgcn_permlane32_swap(__float_as_uint(v), __float_as_uint(v), false, false); return __uint_as_float(rr[0]) + __uint_as_float(rr[1]); }
__device__ __forceinline__ float swap_max(float v) { auto rr = __builtin_amdgcn_permlane32_swap(__float_as_uint(v), __float_as_uint(v), false, false); return fmaxf(__uint_as_float(rr[0]), __uint_as_float(rr[1])); }
__device__ __forceinline__ float wave_sum(float v) {
#pragma unroll
    for (int o = 1; o < 64; o <<= 1) v += __shfl_xor(v, o);
    return v;
}
__device__ __forceinline__ float row_rstd(const float* part, int row, int fq) {
    const f32x4* p = (const f32x4*)(part + (size_t)row * 32 + 8 * fq);
    const f32x4 a = p[0], b = p[1]; float s = ((a.x + a.y) + (a.z + a.w)) + ((b.x + b.y) + (b.z + b.w));
    s += __shfl_xor(s, 16); s += __shfl_xor(s, 32);
    return 1.0f / sqrtf(s * (1.0f / DM) + NORM_EPS);
}


#define XB_TMO      128
#define XB_XCNT(j)  (256  + 64 * (j))
#define XB_XSUB(j)  (1280 + 64 * (j))
#define XB_XGEN(j)  (2304 + 64 * (j))
#define XB_TOP      3328
#define XB_TOPGEN   3392
#define XCD_BAR_WORDS 3456
#define XB_SPIN_CAP (1u << 18)
__device__ __forceinline__ unsigned xb_ld(unsigned* p)              { return __hip_atomic_load(p, __ATOMIC_RELAXED, __HIP_MEMORY_SCOPE_AGENT); }
__device__ __forceinline__ unsigned xb_add(unsigned* p, unsigned v) { return __hip_atomic_fetch_add(p, v, __ATOMIC_RELAXED, __HIP_MEMORY_SCOPE_AGENT); }
__device__ __forceinline__ unsigned xb_xcc_id() { return (unsigned)__builtin_amdgcn_s_getreg((3 << 11) | 20) & 0xFu; }
#define XB_SPIN(cond, bar) do { unsigned _sp = 0; while (cond) { __builtin_amdgcn_s_sleep(1); \
    if ((++_sp & 255u) == 0u) { if (xb_ld(&(bar)[XB_TMO])) break; if (_sp > XB_SPIN_CAP) { atomicAdd(&(bar)[XB_TMO], 1u); break; } } } } while (0)
struct XcdBarrier { unsigned* bar; unsigned x; volatile LAS unsigned* st; };
__device__ __forceinline__ XcdBarrier xcd_barrier_post(unsigned* bar, volatile LAS unsigned* st) {
    XcdBarrier b; b.bar = bar; b.x = xb_xcc_id(); b.st = st;
    if (threadIdx.x == 0) (void)xb_add(&bar[XB_XCNT(b.x)], 1u);
    return b;
}
__device__ __forceinline__ void xcd_barrier_complete(unsigned* bar, unsigned x, unsigned& nloc, unsigned& nx) {
    const unsigned G = gridDim.x * gridDim.y * gridDim.z;
    unsigned sum, cnt, mine, sp = 0u;
    for (;;) {
        sum = 0u; cnt = 0u; mine = 0u;
#pragma unroll
        for (unsigned j = 0; j < 16; ++j) { const unsigned c = xb_ld(&bar[XB_XCNT(j)]); sum += c; cnt += (c > 0u) ? 1u : 0u; mine = (j == x) ? c : mine; }
        if (sum == G) break;
        __builtin_amdgcn_s_sleep(1);
        if ((++sp & 255u) == 0u) { if (xb_ld(&bar[XB_TMO])) break; if (sp > XB_SPIN_CAP) { atomicAdd(&bar[XB_TMO], 1u); break; } }
    }
    nloc = mine > 0u ? mine : 1u; nx = cnt > 0u ? cnt : 1u;
}
__device__ __forceinline__ void xcd_barrier(const XcdBarrier& b) {
    asm volatile("s_waitcnt vmcnt(0)" ::: "memory");
    __syncthreads();
    if (threadIdx.x == 0) {
        unsigned* bar = b.bar;
        __builtin_amdgcn_s_waitcnt(0);
        unsigned nloc = b.st[0], nx = b.st[1];
        if (nloc == 0u) { xcd_barrier_complete(bar, b.x, nloc, nx); b.st[0] = nloc; b.st[1] = nx; }
        const unsigned old = xb_add(&bar[XB_XSUB(b.x)], 1u);
        const unsigned gen = old / nloc;
        if (old + 1u == (gen + 1u) * nloc) {
            __builtin_amdgcn_fence(__ATOMIC_RELEASE, "agent");
            asm volatile("s_waitcnt vmcnt(0)" ::: "memory");
            const unsigned og = xb_add(&bar[XB_TOP], 1u);
            const unsigned tg = og / nx;
            if (og + 1u == (tg + 1u) * nx) xb_add(&bar[XB_TOPGEN], 1u);
            else XB_SPIN(xb_ld(&bar[XB_TOPGEN]) == tg, bar);
            __builtin_amdgcn_fence(__ATOMIC_ACQUIRE, "agent");
            xb_add(&bar[XB_XGEN(b.x)], 1u);
            asm volatile("s_waitcnt vmcnt(0)" ::: "memory");
        } else {
            XB_SPIN(xb_ld(&bar[XB_XGEN(b.x)]) == gen, bar);
            __builtin_amdgcn_fence(__ATOMIC_ACQUIRE, "agent");
            asm volatile("s_waitcnt vmcnt(0)" ::: "memory");
        }
    }
    __syncthreads();
}

namespace pg8 {
constexpr int BM = 256, BK = 64, HALF = 128, HTB = HALF * BK * 2, STAGE_BYTES = 8 * HTB, NXCD = 8, WGM = 8;
__host__ __device__ __forceinline__ int lds_byte(int r, int c) { const int st = (r >> 4) * 2 + (c >> 5), rr = r & 15, cc = c & 31, ob = rr * 64 + cc * 2; return st * 1024 + (ob ^ (((ob >> 9) & 1) << 5)); }
__host__ __device__ __forceinline__ void stage_rc(int b, int& R, int& C) { const int st = b / 1024, sb = b % 1024, swz = sb ^ (((sb >> 9) & 1) << 5); R = (st >> 1) * 16 + swz / 64; C = (st & 1) * 32 + (swz % 64) / 2; }
__host__ __device__ __forceinline__ int perm32(int rho) { const int n = rho >> 4, i = rho & 15; return 8 * (i >> 2) + 4 * n + (i & 3); }
struct Unit { int pm, pn; };
struct Gemm { const bf16_t* A; const bf16_t* Bt; int M, N, K; int a_rows = 256, a_row0 = 0; };
struct StaticOrder {
    int nM, nN, nwg, G, c;
    __host__ __device__ void init(int M, int N, int G_, int c_) { nM = M / BM; nN = N / BM; nwg = nM * nN; G = G_; c = c_; }
    __host__ __device__ void init_tiles(int nM_, int nN_, int G_, int c_) { nM = nM_; nN = nN_; nwg = nM * nN; G = G_; c = c_; }
    __host__ __device__ bool next(int i, Unit& u) const {
        const long L = (long)i * G + c; if (L >= nwg) return false;
        int wgid = (int)L; { const int q = nwg / NXCD, r = nwg % NXCD, xcd = wgid % NXCD, off = wgid / NXCD; wgid = (xcd < r ? xcd * (q + 1) : r * (q + 1) + (xcd - r) * q) + off; }
        const int nig = WGM * nN, gid = wgid / nig, fm = gid * WGM, gsz = (nM - fm) < WGM ? (nM - fm) : WGM;
        u.pm = fm + ((wgid % nig) % gsz); u.pn = (wgid % nig) / gsz; return true;
    }
};
template <class Epi, class Sched, bool ALIGN_EPI, bool SP2>
__device__ __forceinline__ void gemm_phase(LAS unsigned char* lds, const Gemm g, const Sched& S, const Epi& E) {
    const int tid = threadIdx.x, wid = __builtin_amdgcn_readfirstlane(tid >> 6), lane = tid & 63, wr = wid >> 2, wc = wid & 3, fr = lane & 15, fq = lane >> 4;
    const int K = g.K, nt = K / BK;
    unsigned voffA[2], voffB[2];
#pragma unroll
    for (int i = 0; i < 2; ++i) { int R, C; stage_rc(tid * 16 + i * 8192, R, C); const int Rb = Epi::PERM ? ((R & ~31) + perm32(R & 31)) : R;
        voffA[i] = (unsigned)(R * K + C) * 2u; voffB[i] = (unsigned)(Rb * K + C) * 2u; }
    const size_t kstep = (size_t)(BK * 2);
    const size_t hstep = (size_t)HALF * K * 2;
    const size_t tstep = 2 * hstep;
    const unsigned ldsw = (unsigned)wid * 1024u;
    const int aoff = lds_byte(wr * 64 + fr, fq * 8), boff = lds_byte(wc * 32 + fr, fq * 8);
#define PG8_SA(b, h) (((b) * 2 + (h)) * HTB)
#define PG8_SB(b, h) ((4 + (b) * 2 + (h)) * HTB)
#define PG8_STAGE(bufoff, gbase, voff) do { _Pragma("unroll") for (int _i = 0; _i < 2; ++_i) \
        __builtin_amdgcn_global_load_lds((const unsigned*)((const char*)(gbase) + (voff)[_i]), (LAS unsigned*)(lds + (bufoff) + ldsw + _i * 8192), 16, 0, 0); } while (0)
#define PG8_LDA(dst, b, h) do { _Pragma("unroll") for (int m = 0; m < 4; ++m) _Pragma("unroll") for (int k = 0; k < 2; ++k) dst[m][k] = *(const LAS bf16x8*)(lds + PG8_SA(b, h) + aoff + m * 2048 + k * 1024); } while (0)
#define PG8_LDB(dst, b, h) do { _Pragma("unroll") for (int n = 0; n < 2; ++n) _Pragma("unroll") for (int k = 0; k < 2; ++k) dst[n][k] = *(const LAS bf16x8*)(lds + PG8_SB(b, h) + boff + n * 2048 + k * 1024); } while (0)
#define PG8_MMA(ai, bj, At, Bt) do { __builtin_amdgcn_s_setprio(1); _Pragma("unroll") for (int m = 0; m < 4; ++m) _Pragma("unroll") for (int n = 0; n < 2; ++n) _Pragma("unroll") for (int k = 0; k < 2; ++k) \
        acc[ai][bj][m][n] = __builtin_amdgcn_mfma_f32_16x16x32_bf16(Bt[n][k], At[m][k], acc[ai][bj][m][n], 0, 0, 0); __builtin_amdgcn_s_setprio(0); } while (0)
#define PG8_WAIT_V(n) asm volatile("s_waitcnt vmcnt(" #n ")" ::: "memory")
#define PG8_WAIT_L(n) asm volatile("s_waitcnt lgkmcnt(" #n ")" ::: "memory")
#define PG8_BAR __builtin_amdgcn_s_barrier()
#define PG8_SCHED __builtin_amdgcn_sched_barrier(0)
    Unit cur, nxt; int ui = 0;
    if (!S.next(0, cur)) return;
    f32x4 acc[2][2][4][2];
#pragma unroll
    for (int a = 0; a < 2; ++a)
#pragma unroll
        for (int b = 0; b < 2; ++b)
#pragma unroll
            for (int m = 0; m < 4; ++m)
#pragma unroll
                for (int n = 0; n < 2; ++n) acc[a][b][m][n] = (f32x4){0.f, 0.f, 0.f, 0.f};
    bf16x8 At[4][2], B0[2][2], B1[2][2];
    const long atstep = (long)g.a_rows * K * 2, aorg = (long)g.a_row0 * K * 2;
    const char* cA = (const char*)g.A + aorg + (long)cur.pm * atstep; const char* cB = (const char*)g.Bt + (size_t)cur.pn * tstep;
    if constexpr (SP2) {
        PG8_STAGE(PG8_SB(0, 0), cB, voffB); PG8_STAGE(PG8_SB(0, 1), cB + hstep, voffB); PG8_STAGE(PG8_SA(0, 0), cA, voffA); PG8_STAGE(PG8_SA(0, 1), cA + hstep, voffA);
        if (wr == 1) PG8_BAR;
        PG8_WAIT_V(2); PG8_BAR;
        PG8_STAGE(PG8_SB(1, 0), cB + kstep, voffB); PG8_STAGE(PG8_SA(1, 0), cA + kstep, voffA); PG8_STAGE(PG8_SB(1, 1), cB + hstep + kstep, voffB);
        PG8_WAIT_V(6); PG8_BAR;
    } else {
        PG8_STAGE(PG8_SB(0, 0), cB, voffB); PG8_STAGE(PG8_SA(0, 0), cA, voffA); PG8_STAGE(PG8_SB(0, 1), cB + hstep, voffB); PG8_STAGE(PG8_SA(0, 1), cA + hstep, voffA);
        if (wr == 1) PG8_BAR;
        PG8_WAIT_V(4); PG8_BAR;
        PG8_STAGE(PG8_SB(1, 0), cB + kstep, voffB); PG8_STAGE(PG8_SA(1, 0), cA + kstep, voffA); PG8_STAGE(PG8_SB(1, 1), cB + hstep + kstep, voffB);
        PG8_WAIT_V(6); PG8_BAR;
    }
    for (;;) {
        const bool has_next = S.next(ui + 1, nxt);
        const char* nA = has_next ? (const char*)g.A + aorg + (long)nxt.pm * atstep : cA; const char* nB = has_next ? (const char*)g.Bt + (size_t)nxt.pn * tstep : cB;
        for (int t = 0; t < nt; t += 2) {
            const bool last = (t == nt - 2);
            const char* a1 = cA + (size_t)(t + 1) * kstep;
            const char* a2 = last ? nA : cA + (size_t)(t + 2) * kstep; const char* b2 = last ? nB : cB + (size_t)(t + 2) * kstep;
            const char* a3 = a2 + kstep; const char* b3 = b2 + kstep;
            if constexpr (SP2) {
            PG8_LDB(B0, 0, 0); PG8_LDB(B1, 0, 1); PG8_SCHED; PG8_LDA(At, 0, 0); PG8_STAGE(PG8_SA(1, 1), a1 + hstep, voffA);
            PG8_WAIT_V(8); PG8_WAIT_L(0); PG8_BAR; PG8_MMA(0, 0, At, B0); PG8_MMA(0, 1, At, B1); PG8_BAR; PG8_SCHED;
            PG8_LDA(At, 0, 1); PG8_STAGE(PG8_SB(0, 0), b2, voffB); PG8_STAGE(PG8_SB(0, 1), b2 + hstep, voffB); PG8_STAGE(PG8_SA(0, 0), a2, voffA);
            PG8_WAIT_V(8); PG8_WAIT_L(0); PG8_BAR; PG8_MMA(1, 0, At, B0); PG8_MMA(1, 1, At, B1); PG8_BAR; PG8_SCHED;
            PG8_LDB(B0, 1, 0); PG8_LDB(B1, 1, 1); PG8_SCHED; PG8_LDA(At, 1, 0); PG8_STAGE(PG8_SA(0, 1), a2 + hstep, voffA);
            PG8_WAIT_V(8); PG8_WAIT_L(0); PG8_BAR; PG8_MMA(0, 0, At, B0); PG8_MMA(0, 1, At, B1); PG8_BAR; PG8_SCHED;
            PG8_LDA(At, 1, 1); PG8_STAGE(PG8_SB(1, 0), b3, voffB); PG8_STAGE(PG8_SB(1, 1), b3 + hstep, voffB); PG8_STAGE(PG8_SA(1, 0), a3, voffA);
            PG8_WAIT_V(8); PG8_WAIT_L(0); PG8_BAR; PG8_MMA(1, 0, At, B0); PG8_MMA(1, 1, At, B1); PG8_BAR; PG8_SCHED;
            } else {
            PG8_LDB(B0, 0, 0); PG8_SCHED; PG8_LDA(At, 0, 0); PG8_STAGE(PG8_SA(1, 1), a1 + hstep, voffA);
            PG8_WAIT_L(8); PG8_BAR; PG8_WAIT_L(0); PG8_MMA(0, 0, At, B0); PG8_BAR; PG8_SCHED;
            PG8_LDB(B1, 0, 1); PG8_STAGE(PG8_SB(0, 0), b2, voffB);
            PG8_BAR; PG8_WAIT_L(0); PG8_MMA(0, 1, At, B1); PG8_BAR;
            PG8_LDA(At, 0, 1); PG8_STAGE(PG8_SA(0, 0), a2, voffA);
            PG8_BAR; PG8_WAIT_L(0); PG8_MMA(1, 0, At, B0); PG8_BAR; PG8_SCHED;
            PG8_STAGE(PG8_SB(0, 1), b2 + hstep, voffB);
            PG8_WAIT_V(6); PG8_BAR; PG8_MMA(1, 1, At, B1); PG8_BAR;
            PG8_LDB(B0, 1, 0); PG8_SCHED; PG8_LDA(At, 1, 0); PG8_STAGE(PG8_SA(0, 1), a2 + hstep, voffA);
            PG8_WAIT_L(8); PG8_BAR; PG8_WAIT_L(0); PG8_MMA(0, 0, At, B0); PG8_BAR; PG8_SCHED;
            PG8_LDB(B1, 1, 1); PG8_STAGE(PG8_SB(1, 0), b3, voffB);
            PG8_BAR; PG8_WAIT_L(0); PG8_MMA(0, 1, At, B1); PG8_BAR;
            PG8_LDA(At, 1, 1); PG8_STAGE(PG8_SA(1, 0), a3, voffA);
            PG8_BAR; PG8_WAIT_L(0); PG8_MMA(1, 0, At, B0); PG8_BAR; PG8_SCHED;
            PG8_STAGE(PG8_SB(1, 1), b3 + hstep, voffB);
            PG8_WAIT_V(6); PG8_BAR; PG8_MMA(1, 1, At, B1); PG8_BAR;
            }
        }
        if constexpr (ALIGN_EPI) { if (wr == 0) PG8_BAR; }
        { int fr_ = fr, fq_ = fq; asm volatile("" : "+v"(fr_), "+v"(fq_)); E(acc, cur, wr, wc, fr_, fq_); }
        if (!has_next) break;
#pragma unroll
        for (int a = 0; a < 2; ++a)
#pragma unroll
            for (int b = 0; b < 2; ++b)
#pragma unroll
                for (int m = 0; m < 4; ++m)
#pragma unroll
                    for (int n = 0; n < 2; ++n) acc[a][b][m][n] = (f32x4){0.f, 0.f, 0.f, 0.f};
        cur = nxt; cA = nA; cB = nB; ++ui;
        if constexpr (ALIGN_EPI) { if (wr == 1) PG8_BAR; }
    }
    PG8_WAIT_V(0);
    if constexpr (!ALIGN_EPI) { if (wr == 0) PG8_BAR; }
    PG8_BAR;
#undef PG8_SA
#undef PG8_SB
#undef PG8_STAGE
#undef PG8_LDA
#undef PG8_LDB
#undef PG8_MMA
#undef PG8_WAIT_V
#undef PG8_WAIT_L
#undef PG8_BAR
#undef PG8_SCHED
}
}
using pg8::Unit;
typedef f32x4 AccT[2][2][4][2];

struct EpiQKV {
    static constexpr bool PERM = true;
    unsigned char* ws;
    __device__ __forceinline__ void operator()(const AccT& acc, const Unit& u, int wr, int wc, int fr, int fq) const {
        const int row0 = u.pm * 256 + wr * 64 + fr, kind = u.pn >> 3, colt = (u.pn & 7) * 256 + wc * 32 + 8 * fq;
        bf16_t* Vt = (bf16_t*)(ws + WS_VT);
        if (kind < 2) {
            bf16_t* base = (bf16_t*)(ws + (kind == 0 ? WS_Q : WS_K)); const float sc = kind == 0 ? QSCALE : 1.0f;
#pragma unroll
            for (int ai = 0; ai < 2; ++ai)
#pragma unroll
                for (int m = 0; m < 4; ++m) { bf16_t* rowp = base + (size_t)(row0 + ai * 128 + m * 16) * DM + colt;
#pragma unroll
                    for (int bj = 0; bj < 2; ++bj) { const f32x4 v0 = acc[ai][bj][m][0] * sc, v1 = acc[ai][bj][m][1] * sc;
                        u32x4 w; w.x = pk2(v0[0], v0[1]); w.y = pk2(v0[2], v0[3]); w.z = pk2(v1[0], v1[1]); w.w = pk2(v1[2], v1[3]);
                        *(u32x4*)(rowp + bj * 128) = w; } }
        } else {
#pragma unroll
            for (int ai = 0; ai < 2; ++ai)
#pragma unroll
                for (int m = 0; m < 4; ++m) { const int row = row0 + ai * 128 + m * 16, b = row >> 11, s = row & 2047;
#pragma unroll
                    for (int bj = 0; bj < 2; ++bj) { const int c0 = colt + bj * 128, h = c0 >> 7, d0 = c0 & 127;
                        bf16_t* p = Vt + ((size_t)(b * NH + h) * HD + d0) * SEQ + s;
#pragma unroll
                        for (int n = 0; n < 2; ++n)
#pragma unroll
                            for (int j = 0; j < 4; ++j) p[(size_t)(4 * n + j) * SEQ] = f2bf(acc[ai][bj][m][n][j]); } }
        }
    }
};
struct EpiRes {
    static constexpr bool PERM = true;
    const float* res; float* out; bf16_t* outb; float* part;
    __device__ __forceinline__ void operator()(const AccT& acc, const Unit& u, int wr, int wc, int fr, int fq) const {
        const int row0 = u.pm * 256 + wr * 64 + fr, col0 = u.pn * 256 + wc * 32 + 8 * fq;
#pragma unroll
        for (int ai = 0; ai < 2; ++ai)
#pragma unroll
            for (int m = 0; m < 4; ++m) { const int row = row0 + ai * 128 + m * 16; const size_t off = (size_t)row * DM + col0; float ss = 0.f;
#pragma unroll
                for (int bj = 0; bj < 2; ++bj) {
                    const f32x4 r0 = *(const f32x4*)(res + off + bj * 128), r1 = *(const f32x4*)(res + off + bj * 128 + 4);
                    const f32x4 v0 = acc[ai][bj][m][0] + r0, v1 = acc[ai][bj][m][1] + r1;
                    *(f32x4*)(out + off + bj * 128) = v0; *(f32x4*)(out + off + bj * 128 + 4) = v1;
                    if (outb) { u32x4 w; w.x = pk2(v0[0], v0[1]); w.y = pk2(v0[2], v0[3]); w.z = pk2(v1[0], v1[1]); w.w = pk2(v1[2], v1[3]); *(u32x4*)(outb + off + bj * 128) = w; }
                    ss += (v0[0] * v0[0] + v0[1] * v0[1]) + (v0[2] * v0[2] + v0[3] * v0[3]) + (v1[0] * v1[0] + v1[1] * v1[1]) + (v1[2] * v1[2] + v1[3] * v1[3]); }
                if (part) { ss += __shfl_xor(ss, 16); ss += __shfl_xor(ss, 32); if (fq == 0) part[(size_t)row * 32 + u.pn * 4 + wc] = ss; } }
    }
};
struct EpiUp {
    static constexpr bool PERM = true;
    bf16_t* U; const float* part;
    __device__ __forceinline__ void operator()(const AccT& acc, const Unit& u, int wr, int wc, int fr, int fq) const {
        const int row0 = u.pm * 256 + wr * 64 + fr, col0 = u.pn * 256 + wc * 32 + 8 * fq;
#pragma unroll
        for (int ai = 0; ai < 2; ++ai)
#pragma unroll
            for (int m = 0; m < 4; ++m) { const int row = row0 + ai * 128 + m * 16; const float rs = row_rstd(part, row, fq); bf16_t* rowp = U + (size_t)row * NUP + col0;
#pragma unroll
                for (int bj = 0; bj < 2; ++bj) { const f32x4 v0 = acc[ai][bj][m][0] * rs, v1 = acc[ai][bj][m][1] * rs;
                    u32x4 w; w.x = pk2(v0[0], v0[1]); w.y = pk2(v0[2], v0[3]); w.z = pk2(v1[0], v1[1]); w.w = pk2(v1[2], v1[3]);
                    *(u32x4*)(rowp + bj * 128) = w; } }
    }
};
__device__ __forceinline__ float dpp_ror1(float v) { return __int_as_float(__builtin_amdgcn_update_dpp(0, __float_as_int(v), 0x121, 0xf, 0xf, false)); }
__device__ __forceinline__ float dpp_ror2(float v) { return __int_as_float(__builtin_amdgcn_update_dpp(0, __float_as_int(v), 0x122, 0xf, 0xf, false)); }
struct EpiUpConv {
    static constexpr bool PERM = true;
    bf16_t* ACT; const float* part; const float* cw; const float* cb; LAS float* hal;
    __device__ __forceinline__ void operator()(AccT& acc, const Unit& u, int wr, int wc, int fr, int fq) const {
        const int grow0 = 254 * u.pm - 2 + wr * 64 + fr;
#pragma unroll
        for (int ai = 0; ai < 2; ++ai)
#pragma unroll
            for (int m = 0; m < 4; ++m) { const int grow = grow0 + ai * 128 + m * 16; const int rowc = grow < 0 ? 0 : (grow >= MTOK ? MTOK - 1 : grow);
                const float rs = row_rstd(part, rowc, fq);
#pragma unroll
                for (int bj = 0; bj < 2; ++bj) { acc[ai][bj][m][0] *= rs; acc[ai][bj][m][1] *= rs; } }
        const int colw = wc * 32 + 8 * fq;
        if (fr >= 14) {
#pragma unroll
            for (int ai = 0; ai < 2; ++ai)
#pragma unroll
                for (int bj = 0; bj < 2; ++bj)
#pragma unroll
                    for (int n = 0; n < 2; ++n) *(LAS f32x4*)(hal + ((ai * 2 + wr) * 2 + (fr - 14)) * 256 + bj * 128 + colw + 4 * n) = acc[ai][bj][3][n];
        }
        asm volatile("s_waitcnt lgkmcnt(0)" ::: "memory"); __builtin_amdgcn_s_barrier(); asm volatile("" ::: "memory");
#pragma unroll
        for (int n = 0; n < 2; ++n) {
            const int ch = u.pn * 128 + colw + 4 * n;
            f32x4 w[2][3], bb[2];
#pragma unroll
            for (int bj = 0; bj < 2; ++bj) { bb[bj] = *(const f32x4*)(cb + bj * FF + ch);
#pragma unroll
                for (int t = 0; t < 3; ++t) w[bj][t] = *(const f32x4*)(cw + (size_t)t * NUP + bj * FF + ch); }
#pragma unroll
            for (int ai = 0; ai < 2; ++ai)
#pragma unroll
                for (int m = 0; m < 4; ++m) {
                    const int lrow = ai * 128 + wr * 64 + m * 16 + fr, grow = 254 * u.pm - 2 + lrow, pos = grow & 2047;
                    f32x4 cv[2];
#pragma unroll
                    for (int bj = 0; bj < 2; ++bj) {
                        const f32x4 cur = acc[ai][bj][m][n];
                        f32x4 q1, q2;
                        if (m > 0) { const f32x4 pv = acc[ai][bj][m - 1][n];
#pragma unroll
                            for (int e = 0; e < 4; ++e) { q1[e] = dpp_ror1(pv[e]); q2[e] = dpp_ror2(pv[e]); } }
                        else { const int slab = ai * 2 + wr - 1; f32x4 h1 = (f32x4){0.f, 0.f, 0.f, 0.f}, h2 = h1;
                            if (slab >= 0) { h1 = *(const LAS f32x4*)(hal + (slab * 2 + 1) * 256 + bj * 128 + colw + 4 * n); h2 = *(const LAS f32x4*)(hal + (slab * 2) * 256 + bj * 128 + colw + 4 * n); }
                            q1 = h1; q2 = (fr == 1) ? h1 : h2; }
                        f32x4 c = bb[bj];
#pragma unroll
                        for (int e = 0; e < 4; ++e) { const float r1 = dpp_ror1(cur[e]), r2 = dpp_ror2(cur[e]);
                            const float p1 = fr >= 1 ? r1 : q1[e], p2 = fr >= 2 ? r2 : q2[e];
                            float v = c[e] + w[bj][2][e] * cur[e];
                            if (pos >= 1) v += w[bj][1][e] * p1;
                            if (pos >= 2) v += w[bj][0][e] * p2;
                            c[e] = v; }
                        cv[bj] = c;
                    }
                    float a4[4];
#pragma unroll
                    for (int e = 0; e < 4; ++e) { const float gx = cv[0][e]; a4[e] = gx * __builtin_amdgcn_rcpf(1.0f + __expf(-gx)) * cv[1][e]; }
                    if (lrow >= 2 && grow < MTOK) { u32x2 o; o.x = pk2(a4[0], a4[1]); o.y = pk2(a4[2], a4[3]); *(u32x2*)(ACT + (size_t)grow * FF + ch) = o; }
                }
        }
    }
};
struct EpiDsaIn {
    static constexpr bool PERM = false;
    unsigned char* ws; LAS float* scr;
    __device__ __forceinline__ void operator()(const AccT& acc_in, const Unit& u, int wr, int wc, int fr, int fq) const {
        const int row0 = u.pm * 256 + wr * 64 + fr;
        const float* part = (const float*)(ws + WS_PART); const float* ropeC = (const float*)(ws + WS_ROPE); const float* ropeS = ropeC + SEQ * 64;
        bf16_t* VTD = (bf16_t*)(ws + WS_VTD); float* WI = (float*)(ws + WS_WI);
        const bool need_norm = (u.pn < 10) || (u.pn == 20);
        float rs[2][4];
#pragma unroll
        for (int ai = 0; ai < 2; ++ai)
#pragma unroll
            for (int m = 0; m < 4; ++m) rs[ai][m] = row_rstd(part, row0 + ai * 128 + m * 16, fq);
        if (need_norm) {
#pragma unroll
            for (int ai = 0; ai < 2; ++ai)
#pragma unroll
                for (int m = 0; m < 4; ++m)
#pragma unroll
                    for (int bj = 0; bj < 2; ++bj) { const f32x4 a = acc_in[ai][bj][m][0], b = acc_in[ai][bj][m][1];
                        float ss = ((a[0] * a[0] + a[1] * a[1]) + (a[2] * a[2] + a[3] * a[3])) + ((b[0] * b[0] + b[1] * b[1]) + (b[2] * b[2] + b[3] * b[3]));
                        ss += __shfl_xor(ss, 16); ss += __shfl_xor(ss, 32);
                        if (fq == 0) scr[(ai * 128 + wr * 64 + m * 16 + fr) * 8 + bj * 4 + wc] = ss * rs[ai][m] * rs[ai][m]; }
            asm volatile("s_waitcnt lgkmcnt(0)" ::: "memory"); __builtin_amdgcn_s_barrier(); asm volatile("" ::: "memory");
        }
        const int dl = 16 * wc + 4 * fq;
#pragma unroll
        for (int bj = 0; bj < 2; ++bj) {
            const int hh = 2 * u.pn + bj;
            if (hh >= 20 && hh < 24) {
#pragma unroll
                for (int ai = 0; ai < 2; ++ai)
#pragma unroll
                    for (int m = 0; m < 4; ++m) { const int row = row0 + ai * 128 + m * 16, b = row >> 11, s = row & 2047; const float r = rs[ai][m];
                        bf16_t* p = VTD + ((size_t)(b * KVH + (hh - 20)) * HD + dl) * SEQ + s;
#pragma unroll
                        for (int n = 0; n < 2; ++n)
#pragma unroll
                            for (int e = 0; e < 4; ++e) p[(size_t)(64 * n + e) * SEQ] = f2bf(acc_in[ai][bj][m][n][e] * r); }
            } else if (hh == 41) {
                if (wc == 0) {
#pragma unroll
                    for (int ai = 0; ai < 2; ++ai)
#pragma unroll
                        for (int m = 0; m < 4; ++m) { const int row = row0 + ai * 128 + m * 16; *(f32x4*)(WI + (size_t)row * 16 + 4 * fq) = acc_in[ai][bj][m][0] * rs[ai][m]; } }
            } else {
                const bool norm = (hh < 20) || (hh == 40);
                const float* g = (const float*)(ws + WS_GAIN) + (hh < 16 ? 0 : (hh < 20 ? 128 : 256));
                f32x4 g0 = (f32x4){1.f, 1.f, 1.f, 1.f}, g1 = g0;
                if (norm) { g0 = *(const f32x4*)(g + dl); g1 = *(const f32x4*)(g + dl + 64); }
                size_t boff; int ld, cb;
                if (hh < 16) { boff = WS_Q; ld = DM; cb = hh * HD; } else if (hh < 20) { boff = WS_KD; ld = KVH * HD; cb = (hh - 16) * HD; }
                else if (hh < 40) { boff = WS_QI; ld = DM; cb = (hh - 24) * HD; } else { boff = WS_KI; ld = HD; cb = 0; }
                bf16_t* base = (bf16_t*)(ws + boff);
                const float osc = hh < 16 ? QSCALE : 1.0f;
#pragma unroll
                for (int ai = 0; ai < 2; ++ai)
#pragma unroll
                    for (int m = 0; m < 4; ++m) { const int lrow = ai * 128 + wr * 64 + m * 16 + fr, row = u.pm * 256 + lrow, pos = row & 2047;
                        float sc = rs[ai][m];
                        if (norm) { const f32x4 t = *(const LAS f32x4*)(scr + lrow * 8 + bj * 4); sc *= 1.0f / sqrtf(((t[0] + t[1]) + (t[2] + t[3])) * (1.0f / HD) + NORM_EPS); }
                        sc *= osc;
                        const f32x4 c = *(const f32x4*)(ropeC + pos * 64 + dl), sn = *(const f32x4*)(ropeS + pos * 64 + dl);
                        const f32x4 y0 = acc_in[ai][bj][m][0] * g0 * sc, y1 = acc_in[ai][bj][m][1] * g1 * sc;
                        const f32x4 o0 = y0 * c - y1 * sn, o1 = y1 * c + y0 * sn;
                        bf16_t* rp = base + (size_t)row * ld + cb + dl;
                        u32x2 w0, w1; w0.x = pk2(o0[0], o0[1]); w0.y = pk2(o0[2], o0[3]); w1.x = pk2(o1[0], o1[1]); w1.y = pk2(o1[2], o1[3]);
                        *(u32x2*)rp = w0; *(u32x2*)(rp + 64) = w1; }
            }
        }
    }
};

enum { WM_PLAIN = 0, WM_UP = 1, WM_IN = 2 };
__device__ __forceinline__ int colmap(int kind, int np) {
    if (kind == WM_UP) { const int pn = np >> 8, bj = (np >> 7) & 1, q = np & 127; return bj * FF + 128 * pn + q; }
    if (kind == WM_IN) { const int hh = np >> 7, p = np & 127, d = 16 * (p >> 5) + (p & 15) + 64 * ((p >> 4) & 1);
        if (hh < 41) return hh * 128 + d; return (p < 16) ? (5248 + p) : -1; }
    return np;
}
struct WJ { const float* W; const float* gain; bf16_t* WT; int K, N, NP, kind, local; };
__device__ __forceinline__ void tr_load(const WJ& j, int lane, f32x4 (&v)[16]) {
    const int nblk = j.NP / 64, kb = j.local / nblk, nb = j.local - kb * nblk, k0 = 64 * kb, n0 = 64 * nb;
    const int src = colmap(j.kind, n0 + 4 * (lane & 15)), rg = lane >> 4;
    const float* p = j.W + (size_t)(k0 + rg) * j.N + (src >= 0 ? src : 0);
#pragma unroll
    for (int i = 0; i < 16; ++i) { v[i] = *(const f32x4*)(p + (size_t)(4 * i) * j.N); if (src < 0) v[i] = (f32x4){0.f, 0.f, 0.f, 0.f}; }
}
__device__ __forceinline__ void tr_process(const WJ& j, int lane, const f32x4 (&v)[16], LAS float* scr) {
    const int nblk = j.NP / 64, kb = j.local / nblk, nb = j.local - kb * nblk, k0 = 64 * kb, n0 = 64 * nb;
    const int rg = lane >> 4, cg = lane & 15;
    float gl = 1.0f; if (j.gain) gl = j.gain[k0 + lane];
#pragma unroll
    for (int i = 0; i < 16; ++i) { const int kk = 4 * i + rg; const float g = __shfl(gl, kk); LAS float* d = scr + kk * 65 + 4 * cg;
        d[0] = v[i][0] * g; d[1] = v[i][1] * g; d[2] = v[i][2] * g; d[3] = v[i][3] * g; }
    asm volatile("s_waitcnt lgkmcnt(0)" ::: "memory");
    const int c = lane & 7;
#pragma unroll
    for (int jj = 0; jj < 8; ++jj) { const int n = (lane >> 3) + 8 * jj; const LAS float* s = scr + (8 * c) * 65 + n;
        u32x4 o; o.x = pk2(s[0 * 65], s[1 * 65]); o.y = pk2(s[2 * 65], s[3 * 65]); o.z = pk2(s[4 * 65], s[5 * 65]); o.w = pk2(s[6 * 65], s[7 * 65]);
        *(u32x4*)(j.WT + (size_t)(n0 + n) * j.K + k0 + 8 * c) = o; }
    asm volatile("s_waitcnt lgkmcnt(0)" ::: "memory");
}

struct Args {
    const float* x; const float* attn_g; const float* ffn_g; const float* w_qkv; const float* w_o0; const float* w_in;
    const float* qn_g; const float* kn_g; const float* ikn_g; const float* w_o1; const float* w_up; const float* conv_w; const float* conv_b; const float* w_down;
    float* out; unsigned char* ws; int ph_lo, ph_hi;
};

constexpr int WI0 = 32 * 96, WI1 = WI0 + 32 * 32, WI2 = WI1 + 32 * 84, WI3 = WI2 + 32 * 32, WI4 = WI3 + 32 * 176, WI5 = WI4 + 32 * 176, WI6 = WI5 + 88 * 32, WI7 = WI6 + 88 * 32;
__device__ __forceinline__ WJ wj_decode(const Args& a, int it) {
    unsigned char* ws = a.ws; WJ j;
    if (it < WI0)      j = WJ{a.w_qkv, nullptr, (bf16_t*)(ws + WS_WQKV), DM, NQKV, NQKV, WM_PLAIN, it};
    else if (it < WI1) j = WJ{a.w_o0, nullptr, (bf16_t*)(ws + WS_WO0), DM, DM, DM, WM_PLAIN, it - WI0};
    else if (it < WI2) j = WJ{a.w_in, a.attn_g + DM, (bf16_t*)(ws + WS_WIN), DM, NIN, NINP, WM_IN, it - WI1};
    else if (it < WI3) j = WJ{a.w_o1, nullptr, (bf16_t*)(ws + WS_WO1), DM, DM, DM, WM_PLAIN, it - WI2};
    else if (it < WI4) j = WJ{a.w_up, a.ffn_g, (bf16_t*)(ws + WS_WUP), DM, NUP, NUP, WM_UP, it - WI3};
    else if (it < WI5) j = WJ{a.w_up + (size_t)DM * NUP, a.ffn_g + DM, (bf16_t*)(ws + WS_WUP + 44 * MiB), DM, NUP, NUP, WM_UP, it - WI4};
    else if (it < WI6) j = WJ{a.w_down, nullptr, (bf16_t*)(ws + WS_WDN), FF, DM, DM, WM_PLAIN, it - WI5};
    else               j = WJ{a.w_down + (size_t)FF * DM, nullptr, (bf16_t*)(ws + WS_WDN + 22 * MiB), FF, DM, DM, WM_PLAIN, it - WI6};
    return j;
}
__device__ __forceinline__ void prologue_phase(const Args& a, LAS unsigned char* lds, int gw, int ngw, int wave, int lane) {
    unsigned char* ws = a.ws;
    LAS float* scr = (LAS float*)(lds + wave * 16640);
    {
        int it = gw;
        if (it < WI7) {
            f32x4 va[16], vb[16];
            WJ ja = wj_decode(a, it), jb = ja;
            tr_load(ja, lane, va);
            for (;;) {
                int nx = it + ngw; bool hn = nx < WI7;
                if (hn) { jb = wj_decode(a, nx); tr_load(jb, lane, vb); }
                tr_process(ja, lane, va, scr);
                if (!hn) break;
                it = nx; nx = it + ngw; hn = nx < WI7;
                if (hn) { ja = wj_decode(a, nx); tr_load(ja, lane, va); }
                tr_process(jb, lane, vb, scr);
                if (!hn) break;
                it = nx;
            }
        }
    }
    bf16_t* XB = (bf16_t*)(ws + WS_XB);
    for (int m = gw; m < MTOK; m += ngw) {
        const f32x4* xr = (const f32x4*)(a.x + (size_t)m * DM) + lane;
        f32x4 v[8]; float s = 0.f;
#pragma unroll
        for (int j = 0; j < 8; ++j) { v[j] = xr[64 * j]; s += (v[j].x * v[j].x + v[j].y * v[j].y) + (v[j].z * v[j].z + v[j].w * v[j].w); }
        const float rstd = 1.0f / sqrtf(wave_sum(s) * (1.0f / DM) + NORM_EPS);
        u32x2* o8 = (u32x2*)(XB + (size_t)m * DM) + lane;
#pragma unroll
        for (int j = 0; j < 8; ++j) { const f32x4 g = ((const f32x4*)a.attn_g)[lane + 64 * j]; u32x2 w; w.x = pk2(v[j].x * rstd * g.x, v[j].y * rstd * g.y); w.y = pk2(v[j].z * rstd * g.z, v[j].w * rstd * g.w); o8[64 * j] = w; }
    }
    if (gw == 0) { float* gn = (float*)(ws + WS_GAIN); for (int i = lane; i < 128; i += 64) { gn[i] = a.qn_g[i]; gn[128 + i] = a.kn_g[i]; gn[256 + i] = a.ikn_g[i]; } }
    float* rc = (float*)(ws + WS_ROPE); float* rsn = rc + SEQ * 64;
    for (int i = gw * 64 + lane; i < SEQ * 64; i += ngw * 64) {
        const int pos = i >> 6, fi = i & 63;
        const float inv_freq = (float)(1.0 / exp2((double)fi * (2.0 / 128.0) * 13.287712379549449));
        const float ang = (float)pos * inv_freq;
        const double x = (double)ang; const double kq = rint(x * 0.63661977236758134308);
        double r = __builtin_fma(-kq, 1.57079632679489655800e+00, x); r = __builtin_fma(-kq, 6.12323399573676603587e-17, r);
        const double r2 = r * r;
        double sp = -1.0 / 6227020800.0; sp = sp * r2 + 1.0 / 39916800.0; sp = sp * r2 - 1.0 / 362880.0; sp = sp * r2 + 1.0 / 5040.0; sp = sp * r2 - 1.0 / 120.0; sp = sp * r2 + 1.0 / 6.0; const double sv = r - r * r2 * sp;
        double cp = 1.0 / 87178291200.0; cp = cp * r2 - 1.0 / 479001600.0; cp = cp * r2 + 1.0 / 3628800.0; cp = cp * r2 - 1.0 / 40320.0; cp = cp * r2 + 1.0 / 720.0; cp = cp * r2 - 1.0 / 24.0; cp = cp * r2 + 0.5; const double cv = 1.0 - r2 * cp;
        const int q = ((int)kq) & 3;
        const double cs = (q == 0) ? cv : (q == 1) ? -sv : (q == 2) ? -cv : sv;
        const double sn = (q == 0) ? sv : (q == 1) ? cv : (q == 2) ? -sv : -cv;
        rc[i] = (float)cs; rsn[i] = (float)sn;
    }
}

constexpr float SB_EXIT = 220.0f;
__device__ __forceinline__ void sb_attn_phase(const bf16_t* __restrict__ Q, const bf16_t* __restrict__ K, const bf16_t* __restrict__ Vt, bf16_t* __restrict__ O, int gw, int ngw, int lane) {
    const int r = lane & 31, hh = lane >> 5;
    bf16x8 uf[2];
#pragma unroll
    for (int s2 = 0; s2 < 2; ++s2) { u32x4 w;
        unsigned e[8];
#pragma unroll
        for (int j = 0; j < 8; ++j) { const int key = 16 * s2 + 8 * (j >> 2) + 4 * hh + (j & 3); e[j] = (key >= r) ? 0x3f80u : 0u; }
        w.x = e[0] | (e[1] << 16); w.y = e[2] | (e[3] << 16); w.z = e[4] | (e[5] << 16); w.w = e[6] | (e[7] << 16); uf[s2] = __builtin_bit_cast(bf16x8, w); }
    for (int unit = gw; unit < BATCH * NH * 64; unit += ngw) {
        const int bh = unit >> 6, qt = 63 - (unit & 63), b = bh >> 4, h = bh & 15, q0 = qt * 32;
        const bf16_t* qp = Q + (size_t)(b * SEQ + q0 + r) * DM + h * HD + 8 * hh;
        bf16x8 qf[8];
#pragma unroll
        for (int s = 0; s < 8; ++s) qf[s] = *(const bf16x8*)(qp + 16 * s);
        f32x16 o[4];
#pragma unroll
        for (int d = 0; d < 4; ++d) o[d] = f32x16{};
        float carry = 0.f;
        const bf16_t* kbase = K + (size_t)(b * SEQ + r) * DM + h * HD + 8 * hh;
        const bf16_t* vbase = Vt + ((size_t)bh * HD + r) * SEQ + 4 * hh;
        for (int kt = qt; kt >= 0; --kt) {
            const int key0 = kt * 32;
            const bf16_t* kp = kbase + (size_t)key0 * DM;
            bf16x8 kf[8];
#pragma unroll
            for (int s = 0; s < 8; ++s) kf[s] = *(const bf16x8*)(kp + 16 * s);
            bf16x8 vf[4][2];
#pragma unroll
            for (int d = 0; d < 4; ++d)
#pragma unroll
                for (int s2 = 0; s2 < 2; ++s2) { const bf16_t* vp = vbase + (size_t)(32 * d) * SEQ + key0 + 16 * s2;
                    const s16x4 lo = *(const s16x4*)vp, hi = *(const s16x4*)(vp + 8);
                    vf[d][s2] = (bf16x8){lo[0], lo[1], lo[2], lo[3], hi[0], hi[1], hi[2], hi[3]}; }
            f32x16 p = f32x16{};
#pragma unroll
            for (int s = 0; s < 8; ++s) p = __builtin_amdgcn_mfma_f32_32x32x16_bf16(kf[s], qf[s], p, 0, 0, 0);
            const bool diag = (kt == qt);
            f32x16 sp;
#pragma unroll
            for (int i = 0; i < 16; ++i) { const float z = p[i]; float v = fmaxf(z, 0.f) + __builtin_amdgcn_logf(1.0f + __builtin_amdgcn_exp2f(-fabsf(z)));
                if (diag && crow(i, hh) >= r) v = 0.f; sp[i] = v; }
            f32x16 c;
#pragma unroll
            for (int i = 0; i < 16; ++i) c[i] = carry;
            c = __builtin_amdgcn_mfma_f32_32x32x16_bf16(uf[0], pack8(sp, 0), c, 0, 0, 0);
            c = __builtin_amdgcn_mfma_f32_32x32x16_bf16(uf[1], pack8(sp, 8), c, 0, 0, 0);
            f32x16 av;
#pragma unroll
            for (int i = 0; i < 16; ++i) { float v = __builtin_amdgcn_exp2f(p[i] - c[i]); if (diag && crow(i, hh) >= r) v = 0.f; av[i] = v; }
            carry = swap_max(c[0]);
            const bf16x8 pa0 = pack8(av, 0), pa1 = pack8(av, 8);
#pragma unroll
            for (int d = 0; d < 4; ++d) { o[d] = __builtin_amdgcn_mfma_f32_32x32x16_bf16(vf[d][0], pa0, o[d], 0, 0, 0); o[d] = __builtin_amdgcn_mfma_f32_32x32x16_bf16(vf[d][1], pa1, o[d], 0, 0, 0); }
            if (__all(carry > SB_EXIT)) break;
        }
        bf16_t* op = O + (size_t)(b * SEQ + q0 + r) * DM + h * HD + 4 * hh;
#pragma unroll
        for (int d = 0; d < 4; ++d)
#pragma unroll
            for (int g = 0; g < 4; ++g) { u32x2 w; w.x = pk2(o[d][4 * g], o[d][4 * g + 1]); w.y = pk2(o[d][4 * g + 2], o[d][4 * g + 3]); *(u32x2*)(op + 32 * d + 8 * g) = w; }
    }
}

__device__ __forceinline__ void conv_phase(const bf16_t* __restrict__ U, const float* __restrict__ cw, const float* __restrict__ cb, bf16_t* __restrict__ ACT, int gtid, int nthreads) {
    constexpr int C8 = FF / 8;
    for (int it = gtid; it < MTOK * C8; it += nthreads) {
        const int row = it / C8, c8 = it - row * C8, j0 = c8 * 8, pn = j0 >> 7, q = j0 & 127, s = row & 2047;
        const bf16_t* ug = U + (size_t)row * NUP + 256 * pn + q;
        float cgv[2][8];
#pragma unroll
        for (int half = 0; half < 2; ++half) {
            const bf16_t* up = ug + half * 128; const int cc = half * FF + j0;
            const f32x4 b0 = *(const f32x4*)(cb + cc), b1 = *(const f32x4*)(cb + cc + 4);
            float accv[8] = {b0[0], b0[1], b0[2], b0[3], b1[0], b1[1], b1[2], b1[3]};
#pragma unroll
            for (int tap = 0; tap < 3; ++tap) { const int back = 2 - tap;
                if (s >= back) { const u32x4 w = *(const u32x4*)(up - (size_t)back * NUP);
                    const f32x4 w0 = *(const f32x4*)(cw + (size_t)tap * NUP + cc), w1 = *(const f32x4*)(cw + (size_t)tap * NUP + cc + 4);
                    accv[0] += __uint_as_float(w.x << 16) * w0[0]; accv[1] += __uint_as_float(w.x & 0xffff0000u) * w0[1];
                    accv[2] += __uint_as_float(w.y << 16) * w0[2]; accv[3] += __uint_as_float(w.y & 0xffff0000u) * w0[3];
                    accv[4] += __uint_as_float(w.z << 16) * w1[0]; accv[5] += __uint_as_float(w.z & 0xffff0000u) * w1[1];
                    accv[6] += __uint_as_float(w.w << 16) * w1[2]; accv[7] += __uint_as_float(w.w & 0xffff0000u) * w1[3]; } }
#pragma unroll
            for (int e = 0; e < 8; ++e) cgv[half][e] = accv[e];
        }
        float a8[8];
#pragma unroll
        for (int e = 0; e < 8; ++e) { const float gx = cgv[0][e]; a8[e] = gx / (1.0f + __expf(-gx)) * cgv[1][e]; }
        u32x4 w; w.x = pk2(a8[0], a8[1]); w.y = pk2(a8[2], a8[3]); w.z = pk2(a8[4], a8[5]); w.w = pk2(a8[6], a8[7]);
        *(u32x4*)(ACT + (size_t)row * FF + j0) = w;
    }
}

__device__ __forceinline__ unsigned fmap(float f) { const unsigned u = __float_as_uint(f); return (u & 0x80000000u) ? ~u : (u | 0x80000000u); }
__device__ __forceinline__ void indexer_unit(const bf16_t* __restrict__ QI, const bf16_t* __restrict__ KI, const float* __restrict__ WI, unsigned* __restrict__ MASK, LAS float* sc, int b, int t0, int wave, int lane) {
    const int r = lane & 31, hh = lane >> 5, ql_r = r >> 4, head_r = r & 15;
    const int tw = t0 + 2 * wave;
    const bf16_t* ap = QI + (size_t)(b * SEQ + tw + ql_r) * DM + head_r * HD + 8 * hh;
    bf16x8 af[8];
#pragma unroll
    for (int s = 0; s < 8; ++s) af[s] = *(const bf16x8*)(ap + 16 * s);
    float wv[16];
#pragma unroll
    for (int i = 0; i < 16; ++i) { const int rw = crow(i, hh); wv[i] = WI[(size_t)(b * SEQ + tw + (rw >> 4)) * 16 + (rw & 15)]; }
    const int nkt = (t0 + 16 + 31) >> 5;
    const bf16_t* kb = KI + (size_t)(b * SEQ + r) * HD + 8 * hh;
    LAS float* myrow = sc + (2 * wave + hh) * SEQ;
    const int tq = tw + hh;
    for (int kt = 0; kt < nkt; ++kt) {
        const bf16_t* kp = kb + (size_t)kt * 32 * HD;
        bf16x8 bfr[8];
#pragma unroll
        for (int s = 0; s < 8; ++s) bfr[s] = *(const bf16x8*)(kp + 16 * s);
        f32x16 c = f32x16{};
#pragma unroll
        for (int s = 0; s < 8; ++s) c = __builtin_amdgcn_mfma_f32_32x32x16_bf16(af[s], bfr[s], c, 0, 0, 0);
        float s0 = 0.f, s1 = 0.f;
#pragma unroll
        for (int i = 0; i < 8; ++i) { s0 += wv[i] * fmaxf(c[i], 0.f); s1 += wv[i + 8] * fmaxf(c[i + 8], 0.f); }
        const float t0s = swap_sum(s0), t1s = swap_sum(s1);
        const int key = kt * 32 + r;
        float v = (hh ? t1s : t0s) + 0.0f;
        if (key > tq) v = -INFINITY;
        myrow[key] = v;
    }
    asm volatile("s_waitcnt lgkmcnt(0)" ::: "memory");
    for (int ql = 0; ql < 2; ++ql) {
        const int t = tw + ql, n = t + 1;
        unsigned* mrow = MASK + (size_t)(b * SEQ + t) * 64;
        if (n <= TOPK) {
            const int key0 = 32 * lane; unsigned w;
            if (key0 + 31 <= t) w = 0xffffffffu; else if (key0 > t) w = 0u; else w = (1u << (t - key0 + 1)) - 1u;
            mrow[lane] = w;
        } else {
            const LAS float* row = sc + (2 * wave + ql) * SEQ;
            unsigned uv[32];
#pragma unroll
            for (int e = 0; e < 32; ++e) { const int key = e * 64 + lane; uv[e] = (key < n) ? fmap(row[key]) : 0x007fffffu; }
            unsigned prefix = 0u;
            for (int bit = 31; bit >= 0; --bit) {
                const unsigned cand = prefix | (1u << bit); int cnt = 0;
#pragma unroll
                for (int e = 0; e < 32; ++e) cnt += __popcll(__ballot(uv[e] >= cand));
                if (cnt >= TOPK) prefix = cand;
            }
            int cgt = 0;
#pragma unroll
            for (int e = 0; e < 32; ++e) cgt += __popcll(__ballot(uv[e] > prefix));
            const int need = TOPK - cgt; int running = 0;
            const unsigned long long ltm = (1ull << lane) - 1ull;
            unsigned long long keep = 0ull;
#pragma unroll
            for (int e = 0; e < 32; ++e) {
                const unsigned long long eq = __ballot(uv[e] == prefix);
                const bool sel = (uv[e] > prefix) || (uv[e] == prefix && (running + __popcll(eq & ltm)) < need);
                const unsigned long long m64 = __ballot(sel);
                running += __popcll(eq);
                if (lane == e) keep = m64;
            }
            if (lane < 32) *(unsigned long long*)(mrow + 2 * lane) = keep;
        }
    }
    asm volatile("s_waitcnt lgkmcnt(0)" ::: "memory");
}

__device__ __forceinline__ void dsa_attn_unit(const bf16_t* __restrict__ QD, const bf16_t* __restrict__ KD, const bf16_t* __restrict__ VTD, const unsigned* __restrict__ MASK, bf16_t* __restrict__ O,
                                              int b, int g, int h, int q0, int lane) {
    const int r = lane & 31, hh = lane >> 5;
    const bf16_t* qp = QD + (size_t)(b * SEQ + q0 + r) * DM + h * HD + 8 * hh;
    bf16x8 qf[8];
#pragma unroll
    for (int s = 0; s < 8; ++s) qf[s] = *(const bf16x8*)(qp + 16 * s);
    f32x16 o[4];
#pragma unroll
    for (int d = 0; d < 4; ++d) o[d] = f32x16{};
    float mrun = -1e30f, lrun = 0.f;
    const bf16_t* kbase = KD + (size_t)(b * SEQ + r) * (KVH * HD) + g * HD + 8 * hh;
    const bf16_t* vbase = VTD + ((size_t)(b * KVH + g) * HD + r) * SEQ + 4 * hh;
    const unsigned* mrow = MASK + (size_t)(b * SEQ + q0 + r) * 64;
    const int nkt = (q0 + 32) >> 5;
    for (int kt = 0; kt < nkt; ++kt) {
        const int key0 = kt * 32;
        const bf16_t* kp = kbase + (size_t)key0 * (KVH * HD);
        bf16x8 kf[8];
#pragma unroll
        for (int s = 0; s < 8; ++s) kf[s] = *(const bf16x8*)(kp + 16 * s);
        const unsigned mw = mrow[kt];
        bf16x8 vf[4][2];
#pragma unroll
        for (int d = 0; d < 4; ++d)
#pragma unroll
            for (int s2 = 0; s2 < 2; ++s2) { const bf16_t* vp = vbase + (size_t)(32 * d) * SEQ + key0 + 16 * s2;
                const s16x4 lo = *(const s16x4*)vp, hi = *(const s16x4*)(vp + 8);
                vf[d][s2] = (bf16x8){lo[0], lo[1], lo[2], lo[3], hi[0], hi[1], hi[2], hi[3]}; }
        f32x16 p = f32x16{};
#pragma unroll
        for (int s = 0; s < 8; ++s) p = __builtin_amdgcn_mfma_f32_32x32x16_bf16(kf[s], qf[s], p, 0, 0, 0);
        float tmax = -1e30f;
#pragma unroll
        for (int i = 0; i < 16; ++i) { const bool valid = (mw >> crow(i, hh)) & 1u; tmax = fmaxf(tmax, valid ? p[i] : -1e30f); }
        tmax = swap_max(tmax);
        const float mnew = fmaxf(mrun, tmax), alpha = __builtin_amdgcn_exp2f(mrun - mnew);
        float ls = 0.f; f32x16 pe;
#pragma unroll
        for (int i = 0; i < 16; ++i) { const bool valid = (mw >> crow(i, hh)) & 1u; const float e = valid ? __builtin_amdgcn_exp2f(p[i] - mnew) : 0.f; pe[i] = e; ls += e; }
        lrun = lrun * alpha + ls; mrun = mnew;
#pragma unroll
        for (int d = 0; d < 4; ++d)
#pragma unroll
            for (int i = 0; i < 16; ++i) o[d][i] *= alpha;
        const bf16x8 pa0 = pack8(pe, 0), pa1 = pack8(pe, 8);
#pragma unroll
        for (int d = 0; d < 4; ++d) { o[d] = __builtin_amdgcn_mfma_f32_32x32x16_bf16(vf[d][0], pa0, o[d], 0, 0, 0); o[d] = __builtin_amdgcn_mfma_f32_32x32x16_bf16(vf[d][1], pa1, o[d], 0, 0, 0); }
    }
    const float linv = 1.0f / swap_sum(lrun);
    bf16_t* op = O + (size_t)(b * SEQ + q0 + r) * DM + h * HD + 4 * hh;
#pragma unroll
    for (int d = 0; d < 4; ++d)
#pragma unroll
        for (int gq = 0; gq < 4; ++gq) { u32x2 w; w.x = pk2(o[d][4 * gq] * linv, o[d][4 * gq + 1] * linv); w.y = pk2(o[d][4 * gq + 2] * linv, o[d][4 * gq + 3] * linv); *(u32x2*)(op + 32 * d + 8 * gq) = w; }
}


constexpr int KSTR = 272, VSTR = 136, KTILE_B = 64 * KSTR, VTILE_B = 128 * VSTR, KVBUF_B = KTILE_B + VTILE_B;
struct KVStage {
    u32x4 k[2], v[2];
    __device__ __forceinline__ void load(const unsigned char* kg, size_t kstride, const unsigned char* vg, size_t vstride, int tid) {
#pragma unroll
        for (int i = 0; i < 2; ++i) { const int c = tid + 512 * i; k[i] = *(const u32x4*)(kg + (size_t)(c >> 4) * kstride + (c & 15) * 16); v[i] = *(const u32x4*)(vg + (size_t)(c >> 3) * vstride + (c & 7) * 16); }
    }
    __device__ __forceinline__ void store(LAS unsigned char* buf, int tid) const {
#pragma unroll
        for (int i = 0; i < 2; ++i) { const int c = tid + 512 * i;
            *(LAS u32x4*)(buf + (c >> 4) * KSTR + (c & 15) * 16) = k[i];
            LAS unsigned char* vp = buf + KTILE_B + (c >> 3) * VSTR + (c & 7) * 16;
            *(LAS u32x2*)vp = (u32x2){v[i].x, v[i].y}; *(LAS u32x2*)(vp + 8) = (u32x2){v[i].z, v[i].w}; }
    }
};

__device__ __forceinline__ void dsa_attn_block(const bf16_t* __restrict__ QD, const bf16_t* __restrict__ KD, const bf16_t* __restrict__ VTD, const unsigned* __restrict__ MASK, bf16_t* __restrict__ O,
                                               LAS unsigned char* lds, int b, int g, int qb64, int wave, int lane, int tid) {
    const int r = lane & 31, hh = lane >> 5, h = 4 * g + (wave & 3), q0 = 64 * qb64 + 32 * (wave >> 2);
    LAS unsigned char* qlds = lds + 2 * KVBUF_B + wave * (32 * KSTR);
    { const unsigned char* qg = (const unsigned char*)(QD + (size_t)(b * SEQ + q0) * DM + h * HD);
        u32x4 t[8];
#pragma unroll
        for (int i = 0; i < 8; ++i) { const int c = lane + 64 * i; t[i] = *(const u32x4*)(qg + (size_t)(c >> 4) * (DM * 2) + (c & 15) * 16); }
#pragma unroll
        for (int i = 0; i < 8; ++i) { const int c = lane + 64 * i; *(LAS u32x4*)(qlds + (c >> 4) * KSTR + (c & 15) * 16) = t[i]; }
        asm volatile("s_waitcnt lgkmcnt(0)" ::: "memory"); }
    const LAS unsigned char* qfp = qlds + r * KSTR + 16 * hh;
    f32x16 o[4];
#pragma unroll
    for (int d = 0; d < 4; ++d) o[d] = f32x16{};
    float mrun = -1e30f, lrun = 0.f;
    const unsigned char* kg = (const unsigned char*)(KD + (size_t)(b * SEQ) * (KVH * HD) + g * HD);
    const unsigned char* vg = (const unsigned char*)(VTD + (size_t)(b * KVH + g) * HD * SEQ);
    const unsigned long long* mrow = (const unsigned long long*)(MASK + (size_t)(b * SEQ + q0 + r) * 64);
    KVStage sA, sB;
#define MA_LOAD(ST, t) ST.load(kg + (size_t)(t) * 64 * (KVH * HD * 2), KVH * HD * 2, vg + (size_t)(t) * 64 * 2, SEQ * 2, tid)
    MA_LOAD(sA, 0);
    sA.store(lds, tid);
    asm volatile("s_waitcnt lgkmcnt(0)" ::: "memory"); __builtin_amdgcn_s_barrier(); asm volatile("" ::: "memory");
    if (qb64 >= 1) MA_LOAD(sA, 1);
    if (qb64 >= 2) MA_LOAD(sB, 2);
    for (int kt = 0; kt <= qb64; ++kt) {
        LAS unsigned char* buf = lds + (kt & 1) * KVBUF_B;
        const unsigned long long mw = mrow[kt];
        const bool two = (64 * kt + 32) <= q0 + 31;
        f32x16 p0 = f32x16{}, p1 = f32x16{};
        { const LAS unsigned char* kp = buf + r * KSTR + 16 * hh;
            bf16x8 qf[8];
#pragma unroll
            for (int s = 0; s < 8; ++s) qf[s] = *(const LAS bf16x8*)(qfp + 32 * s);
#pragma unroll
            for (int s = 0; s < 8; ++s) p0 = __builtin_amdgcn_mfma_f32_32x32x16_bf16(*(const LAS bf16x8*)(kp + 32 * s), qf[s], p0, 0, 0, 0);
            if (two) {
#pragma unroll
                for (int s = 0; s < 8; ++s) p1 = __builtin_amdgcn_mfma_f32_32x32x16_bf16(*(const LAS bf16x8*)(kp + 32 * KSTR + 32 * s), qf[s], p1, 0, 0, 0); } }
        const unsigned m0 = ((unsigned)mw) >> (4 * hh), m1 = two ? (((unsigned)(mw >> 32)) >> (4 * hh)) : 0u;
        float tmax = -1e30f;
#pragma unroll
        for (int i = 0; i < 16; ++i) { const int kb = crow(i, 0); tmax = fmaxf(tmax, ((m0 >> kb) & 1u) ? p0[i] : -1e30f); tmax = fmaxf(tmax, ((m1 >> kb) & 1u) ? p1[i] : -1e30f); }
        tmax = swap_max(tmax);
        const float mnew = fmaxf(mrun, tmax), alpha = __builtin_amdgcn_exp2f(mrun - mnew);
        float ls = 0.f;
#pragma unroll
        for (int i = 0; i < 16; ++i) { const int kb = crow(i, 0);
            const float e0 = ((m0 >> kb) & 1u) ? __builtin_amdgcn_exp2f(p0[i] - mnew) : 0.f, e1 = ((m1 >> kb) & 1u) ? __builtin_amdgcn_exp2f(p1[i] - mnew) : 0.f;
            p0[i] = e0; p1[i] = e1; ls += e0 + e1; }
        lrun = lrun * alpha + ls; mrun = mnew;
#pragma unroll
        for (int d = 0; d < 4; ++d)
#pragma unroll
            for (int i = 0; i < 16; ++i) o[d][i] *= alpha;
        const bf16x8 pa0 = pack8(p0, 0), pa1 = pack8(p0, 8), pa2 = pack8(p1, 0), pa3 = pack8(p1, 8);
        const LAS unsigned char* vb = buf + KTILE_B + r * VSTR + 8 * hh;
#pragma unroll
        for (int d = 0; d < 4; ++d) {
            const LAS unsigned char* vp = vb + 32 * d * VSTR;
#define VFRAG(ks) ({ const s16x4 lo_ = *(const LAS s16x4*)(vp + 32 * (ks)), hi_ = *(const LAS s16x4*)(vp + 32 * (ks) + 16); (bf16x8){lo_[0], lo_[1], lo_[2], lo_[3], hi_[0], hi_[1], hi_[2], hi_[3]}; })
            o[d] = __builtin_amdgcn_mfma_f32_32x32x16_bf16(VFRAG(0), pa0, o[d], 0, 0, 0);
            o[d] = __builtin_amdgcn_mfma_f32_32x32x16_bf16(VFRAG(1), pa1, o[d], 0, 0, 0);
            if (two) { o[d] = __builtin_amdgcn_mfma_f32_32x32x16_bf16(VFRAG(2), pa2, o[d], 0, 0, 0);
                       o[d] = __builtin_amdgcn_mfma_f32_32x32x16_bf16(VFRAG(3), pa3, o[d], 0, 0, 0); }
#undef VFRAG
        }
        if (kt & 1) { if (kt + 1 <= qb64) sB.store(lds + ((kt + 1) & 1) * KVBUF_B, tid); if (kt + 3 <= qb64) MA_LOAD(sB, kt + 3); }
        else        { if (kt + 1 <= qb64) sA.store(lds + ((kt + 1) & 1) * KVBUF_B, tid); if (kt + 3 <= qb64) MA_LOAD(sA, kt + 3); }
        asm volatile("s_waitcnt lgkmcnt(0)" ::: "memory"); __builtin_amdgcn_s_barrier(); asm volatile("" ::: "memory");
    }
#undef MA_LOAD
    asm volatile("s_waitcnt vmcnt(0)" ::: "memory");
    const float linv = 1.0f / swap_sum(lrun);
    bf16_t* op = O + (size_t)(b * SEQ + q0 + r) * DM + h * HD + 4 * hh;
#pragma unroll
    for (int d = 0; d < 4; ++d)
#pragma unroll
        for (int gq = 0; gq < 4; ++gq) { u32x2 w; w.x = pk2(o[d][4 * gq] * linv, o[d][4 * gq + 1] * linv); w.y = pk2(o[d][4 * gq + 2] * linv, o[d][4 * gq + 3] * linv); *(u32x2*)(op + 32 * d + 8 * gq) = w; }
}


__device__ __forceinline__ void sb_subtile(const LAS unsigned char* kp, const LAS unsigned char* vb, const bf16x8 (&qf)[8], const bf16x8 (&uf)[2], f32x16 (&o)[4], float& carry, bool diag, int rm) {
    f32x16 p = f32x16{};
#pragma unroll
    for (int s = 0; s < 8; ++s) p = __builtin_amdgcn_mfma_f32_32x32x16_bf16(*(const LAS bf16x8*)(kp + 32 * s), qf[s], p, 0, 0, 0);
    f32x16 sp;
#pragma unroll
    for (int i = 0; i < 16; ++i) { const float z = p[i]; float v = fmaxf(z, 0.f) + __builtin_amdgcn_logf(1.0f + __builtin_amdgcn_exp2f(-fabsf(z)));
        if (diag && crow(i, 0) >= rm) v = 0.f; sp[i] = v; }
    f32x16 c;
#pragma unroll
    for (int i = 0; i < 16; ++i) c[i] = carry;
    c = __builtin_amdgcn_mfma_f32_32x32x16_bf16(uf[0], pack8(sp, 0), c, 0, 0, 0);
    c = __builtin_amdgcn_mfma_f32_32x32x16_bf16(uf[1], pack8(sp, 8), c, 0, 0, 0);
#pragma unroll
    for (int i = 0; i < 16; ++i) { float v = __builtin_amdgcn_exp2f(p[i] - c[i]); if (diag && crow(i, 0) >= rm) v = 0.f; p[i] = v; }
    carry = swap_max(c[0]);
    const bf16x8 pa0 = pack8(p, 0), pa1 = pack8(p, 8);
#pragma unroll
    for (int d = 0; d < 4; ++d) { const LAS unsigned char* vp = vb + 32 * d * VSTR;
        const s16x4 l0 = *(const LAS s16x4*)vp, h0 = *(const LAS s16x4*)(vp + 16), l1 = *(const LAS s16x4*)(vp + 32), h1 = *(const LAS s16x4*)(vp + 48);
        o[d] = __builtin_amdgcn_mfma_f32_32x32x16_bf16((bf16x8){l0[0], l0[1], l0[2], l0[3], h0[0], h0[1], h0[2], h0[3]}, pa0, o[d], 0, 0, 0);
        o[d] = __builtin_amdgcn_mfma_f32_32x32x16_bf16((bf16x8){l1[0], l1[1], l1[2], l1[3], h1[0], h1[1], h1[2], h1[3]}, pa1, o[d], 0, 0, 0); }
}
__device__ __forceinline__ void sb_attn_block(const bf16_t* __restrict__ Q, const bf16_t* __restrict__ K, const bf16_t* __restrict__ Vt, bf16_t* __restrict__ O, LAS unsigned char* lds,
                                              int bh, int qblk, int wave, int lane, int tid) {
    const int r = lane & 31, hh = lane >> 5, b = bh >> 4, h = bh & 15, q0 = qblk * 256 + wave * 32, rm = r - 4 * hh;
    bf16x8 uf[2];
#pragma unroll
    for (int s2 = 0; s2 < 2; ++s2) { u32x4 w; unsigned e[8];
#pragma unroll
        for (int j = 0; j < 8; ++j) { const int key = 16 * s2 + 8 * (j >> 2) + 4 * hh + (j & 3); e[j] = (key >= r) ? 0x3f80u : 0u; }
        w.x = e[0] | (e[1] << 16); w.y = e[2] | (e[3] << 16); w.z = e[4] | (e[5] << 16); w.w = e[6] | (e[7] << 16); uf[s2] = __builtin_bit_cast(bf16x8, w); }
    const bf16_t* qp = Q + (size_t)(b * SEQ + q0 + r) * DM + h * HD + 8 * hh;
    bf16x8 qf[8];
#pragma unroll
    for (int s = 0; s < 8; ++s) qf[s] = *(const bf16x8*)(qp + 16 * s);
    f32x16 o[4];
#pragma unroll
    for (int d = 0; d < 4; ++d) o[d] = f32x16{};
    float carry = 0.f; bool done = false;
    const unsigned char* kg = (const unsigned char*)(K + (size_t)(b * SEQ) * DM + h * HD);
    const unsigned char* vg = (const unsigned char*)(Vt + (size_t)bh * HD * SEQ);
    volatile LAS unsigned* flags = (volatile LAS unsigned*)(lds + 2 * KVBUF_B);
    const int ktop = qblk * 4 + 3;
    KVStage sA, sB;
#define SB_LOAD(ST, t) ST.load(kg + (size_t)(t) * 64 * (DM * 2), DM * 2, vg + (size_t)(t) * 64 * 2, SEQ * 2, tid)
    SB_LOAD(sA, ktop);
    sA.store(lds, tid);
    asm volatile("s_waitcnt lgkmcnt(0)" ::: "memory"); __builtin_amdgcn_s_barrier(); asm volatile("" ::: "memory");
    if (ktop >= 1) SB_LOAD(sA, ktop - 1);
    if (ktop >= 2) SB_LOAD(sB, ktop - 2);
    int kt = ktop, it = 0; bool fin = false;
#define SB_STEP(ST) do { \
        const LAS unsigned char* buf = lds + (it & 1) * KVBUF_B; \
        if (!done) { \
            _Pragma("unroll") for (int j = 1; j >= 0; --j) { const int key0 = 64 * kt + 32 * j; \
                if (!done && key0 <= q0) { \
                    sb_subtile(buf + (32 * j + r) * KSTR + 16 * hh, buf + KTILE_B + r * VSTR + 64 * j + 8 * hh, qf, uf, o, carry, key0 == q0, rm); \
                    if (__all(carry > SB_EXIT)) done = true; } } } \
        if (kt >= 1) ST.store(lds + ((it + 1) & 1) * KVBUF_B, tid); \
        if (kt >= 3) SB_LOAD(ST, kt - 3); \
        if (lane == 0) flags[wave] = done ? 1u : 0u; \
        asm volatile("s_waitcnt lgkmcnt(0)" ::: "memory"); __builtin_amdgcn_s_barrier(); asm volatile("" ::: "memory"); \
        if (kt == 0) fin = true; \
        else { unsigned nd = 0; _Pragma("unroll") for (int w = 0; w < 8; ++w) nd += flags[w]; if (nd == 8u) fin = true; } \
        --kt; ++it; } while (0)
    for (;;) { SB_STEP(sA); if (fin) break; SB_STEP(sB); if (fin) break; }
#undef SB_STEP
#undef SB_LOAD
    asm volatile("s_waitcnt vmcnt(0)" ::: "memory");
    bf16_t* op = O + (size_t)(b * SEQ + q0 + r) * DM + h * HD + 4 * hh;
#pragma unroll
    for (int d = 0; d < 4; ++d)
#pragma unroll
        for (int g = 0; g < 4; ++g) { u32x2 w; w.x = pk2(o[d][4 * g], o[d][4 * g + 1]); w.y = pk2(o[d][4 * g + 2], o[d][4 * g + 3]); *(u32x2*)(op + 32 * d + 8 * g) = w; }
}


__device__ __forceinline__ unsigned wave_total_u32(unsigned v) {
    v += (unsigned)__builtin_amdgcn_update_dpp(0, (int)v, 0x111, 0xf, 0xf, true);
    v += (unsigned)__builtin_amdgcn_update_dpp(0, (int)v, 0x112, 0xf, 0xf, true);
    v += (unsigned)__builtin_amdgcn_update_dpp(0, (int)v, 0x114, 0xf, 0xf, true);
    v += (unsigned)__builtin_amdgcn_update_dpp(0, (int)v, 0x118, 0xf, 0xf, true);
    v += (unsigned)__builtin_amdgcn_update_dpp(0, (int)v, 0x142, 0xa, 0xf, false);
    v += (unsigned)__builtin_amdgcn_update_dpp(0, (int)v, 0x143, 0xc, 0xf, false);
    return (unsigned)__builtin_amdgcn_readlane((int)v, 63);
}
__device__ __forceinline__ void causal_mask_row(unsigned* mrow, int t, int lane) {
    const int key0 = 32 * lane; unsigned w;
    if (key0 + 31 <= t) w = 0xffffffffu; else if (key0 > t) w = 0u; else w = (1u << (t - key0 + 1)) - 1u;
    mrow[lane] = w;
}
__device__ __forceinline__ void write_topk_mask(const unsigned (&uv)[32], unsigned prefix, unsigned* mrow, int lane) {
    int cgt = 0;
#pragma unroll
    for (int e = 0; e < 32; ++e) cgt += __popcll(__ballot(uv[e] > prefix));
    const int need = TOPK - cgt; int running = 0;
    const unsigned long long ltm = (1ull << lane) - 1ull;
    unsigned long long keep = 0ull;
#pragma unroll
    for (int e = 0; e < 32; ++e) {
        const unsigned long long eq = __ballot(uv[e] == prefix);
        const bool sel = (uv[e] > prefix) || (uv[e] == prefix && (running + __popcll(eq & ltm)) < need);
        const unsigned long long m64 = __ballot(sel);
        running += __popcll(eq);
        if (lane == e) keep = m64;
    }
    if (lane < 32) *(unsigned long long*)(mrow + 2 * lane) = keep;
}
__device__ __forceinline__ void select_two(const float* rowa, const float* rowb, int ta, unsigned* mrowa, unsigned* mrowb, int lane) {
    const int tb = ta + 1, na = ta + 1, nb = tb + 1;
    if (nb <= TOPK) { causal_mask_row(mrowa, ta, lane); causal_mask_row(mrowb, tb, lane); return; }
    float fa[32], fb[32];
#pragma unroll
    for (int e = 0; e < 32; ++e) { fa[e] = __builtin_nontemporal_load(rowa + e * 64 + lane); fb[e] = __builtin_nontemporal_load(rowb + e * 64 + lane); }
    unsigned ua[32], ub[32];
#pragma unroll
    for (int e = 0; e < 32; ++e) { const int key = e * 64 + lane; const unsigned ma = fmap(fa[e]), mb = fmap(fb[e]); ua[e] = (key < na) ? ma : 0x007fffffu; ub[e] = (key < nb) ? mb : 0x007fffffu; }
    unsigned pa = 0u, pb = 0u; bool da = false, db = false;
    for (int bit = 31; bit >= 0; --bit) {
        const unsigned ca = pa | (1u << bit), cb = pb | (1u << bit);
        unsigned na_ = 0u, nb_ = 0u;
#pragma unroll
        for (int e = 0; e < 32; ++e) { na_ += (ua[e] >= ca) ? 1u : 0u; nb_ += (ub[e] >= cb) ? 1u : 0u; }
        const unsigned tota = wave_total_u32(na_), totb = wave_total_u32(nb_);
        if (!da && tota >= (unsigned)TOPK) { pa = ca; if (tota == (unsigned)TOPK) da = true; }
        if (!db && totb >= (unsigned)TOPK) { pb = cb; if (totb == (unsigned)TOPK) db = true; }
        if (da && db) break;
    }
    if (na <= TOPK) causal_mask_row(mrowa, ta, lane); else write_topk_mask(ua, pa, mrowa, lane);
    write_topk_mask(ub, pb, mrowb, lane);
}

struct KiStage {
    u32x4 k[4];
    __device__ __forceinline__ void load(const unsigned char* kg, int tid) {
#pragma unroll
        for (int i = 0; i < 4; ++i) { const int c = tid + 512 * i; k[i] = *(const u32x4*)(kg + (size_t)(c >> 4) * (HD * 2) + (c & 15) * 16); }
    }
    __device__ __forceinline__ void store(LAS unsigned char* buf, int tid) const {
#pragma unroll
        for (int i = 0; i < 4; ++i) { const int c = tid + 512 * i; *(LAS u32x4*)(buf + (c >> 4) * KSTR + (c & 15) * 16) = k[i]; }
    }
};
constexpr int KIBUF_B = 128 * KSTR;
__device__ __forceinline__ void indexer_block(const bf16_t* __restrict__ QI, const bf16_t* __restrict__ KI, const float* __restrict__ WI, unsigned* __restrict__ MASK, float* __restrict__ SC,
                                              LAS unsigned char* lds, int b, int qb16, int wave, int lane, int tid) {
    const int r = lane & 31, hh = lane >> 5, t0 = 16 * qb16, tw = t0 + 2 * wave;
    const bf16_t* ap = QI + (size_t)(b * SEQ + tw + (r >> 4)) * DM + (r & 15) * HD + 8 * hh;
    bf16x8 af[8];
#pragma unroll
    for (int s = 0; s < 8; ++s) af[s] = *(const bf16x8*)(ap + 16 * s);
    float wv[16];
#pragma unroll
    for (int i = 0; i < 16; ++i) { const int rw = crow(i, hh); wv[i] = WI[(size_t)(b * SEQ + tw + (rw >> 4)) * 16 + (rw & 15)]; }
    float* myrow = SC + ((size_t)(b * 128 + qb16) * 16 + 2 * wave + hh) * SEQ;
    const int tq = tw + hh, ntile = (t0 + 16 + 127) >> 7;
    const unsigned char* kg = (const unsigned char*)(KI + (size_t)(b * SEQ) * HD);
    KiStage sA, sB;
    sA.load(kg, tid);
    sA.store(lds, tid);
    asm volatile("s_waitcnt lgkmcnt(0)" ::: "memory"); __builtin_amdgcn_s_barrier(); asm volatile("" ::: "memory");
    if (ntile > 1) sA.load(kg + (size_t)1 * 128 * (HD * 2), tid);
    if (ntile > 2) sB.load(kg + (size_t)2 * 128 * (HD * 2), tid);
    for (int kt = 0; kt < ntile; ++kt) {
        const LAS unsigned char* buf = lds + (kt & 1) * KIBUF_B;
#pragma unroll
        for (int j = 0; j < 4; ++j) { const int key0 = 128 * kt + 32 * j;
            if (key0 <= t0 + 15) {
                const LAS unsigned char* kp = buf + (32 * j + r) * KSTR + 16 * hh;
                f32x16 c = f32x16{};
#pragma unroll
                for (int s = 0; s < 8; ++s) c = __builtin_amdgcn_mfma_f32_32x32x16_bf16(af[s], *(const LAS bf16x8*)(kp + 32 * s), c, 0, 0, 0);
                float s0 = 0.f, s1 = 0.f;
#pragma unroll
                for (int i = 0; i < 8; ++i) { s0 += wv[i] * fmaxf(c[i], 0.f); s1 += wv[i + 8] * fmaxf(c[i + 8], 0.f); }
                const float t0s = swap_sum(s0), t1s = swap_sum(s1);
                const int key = key0 + r;
                float v = (hh ? t1s : t0s) + 0.0f;
                if (key > tq) v = -INFINITY;
                myrow[key] = v; } }
        if (kt & 1) { if (kt + 1 < ntile) sB.store(lds + ((kt + 1) & 1) * KIBUF_B, tid); if (kt + 3 < ntile) sB.load(kg + (size_t)(kt + 3) * 128 * (HD * 2), tid); }
        else        { if (kt + 1 < ntile) sA.store(lds + ((kt + 1) & 1) * KIBUF_B, tid); if (kt + 3 < ntile) sA.load(kg + (size_t)(kt + 3) * 128 * (HD * 2), tid); }
        asm volatile("s_waitcnt lgkmcnt(0)" ::: "memory"); __builtin_amdgcn_s_barrier(); asm volatile("" ::: "memory");
    }
    asm volatile("s_waitcnt vmcnt(0)" ::: "memory");
    { const float* rowa = SC + ((size_t)(b * 128 + qb16) * 16 + 2 * wave) * SEQ;
      unsigned* mrowa = MASK + (size_t)(b * SEQ + tw) * 64;
      select_two(rowa, rowa + SEQ, tw, mrowa, mrowa + 64, lane); }
}

constexpr int N_PHASES = 12;
__global__ void __launch_bounds__(512, 2) fwd_kernel(Args a) {
    extern __shared__ __attribute__((aligned(16))) unsigned char lds_raw[];
    LAS unsigned char* lds = (LAS unsigned char*)lds_raw;
    cg::grid_group grid = cg::this_grid();
    const int tid = threadIdx.x, lane = tid & 63, wave = __builtin_amdgcn_readfirstlane(tid >> 6);
    const int G = gridDim.x, bx = blockIdx.x;
    const int gw = bx * 8 + wave, ngw = G * 8;
    unsigned char* ws = a.ws;
    const int lo = a.ph_lo, hi = a.ph_hi;
#ifndef REP_PHASE
#define REP_PHASE -1
#endif
#ifndef REP_COUNT
#define REP_COUNT 1
#endif
#define IN(k) (lo <= (k) && (k) < hi)
#define GSYNC(k) do { if ((k) == 0) grid.sync(); else xcd_barrier(xbar); } while (0)
#define SEAM(k) do { if (IN(k) && IN((k) + 1)) GSYNC(k); } while (0)
#define REPS(k) for (int rep_ = 0; rep_ < ((k) == REP_PHASE ? REP_COUNT : 1); ++rep_, (void)(((k) == REP_PHASE && rep_ < REP_COUNT) ? (xcd_barrier(xbar), 0) : 0))
    bf16_t* XB = (bf16_t*)(ws + WS_XB); float* X1 = (float*)(ws + WS_X1); float* X2 = (float*)(ws + WS_X2); float* PART = (float*)(ws + WS_PART);
    bf16_t* Qb = (bf16_t*)(ws + WS_Q); bf16_t* Kb = (bf16_t*)(ws + WS_K); bf16_t* Vtb = (bf16_t*)(ws + WS_VT); bf16_t* Ob = (bf16_t*)(ws + WS_O);
    bf16_t* QIb = (bf16_t*)(ws + WS_QI); bf16_t* KDb = (bf16_t*)(ws + WS_KD); bf16_t* VTDb = (bf16_t*)(ws + WS_VTD); bf16_t* KIb = (bf16_t*)(ws + WS_KI);
    float* WIb = (float*)(ws + WS_WI); unsigned* MASKb = (unsigned*)(ws + WS_MASK);
    bf16_t* ACTb = (bf16_t*)(ws + WS_ACT);
    const float* ropeC = (const float*)(ws + WS_ROPE); const float* ropeS = ropeC + SEQ * 64;

    if (tid < 16) ((volatile LAS unsigned*)(lds + LDS_MISC))[tid] = 0u;
    __syncthreads();
    XcdBarrier xbar = xcd_barrier_post((unsigned*)(ws + WS_CTL), (volatile LAS unsigned*)(lds + LDS_MISC) + 8);
    if (IN(0)) REPS(0) { prologue_phase(a, lds, gw, ngw, wave, lane); }
    SEAM(0);
    if (IN(1)) REPS(1) {
        pg8::Gemm g{XB, (const bf16_t*)(ws + WS_WQKV), MTOK, NQKV, DM}; pg8::StaticOrder S; S.init(MTOK, NQKV, G, bx);
        EpiQKV E{ws};
        pg8::gemm_phase<EpiQKV, pg8::StaticOrder, true, true>(lds, g, S, E);
    }
    SEAM(1);
    if (IN(2)) REPS(2) { for (int unit = bx; unit < BATCH * NH * 8; unit += G) sb_attn_block(Qb, Kb, Vtb, Ob, lds, unit >> 3, 7 - (unit & 7), wave, lane, tid); }
    SEAM(2);
    if (IN(3)) REPS(3) {
        pg8::Gemm g{Ob, (const bf16_t*)(ws + WS_WO0), MTOK, DM, DM}; pg8::StaticOrder S; S.init(MTOK, DM, G, bx);
        EpiRes E{a.x, X1, XB, PART};
        pg8::gemm_phase<EpiRes, pg8::StaticOrder, true, true>(lds, g, S, E);
    }
    SEAM(3);
    if (IN(4)) REPS(4) {
        pg8::Gemm g{XB, (const bf16_t*)(ws + WS_WUP), MTOK, NUP, DM, 254, -2}; pg8::StaticOrder S; S.init_tiles(33, NUP / 256, G, bx);
        EpiUpConv E{ACTb, PART, a.conv_w, a.conv_b, (LAS float*)(lds + LDS_EPI)};
        pg8::gemm_phase<EpiUpConv, pg8::StaticOrder, true, true>(lds, g, S, E);
    }
    SEAM(4);
    if (IN(5)) REPS(5) {
        pg8::Gemm g{ACTb, (const bf16_t*)(ws + WS_WDN), MTOK, DM, FF}; pg8::StaticOrder S; S.init(MTOK, DM, G, bx);
        EpiRes E{X1, X2, XB, PART};
        pg8::gemm_phase<EpiRes, pg8::StaticOrder, true, true>(lds, g, S, E);
    }
    SEAM(5);
    if (IN(6)) REPS(6) {
        pg8::Gemm g{XB, (const bf16_t*)(ws + WS_WIN), MTOK, NINP, DM}; pg8::StaticOrder S; S.init(MTOK, NINP, G, bx);
        EpiDsaIn E{ws, (LAS float*)(lds + LDS_EPI)};
        pg8::gemm_phase<EpiDsaIn, pg8::StaticOrder, true, true>(lds, g, S, E);
    }
    SEAM(6);
    if (IN(7)) REPS(7) {
        for (int pr = bx; pr < 256; pr += G) { const int b = pr >> 6, p = pr & 63;
            for (int half = 0; half < 2; ++half) indexer_block(QIb, KIb, WIb, MASKb, (float*)(ws + WS_ACT), lds, b, half ? p : 127 - p, wave, lane, tid); }
    }
    SEAM(7);
    if (IN(8)) REPS(8) {
        for (int pr = bx; pr < 256; pr += G) { const int b = pr >> 6, g = (pr >> 4) & 3, p = pr & 15;
            for (int half = 0; half < 2; ++half) dsa_attn_block(Qb, KDb, VTDb, MASKb, Ob, lds, b, g, half ? p : 31 - p, wave, lane, tid); }
    }
    SEAM(8);
    if (IN(9)) REPS(9) {
        pg8::Gemm g{Ob, (const bf16_t*)(ws + WS_WO1), MTOK, DM, DM}; pg8::StaticOrder S; S.init(MTOK, DM, G, bx);
        EpiRes E{X2, X1, XB, PART};
        pg8::gemm_phase<EpiRes, pg8::StaticOrder, true, true>(lds, g, S, E);
    }
    SEAM(9);
    if (IN(10)) REPS(10) {
        pg8::Gemm g{XB, (const bf16_t*)(ws + WS_WUP + 44 * MiB), MTOK, NUP, DM, 254, -2}; pg8::StaticOrder S; S.init_tiles(33, NUP / 256, G, bx);
        EpiUpConv E{ACTb, PART, a.conv_w + 3 * NUP, a.conv_b + NUP, (LAS float*)(lds + LDS_EPI)};
        pg8::gemm_phase<EpiUpConv, pg8::StaticOrder, true, true>(lds, g, S, E);
    }
    SEAM(10);
    if (IN(11)) REPS(11) {
        pg8::Gemm g{ACTb, (const bf16_t*)(ws + WS_WDN + 22 * MiB), MTOK, DM, FF}; pg8::StaticOrder S; S.init(MTOK, DM, G, bx);
        EpiRes E{X1, a.out, nullptr, nullptr};
        pg8::gemm_phase<EpiRes, pg8::StaticOrder, true, true>(lds, g, S, E);
    }
#undef IN
#undef SEAM
}

extern "C" void kernel_launch(void* const* d_in, const int* in_sizes, int n_in, void* d_out, int out_size, void* d_ws, size_t ws_size, hipStream_t stream) {
    static int grid = 0;
    if (grid == 0) {
        if (n_in != 14 || out_size != MTOK * DM || ws_size < WS_END) { fprintf(stderr, "kernel_launch: unexpected shapes (n_in %d out %d ws %zu)\n", n_in, out_size, ws_size); grid = -1; return; }
        int dev = 0, cus = 0, per_cu = 0;
        hipGetDevice(&dev); hipDeviceGetAttribute(&cus, hipDeviceAttributeMultiprocessorCount, dev);
        if (hipFuncSetAttribute((const void*)fwd_kernel, hipFuncAttributeMaxDynamicSharedMemorySize, LDS_BYTES) != hipSuccess) { fprintf(stderr, "kernel_launch: hipFuncSetAttribute failed\n"); grid = -1; return; }
        if (hipOccupancyMaxActiveBlocksPerMultiprocessor(&per_cu, (const void*)fwd_kernel, 512, LDS_BYTES) != hipSuccess || per_cu < 1) { fprintf(stderr, "kernel_launch: occupancy query says %d\n", per_cu); per_cu = 1; }
        (void)hipGetLastError();
        grid = cus;
    }
    if (grid < 0) return;
    Args a{};
    a.x = (const float*)d_in[0]; a.attn_g = (const float*)d_in[1]; a.ffn_g = (const float*)d_in[2]; a.w_qkv = (const float*)d_in[3]; a.w_o0 = (const float*)d_in[4]; a.w_in = (const float*)d_in[5];
    a.qn_g = (const float*)d_in[6]; a.kn_g = (const float*)d_in[7]; a.ikn_g = (const float*)d_in[8]; a.w_o1 = (const float*)d_in[9]; a.w_up = (const float*)d_in[10]; a.conv_w = (const float*)d_in[11];
    a.conv_b = (const float*)d_in[12]; a.w_down = (const float*)d_in[13]; a.out = (float*)d_out; a.ws = (unsigned char*)d_ws;
    if (hipMemsetAsync((char*)d_ws + WS_CTL, 0, CTL_BYTES, stream) != hipSuccess) { fprintf(stderr, "kernel_launch: hipMemsetAsync failed\n"); return; }
#if MK_ONE_LAUNCH
    a.ph_lo = 0; a.ph_hi = N_PHASES;
    void* args[] = {&a};
    hipError_t e = hipLaunchCooperativeKernel((const void*)fwd_kernel, dim3(grid), dim3(512), args, LDS_BYTES, stream);
    if (e != hipSuccess) fprintf(stderr, "cooperative launch failed: %s (grid %d)\n", hipGetErrorString(e), grid);
#else
    for (int p = 0; p < N_PHASES; ++p) {
        a.ph_lo = p; a.ph_hi = p + 1;
        void* args[] = {&a};
        hipError_t e = hipLaunchCooperativeKernel((const void*)fwd_kernel, dim3(grid), dim3(512), args, LDS_BYTES, stream);
        if (e != hipSuccess) { fprintf(stderr, "launch %d failed: %s (grid %d)\n", p, hipGetErrorString(e), grid); break; }
    }
#endif
}
```

```cpp
#include <hip/hip_runtime.h>
#include <hip/hip_cooperative_groups.h>
#include <cstdio>
#include <cstdint>
namespace cg = cooperative_groups;

#ifndef HOST_REP_PHASE
#define HOST_REP_PHASE -1
#endif
#ifndef HOST_REP_EXTRA
#define HOST_REP_EXTRA 0
#endif
#ifndef MK_ONE_LAUNCH
#define MK_ONE_LAUNCH 1
#endif

#define LAS __attribute__((address_space(3)))
typedef unsigned short bf16_t;
typedef short bf16x8 __attribute__((ext_vector_type(8)));
typedef short s16x4 __attribute__((ext_vector_type(4)));
typedef float f32x4 __attribute__((ext_vector_type(4)));
typedef float f32x2 __attribute__((ext_vector_type(2)));
typedef float f32x16 __attribute__((ext_vector_type(16)));
typedef unsigned u32x4 __attribute__((ext_vector_type(4)));
typedef unsigned u32x2 __attribute__((ext_vector_type(2)));
typedef __bf16 bf16x2_t __attribute__((ext_vector_type(2)));

constexpr int BATCH = 4, SEQ = 2048, DM = 2048, NH = 16, HD = 128, MTOK = BATCH * SEQ;
constexpr int FF = 5632, NUP = 2 * FF, NQKV = 3 * DM;
constexpr int KVH = 4, NIN = 5264, NINP = 5376;
constexpr int TOPK = 256;
constexpr float NORM_EPS = 1e-6f;
constexpr float LOG2E = 1.4426950408889634f;
constexpr float QSCALE = 0.08838834764831845f * LOG2E;

constexpr size_t MiB = 1u << 20;
constexpr size_t WS_WQKV = 0, WS_WO0 = 24 * MiB, WS_WIN = 32 * MiB, WS_WO1 = 53 * MiB, WS_WUP = 61 * MiB  , WS_WDN = 149 * MiB  ;
constexpr size_t WS_GAIN = 197 * MiB + 512 * 1024  ;
constexpr size_t WS_ROPE = 193 * MiB  , WS_PART = 194 * MiB, WS_MASK = 195 * MiB, WS_WI = 197 * MiB, WS_KI = 198 * MiB;
constexpr size_t WS_XB = 200 * MiB, WS_X1 = 232 * MiB, WS_X2 = 296 * MiB;
constexpr size_t WS_SCR = 360 * MiB;
constexpr size_t WS_U = WS_SCR, WS_ACT = WS_SCR + 176 * MiB;
constexpr size_t WS_Q = WS_SCR, WS_K = WS_SCR + 32 * MiB, WS_VT = WS_SCR + 64 * MiB, WS_O = WS_SCR + 96 * MiB, WS_QI = WS_SCR + 128 * MiB, WS_KD = WS_SCR + 160 * MiB, WS_VTD = WS_SCR + 168 * MiB;
constexpr size_t WS_CTL = WS_ACT + 88 * MiB, CTL_BYTES = 65536;
constexpr size_t WS_END = WS_CTL + CTL_BYTES;

constexpr int LDS_EPI = 131072;
constexpr int LDS_MISC = LDS_EPI + 8192;
constexpr int LDS_BYTES = 147456;

__device__ __forceinline__ unsigned pk2(float lo, float hi) { f32x2 v = {lo, hi}; bf16x2_t b = __builtin_convertvector(v, bf16x2_t); return __builtin_bit_cast(unsigned, b); }
__device__ __forceinline__ bf16_t f2bf(float f) { return (bf16_t)(pk2(f, 0.f) & 0xffffu); }
__device__ __forceinline__ int crow(int r, int hi) { return (r & 3) + 8 * (r >> 2) + 4 * hi; }
__device__ __forceinline__ bf16x8 pack8(const f32x16& p, int b) {
    u32x4 w; w.x = pk2(p[b], p[b + 1]); w.y = pk2(p[b + 2], p[b + 3]); w.z = pk2(p[b + 4], p[b + 5]); w.w = pk2(p[b + 6], p[b + 7]);
    return __builtin_bit_cast(bf16x8, w);
}
__device__ __forceinline__ float swap_sum(float v) { auto rr = __builtin_amdgcn_permlane32_swap(__float_as_uint(v), __float_as_uint(v), false, false); return __uint_as_float(rr[0]) + __uint_as_float(rr[1]); }
__device__ __forceinline__ float swap_max(float v) { auto rr = __builtin_amdgcn_permlane32_swap(__float_as_uint(v), __float_as_uint(v), false, false); return fmaxf(__uint_as_float(rr[0]), __uint_as_float(rr[1])); }
__device__ __forceinline__ float wave_sum(float v) {
#pragma unroll
    for (int o = 1; o < 64; o <<= 1) v += __shfl_xor(v, o);
    return v;
}
__device__ __forceinline__ float row_rstd(const float* part, int row, int fq) {
    const f32x4* p = (const f32x4*)(part + (size_t)row * 32 + 8 * fq);
    const f32x4 a = p[0], b = p[1]; float s = ((a.x + a.y) + (a.z + a.w)) + ((b.x + b.y) + (b.z + b.w));
    s += __shfl_xor(s, 16); s += __shfl_xor(s, 32);
    return 1.0f / sqrtf(s * (1.0f / DM) + NORM_EPS);
}


#define XB_TMO      128
#define XB_XCNT(j)  (256  + 64 * (j))
#define XB_XSUB(j)  (1280 + 64 * (j))
#define XB_XGEN(j)  (2304 + 64 * (j))
#define XB_TOP      3328
#define XB_TOPGEN   3392
#define XCD_BAR_WORDS 3456
#define XB_SPIN_CAP (1u << 18)
__device__ __forceinline__ unsigned xb_ld(unsigned* p)              { return __hip_atomic_load(p, __ATOMIC_RELAXED, __HIP_MEMORY_SCOPE_AGENT); }
__device__ __forceinline__ unsigned xb_add(unsigned* p, unsigned v) { return __hip_atomic_fetch_add(p, v, __ATOMIC_RELAXED, __HIP_MEMORY_SCOPE_AGENT); }
__device__ __forceinline__ unsigned xb_xcc_id() { return (unsigned)__builtin_amdgcn_s_getreg((3 << 11) | 20) & 0xFu; }
#define XB_SPIN(cond, bar) do { unsigned _sp = 0; while (cond) { __builtin_amdgcn_s_sleep(1); \
    if ((++_sp & 255u) == 0u) { if (xb_ld(&(bar)[XB_TMO])) break; if (_sp > XB_SPIN_CAP) { atomicAdd(&(bar)[XB_TMO], 1u); break; } } } } while (0)
struct XcdBarrier { unsigned* bar; unsigned x; volatile LAS unsigned* st; };
__device__ __forceinline__ XcdBarrier xcd_barrier_post(unsigned* bar, volatile LAS unsigned* st) {
    XcdBarrier b; b.bar = bar; b.x = xb_xcc_id(); b.st = st;
    if (threadIdx.x == 0) (void)xb_add(&bar[XB_XCNT(b.x)], 1u);
    return b;
}
__device__ __forceinline__ void xcd_barrier_complete(unsigned* bar, unsigned x, unsigned& nloc, unsigned& nx) {
    const unsigned G = gridDim.x * gridDim.y * gridDim.z;
    unsigned sum, cnt, mine, sp = 0u;
    for (;;) {
        sum = 0u; cnt = 0u; mine = 0u;
#pragma unroll
        for (unsigned j = 0; j < 16; ++j) { const unsigned c = xb_ld(&bar[XB_XCNT(j)]); sum += c; cnt += (c > 0u) ? 1u : 0u; mine = (j == x) ? c : mine; }
        if (sum == G) break;
        __builtin_amdgcn_s_sleep(1);
        if ((++sp & 255u) == 0u) { if (xb_ld(&bar[XB_TMO])) break; if (sp > XB_SPIN_CAP) { atomicAdd(&bar[XB_TMO], 1u); break; } }
    }
    nloc = mine > 0u ? mine : 1u; nx = cnt > 0u ? cnt : 1u;
}
__device__ __forceinline__ void xcd_barrier(const XcdBarrier& b) {
    asm volatile("s_waitcnt vmcnt(0)" ::: "memory");
    __syncthreads();
    if (threadIdx.x == 0) {
        unsigned* bar = b.bar;
        __builtin_amdgcn_s_waitcnt(0);
        unsigned nloc = b.st[0], nx = b.st[1];
        if (nloc == 0u) { xcd_barrier_complete(bar, b.x, nloc, nx); b.st[0] = nloc; b.st[1] = nx; }
        const unsigned old = xb_add(&bar[XB_XSUB(b.x)], 1u);
        const unsigned gen = old / nloc;
        if (old + 1u == (gen + 1u) * nloc) {
            __builtin_amdgcn_fence(__ATOMIC_RELEASE, "agent");
            asm volatile("s_waitcnt vmcnt(0)" ::: "memory");
            const unsigned og = xb_add(&bar[XB_TOP], 1u);
            const unsigned tg = og / nx;
            if (og + 1u == (tg + 1u) * nx) xb_add(&bar[XB_TOPGEN], 1u);
            else XB_SPIN(xb_ld(&bar[XB_TOPGEN]) == tg, bar);
            __builtin_amdgcn_fence(__ATOMIC_ACQUIRE, "agent");
            xb_add(&bar[XB_XGEN(b.x)], 1u);
            asm volatile("s_waitcnt vmcnt(0)" ::: "memory");
        } else {
            XB_SPIN(xb_ld(&bar[XB_XGEN(b.x)]) == gen, bar);
            __builtin_amdgcn_fence(__ATOMIC_ACQUIRE, "agent");
            asm volatile("s_waitcnt vmcnt(0)" ::: "memory");
        }
    }
    __syncthreads();
}

namespace pg8 {
constexpr int BM = 256, BK = 64, HALF = 128, HTB = HALF * BK * 2, STAGE_BYTES = 8 * HTB, NXCD = 8, WGM = 8;
__host__ __device__ __forceinline__ int lds_byte(int r, int c) { const int st = (r >> 4) * 2 + (c >> 5), rr = r & 15, cc = c & 31, ob = rr * 64 + cc * 2; return st * 1024 + (ob ^ (((ob >> 9) & 1) << 5)); }
__host__ __device__ __forceinline__ void stage_rc(int b, int& R, int& C) { const int st = b / 1024, sb = b % 1024, swz = sb ^ (((sb >> 9) & 1) << 5); R = (st >> 1) * 16 + swz / 64; C = (st & 1) * 32 + (swz % 64) / 2; }
__host__ __device__ __forceinline__ int perm32(int rho) { const int n = rho >> 4, i = rho & 15; return 8 * (i >> 2) + 4 * n + (i & 3); }
struct Unit { int pm, pn; };
struct Gemm { const bf16_t* A; const bf16_t* Bt; int M, N, K; int a_rows = 256, a_row0 = 0; };
struct StaticOrder {
    int nM, nN, nwg, G, c;
    __host__ __device__ void init(int M, int N, int G_, int c_) { nM = M / BM; nN = N / BM; nwg = nM * nN; G = G_; c = c_; }
    __host__ __device__ void init_tiles(int nM_, int nN_, int G_, int c_) { nM = nM_; nN = nN_; nwg = nM * nN; G = G_; c = c_; }
    __host__ __device__ bool next(int i, Unit& u) const {
        const long L = (long)i * G + c; if (L >= nwg) return false;
        int wgid = (int)L; { const int q = nwg / NXCD, r = nwg % NXCD, xcd = wgid % NXCD, off = wgid / NXCD; wgid = (xcd < r ? xcd * (q + 1) : r * (q + 1) + (xcd - r) * q) + off; }
        const int nig = WGM * nN, gid = wgid / nig, fm = gid * WGM, gsz = (nM - fm) < WGM ? (nM - fm) : WGM;
        u.pm = fm + ((wgid % nig) % gsz); u.pn = (wgid % nig) / gsz; return true;
    }
};
template <class Epi, class Sched, bool ALIGN_EPI, bool SP2>
__device__ __forceinline__ void gemm_phase(LAS unsigned char* lds, const Gemm g, const Sched& S, const Epi& E) {
    const int tid = threadIdx.x, wid = __builtin_amdgcn_readfirstlane(tid >> 6), lane = tid & 63, wr = wid >> 2, wc = wid & 3, fr = lane & 15, fq = lane >> 4;
    const int K = g.K, nt = K / BK;
    unsigned voffA[2], voffB[2];
#pragma unroll
    for (int i = 0; i < 2; ++i) { int R, C; stage_rc(tid * 16 + i * 8192, R, C); const int Rb = Epi::PERM ? ((R & ~31) + perm32(R & 31)) : R;
        voffA[i] = (unsigned)(R * K + C) * 2u; voffB[i] = (unsigned)(Rb * K + C) * 2u; }
    const size_t kstep = (size_t)(BK * 2);
    const size_t hstep = (size_t)HALF * K * 2;
    const size_t tstep = 2 * hstep;
    const unsigned ldsw = (unsigned)wid * 1024u;
    const int aoff = lds_byte(wr * 64 + fr, fq * 8), boff = lds_byte(wc * 32 + fr, fq * 8);
#define PG8_SA(b, h) (((b) * 2 + (h)) * HTB)
#define PG8_SB(b, h) ((4 + (b) * 2 + (h)) * HTB)
#define PG8_STAGE(bufoff, gbase, voff) do { _Pragma("unroll") for (int _i = 0; _i < 2; ++_i) \
        __builtin_amdgcn_global_load_lds((const unsigned*)((const char*)(gbase) + (voff)[_i]), (LAS unsigned*)(lds + (bufoff) + ldsw + _i * 8192), 16, 0, 0); } while (0)
#define PG8_LDA(dst, b, h) do { _Pragma("unroll") for (int m = 0; m < 4; ++m) _Pragma("unroll") for (int k = 0; k < 2; ++k) dst[m][k] = *(const LAS bf16x8*)(lds + PG8_SA(b, h) + aoff + m * 2048 + k * 1024); } while (0)
#define PG8_LDB(dst, b, h) do { _Pragma("unroll") for (int n = 0; n < 2; ++n) _Pragma("unroll") for (int k = 0; k < 2; ++k) dst[n][k] = *(const LAS bf16x8*)(lds + PG8_SB(b, h) + boff + n * 2048 + k * 1024); } while (0)
#define PG8_MMA(ai, bj, At, Bt) do { __builtin_amdgcn_s_setprio(1); _Pragma("unroll") for (int m = 0; m < 4; ++m) _Pragma("unroll") for (int n = 0; n < 2; ++n) _Pragma("unroll") for (int k = 0; k < 2; ++k) \
        acc[ai][bj][m][n] = __builtin_amdgcn_mfma_f32_16x16x32_bf16(Bt[n][k], At[m][k], acc[ai][bj][m][n], 0, 0, 0); __builtin_amdgcn_s_setprio(0); } while (0)
#define PG8_WAIT_V(n) asm volatile("s_waitcnt vmcnt(" #n ")" ::: "memory")
#define PG8_WAIT_L(n) asm volatile("s_waitcnt lgkmcnt(" #n ")" ::: "memory")
#define PG8_BAR __builtin_amdgcn_s_barrier()
#define PG8_SCHED __builtin_amdgcn_sched_barrier(0)
    Unit cur, nxt; int ui = 0;
    if (!S.next(0, cur)) return;
    f32x4 acc[2][2][4][2];
#pragma unroll
    for (int a = 0; a < 2; ++a)
#pragma unroll
        for (int b = 0; b < 2; ++b)
#pragma unroll
            for (int m = 0; m < 4; ++m)
#pragma unroll
                for (int n = 0; n < 2; ++n) acc[a][b][m][n] = (f32x4){0.f, 0.f, 0.f, 0.f};
    bf16x8 At[4][2], B0[2][2], B1[2][2];
    const long atstep = (long)g.a_rows * K * 2, aorg = (long)g.a_row0 * K * 2;
    const char* cA = (const char*)g.A + aorg + (long)cur.pm * atstep; const char* cB = (const char*)g.Bt + (size_t)cur.pn * tstep;
    if constexpr (SP2) {
        PG8_STAGE(PG8_SB(0, 0), cB, voffB); PG8_STAGE(PG8_SB(0, 1), cB + hstep, voffB); PG8_STAGE(PG8_SA(0, 0), cA, voffA); PG8_STAGE(PG8_SA(0, 1), cA + hstep, voffA);
        if (wr == 1) PG8_BAR;
        PG8_WAIT_V(2); PG8_BAR;
        PG8_STAGE(PG8_SB(1, 0), cB + kstep, voffB); PG8_STAGE(PG8_SA(1, 0), cA + kstep, voffA); PG8_STAGE(PG8_SB(1, 1), cB + hstep + kstep, voffB);
        PG8_WAIT_V(6); PG8_BAR;
    } else {
        PG8_STAGE(PG8_SB(0, 0), cB, voffB); PG8_STAGE(PG8_SA(0, 0), cA, voffA); PG8_STAGE(PG8_SB(0, 1), cB + hstep, voffB); PG8_STAGE(PG8_SA(0, 1), cA + hstep, voffA);
        if (wr == 1) PG8_BAR;
        PG8_WAIT_V(4); PG8_BAR;
        PG8_STAGE(PG8_SB(1, 0), cB + kstep, voffB); PG8_STAGE(PG8_SA(1, 0), cA + kstep, voffA); PG8_STAGE(PG8_SB(1, 1), cB + hstep + kstep, voffB);
        PG8_WAIT_V(6); PG8_BAR;
    }
    for (;;) {
        const bool has_next = S.next(ui + 1, nxt);
        const char* nA = has_next ? (const char*)g.A + aorg + (long)nxt.pm * atstep : cA; const char* nB = has_next ? (const char*)g.Bt + (size_t)nxt.pn * tstep : cB;
        for (int t = 0; t < nt; t += 2) {
            const bool last = (t == nt - 2);
            const char* a1 = cA + (size_t)(t + 1) * kstep;
            const char* a2 = last ? nA : cA + (size_t)(t + 2) * kstep; const char* b2 = last ? nB : cB + (size_t)(t + 2) * kstep;
            const char* a3 = a2 + kstep; const char* b3 = b2 + kstep;
            if constexpr (SP2) {
            PG8_LDB(B0, 0, 0); PG8_LDB(B1, 0, 1); PG8_SCHED; PG8_LDA(At, 0, 0); PG8_STAGE(PG8_SA(1, 1), a1 + hstep, voffA);
            PG8_WAIT_V(8); PG8_WAIT_L(0); PG8_BAR; PG8_MMA(0, 0, At, B0); PG8_MMA(0, 1, At, B1); PG8_BAR; PG8_SCHED;
            PG8_LDA(At, 0, 1); PG8_STAGE(PG8_SB(0, 0), b2, voffB); PG8_STAGE(PG8_SB(0, 1), b2 + hstep, voffB); PG8_STAGE(PG8_SA(0, 0), a2, voffA);
            PG8_WAIT_V(8); PG8_WAIT_L(0); PG8_BAR; PG8_MMA(1, 0, At, B0); PG8_MMA(1, 1, At, B1); PG8_BAR; PG8_SCHED;
            PG8_LDB(B0, 1, 0); PG8_LDB(B1, 1, 1); PG8_SCHED; PG8_LDA(At, 1, 0); PG8_STAGE(PG8_SA(0, 1), a2 + hstep, voffA);
            PG8_WAIT_V(8); PG8_WAIT_L(0); PG8_BAR; PG8_MMA(0, 0, At, B0); PG8_MMA(0, 1, At, B1); PG8_BAR; PG8_SCHED;
            PG8_LDA(At, 1, 1); PG8_STAGE(PG8_SB(1, 0), b3, voffB); PG8_STAGE(PG8_SB(1, 1), b3 + hstep, voffB); PG8_STAGE(PG8_SA(1, 0), a3, voffA);
            PG8_WAIT_V(8); PG8_WAIT_L(0); PG8_BAR; PG8_MMA(1, 0, At, B0); PG8_MMA(1, 1, At, B1); PG8_BAR; PG8_SCHED;
            } else {
            PG8_LDB(B0, 0, 0); PG8_SCHED; PG8_LDA(At, 0, 0); PG8_STAGE(PG8_SA(1, 1), a1 + hstep, voffA);
            PG8_WAIT_L(8); PG8_BAR; PG8_WAIT_L(0); PG8_MMA(0, 0, At, B0); PG8_BAR; PG8_SCHED;
            PG8_LDB(B1, 0, 1); PG8_STAGE(PG8_SB(0, 0), b2, voffB);
            PG8_BAR; PG8_WAIT_L(0); PG8_MMA(0, 1, At, B1); PG8_BAR;
            PG8_LDA(At, 0, 1); PG8_STAGE(PG8_SA(0, 0), a2, voffA);
            PG8_BAR; PG8_WAIT_L(0); PG8_MMA(1, 0, At, B0); PG8_BAR; PG8_SCHED;
            PG8_STAGE(PG8_SB(0, 1), b2 + hstep, voffB);
            PG8_WAIT_V(6); PG8_BAR; PG8_MMA(1, 1, At, B1); PG8_BAR;
            PG8_LDB(B0, 1, 0); PG8_SCHED; PG8_LDA(At, 1, 0); PG8_STAGE(PG8_SA(0, 1), a2 + hstep, voffA);
            PG8_WAIT_L(8); PG8_BAR; PG8_WAIT_L(0); PG8_MMA(0, 0, At, B0); PG8_BAR; PG8_SCHED;
            PG8_LDB(B1, 1, 1); PG8_STAGE(PG8_SB(1, 0), b3, voffB);
            PG8_BAR; PG8_WAIT_L(0); PG8_MMA(0, 1, At, B1); PG8_BAR;
            PG8_LDA(At, 1, 1); PG8_STAGE(PG8_SA(1, 0), a3, voffA);
            PG8_BAR; PG8_WAIT_L(0); PG8_MMA(1, 0, At, B0); PG8_BAR; PG8_SCHED;
            PG8_STAGE(PG8_SB(1, 1), b3 + hstep, voffB);
            PG8_WAIT_V(6); PG8_BAR; PG8_MMA(1, 1, At, B1); PG8_BAR;
            }
        }
        if constexpr (ALIGN_EPI) { if (wr == 0) PG8_BAR; }
        { int fr_ = fr, fq_ = fq; asm volatile("" : "+v"(fr_), "+v"(fq_)); E(acc, cur, wr, wc, fr_, fq_); }
        if (!has_next) break;
#pragma unroll
        for (int a = 0; a < 2; ++a)
#pragma unroll
            for (int b = 0; b < 2; ++b)
#pragma unroll
                for (int m = 0; m < 4; ++m)
#pragma unroll
                    for (int n = 0; n < 2; ++n) acc[a][b][m][n] = (f32x4){0.f, 0.f, 0.f, 0.f};
        cur = nxt; cA = nA; cB = nB; ++ui;
        if constexpr (ALIGN_EPI) { if (wr == 1) PG8_BAR; }
    }
    PG8_WAIT_V(0);
    if constexpr (!ALIGN_EPI) { if (wr == 0) PG8_BAR; }
    PG8_BAR;
#undef PG8_SA
#undef PG8_SB
#undef PG8_STAGE
#undef PG8_LDA
#undef PG8_LDB
#undef PG8_MMA
#undef PG8_WAIT_V
#undef PG8_WAIT_L
#undef PG8_BAR
#undef PG8_SCHED
}
}
using pg8::Unit;
typedef f32x4 AccT[2][2][4][2];

struct EpiQKV {
    static constexpr bool PERM = true;
    unsigned char* ws;
    __device__ __forceinline__ void operator()(const AccT& acc, const Unit& u, int wr, int wc, int fr, int fq) const {
        const int row0 = u.pm * 256 + wr * 64 + fr, kind = u.pn >> 3, colt = (u.pn & 7) * 256 + wc * 32 + 8 * fq;
        bf16_t* Vt = (bf16_t*)(ws + WS_VT);
        if (kind < 2) {
            bf16_t* base = (bf16_t*)(ws + (kind == 0 ? WS_Q : WS_K)); const float sc = kind == 0 ? QSCALE : 1.0f;
#pragma unroll
            for (int ai = 0; ai < 2; ++ai)
#pragma unroll
                for (int m = 0; m < 4; ++m) { bf16_t* rowp = base + (size_t)(row0 + ai * 128 + m * 16) * DM + colt;
#pragma unroll
                    for (int bj = 0; bj < 2; ++bj) { const f32x4 v0 = acc[ai][bj][m][0] * sc, v1 = acc[ai][bj][m][1] * sc;
                        u32x4 w; w.x = pk2(v0[0], v0[1]); w.y = pk2(v0[2], v0[3]); w.z = pk2(v1[0], v1[1]); w.w = pk2(v1[2], v1[3]);
                        *(u32x4*)(rowp + bj * 128) = w; } }
        } else {
#pragma unroll
            for (int ai = 0; ai < 2; ++ai)
#pragma unroll
                for (int m = 0; m < 4; ++m) { const int row = row0 + ai * 128 + m * 16, b = row >> 11, s = row & 2047;
#pragma unroll
                    for (int bj = 0; bj < 2; ++bj) { const int c0 = colt + bj * 128, h = c0 >> 7, d0 = c0 & 127;
                        bf16_t* p = Vt + ((size_t)(b * NH + h) * HD + d0) * SEQ + s;
#pragma unroll
                        for (int n = 0; n < 2; ++n)
#pragma unroll
                            for (int j = 0; j < 4; ++j) p[(size_t)(4 * n + j) * SEQ] = f2bf(acc[ai][bj][m][n][j]); } }
        }
    }
};
struct EpiRes {
    static constexpr bool PERM = true;
    const float* res; float* out; bf16_t* outb; float* part;
    __device__ __forceinline__ void operator()(const AccT& acc, const Unit& u, int wr, int wc, int fr, int fq) const {
        const int row0 = u.pm * 256 + wr * 64 + fr, col0 = u.pn * 256 + wc * 32 + 8 * fq;
#pragma unroll
        for (int ai = 0; ai < 2; ++ai)
#pragma unroll
            for (int m = 0; m < 4; ++m) { const int row = row0 + ai * 128 + m * 16; const size_t off = (size_t)row * DM + col0; float ss = 0.f;
#pragma unroll
                for (int bj = 0; bj < 2; ++bj) {
                    const f32x4 r0 = *(const f32x4*)(res + off + bj * 128), r1 = *(const f32x4*)(res + off + bj * 128 + 4);
                    const f32x4 v0 = acc[ai][bj][m][0] + r0, v1 = acc[ai][bj][m][1] + r1;
                    *(f32x4*)(out + off + bj * 128) = v0; *(f32x4*)(out + off + bj * 128 + 4) = v1;
                    if (outb) { u32x4 w; w.x = pk2(v0[0], v0[1]); w.y = pk2(v0[2], v0[3]); w.z = pk2(v1[0], v1[1]); w.w = pk2(v1[2], v1[3]); *(u32x4*)(outb + off + bj * 128) = w; }
                    ss += (v0[0] * v0[0] + v0[1] * v0[1]) + (v0[2] * v0[2] + v0[3] * v0[3]) + (v1[0] * v1[0] + v1[1] * v1[1]) + (v1[2] * v1[2] + v1[3] * v1[3]); }
                if (part) { ss += __shfl_xor(ss, 16); ss += __shfl_xor(ss, 32); if (fq == 0) part[(size_t)row * 32 + u.pn * 4 + wc] = ss; } }
    }
};
struct EpiUp {
    static constexpr bool PERM = true;
    bf16_t* U; const float* part;
    __device__ __forceinline__ void operator()(const AccT& acc, const Unit& u, int wr, int wc, int fr, int fq) const {
        const int row0 = u.pm * 256 + wr * 64 + fr, col0 = u.pn * 256 + wc * 32 + 8 * fq;
#pragma unroll
        for (int ai = 0; ai < 2; ++ai)
#pragma unroll
            for (int m = 0; m < 4; ++m) { const int row = row0 + ai * 128 + m * 16; const float rs = row_rstd(part, row, fq); bf16_t* rowp = U + (size_t)row * NUP + col0;
#pragma unroll
                for (int bj = 0; bj < 2; ++bj) { const f32x4 v0 = acc[ai][bj][m][0] * rs, v1 = acc[ai][bj][m][1] * rs;
                    u32x4 w; w.x = pk2(v0[0], v0[1]); w.y = pk2(v0[2], v0[3]); w.z = pk2(v1[0], v1[1]); w.w = pk2(v1[2], v1[3]);
                    *(u32x4*)(rowp + bj * 128) = w; } }
    }
};
__device__ __forceinline__ float dpp_ror1(float v) { return __int_as_float(__builtin_amdgcn_update_dpp(0, __float_as_int(v), 0x121, 0xf, 0xf, false)); }
__device__ __forceinline__ float dpp_ror2(float v) { return __int_as_float(__builtin_amdgcn_update_dpp(0, __float_as_int(v), 0x122, 0xf, 0xf, false)); }
struct EpiUpConv {
    static constexpr bool PERM = true;
    bf16_t* ACT; const float* part; const float* cw; const float* cb; LAS float* hal;
    __device__ __forceinline__ void operator()(AccT& acc, const Unit& u, int wr, int wc, int fr, int fq) const {
        const int grow0 = 254 * u.pm - 2 + wr * 64 + fr;
#pragma unroll
        for (int ai = 0; ai < 2; ++ai)
#pragma unroll
            for (int m = 0; m < 4; ++m) { const int grow = grow0 + ai * 128 + m * 16; const int rowc = grow < 0 ? 0 : (grow >= MTOK ? MTOK - 1 : grow);
                const float rs = row_rstd(part, rowc, fq);
#pragma unroll
                for (int bj = 0; bj < 2; ++bj) { acc[ai][bj][m][0] *= rs; acc[ai][bj][m][1] *= rs; } }
        const int colw = wc * 32 + 8 * fq;
        if (fr >= 14) {
#pragma unroll
            for (int ai = 0; ai < 2; ++ai)
#pragma unroll
                for (int bj = 0; bj < 2; ++bj)
#pragma unroll
                    for (int n = 0; n < 2; ++n) *(LAS f32x4*)(hal + ((ai * 2 + wr) * 2 + (fr - 14)) * 256 + bj * 128 + colw + 4 * n) = acc[ai][bj][3][n];
        }
        asm volatile("s_waitcnt lgkmcnt(0)" ::: "memory"); __builtin_amdgcn_s_barrier(); asm volatile("" ::: "memory");
#pragma unroll
        for (int n = 0; n < 2; ++n) {
            const int ch = u.pn * 128 + colw + 4 * n;
            f32x4 w[2][3], bb[2];
#pragma unroll
            for (int bj = 0; bj < 2; ++bj) { bb[bj] = *(const f32x4*)(cb + bj * FF + ch);
#pragma unroll
                for (int t = 0; t < 3; ++t) w[bj][t] = *(const f32x4*)(cw + (size_t)t * NUP + bj * FF + ch); }
#pragma unroll
            for (int ai = 0; ai < 2; ++ai)
#pragma unroll
                for (int m = 0; m < 4; ++m) {
                    const int lrow = ai * 128 + wr * 64 + m * 16 + fr, grow = 254 * u.pm - 2 + lrow, pos = grow & 2047;
                    f32x4 cv[2];
#pragma unroll
                    for (int bj = 0; bj < 2; ++bj) {
                        const f32x4 cur = acc[ai][bj][m][n];
                        f32x4 q1, q2;
                        if (m > 0) { const f32x4 pv = acc[ai][bj][m - 1][n];
#pragma unroll
                            for (int e = 0; e < 4; ++e) { q1[e] = dpp_ror1(pv[e]); q2[e] = dpp_ror2(pv[e]); } }
                        else { const int slab = ai * 2 + wr - 1; f32x4 h1 = (f32x4){0.f, 0.f, 0.f, 0.f}, h2 = h1;
                            if (slab >= 0) { h1 = *(const LAS f32x4*)(hal + (slab * 2 + 1) * 256 + bj * 128 + colw + 4 * n); h2 = *(const LAS f32x4*)(hal + (slab * 2) * 256 + bj * 128 + colw + 4 * n); }
                            q1 = h1; q2 = (fr == 1) ? h1 : h2; }
                        f32x4 c = bb[bj];
#pragma unroll
                        for (int e = 0; e < 4; ++e) { const float r1 = dpp_ror1(cur[e]), r2 = dpp_ror2(cur[e]);
                            const float p1 = fr >= 1 ? r1 : q1[e], p2 = fr >= 2 ? r2 : q2[e];
                            float v = c[e] + w[bj][2][e] * cur[e];
                            if (pos >= 1) v += w[bj][1][e] * p1;
                            if (pos >= 2) v += w[bj][0][e] * p2;
                            c[e] = v; }
                        cv[bj] = c;
                    }
                    float a4[4];
#pragma unroll
                    for (int e = 0; e < 4; ++e) { const float gx = cv[0][e]; a4[e] = gx * __builtin_amdgcn_rcpf(1.0f + __expf(-gx)) * cv[1][e]; }
                    if (lrow >= 2 && grow < MTOK) { u32x2 o; o.x = pk2(a4[0], a4[1]); o.y = pk2(a4[2], a4[3]); *(u32x2*)(ACT + (size_t)grow * FF + ch) = o; }
                }
        }
    }
};
struct EpiDsaIn {
    static constexpr bool PERM = false;
    unsigned char* ws; LAS float* scr;
    __device__ __forceinline__ void operator()(const AccT& acc_in, const Unit& u, int wr, int wc, int fr, int fq) const {
        const int row0 = u.pm * 256 + wr * 64 + fr;
        const float* part = (const float*)(ws + WS_PART); const float* ropeC = (const float*)(ws + WS_ROPE); const float* ropeS = ropeC + SEQ * 64;
        bf16_t* VTD = (bf16_t*)(ws + WS_VTD); float* WI = (float*)(ws + WS_WI);
        const bool need_norm = (u.pn < 10) || (u.pn == 20);
        float rs[2][4];
#pragma unroll
        for (int ai = 0; ai < 2; ++ai)
#pragma unroll
            for (int m = 0; m < 4; ++m) rs[ai][m] = row_rstd(part, row0 + ai * 128 + m * 16, fq);
        if (need_norm) {
#pragma unroll
            for (int ai = 0; ai < 2; ++ai)
#pragma unroll
                for (int m = 0; m < 4; ++m)
#pragma unroll
                    for (int bj = 0; bj < 2; ++bj) { const f32x4 a = acc_in[ai][bj][m][0], b = acc_in[ai][bj][m][1];
                        float ss = ((a[0] * a[0] + a[1] * a[1]) + (a[2] * a[2] + a[3] * a[3])) + ((b[0] * b[0] + b[1] * b[1]) + (b[2] * b[2] + b[3] * b[3]));
                        ss += __shfl_xor(ss, 16); ss += __shfl_xor(ss, 32);
                        if (fq == 0) scr[(ai * 128 + wr * 64 + m * 16 + fr) * 8 + bj * 4 + wc] = ss * rs[ai][m] * rs[ai][m]; }
            asm volatile("s_waitcnt lgkmcnt(0)" ::: "memory"); __builtin_amdgcn_s_barrier(); asm volatile("" ::: "memory");
        }
        const int dl = 16 * wc + 4 * fq;
#pragma unroll
        for (int bj = 0; bj < 2; ++bj) {
            const int hh = 2 * u.pn + bj;
            if (hh >= 20 && hh < 24) {
#pragma unroll
                for (int ai = 0; ai < 2; ++ai)
#pragma unroll
                    for (int m = 0; m < 4; ++m) { const int row = row0 + ai * 128 + m * 16, b = row >> 11, s = row & 2047; const float r = rs[ai][m];
                        bf16_t* p = VTD + ((size_t)(b * KVH + (hh - 20)) * HD + dl) * SEQ + s;
#pragma unroll
                        for (int n = 0; n < 2; ++n)
#pragma unroll
                            for (int e = 0; e < 4; ++e) p[(size_t)(64 * n + e) * SEQ] = f2bf(acc_in[ai][bj][m][n][e] * r); }
            } else if (hh == 41) {
                if (wc == 0) {
#pragma unroll
                    for (int ai = 0; ai < 2; ++ai)
#pragma unroll
                        for (int m = 0; m < 4; ++m) { const int row = row0 + ai * 128 + m * 16; *(f32x4*)(WI + (size_t)row * 16 + 4 * fq) = acc_in[ai][bj][m][0] * rs[ai][m]; } }
            } else {
                const bool norm = (hh < 20) || (hh == 40);
                const float* g = (const float*)(ws + WS_GAIN) + (hh < 16 ? 0 : (hh < 20 ? 128 : 256));
                f32x4 g0 = (f32x4){1.f, 1.f, 1.f, 1.f}, g1 = g0;
                if (norm) { g0 = *(const f32x4*)(g + dl); g1 = *(const f32x4*)(g + dl + 64); }
                size_t boff; int ld, cb;
                if (hh < 16) { boff = WS_Q; ld = DM; cb = hh * HD; } else if (hh < 20) { boff = WS_KD; ld = KVH * HD; cb = (hh - 16) * HD; }
                else if (hh < 40) { boff = WS_QI; ld = DM; cb = (hh - 24) * HD; } else { boff = WS_KI; ld = HD; cb = 0; }
                bf16_t* base = (bf16_t*)(ws + boff);
                const float osc = hh < 16 ? QSCALE : 1.0f;
#pragma unroll
                for (int ai = 0; ai < 2; ++ai)
#pragma unroll
                    for (int m = 0; m < 4; ++m) { const int lrow = ai * 128 + wr * 64 + m * 16 + fr, row = u.pm * 256 + lrow, pos = row & 2047;
                        float sc = rs[ai][m];
                        if (norm) { const f32x4 t = *(const LAS f32x4*)(scr + lrow * 8 + bj * 4); sc *= 1.0f / sqrtf(((t[0] + t[1]) + (t[2] + t[3])) * (1.0f / HD) + NORM_EPS); }
                        sc *= osc;
                        const f32x4 c = *(const f32x4*)(ropeC + pos * 64 + dl), sn = *(const f32x4*)(ropeS + pos * 64 + dl);
                        const f32x4 y0 = acc_in[ai][bj][m][0] * g0 * sc, y1 = acc_in[ai][bj][m][1] * g1 * sc;
                        const f32x4 o0 = y0 * c - y1 * sn, o1 = y1 * c + y0 * sn;
                        bf16_t* rp = base + (size_t)row * ld + cb + dl;
                        u32x2 w0, w1; w0.x = pk2(o0[0], o0[1]); w0.y = pk2(o0[2], o0[3]); w1.x = pk2(o1[0], o1[1]); w1.y = pk2(o1[2], o1[3]);
                        *(u32x2*)rp = w0; *(u32x2*)(rp + 64) = w1; }
            }
        }
    }
};

enum { WM_PLAIN = 0, WM_UP = 1, WM_IN = 2 };
__device__ __forceinline__ int colmap(int kind, int np) {
    if (kind == WM_UP) { const int pn = np >> 8, bj = (np >> 7) & 1, q = np & 127; return bj * FF + 128 * pn + q; }
    if (kind == WM_IN) { const int hh = np >> 7, p = np & 127, d = 16 * (p >> 5) + (p & 15) + 64 * ((p >> 4) & 1);
        if (hh < 41) return hh * 128 + d; return (p < 16) ? (5248 + p) : -1; }
    return np;
}
struct WJ { const float* W; const float* gain; bf16_t* WT; int K, N, NP, kind, local; };
__device__ __forceinline__ void tr_load(const WJ& j, int lane, f32x4 (&v)[16]) {
    const int nblk = j.NP / 64, kb = j.local / nblk, nb = j.local - kb * nblk, k0 = 64 * kb, n0 = 64 * nb;
    const int src = colmap(j.kind, n0 + 4 * (lane & 15)), rg = lane >> 4;
    const float* p = j.W + (size_t)(k0 + rg) * j.N + (src >= 0 ? src : 0);
#pragma unroll
    for (int i = 0; i < 16; ++i) { v[i] = *(const f32x4*)(p + (size_t)(4 * i) * j.N); if (src < 0) v[i] = (f32x4){0.f, 0.f, 0.f, 0.f}; }
}
__device__ __forceinline__ void tr_process(const WJ& j, int lane, const f32x4 (&v)[16], LAS float* scr) {
    const int nblk = j.NP / 64, kb = j.local / nblk, nb = j.local - kb * nblk, k0 = 64 * kb, n0 = 64 * nb;
    const int rg = lane >> 4, cg = lane & 15;
    float gl = 1.0f; if (j.gain) gl = j.gain[k0 + lane];
#pragma unroll
    for (int i = 0; i < 16; ++i) { const int kk = 4 * i + rg; const float g = __shfl(gl, kk); LAS float* d = scr + kk * 65 + 4 * cg;
        d[0] = v[i][0] * g; d[1] = v[i][1] * g; d[2] = v[i][2] * g; d[3] = v[i][3] * g; }
    asm volatile("s_waitcnt lgkmcnt(0)" ::: "memory");
    const int c = lane & 7;
#pragma unroll
    for (int jj = 0; jj < 8; ++jj) { const int n = (lane >> 3) + 8 * jj; const LAS float* s = scr + (8 * c) * 65 + n;
        u32x4 o; o.x = pk2(s[0 * 65], s[1 * 65]); o.y = pk2(s[2 * 65], s[3 * 65]); o.z = pk2(s[4 * 65], s[5 * 65]); o.w = pk2(s[6 * 65], s[7 * 65]);
        *(u32x4*)(j.WT + (size_t)(n0 + n) * j.K + k0 + 8 * c) = o; }
    asm volatile("s_waitcnt lgkmcnt(0)" ::: "memory");
}

struct Args {
    const float* x; const float* attn_g; const float* ffn_g; const float* w_qkv; const float* w_o0; const float* w_in;
    const float* qn_g; const float* kn_g; const float* ikn_g; const float* w_o1; const float* w_up; const float* conv_w; const float* conv_b; const float* w_down;
    float* out; unsigned char* ws; int ph_lo, ph_hi;
};

constexpr int WI0 = 32 * 96, WI1 = WI0 + 32 * 32, WI2 = WI1 + 32 * 84, WI3 = WI2 + 32 * 32, WI4 = WI3 + 32 * 176, WI5 = WI4 + 32 * 176, WI6 = WI5 + 88 * 32, WI7 = WI6 + 88 * 32;
__device__ __forceinline__ WJ wj_decode(const Args& a, int it) {
    unsigned char* ws = a.ws; WJ j;
    if (it < WI0)      j = WJ{a.w_qkv, nullptr, (bf16_t*)(ws + WS_WQKV), DM, NQKV, NQKV, WM_PLAIN, it};
    else if (it < WI1) j = WJ{a.w_o0, nullptr, (bf16_t*)(ws + WS_WO0), DM, DM, DM, WM_PLAIN, it - WI0};
    else if (it < WI2) j = WJ{a.w_in, a.attn_g + DM, (bf16_t*)(ws + WS_WIN), DM, NIN, NINP, WM_IN, it - WI1};
    else if (it < WI3) j = WJ{a.w_o1, nullptr, (bf16_t*)(ws + WS_WO1), DM, DM, DM, WM_PLAIN, it - WI2};
    else if (it < WI4) j = WJ{a.w_up, a.ffn_g, (bf16_t*)(ws + WS_WUP), DM, NUP, NUP, WM_UP, it - WI3};
    else if (it < WI5) j = WJ{a.w_up + (size_t)DM * NUP, a.ffn_g + DM, (bf16_t*)(ws + WS_WUP + 44 * MiB), DM, NUP, NUP, WM_UP, it - WI4};
    else if (it < WI6) j = WJ{a.w_down, nullptr, (bf16_t*)(ws + WS_WDN), FF, DM, DM, WM_PLAIN, it - WI5};
    else               j = WJ{a.w_down + (size_t)FF * DM, nullptr, (bf16_t*)(ws + WS_WDN + 22 * MiB), FF, DM, DM, WM_PLAIN, it - WI6};
    return j;
}
__device__ __forceinline__ void convert_items(const Args& a, LAS float* scr, int lo, int hi, int vw, int nvw, int lane) {
    int it = lo + vw;
    if (it >= hi) return;
    f32x4 va[16], vb[16];
    WJ ja = wj_decode(a, it), jb = ja;
    tr_load(ja, lane, va);
    for (;;) {
        int nx = it + nvw; bool hn = nx < hi;
        if (hn) { jb = wj_decode(a, nx); tr_load(jb, lane, vb); }
        tr_process(ja, lane, va, scr);
        if (!hn) break;
        it = nx; nx = it + nvw; hn = nx < hi;
        if (hn) { ja = wj_decode(a, nx); tr_load(ja, lane, va); }
        tr_process(jb, lane, vb, scr);
        if (!hn) break;
        it = nx;
    }
}
struct Offload { int g_up, g_in; bool up0, in1, up1; };
__device__ __forceinline__ Offload make_offload(int G) {
    Offload o; const int u_up = 33 * (NUP / 256), u_in = (MTOK / 256) * (NINP / 256);
    const int r_up = (u_up + G - 1) / G, r_in = (u_in + G - 1) / G;
    o.g_up = (u_up + r_up - 1) / r_up; o.g_in = (u_in + r_in - 1) / r_in;
    o.up0 = (G - o.g_up) >= 8; o.up1 = o.up0; o.in1 = (G - o.g_in) >= 16;
    return o;
}
__device__ __forceinline__ void prologue_phase(const Args& a, LAS unsigned char* lds, int gw, int ngw, int wave, int lane, const Offload& offl) {
    unsigned char* ws = a.ws;
    LAS float* scr = (LAS float*)(lds + wave * 16640);
    convert_items(a, scr, 0, WI1, gw, ngw, lane);
    convert_items(a, scr, WI3, WI4, gw, ngw, lane);
    if (!offl.up0) { convert_items(a, scr, WI5, WI6, gw, ngw, lane); convert_items(a, scr, WI1, WI2, gw, ngw, lane); }
    if (!offl.in1) { convert_items(a, scr, WI2, WI3, gw, ngw, lane); convert_items(a, scr, WI4, WI5, gw, ngw, lane); }
    if (!offl.up1) { convert_items(a, scr, WI6, WI7, gw, ngw, lane); }
    bf16_t* XB = (bf16_t*)(ws + WS_XB);
    for (int m = gw; m < MTOK; m += ngw) {
        const f32x4* xr = (const f32x4*)(a.x + (size_t)m * DM) + lane;
        f32x4 v[8]; float s = 0.f;
#pragma unroll
        for (int j = 0; j < 8; ++j) { v[j] = xr[64 * j]; s += (v[j].x * v[j].x + v[j].y * v[j].y) + (v[j].z * v[j].z + v[j].w * v[j].w); }
        const float rstd = 1.0f / sqrtf(wave_sum(s) * (1.0f / DM) + NORM_EPS);
        u32x2* o8 = (u32x2*)(XB + (size_t)m * DM) + lane;
#pragma unroll
        for (int j = 0; j < 8; ++j) { const f32x4 g = ((const f32x4*)a.attn_g)[lane + 64 * j]; u32x2 w; w.x = pk2(v[j].x * rstd * g.x, v[j].y * rstd * g.y); w.y = pk2(v[j].z * rstd * g.z, v[j].w * rstd * g.w); o8[64 * j] = w; }
    }
    if (gw == 0) { float* gn = (float*)(ws + WS_GAIN); for (int i = lane; i < 128; i += 64) { gn[i] = a.qn_g[i]; gn[128 + i] = a.kn_g[i]; gn[256 + i] = a.ikn_g[i]; } }
    float* rc = (float*)(ws + WS_ROPE); float* rsn = rc + SEQ * 64;
    for (int i = gw * 64 + lane; i < SEQ * 64; i += ngw * 64) {
        const int pos = i >> 6, fi = i & 63;
        const float inv_freq = (float)(1.0 / exp2((double)fi * (2.0 / 128.0) * 13.287712379549449));
        const float ang = (float)pos * inv_freq;
        const double x = (double)ang; const double kq = rint(x * 0.63661977236758134308);
        double r = __builtin_fma(-kq, 1.57079632679489655800e+00, x); r = __builtin_fma(-kq, 6.12323399573676603587e-17, r);
        const double r2 = r * r;
        double sp = -1.0 / 6227020800.0; sp = sp * r2 + 1.0 / 39916800.0; sp = sp * r2 - 1.0 / 362880.0; sp = sp * r2 + 1.0 / 5040.0; sp = sp * r2 - 1.0 / 120.0; sp = sp * r2 + 1.0 / 6.0; const double sv = r - r * r2 * sp;
        double cp = 1.0 / 87178291200.0; cp = cp * r2 - 1.0 / 479001600.0; cp = cp * r2 + 1.0 / 3628800.0; cp = cp * r2 - 1.0 / 40320.0; cp = cp * r2 + 1.0 / 720.0; cp = cp * r2 - 1.0 / 24.0; cp = cp * r2 + 0.5; const double cv = 1.0 - r2 * cp;
        const int q = ((int)kq) & 3;
        const double cs = (q == 0) ? cv : (q == 1) ? -sv : (q == 2) ? -cv : sv;
        const double sn = (q == 0) ? sv : (q == 1) ? cv : (q == 2) ? -sv : -cv;
        rc[i] = (float)cs; rsn[i] = (float)sn;
    }
}

constexpr float SB_EXIT = 220.0f;
__device__ __forceinline__ void sb_attn_phase(const bf16_t* __restrict__ Q, const bf16_t* __restrict__ K, const bf16_t* __restrict__ Vt, bf16_t* __restrict__ O, int gw, int ngw, int lane) {
    const int r = lane & 31, hh = lane >> 5;
    bf16x8 uf[2];
#pragma unroll
    for (int s2 = 0; s2 < 2; ++s2) { u32x4 w;
        unsigned e[8];
#pragma unroll
        for (int j = 0; j < 8; ++j) { const int key = 16 * s2 + 8 * (j >> 2) + 4 * hh + (j & 3); e[j] = (key >= r) ? 0x3f80u : 0u; }
        w.x = e[0] | (e[1] << 16); w.y = e[2] | (e[3] << 16); w.z = e[4] | (e[5] << 16); w.w = e[6] | (e[7] << 16); uf[s2] = __builtin_bit_cast(bf16x8, w); }
    for (int unit = gw; unit < BATCH * NH * 64; unit += ngw) {
        const int bh = unit >> 6, qt = 63 - (unit & 63), b = bh >> 4, h = bh & 15, q0 = qt * 32;
        const bf16_t* qp = Q + (size_t)(b * SEQ + q0 + r) * DM + h * HD + 8 * hh;
        bf16x8 qf[8];
#pragma unroll
        for (int s = 0; s < 8; ++s) qf[s] = *(const bf16x8*)(qp + 16 * s);
        f32x16 o[4];
#pragma unroll
        for (int d = 0; d < 4; ++d) o[d] = f32x16{};
        float carry = 0.f;
        const bf16_t* kbase = K + (size_t)(b * SEQ + r) * DM + h * HD + 8 * hh;
        const bf16_t* vbase = Vt + ((size_t)bh * HD + r) * SEQ + 4 * hh;
        for (int kt = qt; kt >= 0; --kt) {
            const int key0 = kt * 32;
            const bf16_t* kp = kbase + (size_t)key0 * DM;
            bf16x8 kf[8];
#pragma unroll
            for (int s = 0; s < 8; ++s) kf[s] = *(const bf16x8*)(kp + 16 * s);
            bf16x8 vf[4][2];
#pragma unroll
            for (int d = 0; d < 4; ++d)
#pragma unroll
                for (int s2 = 0; s2 < 2; ++s2) { const bf16_t* vp = vbase + (size_t)(32 * d) * SEQ + key0 + 16 * s2;
                    const s16x4 lo = *(const s16x4*)vp, hi = *(const s16x4*)(vp + 8);
                    vf[d][s2] = (bf16x8){lo[0], lo[1], lo[2], lo[3], hi[0], hi[1], hi[2], hi[3]}; }
            f32x16 p = f32x16{};
#pragma unroll
            for (int s = 0; s < 8; ++s) p = __builtin_amdgcn_mfma_f32_32x32x16_bf16(kf[s], qf[s], p, 0, 0, 0);
            const bool diag = (kt == qt);
            f32x16 sp;
#pragma unroll
            for (int i = 0; i < 16; ++i) { const float z = p[i]; float v = fmaxf(z, 0.f) + __builtin_amdgcn_logf(1.0f + __builtin_amdgcn_exp2f(-fabsf(z)));
                if (diag && crow(i, hh) >= r) v = 0.f; sp[i] = v; }
            f32x16 c;
#pragma unroll
            for (int i = 0; i < 16; ++i) c[i] = carry;
            c = __builtin_amdgcn_mfma_f32_32x32x16_bf16(uf[0], pack8(sp, 0), c, 0, 0, 0);
            c = __builtin_amdgcn_mfma_f32_32x32x16_bf16(uf[1], pack8(sp, 8), c, 0, 0, 0);
            f32x16 av;
#pragma unroll
            for (int i = 0; i < 16; ++i) { float v = __builtin_amdgcn_exp2f(p[i] - c[i]); if (diag && crow(i, hh) >= r) v = 0.f; av[i] = v; }
            carry = swap_max(c[0]);
            const bf16x8 pa0 = pack8(av, 0), pa1 = pack8(av, 8);
#pragma unroll
            for (int d = 0; d < 4; ++d) { o[d] = __builtin_amdgcn_mfma_f32_32x32x16_bf16(vf[d][0], pa0, o[d], 0, 0, 0); o[d] = __builtin_amdgcn_mfma_f32_32x32x16_bf16(vf[d][1], pa1, o[d], 0, 0, 0); }
            if (__all(carry > SB_EXIT)) break;
        }
        bf16_t* op = O + (size_t)(b * SEQ + q0 + r) * DM + h * HD + 4 * hh;
#pragma unroll
        for (int d = 0; d < 4; ++d)
#pragma unroll
            for (int g = 0; g < 4; ++g) { u32x2 w; w.x = pk2(o[d][4 * g], o[d][4 * g + 1]); w.y = pk2(o[d][4 * g + 2], o[d][4 * g + 3]); *(u32x2*)(op + 32 * d + 8 * g) = w; }
    }
}

__device__ __forceinline__ void conv_phase(const bf16_t* __restrict__ U, const float* __restrict__ cw, const float* __restrict__ cb, bf16_t* __restrict__ ACT, int gtid, int nthreads) {
    constexpr int C8 = FF / 8;
    for (int it = gtid; it < MTOK * C8; it += nthreads) {
        const int row = it / C8, c8 = it - row * C8, j0 = c8 * 8, pn = j0 >> 7, q = j0 & 127, s = row & 2047;
        const bf16_t* ug = U + (size_t)row * NUP + 256 * pn + q;
        float cgv[2][8];
#pragma unroll
        for (int half = 0; half < 2; ++half) {
            const bf16_t* up = ug + half * 128; const int cc = half * FF + j0;
            const f32x4 b0 = *(const f32x4*)(cb + cc), b1 = *(const f32x4*)(cb + cc + 4);
            float accv[8] = {b0[0], b0[1], b0[2], b0[3], b1[0], b1[1], b1[2], b1[3]};
#pragma unroll
            for (int tap = 0; tap < 3; ++tap) { const int back = 2 - tap;
                if (s >= back) { const u32x4 w = *(const u32x4*)(up - (size_t)back * NUP);
                    const f32x4 w0 = *(const f32x4*)(cw + (size_t)tap * NUP + cc), w1 = *(const f32x4*)(cw + (size_t)tap * NUP + cc + 4);
                    accv[0] += __uint_as_float(w.x << 16) * w0[0]; accv[1] += __uint_as_float(w.x & 0xffff0000u) * w0[1];
                    accv[2] += __uint_as_float(w.y << 16) * w0[2]; accv[3] += __uint_as_float(w.y & 0xffff0000u) * w0[3];
                    accv[4] += __uint_as_float(w.z << 16) * w1[0]; accv[5] += __uint_as_float(w.z & 0xffff0000u) * w1[1];
                    accv[6] += __uint_as_float(w.w << 16) * w1[2]; accv[7] += __uint_as_float(w.w & 0xffff0000u) * w1[3]; } }
#pragma unroll
            for (int e = 0; e < 8; ++e) cgv[half][e] = accv[e];
        }
        float a8[8];
#pragma unroll
        for (int e = 0; e < 8; ++e) { const float gx = cgv[0][e]; a8[e] = gx / (1.0f + __expf(-gx)) * cgv[1][e]; }
        u32x4 w; w.x = pk2(a8[0], a8[1]); w.y = pk2(a8[2], a8[3]); w.z = pk2(a8[4], a8[5]); w.w = pk2(a8[6], a8[7]);
        *(u32x4*)(ACT + (size_t)row * FF + j0) = w;
    }
}

__device__ __forceinline__ unsigned fmap(float f) { const unsigned u = __float_as_uint(f); return (u & 0x80000000u) ? ~u : (u | 0x80000000u); }
__device__ __forceinline__ void indexer_unit(const bf16_t* __restrict__ QI, const bf16_t* __restrict__ KI, const float* __restrict__ WI, unsigned* __restrict__ MASK, LAS float* sc, int b, int t0, int wave, int lane) {
    const int r = lane & 31, hh = lane >> 5, ql_r = r >> 4, head_r = r & 15;
    const int tw = t0 + 2 * wave;
    const bf16_t* ap = QI + (size_t)(b * SEQ + tw + ql_r) * DM + head_r * HD + 8 * hh;
    bf16x8 af[8];
#pragma unroll
    for (int s = 0; s < 8; ++s) af[s] = *(const bf16x8*)(ap + 16 * s);
    float wv[16];
#pragma unroll
    for (int i = 0; i < 16; ++i) { const int rw = crow(i, hh); wv[i] = WI[(size_t)(b * SEQ + tw + (rw >> 4)) * 16 + (rw & 15)]; }
    const int nkt = (t0 + 16 + 31) >> 5;
    const bf16_t* kb = KI + (size_t)(b * SEQ + r) * HD + 8 * hh;
    LAS float* myrow = sc + (2 * wave + hh) * SEQ;
    const int tq = tw + hh;
    for (int kt = 0; kt < nkt; ++kt) {
        const bf16_t* kp = kb + (size_t)kt * 32 * HD;
        bf16x8 bfr[8];
#pragma unroll
        for (int s = 0; s < 8; ++s) bfr[s] = *(const bf16x8*)(kp + 16 * s);
        f32x16 c = f32x16{};
#pragma unroll
        for (int s = 0; s < 8; ++s) c = __builtin_amdgcn_mfma_f32_32x32x16_bf16(af[s], bfr[s], c, 0, 0, 0);
        float s0 = 0.f, s1 = 0.f;
#pragma unroll
        for (int i = 0; i < 8; ++i) { s0 += wv[i] * fmaxf(c[i], 0.f); s1 += wv[i + 8] * fmaxf(c[i + 8], 0.f); }
        const float t0s = swap_sum(s0), t1s = swap_sum(s1);
        const int key = kt * 32 + r;
        float v = (hh ? t1s : t0s) + 0.0f;
        if (key > tq) v = -INFINITY;
        myrow[key] = v;
    }
    asm volatile("s_waitcnt lgkmcnt(0)" ::: "memory");
    for (int ql = 0; ql < 2; ++ql) {
        const int t = tw + ql, n = t + 1;
        unsigned* mrow = MASK + (size_t)(b * SEQ + t) * 64;
        if (n <= TOPK) {
            const int key0 = 32 * lane; unsigned w;
            if (key0 + 31 <= t) w = 0xffffffffu; else if (key0 > t) w = 0u; else w = (1u << (t - key0 + 1)) - 1u;
            mrow[lane] = w;
        } else {
            const LAS float* row = sc + (2 * wave + ql) * SEQ;
            unsigned uv[32];
#pragma unroll
            for (int e = 0; e < 32; ++e) { const int key = e * 64 + lane; uv[e] = (key < n) ? fmap(row[key]) : 0x007fffffu; }
            unsigned prefix = 0u;
            for (int bit = 31; bit >= 0; --bit) {
                const unsigned cand = prefix | (1u << bit); int cnt = 0;
#pragma unroll
                for (int e = 0; e < 32; ++e) cnt += __popcll(__ballot(uv[e] >= cand));
                if (cnt >= TOPK) prefix = cand;
            }
            int cgt = 0;
#pragma unroll
            for (int e = 0; e < 32; ++e) cgt += __popcll(__ballot(uv[e] > prefix));
            const int need = TOPK - cgt; int running = 0;
            const unsigned long long ltm = (1ull << lane) - 1ull;
            unsigned long long keep = 0ull;
#pragma unroll
            for (int e = 0; e < 32; ++e) {
                const unsigned long long eq = __ballot(uv[e] == prefix);
                const bool sel = (uv[e] > prefix) || (uv[e] == prefix && (running + __popcll(eq & ltm)) < need);
                const unsigned long long m64 = __ballot(sel);
                running += __popcll(eq);
                if (lane == e) keep = m64;
            }
            if (lane < 32) *(unsigned long long*)(mrow + 2 * lane) = keep;
        }
    }
    asm volatile("s_waitcnt lgkmcnt(0)" ::: "memory");
}

__device__ __forceinline__ void dsa_attn_unit(const bf16_t* __restrict__ QD, const bf16_t* __restrict__ KD, const bf16_t* __restrict__ VTD, const unsigned* __restrict__ MASK, bf16_t* __restrict__ O,
                                              int b, int g, int h, int q0, int lane) {
    const int r = lane & 31, hh = lane >> 5;
    const bf16_t* qp = QD + (size_t)(b * SEQ + q0 + r) * DM + h * HD + 8 * hh;
    bf16x8 qf[8];
#pragma unroll
    for (int s = 0; s < 8; ++s) qf[s] = *(const bf16x8*)(qp + 16 * s);
    f32x16 o[4];
#pragma unroll
    for (int d = 0; d < 4; ++d) o[d] = f32x16{};
    float mrun = -1e30f, lrun = 0.f;
    const bf16_t* kbase = KD + (size_t)(b * SEQ + r) * (KVH * HD) + g * HD + 8 * hh;
    const bf16_t* vbase = VTD + ((size_t)(b * KVH + g) * HD + r) * SEQ + 4 * hh;
    const unsigned* mrow = MASK + (size_t)(b * SEQ + q0 + r) * 64;
    const int nkt = (q0 + 32) >> 5;
    for (int kt = 0; kt < nkt; ++kt) {
        const int key0 = kt * 32;
        const bf16_t* kp = kbase + (size_t)key0 * (KVH * HD);
        bf16x8 kf[8];
#pragma unroll
        for (int s = 0; s < 8; ++s) kf[s] = *(const bf16x8*)(kp + 16 * s);
        const unsigned mw = mrow[kt];
        bf16x8 vf[4][2];
#pragma unroll
        for (int d = 0; d < 4; ++d)
#pragma unroll
            for (int s2 = 0; s2 < 2; ++s2) { const bf16_t* vp = vbase + (size_t)(32 * d) * SEQ + key0 + 16 * s2;
                const s16x4 lo = *(const s16x4*)vp, hi = *(const s16x4*)(vp + 8);
                vf[d][s2] = (bf16x8){lo[0], lo[1], lo[2], lo[3], hi[0], hi[1], hi[2], hi[3]}; }
        f32x16 p = f32x16{};
#pragma unroll
        for (int s = 0; s < 8; ++s) p = __builtin_amdgcn_mfma_f32_32x32x16_bf16(kf[s], qf[s], p, 0, 0, 0);
        float tmax = -1e30f;
#pragma unroll
        for (int i = 0; i < 16; ++i) { const bool valid = (mw >> crow(i, hh)) & 1u; tmax = fmaxf(tmax, valid ? p[i] : -1e30f); }
        tmax = swap_max(tmax);
        const float mnew = fmaxf(mrun, tmax), alpha = __builtin_amdgcn_exp2f(mrun - mnew);
        float ls = 0.f; f32x16 pe;
#pragma unroll
        for (int i = 0; i < 16; ++i) { const bool valid = (mw >> crow(i, hh)) & 1u; const float e = valid ? __builtin_amdgcn_exp2f(p[i] - mnew) : 0.f; pe[i] = e; ls += e; }
        lrun = lrun * alpha + ls; mrun = mnew;
#pragma unroll
        for (int d = 0; d < 4; ++d)
#pragma unroll
            for (int i = 0; i < 16; ++i) o[d][i] *= alpha;
        const bf16x8 pa0 = pack8(pe, 0), pa1 = pack8(pe, 8);
#pragma unroll
        for (int d = 0; d < 4; ++d) { o[d] = __builtin_amdgcn_mfma_f32_32x32x16_bf16(vf[d][0], pa0, o[d], 0, 0, 0); o[d] = __builtin_amdgcn_mfma_f32_32x32x16_bf16(vf[d][1], pa1, o[d], 0, 0, 0); }
    }
    const float linv = 1.0f / swap_sum(lrun);
    bf16_t* op = O + (size_t)(b * SEQ + q0 + r) * DM + h * HD + 4 * hh;
#pragma unroll
    for (int d = 0; d < 4; ++d)
#pragma unroll
        for (int gq = 0; gq < 4; ++gq) { u32x2 w; w.x = pk2(o[d][4 * gq] * linv, o[d][4 * gq + 1] * linv); w.y = pk2(o[d][4 * gq + 2] * linv, o[d][4 * gq + 3] * linv); *(u32x2*)(op + 32 * d + 8 * gq) = w; }
}


constexpr int KSTR = 272, VSTR = 136, KTILE_B = 64 * KSTR, VTILE_B = 128 * VSTR, KVBUF_B = KTILE_B + VTILE_B;
struct KVStage {
    u32x4 k[2], v[2];
    __device__ __forceinline__ void load(const unsigned char* kg, size_t kstride, const unsigned char* vg, size_t vstride, int tid) {
#pragma unroll
        for (int i = 0; i < 2; ++i) { const int c = tid + 512 * i; k[i] = *(const u32x4*)(kg + (size_t)(c >> 4) * kstride + (c & 15) * 16); v[i] = *(const u32x4*)(vg + (size_t)(c >> 3) * vstride + (c & 7) * 16); }
    }
    __device__ __forceinline__ void store(LAS unsigned char* buf, int tid) const {
#pragma unroll
        for (int i = 0; i < 2; ++i) { const int c = tid + 512 * i;
            *(LAS u32x4*)(buf + (c >> 4) * KSTR + (c & 15) * 16) = k[i];
            LAS unsigned char* vp = buf + KTILE_B + (c >> 3) * VSTR + (c & 7) * 16;
            *(LAS u32x2*)vp = (u32x2){v[i].x, v[i].y}; *(LAS u32x2*)(vp + 8) = (u32x2){v[i].z, v[i].w}; }
    }
};

__device__ __forceinline__ void dsa_attn_block(const bf16_t* __restrict__ QD, const bf16_t* __restrict__ KD, const bf16_t* __restrict__ VTD, const unsigned* __restrict__ MASK, bf16_t* __restrict__ O,
                                               LAS unsigned char* lds, int b, int g, int qb64, int wave, int lane, int tid) {
    const int r = lane & 31, hh = lane >> 5, h = 4 * g + (wave & 3), q0 = 64 * qb64 + 32 * (wave >> 2);
    LAS unsigned char* qlds = lds + 2 * KVBUF_B + wave * (32 * KSTR);
    { const unsigned char* qg = (const unsigned char*)(QD + (size_t)(b * SEQ + q0) * DM + h * HD);
        u32x4 t[8];
#pragma unroll
        for (int i = 0; i < 8; ++i) { const int c = lane + 64 * i; t[i] = *(const u32x4*)(qg + (size_t)(c >> 4) * (DM * 2) + (c & 15) * 16); }
#pragma unroll
        for (int i = 0; i < 8; ++i) { const int c = lane + 64 * i; *(LAS u32x4*)(qlds + (c >> 4) * KSTR + (c & 15) * 16) = t[i]; }
        asm volatile("s_waitcnt lgkmcnt(0)" ::: "memory"); }
    const LAS unsigned char* qfp = qlds + r * KSTR + 16 * hh;
    f32x16 o[4];
#pragma unroll
    for (int d = 0; d < 4; ++d) o[d] = f32x16{};
    float mrun = -1e30f, lrun = 0.f;
    const unsigned char* kg = (const unsigned char*)(KD + (size_t)(b * SEQ) * (KVH * HD) + g * HD);
    const unsigned char* vg = (const unsigned char*)(VTD + (size_t)(b * KVH + g) * HD * SEQ);
    const unsigned long long* mrow = (const unsigned long long*)(MASK + (size_t)(b * SEQ + q0 + r) * 64);
    KVStage sA, sB;
#define MA_LOAD(ST, t) ST.load(kg + (size_t)(t) * 64 * (KVH * HD * 2), KVH * HD * 2, vg + (size_t)(t) * 64 * 2, SEQ * 2, tid)
    MA_LOAD(sA, 0);
    sA.store(lds, tid);
    asm volatile("s_waitcnt lgkmcnt(0)" ::: "memory"); __builtin_amdgcn_s_barrier(); asm volatile("" ::: "memory");
    if (qb64 >= 1) MA_LOAD(sA, 1);
    if (qb64 >= 2) MA_LOAD(sB, 2);
    unsigned long long mw_next = mrow[0];
    for (int kt = 0; kt <= qb64; ++kt) {
        LAS unsigned char* buf = lds + (kt & 1) * KVBUF_B;
        const unsigned long long mw = mw_next;
        if (kt < qb64) mw_next = mrow[kt + 1];
        const bool two = (64 * kt + 32) <= q0 + 31;
        f32x16 p0 = f32x16{}, p1 = f32x16{};
        { const LAS unsigned char* kp = buf + r * KSTR + 16 * hh;
            bf16x8 qf[8];
#pragma unroll
            for (int s = 0; s < 8; ++s) qf[s] = *(const LAS bf16x8*)(qfp + 32 * s);
#pragma unroll
            for (int s = 0; s < 8; ++s) p0 = __builtin_amdgcn_mfma_f32_32x32x16_bf16(*(const LAS bf16x8*)(kp + 32 * s), qf[s], p0, 0, 0, 0);
            if (two) {
#pragma unroll
                for (int s = 0; s < 8; ++s) p1 = __builtin_amdgcn_mfma_f32_32x32x16_bf16(*(const LAS bf16x8*)(kp + 32 * KSTR + 32 * s), qf[s], p1, 0, 0, 0); } }
        const unsigned m0 = ((unsigned)mw) >> (4 * hh), m1 = two ? (((unsigned)(mw >> 32)) >> (4 * hh)) : 0u;
        float tmax = -1e30f;
#pragma unroll
        for (int i = 0; i < 16; ++i) { const int kb = crow(i, 0); tmax = fmaxf(tmax, ((m0 >> kb) & 1u) ? p0[i] : -1e30f); tmax = fmaxf(tmax, ((m1 >> kb) & 1u) ? p1[i] : -1e30f); }
        tmax = swap_max(tmax);
        const float mnew = fmaxf(mrun, tmax);
        if (__any(mnew > mrun)) {
            const float alpha = __builtin_amdgcn_exp2f(mrun - mnew);
            lrun *= alpha;
#pragma unroll
            for (int d = 0; d < 4; ++d)
#pragma unroll
                for (int i = 0; i < 16; ++i) o[d][i] *= alpha;
        }
        float ls = 0.f;
#pragma unroll
        for (int i = 0; i < 16; ++i) { const int kb = crow(i, 0);
            const float e0 = ((m0 >> kb) & 1u) ? __builtin_amdgcn_exp2f(p0[i] - mnew) : 0.f, e1 = ((m1 >> kb) & 1u) ? __builtin_amdgcn_exp2f(p1[i] - mnew) : 0.f;
            p0[i] = e0; p1[i] = e1; ls += e0 + e1; }
        lrun += ls; mrun = mnew;
        const bf16x8 pa0 = pack8(p0, 0), pa1 = pack8(p0, 8), pa2 = pack8(p1, 0), pa3 = pack8(p1, 8);
        const LAS unsigned char* vb = buf + KTILE_B + r * VSTR + 8 * hh;
#pragma unroll
        for (int d = 0; d < 4; ++d) {
            const LAS unsigned char* vp = vb + 32 * d * VSTR;
#define VFRAG(ks) ({ const s16x4 lo_ = *(const LAS s16x4*)(vp + 32 * (ks)), hi_ = *(const LAS s16x4*)(vp + 32 * (ks) + 16); (bf16x8){lo_[0], lo_[1], lo_[2], lo_[3], hi_[0], hi_[1], hi_[2], hi_[3]}; })
            o[d] = __builtin_amdgcn_mfma_f32_32x32x16_bf16(VFRAG(0), pa0, o[d], 0, 0, 0);
            o[d] = __builtin_amdgcn_mfma_f32_32x32x16_bf16(VFRAG(1), pa1, o[d], 0, 0, 0);
            if (two) { o[d] = __builtin_amdgcn_mfma_f32_32x32x16_bf16(VFRAG(2), pa2, o[d], 0, 0, 0);
                       o[d] = __builtin_amdgcn_mfma_f32_32x32x16_bf16(VFRAG(3), pa3, o[d], 0, 0, 0); }
#undef VFRAG
        }
        if (kt & 1) { if (kt + 1 <= qb64) sB.store(lds + ((kt + 1) & 1) * KVBUF_B, tid); if (kt + 3 <= qb64) MA_LOAD(sB, kt + 3); }
        else        { if (kt + 1 <= qb64) sA.store(lds + ((kt + 1) & 1) * KVBUF_B, tid); if (kt + 3 <= qb64) MA_LOAD(sA, kt + 3); }
        asm volatile("s_waitcnt lgkmcnt(0)" ::: "memory"); __builtin_amdgcn_s_barrier(); asm volatile("" ::: "memory");
    }
#undef MA_LOAD
    asm volatile("s_waitcnt vmcnt(0)" ::: "memory");
    const float linv = 1.0f / swap_sum(lrun);
    bf16_t* op = O + (size_t)(b * SEQ + q0 + r) * DM + h * HD + 4 * hh;
#pragma unroll
    for (int d = 0; d < 4; ++d)
#pragma unroll
        for (int gq = 0; gq < 4; ++gq) { u32x2 w; w.x = pk2(o[d][4 * gq] * linv, o[d][4 * gq + 1] * linv); w.y = pk2(o[d][4 * gq + 2] * linv, o[d][4 * gq + 3] * linv); *(u32x2*)(op + 32 * d + 8 * gq) = w; }
}


__device__ __forceinline__ void sb_subtile(const LAS unsigned char* kp, const LAS unsigned char* vb, const bf16x8 (&qf)[8], const bf16x8 (&uf)[2], f32x16 (&o)[4], float& carry, bool diag, int rm) {
    f32x16 p = f32x16{};
#pragma unroll
    for (int s = 0; s < 8; ++s) p = __builtin_amdgcn_mfma_f32_32x32x16_bf16(*(const LAS bf16x8*)(kp + 32 * s), qf[s], p, 0, 0, 0);
    f32x16 sp;
#pragma unroll
    for (int i = 0; i < 16; ++i) { const float z = p[i]; float v = fmaxf(z, 0.f) + __builtin_amdgcn_logf(1.0f + __builtin_amdgcn_exp2f(-fabsf(z)));
        if (diag && crow(i, 0) >= rm) v = 0.f; sp[i] = v; }
    f32x16 c;
#pragma unroll
    for (int i = 0; i < 16; ++i) c[i] = carry;
    c = __builtin_amdgcn_mfma_f32_32x32x16_bf16(uf[0], pack8(sp, 0), c, 0, 0, 0);
    c = __builtin_amdgcn_mfma_f32_32x32x16_bf16(uf[1], pack8(sp, 8), c, 0, 0, 0);
#pragma unroll
    for (int i = 0; i < 16; ++i) { float v = __builtin_amdgcn_exp2f(p[i] - c[i]); if (diag && crow(i, 0) >= rm) v = 0.f; p[i] = v; }
    carry = swap_max(c[0]);
    const bf16x8 pa0 = pack8(p, 0), pa1 = pack8(p, 8);
#pragma unroll
    for (int d = 0; d < 4; ++d) { const LAS unsigned char* vp = vb + 32 * d * VSTR;
        const s16x4 l0 = *(const LAS s16x4*)vp, h0 = *(const LAS s16x4*)(vp + 16), l1 = *(const LAS s16x4*)(vp + 32), h1 = *(const LAS s16x4*)(vp + 48);
        o[d] = __builtin_amdgcn_mfma_f32_32x32x16_bf16((bf16x8){l0[0], l0[1], l0[2], l0[3], h0[0], h0[1], h0[2], h0[3]}, pa0, o[d], 0, 0, 0);
        o[d] = __builtin_amdgcn_mfma_f32_32x32x16_bf16((bf16x8){l1[0], l1[1], l1[2], l1[3], h1[0], h1[1], h1[2], h1[3]}, pa1, o[d], 0, 0, 0); }
}
__device__ __forceinline__ void sb_attn_block(const bf16_t* __restrict__ Q, const bf16_t* __restrict__ K, const bf16_t* __restrict__ Vt, bf16_t* __restrict__ O, LAS unsigned char* lds,
                                              int bh, int qblk, int wave, int lane, int tid) {
    const int r = lane & 31, hh = lane >> 5, b = bh >> 4, h = bh & 15, q0 = qblk * 256 + wave * 32, rm = r - 4 * hh;
    bf16x8 uf[2];
#pragma unroll
    for (int s2 = 0; s2 < 2; ++s2) { u32x4 w; unsigned e[8];
#pragma unroll
        for (int j = 0; j < 8; ++j) { const int key = 16 * s2 + 8 * (j >> 2) + 4 * hh + (j & 3); e[j] = (key >= r) ? 0x3f80u : 0u; }
        w.x = e[0] | (e[1] << 16); w.y = e[2] | (e[3] << 16); w.z = e[4] | (e[5] << 16); w.w = e[6] | (e[7] << 16); uf[s2] = __builtin_bit_cast(bf16x8, w); }
    const bf16_t* qp = Q + (size_t)(b * SEQ + q0 + r) * DM + h * HD + 8 * hh;
    bf16x8 qf[8];
#pragma unroll
    for (int s = 0; s < 8; ++s) qf[s] = *(const bf16x8*)(qp + 16 * s);
    f32x16 o[4];
#pragma unroll
    for (int d = 0; d < 4; ++d) o[d] = f32x16{};
    float carry = 0.f; bool done = false;
    const unsigned char* kg = (const unsigned char*)(K + (size_t)(b * SEQ) * DM + h * HD);
    const unsigned char* vg = (const unsigned char*)(Vt + (size_t)bh * HD * SEQ);
    volatile LAS unsigned* flags = (volatile LAS unsigned*)(lds + 2 * KVBUF_B);
    const int ktop = qblk * 4 + 3;
    KVStage sA, sB;
#define SB_LOAD(ST, t) ST.load(kg + (size_t)(t) * 64 * (DM * 2), DM * 2, vg + (size_t)(t) * 64 * 2, SEQ * 2, tid)
    SB_LOAD(sA, ktop);
    sA.store(lds, tid);
    asm volatile("s_waitcnt lgkmcnt(0)" ::: "memory"); __builtin_amdgcn_s_barrier(); asm volatile("" ::: "memory");
    if (ktop >= 1) SB_LOAD(sA, ktop - 1);
    if (ktop >= 2) SB_LOAD(sB, ktop - 2);
    int kt = ktop, it = 0; bool fin = false;
#define SB_STEP(ST) do { \
        const LAS unsigned char* buf = lds + (it & 1) * KVBUF_B; \
        if (!done) { \
            _Pragma("unroll") for (int j = 1; j >= 0; --j) { const int key0 = 64 * kt + 32 * j; \
                if (!done && key0 <= q0) { \
                    sb_subtile(buf + (32 * j + r) * KSTR + 16 * hh, buf + KTILE_B + r * VSTR + 64 * j + 8 * hh, qf, uf, o, carry, key0 == q0, rm); \
                    if (__all(carry > SB_EXIT)) done = true; } } } \
        if (kt >= 1) ST.store(lds + ((it + 1) & 1) * KVBUF_B, tid); \
        if (kt >= 3) SB_LOAD(ST, kt - 3); \
        if (lane == 0) flags[wave] = done ? 1u : 0u; \
        asm volatile("s_waitcnt lgkmcnt(0)" ::: "memory"); __builtin_amdgcn_s_barrier(); asm volatile("" ::: "memory"); \
        if (kt == 0) fin = true; \
        else { unsigned nd = 0; _Pragma("unroll") for (int w = 0; w < 8; ++w) nd += flags[w]; if (nd == 8u) fin = true; } \
        --kt; ++it; } while (0)
    for (;;) { SB_STEP(sA); if (fin) break; SB_STEP(sB); if (fin) break; }
#undef SB_STEP
#undef SB_LOAD
    asm volatile("s_waitcnt vmcnt(0)" ::: "memory");
    bf16_t* op = O + (size_t)(b * SEQ + q0 + r) * DM + h * HD + 4 * hh;
#pragma unroll
    for (int d = 0; d < 4; ++d)
#pragma unroll
        for (int g = 0; g < 4; ++g) { u32x2 w; w.x = pk2(o[d][4 * g], o[d][4 * g + 1]); w.y = pk2(o[d][4 * g + 2], o[d][4 * g + 3]); *(u32x2*)(op + 32 * d + 8 * g) = w; }
}


__device__ __forceinline__ unsigned wave_total_u32(unsigned v) {
    v += (unsigned)__builtin_amdgcn_update_dpp(0, (int)v, 0x111, 0xf, 0xf, true);
    v += (unsigned)__builtin_amdgcn_update_dpp(0, (int)v, 0x112, 0xf, 0xf, true);
    v += (unsigned)__builtin_amdgcn_update_dpp(0, (int)v, 0x114, 0xf, 0xf, true);
    v += (unsigned)__builtin_amdgcn_update_dpp(0, (int)v, 0x118, 0xf, 0xf, true);
    v += (unsigned)__builtin_amdgcn_update_dpp(0, (int)v, 0x142, 0xa, 0xf, false);
    v += (unsigned)__builtin_amdgcn_update_dpp(0, (int)v, 0x143, 0xc, 0xf, false);
    return (unsigned)__builtin_amdgcn_readlane((int)v, 63);
}
__device__ __forceinline__ void causal_mask_row(unsigned* mrow, int t, int lane) {
    const int key0 = 32 * lane; unsigned w;
    if (key0 + 31 <= t) w = 0xffffffffu; else if (key0 > t) w = 0u; else w = (1u << (t - key0 + 1)) - 1u;
    mrow[lane] = w;
}
__device__ __forceinline__ void write_topk_mask(const unsigned (&uv)[32], unsigned prefix, unsigned* mrow, int lane) {
    int cgt = 0;
#pragma unroll
    for (int e = 0; e < 32; ++e) cgt += __popcll(__ballot(uv[e] > prefix));
    const int need = TOPK - cgt; int running = 0;
    const unsigned long long ltm = (1ull << lane) - 1ull;
    unsigned long long keep = 0ull;
#pragma unroll
    for (int e = 0; e < 32; ++e) {
        const unsigned long long eq = __ballot(uv[e] == prefix);
        const bool sel = (uv[e] > prefix) || (uv[e] == prefix && (running + __popcll(eq & ltm)) < need);
        const unsigned long long m64 = __ballot(sel);
        running += __popcll(eq);
        if (lane == e) keep = m64;
    }
    if (lane < 32) *(unsigned long long*)(mrow + 2 * lane) = keep;
}
__device__ __forceinline__ void select_two(const float* rowa, const float* rowb, int ta, unsigned* mrowa, unsigned* mrowb, int lane) {
    const int tb = ta + 1, na = ta + 1, nb = tb + 1;
    if (nb <= TOPK) { causal_mask_row(mrowa, ta, lane); causal_mask_row(mrowb, tb, lane); return; }
    float fa[32], fb[32];
#pragma unroll
    for (int e = 0; e < 32; ++e) { fa[e] = __builtin_nontemporal_load(rowa + e * 64 + lane); fb[e] = __builtin_nontemporal_load(rowb + e * 64 + lane); }
    unsigned ua[32], ub[32];
#pragma unroll
    for (int e = 0; e < 32; ++e) { const int key = e * 64 + lane; const unsigned ma = fmap(fa[e]), mb = fmap(fb[e]); ua[e] = (key < na) ? ma : 0x007fffffu; ub[e] = (key < nb) ? mb : 0x007fffffu; }
    unsigned pa = 0u, pb = 0u; bool da = false, db = false;
    for (int bit = 31; bit >= 0; --bit) {
        const unsigned ca = pa | (1u << bit), cb = pb | (1u << bit);
        unsigned na_ = 0u, nb_ = 0u;
#pragma unroll
        for (int e = 0; e < 32; ++e) { na_ += (ua[e] >= ca) ? 1u : 0u; nb_ += (ub[e] >= cb) ? 1u : 0u; }
        const unsigned tota = wave_total_u32(na_), totb = wave_total_u32(nb_);
        if (!da && tota >= (unsigned)TOPK) { pa = ca; if (tota == (unsigned)TOPK) da = true; }
        if (!db && totb >= (unsigned)TOPK) { pb = cb; if (totb == (unsigned)TOPK) db = true; }
        if (da && db) break;
    }
    if (na <= TOPK) causal_mask_row(mrowa, ta, lane); else write_topk_mask(ua, pa, mrowa, lane);
    write_topk_mask(ub, pb, mrowb, lane);
}

struct KiStage {
    u32x4 k[4];
    __device__ __forceinline__ void load(const unsigned char* kg, int tid) {
#pragma unroll
        for (int i = 0; i < 4; ++i) { const int c = tid + 512 * i; k[i] = *(const u32x4*)(kg + (size_t)(c >> 4) * (HD * 2) + (c & 15) * 16); }
    }
    __device__ __forceinline__ void store(LAS unsigned char* buf, int tid) const {
#pragma unroll
        for (int i = 0; i < 4; ++i) { const int c = tid + 512 * i; *(LAS u32x4*)(buf + (c >> 4) * KSTR + (c & 15) * 16) = k[i]; }
    }
};
constexpr int KIBUF_B = 128 * KSTR;
__device__ __forceinline__ void indexer_block(const bf16_t* __restrict__ QI, const bf16_t* __restrict__ KI, const float* __restrict__ WI, unsigned* __restrict__ MASK, float* __restrict__ SC,
                                              LAS unsigned char* lds, int b, int qb16, int wave, int lane, int tid) {
    const int r = lane & 31, hh = lane >> 5, t0 = 16 * qb16, tw = t0 + 2 * wave;
    const bf16_t* ap = QI + (size_t)(b * SEQ + tw + (r >> 4)) * DM + (r & 15) * HD + 8 * hh;
    bf16x8 af[8];
#pragma unroll
    for (int s = 0; s < 8; ++s) af[s] = *(const bf16x8*)(ap + 16 * s);
    float wv[16];
#pragma unroll
    for (int i = 0; i < 16; ++i) { const int rw = crow(i, hh); wv[i] = WI[(size_t)(b * SEQ + tw + (rw >> 4)) * 16 + (rw & 15)]; }
    float* myrow = SC + ((size_t)(b * 128 + qb16) * 16 + 2 * wave + hh) * SEQ;
    const int tq = tw + hh, ntile = (t0 + 16 + 127) >> 7;
    const unsigned char* kg = (const unsigned char*)(KI + (size_t)(b * SEQ) * HD);
    KiStage sA, sB;
    sA.load(kg, tid);
    sA.store(lds, tid);
    asm volatile("s_waitcnt lgkmcnt(0)" ::: "memory"); __builtin_amdgcn_s_barrier(); asm volatile("" ::: "memory");
    if (ntile > 1) sA.load(kg + (size_t)1 * 128 * (HD * 2), tid);
    if (ntile > 2) sB.load(kg + (size_t)2 * 128 * (HD * 2), tid);
    for (int kt = 0; kt < ntile; ++kt) {
        const LAS unsigned char* buf = lds + (kt & 1) * KIBUF_B;
#pragma unroll
        for (int j = 0; j < 4; ++j) { const int key0 = 128 * kt + 32 * j;
            if (key0 <= t0 + 15) {
                const LAS unsigned char* kp = buf + (32 * j + r) * KSTR + 16 * hh;
                f32x16 c = f32x16{};
#pragma unroll
                for (int s = 0; s < 8; ++s) c = __builtin_amdgcn_mfma_f32_32x32x16_bf16(af[s], *(const LAS bf16x8*)(kp + 32 * s), c, 0, 0, 0);
                float s0 = 0.f, s1 = 0.f;
#pragma unroll
                for (int i = 0; i < 8; ++i) { s0 += wv[i] * fmaxf(c[i], 0.f); s1 += wv[i + 8] * fmaxf(c[i + 8], 0.f); }
                const float t0s = swap_sum(s0), t1s = swap_sum(s1);
                const int key = key0 + r;
                float v = (hh ? t1s : t0s) + 0.0f;
                if (key > tq) v = -INFINITY;
                myrow[key] = v; } }
        if (kt & 1) { if (kt + 1 < ntile) sB.store(lds + ((kt + 1) & 1) * KIBUF_B, tid); if (kt + 3 < ntile) sB.load(kg + (size_t)(kt + 3) * 128 * (HD * 2), tid); }
        else        { if (kt + 1 < ntile) sA.store(lds + ((kt + 1) & 1) * KIBUF_B, tid); if (kt + 3 < ntile) sA.load(kg + (size_t)(kt + 3) * 128 * (HD * 2), tid); }
        asm volatile("s_waitcnt lgkmcnt(0)" ::: "memory"); __builtin_amdgcn_s_barrier(); asm volatile("" ::: "memory");
    }
    asm volatile("s_waitcnt vmcnt(0)" ::: "memory");
    { const float* rowa = SC + ((size_t)(b * 128 + qb16) * 16 + 2 * wave) * SEQ;
      unsigned* mrowa = MASK + (size_t)(b * SEQ + tw) * 64;
      select_two(rowa, rowa + SEQ, tw, mrowa, mrowa + 64, lane); }
}

constexpr int N_PHASES = 12;
__global__ void __launch_bounds__(512, 2) fwd_kernel(Args a) {
    extern __shared__ __attribute__((aligned(16))) unsigned char lds_raw[];
    LAS unsigned char* lds = (LAS unsigned char*)lds_raw;
    cg::grid_group grid = cg::this_grid();
    const int tid = threadIdx.x, lane = tid & 63, wave = __builtin_amdgcn_readfirstlane(tid >> 6);
    const int G = gridDim.x, bx = blockIdx.x;
    const int gw = bx * 8 + wave, ngw = G * 8;
    unsigned char* ws = a.ws;
    const int lo = a.ph_lo, hi = a.ph_hi;
#ifndef REP_PHASE
#define REP_PHASE -1
#endif
#ifndef REP_COUNT
#define REP_COUNT 1
#endif
#define IN(k) (lo <= (k) && (k) < hi)
#define GSYNC(k) do { if ((k) == 0) grid.sync(); else xcd_barrier(xbar); } while (0)
#define SEAM(k) do { if (IN(k) && IN((k) + 1)) GSYNC(k); } while (0)
#define REPS(k) for (int rep_ = 0; rep_ < ((k) == REP_PHASE ? REP_COUNT : 1); ++rep_, (void)(((k) == REP_PHASE && rep_ < REP_COUNT) ? (xcd_barrier(xbar), 0) : 0))
    bf16_t* XB = (bf16_t*)(ws + WS_XB); float* X1 = (float*)(ws + WS_X1); float* X2 = (float*)(ws + WS_X2); float* PART = (float*)(ws + WS_PART);
    bf16_t* Qb = (bf16_t*)(ws + WS_Q); bf16_t* Kb = (bf16_t*)(ws + WS_K); bf16_t* Vtb = (bf16_t*)(ws + WS_VT); bf16_t* Ob = (bf16_t*)(ws + WS_O);
    bf16_t* QIb = (bf16_t*)(ws + WS_QI); bf16_t* KDb = (bf16_t*)(ws + WS_KD); bf16_t* VTDb = (bf16_t*)(ws + WS_VTD); bf16_t* KIb = (bf16_t*)(ws + WS_KI);
    float* WIb = (float*)(ws + WS_WI); unsigned* MASKb = (unsigned*)(ws + WS_MASK);
    bf16_t* ACTb = (bf16_t*)(ws + WS_ACT);
    const float* ropeC = (const float*)(ws + WS_ROPE); const float* ropeS = ropeC + SEQ * 64;

    if (tid < 16) ((volatile LAS unsigned*)(lds + LDS_MISC))[tid] = 0u;
    __syncthreads();
    XcdBarrier xbar = xcd_barrier_post((unsigned*)(ws + WS_CTL), (volatile LAS unsigned*)(lds + LDS_MISC) + 8);
    const Offload offl = make_offload(G);
    if (IN(0)) REPS(0) { prologue_phase(a, lds, gw, ngw, wave, lane, offl); }
    SEAM(0);
    if (IN(1)) REPS(1) {
        pg8::Gemm g{XB, (const bf16_t*)(ws + WS_WQKV), MTOK, NQKV, DM}; pg8::StaticOrder S; S.init(MTOK, NQKV, G, bx);
        EpiQKV E{ws};
        pg8::gemm_phase<EpiQKV, pg8::StaticOrder, true, true>(lds, g, S, E);
    }
    SEAM(1);
    if (IN(2)) REPS(2) { for (int unit = bx; unit < BATCH * NH * 8; unit += G) sb_attn_block(Qb, Kb, Vtb, Ob, lds, unit >> 3, 7 - (unit & 7), wave, lane, tid); }
    SEAM(2);
    if (IN(3)) REPS(3) {
        pg8::Gemm g{Ob, (const bf16_t*)(ws + WS_WO0), MTOK, DM, DM}; pg8::StaticOrder S; S.init(MTOK, DM, G, bx);
        EpiRes E{a.x, X1, XB, PART};
        pg8::gemm_phase<EpiRes, pg8::StaticOrder, true, true>(lds, g, S, E);
    }
    SEAM(3);
    if (IN(4)) REPS(4) {
        const int Gg = offl.up0 ? offl.g_up : G;
        if (bx < Gg) {
        pg8::Gemm g{XB, (const bf16_t*)(ws + WS_WUP), MTOK, NUP, DM, 254, -2}; pg8::StaticOrder S; S.init_tiles(33, NUP / 256, Gg, bx);
        EpiUpConv E{ACTb, PART, a.conv_w, a.conv_b, (LAS float*)(lds + LDS_EPI)};
        pg8::gemm_phase<EpiUpConv, pg8::StaticOrder, true, true>(lds, g, S, E);
        } else { LAS float* scr = (LAS float*)(lds + wave * 16640); const int vw = (bx - Gg) * 8 + wave, nvw = (G - Gg) * 8;
            convert_items(a, scr, WI5, WI6, vw, nvw, lane); convert_items(a, scr, WI1, WI2, vw, nvw, lane); }
    }
    SEAM(4);
    if (IN(5)) REPS(5) {
        pg8::Gemm g{ACTb, (const bf16_t*)(ws + WS_WDN), MTOK, DM, FF}; pg8::StaticOrder S; S.init(MTOK, DM, G, bx);
        EpiRes E{X1, X2, XB, PART};
        pg8::gemm_phase<EpiRes, pg8::StaticOrder, true, true>(lds, g, S, E);
    }
    SEAM(5);
    if (IN(6)) REPS(6) {
        const int Gg = offl.in1 ? offl.g_in : G;
        if (bx < Gg) {
        pg8::Gemm g{XB, (const bf16_t*)(ws + WS_WIN), MTOK, NINP, DM}; pg8::StaticOrder S; S.init(MTOK, NINP, Gg, bx);
        EpiDsaIn E{ws, (LAS float*)(lds + LDS_EPI)};
        pg8::gemm_phase<EpiDsaIn, pg8::StaticOrder, true, true>(lds, g, S, E);
        } else { LAS float* scr = (LAS float*)(lds + wave * 16640); const int vw = (bx - Gg) * 8 + wave, nvw = (G - Gg) * 8;
            convert_items(a, scr, WI2, WI3, vw, nvw, lane); convert_items(a, scr, WI4, WI5, vw, nvw, lane); }
    }
    SEAM(6);
    if (IN(7)) REPS(7) {
        for (int pr = bx; pr < 256; pr += G) { const int b = pr >> 6, p = pr & 63;
            for (int half = 0; half < 2; ++half) indexer_block(QIb, KIb, WIb, MASKb, (float*)(ws + WS_ACT), lds, b, half ? p : 127 - p, wave, lane, tid); }
    }
    SEAM(7);
    if (IN(8)) REPS(8) {
        for (int pr = bx; pr < 256; pr += G) { const int b = pr >> 6, g = (pr >> 4) & 3, p = pr & 15;
            for (int half = 0; half < 2; ++half) dsa_attn_block(Qb, KDb, VTDb, MASKb, Ob, lds, b, g, half ? p : 31 - p, wave, lane, tid); }
    }
    SEAM(8);
    if (IN(9)) REPS(9) {
        pg8::Gemm g{Ob, (const bf16_t*)(ws + WS_WO1), MTOK, DM, DM}; pg8::StaticOrder S; S.init(MTOK, DM, G, bx);
        EpiRes E{X2, X1, XB, PART};
        pg8::gemm_phase<EpiRes, pg8::StaticOrder, true, true>(lds, g, S, E);
    }
    SEAM(9);
    if (IN(10)) REPS(10) {
        const int Gg = offl.up1 ? offl.g_up : G;
        if (bx < Gg) {
        pg8::Gemm g{XB, (const bf16_t*)(ws + WS_WUP + 44 * MiB), MTOK, NUP, DM, 254, -2}; pg8::StaticOrder S; S.init_tiles(33, NUP / 256, Gg, bx);
        EpiUpConv E{ACTb, PART, a.conv_w + 3 * NUP, a.conv_b + NUP, (LAS float*)(lds + LDS_EPI)};
        pg8::gemm_phase<EpiUpConv, pg8::StaticOrder, true, true>(lds, g, S, E);
        } else { LAS float* scr = (LAS float*)(lds + wave * 16640); const int vw = (bx - Gg) * 8 + wave, nvw = (G - Gg) * 8;
            convert_items(a, scr, WI6, WI7, vw, nvw, lane); }
    }
    SEAM(10);
    if (IN(11)) REPS(11) {
        pg8::Gemm g{ACTb, (const bf16_t*)(ws + WS_WDN + 22 * MiB), MTOK, DM, FF}; pg8::StaticOrder S; S.init(MTOK, DM, G, bx);
        EpiRes E{X1, a.out, nullptr, nullptr};
        pg8::gemm_phase<EpiRes, pg8::StaticOrder, true, true>(lds, g, S, E);
    }
#undef IN
#undef SEAM
}

extern "C" void kernel_launch(void* const* d_in, const int* in_sizes, int n_in, void* d_out, int out_size, void* d_ws, size_t ws_size, hipStream_t stream) {
    static int grid = 0;
    if (grid == 0) {
        if (n_in != 14 || out_size != MTOK * DM || ws_size < WS_END) { fprintf(stderr, "kernel_launch: unexpected shapes (n_in %d out %d ws %zu)\n", n_in, out_size, ws_size); grid = -1; return; }
        int dev = 0, cus = 0, per_cu = 0;
        hipGetDevice(&dev); hipDeviceGetAttribute(&cus, hipDeviceAttributeMultiprocessorCount, dev);
        if (hipFuncSetAttribute((const void*)fwd_kernel, hipFuncAttributeMaxDynamicSharedMemorySize, LDS_BYTES) != hipSuccess) { fprintf(stderr, "kernel_launch: hipFuncSetAttribute failed\n"); grid = -1; return; }
        if (hipOccupancyMaxActiveBlocksPerMultiprocessor(&per_cu, (const void*)fwd_kernel, 512, LDS_BYTES) != hipSuccess || per_cu < 1) { fprintf(stderr, "kernel_launch: occupancy query says %d\n", per_cu); per_cu = 1; }
        (void)hipGetLastError();
        grid = cus;
    }
    if (grid < 0) return;
    Args a{};
    a.x = (const float*)d_in[0]; a.attn_g = (const float*)d_in[1]; a.ffn_g = (const float*)d_in[2]; a.w_qkv = (const float*)d_in[3]; a.w_o0 = (const float*)d_in[4]; a.w_in = (const float*)d_in[5];
    a.qn_g = (const float*)d_in[6]; a.kn_g = (const float*)d_in[7]; a.ikn_g = (const float*)d_in[8]; a.w_o1 = (const float*)d_in[9]; a.w_up = (const float*)d_in[10]; a.conv_w = (const float*)d_in[11];
    a.conv_b = (const float*)d_in[12]; a.w_down = (const float*)d_in[13]; a.out = (float*)d_out; a.ws = (unsigned char*)d_ws;
    if (hipMemsetAsync((char*)d_ws + WS_CTL, 0, CTL_BYTES, stream) != hipSuccess) { fprintf(stderr, "kernel_launch: hipMemsetAsync failed\n"); return; }
#if MK_ONE_LAUNCH
    a.ph_lo = 0; a.ph_hi = N_PHASES;
    void* args[] = {&a};
    hipError_t e = hipLaunchCooperativeKernel((const void*)fwd_kernel, dim3(grid), dim3(512), args, LDS_BYTES, stream);
    if (e != hipSuccess) fprintf(stderr, "cooperative launch failed: %s (grid %d)\n", hipGetErrorString(e), grid);
#else
    for (int pp = 0; pp < N_PHASES + HOST_REP_EXTRA; ++pp) {
        const int p = pp < N_PHASES ? pp : -1;
        if (p < 0) continue;
        for (int hr = 0; hr < ((p == HOST_REP_PHASE) ? 1 + HOST_REP_EXTRA : 1); ++hr) {
        a.ph_lo = p; a.ph_hi = p + 1;
        void* args[] = {&a};
        hipError_t e = hipLaunchCooperativeKernel((const void*)fwd_kernel, dim3(grid), dim3(512), args, LDS_BYTES, stream);
        if (e != hipSuccess) { fprintf(stderr, "launch %d failed: %s (grid %d)\n", p, hipGetErrorString(e), grid); break; }
        }
    }
#endif
}
```

```cpp
#include <hip/hip_runtime.h>
#include <hip/hip_cooperative_groups.h>
#include <cstdio>
#include <cstdint>
namespace cg = cooperative_groups;

#ifndef HOST_REP_PHASE
#define HOST_REP_PHASE -1
#endif
#ifndef HOST_REP_EXTRA
#define HOST_REP_EXTRA 0
#endif
#ifndef MK_ONE_LAUNCH
#define MK_ONE_LAUNCH 1
#endif

#define LAS __attribute__((address_space(3)))
typedef unsigned short bf16_t;
typedef short bf16x8 __attribute__((ext_vector_type(8)));
typedef short s16x4 __attribute__((ext_vector_type(4)));
typedef float f32x4 __attribute__((ext_vector_type(4)));
typedef float f32x2 __attribute__((ext_vector_type(2)));
typedef float f32x16 __attribute__((ext_vector_type(16)));
typedef unsigned u32x4 __attribute__((ext_vector_type(4)));
typedef unsigned u32x2 __attribute__((ext_vector_type(2)));
typedef __bf16 bf16x2_t __attribute__((ext_vector_type(2)));

constexpr int BATCH = 4, SEQ = 2048, DM = 2048, NH = 16, HD = 128, MTOK = BATCH * SEQ;
constexpr int FF = 5632, NUP = 2 * FF, NQKV = 3 * DM;
constexpr int KVH = 4, NIN = 5264, NINP = 5376;
constexpr int TOPK = 256;
constexpr float NORM_EPS = 1e-6f;
constexpr float LOG2E = 1.4426950408889634f;
constexpr float QSCALE = 0.08838834764831845f * LOG2E;

constexpr size_t MiB = 1u << 20;
constexpr size_t WS_WQKV = 0, WS_WO0 = 24 * MiB, WS_WIN = 32 * MiB, WS_WO1 = 53 * MiB, WS_WUP = 61 * MiB  , WS_WDN = 149 * MiB  ;
constexpr size_t WS_GAIN = 197 * MiB + 512 * 1024  ;
constexpr size_t WS_ROPE = 193 * MiB  , WS_PART = 194 * MiB, WS_MASK = 195 * MiB, WS_WI = 197 * MiB, WS_KI = 198 * MiB;
constexpr size_t WS_XB = 200 * MiB, WS_X1 = 232 * MiB, WS_X2 = 296 * MiB;
constexpr size_t WS_SCR = 360 * MiB;
constexpr size_t WS_U = WS_SCR, WS_ACT = WS_SCR + 176 * MiB;
constexpr size_t WS_Q = WS_SCR, WS_K = WS_SCR + 32 * MiB, WS_VT = WS_SCR + 64 * MiB, WS_O = WS_SCR + 96 * MiB, WS_QI = WS_SCR + 128 * MiB, WS_KD = WS_SCR + 160 * MiB, WS_VTD = WS_SCR + 168 * MiB;
constexpr size_t WS_CTL = WS_ACT + 88 * MiB, CTL_BYTES = 65536;
constexpr size_t WS_END = WS_CTL + CTL_BYTES;

constexpr int LDS_EPI = 131072;
constexpr int LDS_MISC = LDS_EPI + 8192;
constexpr int LDS_BYTES = 147456;

__device__ __forceinline__ unsigned pk2(float lo, float hi) { f32x2 v = {lo, hi}; bf16x2_t b = __builtin_convertvector(v, bf16x2_t); return __builtin_bit_cast(unsigned, b); }
__device__ __forceinline__ bf16_t f2bf(float f) { return (bf16_t)(pk2(f, 0.f) & 0xffffu); }
__device__ __forceinline__ int crow(int r, int hi) { return (r & 3) + 8 * (r >> 2) + 4 * hi; }
__device__ __forceinline__ bf16x8 pack8(const f32x16& p, int b) {
    u32x4 w; w.x = pk2(p[b], p[b + 1]); w.y = pk2(p[b + 2], p[b + 3]); w.z = pk2(p[b + 4], p[b + 5]); w.w = pk2(p[b + 6], p[b + 7]);
    return __builtin_bit_cast(bf16x8, w);
}
__device__ __forceinline__ float swap_sum(float v) { auto rr = __builtin_amdgcn_permlane32_swap(__float_as_uint(v), __float_as_uint(v), false, false); return __uint_as_float(rr[0]) + __uint_as_float(rr[1]); }
__device__ __forceinline__ float swap_max(float v) { auto rr = __builtin_amdgcn_permlane32_swap(__float_as_uint(v), __float_as_uint(v), false, false); return fmaxf(__uint_as_float(rr[0]), __uint_as_float(rr[1])); }
__device__ __forceinline__ float wave_sum(float v) {
#pragma unroll
    for (int o = 1; o < 64; o <<= 1) v += __shfl_xor(v, o);
    return v;
}
__device__ __forceinline__ float row_rstd(const float* part, int row, int fq) {
    const f32x4* p = (const f32x4*)(part + (size_t)row * 32 + 8 * fq);
    const f32x4 a = p[0], b = p[1]; float s = ((a.x + a.y) + (a.z + a.w)) + ((b.x + b.y) + (b.z + b.w));
    s += __shfl_xor(s, 16); s += __shfl_xor(s, 32);
    return 1.0f / sqrtf(s * (1.0f / DM) + NORM_EPS);
}


#define XB_TMO      128
#define XB_XCNT(j)  (256  + 64 * (j))
#define XB_XSUB(j)  (1280 + 64 * (j))
#define XB_XGEN(j)  (2304 + 64 * (j))
#define XB_TOP      3328
#define XB_TOPGEN   3392
#define XCD_BAR_WORDS 3456
#define XB_SPIN_CAP (1u << 18)
__device__ __forceinline__ unsigned xb_ld(unsigned* p)              { return __hip_atomic_load(p, __ATOMIC_RELAXED, __HIP_MEMORY_SCOPE_AGENT); }
__device__ __forceinline__ unsigned xb_add(unsigned* p, unsigned v) { return __hip_atomic_fetch_add(p, v, __ATOMIC_RELAXED, __HIP_MEMORY_SCOPE_AGENT); }
__device__ __forceinline__ unsigned xb_xcc_id() { return (unsigned)__builtin_amdgcn_s_getreg((3 << 11) | 20) & 0xFu; }
#define XB_SPIN(cond, bar) do { unsigned _sp = 0; while (cond) { __builtin_amdgcn_s_sleep(1); \
    if ((++_sp & 255u) == 0u) { if (xb_ld(&(bar)[XB_TMO])) break; if (_sp > XB_SPIN_CAP) { atomicAdd(&(bar)[XB_TMO], 1u); break; } } } } while (0)
struct XcdBarrier { unsigned* bar; unsigned x; volatile LAS unsigned* st; };
__device__ __forceinline__ XcdBarrier xcd_barrier_post(unsigned* bar, volatile LAS unsigned* st) {
    XcdBarrier b; b.bar = bar; b.x = xb_xcc_id(); b.st = st;
    if (threadIdx.x == 0) (void)xb_add(&bar[XB_XCNT(b.x)], 1u);
    return b;
}
__device__ __forceinline__ void xcd_barrier_complete(unsigned* bar, unsigned x, unsigned& nloc, unsigned& nx) {
    const unsigned G = gridDim.x * gridDim.y * gridDim.z;
    unsigned sum, cnt, mine, sp = 0u;
    for (;;) {
        sum = 0u; cnt = 0u; mine = 0u;
#pragma unroll
        for (unsigned j = 0; j < 16; ++j) { const unsigned c = xb_ld(&bar[XB_XCNT(j)]); sum += c; cnt += (c > 0u) ? 1u : 0u; mine = (j == x) ? c : mine; }
        if (sum == G) break;
        __builtin_amdgcn_s_sleep(1);
        if ((++sp & 255u) == 0u) { if (xb_ld(&bar[XB_TMO])) break; if (sp > XB_SPIN_CAP) { atomicAdd(&bar[XB_TMO], 1u); break; } }
    }
    nloc = mine > 0u ? mine : 1u; nx = cnt > 0u ? cnt : 1u;
}
__device__ __forceinline__ void xcd_barrier(const XcdBarrier& b) {
    asm volatile("s_waitcnt vmcnt(0)" ::: "memory");
    __syncthreads();
    if (threadIdx.x == 0) {
        unsigned* bar = b.bar;
        __builtin_amdgcn_s_waitcnt(0);
        unsigned nloc = b.st[0], nx = b.st[1];
        if (nloc == 0u) { xcd_barrier_complete(bar, b.x, nloc, nx); b.st[0] = nloc; b.st[1] = nx; }
        const unsigned old = xb_add(&bar[XB_XSUB(b.x)], 1u);
        const unsigned gen = old / nloc;
        if (old + 1u == (gen + 1u) * nloc) {
            __builtin_amdgcn_fence(__ATOMIC_RELEASE, "agent");
            asm volatile("s_waitcnt vmcnt(0)" ::: "memory");
            const unsigned og = xb_add(&bar[XB_TOP], 1u);
            const unsigned tg = og / nx;
            if (og + 1u == (tg + 1u) * nx) xb_add(&bar[XB_TOPGEN], 1u);
            else XB_SPIN(xb_ld(&bar[XB_TOPGEN]) == tg, bar);
            __builtin_amdgcn_fence(__ATOMIC_ACQUIRE, "agent");
            xb_add(&bar[XB_XGEN(b.x)], 1u);
            asm volatile("s_waitcnt vmcnt(0)" ::: "memory");
        } else {
            XB_SPIN(xb_ld(&bar[XB_XGEN(b.x)]) == gen, bar);
            __builtin_amdgcn_fence(__ATOMIC_ACQUIRE, "agent");
            asm volatile("s_waitcnt vmcnt(0)" ::: "memory");
        }
    }
    __syncthreads();
}

namespace pg8 {
constexpr int BM = 256, BK = 64, HALF = 128, HTB = HALF * BK * 2, STAGE_BYTES = 8 * HTB, NXCD = 8, WGM = 8;
__host__ __device__ __forceinline__ int lds_byte(int r, int c) { const int st = (r >> 4) * 2 + (c >> 5), rr = r & 15, cc = c & 31, ob = rr * 64 + cc * 2; return st * 1024 + (ob ^ (((ob >> 9) & 1) << 5)); }
__host__ __device__ __forceinline__ void stage_rc(int b, int& R, int& C) { const int st = b / 1024, sb = b % 1024, swz = sb ^ (((sb >> 9) & 1) << 5); R = (st >> 1) * 16 + swz / 64; C = (st & 1) * 32 + (swz % 64) / 2; }
__host__ __device__ __forceinline__ int perm32(int rho) { const int n = rho >> 4, i = rho & 15; return 8 * (i >> 2) + 4 * n + (i & 3); }
struct Unit { int pm, pn; };
struct Gemm { const bf16_t* A; const bf16_t* Bt; int M, N, K; int a_rows = 256, a_row0 = 0; };
struct StaticOrder {
    int nM, nN, nwg, G, c;
    __host__ __device__ void init(int M, int N, int G_, int c_) { nM = M / BM; nN = N / BM; nwg = nM * nN; G = G_; c = c_; }
    __host__ __device__ void init_tiles(int nM_, int nN_, int G_, int c_) { nM = nM_; nN = nN_; nwg = nM * nN; G = G_; c = c_; }
    __host__ __device__ bool next(int i, Unit& u) const {
        const long L = (long)i * G + c; if (L >= nwg) return false;
        int wgid = (int)L; { const int q = nwg / NXCD, r = nwg % NXCD, xcd = wgid % NXCD, off = wgid / NXCD; wgid = (xcd < r ? xcd * (q + 1) : r * (q + 1) + (xcd - r) * q) + off; }
        const int nig = WGM * nN, gid = wgid / nig, fm = gid * WGM, gsz = (nM - fm) < WGM ? (nM - fm) : WGM;
        u.pm = fm + ((wgid % nig) % gsz); u.pn = (wgid % nig) / gsz; return true;
    }
};
template <class Epi, class Sched, bool ALIGN_EPI, bool SP2>
__device__ __forceinline__ void gemm_phase(LAS unsigned char* lds, const Gemm g, const Sched& S, const Epi& E) {
    const int tid = threadIdx.x, wid = __builtin_amdgcn_readfirstlane(tid >> 6), lane = tid & 63, wr = wid >> 2, wc = wid & 3, fr = lane & 15, fq = lane >> 4;
    const int K = g.K, nt = K / BK;
    unsigned voffA[2], voffB[2];
#pragma unroll
    for (int i = 0; i < 2; ++i) { int R, C; stage_rc(tid * 16 + i * 8192, R, C); const int Rb = Epi::PERM ? ((R & ~31) + perm32(R & 31)) : R;
        voffA[i] = (unsigned)(R * K + C) * 2u; voffB[i] = (unsigned)(Rb * K + C) * 2u; }
    const size_t kstep = (size_t)(BK * 2);
    const size_t hstep = (size_t)HALF * K * 2;
    const size_t tstep = 2 * hstep;
    const unsigned ldsw = (unsigned)wid * 1024u;
    const int aoff = lds_byte(wr * 64 + fr, fq * 8), boff = lds_byte(wc * 32 + fr, fq * 8);
#define PG8_SA(b, h) (((b) * 2 + (h)) * HTB)
#define PG8_SB(b, h) ((4 + (b) * 2 + (h)) * HTB)
#define PG8_STAGE(bufoff, gbase, voff) do { _Pragma("unroll") for (int _i = 0; _i < 2; ++_i) \
        __builtin_amdgcn_global_load_lds((const unsigned*)((const char*)(gbase) + (voff)[_i]), (LAS unsigned*)(lds + (bufoff) + ldsw + _i * 8192), 16, 0, 0); } while (0)
#define PG8_LDA(dst, b, h) do { _Pragma("unroll") for (int m = 0; m < 4; ++m) _Pragma("unroll") for (int k = 0; k < 2; ++k) dst[m][k] = *(const LAS bf16x8*)(lds + PG8_SA(b, h) + aoff + m * 2048 + k * 1024); } while (0)
#define PG8_LDB(dst, b, h) do { _Pragma("unroll") for (int n = 0; n < 2; ++n) _Pragma("unroll") for (int k = 0; k < 2; ++k) dst[n][k] = *(const LAS bf16x8*)(lds + PG8_SB(b, h) + boff + n * 2048 + k * 1024); } while (0)
#define PG8_MMA(ai, bj, At, Bt) do { __builtin_amdgcn_s_setprio(1); _Pragma("unroll") for (int m = 0; m < 4; ++m) _Pragma("unroll") for (int n = 0; n < 2; ++n) _Pragma("unroll") for (int k = 0; k < 2; ++k) \
        acc[ai][bj][m][n] = __builtin_amdgcn_mfma_f32_16x16x32_bf16(Bt[n][k], At[m][k], acc[ai][bj][m][n], 0, 0, 0); __builtin_amdgcn_s_setprio(0); } while (0)
#define PG8_WAIT_V(n) asm volatile("s_waitcnt vmcnt(" #n ")" ::: "memory")
#define PG8_WAIT_L(n) asm volatile("s_waitcnt lgkmcnt(" #n ")" ::: "memory")
#define PG8_BAR __builtin_amdgcn_s_barrier()
#define PG8_SCHED __builtin_amdgcn_sched_barrier(0)
    Unit cur, nxt; int ui = 0;
    if (!S.next(0, cur)) return;
    f32x4 acc[2][2][4][2];
#pragma unroll
    for (int a = 0; a < 2; ++a)
#pragma unroll
        for (int b = 0; b < 2; ++b)
#pragma unroll
            for (int m = 0; m < 4; ++m)
#pragma unroll
                for (int n = 0; n < 2; ++n) acc[a][b][m][n] = (f32x4){0.f, 0.f, 0.f, 0.f};
    bf16x8 At[4][2], B0[2][2], B1[2][2];
    const long atstep = (long)g.a_rows * K * 2, aorg = (long)g.a_row0 * K * 2;
    const char* cA = (const char*)g.A + aorg + (long)cur.pm * atstep; const char* cB = (const char*)g.Bt + (size_t)cur.pn * tstep;
    if constexpr (SP2) {
        PG8_STAGE(PG8_SB(0, 0), cB, voffB); PG8_STAGE(PG8_SB(0, 1), cB + hstep, voffB); PG8_STAGE(PG8_SA(0, 0), cA, voffA); PG8_STAGE(PG8_SA(0, 1), cA + hstep, voffA);
        if (wr == 1) PG8_BAR;
        PG8_WAIT_V(2); PG8_BAR;
        PG8_STAGE(PG8_SB(1, 0), cB + kstep, voffB); PG8_STAGE(PG8_SA(1, 0), cA + kstep, voffA); PG8_STAGE(PG8_SB(1, 1), cB + hstep + kstep, voffB);
        PG8_WAIT_V(6); PG8_BAR;
    } else {
        PG8_STAGE(PG8_SB(0, 0), cB, voffB); PG8_STAGE(PG8_SA(0, 0), cA, voffA); PG8_STAGE(PG8_SB(0, 1), cB + hstep, voffB); PG8_STAGE(PG8_SA(0, 1), cA + hstep, voffA);
        if (wr == 1) PG8_BAR;
        PG8_WAIT_V(4); PG8_BAR;
        PG8_STAGE(PG8_SB(1, 0), cB + kstep, voffB); PG8_STAGE(PG8_SA(1, 0), cA + kstep, voffA); PG8_STAGE(PG8_SB(1, 1), cB + hstep + kstep, voffB);
        PG8_WAIT_V(6); PG8_BAR;
    }
    for (;;) {
        const bool has_next = S.next(ui + 1, nxt);
        const char* nA = has_next ? (const char*)g.A + aorg + (long)nxt.pm * atstep : cA; const char* nB = has_next ? (const char*)g.Bt + (size_t)nxt.pn * tstep : cB;
        for (int t = 0; t < nt; t += 2) {
            const bool last = (t == nt - 2);
            const char* a1 = cA + (size_t)(t + 1) * kstep;
            const char* a2 = last ? nA : cA + (size_t)(t + 2) * kstep; const char* b2 = last ? nB : cB + (size_t)(t + 2) * kstep;
            const char* a3 = a2 + kstep; const char* b3 = b2 + kstep;
            if constexpr (SP2) {
            PG8_LDB(B0, 0, 0); PG8_LDB(B1, 0, 1); PG8_SCHED; PG8_LDA(At, 0, 0); PG8_STAGE(PG8_SA(1, 1), a1 + hstep, voffA);
            PG8_WAIT_V(8); PG8_WAIT_L(0); PG8_BAR; PG8_MMA(0, 0, At, B0); PG8_MMA(0, 1, At, B1); PG8_BAR; PG8_SCHED;
            PG8_LDA(At, 0, 1); PG8_STAGE(PG8_SB(0, 0), b2, voffB); PG8_STAGE(PG8_SB(0, 1), b2 + hstep, voffB); PG8_STAGE(PG8_SA(0, 0), a2, voffA);
            PG8_WAIT_V(8); PG8_WAIT_L(0); PG8_BAR; PG8_MMA(1, 0, At, B0); PG8_MMA(1, 1, At, B1); PG8_BAR; PG8_SCHED;
            PG8_LDB(B0, 1, 0); PG8_LDB(B1, 1, 1); PG8_SCHED; PG8_LDA(At, 1, 0); PG8_STAGE(PG8_SA(0, 1), a2 + hstep, voffA);
            PG8_WAIT_V(8); PG8_WAIT_L(0); PG8_BAR; PG8_MMA(0, 0, At, B0); PG8_MMA(0, 1, At, B1); PG8_BAR; PG8_SCHED;
            PG8_LDA(At, 1, 1); PG8_STAGE(PG8_SB(1, 0), b3, voffB); PG8_STAGE(PG8_SB(1, 1), b3 + hstep, voffB); PG8_STAGE(PG8_SA(1, 0), a3, voffA);
            PG8_WAIT_V(8); PG8_WAIT_L(0); PG8_BAR; PG8_MMA(1, 0, At, B0); PG8_MMA(1, 1, At, B1); PG8_BAR; PG8_SCHED;
            } else {
            PG8_LDB(B0, 0, 0); PG8_SCHED; PG8_LDA(At, 0, 0); PG8_STAGE(PG8_SA(1, 1), a1 + hstep, voffA);
            PG8_WAIT_L(8); PG8_BAR; PG8_WAIT_L(0); PG8_MMA(0, 0, At, B0); PG8_BAR; PG8_SCHED;
            PG8_LDB(B1, 0, 1); PG8_STAGE(PG8_SB(0, 0), b2, voffB);
            PG8_BAR; PG8_WAIT_L(0); PG8_MMA(0, 1, At, B1); PG8_BAR;
            PG8_LDA(At, 0, 1); PG8_STAGE(PG8_SA(0, 0), a2, voffA);
            PG8_BAR; PG8_WAIT_L(0); PG8_MMA(1, 0, At, B0); PG8_BAR; PG8_SCHED;
            PG8_STAGE(PG8_SB(0, 1), b2 + hstep, voffB);
            PG8_WAIT_V(6); PG8_BAR; PG8_MMA(1, 1, At, B1); PG8_BAR;
            PG8_LDB(B0, 1, 0); PG8_SCHED; PG8_LDA(At, 1, 0); PG8_STAGE(PG8_SA(0, 1), a2 + hstep, voffA);
            PG8_WAIT_L(8); PG8_BAR; PG8_WAIT_L(0); PG8_MMA(0, 0, At, B0); PG8_BAR; PG8_SCHED;
            PG8_LDB(B1, 1, 1); PG8_STAGE(PG8_SB(1, 0), b3, voffB);
            PG8_BAR; PG8_WAIT_L(0); PG8_MMA(0, 1, At, B1); PG8_BAR;
            PG8_LDA(At, 1, 1); PG8_STAGE(PG8_SA(1, 0), a3, voffA);
            PG8_BAR; PG8_WAIT_L(0); PG8_MMA(1, 0, At, B0); PG8_BAR; PG8_SCHED;
            PG8_STAGE(PG8_SB(1, 1), b3 + hstep, voffB);
            PG8_WAIT_V(6); PG8_BAR; PG8_MMA(1, 1, At, B1); PG8_BAR;
            }
        }
        if constexpr (ALIGN_EPI) { if (wr == 0) PG8_BAR; }
        { int fr_ = fr, fq_ = fq; asm volatile("" : "+v"(fr_), "+v"(fq_)); E(acc, cur, wr, wc, fr_, fq_); }
        if (!has_next) break;
#pragma unroll
        for (int a = 0; a < 2; ++a)
#pragma unroll
            for (int b = 0; b < 2; ++b)
#pragma unroll
                for (int m = 0; m < 4; ++m)
#pragma unroll
                    for (int n = 0; n < 2; ++n) acc[a][b][m][n] = (f32x4){0.f, 0.f, 0.f, 0.f};
        cur = nxt; cA = nA; cB = nB; ++ui;
        if constexpr (ALIGN_EPI) { if (wr == 1) PG8_BAR; }
    }
    PG8_WAIT_V(0);
    if constexpr (!ALIGN_EPI) { if (wr == 0) PG8_BAR; }
    PG8_BAR;
#undef PG8_SA
#undef PG8_SB
#undef PG8_STAGE
#undef PG8_LDA
#undef PG8_LDB
#undef PG8_MMA
#undef PG8_WAIT_V
#undef PG8_WAIT_L
#undef PG8_BAR
#undef PG8_SCHED
}
}
using pg8::Unit;
typedef f32x4 AccT[2][2][4][2];

struct EpiQKV {
    static constexpr bool PERM = true;
    unsigned char* ws;
    __device__ __forceinline__ void operator()(const AccT& acc, const Unit& u, int wr, int wc, int fr, int fq) const {
        const int row0 = u.pm * 256 + wr * 64 + fr, kind = u.pn >> 3, colt = (u.pn & 7) * 256 + wc * 32 + 8 * fq;
        bf16_t* Vt = (bf16_t*)(ws + WS_VT);
        if (kind < 2) {
            bf16_t* base = (bf16_t*)(ws + (kind == 0 ? WS_Q : WS_K)); const float sc = kind == 0 ? QSCALE : 1.0f;
#pragma unroll
            for (int ai = 0; ai < 2; ++ai)
#pragma unroll
                for (int m = 0; m < 4; ++m) { bf16_t* rowp = base + (size_t)(row0 + ai * 128 + m * 16) * DM + colt;
#pragma unroll
                    for (int bj = 0; bj < 2; ++bj) { const f32x4 v0 = acc[ai][bj][m][0] * sc, v1 = acc[ai][bj][m][1] * sc;
                        u32x4 w; w.x = pk2(v0[0], v0[1]); w.y = pk2(v0[2], v0[3]); w.z = pk2(v1[0], v1[1]); w.w = pk2(v1[2], v1[3]);
                        *(u32x4*)(rowp + bj * 128) = w; } }
        } else {
#pragma unroll
            for (int ai = 0; ai < 2; ++ai)
#pragma unroll
                for (int m = 0; m < 4; ++m) { const int row = row0 + ai * 128 + m * 16, b = row >> 11, s = row & 2047;
#pragma unroll
                    for (int bj = 0; bj < 2; ++bj) { const int c0 = colt + bj * 128, h = c0 >> 7, d0 = c0 & 127;
                        bf16_t* p = Vt + ((size_t)(b * NH + h) * HD + d0) * SEQ + s;
#pragma unroll
                        for (int n = 0; n < 2; ++n)
#pragma unroll
                            for (int j = 0; j < 4; ++j) p[(size_t)(4 * n + j) * SEQ] = f2bf(acc[ai][bj][m][n][j]); } }
        }
    }
};
struct EpiRes {
    static constexpr bool PERM = true;
    const float* res; float* out; bf16_t* outb; float* part;
    __device__ __forceinline__ void operator()(const AccT& acc, const Unit& u, int wr, int wc, int fr, int fq) const {
        const int row0 = u.pm * 256 + wr * 64 + fr, col0 = u.pn * 256 + wc * 32 + 8 * fq;
        f32x4 rb[2][4];
#define ER_LOAD(buf, g) do { const size_t off_ = (size_t)(row0 + ((g) >> 2) * 128 + ((g) & 3) * 16) * DM + col0; \
            rb[buf][0] = *(const f32x4*)(res + off_); rb[buf][1] = *(const f32x4*)(res + off_ + 4); rb[buf][2] = *(const f32x4*)(res + off_ + 128); rb[buf][3] = *(const f32x4*)(res + off_ + 132); } while (0)
        ER_LOAD(0, 0);
#pragma unroll
        for (int g = 0; g < 8; ++g) {
            const int ai = g >> 2, m = g & 3, cur = g & 1;
            if (g + 1 < 8) ER_LOAD(cur ^ 1, g + 1);
            const int row = row0 + ai * 128 + m * 16; const size_t off = (size_t)row * DM + col0; float ss = 0.f;
#pragma unroll
            for (int bj = 0; bj < 2; ++bj) {
                const f32x4 v0 = acc[ai][bj][m][0] + rb[cur][2 * bj], v1 = acc[ai][bj][m][1] + rb[cur][2 * bj + 1];
                *(f32x4*)(out + off + bj * 128) = v0; *(f32x4*)(out + off + bj * 128 + 4) = v1;
                if (outb) { u32x4 w; w.x = pk2(v0[0], v0[1]); w.y = pk2(v0[2], v0[3]); w.z = pk2(v1[0], v1[1]); w.w = pk2(v1[2], v1[3]); *(u32x4*)(outb + off + bj * 128) = w; }
                ss += (v0[0] * v0[0] + v0[1] * v0[1]) + (v0[2] * v0[2] + v0[3] * v0[3]) + (v1[0] * v1[0] + v1[1] * v1[1]) + (v1[2] * v1[2] + v1[3] * v1[3]); }
            if (part) { ss += __shfl_xor(ss, 16); ss += __shfl_xor(ss, 32); if (fq == 0) part[(size_t)row * 32 + u.pn * 4 + wc] = ss; }
        }
#undef ER_LOAD
    }
};
struct EpiUp {
    static constexpr bool PERM = true;
    bf16_t* U; const float* part;
    __device__ __forceinline__ void operator()(const AccT& acc, const Unit& u, int wr, int wc, int fr, int fq) const {
        const int row0 = u.pm * 256 + wr * 64 + fr, col0 = u.pn * 256 + wc * 32 + 8 * fq;
#pragma unroll
        for (int ai = 0; ai < 2; ++ai)
#pragma unroll
            for (int m = 0; m < 4; ++m) { const int row = row0 + ai * 128 + m * 16; const float rs = row_rstd(part, row, fq); bf16_t* rowp = U + (size_t)row * NUP + col0;
#pragma unroll
                for (int bj = 0; bj < 2; ++bj) { const f32x4 v0 = acc[ai][bj][m][0] * rs, v1 = acc[ai][bj][m][1] * rs;
                    u32x4 w; w.x = pk2(v0[0], v0[1]); w.y = pk2(v0[2], v0[3]); w.z = pk2(v1[0], v1[1]); w.w = pk2(v1[2], v1[3]);
                    *(u32x4*)(rowp + bj * 128) = w; } }
    }
};
__device__ __forceinline__ float dpp_ror1(float v) { return __int_as_float(__builtin_amdgcn_update_dpp(0, __float_as_int(v), 0x121, 0xf, 0xf, false)); }
__device__ __forceinline__ float dpp_ror2(float v) { return __int_as_float(__builtin_amdgcn_update_dpp(0, __float_as_int(v), 0x122, 0xf, 0xf, false)); }
struct EpiUpConv {
    static constexpr bool PERM = true;
    bf16_t* ACT; const float* part; const float* cw; const float* cb; LAS float* hal;
    __device__ __forceinline__ void operator()(AccT& acc, const Unit& u, int wr, int wc, int fr, int fq) const {
        const int grow0 = 254 * u.pm - 2 + wr * 64 + fr;
#pragma unroll
        for (int ai = 0; ai < 2; ++ai)
#pragma unroll
            for (int m = 0; m < 4; ++m) { const int grow = grow0 + ai * 128 + m * 16; const int rowc = grow < 0 ? 0 : (grow >= MTOK ? MTOK - 1 : grow);
                const float rs = row_rstd(part, rowc, fq);
#pragma unroll
                for (int bj = 0; bj < 2; ++bj) { acc[ai][bj][m][0] *= rs; acc[ai][bj][m][1] *= rs; } }
        const int colw = wc * 32 + 8 * fq;
        if (fr >= 14) {
#pragma unroll
            for (int ai = 0; ai < 2; ++ai)
#pragma unroll
                for (int bj = 0; bj < 2; ++bj)
#pragma unroll
                    for (int n = 0; n < 2; ++n) *(LAS f32x4*)(hal + ((ai * 2 + wr) * 2 + (fr - 14)) * 256 + bj * 128 + colw + 4 * n) = acc[ai][bj][3][n];
        }
        asm volatile("s_waitcnt lgkmcnt(0)" ::: "memory"); __builtin_amdgcn_s_barrier(); asm volatile("" ::: "memory");
#pragma unroll
        for (int n = 0; n < 2; ++n) {
            const int ch = u.pn * 128 + colw + 4 * n;
            f32x4 w[2][3], bb[2];
#pragma unroll
            for (int bj = 0; bj < 2; ++bj) { bb[bj] = *(const f32x4*)(cb + bj * FF + ch);
#pragma unroll
                for (int t = 0; t < 3; ++t) w[bj][t] = *(const f32x4*)(cw + (size_t)t * NUP + bj * FF + ch); }
#pragma unroll
            for (int ai = 0; ai < 2; ++ai)
#pragma unroll
                for (int m = 0; m < 4; ++m) {
                    const int lrow = ai * 128 + wr * 64 + m * 16 + fr, grow = 254 * u.pm - 2 + lrow, pos = grow & 2047;
                    f32x4 cv[2];
#pragma unroll
                    for (int bj = 0; bj < 2; ++bj) {
                        const f32x4 cur = acc[ai][bj][m][n];
                        f32x4 q1, q2;
                        if (m > 0) { const f32x4 pv = acc[ai][bj][m - 1][n];
#pragma unroll
                            for (int e = 0; e < 4; ++e) { q1[e] = dpp_ror1(pv[e]); q2[e] = dpp_ror2(pv[e]); } }
                        else { const int slab = ai * 2 + wr - 1; f32x4 h1 = (f32x4){0.f, 0.f, 0.f, 0.f}, h2 = h1;
                            if (slab >= 0) { h1 = *(const LAS f32x4*)(hal + (slab * 2 + 1) * 256 + bj * 128 + colw + 4 * n); h2 = *(const LAS f32x4*)(hal + (slab * 2) * 256 + bj * 128 + colw + 4 * n); }
                            q1 = h1; q2 = (fr == 1) ? h1 : h2; }
                        f32x4 c = bb[bj];
#pragma unroll
                        for (int e = 0; e < 4; ++e) { const float r1 = dpp_ror1(cur[e]), r2 = dpp_ror2(cur[e]);
                            const float p1 = fr >= 1 ? r1 : q1[e], p2 = fr >= 2 ? r2 : q2[e];
                            float v = c[e] + w[bj][2][e] * cur[e];
                            if (pos >= 1) v += w[bj][1][e] * p1;
                            if (pos >= 2) v += w[bj][0][e] * p2;
                            c[e] = v; }
                        cv[bj] = c;
                    }
                    float a4[4];
#pragma unroll
                    for (int e = 0; e < 4; ++e) { const float gx = cv[0][e]; a4[e] = gx * __builtin_amdgcn_rcpf(1.0f + __expf(-gx)) * cv[1][e]; }
                    if (lrow >= 2 && grow < MTOK) { u32x2 o; o.x = pk2(a4[0], a4[1]); o.y = pk2(a4[2], a4[3]); *(u32x2*)(ACT + (size_t)grow * FF + ch) = o; }
                }
        }
    }
};
struct EpiDsaIn {
    static constexpr bool PERM = false;
    unsigned char* ws; LAS float* scr;
    __device__ __forceinline__ void operator()(const AccT& acc_in, const Unit& u, int wr, int wc, int fr, int fq) const {
        const int row0 = u.pm * 256 + wr * 64 + fr;
        const float* part = (const float*)(ws + WS_PART); const float* ropeC = (const float*)(ws + WS_ROPE); const float* ropeS = ropeC + SEQ * 64;
        bf16_t* VTD = (bf16_t*)(ws + WS_VTD); float* WI = (float*)(ws + WS_WI);
        const bool need_norm = (u.pn < 10) || (u.pn == 20);
        float rs[2][4];
#pragma unroll
        for (int ai = 0; ai < 2; ++ai)
#pragma unroll
            for (int m = 0; m < 4; ++m) rs[ai][m] = row_rstd(part, row0 + ai * 128 + m * 16, fq);
        if (need_norm) {
#pragma unroll
            for (int ai = 0; ai < 2; ++ai)
#pragma unroll
                for (int m = 0; m < 4; ++m)
#pragma unroll
                    for (int bj = 0; bj < 2; ++bj) { const f32x4 a = acc_in[ai][bj][m][0], b = acc_in[ai][bj][m][1];
                        float ss = ((a[0] * a[0] + a[1] * a[1]) + (a[2] * a[2] + a[3] * a[3])) + ((b[0] * b[0] + b[1] * b[1]) + (b[2] * b[2] + b[3] * b[3]));
                        ss += __shfl_xor(ss, 16); ss += __shfl_xor(ss, 32);
                        if (fq == 0) scr[(ai * 128 + wr * 64 + m * 16 + fr) * 8 + bj * 4 + wc] = ss * rs[ai][m] * rs[ai][m]; }
            asm volatile("s_waitcnt lgkmcnt(0)" ::: "memory"); __builtin_amdgcn_s_barrier(); asm volatile("" ::: "memory");
        }
        const int dl = 16 * wc + 4 * fq;
#pragma unroll
        for (int bj = 0; bj < 2; ++bj) {
            const int hh = 2 * u.pn + bj;
            if (hh >= 20 && hh < 24) {
#pragma unroll
                for (int ai = 0; ai < 2; ++ai)
#pragma unroll
                    for (int m = 0; m < 4; ++m) { const int row = row0 + ai * 128 + m * 16, b = row >> 11, s = row & 2047; const float r = rs[ai][m];
                        bf16_t* p = VTD + ((size_t)(b * KVH + (hh - 20)) * HD + dl) * SEQ + s;
#pragma unroll
                        for (int n = 0; n < 2; ++n)
#pragma unroll
                            for (int e = 0; e < 4; ++e) p[(size_t)(64 * n + e) * SEQ] = f2bf(acc_in[ai][bj][m][n][e] * r); }
            } else if (hh == 41) {
                if (wc == 0) {
#pragma unroll
                    for (int ai = 0; ai < 2; ++ai)
#pragma unroll
                        for (int m = 0; m < 4; ++m) { const int row = row0 + ai * 128 + m * 16; *(f32x4*)(WI + (size_t)row * 16 + 4 * fq) = acc_in[ai][bj][m][0] * rs[ai][m]; } }
            } else {
                const bool norm = (hh < 20) || (hh == 40);
                const float* g = (const float*)(ws + WS_GAIN) + (hh < 16 ? 0 : (hh < 20 ? 128 : 256));
                f32x4 g0 = (f32x4){1.f, 1.f, 1.f, 1.f}, g1 = g0;
                if (norm) { g0 = *(const f32x4*)(g + dl); g1 = *(const f32x4*)(g + dl + 64); }
                size_t boff; int ld, cb;
                if (hh < 16) { boff = WS_Q; ld = DM; cb = hh * HD; } else if (hh < 20) { boff = WS_KD; ld = KVH * HD; cb = (hh - 16) * HD; }
                else if (hh < 40) { boff = WS_QI; ld = DM; cb = (hh - 24) * HD; } else { boff = WS_KI; ld = HD; cb = 0; }
                bf16_t* base = (bf16_t*)(ws + boff);
                const float osc = hh < 16 ? QSCALE : 1.0f;
#pragma unroll
                for (int ai = 0; ai < 2; ++ai)
#pragma unroll
                    for (int m = 0; m < 4; ++m) { const int lrow = ai * 128 + wr * 64 + m * 16 + fr, row = u.pm * 256 + lrow, pos = row & 2047;
                        float sc = rs[ai][m];
                        if (norm) { const f32x4 t = *(const LAS f32x4*)(scr + lrow * 8 + bj * 4); sc *= 1.0f / sqrtf(((t[0] + t[1]) + (t[2] + t[3])) * (1.0f / HD) + NORM_EPS); }
                        sc *= osc;
                        const f32x4 c = *(const f32x4*)(ropeC + pos * 64 + dl), sn = *(const f32x4*)(ropeS + pos * 64 + dl);
                        const f32x4 y0 = acc_in[ai][bj][m][0] * g0 * sc, y1 = acc_in[ai][bj][m][1] * g1 * sc;
                        const f32x4 o0 = y0 * c - y1 * sn, o1 = y1 * c + y0 * sn;
                        bf16_t* rp = base + (size_t)row * ld + cb + dl;
                        u32x2 w0, w1; w0.x = pk2(o0[0], o0[1]); w0.y = pk2(o0[2], o0[3]); w1.x = pk2(o1[0], o1[1]); w1.y = pk2(o1[2], o1[3]);
                        *(u32x2*)rp = w0; *(u32x2*)(rp + 64) = w1; }
            }
        }
    }
};

enum { WM_PLAIN = 0, WM_UP = 1, WM_IN = 2 };
__device__ __forceinline__ int colmap(int kind, int np) {
    if (kind == WM_UP) { const int pn = np >> 8, bj = (np >> 7) & 1, q = np & 127; return bj * FF + 128 * pn + q; }
    if (kind == WM_IN) { const int hh = np >> 7, p = np & 127, d = 16 * (p >> 5) + (p & 15) + 64 * ((p >> 4) & 1);
        if (hh < 41) return hh * 128 + d; return (p < 16) ? (5248 + p) : -1; }
    return np;
}
struct WJ { const float* W; const float* gain; bf16_t* WT; int K, N, NP, kind, local; };
__device__ __forceinline__ void tr_load(const WJ& j, int lane, f32x4 (&v)[16]) {
    const int nblk = j.NP / 64, kb = j.local / nblk, nb = j.local - kb * nblk, k0 = 64 * kb, n0 = 64 * nb;
    const int src = colmap(j.kind, n0 + 4 * (lane & 15)), rg = lane >> 4;
    const float* p = j.W + (size_t)(k0 + rg) * j.N + (src >= 0 ? src : 0);
#pragma unroll
    for (int i = 0; i < 16; ++i) { v[i] = *(const f32x4*)(p + (size_t)(4 * i) * j.N); if (src < 0) v[i] = (f32x4){0.f, 0.f, 0.f, 0.f}; }
}
__device__ __forceinline__ void tr_process(const WJ& j, int lane, const f32x4 (&v)[16], LAS float* scr) {
    const int nblk = j.NP / 64, kb = j.local / nblk, nb = j.local - kb * nblk, k0 = 64 * kb, n0 = 64 * nb;
    const int rg = lane >> 4, cg = lane & 15;
    float gl = 1.0f; if (j.gain) gl = j.gain[k0 + lane];
#pragma unroll
    for (int i = 0; i < 16; ++i) { const int kk = 4 * i + rg; const float g = __shfl(gl, kk); LAS float* d = scr + kk * 65 + 4 * cg;
        d[0] = v[i][0] * g; d[1] = v[i][1] * g; d[2] = v[i][2] * g; d[3] = v[i][3] * g; }
    asm volatile("s_waitcnt lgkmcnt(0)" ::: "memory");
    const int c = lane & 7;
#pragma unroll
    for (int jj = 0; jj < 8; ++jj) { const int n = (lane >> 3) + 8 * jj; const LAS float* s = scr + (8 * c) * 65 + n;
        u32x4 o; o.x = pk2(s[0 * 65], s[1 * 65]); o.y = pk2(s[2 * 65], s[3 * 65]); o.z = pk2(s[4 * 65], s[5 * 65]); o.w = pk2(s[6 * 65], s[7 * 65]);
        *(u32x4*)(j.WT + (size_t)(n0 + n) * j.K + k0 + 8 * c) = o; }
    asm volatile("s_waitcnt lgkmcnt(0)" ::: "memory");
}

struct Args {
    const float* x; const float* attn_g; const float* ffn_g; const float* w_qkv; const float* w_o0; const float* w_in;
    const float* qn_g; const float* kn_g; const float* ikn_g; const float* w_o1; const float* w_up; const float* conv_w; const float* conv_b; const float* w_down;
    float* out; unsigned char* ws; int ph_lo, ph_hi;
};

constexpr int WI0 = 32 * 96, WI1 = WI0 + 32 * 32, WI2 = WI1 + 32 * 84, WI3 = WI2 + 32 * 32, WI4 = WI3 + 32 * 176, WI5 = WI4 + 32 * 176, WI6 = WI5 + 88 * 32, WI7 = WI6 + 88 * 32;
__device__ __forceinline__ WJ wj_decode(const Args& a, int it) {
    unsigned char* ws = a.ws; WJ j;
    if (it < WI0)      j = WJ{a.w_qkv, nullptr, (bf16_t*)(ws + WS_WQKV), DM, NQKV, NQKV, WM_PLAIN, it};
    else if (it < WI1) j = WJ{a.w_o0, nullptr, (bf16_t*)(ws + WS_WO0), DM, DM, DM, WM_PLAIN, it - WI0};
    else if (it < WI2) j = WJ{a.w_in, a.attn_g + DM, (bf16_t*)(ws + WS_WIN), DM, NIN, NINP, WM_IN, it - WI1};
    else if (it < WI3) j = WJ{a.w_o1, nullptr, (bf16_t*)(ws + WS_WO1), DM, DM, DM, WM_PLAIN, it - WI2};
    else if (it < WI4) j = WJ{a.w_up, a.ffn_g, (bf16_t*)(ws + WS_WUP), DM, NUP, NUP, WM_UP, it - WI3};
    else if (it < WI5) j = WJ{a.w_up + (size_t)DM * NUP, a.ffn_g + DM, (bf16_t*)(ws + WS_WUP + 44 * MiB), DM, NUP, NUP, WM_UP, it - WI4};
    else if (it < WI6) j = WJ{a.w_down, nullptr, (bf16_t*)(ws + WS_WDN), FF, DM, DM, WM_PLAIN, it - WI5};
    else               j = WJ{a.w_down + (size_t)FF * DM, nullptr, (bf16_t*)(ws + WS_WDN + 22 * MiB), FF, DM, DM, WM_PLAIN, it - WI6};
    return j;
}
__device__ __forceinline__ void convert_items(const Args& a, LAS float* scr, int lo, int hi, int vw, int nvw, int lane) {
    int it = lo + vw;
    if (it >= hi) return;
    f32x4 va[16], vb[16];
    WJ ja = wj_decode(a, it), jb = ja;
    tr_load(ja, lane, va);
    for (;;) {
        int nx = it + nvw; bool hn = nx < hi;
        if (hn) { jb = wj_decode(a, nx); tr_load(jb, lane, vb); }
        tr_process(ja, lane, va, scr);
        if (!hn) break;
        it = nx; nx = it + nvw; hn = nx < hi;
        if (hn) { ja = wj_decode(a, nx); tr_load(ja, lane, va); }
        tr_process(jb, lane, vb, scr);
        if (!hn) break;
        it = nx;
    }
}
struct Offload { int g_up, g_in; bool up0, in1, up1; };
__device__ __forceinline__ Offload make_offload(int G) {
    Offload o; const int u_up = 33 * (NUP / 256), u_in = (MTOK / 256) * (NINP / 256);
    const int r_up = (u_up + G - 1) / G, r_in = (u_in + G - 1) / G;
    o.g_up = (u_up + r_up - 1) / r_up; o.g_in = (u_in + r_in - 1) / r_in;
    o.up0 = (G - o.g_up) >= 8; o.up1 = o.up0; o.in1 = (G - o.g_in) >= 16;
    return o;
}
__device__ __forceinline__ void prologue_phase(const Args& a, LAS unsigned char* lds, int gw, int ngw, int wave, int lane, const Offload& offl) {
    unsigned char* ws = a.ws;
    LAS float* scr = (LAS float*)(lds + wave * 16640);
    convert_items(a, scr, 0, WI1, gw, ngw, lane);
    convert_items(a, scr, WI3, WI4, gw, ngw, lane);
    if (!offl.up0) { convert_items(a, scr, WI5, WI6, gw, ngw, lane); convert_items(a, scr, WI1, WI2, gw, ngw, lane); }
    if (!offl.in1) { convert_items(a, scr, WI2, WI3, gw, ngw, lane); convert_items(a, scr, WI4, WI5, gw, ngw, lane); }
    if (!offl.up1) { convert_items(a, scr, WI6, WI7, gw, ngw, lane); }
    bf16_t* XB = (bf16_t*)(ws + WS_XB);
    for (int m = gw; m < MTOK; m += ngw) {
        const f32x4* xr = (const f32x4*)(a.x + (size_t)m * DM) + lane;
        f32x4 v[8]; float s = 0.f;
#pragma unroll
        for (int j = 0; j < 8; ++j) { v[j] = xr[64 * j]; s += (v[j].x * v[j].x + v[j].y * v[j].y) + (v[j].z * v[j].z + v[j].w * v[j].w); }
        const float rstd = 1.0f / sqrtf(wave_sum(s) * (1.0f / DM) + NORM_EPS);
        u32x2* o8 = (u32x2*)(XB + (size_t)m * DM) + lane;
#pragma unroll
        for (int j = 0; j < 8; ++j) { const f32x4 g = ((const f32x4*)a.attn_g)[lane + 64 * j]; u32x2 w; w.x = pk2(v[j].x * rstd * g.x, v[j].y * rstd * g.y); w.y = pk2(v[j].z * rstd * g.z, v[j].w * rstd * g.w); o8[64 * j] = w; }
    }
    if (gw == 0) { float* gn = (float*)(ws + WS_GAIN); for (int i = lane; i < 128; i += 64) { gn[i] = a.qn_g[i]; gn[128 + i] = a.kn_g[i]; gn[256 + i] = a.ikn_g[i]; } }
    float* rc = (float*)(ws + WS_ROPE); float* rsn = rc + SEQ * 64;
    for (int i = gw * 64 + lane; i < SEQ * 64; i += ngw * 64) {
        const int pos = i >> 6, fi = i & 63;
        const float inv_freq = (float)(1.0 / exp2((double)fi * (2.0 / 128.0) * 13.287712379549449));
        const float ang = (float)pos * inv_freq;
        const double x = (double)ang; const double kq = rint(x * 0.63661977236758134308);
        double r = __builtin_fma(-kq, 1.57079632679489655800e+00, x); r = __builtin_fma(-kq, 6.12323399573676603587e-17, r);
        const double r2 = r * r;
        double sp = -1.0 / 6227020800.0; sp = sp * r2 + 1.0 / 39916800.0; sp = sp * r2 - 1.0 / 362880.0; sp = sp * r2 + 1.0 / 5040.0; sp = sp * r2 - 1.0 / 120.0; sp = sp * r2 + 1.0 / 6.0; const double sv = r - r * r2 * sp;
        double cp = 1.0 / 87178291200.0; cp = cp * r2 - 1.0 / 479001600.0; cp = cp * r2 + 1.0 / 3628800.0; cp = cp * r2 - 1.0 / 40320.0; cp = cp * r2 + 1.0 / 720.0; cp = cp * r2 - 1.0 / 24.0; cp = cp * r2 + 0.5; const double cv = 1.0 - r2 * cp;
        const int q = ((int)kq) & 3;
        const double cs = (q == 0) ? cv : (q == 1) ? -sv : (q == 2) ? -cv : sv;
        const double sn = (q == 0) ? sv : (q == 1) ? cv : (q == 2) ? -sv : -cv;
        rc[i] = (float)cs; rsn[i] = (float)sn;
    }
}

constexpr float SB_EXIT = 220.0f;
__device__ __forceinline__ void sb_attn_phase(const bf16_t* __restrict__ Q, const bf16_t* __restrict__ K, const bf16_t* __restrict__ Vt, bf16_t* __restrict__ O, int gw, int ngw, int lane) {
    const int r = lane & 31, hh = lane >> 5;
    bf16x8 uf[2];
#pragma unroll
    for (int s2 = 0; s2 < 2; ++s2) { u32x4 w;
        unsigned e[8];
#pragma unroll
        for (int j = 0; j < 8; ++j) { const int key = 16 * s2 + 8 * (j >> 2) + 4 * hh + (j & 3); e[j] = (key >= r) ? 0x3f80u : 0u; }
        w.x = e[0] | (e[1] << 16); w.y = e[2] | (e[3] << 16); w.z = e[4] | (e[5] << 16); w.w = e[6] | (e[7] << 16); uf[s2] = __builtin_bit_cast(bf16x8, w); }
    for (int unit = gw; unit < BATCH * NH * 64; unit += ngw) {
        const int bh = unit >> 6, qt = 63 - (unit & 63), b = bh >> 4, h = bh & 15, q0 = qt * 32;
        const bf16_t* qp = Q + (size_t)(b * SEQ + q0 + r) * DM + h * HD + 8 * hh;
        bf16x8 qf[8];
#pragma unroll
        for (int s = 0; s < 8; ++s) qf[s] = *(const bf16x8*)(qp + 16 * s);
        f32x16 o[4];
#pragma unroll
        for (int d = 0; d < 4; ++d) o[d] = f32x16{};
        float carry = 0.f;
        const bf16_t* kbase = K + (size_t)(b * SEQ + r) * DM + h * HD + 8 * hh;
        const bf16_t* vbase = Vt + ((size_t)bh * HD + r) * SEQ + 4 * hh;
        for (int kt = qt; kt >= 0; --kt) {
            const int key0 = kt * 32;
            const bf16_t* kp = kbase + (size_t)key0 * DM;
            bf16x8 kf[8];
#pragma unroll
            for (int s = 0; s < 8; ++s) kf[s] = *(const bf16x8*)(kp + 16 * s);
            bf16x8 vf[4][2];
#pragma unroll
            for (int d = 0; d < 4; ++d)
#pragma unroll
                for (int s2 = 0; s2 < 2; ++s2) { const bf16_t* vp = vbase + (size_t)(32 * d) * SEQ + key0 + 16 * s2;
                    const s16x4 lo = *(const s16x4*)vp, hi = *(const s16x4*)(vp + 8);
                    vf[d][s2] = (bf16x8){lo[0], lo[1], lo[2], lo[3], hi[0], hi[1], hi[2], hi[3]}; }
            f32x16 p = f32x16{};
#pragma unroll
            for (int s = 0; s < 8; ++s) p = __builtin_amdgcn_mfma_f32_32x32x16_bf16(kf[s], qf[s], p, 0, 0, 0);
            const bool diag = (kt == qt);
            f32x16 sp;
#pragma unroll
            for (int i = 0; i < 16; ++i) { const float z = p[i]; float v = fmaxf(z, 0.f) + __builtin_amdgcn_logf(1.0f + __builtin_amdgcn_exp2f(-fabsf(z)));
                if (diag && crow(i, hh) >= r) v = 0.f; sp[i] = v; }
            f32x16 c;
#pragma unroll
            for (int i = 0; i < 16; ++i) c[i] = carry;
            c = __builtin_amdgcn_mfma_f32_32x32x16_bf16(uf[0], pack8(sp, 0), c, 0, 0, 0);
            c = __builtin_amdgcn_mfma_f32_32x32x16_bf16(uf[1], pack8(sp, 8), c, 0, 0, 0);
            f32x16 av;
#pragma unroll
            for (int i = 0; i < 16; ++i) { float v = __builtin_amdgcn_exp2f(p[i] - c[i]); if (diag && crow(i, hh) >= r) v = 0.f; av[i] = v; }
            carry = swap_max(c[0]);
            const bf16x8 pa0 = pack8(av, 0), pa1 = pack8(av, 8);
#pragma unroll
            for (int d = 0; d < 4; ++d) { o[d] = __builtin_amdgcn_mfma_f32_32x32x16_bf16(vf[d][0], pa0, o[d], 0, 0, 0); o[d] = __builtin_amdgcn_mfma_f32_32x32x16_bf16(vf[d][1], pa1, o[d], 0, 0, 0); }
            if (__all(carry > SB_EXIT)) break;
        }
        bf16_t* op = O + (size_t)(b * SEQ + q0 + r) * DM + h * HD + 4 * hh;
#pragma unroll
        for (int d = 0; d < 4; ++d)
#pragma unroll
            for (int g = 0; g < 4; ++g) { u32x2 w; w.x = pk2(o[d][4 * g], o[d][4 * g + 1]); w.y = pk2(o[d][4 * g + 2], o[d][4 * g + 3]); *(u32x2*)(op + 32 * d + 8 * g) = w; }
    }
}

__device__ __forceinline__ void conv_phase(const bf16_t* __restrict__ U, const float* __restrict__ cw, const float* __restrict__ cb, bf16_t* __restrict__ ACT, int gtid, int nthreads) {
    constexpr int C8 = FF / 8;
    for (int it = gtid; it < MTOK * C8; it += nthreads) {
        const int row = it / C8, c8 = it - row * C8, j0 = c8 * 8, pn = j0 >> 7, q = j0 & 127, s = row & 2047;
        const bf16_t* ug = U + (size_t)row * NUP + 256 * pn + q;
        float cgv[2][8];
#pragma unroll
        for (int half = 0; half < 2; ++half) {
            const bf16_t* up = ug + half * 128; const int cc = half * FF + j0;
            const f32x4 b0 = *(const f32x4*)(cb + cc), b1 = *(const f32x4*)(cb + cc + 4);
            float accv[8] = {b0[0], b0[1], b0[2], b0[3], b1[0], b1[1], b1[2], b1[3]};
#pragma unroll
            for (int tap = 0; tap < 3; ++tap) { const int back = 2 - tap;
                if (s >= back) { const u32x4 w = *(const u32x4*)(up - (size_t)back * NUP);
                    const f32x4 w0 = *(const f32x4*)(cw + (size_t)tap * NUP + cc), w1 = *(const f32x4*)(cw + (size_t)tap * NUP + cc + 4);
                    accv[0] += __uint_as_float(w.x << 16) * w0[0]; accv[1] += __uint_as_float(w.x & 0xffff0000u) * w0[1];
                    accv[2] += __uint_as_float(w.y << 16) * w0[2]; accv[3] += __uint_as_float(w.y & 0xffff0000u) * w0[3];
                    accv[4] += __uint_as_float(w.z << 16) * w1[0]; accv[5] += __uint_as_float(w.z & 0xffff0000u) * w1[1];
                    accv[6] += __uint_as_float(w.w << 16) * w1[2]; accv[7] += __uint_as_float(w.w & 0xffff0000u) * w1[3]; } }
#pragma unroll
            for (int e = 0; e < 8; ++e) cgv[half][e] = accv[e];
        }
        float a8[8];
#pragma unroll
        for (int e = 0; e < 8; ++e) { const float gx = cgv[0][e]; a8[e] = gx / (1.0f + __expf(-gx)) * cgv[1][e]; }
        u32x4 w; w.x = pk2(a8[0], a8[1]); w.y = pk2(a8[2], a8[3]); w.z = pk2(a8[4], a8[5]); w.w = pk2(a8[6], a8[7]);
        *(u32x4*)(ACT + (size_t)row * FF + j0) = w;
    }
}

__device__ __forceinline__ unsigned fmap(float f) { const unsigned u = __float_as_uint(f); return (u & 0x80000000u) ? ~u : (u | 0x80000000u); }
__device__ __forceinline__ void indexer_unit(const bf16_t* __restrict__ QI, const bf16_t* __restrict__ KI, const float* __restrict__ WI, unsigned* __restrict__ MASK, LAS float* sc, int b, int t0, int wave, int lane) {
    const int r = lane & 31, hh = lane >> 5, ql_r = r >> 4, head_r = r & 15;
    const int tw = t0 + 2 * wave;
    const bf16_t* ap = QI + (size_t)(b * SEQ + tw + ql_r) * DM + head_r * HD + 8 * hh;
    bf16x8 af[8];
#pragma unroll
    for (int s = 0; s < 8; ++s) af[s] = *(const bf16x8*)(ap + 16 * s);
    float wv[16];
#pragma unroll
    for (int i = 0; i < 16; ++i) { const int rw = crow(i, hh); wv[i] = WI[(size_t)(b * SEQ + tw + (rw >> 4)) * 16 + (rw & 15)]; }
    const int nkt = (t0 + 16 + 31) >> 5;
    const bf16_t* kb = KI + (size_t)(b * SEQ + r) * HD + 8 * hh;
    LAS float* myrow = sc + (2 * wave + hh) * SEQ;
    const int tq = tw + hh;
    for (int kt = 0; kt < nkt; ++kt) {
        const bf16_t* kp = kb + (size_t)kt * 32 * HD;
        bf16x8 bfr[8];
#pragma unroll
        for (int s = 0; s < 8; ++s) bfr[s] = *(const bf16x8*)(kp + 16 * s);
        f32x16 c = f32x16{};
#pragma unroll
        for (int s = 0; s < 8; ++s) c = __builtin_amdgcn_mfma_f32_32x32x16_bf16(af[s], bfr[s], c, 0, 0, 0);
        float s0 = 0.f, s1 = 0.f;
#pragma unroll
        for (int i = 0; i < 8; ++i) { s0 += wv[i] * fmaxf(c[i], 0.f); s1 += wv[i + 8] * fmaxf(c[i + 8], 0.f); }
        const float t0s = swap_sum(s0), t1s = swap_sum(s1);
        const int key = kt * 32 + r;
        float v = (hh ? t1s : t0s) + 0.0f;
        if (key > tq) v = -INFINITY;
        myrow[key] = v;
    }
    asm volatile("s_waitcnt lgkmcnt(0)" ::: "memory");
    for (int ql = 0; ql < 2; ++ql) {
        const int t = tw + ql, n = t + 1;
        unsigned* mrow = MASK + (size_t)(b * SEQ + t) * 64;
        if (n <= TOPK) {
            const int key0 = 32 * lane; unsigned w;
            if (key0 + 31 <= t) w = 0xffffffffu; else if (key0 > t) w = 0u; else w = (1u << (t - key0 + 1)) - 1u;
            mrow[lane] = w;
        } else {
            const LAS float* row = sc + (2 * wave + ql) * SEQ;
            unsigned uv[32];
#pragma unroll
            for (int e = 0; e < 32; ++e) { const int key = e * 64 + lane; uv[e] = (key < n) ? fmap(row[key]) : 0x007fffffu; }
            unsigned prefix = 0u;
            for (int bit = 31; bit >= 0; --bit) {
                const unsigned cand = prefix | (1u << bit); int cnt = 0;
#pragma unroll
                for (int e = 0; e < 32; ++e) cnt += __popcll(__ballot(uv[e] >= cand));
                if (cnt >= TOPK) prefix = cand;
            }
            int cgt = 0;
#pragma unroll
            for (int e = 0; e < 32; ++e) cgt += __popcll(__ballot(uv[e] > prefix));
            const int need = TOPK - cgt; int running = 0;
            const unsigned long long ltm = (1ull << lane) - 1ull;
            unsigned long long keep = 0ull;
#pragma unroll
            for (int e = 0; e < 32; ++e) {
                const unsigned long long eq = __ballot(uv[e] == prefix);
                const bool sel = (uv[e] > prefix) || (uv[e] == prefix && (running + __popcll(eq & ltm)) < need);
                const unsigned long long m64 = __ballot(sel);
                running += __popcll(eq);
                if (lane == e) keep = m64;
            }
            if (lane < 32) *(unsigned long long*)(mrow + 2 * lane) = keep;
        }
    }
    asm volatile("s_waitcnt lgkmcnt(0)" ::: "memory");
}

__device__ __forceinline__ void dsa_attn_unit(const bf16_t* __restrict__ QD, const bf16_t* __restrict__ KD, const bf16_t* __restrict__ VTD, const unsigned* __restrict__ MASK, bf16_t* __restrict__ O,
                                              int b, int g, int h, int q0, int lane) {
    const int r = lane & 31, hh = lane >> 5;
    const bf16_t* qp = QD + (size_t)(b * SEQ + q0 + r) * DM + h * HD + 8 * hh;
    bf16x8 qf[8];
#pragma unroll
    for (int s = 0; s < 8; ++s) qf[s] = *(const bf16x8*)(qp + 16 * s);
    f32x16 o[4];
#pragma unroll
    for (int d = 0; d < 4; ++d) o[d] = f32x16{};
    float mrun = -1e30f, lrun = 0.f;
    const bf16_t* kbase = KD + (size_t)(b * SEQ + r) * (KVH * HD) + g * HD + 8 * hh;
    const bf16_t* vbase = VTD + ((size_t)(b * KVH + g) * HD + r) * SEQ + 4 * hh;
    const unsigned* mrow = MASK + (size_t)(b * SEQ + q0 + r) * 64;
    const int nkt = (q0 + 32) >> 5;
    for (int kt = 0; kt < nkt; ++kt) {
        const int key0 = kt * 32;
        const bf16_t* kp = kbase + (size_t)key0 * (KVH * HD);
        bf16x8 kf[8];
#pragma unroll
        for (int s = 0; s < 8; ++s) kf[s] = *(const bf16x8*)(kp + 16 * s);
        const unsigned mw = mrow[kt];
        bf16x8 vf[4][2];
#pragma unroll
        for (int d = 0; d < 4; ++d)
#pragma unroll
            for (int s2 = 0; s2 < 2; ++s2) { const bf16_t* vp = vbase + (size_t)(32 * d) * SEQ + key0 + 16 * s2;
                const s16x4 lo = *(const s16x4*)vp, hi = *(const s16x4*)(vp + 8);
                vf[d][s2] = (bf16x8){lo[0], lo[1], lo[2], lo[3], hi[0], hi[1], hi[2], hi[3]}; }
        f32x16 p = f32x16{};
#pragma unroll
        for (int s = 0; s < 8; ++s) p = __builtin_amdgcn_mfma_f32_32x32x16_bf16(kf[s], qf[s], p, 0, 0, 0);
        float tmax = -1e30f;
#pragma unroll
        for (int i = 0; i < 16; ++i) { const bool valid = (mw >> crow(i, hh)) & 1u; tmax = fmaxf(tmax, valid ? p[i] : -1e30f); }
        tmax = swap_max(tmax);
        const float mnew = fmaxf(mrun, tmax), alpha = __builtin_amdgcn_exp2f(mrun - mnew);
        float ls = 0.f; f32x16 pe;
#pragma unroll
        for (int i = 0; i < 16; ++i) { const bool valid = (mw >> crow(i, hh)) & 1u; const float e = valid ? __builtin_amdgcn_exp2f(p[i] - mnew) : 0.f; pe[i] = e; ls += e; }
        lrun = lrun * alpha + ls; mrun = mnew;
#pragma unroll
        for (int d = 0; d < 4; ++d)
#pragma unroll
            for (int i = 0; i < 16; ++i) o[d][i] *= alpha;
        const bf16x8 pa0 = pack8(pe, 0), pa1 = pack8(pe, 8);
#pragma unroll
        for (int d = 0; d < 4; ++d) { o[d] = __builtin_amdgcn_mfma_f32_32x32x16_bf16(vf[d][0], pa0, o[d], 0, 0, 0); o[d] = __builtin_amdgcn_mfma_f32_32x32x16_bf16(vf[d][1], pa1, o[d], 0, 0, 0); }
    }
    const float linv = 1.0f / swap_sum(lrun);
    bf16_t* op = O + (size_t)(b * SEQ + q0 + r) * DM + h * HD + 4 * hh;
#pragma unroll
    for (int d = 0; d < 4; ++d)
#pragma unroll
        for (int gq = 0; gq < 4; ++gq) { u32x2 w; w.x = pk2(o[d][4 * gq] * linv, o[d][4 * gq + 1] * linv); w.y = pk2(o[d][4 * gq + 2] * linv, o[d][4 * gq + 3] * linv); *(u32x2*)(op + 32 * d + 8 * gq) = w; }
}


constexpr int KSTR = 272, VSTR = 136, KTILE_B = 64 * KSTR, VTILE_B = 128 * VSTR, KVBUF_B = KTILE_B + VTILE_B;
struct KVStage {
    u32x4 k[2], v[2];
    __device__ __forceinline__ void load(const unsigned char* kg, size_t kstride, const unsigned char* vg, size_t vstride, int tid) {
#pragma unroll
        for (int i = 0; i < 2; ++i) { const int c = tid + 512 * i; k[i] = *(const u32x4*)(kg + (size_t)(c >> 4) * kstride + (c & 15) * 16); v[i] = *(const u32x4*)(vg + (size_t)(c >> 3) * vstride + (c & 7) * 16); }
    }
    __device__ __forceinline__ void store(LAS unsigned char* buf, int tid) const {
#pragma unroll
        for (int i = 0; i < 2; ++i) { const int c = tid + 512 * i;
            *(LAS u32x4*)(buf + (c >> 4) * KSTR + (c & 15) * 16) = k[i];
            LAS unsigned char* vp = buf + KTILE_B + (c >> 3) * VSTR + (c & 7) * 16;
            *(LAS u32x2*)vp = (u32x2){v[i].x, v[i].y}; *(LAS u32x2*)(vp + 8) = (u32x2){v[i].z, v[i].w}; }
    }
};

__device__ __forceinline__ void dsa_attn_block(const bf16_t* __restrict__ QD, const bf16_t* __restrict__ KD, const bf16_t* __restrict__ VTD, const unsigned* __restrict__ MASK, bf16_t* __restrict__ O,
                                               LAS unsigned char* lds, int b, int g, int qb64, int wave, int lane, int tid) {
    const int r = lane & 31, hh = lane >> 5, h = 4 * g + (wave & 3), q0 = 64 * qb64 + 32 * (wave >> 2);
    LAS unsigned char* qlds = lds + 2 * KVBUF_B + wave * (32 * KSTR);
    { const unsigned char* qg = (const unsigned char*)(QD + (size_t)(b * SEQ + q0) * DM + h * HD);
        u32x4 t[8];
#pragma unroll
        for (int i = 0; i < 8; ++i) { const int c = lane + 64 * i; t[i] = *(const u32x4*)(qg + (size_t)(c >> 4) * (DM * 2) + (c & 15) * 16); }
#pragma unroll
        for (int i = 0; i < 8; ++i) { const int c = lane + 64 * i; *(LAS u32x4*)(qlds + (c >> 4) * KSTR + (c & 15) * 16) = t[i]; }
        asm volatile("s_waitcnt lgkmcnt(0)" ::: "memory"); }
    const LAS unsigned char* qfp = qlds + r * KSTR + 16 * hh;
    f32x16 o[4];
#pragma unroll
    for (int d = 0; d < 4; ++d) o[d] = f32x16{};
    float mrun = -1e30f, lrun = 0.f;
    const unsigned char* kg = (const unsigned char*)(KD + (size_t)(b * SEQ) * (KVH * HD) + g * HD);
    const unsigned char* vg = (const unsigned char*)(VTD + (size_t)(b * KVH + g) * HD * SEQ);
    const unsigned long long* mrow = (const unsigned long long*)(MASK + (size_t)(b * SEQ + q0 + r) * 64);
    KVStage sA, sB;
#define MA_LOAD(ST, t) ST.load(kg + (size_t)(t) * 64 * (KVH * HD * 2), KVH * HD * 2, vg + (size_t)(t) * 64 * 2, SEQ * 2, tid)
    MA_LOAD(sA, 0);
    sA.store(lds, tid);
    asm volatile("s_waitcnt lgkmcnt(0)" ::: "memory"); __builtin_amdgcn_s_barrier(); asm volatile("" ::: "memory");
    if (qb64 >= 1) MA_LOAD(sA, 1);
    if (qb64 >= 2) MA_LOAD(sB, 2);
    unsigned long long mw_next = mrow[0];
    for (int kt = 0; kt <= qb64; ++kt) {
        LAS unsigned char* buf = lds + (kt & 1) * KVBUF_B;
        const unsigned long long mw = mw_next;
        if (kt < qb64) mw_next = mrow[kt + 1];
        const bool two = (64 * kt + 32) <= q0 + 31;
        f32x16 p0 = f32x16{}, p1 = f32x16{};
        { const LAS unsigned char* kp = buf + r * KSTR + 16 * hh;
            bf16x8 qf[8];
#pragma unroll
            for (int s = 0; s < 8; ++s) qf[s] = *(const LAS bf16x8*)(qfp + 32 * s);
#pragma unroll
            for (int s = 0; s < 8; ++s) p0 = __builtin_amdgcn_mfma_f32_32x32x16_bf16(*(const LAS bf16x8*)(kp + 32 * s), qf[s], p0, 0, 0, 0);
            if (two) {
#pragma unroll
                for (int s = 0; s < 8; ++s) p1 = __builtin_amdgcn_mfma_f32_32x32x16_bf16(*(const LAS bf16x8*)(kp + 32 * KSTR + 32 * s), qf[s], p1, 0, 0, 0); } }
        const unsigned m0 = ((unsigned)mw) >> (4 * hh), m1 = two ? (((unsigned)(mw >> 32)) >> (4 * hh)) : 0u;
        float tmax = -1e30f;
#pragma unroll
        for (int i = 0; i < 16; ++i) { const int kb = crow(i, 0); tmax = fmaxf(tmax, ((m0 >> kb) & 1u) ? p0[i] : -1e30f); tmax = fmaxf(tmax, ((m1 >> kb) & 1u) ? p1[i] : -1e30f); }
        tmax = swap_max(tmax);
        const float mnew = fmaxf(mrun, tmax);
        if (__any(mnew > mrun)) {
            const float alpha = __builtin_amdgcn_exp2f(mrun - mnew);
            lrun *= alpha;
#pragma unroll
            for (int d = 0; d < 4; ++d)
#pragma unroll
                for (int i = 0; i < 16; ++i) o[d][i] *= alpha;
        }
        float ls = 0.f;
#pragma unroll
        for (int i = 0; i < 16; ++i) { const int kb = crow(i, 0);
            const float e0 = ((m0 >> kb) & 1u) ? __builtin_amdgcn_exp2f(p0[i] - mnew) : 0.f, e1 = ((m1 >> kb) & 1u) ? __builtin_amdgcn_exp2f(p1[i] - mnew) : 0.f;
            p0[i] = e0; p1[i] = e1; ls += e0 + e1; }
        lrun += ls; mrun = mnew;
        const bf16x8 pa0 = pack8(p0, 0), pa1 = pack8(p0, 8), pa2 = pack8(p1, 0), pa3 = pack8(p1, 8);
        const LAS unsigned char* vb = buf + KTILE_B + r * VSTR + 8 * hh;
#pragma unroll
        for (int d = 0; d < 4; ++d) {
            const LAS unsigned char* vp = vb + 32 * d * VSTR;
#define VFRAG(ks) ({ const s16x4 lo_ = *(const LAS s16x4*)(vp + 32 * (ks)), hi_ = *(const LAS s16x4*)(vp + 32 * (ks) + 16); (bf16x8){lo_[0], lo_[1], lo_[2], lo_[3], hi_[0], hi_[1], hi_[2], hi_[3]}; })
            o[d] = __builtin_amdgcn_mfma_f32_32x32x16_bf16(VFRAG(0), pa0, o[d], 0, 0, 0);
            o[d] = __builtin_amdgcn_mfma_f32_32x32x16_bf16(VFRAG(1), pa1, o[d], 0, 0, 0);
            if (two) { o[d] = __builtin_amdgcn_mfma_f32_32x32x16_bf16(VFRAG(2), pa2, o[d], 0, 0, 0);
                       o[d] = __builtin_amdgcn_mfma_f32_32x32x16_bf16(VFRAG(3), pa3, o[d], 0, 0, 0); }
#undef VFRAG
        }
        if (kt & 1) { if (kt + 1 <= qb64) sB.store(lds + ((kt + 1) & 1) * KVBUF_B, tid); if (kt + 3 <= qb64) MA_LOAD(sB, kt + 3); }
        else        { if (kt + 1 <= qb64) sA.store(lds + ((kt + 1) & 1) * KVBUF_B, tid); if (kt + 3 <= qb64) MA_LOAD(sA, kt + 3); }
        asm volatile("s_waitcnt lgkmcnt(0)" ::: "memory"); __builtin_amdgcn_s_barrier(); asm volatile("" ::: "memory");
    }
#undef MA_LOAD
    asm volatile("s_waitcnt vmcnt(0)" ::: "memory");
    const float linv = 1.0f / swap_sum(lrun);
    bf16_t* op = O + (size_t)(b * SEQ + q0 + r) * DM + h * HD + 4 * hh;
#pragma unroll
    for (int d = 0; d < 4; ++d)
#pragma unroll
        for (int gq = 0; gq < 4; ++gq) { u32x2 w; w.x = pk2(o[d][4 * gq] * linv, o[d][4 * gq + 1] * linv); w.y = pk2(o[d][4 * gq + 2] * linv, o[d][4 * gq + 3] * linv); *(u32x2*)(op + 32 * d + 8 * gq) = w; }
}


__device__ __forceinline__ void sb_subtile(const LAS unsigned char* kp, const LAS unsigned char* vb, const bf16x8 (&qf)[8], const bf16x8 (&uf)[2], f32x16 (&o)[4], float& carry, bool diag, int rm) {
    f32x16 p = f32x16{};
#pragma unroll
    for (int s = 0; s < 8; ++s) p = __builtin_amdgcn_mfma_f32_32x32x16_bf16(*(const LAS bf16x8*)(kp + 32 * s), qf[s], p, 0, 0, 0);
    f32x16 sp;
#pragma unroll
    for (int i = 0; i < 16; ++i) { const float z = p[i]; float v = fmaxf(z, 0.f) + __builtin_amdgcn_logf(1.0f + __builtin_amdgcn_exp2f(-fabsf(z)));
        if (diag && crow(i, 0) >= rm) v = 0.f; sp[i] = v; }
    f32x16 c;
#pragma unroll
    for (int i = 0; i < 16; ++i) c[i] = carry;
    c = __builtin_amdgcn_mfma_f32_32x32x16_bf16(uf[0], pack8(sp, 0), c, 0, 0, 0);
    c = __builtin_amdgcn_mfma_f32_32x32x16_bf16(uf[1], pack8(sp, 8), c, 0, 0, 0);
#pragma unroll
    for (int i = 0; i < 16; ++i) { float v = __builtin_amdgcn_exp2f(p[i] - c[i]); if (diag && crow(i, 0) >= rm) v = 0.f; p[i] = v; }
    carry = swap_max(c[0]);
    const bf16x8 pa0 = pack8(p, 0), pa1 = pack8(p, 8);
#pragma unroll
    for (int d = 0; d < 4; ++d) { const LAS unsigned char* vp = vb + 32 * d * VSTR;
        const s16x4 l0 = *(const LAS s16x4*)vp, h0 = *(const LAS s16x4*)(vp + 16), l1 = *(const LAS s16x4*)(vp + 32), h1 = *(const LAS s16x4*)(vp + 48);
        o[d] = __builtin_amdgcn_mfma_f32_32x32x16_bf16((bf16x8){l0[0], l0[1], l0[2], l0[3], h0[0], h0[1], h0[2], h0[3]}, pa0, o[d], 0, 0, 0);
        o[d] = __builtin_amdgcn_mfma_f32_32x32x16_bf16((bf16x8){l1[0], l1[1], l1[2], l1[3], h1[0], h1[1], h1[2], h1[3]}, pa1, o[d], 0, 0, 0); }
}
__device__ __forceinline__ void sb_attn_block(const bf16_t* __restrict__ Q, const bf16_t* __restrict__ K, const bf16_t* __restrict__ Vt, bf16_t* __restrict__ O, LAS unsigned char* lds,
                                              int bh, int qblk, int wave, int lane, int tid) {
    const int r = lane & 31, hh = lane >> 5, b = bh >> 4, h = bh & 15, q0 = qblk * 256 + wave * 32, rm = r - 4 * hh;
    bf16x8 uf[2];
#pragma unroll
    for (int s2 = 0; s2 < 2; ++s2) { u32x4 w; unsigned e[8];
#pragma unroll
        for (int j = 0; j < 8; ++j) { const int key = 16 * s2 + 8 * (j >> 2) + 4 * hh + (j & 3); e[j] = (key >= r) ? 0x3f80u : 0u; }
        w.x = e[0] | (e[1] << 16); w.y = e[2] | (e[3] << 16); w.z = e[4] | (e[5] << 16); w.w = e[6] | (e[7] << 16); uf[s2] = __builtin_bit_cast(bf16x8, w); }
    const bf16_t* qp = Q + (size_t)(b * SEQ + q0 + r) * DM + h * HD + 8 * hh;
    bf16x8 qf[8];
#pragma unroll
    for (int s = 0; s < 8; ++s) qf[s] = *(const bf16x8*)(qp + 16 * s);
    f32x16 o[4];
#pragma unroll
    for (int d = 0; d < 4; ++d) o[d] = f32x16{};
    float carry = 0.f; bool done = false;
    const unsigned char* kg = (const unsigned char*)(K + (size_t)(b * SEQ) * DM + h * HD);
    const unsigned char* vg = (const unsigned char*)(Vt + (size_t)bh * HD * SEQ);
    volatile LAS unsigned* flags = (volatile LAS unsigned*)(lds + 2 * KVBUF_B);
    const int ktop = qblk * 4 + 3;
    KVStage sA, sB;
#define SB_LOAD(ST, t) ST.load(kg + (size_t)(t) * 64 * (DM * 2), DM * 2, vg + (size_t)(t) * 64 * 2, SEQ * 2, tid)
    SB_LOAD(sA, ktop);
    sA.store(lds, tid);
    asm volatile("s_waitcnt lgkmcnt(0)" ::: "memory"); __builtin_amdgcn_s_barrier(); asm volatile("" ::: "memory");
    if (ktop >= 1) SB_LOAD(sA, ktop - 1);
    if (ktop >= 2) SB_LOAD(sB, ktop - 2);
    int kt = ktop, it = 0; bool fin = false;
#define SB_STEP(ST) do { \
        const LAS unsigned char* buf = lds + (it & 1) * KVBUF_B; \
        if (!done) { \
            _Pragma("unroll") for (int j = 1; j >= 0; --j) { const int key0 = 64 * kt + 32 * j; \
                if (!done && key0 <= q0) { \
                    sb_subtile(buf + (32 * j + r) * KSTR + 16 * hh, buf + KTILE_B + r * VSTR + 64 * j + 8 * hh, qf, uf, o, carry, key0 == q0, rm); \
                    if (__all(carry > SB_EXIT)) done = true; } } } \
        if (kt >= 1) ST.store(lds + ((it + 1) & 1) * KVBUF_B, tid); \
        if (kt >= 3) SB_LOAD(ST, kt - 3); \
        if (lane == 0) flags[wave] = done ? 1u : 0u; \
        asm volatile("s_waitcnt lgkmcnt(0)" ::: "memory"); __builtin_amdgcn_s_barrier(); asm volatile("" ::: "memory"); \
        if (kt == 0) fin = true; \
        else { unsigned nd = 0; _Pragma("unroll") for (int w = 0; w < 8; ++w) nd += flags[w]; if (nd == 8u) fin = true; } \
        --kt; ++it; } while (0)
    for (;;) { SB_STEP(sA); if (fin) break; SB_STEP(sB); if (fin) break; }
#undef SB_STEP
#undef SB_LOAD
    asm volatile("s_waitcnt vmcnt(0)" ::: "memory");
    bf16_t* op = O + (size_t)(b * SEQ + q0 + r) * DM + h * HD + 4 * hh;
#pragma unroll
    for (int d = 0; d < 4; ++d)
#pragma unroll
        for (int g = 0; g < 4; ++g) { u32x2 w; w.x = pk2(o[d][4 * g], o[d][4 * g + 1]); w.y = pk2(o[d][4 * g + 2], o[d][4 * g + 3]); *(u32x2*)(op + 32 * d + 8 * g) = w; }
}


__device__ __forceinline__ unsigned wave_total_u32(unsigned v) {
    v += (unsigned)__builtin_amdgcn_update_dpp(0, (int)v, 0x111, 0xf, 0xf, true);
    v += (unsigned)__builtin_amdgcn_update_dpp(0, (int)v, 0x112, 0xf, 0xf, true);
    v += (unsigned)__builtin_amdgcn_update_dpp(0, (int)v, 0x114, 0xf, 0xf, true);
    v += (unsigned)__builtin_amdgcn_update_dpp(0, (int)v, 0x118, 0xf, 0xf, true);
    v += (unsigned)__builtin_amdgcn_update_dpp(0, (int)v, 0x142, 0xa, 0xf, false);
    v += (unsigned)__builtin_amdgcn_update_dpp(0, (int)v, 0x143, 0xc, 0xf, false);
    return (unsigned)__builtin_amdgcn_readlane((int)v, 63);
}
__device__ __forceinline__ void causal_mask_row(unsigned* mrow, int t, int lane) {
    const int key0 = 32 * lane; unsigned w;
    if (key0 + 31 <= t) w = 0xffffffffu; else if (key0 > t) w = 0u; else w = (1u << (t - key0 + 1)) - 1u;
    mrow[lane] = w;
}
__device__ __forceinline__ void write_topk_mask(const unsigned (&uv)[32], unsigned prefix, unsigned* mrow, int lane) {
    int cgt = 0;
#pragma unroll
    for (int e = 0; e < 32; ++e) cgt += __popcll(__ballot(uv[e] > prefix));
    const int need = TOPK - cgt; int running = 0;
    const unsigned long long ltm = (1ull << lane) - 1ull;
    unsigned long long keep = 0ull;
#pragma unroll
    for (int e = 0; e < 32; ++e) {
        const unsigned long long eq = __ballot(uv[e] == prefix);
        const bool sel = (uv[e] > prefix) || (uv[e] == prefix && (running + __popcll(eq & ltm)) < need);
        const unsigned long long m64 = __ballot(sel);
        running += __popcll(eq);
        if (lane == e) keep = m64;
    }
    if (lane < 32) *(unsigned long long*)(mrow + 2 * lane) = keep;
}
__device__ __forceinline__ void select_two(const float* rowa, const float* rowb, int ta, unsigned* mrowa, unsigned* mrowb, int lane) {
    const int tb = ta + 1, na = ta + 1, nb = tb + 1;
    if (nb <= TOPK) { causal_mask_row(mrowa, ta, lane); causal_mask_row(mrowb, tb, lane); return; }
    float fa[32], fb[32];
#pragma unroll
    for (int e = 0; e < 32; ++e) { fa[e] = __builtin_nontemporal_load(rowa + e * 64 + lane); fb[e] = __builtin_nontemporal_load(rowb + e * 64 + lane); }
    unsigned ua[32], ub[32];
#pragma unroll
    for (int e = 0; e < 32; ++e) { const int key = e * 64 + lane; const unsigned ma = fmap(fa[e]), mb = fmap(fb[e]); ua[e] = (key < na) ? ma : 0x007fffffu; ub[e] = (key < nb) ? mb : 0x007fffffu; }
    unsigned pa = 0u, pb = 0u; bool da = false, db = false;
    for (int bit = 31; bit >= 0; --bit) {
        const unsigned ca = pa | (1u << bit), cb = pb | (1u << bit);
        unsigned na_ = 0u, nb_ = 0u;
#pragma unroll
        for (int e = 0; e < 32; ++e) { na_ += (ua[e] >= ca) ? 1u : 0u; nb_ += (ub[e] >= cb) ? 1u : 0u; }
        const unsigned tota = wave_total_u32(na_), totb = wave_total_u32(nb_);
        if (!da && tota >= (unsigned)TOPK) { pa = ca; if (tota == (unsigned)TOPK) da = true; }
        if (!db && totb >= (unsigned)TOPK) { pb = cb; if (totb == (unsigned)TOPK) db = true; }
        if (da && db) break;
    }
    if (na <= TOPK) causal_mask_row(mrowa, ta, lane); else write_topk_mask(ua, pa, mrowa, lane);
    write_topk_mask(ub, pb, mrowb, lane);
}

struct KiStage {
    u32x4 k[4];
    __device__ __forceinline__ void load(const unsigned char* kg, int tid) {
#pragma unroll
        for (int i = 0; i < 4; ++i) { const int c = tid + 512 * i; k[i] = *(const u32x4*)(kg + (size_t)(c >> 4) * (HD * 2) + (c & 15) * 16); }
    }
    __device__ __forceinline__ void store(LAS unsigned char* buf, int tid) const {
#pragma unroll
        for (int i = 0; i < 4; ++i) { const int c = tid + 512 * i; *(LAS u32x4*)(buf + (c >> 4) * KSTR + (c & 15) * 16) = k[i]; }
    }
};
constexpr int KIBUF_B = 128 * KSTR;
__device__ __forceinline__ void indexer_block(const bf16_t* __restrict__ QI, const bf16_t* __restrict__ KI, const float* __restrict__ WI, unsigned* __restrict__ MASK, float* __restrict__ SC,
                                              LAS unsigned char* lds, int b, int qb16, int wave, int lane, int tid) {
    const int r = lane & 31, hh = lane >> 5, t0 = 16 * qb16, tw = t0 + 2 * wave;
    const bf16_t* ap = QI + (size_t)(b * SEQ + tw + (r >> 4)) * DM + (r & 15) * HD + 8 * hh;
    bf16x8 af[8];
#pragma unroll
    for (int s = 0; s < 8; ++s) af[s] = *(const bf16x8*)(ap + 16 * s);
    float wv[16];
#pragma unroll
    for (int i = 0; i < 16; ++i) { const int rw = crow(i, hh); wv[i] = WI[(size_t)(b * SEQ + tw + (rw >> 4)) * 16 + (rw & 15)]; }
    float* myrow = SC + ((size_t)(b * 128 + qb16) * 16 + 2 * wave + hh) * SEQ;
    const int tq = tw + hh, ntile = (t0 + 16 + 127) >> 7;
    const unsigned char* kg = (const unsigned char*)(KI + (size_t)(b * SEQ) * HD);
    KiStage sA, sB;
    sA.load(kg, tid);
    sA.store(lds, tid);
    asm volatile("s_waitcnt lgkmcnt(0)" ::: "memory"); __builtin_amdgcn_s_barrier(); asm volatile("" ::: "memory");
    if (ntile > 1) sA.load(kg + (size_t)1 * 128 * (HD * 2), tid);
    if (ntile > 2) sB.load(kg + (size_t)2 * 128 * (HD * 2), tid);
    for (int kt = 0; kt < ntile; ++kt) {
        const LAS unsigned char* buf = lds + (kt & 1) * KIBUF_B;
#pragma unroll
        for (int j = 0; j < 4; ++j) { const int key0 = 128 * kt + 32 * j;
            if (key0 <= t0 + 15) {
                const LAS unsigned char* kp = buf + (32 * j + r) * KSTR + 16 * hh;
                f32x16 c = f32x16{};
#pragma unroll
                for (int s = 0; s < 8; ++s) c = __builtin_amdgcn_mfma_f32_32x32x16_bf16(af[s], *(const LAS bf16x8*)(kp + 32 * s), c, 0, 0, 0);
                float s0 = 0.f, s1 = 0.f;
#pragma unroll
                for (int i = 0; i < 8; ++i) { s0 += wv[i] * fmaxf(c[i], 0.f); s1 += wv[i + 8] * fmaxf(c[i + 8], 0.f); }
                const float t0s = swap_sum(s0), t1s = swap_sum(s1);
                const int key = key0 + r;
                float v = (hh ? t1s : t0s) + 0.0f;
                if (key > tq) v = -INFINITY;
                myrow[key] = v; } }
        if (kt & 1) { if (kt + 1 < ntile) sB.store(lds + ((kt + 1) & 1) * KIBUF_B, tid); if (kt + 3 < ntile) sB.load(kg + (size_t)(kt + 3) * 128 * (HD * 2), tid); }
        else        { if (kt + 1 < ntile) sA.store(lds + ((kt + 1) & 1) * KIBUF_B, tid); if (kt + 3 < ntile) sA.load(kg + (size_t)(kt + 3) * 128 * (HD * 2), tid); }
        asm volatile("s_waitcnt lgkmcnt(0)" ::: "memory"); __builtin_amdgcn_s_barrier(); asm volatile("" ::: "memory");
    }
    asm volatile("s_waitcnt vmcnt(0)" ::: "memory");
    { const float* rowa = SC + ((size_t)(b * 128 + qb16) * 16 + 2 * wave) * SEQ;
      unsigned* mrowa = MASK + (size_t)(b * SEQ + tw) * 64;
      select_two(rowa, rowa + SEQ, tw, mrowa, mrowa + 64, lane); }
}

constexpr int N_PHASES = 12;
__global__ void __launch_bounds__(512, 2) fwd_kernel(Args a) {
    extern __shared__ __attribute__((aligned(16))) unsigned char lds_raw[];
    LAS unsigned char* lds = (LAS unsigned char*)lds_raw;
    cg::grid_group grid = cg::this_grid();
    const int tid = threadIdx.x, lane = tid & 63, wave = __builtin_amdgcn_readfirstlane(tid >> 6);
    const int G = gridDim.x, bx = blockIdx.x;
    const int gw = bx * 8 + wave, ngw = G * 8;
    unsigned char* ws = a.ws;
    const int lo = a.ph_lo, hi = a.ph_hi;
#ifndef REP_PHASE
#define REP_PHASE -1
#endif
#ifndef REP_COUNT
#define REP_COUNT 1
#endif
#define IN(k) (lo <= (k) && (k) < hi)
#define GSYNC(k) do { if ((k) == 0 && a.ph_hi > 1000) grid.sync(); xcd_barrier(xbar); } while (0)
#define SEAM(k) do { if (IN(k) && IN((k) + 1)) GSYNC(k); } while (0)
#define REPS(k) for (int rep_ = 0; rep_ < ((k) == REP_PHASE ? REP_COUNT : 1); ++rep_, (void)(((k) == REP_PHASE && rep_ < REP_COUNT) ? (xcd_barrier(xbar), 0) : 0))
    bf16_t* XB = (bf16_t*)(ws + WS_XB); float* X1 = (float*)(ws + WS_X1); float* X2 = (float*)(ws + WS_X2); float* PART = (float*)(ws + WS_PART);
    bf16_t* Qb = (bf16_t*)(ws + WS_Q); bf16_t* Kb = (bf16_t*)(ws + WS_K); bf16_t* Vtb = (bf16_t*)(ws + WS_VT); bf16_t* Ob = (bf16_t*)(ws + WS_O);
    bf16_t* QIb = (bf16_t*)(ws + WS_QI); bf16_t* KDb = (bf16_t*)(ws + WS_KD); bf16_t* VTDb = (bf16_t*)(ws + WS_VTD); bf16_t* KIb = (bf16_t*)(ws + WS_KI);
    float* WIb = (float*)(ws + WS_WI); unsigned* MASKb = (unsigned*)(ws + WS_MASK);
    bf16_t* ACTb = (bf16_t*)(ws + WS_ACT);
    const float* ropeC = (const float*)(ws + WS_ROPE); const float* ropeS = ropeC + SEQ * 64;

    if (tid < 16) ((volatile LAS unsigned*)(lds + LDS_MISC))[tid] = 0u;
    __syncthreads();
    XcdBarrier xbar = xcd_barrier_post((unsigned*)(ws + WS_CTL), (volatile LAS unsigned*)(lds + LDS_MISC) + 8);
    const Offload offl = make_offload(G);
    if (IN(0)) REPS(0) { prologue_phase(a, lds, gw, ngw, wave, lane, offl); }
    SEAM(0);
    if (IN(1)) REPS(1) {
        pg8::Gemm g{XB, (const bf16_t*)(ws + WS_WQKV), MTOK, NQKV, DM}; pg8::StaticOrder S; S.init(MTOK, NQKV, G, bx);
        EpiQKV E{ws};
        pg8::gemm_phase<EpiQKV, pg8::StaticOrder, true, true>(lds, g, S, E);
    }
    SEAM(1);
    if (IN(2)) REPS(2) { for (int unit = bx; unit < BATCH * NH * 8; unit += G) sb_attn_block(Qb, Kb, Vtb, Ob, lds, unit >> 3, 7 - (unit & 7), wave, lane, tid); }
    SEAM(2);
    if (IN(3)) REPS(3) {
        pg8::Gemm g{Ob, (const bf16_t*)(ws + WS_WO0), MTOK, DM, DM}; pg8::StaticOrder S; S.init(MTOK, DM, G, bx);
        EpiRes E{a.x, X1, XB, PART};
        pg8::gemm_phase<EpiRes, pg8::StaticOrder, true, true>(lds, g, S, E);
    }
    SEAM(3);
    if (IN(4)) REPS(4) {
        const int Gg = offl.up0 ? offl.g_up : G;
        if (bx < Gg) {
        pg8::Gemm g{XB, (const bf16_t*)(ws + WS_WUP), MTOK, NUP, DM, 254, -2}; pg8::StaticOrder S; S.init_tiles(33, NUP / 256, Gg, bx);
        EpiUpConv E{ACTb, PART, a.conv_w, a.conv_b, (LAS float*)(lds + LDS_EPI)};
        pg8::gemm_phase<EpiUpConv, pg8::StaticOrder, true, true>(lds, g, S, E);
        } else { LAS float* scr = (LAS float*)(lds + wave * 16640); const int vw = (bx - Gg) * 8 + wave, nvw = (G - Gg) * 8;
            convert_items(a, scr, WI5, WI6, vw, nvw, lane); convert_items(a, scr, WI1, WI2, vw, nvw, lane); }
    }
    SEAM(4);
    if (IN(5)) REPS(5) {
        pg8::Gemm g{ACTb, (const bf16_t*)(ws + WS_WDN), MTOK, DM, FF}; pg8::StaticOrder S; S.init(MTOK, DM, G, bx);
        EpiRes E{X1, X2, XB, PART};
        pg8::gemm_phase<EpiRes, pg8::StaticOrder, true, true>(lds, g, S, E);
    }
    SEAM(5);
    if (IN(6)) REPS(6) {
        const int Gg = offl.in1 ? offl.g_in : G;
        if (bx < Gg) {
        pg8::Gemm g{XB, (const bf16_t*)(ws + WS_WIN), MTOK, NINP, DM}; pg8::StaticOrder S; S.init(MTOK, NINP, Gg, bx);
        EpiDsaIn E{ws, (LAS float*)(lds + LDS_EPI)};
        pg8::gemm_phase<EpiDsaIn, pg8::StaticOrder, true, true>(lds, g, S, E);
        } else { LAS float* scr = (LAS float*)(lds + wave * 16640); const int vw = (bx - Gg) * 8 + wave, nvw = (G - Gg) * 8;
            convert_items(a, scr, WI2, WI3, vw, nvw, lane); convert_items(a, scr, WI4, WI5, vw, nvw, lane); }
    }
    SEAM(6);
    if (IN(7)) REPS(7) {
        for (int pr = bx; pr < 256; pr += G) { const int b = pr >> 6, p = pr & 63;
            for (int half = 0; half < 2; ++half) indexer_block(QIb, KIb, WIb, MASKb, (float*)(ws + WS_ACT), lds, b, half ? p : 127 - p, wave, lane, tid); }
    }
    SEAM(7);
    if (IN(8)) REPS(8) {
        for (int pr = bx; pr < 256; pr += G) { const int b = pr >> 6, g = (pr >> 4) & 3, p = pr & 15;
            for (int half = 0; half < 2; ++half) dsa_attn_block(Qb, KDb, VTDb, MASKb, Ob, lds, b, g, half ? p : 31 - p, wave, lane, tid); }
    }
    SEAM(8);
    if (IN(9)) REPS(9) {
        pg8::Gemm g{Ob, (const bf16_t*)(ws + WS_WO1), MTOK, DM, DM}; pg8::StaticOrder S; S.init(MTOK, DM, G, bx);
        EpiRes E{X2, X1, XB, PART};
        pg8::gemm_phase<EpiRes, pg8::StaticOrder, true, true>(lds, g, S, E);
    }
    SEAM(9);
    if (IN(10)) REPS(10) {
        const int Gg = offl.up1 ? offl.g_up : G;
        if (bx < Gg) {
        pg8::Gemm g{XB, (const bf16_t*)(ws + WS_WUP + 44 * MiB), MTOK, NUP, DM, 254, -2}; pg8::StaticOrder S; S.init_tiles(33, NUP / 256, Gg, bx);
        EpiUpConv E{ACTb, PART, a.conv_w + 3 * NUP, a.conv_b + NUP, (LAS float*)(lds + LDS_EPI)};
        pg8::gemm_phase<EpiUpConv, pg8::StaticOrder, true, true>(lds, g, S, E);
        } else { LAS float* scr = (LAS float*)(lds + wave * 16640); const int vw = (bx - Gg) * 8 + wave, nvw = (G - Gg) * 8;
            convert_items(a, scr, WI6, WI7, vw, nvw, lane); }
    }
    SEAM(10);
    if (IN(11)) REPS(11) {
        pg8::Gemm g{ACTb, (const bf16_t*)(ws + WS_WDN + 22 * MiB), MTOK, DM, FF}; pg8::StaticOrder S; S.init(MTOK, DM, G, bx);
        EpiRes E{X1, a.out, nullptr, nullptr};
        pg8::gemm_phase<EpiRes, pg8::StaticOrder, true, true>(lds, g, S, E);
    }
#undef IN
#undef SEAM
}

extern "C" void kernel_launch(void* const* d_in, const int* in_sizes, int n_in, void* d_out, int out_size, void* d_ws, size_t ws_size, hipStream_t stream) {
    static int grid = 0;
    if (grid == 0) {
        if (n_in != 14 || out_size != MTOK * DM || ws_size < WS_END) { fprintf(stderr, "kernel_launch: unexpected shapes (n_in %d out %d ws %zu)\n", n_in, out_size, ws_size); grid = -1; return; }
        int dev = 0, cus = 0, per_cu = 0;
        hipGetDevice(&dev); hipDeviceGetAttribute(&cus, hipDeviceAttributeMultiprocessorCount, dev);
        if (hipFuncSetAttribute((const void*)fwd_kernel, hipFuncAttributeMaxDynamicSharedMemorySize, LDS_BYTES) != hipSuccess) { fprintf(stderr, "kernel_launch: hipFuncSetAttribute failed\n"); grid = -1; return; }
        if (hipOccupancyMaxActiveBlocksPerMultiprocessor(&per_cu, (const void*)fwd_kernel, 512, LDS_BYTES) != hipSuccess || per_cu < 1) { fprintf(stderr, "kernel_launch: occupancy query says %d\n", per_cu); per_cu = 1; }
        (void)hipGetLastError();
        grid = cus;
    }
    if (grid < 0) return;
    Args a{};
    a.x = (const float*)d_in[0]; a.attn_g = (const float*)d_in[1]; a.ffn_g = (const float*)d_in[2]; a.w_qkv = (const float*)d_in[3]; a.w_o0 = (const float*)d_in[4]; a.w_in = (const float*)d_in[5];
    a.qn_g = (const float*)d_in[6]; a.kn_g = (const float*)d_in[7]; a.ikn_g = (const float*)d_in[8]; a.w_o1 = (const float*)d_in[9]; a.w_up = (const float*)d_in[10]; a.conv_w = (const float*)d_in[11];
    a.conv_b = (const float*)d_in[12]; a.w_down = (const float*)d_in[13]; a.out = (float*)d_out; a.ws = (unsigned char*)d_ws;
    if (hipMemsetAsync((char*)d_ws + WS_CTL, 0, CTL_BYTES, stream) != hipSuccess) { fprintf(stderr, "kernel_launch: hipMemsetAsync failed\n"); return; }
#if MK_ONE_LAUNCH
    a.ph_lo = 0; a.ph_hi = N_PHASES;
    void* args[] = {&a};
    hipError_t e = hipLaunchCooperativeKernel((const void*)fwd_kernel, dim3(grid), dim3(512), args, LDS_BYTES, stream);
    if (e != hipSuccess) fprintf(stderr, "cooperative launch failed: %s (grid %d)\n", hipGetErrorString(e), grid);
#else
    for (int pp = 0; pp < N_PHASES + HOST_REP_EXTRA; ++pp) {
        const int p = pp < N_PHASES ? pp : -1;
        if (p < 0) continue;
        for (int hr = 0; hr < ((p == HOST_REP_PHASE) ? 1 + HOST_REP_EXTRA : 1); ++hr) {
        a.ph_lo = p; a.ph_hi = p + 1;
        void* args[] = {&a};
        hipError_t e = hipLaunchCooperativeKernel((const void*)fwd_kernel, dim3(grid), dim3(512), args, LDS_BYTES, stream);
        if (e != hipSuccess) { fprintf(stderr, "launch %d failed: %s (grid %d)\n", p, hipGetErrorString(e), grid); break; }
        }
    }
#endif
}
```

```cpp
#include <hip/hip_runtime.h>
#include <hip/hip_cooperative_groups.h>
#include <cstdio>
#include <cstdint>
namespace cg = cooperative_groups;

#ifndef HOST_REP_PHASE
#define HOST_REP_PHASE -1
#endif
#ifndef HOST_REP_EXTRA
#define HOST_REP_EXTRA 0
#endif
#ifndef MK_ONE_LAUNCH
#define MK_ONE_LAUNCH 1
#endif

#define LAS __attribute__((address_space(3)))
typedef unsigned short bf16_t;
typedef short bf16x8 __attribute__((ext_vector_type(8)));
typedef short s16x4 __attribute__((ext_vector_type(4)));
typedef float f32x4 __attribute__((ext_vector_type(4)));
typedef float f32x2 __attribute__((ext_vector_type(2)));
typedef float f32x16 __attribute__((ext_vector_type(16)));
typedef unsigned u32x4 __attribute__((ext_vector_type(4)));
typedef unsigned u32x2 __attribute__((ext_vector_type(2)));
typedef __bf16 bf16x2_t __attribute__((ext_vector_type(2)));

constexpr int BATCH = 4, SEQ = 2048, DM = 2048, NH = 16, HD = 128, MTOK = BATCH * SEQ;
constexpr int FF = 5632, NUP = 2 * FF, NQKV = 3 * DM;
constexpr int KVH = 4, NIN = 5264, NINP = 5376;
constexpr int TOPK = 256;
constexpr float NORM_EPS = 1e-6f;
constexpr float LOG2E = 1.4426950408889634f;
constexpr float QSCALE = 0.08838834764831845f * LOG2E;

constexpr size_t MiB = 1u << 20;
constexpr size_t WS_WQKV = 0, WS_WO0 = 24 * MiB, WS_WIN = 32 * MiB, WS_WO1 = 53 * MiB, WS_WUP = 61 * MiB  , WS_WDN = 149 * MiB  ;
constexpr size_t WS_GAIN = 197 * MiB + 512 * 1024  ;
constexpr size_t WS_ROPE = 193 * MiB  , WS_PART = 194 * MiB, WS_MASK = 195 * MiB, WS_WI = 197 * MiB, WS_KI = 198 * MiB;
constexpr size_t WS_XB = 200 * MiB, WS_X1 = 232 * MiB, WS_X2 = 296 * MiB;
constexpr size_t WS_SCR = 360 * MiB;
constexpr size_t WS_U = WS_SCR, WS_ACT = WS_SCR + 176 * MiB;
constexpr size_t WS_Q = WS_SCR, WS_K = WS_SCR + 32 * MiB, WS_VT = WS_SCR + 64 * MiB, WS_O = WS_SCR + 96 * MiB, WS_QI = WS_SCR + 128 * MiB, WS_KD = WS_SCR + 160 * MiB, WS_VTD = WS_SCR + 168 * MiB;
constexpr size_t WS_CTL = WS_ACT + 88 * MiB, CTL_BYTES = 65536;
constexpr size_t WS_END = WS_CTL + CTL_BYTES;

constexpr int LDS_EPI = 131072;
constexpr int LDS_MISC = LDS_EPI + 8192;
constexpr int LDS_BYTES = 147456;

__device__ __forceinline__ unsigned pk2(float lo, float hi) { f32x2 v = {lo, hi}; bf16x2_t b = __builtin_convertvector(v, bf16x2_t); return __builtin_bit_cast(unsigned, b); }
__device__ __forceinline__ bf16_t f2bf(float f) { return (bf16_t)(pk2(f, 0.f) & 0xffffu); }
__device__ __forceinline__ float relu_i(float x) { const int b = __float_as_int(x); return __int_as_float(b > 0 ? b : 0); }
__device__ __forceinline__ int crow(int r, int hi) { return (r & 3) + 8 * (r >> 2) + 4 * hi; }
__device__ __forceinline__ bf16x8 pack8(const f32x16& p, int b) {
    u32x4 w; w.x = pk2(p[b], p[b + 1]); w.y = pk2(p[b + 2], p[b + 3]); w.z = pk2(p[b + 4], p[b + 5]); w.w = pk2(p[b + 6], p[b + 7]);
    return __builtin_bit_cast(bf16x8, w);
}
__device__ __forceinline__ float swap_sum(float v) { auto rr = __builtin_amdgcn_permlane32_swap(__float_as_uint(v), __float_as_uint(v), false, false); return __uint_as_float(rr[0]) + __uint_as_float(rr[1]); }
__device__ __forceinline__ float swap_max(float v) { auto rr = __builtin_amdgcn_permlane32_swap(__float_as_uint(v), __float_as_uint(v), false, false); return fmaxf(__uint_as_float(rr[0]), __uint_as_float(rr[1])); }
__device__ __forceinline__ float wave_sum(float v) {
#pragma unroll
    for (int o = 1; o < 64; o <<= 1) v += __shfl_xor(v, o);
    return v;
}
__device__ __forceinline__ float row_rstd(const float* part, int row, int fq) {
    const f32x4* p = (const f32x4*)(part + (size_t)row * 32 + 8 * fq);
    const f32x4 a = p[0], b = p[1]; float s = ((a.x + a.y) + (a.z + a.w)) + ((b.x + b.y) + (b.z + b.w));
    s += __shfl_xor(s, 16); s += __shfl_xor(s, 32);
    return 1.0f / sqrtf(s * (1.0f / DM) + NORM_EPS);
}


#define XB_TMO      128
#define XB_XCNT(j)  (256  + 64 * (j))
#define XB_XSUB(j)  (1280 + 64 * (j))
#define XB_XGEN(j)  (2304 + 64 * (j))
#define XB_TOP      3328
#define XB_TOPGEN   3392
#define XCD_BAR_WORDS 3456
#define XB_SPIN_CAP (1u << 18)
__device__ __forceinline__ unsigned xb_ld(unsigned* p)              { return __hip_atomic_load(p, __ATOMIC_RELAXED, __HIP_MEMORY_SCOPE_AGENT); }
__device__ __forceinline__ unsigned xb_add(unsigned* p, unsigned v) { return __hip_atomic_fetch_add(p, v, __ATOMIC_RELAXED, __HIP_MEMORY_SCOPE_AGENT); }
__device__ __forceinline__ unsigned xb_xcc_id() { return (unsigned)__builtin_amdgcn_s_getreg((3 << 11) | 20) & 0xFu; }
#define XB_SPIN(cond, bar) do { unsigned _sp = 0; while (cond) { __builtin_amdgcn_s_sleep(1); \
    if ((++_sp & 255u) == 0u) { if (xb_ld(&(bar)[XB_TMO])) break; if (_sp > XB_SPIN_CAP) { atomicAdd(&(bar)[XB_TMO], 1u); break; } } } } while (0)
struct XcdBarrier { unsigned* bar; unsigned x; volatile LAS unsigned* st; };
__device__ __forceinline__ XcdBarrier xcd_barrier_post(unsigned* bar, volatile LAS unsigned* st) {
    XcdBarrier b; b.bar = bar; b.x = xb_xcc_id(); b.st = st;
    if (threadIdx.x == 0) (void)xb_add(&bar[XB_XCNT(b.x)], 1u);
    return b;
}
__device__ __forceinline__ void xcd_barrier_complete(unsigned* bar, unsigned x, unsigned& nloc, unsigned& nx) {
    const unsigned G = gridDim.x * gridDim.y * gridDim.z;
    unsigned sum, cnt, mine, sp = 0u;
    for (;;) {
        sum = 0u; cnt = 0u; mine = 0u;
#pragma unroll
        for (unsigned j = 0; j < 16; ++j) { const unsigned c = xb_ld(&bar[XB_XCNT(j)]); sum += c; cnt += (c > 0u) ? 1u : 0u; mine = (j == x) ? c : mine; }
        if (sum == G) break;
        __builtin_amdgcn_s_sleep(1);
        if ((++sp & 255u) == 0u) { if (xb_ld(&bar[XB_TMO])) break; if (sp > XB_SPIN_CAP) { atomicAdd(&bar[XB_TMO], 1u); break; } }
    }
    nloc = mine > 0u ? mine : 1u; nx = cnt > 0u ? cnt : 1u;
}
__device__ __forceinline__ void xcd_barrier(const XcdBarrier& b) {
    asm volatile("s_waitcnt vmcnt(0)" ::: "memory");
    __syncthreads();
    if (threadIdx.x == 0) {
        unsigned* bar = b.bar;
        __builtin_amdgcn_s_waitcnt(0);
        unsigned nloc = b.st[0], nx = b.st[1];
        if (nloc == 0u) { xcd_barrier_complete(bar, b.x, nloc, nx); b.st[0] = nloc; b.st[1] = nx; }
        const unsigned old = xb_add(&bar[XB_XSUB(b.x)], 1u);
        const unsigned gen = old / nloc;
        if (old + 1u == (gen + 1u) * nloc) {
            __builtin_amdgcn_fence(__ATOMIC_RELEASE, "agent");
            asm volatile("s_waitcnt vmcnt(0)" ::: "memory");
            const unsigned og = xb_add(&bar[XB_TOP], 1u);
            const unsigned tg = og / nx;
            if (og + 1u == (tg + 1u) * nx) xb_add(&bar[XB_TOPGEN], 1u);
            else XB_SPIN(xb_ld(&bar[XB_TOPGEN]) == tg, bar);
            __builtin_amdgcn_fence(__ATOMIC_ACQUIRE, "agent");
            xb_add(&bar[XB_XGEN(b.x)], 1u);
            asm volatile("s_waitcnt vmcnt(0)" ::: "memory");
        } else {
            XB_SPIN(xb_ld(&bar[XB_XGEN(b.x)]) == gen, bar);
            __builtin_amdgcn_fence(__ATOMIC_ACQUIRE, "agent");
            asm volatile("s_waitcnt vmcnt(0)" ::: "memory");
        }
    }
    __syncthreads();
}

namespace pg8 {
constexpr int BM = 256, BK = 64, HALF = 128, HTB = HALF * BK * 2, STAGE_BYTES = 8 * HTB, NXCD = 8, WGM = 8;
__host__ __device__ __forceinline__ int lds_byte(int r, int c) { const int st = (r >> 4) * 2 + (c >> 5), rr = r & 15, cc = c & 31, ob = rr * 64 + cc * 2; return st * 1024 + (ob ^ (((ob >> 9) & 1) << 5)); }
__host__ __device__ __forceinline__ void stage_rc(int b, int& R, int& C) { const int st = b / 1024, sb = b % 1024, swz = sb ^ (((sb >> 9) & 1) << 5); R = (st >> 1) * 16 + swz / 64; C = (st & 1) * 32 + (swz % 64) / 2; }
__host__ __device__ __forceinline__ int perm32(int rho) { const int n = rho >> 4, i = rho & 15; return 8 * (i >> 2) + 4 * n + (i & 3); }
struct Unit { int pm, pn; };
struct Gemm { const bf16_t* A; const bf16_t* Bt; int M, N, K; int a_rows = 256, a_row0 = 0; };
struct StaticOrder {
    int nM, nN, nwg, G, c;
    __host__ __device__ void init(int M, int N, int G_, int c_) { nM = M / BM; nN = N / BM; nwg = nM * nN; G = G_; c = c_; }
    __host__ __device__ void init_tiles(int nM_, int nN_, int G_, int c_) { nM = nM_; nN = nN_; nwg = nM * nN; G = G_; c = c_; }
    __host__ __device__ bool next(int i, Unit& u) const {
        const long L = (long)i * G + c; if (L >= nwg) return false;
        int wgid = (int)L; { const int q = nwg / NXCD, r = nwg % NXCD, xcd = wgid % NXCD, off = wgid / NXCD; wgid = (xcd < r ? xcd * (q + 1) : r * (q + 1) + (xcd - r) * q) + off; }
        const int nig = WGM * nN, gid = wgid / nig, fm = gid * WGM, gsz = (nM - fm) < WGM ? (nM - fm) : WGM;
        u.pm = fm + ((wgid % nig) % gsz); u.pn = (wgid % nig) / gsz; return true;
    }
};
template <class Epi, class Sched, bool ALIGN_EPI, bool SP2>
__device__ __forceinline__ void gemm_phase(LAS unsigned char* lds, const Gemm g, const Sched& S, const Epi& E) {
    const int tid = threadIdx.x, wid = __builtin_amdgcn_readfirstlane(tid >> 6), lane = tid & 63, wr = wid >> 2, wc = wid & 3, fr = lane & 15, fq = lane >> 4;
    const int K = g.K, nt = K / BK;
    unsigned voffA[2], voffB[2];
#pragma unroll
    for (int i = 0; i < 2; ++i) { int R, C; stage_rc(tid * 16 + i * 8192, R, C); const int Rb = Epi::PERM ? ((R & ~31) + perm32(R & 31)) : R;
        voffA[i] = (unsigned)(R * K + C) * 2u; voffB[i] = (unsigned)(Rb * K + C) * 2u; }
    const size_t kstep = (size_t)(BK * 2);
    const size_t hstep = (size_t)HALF * K * 2;
    const size_t tstep = 2 * hstep;
    const unsigned ldsw = (unsigned)wid * 1024u;
    const int aoff = lds_byte(wr * 64 + fr, fq * 8), boff = lds_byte(wc * 32 + fr, fq * 8);
#define PG8_SA(b, h) (((b) * 2 + (h)) * HTB)
#define PG8_SB(b, h) ((4 + (b) * 2 + (h)) * HTB)
#define PG8_STAGE(bufoff, gbase, voff) do { _Pragma("unroll") for (int _i = 0; _i < 2; ++_i) \
        __builtin_amdgcn_global_load_lds((const unsigned*)((const char*)(gbase) + (voff)[_i]), (LAS unsigned*)(lds + (bufoff) + ldsw + _i * 8192), 16, 0, 0); } while (0)
#define PG8_LDA(dst, b, h) do { _Pragma("unroll") for (int m = 0; m < 4; ++m) _Pragma("unroll") for (int k = 0; k < 2; ++k) dst[m][k] = *(const LAS bf16x8*)(lds + PG8_SA(b, h) + aoff + m * 2048 + k * 1024); } while (0)
#define PG8_LDB(dst, b, h) do { _Pragma("unroll") for (int n = 0; n < 2; ++n) _Pragma("unroll") for (int k = 0; k < 2; ++k) dst[n][k] = *(const LAS bf16x8*)(lds + PG8_SB(b, h) + boff + n * 2048 + k * 1024); } while (0)
#define PG8_MMA(ai, bj, At, Bt) do { __builtin_amdgcn_s_setprio(1); _Pragma("unroll") for (int m = 0; m < 4; ++m) _Pragma("unroll") for (int n = 0; n < 2; ++n) _Pragma("unroll") for (int k = 0; k < 2; ++k) \
        acc[ai][bj][m][n] = __builtin_amdgcn_mfma_f32_16x16x32_bf16(Bt[n][k], At[m][k], acc[ai][bj][m][n], 0, 0, 0); __builtin_amdgcn_s_setprio(0); } while (0)
#define PG8_WAIT_V(n) asm volatile("s_waitcnt vmcnt(" #n ")" ::: "memory")
#define PG8_WAIT_L(n) asm volatile("s_waitcnt lgkmcnt(" #n ")" ::: "memory")
#define PG8_BAR __builtin_amdgcn_s_barrier()
#define PG8_SCHED __builtin_amdgcn_sched_barrier(0)
    Unit cur, nxt; int ui = 0;
    if (!S.next(0, cur)) return;
    f32x4 acc[2][2][4][2];
#pragma unroll
    for (int a = 0; a < 2; ++a)
#pragma unroll
        for (int b = 0; b < 2; ++b)
#pragma unroll
            for (int m = 0; m < 4; ++m)
#pragma unroll
                for (int n = 0; n < 2; ++n) acc[a][b][m][n] = (f32x4){0.f, 0.f, 0.f, 0.f};
    bf16x8 At[4][2], B0[2][2], B1[2][2];
    const long atstep = (long)g.a_rows * K * 2, aorg = (long)g.a_row0 * K * 2;
    const char* cA = (const char*)g.A + aorg + (long)cur.pm * atstep; const char* cB = (const char*)g.Bt + (size_t)cur.pn * tstep;
    if constexpr (SP2) {
        PG8_STAGE(PG8_SB(0, 0), cB, voffB); PG8_STAGE(PG8_SB(0, 1), cB + hstep, voffB); PG8_STAGE(PG8_SA(0, 0), cA, voffA); PG8_STAGE(PG8_SA(0, 1), cA + hstep, voffA);
        if (wr == 1) PG8_BAR;
        PG8_WAIT_V(2); PG8_BAR;
        PG8_STAGE(PG8_SB(1, 0), cB + kstep, voffB); PG8_STAGE(PG8_SA(1, 0), cA + kstep, voffA); PG8_STAGE(PG8_SB(1, 1), cB + hstep + kstep, voffB);
        PG8_WAIT_V(6); PG8_BAR;
    } else {
        PG8_STAGE(PG8_SB(0, 0), cB, voffB); PG8_STAGE(PG8_SA(0, 0), cA, voffA); PG8_STAGE(PG8_SB(0, 1), cB + hstep, voffB); PG8_STAGE(PG8_SA(0, 1), cA + hstep, voffA);
        if (wr == 1) PG8_BAR;
        PG8_WAIT_V(4); PG8_BAR;
        PG8_STAGE(PG8_SB(1, 0), cB + kstep, voffB); PG8_STAGE(PG8_SA(1, 0), cA + kstep, voffA); PG8_STAGE(PG8_SB(1, 1), cB + hstep + kstep, voffB);
        PG8_WAIT_V(6); PG8_BAR;
    }
    for (;;) {
        const bool has_next = S.next(ui + 1, nxt);
        const char* nA = has_next ? (const char*)g.A + aorg + (long)nxt.pm * atstep : cA; const char* nB = has_next ? (const char*)g.Bt + (size_t)nxt.pn * tstep : cB;
        for (int t = 0; t < nt; t += 2) {
            const bool last = (t == nt - 2);
            const char* a1 = cA + (size_t)(t + 1) * kstep;
            const char* a2 = last ? nA : cA + (size_t)(t + 2) * kstep; const char* b2 = last ? nB : cB + (size_t)(t + 2) * kstep;
            const char* a3 = a2 + kstep; const char* b3 = b2 + kstep;
            if constexpr (SP2) {
            PG8_LDB(B0, 0, 0); PG8_LDB(B1, 0, 1); PG8_SCHED; PG8_LDA(At, 0, 0); PG8_STAGE(PG8_SA(1, 1), a1 + hstep, voffA);
            PG8_WAIT_V(8); PG8_WAIT_L(0); PG8_BAR; PG8_MMA(0, 0, At, B0); PG8_MMA(0, 1, At, B1); PG8_BAR; PG8_SCHED;
            PG8_LDA(At, 0, 1); PG8_STAGE(PG8_SB(0, 0), b2, voffB); PG8_STAGE(PG8_SB(0, 1), b2 + hstep, voffB); PG8_STAGE(PG8_SA(0, 0), a2, voffA);
            PG8_WAIT_V(8); PG8_WAIT_L(0); PG8_BAR; PG8_MMA(1, 0, At, B0); PG8_MMA(1, 1, At, B1); PG8_BAR; PG8_SCHED;
            PG8_LDB(B0, 1, 0); PG8_LDB(B1, 1, 1); PG8_SCHED; PG8_LDA(At, 1, 0); PG8_STAGE(PG8_SA(0, 1), a2 + hstep, voffA);
            PG8_WAIT_V(8); PG8_WAIT_L(0); PG8_BAR; PG8_MMA(0, 0, At, B0); PG8_MMA(0, 1, At, B1); PG8_BAR; PG8_SCHED;
            PG8_LDA(At, 1, 1); PG8_STAGE(PG8_SB(1, 0), b3, voffB); PG8_STAGE(PG8_SB(1, 1), b3 + hstep, voffB); PG8_STAGE(PG8_SA(1, 0), a3, voffA);
            PG8_WAIT_V(8); PG8_WAIT_L(0); PG8_BAR; PG8_MMA(1, 0, At, B0); PG8_MMA(1, 1, At, B1); PG8_BAR; PG8_SCHED;
            } else {
            PG8_LDB(B0, 0, 0); PG8_SCHED; PG8_LDA(At, 0, 0); PG8_STAGE(PG8_SA(1, 1), a1 + hstep, voffA);
            PG8_WAIT_L(8); PG8_BAR; PG8_WAIT_L(0); PG8_MMA(0, 0, At, B0); PG8_BAR; PG8_SCHED;
            PG8_LDB(B1, 0, 1); PG8_STAGE(PG8_SB(0, 0), b2, voffB);
            PG8_BAR; PG8_WAIT_L(0); PG8_MMA(0, 1, At, B1); PG8_BAR;
            PG8_LDA(At, 0, 1); PG8_STAGE(PG8_SA(0, 0), a2, voffA);
            PG8_BAR; PG8_WAIT_L(0); PG8_MMA(1, 0, At, B0); PG8_BAR; PG8_SCHED;
            PG8_STAGE(PG8_SB(0, 1), b2 + hstep, voffB);
            PG8_WAIT_V(6); PG8_BAR; PG8_MMA(1, 1, At, B1); PG8_BAR;
            PG8_LDB(B0, 1, 0); PG8_SCHED; PG8_LDA(At, 1, 0); PG8_STAGE(PG8_SA(0, 1), a2 + hstep, voffA);
            PG8_WAIT_L(8); PG8_BAR; PG8_WAIT_L(0); PG8_MMA(0, 0, At, B0); PG8_BAR; PG8_SCHED;
            PG8_LDB(B1, 1, 1); PG8_STAGE(PG8_SB(1, 0), b3, voffB);
            PG8_BAR; PG8_WAIT_L(0); PG8_MMA(0, 1, At, B1); PG8_BAR;
            PG8_LDA(At, 1, 1); PG8_STAGE(PG8_SA(1, 0), a3, voffA);
            PG8_BAR; PG8_WAIT_L(0); PG8_MMA(1, 0, At, B0); PG8_BAR; PG8_SCHED;
            PG8_STAGE(PG8_SB(1, 1), b3 + hstep, voffB);
            PG8_WAIT_V(6); PG8_BAR; PG8_MMA(1, 1, At, B1); PG8_BAR;
            }
        }
        if constexpr (ALIGN_EPI) { if (wr == 0) PG8_BAR; }
        { int fr_ = fr, fq_ = fq; asm volatile("" : "+v"(fr_), "+v"(fq_)); E(acc, cur, wr, wc, fr_, fq_); }
        if (!has_next) break;
#pragma unroll
        for (int a = 0; a < 2; ++a)
#pragma unroll
            for (int b = 0; b < 2; ++b)
#pragma unroll
                for (int m = 0; m < 4; ++m)
#pragma unroll
                    for (int n = 0; n < 2; ++n) acc[a][b][m][n] = (f32x4){0.f, 0.f, 0.f, 0.f};
        cur = nxt; cA = nA; cB = nB; ++ui;
        if constexpr (ALIGN_EPI) { if (wr == 1) PG8_BAR; }
    }
    PG8_WAIT_V(0);
    if constexpr (!ALIGN_EPI) { if (wr == 0) PG8_BAR; }
    PG8_BAR;
#undef PG8_SA
#undef PG8_SB
#undef PG8_STAGE
#undef PG8_LDA
#undef PG8_LDB
#undef PG8_MMA
#undef PG8_WAIT_V
#undef PG8_WAIT_L
#undef PG8_BAR
#undef PG8_SCHED
}
}
using pg8::Unit;
typedef f32x4 AccT[2][2][4][2];

struct EpiQKV {
    static constexpr bool PERM = true;
    unsigned char* ws;
    __device__ __forceinline__ void operator()(const AccT& acc, const Unit& u, int wr, int wc, int fr, int fq) const {
        const int row0 = u.pm * 256 + wr * 64 + fr, kind = u.pn >> 3, colt = (u.pn & 7) * 256 + wc * 32 + 8 * fq;
        if (kind == 0) {
            bf16_t* base = (bf16_t*)(ws + WS_Q);
#pragma unroll
            for (int ai = 0; ai < 2; ++ai)
#pragma unroll
                for (int m = 0; m < 4; ++m) { bf16_t* rowp = base + (size_t)(row0 + ai * 128 + m * 16) * DM + colt;
#pragma unroll
                    for (int bj = 0; bj < 2; ++bj) { const f32x4 v0 = acc[ai][bj][m][0] * QSCALE, v1 = acc[ai][bj][m][1] * QSCALE;
                        u32x4 w; w.x = pk2(v0[0], v0[1]); w.y = pk2(v0[2], v0[3]); w.z = pk2(v1[0], v1[1]); w.w = pk2(v1[2], v1[3]);
                        *(u32x4*)(rowp + bj * 128) = w; } }
        } else if (kind == 1) {
            bf16_t* KF = (bf16_t*)(ws + WS_K);
#pragma unroll
            for (int ai = 0; ai < 2; ++ai)
#pragma unroll
                for (int m = 0; m < 4; ++m) { const int row = row0 + ai * 128 + m * 16, b = row >> 11, st = row & 2047;
#pragma unroll
                    for (int bj = 0; bj < 2; ++bj) { const int c0 = colt + bj * 128, h = c0 >> 7, d0 = c0 & 127;
                        const size_t idx = ((((size_t)(b * NH + h) * 64 + (st >> 5)) * 8 + (d0 >> 4)) * 64 + (st & 31) + 32 * ((d0 >> 3) & 1)) * 8;
                        const f32x4 v0 = acc[ai][bj][m][0], v1 = acc[ai][bj][m][1];
                        u32x4 w; w.x = pk2(v0[0], v0[1]); w.y = pk2(v0[2], v0[3]); w.z = pk2(v1[0], v1[1]); w.w = pk2(v1[2], v1[3]);
                        *(u32x4*)(KF + idx) = w; } }
        } else {
            bf16_t* VF = (bf16_t*)(ws + WS_VT);
#pragma unroll
            for (int ai = 0; ai < 2; ++ai)
#pragma unroll
                for (int m = 0; m < 4; ++m) { const int row = row0 + ai * 128 + m * 16, b = row >> 11, st = row & 2047, k32 = st & 31, kk = k32 & 15;
                    const int slot = 4 * (kk >> 3) + (kk & 3), lhi = 32 * ((kk >> 2) & 1), s2 = k32 >> 4;
#pragma unroll
                    for (int bj = 0; bj < 2; ++bj) { const int c0 = colt + bj * 128, h = c0 >> 7, d0 = c0 & 127;
                        bf16_t* p = VF + (((((size_t)(b * NH + h) * 64 + (st >> 5)) * 4 + (d0 >> 5)) * 2 + s2) * 64 + (d0 & 31) + lhi) * 8 + slot;
#pragma unroll
                        for (int n = 0; n < 2; ++n)
#pragma unroll
                            for (int j = 0; j < 4; ++j) p[(4 * n + j) * 8] = f2bf(acc[ai][bj][m][n][j]); } }
        }
    }
};
struct EpiRes {
    static constexpr bool PERM = true;
    const float* res; float* out; bf16_t* outb; float* part;
    __device__ __forceinline__ void operator()(const AccT& acc, const Unit& u, int wr, int wc, int fr, int fq) const {
        const int row0 = u.pm * 256 + wr * 64 + fr, col0 = u.pn * 256 + wc * 32 + 8 * fq;
        f32x4 rb[2][4];
#define ER_LOAD(buf, g) do { const size_t off_ = (size_t)(row0 + ((g) >> 2) * 128 + ((g) & 3) * 16) * DM + col0; \
            rb[buf][0] = *(const f32x4*)(res + off_); rb[buf][1] = *(const f32x4*)(res + off_ + 4); rb[buf][2] = *(const f32x4*)(res + off_ + 128); rb[buf][3] = *(const f32x4*)(res + off_ + 132); } while (0)
        ER_LOAD(0, 0);
#pragma unroll
        for (int g = 0; g < 8; ++g) {
            const int ai = g >> 2, m = g & 3, cur = g & 1;
            if (g + 1 < 8) ER_LOAD(cur ^ 1, g + 1);
            const int row = row0 + ai * 128 + m * 16; const size_t off = (size_t)row * DM + col0; float ss = 0.f;
#pragma unroll
            for (int bj = 0; bj < 2; ++bj) {
                const f32x4 v0 = acc[ai][bj][m][0] + rb[cur][2 * bj], v1 = acc[ai][bj][m][1] + rb[cur][2 * bj + 1];
                *(f32x4*)(out + off + bj * 128) = v0; *(f32x4*)(out + off + bj * 128 + 4) = v1;
                if (outb) { u32x4 w; w.x = pk2(v0[0], v0[1]); w.y = pk2(v0[2], v0[3]); w.z = pk2(v1[0], v1[1]); w.w = pk2(v1[2], v1[3]); *(u32x4*)(outb + off + bj * 128) = w; }
                ss += (v0[0] * v0[0] + v0[1] * v0[1]) + (v0[2] * v0[2] + v0[3] * v0[3]) + (v1[0] * v1[0] + v1[1] * v1[1]) + (v1[2] * v1[2] + v1[3] * v1[3]); }
            if (part) { ss += __shfl_xor(ss, 16); ss += __shfl_xor(ss, 32); if (fq == 0) part[(size_t)row * 32 + u.pn * 4 + wc] = ss; }
        }
#undef ER_LOAD
    }
};
struct EpiUp {
    static constexpr bool PERM = true;
    bf16_t* U; const float* part;
    __device__ __forceinline__ void operator()(const AccT& acc, const Unit& u, int wr, int wc, int fr, int fq) const {
        const int row0 = u.pm * 256 + wr * 64 + fr, col0 = u.pn * 256 + wc * 32 + 8 * fq;
#pragma unroll
        for (int ai = 0; ai < 2; ++ai)
#pragma unroll
            for (int m = 0; m < 4; ++m) { const int row = row0 + ai * 128 + m * 16; const float rs = row_rstd(part, row, fq); bf16_t* rowp = U + (size_t)row * NUP + col0;
#pragma unroll
                for (int bj = 0; bj < 2; ++bj) { const f32x4 v0 = acc[ai][bj][m][0] * rs, v1 = acc[ai][bj][m][1] * rs;
                    u32x4 w; w.x = pk2(v0[0], v0[1]); w.y = pk2(v0[2], v0[3]); w.z = pk2(v1[0], v1[1]); w.w = pk2(v1[2], v1[3]);
                    *(u32x4*)(rowp + bj * 128) = w; } }
    }
};
__device__ __forceinline__ float dpp_ror1(float v) { return __int_as_float(__builtin_amdgcn_update_dpp(0, __float_as_int(v), 0x121, 0xf, 0xf, false)); }
__device__ __forceinline__ float dpp_ror2(float v) { return __int_as_float(__builtin_amdgcn_update_dpp(0, __float_as_int(v), 0x122, 0xf, 0xf, false)); }
struct EpiUpConv {
    static constexpr bool PERM = true;
    bf16_t* ACT; const float* part; const float* cw; const float* cb; LAS float* hal;
    __device__ __forceinline__ void operator()(AccT& acc, const Unit& u, int wr, int wc, int fr, int fq) const {
        const int grow0 = 254 * u.pm - 2 + wr * 64 + fr;
#pragma unroll
        for (int ai = 0; ai < 2; ++ai)
#pragma unroll
            for (int m = 0; m < 4; ++m) { const int grow = grow0 + ai * 128 + m * 16; const int rowc = grow < 0 ? 0 : (grow >= MTOK ? MTOK - 1 : grow);
                const float rs = row_rstd(part, rowc, fq);
#pragma unroll
                for (int bj = 0; bj < 2; ++bj) { acc[ai][bj][m][0] *= rs; acc[ai][bj][m][1] *= rs; } }
        const int colw = wc * 32 + 8 * fq;
        if (fr >= 14) {
#pragma unroll
            for (int ai = 0; ai < 2; ++ai)
#pragma unroll
                for (int bj = 0; bj < 2; ++bj)
#pragma unroll
                    for (int n = 0; n < 2; ++n) *(LAS f32x4*)(hal + ((ai * 2 + wr) * 2 + (fr - 14)) * 256 + bj * 128 + colw + 4 * n) = acc[ai][bj][3][n];
        }
        asm volatile("s_waitcnt lgkmcnt(0)" ::: "memory"); __builtin_amdgcn_s_barrier(); asm volatile("" ::: "memory");
#pragma unroll
        for (int n = 0; n < 2; ++n) {
            const int ch = u.pn * 128 + colw + 4 * n;
            f32x4 w[2][3], bb[2];
#pragma unroll
            for (int bj = 0; bj < 2; ++bj) { bb[bj] = *(const f32x4*)(cb + bj * FF + ch);
#pragma unroll
                for (int t = 0; t < 3; ++t) w[bj][t] = *(const f32x4*)(cw + (size_t)t * NUP + bj * FF + ch); }
#pragma unroll
            for (int ai = 0; ai < 2; ++ai)
#pragma unroll
                for (int m = 0; m < 4; ++m) {
                    const int lrow = ai * 128 + wr * 64 + m * 16 + fr, grow = 254 * u.pm - 2 + lrow, pos = grow & 2047;
                    f32x4 cv[2];
#pragma unroll
                    for (int bj = 0; bj < 2; ++bj) {
                        const f32x4 cur = acc[ai][bj][m][n];
                        f32x4 q1, q2;
                        if (m > 0) { const f32x4 pv = acc[ai][bj][m - 1][n];
#pragma unroll
                            for (int e = 0; e < 4; ++e) { q1[e] = dpp_ror1(pv[e]); q2[e] = dpp_ror2(pv[e]); } }
                        else { const int slab = ai * 2 + wr - 1; f32x4 h1 = (f32x4){0.f, 0.f, 0.f, 0.f}, h2 = h1;
                            if (slab >= 0) { h1 = *(const LAS f32x4*)(hal + (slab * 2 + 1) * 256 + bj * 128 + colw + 4 * n); h2 = *(const LAS f32x4*)(hal + (slab * 2) * 256 + bj * 128 + colw + 4 * n); }
                            q1 = h1; q2 = (fr == 1) ? h1 : h2; }
                        f32x4 c = bb[bj];
#pragma unroll
                        for (int e = 0; e < 4; ++e) { const float r1 = dpp_ror1(cur[e]), r2 = dpp_ror2(cur[e]);
                            const float p1 = fr >= 1 ? r1 : q1[e], p2 = fr >= 2 ? r2 : q2[e];
                            float v = c[e] + w[bj][2][e] * cur[e];
                            if (pos >= 1) v += w[bj][1][e] * p1;
                            if (pos >= 2) v += w[bj][0][e] * p2;
                            c[e] = v; }
                        cv[bj] = c;
                    }
                    float a4[4];
#pragma unroll
                    for (int e = 0; e < 4; ++e) { const float gx = cv[0][e]; a4[e] = gx * __builtin_amdgcn_rcpf(1.0f + __expf(-gx)) * cv[1][e]; }
                    if (lrow >= 2 && grow < MTOK) { u32x2 o; o.x = pk2(a4[0], a4[1]); o.y = pk2(a4[2], a4[3]); *(u32x2*)(ACT + (size_t)grow * FF + ch) = o; }
                }
        }
    }
};
struct EpiDsaIn {
    static constexpr bool PERM = false;
    unsigned char* ws; LAS float* scr;
    __device__ __forceinline__ void operator()(const AccT& acc_in, const Unit& u, int wr, int wc, int fr, int fq) const {
        const int row0 = u.pm * 256 + wr * 64 + fr;
        const float* part = (const float*)(ws + WS_PART); const float* ropeC = (const float*)(ws + WS_ROPE); const float* ropeS = ropeC + SEQ * 64;
        bf16_t* VTD = (bf16_t*)(ws + WS_VTD); float* WI = (float*)(ws + WS_WI);
        const bool need_norm = (u.pn < 10) || (u.pn == 20);
        float rs[2][4];
#pragma unroll
        for (int ai = 0; ai < 2; ++ai)
#pragma unroll
            for (int m = 0; m < 4; ++m) rs[ai][m] = row_rstd(part, row0 + ai * 128 + m * 16, fq);
        if (need_norm) {
#pragma unroll
            for (int ai = 0; ai < 2; ++ai)
#pragma unroll
                for (int m = 0; m < 4; ++m)
#pragma unroll
                    for (int bj = 0; bj < 2; ++bj) { const f32x4 a = acc_in[ai][bj][m][0], b = acc_in[ai][bj][m][1];
                        float ss = ((a[0] * a[0] + a[1] * a[1]) + (a[2] * a[2] + a[3] * a[3])) + ((b[0] * b[0] + b[1] * b[1]) + (b[2] * b[2] + b[3] * b[3]));
                        ss += __shfl_xor(ss, 16); ss += __shfl_xor(ss, 32);
                        if (fq == 0) scr[(ai * 128 + wr * 64 + m * 16 + fr) * 8 + bj * 4 + wc] = ss * rs[ai][m] * rs[ai][m]; }
            asm volatile("s_waitcnt lgkmcnt(0)" ::: "memory"); __builtin_amdgcn_s_barrier(); asm volatile("" ::: "memory");
        }
        const int dl = 16 * wc + 4 * fq;
#pragma unroll
        for (int bj = 0; bj < 2; ++bj) {
            const int hh = 2 * u.pn + bj;
            if (hh >= 20 && hh < 24) {
#pragma unroll
                for (int ai = 0; ai < 2; ++ai)
#pragma unroll
                    for (int m = 0; m < 4; ++m) { const int row = row0 + ai * 128 + m * 16, b = row >> 11, s = row & 2047; const float r = rs[ai][m];
                        bf16_t* p = VTD + ((size_t)(b * KVH + (hh - 20)) * HD + dl) * SEQ + s;
#pragma unroll
                        for (int n = 0; n < 2; ++n)
#pragma unroll
                            for (int e = 0; e < 4; ++e) p[(size_t)(64 * n + e) * SEQ] = f2bf(acc_in[ai][bj][m][n][e] * r); }
            } else if (hh == 41) {
                if (wc == 0) {
#pragma unroll
                    for (int ai = 0; ai < 2; ++ai)
#pragma unroll
                        for (int m = 0; m < 4; ++m) { const int row = row0 + ai * 128 + m * 16; *(f32x4*)(WI + (size_t)row * 16 + 4 * fq) = acc_in[ai][bj][m][0] * rs[ai][m]; } }
            } else {
                const bool norm = (hh < 20) || (hh == 40);
                const float* g = (const float*)(ws + WS_GAIN) + (hh < 16 ? 0 : (hh < 20 ? 128 : 256));
                f32x4 g0 = (f32x4){1.f, 1.f, 1.f, 1.f}, g1 = g0;
                if (norm) { g0 = *(const f32x4*)(g + dl); g1 = *(const f32x4*)(g + dl + 64); }
                size_t boff; int ld, cb;
                if (hh < 16) { boff = WS_Q; ld = DM; cb = hh * HD; } else if (hh < 20) { boff = WS_KD; ld = KVH * HD; cb = (hh - 16) * HD; }
                else if (hh < 40) { boff = WS_QI; ld = DM; cb = (hh - 24) * HD; } else { boff = WS_KI; ld = HD; cb = 0; }
                bf16_t* base = (bf16_t*)(ws + boff);
                const float osc = hh < 16 ? QSCALE : 1.0f;
#pragma unroll
                for (int ai = 0; ai < 2; ++ai)
#pragma unroll
                    for (int m = 0; m < 4; ++m) { const int lrow = ai * 128 + wr * 64 + m * 16 + fr, row = u.pm * 256 + lrow, pos = row & 2047;
                        float sc = rs[ai][m];
                        if (norm) { const f32x4 t = *(const LAS f32x4*)(scr + lrow * 8 + bj * 4); sc *= 1.0f / sqrtf(((t[0] + t[1]) + (t[2] + t[3])) * (1.0f / HD) + NORM_EPS); }
                        sc *= osc;
                        const f32x4 c = *(const f32x4*)(ropeC + pos * 64 + dl), sn = *(const f32x4*)(ropeS + pos * 64 + dl);
                        const f32x4 y0 = acc_in[ai][bj][m][0] * g0 * sc, y1 = acc_in[ai][bj][m][1] * g1 * sc;
                        const f32x4 o0 = y0 * c - y1 * sn, o1 = y1 * c + y0 * sn;
                        bf16_t* rp = base + (size_t)row * ld + cb + dl;
                        u32x2 w0, w1; w0.x = pk2(o0[0], o0[1]); w0.y = pk2(o0[2], o0[3]); w1.x = pk2(o1[0], o1[1]); w1.y = pk2(o1[2], o1[3]);
                        *(u32x2*)rp = w0; *(u32x2*)(rp + 64) = w1; }
            }
        }
    }
};

enum { WM_PLAIN = 0, WM_UP = 1, WM_IN = 2 };
__device__ __forceinline__ int colmap(int kind, int np) {
    if (kind == WM_UP) { const int pn = np >> 8, bj = (np >> 7) & 1, q = np & 127; return bj * FF + 128 * pn + q; }
    if (kind == WM_IN) { const int hh = np >> 7, p = np & 127, d = 16 * (p >> 5) + (p & 15) + 64 * ((p >> 4) & 1);
        if (hh < 41) return hh * 128 + d; return (p < 16) ? (5248 + p) : -1; }
    return np;
}
struct WJ { const float* W; const float* gain; bf16_t* WT; int K, N, NP, kind, local; };
__device__ __forceinline__ void tr_load(const WJ& j, int lane, f32x4 (&v)[16]) {
    const int nblk = j.NP / 64, kb = j.local / nblk, nb = j.local - kb * nblk, k0 = 64 * kb, n0 = 64 * nb;
    const int src = colmap(j.kind, n0 + 4 * (lane & 15)), rg = lane >> 4;
    const float* p = j.W + (size_t)(k0 + rg) * j.N + (src >= 0 ? src : 0);
#pragma unroll
    for (int i = 0; i < 16; ++i) { v[i] = *(const f32x4*)(p + (size_t)(4 * i) * j.N); if (src < 0) v[i] = (f32x4){0.f, 0.f, 0.f, 0.f}; }
}
__device__ __forceinline__ void tr_process(const WJ& j, int lane, const f32x4 (&v)[16], LAS float* scr) {
    const int nblk = j.NP / 64, kb = j.local / nblk, nb = j.local - kb * nblk, k0 = 64 * kb, n0 = 64 * nb;
    const int rg = lane >> 4, cg = lane & 15;
    float gl = 1.0f; if (j.gain) gl = j.gain[k0 + lane];
#pragma unroll
    for (int i = 0; i < 16; ++i) { const int kk = 4 * i + rg; const float g = __shfl(gl, kk); LAS float* d = scr + kk * 65 + 4 * cg;
        d[0] = v[i][0] * g; d[1] = v[i][1] * g; d[2] = v[i][2] * g; d[3] = v[i][3] * g; }
    asm volatile("s_waitcnt lgkmcnt(0)" ::: "memory");
    const int c = lane & 7;
#pragma unroll
    for (int jj = 0; jj < 8; ++jj) { const int n = (lane >> 3) + 8 * jj; const LAS float* s = scr + (8 * c) * 65 + n;
        u32x4 o; o.x = pk2(s[0 * 65], s[1 * 65]); o.y = pk2(s[2 * 65], s[3 * 65]); o.z = pk2(s[4 * 65], s[5 * 65]); o.w = pk2(s[6 * 65], s[7 * 65]);
        *(u32x4*)(j.WT + (size_t)(n0 + n) * j.K + k0 + 8 * c) = o; }
    asm volatile("s_waitcnt lgkmcnt(0)" ::: "memory");
}

struct Args {
    const float* x; const float* attn_g; const float* ffn_g; const float* w_qkv; const float* w_o0; const float* w_in;
    const float* qn_g; const float* kn_g; const float* ikn_g; const float* w_o1; const float* w_up; const float* conv_w; const float* conv_b; const float* w_down;
    float* out; unsigned char* ws; int ph_lo, ph_hi;
};

constexpr int WI0 = 32 * 96, WI1 = WI0 + 32 * 32, WI2 = WI1 + 32 * 84, WI3 = WI2 + 32 * 32, WI4 = WI3 + 32 * 176, WI5 = WI4 + 32 * 176, WI6 = WI5 + 88 * 32, WI7 = WI6 + 88 * 32;
__device__ __forceinline__ WJ wj_decode(const Args& a, int it) {
    unsigned char* ws = a.ws; WJ j;
    if (it < WI0)      j = WJ{a.w_qkv, nullptr, (bf16_t*)(ws + WS_WQKV), DM, NQKV, NQKV, WM_PLAIN, it};
    else if (it < WI1) j = WJ{a.w_o0, nullptr, (bf16_t*)(ws + WS_WO0), DM, DM, DM, WM_PLAIN, it - WI0};
    else if (it < WI2) j = WJ{a.w_in, a.attn_g + DM, (bf16_t*)(ws + WS_WIN), DM, NIN, NINP, WM_IN, it - WI1};
    else if (it < WI3) j = WJ{a.w_o1, nullptr, (bf16_t*)(ws + WS_WO1), DM, DM, DM, WM_PLAIN, it - WI2};
    else if (it < WI4) j = WJ{a.w_up, a.ffn_g, (bf16_t*)(ws + WS_WUP), DM, NUP, NUP, WM_UP, it - WI3};
    else if (it < WI5) j = WJ{a.w_up + (size_t)DM * NUP, a.ffn_g + DM, (bf16_t*)(ws + WS_WUP + 44 * MiB), DM, NUP, NUP, WM_UP, it - WI4};
    else if (it < WI6) j = WJ{a.w_down, nullptr, (bf16_t*)(ws + WS_WDN), FF, DM, DM, WM_PLAIN, it - WI5};
    else               j = WJ{a.w_down + (size_t)FF * DM, nullptr, (bf16_t*)(ws + WS_WDN + 22 * MiB), FF, DM, DM, WM_PLAIN, it - WI6};
    return j;
}
__device__ __forceinline__ void convert_items(const Args& a, LAS float* scr, int lo, int hi, int vw, int nvw, int lane) {
    int it = lo + vw;
    if (it >= hi) return;
    f32x4 va[16], vb[16];
    WJ ja = wj_decode(a, it), jb = ja;
    tr_load(ja, lane, va);
    for (;;) {
        int nx = it + nvw; bool hn = nx < hi;
        if (hn) { jb = wj_decode(a, nx); tr_load(jb, lane, vb); }
        tr_process(ja, lane, va, scr);
        if (!hn) break;
        it = nx; nx = it + nvw; hn = nx < hi;
        if (hn) { ja = wj_decode(a, nx); tr_load(ja, lane, va); }
        tr_process(jb, lane, vb, scr);
        if (!hn) break;
        it = nx;
    }
}
struct Offload { int g_up, g_in; bool up0, in1, up1; };
__device__ __forceinline__ Offload make_offload(int G) {
    Offload o; const int u_up = 33 * (NUP / 256), u_in = (MTOK / 256) * (NINP / 256);
    const int r_up = (u_up + G - 1) / G, r_in = (u_in + G - 1) / G;
    o.g_up = (u_up + r_up - 1) / r_up; o.g_in = (u_in + r_in - 1) / r_in;
    o.up0 = (G - o.g_up) >= 8; o.up1 = o.up0; o.in1 = (G - o.g_in) >= 16;
    return o;
}
__device__ __forceinline__ void prologue_phase(const Args& a, LAS unsigned char* lds, int gw, int ngw, int wave, int lane, const Offload& offl) {
    unsigned char* ws = a.ws;
    LAS float* scr = (LAS float*)(lds + wave * 16640);
    convert_items(a, scr, 0, WI1, gw, ngw, lane);
    convert_items(a, scr, WI3, WI4, gw, ngw, lane);
    if (!offl.up0) { convert_items(a, scr, WI5, WI6, gw, ngw, lane); convert_items(a, scr, WI1, WI2, gw, ngw, lane); }
    if (!offl.in1) { convert_items(a, scr, WI2, WI3, gw, ngw, lane); convert_items(a, scr, WI4, WI5, gw, ngw, lane); }
    if (!offl.up1) { convert_items(a, scr, WI6, WI7, gw, ngw, lane); }
    bf16_t* XB = (bf16_t*)(ws + WS_XB);
    for (int m = gw; m < MTOK; m += ngw) {
        const f32x4* xr = (const f32x4*)(a.x + (size_t)m * DM) + lane;
        f32x4 v[8]; float s = 0.f;
#pragma unroll
        for (int j = 0; j < 8; ++j) { v[j] = xr[64 * j]; s += (v[j].x * v[j].x + v[j].y * v[j].y) + (v[j].z * v[j].z + v[j].w * v[j].w); }
        const float rstd = 1.0f / sqrtf(wave_sum(s) * (1.0f / DM) + NORM_EPS);
        u32x2* o8 = (u32x2*)(XB + (size_t)m * DM) + lane;
#pragma unroll
        for (int j = 0; j < 8; ++j) { const f32x4 g = ((const f32x4*)a.attn_g)[lane + 64 * j]; u32x2 w; w.x = pk2(v[j].x * rstd * g.x, v[j].y * rstd * g.y); w.y = pk2(v[j].z * rstd * g.z, v[j].w * rstd * g.w); o8[64 * j] = w; }
    }
    if (gw == 0) { float* gn = (float*)(ws + WS_GAIN); for (int i = lane; i < 128; i += 64) { gn[i] = a.qn_g[i]; gn[128 + i] = a.kn_g[i]; gn[256 + i] = a.ikn_g[i]; } }
    float* rc = (float*)(ws + WS_ROPE); float* rsn = rc + SEQ * 64;
    for (int i = gw * 64 + lane; i < SEQ * 64; i += ngw * 64) {
        const int pos = i >> 6, fi = i & 63;
        const float inv_freq = (float)(1.0 / exp2((double)fi * (2.0 / 128.0) * 13.287712379549449));
        const float ang = (float)pos * inv_freq;
        const double x = (double)ang; const double kq = rint(x * 0.63661977236758134308);
        double r = __builtin_fma(-kq, 1.57079632679489655800e+00, x); r = __builtin_fma(-kq, 6.12323399573676603587e-17, r);
        const double r2 = r * r;
        double sp = -1.0 / 6227020800.0; sp = sp * r2 + 1.0 / 39916800.0; sp = sp * r2 - 1.0 / 362880.0; sp = sp * r2 + 1.0 / 5040.0; sp = sp * r2 - 1.0 / 120.0; sp = sp * r2 + 1.0 / 6.0; const double sv = r - r * r2 * sp;
        double cp = 1.0 / 87178291200.0; cp = cp * r2 - 1.0 / 479001600.0; cp = cp * r2 + 1.0 / 3628800.0; cp = cp * r2 - 1.0 / 40320.0; cp = cp * r2 + 1.0 / 720.0; cp = cp * r2 - 1.0 / 24.0; cp = cp * r2 + 0.5; const double cv = 1.0 - r2 * cp;
        const int q = ((int)kq) & 3;
        const double cs = (q == 0) ? cv : (q == 1) ? -sv : (q == 2) ? -cv : sv;
        const double sn = (q == 0) ? sv : (q == 1) ? cv : (q == 2) ? -sv : -cv;
        rc[i] = (float)cs; rsn[i] = (float)sn;
    }
}

constexpr float SB_EXIT = 220.0f;
__device__ __forceinline__ void sb_attn_phase(const bf16_t* __restrict__ Q, const bf16_t* __restrict__ K, const bf16_t* __restrict__ Vt, bf16_t* __restrict__ O, int gw, int ngw, int lane) {
    const int r = lane & 31, hh = lane >> 5;
    bf16x8 uf[2];
#pragma unroll
    for (int s2 = 0; s2 < 2; ++s2) { u32x4 w;
        unsigned e[8];
#pragma unroll
        for (int j = 0; j < 8; ++j) { const int key = 16 * s2 + 8 * (j >> 2) + 4 * hh + (j & 3); e[j] = (key >= r) ? 0x3f80u : 0u; }
        w.x = e[0] | (e[1] << 16); w.y = e[2] | (e[3] << 16); w.z = e[4] | (e[5] << 16); w.w = e[6] | (e[7] << 16); uf[s2] = __builtin_bit_cast(bf16x8, w); }
    for (int unit = gw; unit < BATCH * NH * 64; unit += ngw) {
        const int bh = unit >> 6, qt = 63 - (unit & 63), b = bh >> 4, h = bh & 15, q0 = qt * 32;
        const bf16_t* qp = Q + (size_t)(b * SEQ + q0 + r) * DM + h * HD + 8 * hh;
        bf16x8 qf[8];
#pragma unroll
        for (int s = 0; s < 8; ++s) qf[s] = *(const bf16x8*)(qp + 16 * s);
        f32x16 o[4];
#pragma unroll
        for (int d = 0; d < 4; ++d) o[d] = f32x16{};
        float carry = 0.f;
        const bf16_t* kbase = K + (size_t)(b * SEQ + r) * DM + h * HD + 8 * hh;
        const bf16_t* vbase = Vt + ((size_t)bh * HD + r) * SEQ + 4 * hh;
        for (int kt = qt; kt >= 0; --kt) {
            const int key0 = kt * 32;
            const bf16_t* kp = kbase + (size_t)key0 * DM;
            bf16x8 kf[8];
#pragma unroll
            for (int s = 0; s < 8; ++s) kf[s] = *(const bf16x8*)(kp + 16 * s);
            bf16x8 vf[4][2];
#pragma unroll
            for (int d = 0; d < 4; ++d)
#pragma unroll
                for (int s2 = 0; s2 < 2; ++s2) { const bf16_t* vp = vbase + (size_t)(32 * d) * SEQ + key0 + 16 * s2;
                    const s16x4 lo = *(const s16x4*)vp, hi = *(const s16x4*)(vp + 8);
                    vf[d][s2] = (bf16x8){lo[0], lo[1], lo[2], lo[3], hi[0], hi[1], hi[2], hi[3]}; }
            f32x16 p = f32x16{};
#pragma unroll
            for (int s = 0; s < 8; ++s) p = __builtin_amdgcn_mfma_f32_32x32x16_bf16(kf[s], qf[s], p, 0, 0, 0);
            const bool diag = (kt == qt);
            f32x16 sp;
#pragma unroll
            for (int i = 0; i < 16; ++i) { const float z = p[i]; float v = fmaxf(z, 0.f) + __builtin_amdgcn_logf(1.0f + __builtin_amdgcn_exp2f(-fabsf(z)));
                if (diag && crow(i, hh) >= r) v = 0.f; sp[i] = v; }
            f32x16 c;
#pragma unroll
            for (int i = 0; i < 16; ++i) c[i] = carry;
            c = __builtin_amdgcn_mfma_f32_32x32x16_bf16(uf[0], pack8(sp, 0), c, 0, 0, 0);
            c = __builtin_amdgcn_mfma_f32_32x32x16_bf16(uf[1], pack8(sp, 8), c, 0, 0, 0);
            f32x16 av;
#pragma unroll
            for (int i = 0; i < 16; ++i) { float v = __builtin_amdgcn_exp2f(p[i] - c[i]); if (diag && crow(i, hh) >= r) v = 0.f; av[i] = v; }
            carry = swap_max(c[0]);
            const bf16x8 pa0 = pack8(av, 0), pa1 = pack8(av, 8);
#pragma unroll
            for (int d = 0; d < 4; ++d) { o[d] = __builtin_amdgcn_mfma_f32_32x32x16_bf16(vf[d][0], pa0, o[d], 0, 0, 0); o[d] = __builtin_amdgcn_mfma_f32_32x32x16_bf16(vf[d][1], pa1, o[d], 0, 0, 0); }
            if (__all(carry > SB_EXIT)) break;
        }
        bf16_t* op = O + (size_t)(b * SEQ + q0 + r) * DM + h * HD + 4 * hh;
#pragma unroll
        for (int d = 0; d < 4; ++d)
#pragma unroll
            for (int g = 0; g < 4; ++g) { u32x2 w; w.x = pk2(o[d][4 * g], o[d][4 * g + 1]); w.y = pk2(o[d][4 * g + 2], o[d][4 * g + 3]); *(u32x2*)(op + 32 * d + 8 * g) = w; }
    }
}

__device__ __forceinline__ void conv_phase(const bf16_t* __restrict__ U, const float* __restrict__ cw, const float* __restrict__ cb, bf16_t* __restrict__ ACT, int gtid, int nthreads) {
    constexpr int C8 = FF / 8;
    for (int it = gtid; it < MTOK * C8; it += nthreads) {
        const int row = it / C8, c8 = it - row * C8, j0 = c8 * 8, pn = j0 >> 7, q = j0 & 127, s = row & 2047;
        const bf16_t* ug = U + (size_t)row * NUP + 256 * pn + q;
        float cgv[2][8];
#pragma unroll
        for (int half = 0; half < 2; ++half) {
            const bf16_t* up = ug + half * 128; const int cc = half * FF + j0;
            const f32x4 b0 = *(const f32x4*)(cb + cc), b1 = *(const f32x4*)(cb + cc + 4);
            float accv[8] = {b0[0], b0[1], b0[2], b0[3], b1[0], b1[1], b1[2], b1[3]};
#pragma unroll
            for (int tap = 0; tap < 3; ++tap) { const int back = 2 - tap;
                if (s >= back) { const u32x4 w = *(const u32x4*)(up - (size_t)back * NUP);
                    const f32x4 w0 = *(const f32x4*)(cw + (size_t)tap * NUP + cc), w1 = *(const f32x4*)(cw + (size_t)tap * NUP + cc + 4);
                    accv[0] += __uint_as_float(w.x << 16) * w0[0]; accv[1] += __uint_as_float(w.x & 0xffff0000u) * w0[1];
                    accv[2] += __uint_as_float(w.y << 16) * w0[2]; accv[3] += __uint_as_float(w.y & 0xffff0000u) * w0[3];
                    accv[4] += __uint_as_float(w.z << 16) * w1[0]; accv[5] += __uint_as_float(w.z & 0xffff0000u) * w1[1];
                    accv[6] += __uint_as_float(w.w << 16) * w1[2]; accv[7] += __uint_as_float(w.w & 0xffff0000u) * w1[3]; } }
#pragma unroll
            for (int e = 0; e < 8; ++e) cgv[half][e] = accv[e];
        }
        float a8[8];
#pragma unroll
        for (int e = 0; e < 8; ++e) { const float gx = cgv[0][e]; a8[e] = gx / (1.0f + __expf(-gx)) * cgv[1][e]; }
        u32x4 w; w.x = pk2(a8[0], a8[1]); w.y = pk2(a8[2], a8[3]); w.z = pk2(a8[4], a8[5]); w.w = pk2(a8[6], a8[7]);
        *(u32x4*)(ACT + (size_t)row * FF + j0) = w;
    }
}

__device__ __forceinline__ unsigned fmap(float f) { const unsigned u = __float_as_uint(f); return (u & 0x80000000u) ? ~u : (u | 0x80000000u); }
__device__ __forceinline__ void indexer_unit(const bf16_t* __restrict__ QI, const bf16_t* __restrict__ KI, const float* __restrict__ WI, unsigned* __restrict__ MASK, LAS float* sc, int b, int t0, int wave, int lane) {
    const int r = lane & 31, hh = lane >> 5, ql_r = r >> 4, head_r = r & 15;
    const int tw = t0 + 2 * wave;
    const bf16_t* ap = QI + (size_t)(b * SEQ + tw + ql_r) * DM + head_r * HD + 8 * hh;
    bf16x8 af[8];
#pragma unroll
    for (int s = 0; s < 8; ++s) af[s] = *(const bf16x8*)(ap + 16 * s);
    float wv[16];
#pragma unroll
    for (int i = 0; i < 16; ++i) { const int rw = crow(i, hh); wv[i] = WI[(size_t)(b * SEQ + tw + (rw >> 4)) * 16 + (rw & 15)]; }
    const int nkt = (t0 + 16 + 31) >> 5;
    const bf16_t* kb = KI + (size_t)(b * SEQ + r) * HD + 8 * hh;
    LAS float* myrow = sc + (2 * wave + hh) * SEQ;
    const int tq = tw + hh;
    for (int kt = 0; kt < nkt; ++kt) {
        const bf16_t* kp = kb + (size_t)kt * 32 * HD;
        bf16x8 bfr[8];
#pragma unroll
        for (int s = 0; s < 8; ++s) bfr[s] = *(const bf16x8*)(kp + 16 * s);
        f32x16 c = f32x16{};
#pragma unroll
        for (int s = 0; s < 8; ++s) c = __builtin_amdgcn_mfma_f32_32x32x16_bf16(af[s], bfr[s], c, 0, 0, 0);
        float s0 = 0.f, s1 = 0.f;
#pragma unroll
        for (int i = 0; i < 8; ++i) { s0 += wv[i] * relu_i(c[i]); s1 += wv[i + 8] * relu_i(c[i + 8]); }
        const float t0s = swap_sum(s0), t1s = swap_sum(s1);
        const int key = kt * 32 + r;
        float v = (hh ? t1s : t0s) + 0.0f;
        if (key > tq) v = -INFINITY;
        myrow[key] = v;
    }
    asm volatile("s_waitcnt lgkmcnt(0)" ::: "memory");
    for (int ql = 0; ql < 2; ++ql) {
        const int t = tw + ql, n = t + 1;
        unsigned* mrow = MASK + (size_t)(b * SEQ + t) * 64;
        if (n <= TOPK) {
            const int key0 = 32 * lane; unsigned w;
            if (key0 + 31 <= t) w = 0xffffffffu; else if (key0 > t) w = 0u; else w = (1u << (t - key0 + 1)) - 1u;
            mrow[lane] = w;
        } else {
            const LAS float* row = sc + (2 * wave + ql) * SEQ;
            unsigned uv[32];
#pragma unroll
            for (int e = 0; e < 32; ++e) { const int key = e * 64 + lane; uv[e] = (key < n) ? fmap(row[key]) : 0x007fffffu; }
            unsigned prefix = 0u;
            for (int bit = 31; bit >= 0; --bit) {
                const unsigned cand = prefix | (1u << bit); int cnt = 0;
#pragma unroll
                for (int e = 0; e < 32; ++e) cnt += __popcll(__ballot(uv[e] >= cand));
                if (cnt >= TOPK) prefix = cand;
            }
            int cgt = 0;
#pragma unroll
            for (int e = 0; e < 32; ++e) cgt += __popcll(__ballot(uv[e] > prefix));
            const int need = TOPK - cgt; int running = 0;
            const unsigned long long ltm = (1ull << lane) - 1ull;
            unsigned long long keep = 0ull;
#pragma unroll
            for (int e = 0; e < 32; ++e) {
                const unsigned long long eq = __ballot(uv[e] == prefix);
                const bool sel = (uv[e] > prefix) || (uv[e] == prefix && (running + __popcll(eq & ltm)) < need);
                const unsigned long long m64 = __ballot(sel);
                running += __popcll(eq);
                if (lane == e) keep = m64;
            }
            if (lane < 32) *(unsigned long long*)(mrow + 2 * lane) = keep;
        }
    }
    asm volatile("s_waitcnt lgkmcnt(0)" ::: "memory");
}

__device__ __forceinline__ void dsa_attn_unit(const bf16_t* __restrict__ QD, const bf16_t* __restrict__ KD, const bf16_t* __restrict__ VTD, const unsigned* __restrict__ MASK, bf16_t* __restrict__ O,
                                              int b, int g, int h, int q0, int lane) {
    const int r = lane & 31, hh = lane >> 5;
    const bf16_t* qp = QD + (size_t)(b * SEQ + q0 + r) * DM + h * HD + 8 * hh;
    bf16x8 qf[8];
#pragma unroll
    for (int s = 0; s < 8; ++s) qf[s] = *(const bf16x8*)(qp + 16 * s);
    f32x16 o[4];
#pragma unroll
    for (int d = 0; d < 4; ++d) o[d] = f32x16{};
    float mrun = -1e30f, lrun = 0.f;
    const bf16_t* kbase = KD + (size_t)(b * SEQ + r) * (KVH * HD) + g * HD + 8 * hh;
    const bf16_t* vbase = VTD + ((size_t)(b * KVH + g) * HD + r) * SEQ + 4 * hh;
    const unsigned* mrow = MASK + (size_t)(b * SEQ + q0 + r) * 64;
    const int nkt = (q0 + 32) >> 5;
    for (int kt = 0; kt < nkt; ++kt) {
        const int key0 = kt * 32;
        const bf16_t* kp = kbase + (size_t)key0 * (KVH * HD);
        bf16x8 kf[8];
#pragma unroll
        for (int s = 0; s < 8; ++s) kf[s] = *(const bf16x8*)(kp + 16 * s);
        const unsigned mw = mrow[kt];
        bf16x8 vf[4][2];
#pragma unroll
        for (int d = 0; d < 4; ++d)
#pragma unroll
            for (int s2 = 0; s2 < 2; ++s2) { const bf16_t* vp = vbase + (size_t)(32 * d) * SEQ + key0 + 16 * s2;
                const s16x4 lo = *(const s16x4*)vp, hi = *(const s16x4*)(vp + 8);
                vf[d][s2] = (bf16x8){lo[0], lo[1], lo[2], lo[3], hi[0], hi[1], hi[2], hi[3]}; }
        f32x16 p = f32x16{};
#pragma unroll
        for (int s = 0; s < 8; ++s) p = __builtin_amdgcn_mfma_f32_32x32x16_bf16(kf[s], qf[s], p, 0, 0, 0);
        float tmax = -1e30f;
#pragma unroll
        for (int i = 0; i < 16; ++i) { const bool valid = (mw >> crow(i, hh)) & 1u; tmax = fmaxf(tmax, valid ? p[i] : -1e30f); }
        tmax = swap_max(tmax);
        const float mnew = fmaxf(mrun, tmax), alpha = __builtin_amdgcn_exp2f(mrun - mnew);
        float ls = 0.f; f32x16 pe;
#pragma unroll
        for (int i = 0; i < 16; ++i) { const bool valid = (mw >> crow(i, hh)) & 1u; const float e = valid ? __builtin_amdgcn_exp2f(p[i] - mnew) : 0.f; pe[i] = e; ls += e; }
        lrun = lrun * alpha + ls; mrun = mnew;
#pragma unroll
        for (int d = 0; d < 4; ++d)
#pragma unroll
            for (int i = 0; i < 16; ++i) o[d][i] *= alpha;
        const bf16x8 pa0 = pack8(pe, 0), pa1 = pack8(pe, 8);
#pragma unroll
        for (int d = 0; d < 4; ++d) { o[d] = __builtin_amdgcn_mfma_f32_32x32x16_bf16(vf[d][0], pa0, o[d], 0, 0, 0); o[d] = __builtin_amdgcn_mfma_f32_32x32x16_bf16(vf[d][1], pa1, o[d], 0, 0, 0); }
    }
    const float linv = 1.0f / swap_sum(lrun);
    bf16_t* op = O + (size_t)(b * SEQ + q0 + r) * DM + h * HD + 4 * hh;
#pragma unroll
    for (int d = 0; d < 4; ++d)
#pragma unroll
        for (int gq = 0; gq < 4; ++gq) { u32x2 w; w.x = pk2(o[d][4 * gq] * linv, o[d][4 * gq + 1] * linv); w.y = pk2(o[d][4 * gq + 2] * linv, o[d][4 * gq + 3] * linv); *(u32x2*)(op + 32 * d + 8 * gq) = w; }
}


constexpr int KSTR = 272, VSTR = 136, KTILE_B = 64 * KSTR, VTILE_B = 128 * VSTR, KVBUF_B = KTILE_B + VTILE_B;
struct KVStage {
    u32x4 k[2], v[2];
    __device__ __forceinline__ void load(const unsigned char* kg, size_t kstride, const unsigned char* vg, size_t vstride, int tid) {
#pragma unroll
        for (int i = 0; i < 2; ++i) { const int c = tid + 512 * i; k[i] = *(const u32x4*)(kg + (size_t)(c >> 4) * kstride + (c & 15) * 16); v[i] = *(const u32x4*)(vg + (size_t)(c >> 3) * vstride + (c & 7) * 16); }
    }
    __device__ __forceinline__ void store(LAS unsigned char* buf, int tid) const {
#pragma unroll
        for (int i = 0; i < 2; ++i) { const int c = tid + 512 * i;
            *(LAS u32x4*)(buf + (c >> 4) * KSTR + (c & 15) * 16) = k[i];
            LAS unsigned char* vp = buf + KTILE_B + (c >> 3) * VSTR + (c & 7) * 16;
            *(LAS u32x2*)vp = (u32x2){v[i].x, v[i].y}; *(LAS u32x2*)(vp + 8) = (u32x2){v[i].z, v[i].w}; }
    }
};

__device__ __forceinline__ void dsa_attn_block(const bf16_t* __restrict__ QD, const bf16_t* __restrict__ KD, const bf16_t* __restrict__ VTD, const unsigned* __restrict__ MASK, bf16_t* __restrict__ O,
                                               LAS unsigned char* lds, int b, int g, int qb64, int wave, int lane, int tid) {
    const int r = lane & 31, hh = lane >> 5, h = 4 * g + (wave & 3), q0 = 64 * qb64 + 32 * (wave >> 2);
    LAS unsigned char* qlds = lds + 2 * KVBUF_B + wave * (32 * KSTR);
    { const unsigned char* qg = (const unsigned char*)(QD + (size_t)(b * SEQ + q0) * DM + h * HD);
        u32x4 t[8];
#pragma unroll
        for (int i = 0; i < 8; ++i) { const int c = lane + 64 * i; t[i] = *(const u32x4*)(qg + (size_t)(c >> 4) * (DM * 2) + (c & 15) * 16); }
#pragma unroll
        for (int i = 0; i < 8; ++i) { const int c = lane + 64 * i; *(LAS u32x4*)(qlds + (c >> 4) * KSTR + (c & 15) * 16) = t[i]; }
        asm volatile("s_waitcnt lgkmcnt(0)" ::: "memory"); }
    const LAS unsigned char* qfp = qlds + r * KSTR + 16 * hh;
    f32x16 o[4];
#pragma unroll
    for (int d = 0; d < 4; ++d) o[d] = f32x16{};
    float mrun = -1e29f, lrun = 0.f;
    const unsigned char* kg = (const unsigned char*)(KD + (size_t)(b * SEQ) * (KVH * HD) + g * HD);
    const unsigned char* vg = (const unsigned char*)(VTD + (size_t)(b * KVH + g) * HD * SEQ);
    const unsigned long long* mrow = (const unsigned long long*)(MASK + (size_t)(b * SEQ + q0 + r) * 64);
    KVStage sA, sB;
#define MA_LOAD(ST, t) ST.load(kg + (size_t)(t) * 64 * (KVH * HD * 2), KVH * HD * 2, vg + (size_t)(t) * 64 * 2, SEQ * 2, tid)
    MA_LOAD(sA, 0);
    sA.store(lds, tid);
    asm volatile("s_waitcnt lgkmcnt(0)" ::: "memory"); __builtin_amdgcn_s_barrier(); asm volatile("" ::: "memory");
    if (qb64 >= 1) MA_LOAD(sA, 1);
    if (qb64 >= 2) MA_LOAD(sB, 2);
    unsigned long long mw_next = mrow[0];
    for (int kt = 0; kt <= qb64; ++kt) {
        LAS unsigned char* buf = lds + (kt & 1) * KVBUF_B;
        const unsigned long long mw = mw_next;
        if (kt < qb64) mw_next = mrow[kt + 1];
        const bool two = (64 * kt + 32) <= q0 + 31;
        f32x16 p0 = f32x16{}, p1 = f32x16{};
        { const LAS unsigned char* kp = buf + r * KSTR + 16 * hh;
            bf16x8 qf[8];
#pragma unroll
            for (int s = 0; s < 8; ++s) qf[s] = *(const LAS bf16x8*)(qfp + 32 * s);
#pragma unroll
            for (int s = 0; s < 8; ++s) p0 = __builtin_amdgcn_mfma_f32_32x32x16_bf16(*(const LAS bf16x8*)(kp + 32 * s), qf[s], p0, 0, 0, 0);
            if (two) {
#pragma unroll
                for (int s = 0; s < 8; ++s) p1 = __builtin_amdgcn_mfma_f32_32x32x16_bf16(*(const LAS bf16x8*)(kp + 32 * KSTR + 32 * s), qf[s], p1, 0, 0, 0); } }
        const int m0 = (int)(((unsigned)mw) >> (4 * hh)), m1 = two ? (int)(((unsigned)(mw >> 32)) >> (4 * hh)) : 0;
        const unsigned NEGB = 0xf149f2cau;
#pragma unroll
        for (int i = 0; i < 16; ++i) { const int kb = crow(i, 0);
            const unsigned t0 = (unsigned)((m0 << (31 - kb)) >> 31), t1 = (unsigned)((m1 << (31 - kb)) >> 31);
            p0[i] = __uint_as_float((__float_as_uint(p0[i]) & t0) | (NEGB & ~t0)); p1[i] = __uint_as_float((__float_as_uint(p1[i]) & t1) | (NEGB & ~t1)); }
        float tmax = fmaxf(p0[0], p1[0]);
#pragma unroll
        for (int i = 1; i < 16; ++i) tmax = fmaxf(fmaxf(tmax, p0[i]), p1[i]);
        tmax = swap_max(tmax);
        const float mnew = fmaxf(mrun, tmax);
        if (__any(mnew > mrun)) {
            const float alpha = __builtin_amdgcn_exp2f(mrun - mnew);
            lrun *= alpha;
#pragma unroll
            for (int d = 0; d < 4; ++d)
#pragma unroll
                for (int i = 0; i < 16; ++i) o[d][i] *= alpha;
        }
        float ls = 0.f;
#pragma unroll
        for (int i = 0; i < 16; ++i) { const float e0 = __builtin_amdgcn_exp2f(p0[i] - mnew), e1 = __builtin_amdgcn_exp2f(p1[i] - mnew); p0[i] = e0; p1[i] = e1; ls += e0 + e1; }
        lrun += ls; mrun = mnew;
        const bf16x8 pa0 = pack8(p0, 0), pa1 = pack8(p0, 8), pa2 = pack8(p1, 0), pa3 = pack8(p1, 8);
        const LAS unsigned char* vb = buf + KTILE_B + r * VSTR + 8 * hh;
#pragma unroll
        for (int d = 0; d < 4; ++d) {
            const LAS unsigned char* vp = vb + 32 * d * VSTR;
#define VFRAG(ks) ({ const s16x4 lo_ = *(const LAS s16x4*)(vp + 32 * (ks)), hi_ = *(const LAS s16x4*)(vp + 32 * (ks) + 16); (bf16x8){lo_[0], lo_[1], lo_[2], lo_[3], hi_[0], hi_[1], hi_[2], hi_[3]}; })
            o[d] = __builtin_amdgcn_mfma_f32_32x32x16_bf16(VFRAG(0), pa0, o[d], 0, 0, 0);
            o[d] = __builtin_amdgcn_mfma_f32_32x32x16_bf16(VFRAG(1), pa1, o[d], 0, 0, 0);
            if (two) { o[d] = __builtin_amdgcn_mfma_f32_32x32x16_bf16(VFRAG(2), pa2, o[d], 0, 0, 0);
                       o[d] = __builtin_amdgcn_mfma_f32_32x32x16_bf16(VFRAG(3), pa3, o[d], 0, 0, 0); }
#undef VFRAG
        }
        if (kt & 1) { if (kt + 1 <= qb64) sB.store(lds + ((kt + 1) & 1) * KVBUF_B, tid); if (kt + 3 <= qb64) MA_LOAD(sB, kt + 3); }
        else        { if (kt + 1 <= qb64) sA.store(lds + ((kt + 1) & 1) * KVBUF_B, tid); if (kt + 3 <= qb64) MA_LOAD(sA, kt + 3); }
        asm volatile("s_waitcnt lgkmcnt(0)" ::: "memory"); __builtin_amdgcn_s_barrier(); asm volatile("" ::: "memory");
    }
#undef MA_LOAD
    asm volatile("s_waitcnt vmcnt(0)" ::: "memory");
    const float linv = 1.0f / swap_sum(lrun);
    bf16_t* op = O + (size_t)(b * SEQ + q0 + r) * DM + h * HD + 4 * hh;
#pragma unroll
    for (int d = 0; d < 4; ++d)
#pragma unroll
        for (int gq = 0; gq < 4; ++gq) { u32x2 w; w.x = pk2(o[d][4 * gq] * linv, o[d][4 * gq + 1] * linv); w.y = pk2(o[d][4 * gq + 2] * linv, o[d][4 * gq + 3] * linv); *(u32x2*)(op + 32 * d + 8 * gq) = w; }
}


__device__ __forceinline__ void sb_subtile(const LAS unsigned char* kp, const LAS unsigned char* vb, const bf16x8 (&qf)[8], const bf16x8 (&uf)[2], f32x16 (&o)[4], float& carry, bool diag, int rm) {
    f32x16 p = f32x16{};
#pragma unroll
    for (int s = 0; s < 8; ++s) p = __builtin_amdgcn_mfma_f32_32x32x16_bf16(*(const LAS bf16x8*)(kp + 32 * s), qf[s], p, 0, 0, 0);
    f32x16 sp;
#pragma unroll
    for (int i = 0; i < 16; ++i) sp[i] = __builtin_amdgcn_logf(1.0f + __builtin_amdgcn_exp2f(fminf(p[i], 120.0f)));
    if (diag) {
#pragma unroll
        for (int i = 0; i < 16; ++i) if (crow(i, 0) >= rm) { sp[i] = 0.f; p[i] = -1e30f; } }
    f32x16 c;
#pragma unroll
    for (int i = 0; i < 16; ++i) c[i] = carry;
    c = __builtin_amdgcn_mfma_f32_32x32x16_bf16(uf[0], pack8(sp, 0), c, 0, 0, 0);
    c = __builtin_amdgcn_mfma_f32_32x32x16_bf16(uf[1], pack8(sp, 8), c, 0, 0, 0);
#pragma unroll
    for (int i = 0; i < 16; ++i) p[i] = __builtin_amdgcn_exp2f(p[i] - c[i]);
    carry = swap_max(c[0]);
    const bf16x8 pa0 = pack8(p, 0), pa1 = pack8(p, 8);
#pragma unroll
    for (int d = 0; d < 4; ++d) { const LAS unsigned char* vp = vb + 32 * d * VSTR;
        const s16x4 l0 = *(const LAS s16x4*)vp, h0 = *(const LAS s16x4*)(vp + 16), l1 = *(const LAS s16x4*)(vp + 32), h1 = *(const LAS s16x4*)(vp + 48);
        o[d] = __builtin_amdgcn_mfma_f32_32x32x16_bf16((bf16x8){l0[0], l0[1], l0[2], l0[3], h0[0], h0[1], h0[2], h0[3]}, pa0, o[d], 0, 0, 0);
        o[d] = __builtin_amdgcn_mfma_f32_32x32x16_bf16((bf16x8){l1[0], l1[1], l1[2], l1[3], h1[0], h1[1], h1[2], h1[3]}, pa1, o[d], 0, 0, 0); }
}
__device__ __forceinline__ void sb_attn_block(const bf16_t* __restrict__ Q, const bf16_t* __restrict__ K, const bf16_t* __restrict__ Vt, bf16_t* __restrict__ O, LAS unsigned char* lds,
                                              int bh, int qblk, int wave, int lane, int tid) {
    const int r = lane & 31, hh = lane >> 5, b = bh >> 4, h = bh & 15, q0 = qblk * 256 + wave * 32, rm = r - 4 * hh;
    bf16x8 uf[2];
#pragma unroll
    for (int s2 = 0; s2 < 2; ++s2) { u32x4 w; unsigned e[8];
#pragma unroll
        for (int j = 0; j < 8; ++j) { const int key = 16 * s2 + 8 * (j >> 2) + 4 * hh + (j & 3); e[j] = (key >= r) ? 0x3f80u : 0u; }
        w.x = e[0] | (e[1] << 16); w.y = e[2] | (e[3] << 16); w.z = e[4] | (e[5] << 16); w.w = e[6] | (e[7] << 16); uf[s2] = __builtin_bit_cast(bf16x8, w); }
    const bf16_t* qp = Q + (size_t)(b * SEQ + q0 + r) * DM + h * HD + 8 * hh;
    bf16x8 qf[8];
#pragma unroll
    for (int s = 0; s < 8; ++s) qf[s] = *(const bf16x8*)(qp + 16 * s);
    f32x16 o[4];
#pragma unroll
    for (int d = 0; d < 4; ++d) o[d] = f32x16{};
    float carry = 0.f; bool done = false;
    const unsigned char* kg = (const unsigned char*)(K + (size_t)(b * SEQ) * DM + h * HD);
    const unsigned char* vg = (const unsigned char*)(Vt + (size_t)bh * HD * SEQ);
    volatile LAS unsigned* flags = (volatile LAS unsigned*)(lds + 2 * KVBUF_B);
    const int ktop = qblk * 4 + 3;
    KVStage sA, sB;
#define SB_LOAD(ST, t) ST.load(kg + (size_t)(t) * 64 * (DM * 2), DM * 2, vg + (size_t)(t) * 64 * 2, SEQ * 2, tid)
    SB_LOAD(sA, ktop);
    sA.store(lds, tid);
    asm volatile("s_waitcnt lgkmcnt(0)" ::: "memory"); __builtin_amdgcn_s_barrier(); asm volatile("" ::: "memory");
    if (ktop >= 1) SB_LOAD(sA, ktop - 1);
    if (ktop >= 2) SB_LOAD(sB, ktop - 2);
    int kt = ktop, it = 0; bool fin = false;
#define SB_STEP(ST) do { \
        const LAS unsigned char* buf = lds + (it & 1) * KVBUF_B; \
        if (!done) { \
            _Pragma("unroll") for (int j = 1; j >= 0; --j) { const int key0 = 64 * kt + 32 * j; \
                if (!done && key0 <= q0) { \
                    sb_subtile(buf + (32 * j + r) * KSTR + 16 * hh, buf + KTILE_B + r * VSTR + 64 * j + 8 * hh, qf, uf, o, carry, key0 == q0, rm); \
                    if (__all(carry > SB_EXIT)) done = true; } } } \
        if (kt >= 1) ST.store(lds + ((it + 1) & 1) * KVBUF_B, tid); \
        if (kt >= 3) SB_LOAD(ST, kt - 3); \
        if (lane == 0) flags[wave] = done ? 1u : 0u; \
        asm volatile("s_waitcnt lgkmcnt(0)" ::: "memory"); __builtin_amdgcn_s_barrier(); asm volatile("" ::: "memory"); \
        if (kt == 0) fin = true; \
        else { unsigned nd = 0; _Pragma("unroll") for (int w = 0; w < 8; ++w) nd += flags[w]; if (nd == 8u) fin = true; } \
        --kt; ++it; } while (0)
    for (;;) { SB_STEP(sA); if (fin) break; SB_STEP(sB); if (fin) break; }
#undef SB_STEP
#undef SB_LOAD
    asm volatile("s_waitcnt vmcnt(0)" ::: "memory");
    bf16_t* op = O + (size_t)(b * SEQ + q0 + r) * DM + h * HD + 4 * hh;
#pragma unroll
    for (int d = 0; d < 4; ++d)
#pragma unroll
        for (int g = 0; g < 4; ++g) { u32x2 w; w.x = pk2(o[d][4 * g], o[d][4 * g + 1]); w.y = pk2(o[d][4 * g + 2], o[d][4 * g + 3]); *(u32x2*)(op + 32 * d + 8 * g) = w; }
}


__device__ __forceinline__ unsigned wave_total_u32(unsigned v) {
    v += (unsigned)__builtin_amdgcn_update_dpp(0, (int)v, 0x111, 0xf, 0xf, true);
    v += (unsigned)__builtin_amdgcn_update_dpp(0, (int)v, 0x112, 0xf, 0xf, true);
    v += (unsigned)__builtin_amdgcn_update_dpp(0, (int)v, 0x114, 0xf, 0xf, true);
    v += (unsigned)__builtin_amdgcn_update_dpp(0, (int)v, 0x118, 0xf, 0xf, true);
    v += (unsigned)__builtin_amdgcn_update_dpp(0, (int)v, 0x142, 0xa, 0xf, false);
    v += (unsigned)__builtin_amdgcn_update_dpp(0, (int)v, 0x143, 0xc, 0xf, false);
    return (unsigned)__builtin_amdgcn_readlane((int)v, 63);
}
__device__ __forceinline__ void causal_mask_row(unsigned* mrow, int t, int lane) {
    const int key0 = 32 * lane; unsigned w;
    if (key0 + 31 <= t) w = 0xffffffffu; else if (key0 > t) w = 0u; else w = (1u << (t - key0 + 1)) - 1u;
    mrow[lane] = w;
}
__device__ __forceinline__ void write_topk_mask(const unsigned (&uv)[32], unsigned prefix, unsigned* mrow, int lane) {
    int cgt = 0;
#pragma unroll
    for (int e = 0; e < 32; ++e) cgt += __popcll(__ballot(uv[e] > prefix));
    const int need = TOPK - cgt; int running = 0;
    const unsigned long long ltm = (1ull << lane) - 1ull;
    unsigned long long keep = 0ull;
#pragma unroll
    for (int e = 0; e < 32; ++e) {
        const unsigned long long eq = __ballot(uv[e] == prefix);
        const bool sel = (uv[e] > prefix) || (uv[e] == prefix && (running + __popcll(eq & ltm)) < need);
        const unsigned long long m64 = __ballot(sel);
        running += __popcll(eq);
        if (lane == e) keep = m64;
    }
    if (lane < 32) *(unsigned long long*)(mrow + 2 * lane) = keep;
}
__device__ __forceinline__ void select_two(const float* rowa, const float* rowb, int ta, unsigned* mrowa, unsigned* mrowb, int lane) {
    const int tb = ta + 1, na = ta + 1, nb = tb + 1;
    if (nb <= TOPK) { causal_mask_row(mrowa, ta, lane); causal_mask_row(mrowb, tb, lane); return; }
    float fa[32], fb[32];
#pragma unroll
    for (int e = 0; e < 32; ++e) { fa[e] = __builtin_nontemporal_load(rowa + e * 64 + lane); fb[e] = __builtin_nontemporal_load(rowb + e * 64 + lane); }
    unsigned ua[32], ub[32];
#pragma unroll
    for (int e = 0; e < 32; ++e) { const int key = e * 64 + lane; const unsigned ma = fmap(fa[e]), mb = fmap(fb[e]); ua[e] = (key < na) ? ma : 0x007fffffu; ub[e] = (key < nb) ? mb : 0x007fffffu; }
    unsigned pa = 0u, pb = 0u; bool da = false, db = false;
    for (int bit = 31; bit >= 0; --bit) {
        const unsigned ca = pa | (1u << bit), cb = pb | (1u << bit);
        unsigned na_ = 0u, nb_ = 0u;
#pragma unroll
        for (int e = 0; e < 32; ++e) { na_ += (ua[e] >= ca) ? 1u : 0u; nb_ += (ub[e] >= cb) ? 1u : 0u; }
        const unsigned tota = wave_total_u32(na_), totb = wave_total_u32(nb_);
        if (!da && tota >= (unsigned)TOPK) { pa = ca; if (tota == (unsigned)TOPK) da = true; }
        if (!db && totb >= (unsigned)TOPK) { pb = cb; if (totb == (unsigned)TOPK) db = true; }
        if (da && db) break;
    }
    if (na <= TOPK) causal_mask_row(mrowa, ta, lane); else write_topk_mask(ua, pa, mrowa, lane);
    write_topk_mask(ub, pb, mrowb, lane);
}

struct KiStage {
    u32x4 k[4];
    __device__ __forceinline__ void load(const unsigned char* kg, int tid) {
#pragma unroll
        for (int i = 0; i < 4; ++i) { const int c = tid + 512 * i; k[i] = *(const u32x4*)(kg + (size_t)(c >> 4) * (HD * 2) + (c & 15) * 16); }
    }
    __device__ __forceinline__ void store(LAS unsigned char* buf, int tid) const {
#pragma unroll
        for (int i = 0; i < 4; ++i) { const int c = tid + 512 * i; *(LAS u32x4*)(buf + (c >> 4) * KSTR + (c & 15) * 16) = k[i]; }
    }
};
constexpr int KIBUF_B = 128 * KSTR;
__device__ __forceinline__ void indexer_block(const bf16_t* __restrict__ QI, const bf16_t* __restrict__ KI, const float* __restrict__ WI, unsigned* __restrict__ MASK, float* __restrict__ SC,
                                              LAS unsigned char* lds, int b, int qb16, int wave, int lane, int tid) {
    const int r = lane & 31, hh = lane >> 5, t0 = 16 * qb16, tw = t0 + 2 * wave;
    const bf16_t* ap = QI + (size_t)(b * SEQ + tw + (r >> 4)) * DM + (r & 15) * HD + 8 * hh;
    bf16x8 af[8];
#pragma unroll
    for (int s = 0; s < 8; ++s) af[s] = *(const bf16x8*)(ap + 16 * s);
    float wv[16];
#pragma unroll
    for (int i = 0; i < 16; ++i) { const int rw = crow(i, hh); wv[i] = WI[(size_t)(b * SEQ + tw + (rw >> 4)) * 16 + (rw & 15)]; }
    float* myrow = SC + ((size_t)(b * 128 + qb16) * 16 + 2 * wave + hh) * SEQ;
    const int tq = tw + hh, ntile = (t0 + 16 + 127) >> 7;
    const unsigned char* kg = (const unsigned char*)(KI + (size_t)(b * SEQ) * HD);
    KiStage sA, sB;
    sA.load(kg, tid);
    sA.store(lds, tid);
    asm volatile("s_waitcnt lgkmcnt(0)" ::: "memory"); __builtin_amdgcn_s_barrier(); asm volatile("" ::: "memory");
    if (ntile > 1) sA.load(kg + (size_t)1 * 128 * (HD * 2), tid);
    if (ntile > 2) sB.load(kg + (size_t)2 * 128 * (HD * 2), tid);
    for (int kt = 0; kt < ntile; ++kt) {
        const LAS unsigned char* buf = lds + (kt & 1) * KIBUF_B;
#pragma unroll
        for (int j = 0; j < 4; ++j) { const int key0 = 128 * kt + 32 * j;
            if (key0 <= t0 + 15) {
                const LAS unsigned char* kp = buf + (32 * j + r) * KSTR + 16 * hh;
                f32x16 c = f32x16{};
#pragma unroll
                for (int s = 0; s < 8; ++s) c = __builtin_amdgcn_mfma_f32_32x32x16_bf16(af[s], *(const LAS bf16x8*)(kp + 32 * s), c, 0, 0, 0);
                float s0 = 0.f, s1 = 0.f;
#pragma unroll
                for (int i = 0; i < 8; ++i) { s0 += wv[i] * relu_i(c[i]); s1 += wv[i + 8] * relu_i(c[i + 8]); }
                const float t0s = swap_sum(s0), t1s = swap_sum(s1);
                const int key = key0 + r;
                float v = (hh ? t1s : t0s) + 0.0f;
                if (key > tq) v = -INFINITY;
                myrow[key] = v; } }
        if (kt & 1) { if (kt + 1 < ntile) sB.store(lds + ((kt + 1) & 1) * KIBUF_B, tid); if (kt + 3 < ntile) sB.load(kg + (size_t)(kt + 3) * 128 * (HD * 2), tid); }
        else        { if (kt + 1 < ntile) sA.store(lds + ((kt + 1) & 1) * KIBUF_B, tid); if (kt + 3 < ntile) sA.load(kg + (size_t)(kt + 3) * 128 * (HD * 2), tid); }
        asm volatile("s_waitcnt lgkmcnt(0)" ::: "memory"); __builtin_amdgcn_s_barrier(); asm volatile("" ::: "memory");
    }
    asm volatile("s_waitcnt vmcnt(0)" ::: "memory");
    { const float* rowa = SC + ((size_t)(b * 128 + qb16) * 16 + 2 * wave) * SEQ;
      unsigned* mrowa = MASK + (size_t)(b * SEQ + tw) * 64;
      select_two(rowa, rowa + SEQ, tw, mrowa, mrowa + 64, lane); }
}


__device__ __forceinline__ void sb_attn_waves(const bf16_t* __restrict__ Q, const bf16_t* __restrict__ KF, const bf16_t* __restrict__ VF, bf16_t* __restrict__ O, int gw, int ngw, int lane) {
    const int r = lane & 31, hh = lane >> 5, rm = r - 4 * hh;
    bf16x8 uf[2];
#pragma unroll
    for (int s2 = 0; s2 < 2; ++s2) { u32x4 w; unsigned e[8];
#pragma unroll
        for (int j = 0; j < 8; ++j) { const int key = 16 * s2 + 8 * (j >> 2) + 4 * hh + (j & 3); e[j] = (key >= r) ? 0x3f80u : 0u; }
        w.x = e[0] | (e[1] << 16); w.y = e[2] | (e[3] << 16); w.z = e[4] | (e[5] << 16); w.w = e[6] | (e[7] << 16); uf[s2] = __builtin_bit_cast(bf16x8, w); }
    for (int unit = gw; unit < BATCH * NH * 64; unit += ngw) {
        const int bh = unit >> 6, qt = 63 - (unit & 63), b = bh >> 4, h = bh & 15, q0 = qt * 32;
        const bf16_t* qp = Q + (size_t)(b * SEQ + q0 + r) * DM + h * HD + 8 * hh;
        bf16x8 qf[8];
#pragma unroll
        for (int s = 0; s < 8; ++s) qf[s] = *(const bf16x8*)(qp + 16 * s);
        f32x16 o[4];
#pragma unroll
        for (int d = 0; d < 4; ++d) o[d] = f32x16{};
        float carry = 0.f;
        const bf16x8* kbase = (const bf16x8*)KF + (size_t)bh * 64 * 8 * 64 + lane;
        const bf16x8* vbase = (const bf16x8*)VF + (size_t)bh * 64 * 8 * 64 + lane;
        bf16x8 kf[8];
#pragma unroll
        for (int s = 0; s < 8; ++s) kf[s] = kbase[(size_t)(qt * 8 + s) * 64];
        for (int kt = qt; kt >= 0; --kt) {
            bf16x8 vf[8], kn[8];
#pragma unroll
            for (int i = 0; i < 8; ++i) vf[i] = vbase[(size_t)(kt * 8 + i) * 64];
            const int ktn = kt > 0 ? kt - 1 : 0;
#pragma unroll
            for (int s = 0; s < 8; ++s) kn[s] = kbase[(size_t)(ktn * 8 + s) * 64];
            f32x16 p = f32x16{};
#pragma unroll
            for (int s = 0; s < 8; ++s) p = __builtin_amdgcn_mfma_f32_32x32x16_bf16(kf[s], qf[s], p, 0, 0, 0);
            f32x16 sp;
#pragma unroll
            for (int i = 0; i < 16; ++i) sp[i] = __builtin_amdgcn_logf(1.0f + __builtin_amdgcn_exp2f(fminf(p[i], 120.0f)));
            if (kt == qt) {
#pragma unroll
                for (int i = 0; i < 16; ++i) if (crow(i, 0) >= rm) { sp[i] = 0.f; p[i] = -1e30f; } }
            f32x16 c;
#pragma unroll
            for (int i = 0; i < 16; ++i) c[i] = carry;
            c = __builtin_amdgcn_mfma_f32_32x32x16_bf16(uf[0], pack8(sp, 0), c, 0, 0, 0);
            c = __builtin_amdgcn_mfma_f32_32x32x16_bf16(uf[1], pack8(sp, 8), c, 0, 0, 0);
#pragma unroll
            for (int i = 0; i < 16; ++i) p[i] = __builtin_amdgcn_exp2f(p[i] - c[i]);
            carry = swap_max(c[0]);
            const bf16x8 pa0 = pack8(p, 0), pa1 = pack8(p, 8);
#pragma unroll
            for (int d = 0; d < 4; ++d) { o[d] = __builtin_amdgcn_mfma_f32_32x32x16_bf16(vf[2 * d], pa0, o[d], 0, 0, 0); o[d] = __builtin_amdgcn_mfma_f32_32x32x16_bf16(vf[2 * d + 1], pa1, o[d], 0, 0, 0); }
            if (__all(carry > SB_EXIT)) break;
#pragma unroll
            for (int s = 0; s < 8; ++s) kf[s] = kn[s];
        }
        bf16_t* op = O + (size_t)(b * SEQ + q0 + r) * DM + h * HD + 4 * hh;
#pragma unroll
        for (int d = 0; d < 4; ++d)
#pragma unroll
            for (int g = 0; g < 4; ++g) { u32x2 w; w.x = pk2(o[d][4 * g], o[d][4 * g + 1]); w.y = pk2(o[d][4 * g + 2], o[d][4 * g + 3]); *(u32x2*)(op + 32 * d + 8 * g) = w; }
    }
}

constexpr int N_PHASES = 12;
__global__ void __launch_bounds__(512, 2) fwd_kernel(Args a) {
    extern __shared__ __attribute__((aligned(16))) unsigned char lds_raw[];
    LAS unsigned char* lds = (LAS unsigned char*)lds_raw;
    cg::grid_group grid = cg::this_grid();
    const int tid = threadIdx.x, lane = tid & 63, wave = __builtin_amdgcn_readfirstlane(tid >> 6);
    const int G = gridDim.x, bx = blockIdx.x;
    const int gw = bx * 8 + wave, ngw = G * 8;
    unsigned char* ws = a.ws;
    const int lo = a.ph_lo, hi = a.ph_hi;
#ifndef REP_PHASE
#define REP_PHASE -1
#endif
#ifndef REP_COUNT
#define REP_COUNT 1
#endif
#define IN(k) (lo <= (k) && (k) < hi)
#define GSYNC(k) do { if ((k) == 0 && a.ph_hi > 1000) grid.sync(); xcd_barrier(xbar); } while (0)
#define SEAM(k) do { if (IN(k) && IN((k) + 1)) GSYNC(k); } while (0)
#define REPS(k) for (int rep_ = 0; rep_ < ((k) == REP_PHASE ? REP_COUNT : 1); ++rep_, (void)(((k) == REP_PHASE && rep_ < REP_COUNT) ? (xcd_barrier(xbar), 0) : 0))
    bf16_t* XB = (bf16_t*)(ws + WS_XB); float* X1 = (float*)(ws + WS_X1); float* X2 = (float*)(ws + WS_X2); float* PART = (float*)(ws + WS_PART);
    bf16_t* Qb = (bf16_t*)(ws + WS_Q); bf16_t* Kb = (bf16_t*)(ws + WS_K); bf16_t* Vtb = (bf16_t*)(ws + WS_VT); bf16_t* Ob = (bf16_t*)(ws + WS_O);
    bf16_t* QIb = (bf16_t*)(ws + WS_QI); bf16_t* KDb = (bf16_t*)(ws + WS_KD); bf16_t* VTDb = (bf16_t*)(ws + WS_VTD); bf16_t* KIb = (bf16_t*)(ws + WS_KI);
    float* WIb = (float*)(ws + WS_WI); unsigned* MASKb = (unsigned*)(ws + WS_MASK);
    bf16_t* ACTb = (bf16_t*)(ws + WS_ACT);
    const float* ropeC = (const float*)(ws + WS_ROPE); const float* ropeS = ropeC + SEQ * 64;

    if (tid < 16) ((volatile LAS unsigned*)(lds + LDS_MISC))[tid] = 0u;
    __syncthreads();
    XcdBarrier xbar = xcd_barrier_post((unsigned*)(ws + WS_CTL), (volatile LAS unsigned*)(lds + LDS_MISC) + 8);
    const Offload offl = make_offload(G);
    if (IN(0)) REPS(0) { prologue_phase(a, lds, gw, ngw, wave, lane, offl); }
    SEAM(0);
    if (IN(1)) REPS(1) {
        pg8::Gemm g{XB, (const bf16_t*)(ws + WS_WQKV), MTOK, NQKV, DM}; pg8::StaticOrder S; S.init(MTOK, NQKV, G, bx);
        EpiQKV E{ws};
        pg8::gemm_phase<EpiQKV, pg8::StaticOrder, true, true>(lds, g, S, E);
    }
    SEAM(1);
    if (IN(2)) REPS(2) { sb_attn_waves(Qb, Kb, Vtb, Ob, gw, ngw, lane); }
    SEAM(2);
    if (IN(3)) REPS(3) {
        pg8::Gemm g{Ob, (const bf16_t*)(ws + WS_WO0), MTOK, DM, DM}; pg8::StaticOrder S; S.init(MTOK, DM, G, bx);
        EpiRes E{a.x, X1, XB, PART};
        pg8::gemm_phase<EpiRes, pg8::StaticOrder, true, true>(lds, g, S, E);
    }
    SEAM(3);
    if (IN(4)) REPS(4) {
        const int Gg = offl.up0 ? offl.g_up : G;
        if (bx < Gg) {
        pg8::Gemm g{XB, (const bf16_t*)(ws + WS_WUP), MTOK, NUP, DM, 254, -2}; pg8::StaticOrder S; S.init_tiles(33, NUP / 256, Gg, bx);
        EpiUpConv E{ACTb, PART, a.conv_w, a.conv_b, (LAS float*)(lds + LDS_EPI)};
        pg8::gemm_phase<EpiUpConv, pg8::StaticOrder, true, true>(lds, g, S, E);
        } else { LAS float* scr = (LAS float*)(lds + wave * 16640); const int vw = (bx - Gg) * 8 + wave, nvw = (G - Gg) * 8;
            convert_items(a, scr, WI5, WI6, vw, nvw, lane); convert_items(a, scr, WI1, WI2, vw, nvw, lane); }
    }
    SEAM(4);
    if (IN(5)) REPS(5) {
        pg8::Gemm g{ACTb, (const bf16_t*)(ws + WS_WDN), MTOK, DM, FF}; pg8::StaticOrder S; S.init(MTOK, DM, G, bx);
        EpiRes E{X1, X2, XB, PART};
        pg8::gemm_phase<EpiRes, pg8::StaticOrder, true, true>(lds, g, S, E);
    }
    SEAM(5);
    if (IN(6)) REPS(6) {
        const int Gg = offl.in1 ? offl.g_in : G;
        if (bx < Gg) {
        pg8::Gemm g{XB, (const bf16_t*)(ws + WS_WIN), MTOK, NINP, DM}; pg8::StaticOrder S; S.init(MTOK, NINP, Gg, bx);
        EpiDsaIn E{ws, (LAS float*)(lds + LDS_EPI)};
        pg8::gemm_phase<EpiDsaIn, pg8::StaticOrder, true, true>(lds, g, S, E);
        } else { LAS float* scr = (LAS float*)(lds + wave * 16640); const int vw = (bx - Gg) * 8 + wave, nvw = (G - Gg) * 8;
            convert_items(a, scr, WI2, WI3, vw, nvw, lane); convert_items(a, scr, WI4, WI5, vw, nvw, lane); }
    }
    SEAM(6);
    if (IN(7)) REPS(7) {
        for (int pr = bx; pr < 256; pr += G) { const int b = pr >> 6, p = pr & 63;
            for (int half = 0; half < 2; ++half) indexer_block(QIb, KIb, WIb, MASKb, (float*)(ws + WS_ACT), lds, b, half ? p : 127 - p, wave, lane, tid); }
    }
    SEAM(7);
    if (IN(8)) REPS(8) {
        for (int pr = bx; pr < 256; pr += G) { const int b = pr >> 6, g = (pr >> 4) & 3, p = pr & 15;
            for (int half = 0; half < 2; ++half) dsa_attn_block(Qb, KDb, VTDb, MASKb, Ob, lds, b, g, half ? p : 31 - p, wave, lane, tid); }
    }
    SEAM(8);
    if (IN(9)) REPS(9) {
        pg8::Gemm g{Ob, (const bf16_t*)(ws + WS_WO1), MTOK, DM, DM}; pg8::StaticOrder S; S.init(MTOK, DM, G, bx);
        EpiRes E{X2, X1, XB, PART};
        pg8::gemm_phase<EpiRes, pg8::StaticOrder, true, true>(lds, g, S, E);
    }
    SEAM(9);
    if (IN(10)) REPS(10) {
        const int Gg = offl.up1 ? offl.g_up : G;
        if (bx < Gg) {
        pg8::Gemm g{XB, (const bf16_t*)(ws + WS_WUP + 44 * MiB), MTOK, NUP, DM, 254, -2}; pg8::StaticOrder S; S.init_tiles(33, NUP / 256, Gg, bx);
        EpiUpConv E{ACTb, PART, a.conv_w + 3 * NUP, a.conv_b + NUP, (LAS float*)(lds + LDS_EPI)};
        pg8::gemm_phase<EpiUpConv, pg8::StaticOrder, true, true>(lds, g, S, E);
        } else { LAS float* scr = (LAS float*)(lds + wave * 16640); const int vw = (bx - Gg) * 8 + wave, nvw = (G - Gg) * 8;
            convert_items(a, scr, WI6, WI7, vw, nvw, lane); }
    }
    SEAM(10);
    if (IN(11)) REPS(11) {
        pg8::Gemm g{ACTb, (const bf16_t*)(ws + WS_WDN + 22 * MiB), MTOK, DM, FF}; pg8::StaticOrder S; S.init(MTOK, DM, G, bx);
        EpiRes E{X1, a.out, nullptr, nullptr};
        pg8::gemm_phase<EpiRes, pg8::StaticOrder, true, true>(lds, g, S, E);
    }
#undef IN
#undef SEAM
}

extern "C" void kernel_launch(void* const* d_in, const int* in_sizes, int n_in, void* d_out, int out_size, void* d_ws, size_t ws_size, hipStream_t stream) {
    static int grid = 0;
    if (grid == 0) {
        if (n_in != 14 || out_size != MTOK * DM || ws_size < WS_END) { fprintf(stderr, "kernel_launch: unexpected shapes (n_in %d out %d ws %zu)\n", n_in, out_size, ws_size); grid = -1; return; }
        int dev = 0, cus = 0, per_cu = 0;
        hipGetDevice(&dev); hipDeviceGetAttribute(&cus, hipDeviceAttributeMultiprocessorCount, dev);
        if (hipFuncSetAttribute((const void*)fwd_kernel, hipFuncAttributeMaxDynamicSharedMemorySize, LDS_BYTES) != hipSuccess) { fprintf(stderr, "kernel_launch: hipFuncSetAttribute failed\n"); grid = -1; return; }
        if (hipOccupancyMaxActiveBlocksPerMultiprocessor(&per_cu, (const void*)fwd_kernel, 512, LDS_BYTES) != hipSuccess || per_cu < 1) { fprintf(stderr, "kernel_launch: occupancy query says %d\n", per_cu); per_cu = 1; }
        (void)hipGetLastError();
        grid = cus;
    }
    if (grid < 0) return;
    Args a{};
    a.x = (const float*)d_in[0]; a.attn_g = (const float*)d_in[1]; a.ffn_g = (const float*)d_in[2]; a.w_qkv = (const float*)d_in[3]; a.w_o0 = (const float*)d_in[4]; a.w_in = (const float*)d_in[5];
    a.qn_g = (const float*)d_in[6]; a.kn_g = (const float*)d_in[7]; a.ikn_g = (const float*)d_in[8]; a.w_o1 = (const float*)d_in[9]; a.w_up = (const float*)d_in[10]; a.conv_w = (const float*)d_in[11];
    a.conv_b = (const float*)d_in[12]; a.w_down = (const float*)d_in[13]; a.out = (float*)d_out; a.ws = (unsigned char*)d_ws;
    if (hipMemsetAsync((char*)d_ws + WS_CTL, 0, CTL_BYTES, stream) != hipSuccess) { fprintf(stderr, "kernel_launch: hipMemsetAsync failed\n"); return; }
#if MK_ONE_LAUNCH
    a.ph_lo = 0; a.ph_hi = N_PHASES;
    void* args[] = {&a};
    hipError_t e = hipLaunchCooperativeKernel((const void*)fwd_kernel, dim3(grid), dim3(512), args, LDS_BYTES, stream);
    if (e != hipSuccess) fprintf(stderr, "cooperative launch failed: %s (grid %d)\n", hipGetErrorString(e), grid);
#else
    for (int pp = 0; pp < N_PHASES + HOST_REP_EXTRA; ++pp) {
        const int p = pp < N_PHASES ? pp : -1;
        if (p < 0) continue;
        for (int hr = 0; hr < ((p == HOST_REP_PHASE) ? 1 + HOST_REP_EXTRA : 1); ++hr) {
        a.ph_lo = p; a.ph_hi = p + 1;
        void* args[] = {&a};
        hipError_t e = hipLaunchCooperativeKernel((const void*)fwd_kernel, dim3(grid), dim3(512), args, LDS_BYTES, stream);
        if (e != hipSuccess) { fprintf(stderr, "launch %d failed: %s (grid %d)\n", p, hipGetErrorString(e), grid); break; }
        }
    }
#endif
}
```

```cpp
#include <hip/hip_runtime.h>
#include <hip/hip_cooperative_groups.h>
#include <cstdio>
#include <cstdint>
namespace cg = cooperative_groups;

#ifndef HOST_REP_PHASE
#define HOST_REP_PHASE -1
#endif
#ifndef HOST_REP_EXTRA
#define HOST_REP_EXTRA 0
#endif
#ifndef MK_ONE_LAUNCH
#define MK_ONE_LAUNCH 1
#endif

#define LAS __attribute__((address_space(3)))
typedef unsigned short bf16_t;
typedef short bf16x8 __attribute__((ext_vector_type(8)));
typedef short s16x4 __attribute__((ext_vector_type(4)));
typedef float f32x4 __attribute__((ext_vector_type(4)));
typedef float f32x2 __attribute__((ext_vector_type(2)));
typedef float f32x16 __attribute__((ext_vector_type(16)));
typedef unsigned u32x4 __attribute__((ext_vector_type(4)));
typedef unsigned u32x2 __attribute__((ext_vector_type(2)));
typedef __bf16 bf16x2_t __attribute__((ext_vector_type(2)));

constexpr int BATCH = 4, SEQ = 2048, DM = 2048, NH = 16, HD = 128, MTOK = BATCH * SEQ;
constexpr int FF = 5632, NUP = 2 * FF, NQKV = 3 * DM;
constexpr int KVH = 4, NIN = 5264, NINP = 5376;
constexpr int TOPK = 256;
constexpr float NORM_EPS = 1e-6f;
constexpr float LOG2E = 1.4426950408889634f;
constexpr float QSCALE = 0.08838834764831845f * LOG2E;

constexpr size_t MiB = 1u << 20;
constexpr size_t WS_WQKV = 0, WS_WO0 = 24 * MiB, WS_WIN = 32 * MiB, WS_WO1 = 53 * MiB, WS_WUP = 61 * MiB  , WS_WDN = 149 * MiB  ;
constexpr size_t WS_GAIN = 197 * MiB + 512 * 1024  ;
constexpr size_t WS_ROPE = 193 * MiB  , WS_PART = 194 * MiB, WS_MASK = 195 * MiB, WS_WI = 197 * MiB, WS_KI = 198 * MiB;
constexpr size_t WS_XB = 200 * MiB, WS_X1 = 232 * MiB, WS_X2 = 296 * MiB;
constexpr size_t WS_SCR = 360 * MiB;
constexpr size_t WS_U = WS_SCR, WS_ACT = WS_SCR + 176 * MiB;
constexpr size_t WS_Q = WS_SCR, WS_K = WS_SCR + 32 * MiB, WS_VT = WS_SCR + 64 * MiB, WS_O = WS_SCR + 96 * MiB, WS_QI = WS_SCR + 128 * MiB, WS_KD = WS_SCR + 160 * MiB, WS_VTD = WS_SCR + 168 * MiB;
constexpr size_t WS_CTL = WS_ACT + 88 * MiB, CTL_BYTES = 65536;
constexpr size_t WS_END = WS_CTL + CTL_BYTES;

constexpr int LDS_EPI = 131072;
constexpr int LDS_MISC = LDS_EPI + 8192;
constexpr int LDS_BYTES = 147456;

__device__ __forceinline__ unsigned pk2(float lo, float hi) { f32x2 v = {lo, hi}; bf16x2_t b = __builtin_convertvector(v, bf16x2_t); return __builtin_bit_cast(unsigned, b); }
__device__ __forceinline__ bf16_t f2bf(float f) { return (bf16_t)(pk2(f, 0.f) & 0xffffu); }
__device__ __forceinline__ float relu_i(float x) { const int b = __float_as_int(x); return __int_as_float(b > 0 ? b : 0); }
__device__ __forceinline__ int crow(int r, int hi) { return (r & 3) + 8 * (r >> 2) + 4 * hi; }
__device__ __forceinline__ bf16x8 pack8(const f32x16& p, int b) {
    u32x4 w; w.x = pk2(p[b], p[b + 1]); w.y = pk2(p[b + 2], p[b + 3]); w.z = pk2(p[b + 4], p[b + 5]); w.w = pk2(p[b + 6], p[b + 7]);
    return __builtin_bit_cast(bf16x8, w);
}
__device__ __forceinline__ float swap_sum(float v) { auto rr = __builtin_amdgcn_permlane32_swap(__float_as_uint(v), __float_as_uint(v), false, false); return __uint_as_float(rr[0]) + __uint_as_float(rr[1]); }
__device__ __forceinline__ float swap_max(float v) { auto rr = __builtin_amdgcn_permlane32_swap(__float_as_uint(v), __float_as_uint(v), false, false); return fmaxf(__uint_as_float(rr[0]), __uint_as_float(rr[1])); }
__device__ __forceinline__ float wave_sum(float v) {
#pragma unroll
    for (int o = 1; o < 64; o <<= 1) v += __shfl_xor(v, o);
    return v;
}
__device__ __forceinline__ float row_rstd(const float* part, int row, int fq) {
    const f32x4* p = (const f32x4*)(part + (size_t)row * 32 + 8 * fq);
    const f32x4 a = p[0], b = p[1]; float s = ((a.x + a.y) + (a.z + a.w)) + ((b.x + b.y) + (b.z + b.w));
    s += __shfl_xor(s, 16); s += __shfl_xor(s, 32);
    return 1.0f / sqrtf(s * (1.0f / DM) + NORM_EPS);
}


#define XB_TMO      128
#define XB_XCNT(j)  (256  + 64 * (j))
#define XB_XSUB(j)  (1280 + 64 * (j))
#define XB_XGEN(j)  (2304 + 64 * (j))
#define XB_TOP      3328
#define XB_TOPGEN   3392
#define XCD_BAR_WORDS 3456
#define XB_SPIN_CAP (1u << 18)
__device__ __forceinline__ unsigned xb_ld(unsigned* p)              { return __hip_atomic_load(p, __ATOMIC_RELAXED, __HIP_MEMORY_SCOPE_AGENT); }
__device__ __forceinline__ unsigned xb_add(unsigned* p, unsigned v) { return __hip_atomic_fetch_add(p, v, __ATOMIC_RELAXED, __HIP_MEMORY_SCOPE_AGENT); }
__device__ __forceinline__ unsigned xb_xcc_id() { return (unsigned)__builtin_amdgcn_s_getreg((3 << 11) | 20) & 0xFu; }
#define XB_SPIN(cond, bar) do { unsigned _sp = 0; while (cond) { __builtin_amdgcn_s_sleep(1); \
    if ((++_sp & 255u) == 0u) { if (xb_ld(&(bar)[XB_TMO])) break; if (_sp > XB_SPIN_CAP) { atomicAdd(&(bar)[XB_TMO], 1u); break; } } } } while (0)
struct XcdBarrier { unsigned* bar; unsigned x; volatile LAS unsigned* st; };
__device__ __forceinline__ XcdBarrier xcd_barrier_post(unsigned* bar, volatile LAS unsigned* st) {
    XcdBarrier b; b.bar = bar; b.x = xb_xcc_id(); b.st = st;
    if (threadIdx.x == 0) (void)xb_add(&bar[XB_XCNT(b.x)], 1u);
    return b;
}
__device__ __forceinline__ void xcd_barrier_complete(unsigned* bar, unsigned x, unsigned& nloc, unsigned& nx) {
    const unsigned G = gridDim.x * gridDim.y * gridDim.z;
    unsigned sum, cnt, mine, sp = 0u;
    for (;;) {
        sum = 0u; cnt = 0u; mine = 0u;
#pragma unroll
        for (unsigned j = 0; j < 16; ++j) { const unsigned c = xb_ld(&bar[XB_XCNT(j)]); sum += c; cnt += (c > 0u) ? 1u : 0u; mine = (j == x) ? c : mine; }
        if (sum == G) break;
        __builtin_amdgcn_s_sleep(1);
        if ((++sp & 255u) == 0u) { if (xb_ld(&bar[XB_TMO])) break; if (sp > XB_SPIN_CAP) { atomicAdd(&bar[XB_TMO], 1u); break; } }
    }
    nloc = mine > 0u ? mine : 1u; nx = cnt > 0u ? cnt : 1u;
}
__device__ __forceinline__ void xcd_barrier(const XcdBarrier& b) {
    asm volatile("s_waitcnt vmcnt(0)" ::: "memory");
    __syncthreads();
    if (threadIdx.x == 0) {
        unsigned* bar = b.bar;
        __builtin_amdgcn_s_waitcnt(0);
        unsigned nloc = b.st[0], nx = b.st[1];
        if (nloc == 0u) { xcd_barrier_complete(bar, b.x, nloc, nx); b.st[0] = nloc; b.st[1] = nx; }
        const unsigned old = xb_add(&bar[XB_XSUB(b.x)], 1u);
        const unsigned gen = old / nloc;
        if (old + 1u == (gen + 1u) * nloc) {
            __builtin_amdgcn_fence(__ATOMIC_RELEASE, "agent");
            asm volatile("s_waitcnt vmcnt(0)" ::: "memory");
            const unsigned og = xb_add(&bar[XB_TOP], 1u);
            const unsigned tg = og / nx;
            if (og + 1u == (tg + 1u) * nx) xb_add(&bar[XB_TOPGEN], 1u);
            else XB_SPIN(xb_ld(&bar[XB_TOPGEN]) == tg, bar);
            __builtin_amdgcn_fence(__ATOMIC_ACQUIRE, "agent");
            xb_add(&bar[XB_XGEN(b.x)], 1u);
            asm volatile("s_waitcnt vmcnt(0)" ::: "memory");
        } else {
            XB_SPIN(xb_ld(&bar[XB_XGEN(b.x)]) == gen, bar);
            __builtin_amdgcn_fence(__ATOMIC_ACQUIRE, "agent");
            asm volatile("s_waitcnt vmcnt(0)" ::: "memory");
        }
    }
    __syncthreads();
}

namespace pg8 {
constexpr int BM = 256, BK = 64, HALF = 128, HTB = HALF * BK * 2, STAGE_BYTES = 8 * HTB, NXCD = 8, WGM = 8;
__host__ __device__ __forceinline__ int lds_byte(int r, int c) { const int st = (r >> 4) * 2 + (c >> 5), rr = r & 15, cc = c & 31, ob = rr * 64 + cc * 2; return st * 1024 + (ob ^ (((ob >> 9) & 1) << 5)); }
__host__ __device__ __forceinline__ void stage_rc(int b, int& R, int& C) { const int st = b / 1024, sb = b % 1024, swz = sb ^ (((sb >> 9) & 1) << 5); R = (st >> 1) * 16 + swz / 64; C = (st & 1) * 32 + (swz % 64) / 2; }
__host__ __device__ __forceinline__ int perm32(int rho) { const int n = rho >> 4, i = rho & 15; return 8 * (i >> 2) + 4 * n + (i & 3); }
struct Unit { int pm, pn; };
struct Gemm { const bf16_t* A; const bf16_t* Bt; int M, N, K; int a_rows = 256, a_row0 = 0; };
struct StaticOrder {
    int nM, nN, nwg, G, c;
    __host__ __device__ void init(int M, int N, int G_, int c_) { nM = M / BM; nN = N / BM; nwg = nM * nN; G = G_; c = c_; }
    __host__ __device__ void init_tiles(int nM_, int nN_, int G_, int c_) { nM = nM_; nN = nN_; nwg = nM * nN; G = G_; c = c_; }
    __host__ __device__ bool next(int i, Unit& u) const {
        const long L = (long)i * G + c; if (L >= nwg) return false;
        int wgid = (int)L; { const int q = nwg / NXCD, r = nwg % NXCD, xcd = wgid % NXCD, off = wgid / NXCD; wgid = (xcd < r ? xcd * (q + 1) : r * (q + 1) + (xcd - r) * q) + off; }
        const int nig = WGM * nN, gid = wgid / nig, fm = gid * WGM, gsz = (nM - fm) < WGM ? (nM - fm) : WGM;
        u.pm = fm + ((wgid % nig) % gsz); u.pn = (wgid % nig) / gsz; return true;
    }
};
template <class Epi, class Sched, bool ALIGN_EPI, bool SP2>
__device__ __forceinline__ void gemm_phase(LAS unsigned char* lds, const Gemm g, const Sched& S, const Epi& E) {
    const int tid = threadIdx.x, wid = __builtin_amdgcn_readfirstlane(tid >> 6), lane = tid & 63, wr = wid >> 2, wc = wid & 3, fr = lane & 15, fq = lane >> 4;
    const int K = g.K, nt = K / BK;
    unsigned voffA[2], voffB[2];
#pragma unroll
    for (int i = 0; i < 2; ++i) { int R, C; stage_rc(tid * 16 + i * 8192, R, C); const int Rb = Epi::PERM ? ((R & ~31) + perm32(R & 31)) : R;
        voffA[i] = (unsigned)(R * K + C) * 2u; voffB[i] = (unsigned)(Rb * K + C) * 2u; }
    const size_t kstep = (size_t)(BK * 2);
    const size_t hstep = (size_t)HALF * K * 2;
    const size_t tstep = 2 * hstep;
    const unsigned ldsw = (unsigned)wid * 1024u;
    const int aoff = lds_byte(wr * 64 + fr, fq * 8), boff = lds_byte(wc * 32 + fr, fq * 8);
#define PG8_SA(b, h) (((b) * 2 + (h)) * HTB)
#define PG8_SB(b, h) ((4 + (b) * 2 + (h)) * HTB)
#define PG8_STAGE(bufoff, gbase, voff) do { _Pragma("unroll") for (int _i = 0; _i < 2; ++_i) \
        __builtin_amdgcn_global_load_lds((const unsigned*)((const char*)(gbase) + (voff)[_i]), (LAS unsigned*)(lds + (bufoff) + ldsw + _i * 8192), 16, 0, 0); } while (0)
#define PG8_LDA(dst, b, h) do { _Pragma("unroll") for (int m = 0; m < 4; ++m) _Pragma("unroll") for (int k = 0; k < 2; ++k) dst[m][k] = *(const LAS bf16x8*)(lds + PG8_SA(b, h) + aoff + m * 2048 + k * 1024); } while (0)
#define PG8_LDB(dst, b, h) do { _Pragma("unroll") for (int n = 0; n < 2; ++n) _Pragma("unroll") for (int k = 0; k < 2; ++k) dst[n][k] = *(const LAS bf16x8*)(lds + PG8_SB(b, h) + boff + n * 2048 + k * 1024); } while (0)
#define PG8_MMA(ai, bj, At, Bt) do { __builtin_amdgcn_s_setprio(1); _Pragma("unroll") for (int m = 0; m < 4; ++m) _Pragma("unroll") for (int n = 0; n < 2; ++n) _Pragma("unroll") for (int k = 0; k < 2; ++k) \
        acc[ai][bj][m][n] = __builtin_amdgcn_mfma_f32_16x16x32_bf16(Bt[n][k], At[m][k], acc[ai][bj][m][n], 0, 0, 0); __builtin_amdgcn_s_setprio(0); } while (0)
#define PG8_WAIT_V(n) asm volatile("s_waitcnt vmcnt(" #n ")" ::: "memory")
#define PG8_WAIT_L(n) asm volatile("s_waitcnt lgkmcnt(" #n ")" ::: "memory")
#define PG8_BAR __builtin_amdgcn_s_barrier()
#define PG8_SCHED __builtin_amdgcn_sched_barrier(0)
    Unit cur, nxt; int ui = 0;
    if (!S.next(0, cur)) return;
    f32x4 acc[2][2][4][2];
#pragma unroll
    for (int a = 0; a < 2; ++a)
#pragma unroll
        for (int b = 0; b < 2; ++b)
#pragma unroll
            for (int m = 0; m < 4; ++m)
#pragma unroll
                for (int n = 0; n < 2; ++n) acc[a][b][m][n] = (f32x4){0.f, 0.f, 0.f, 0.f};
    bf16x8 At[4][2], B0[2][2], B1[2][2];
    const long atstep = (long)g.a_rows * K * 2, aorg = (long)g.a_row0 * K * 2;
    const char* cA = (const char*)g.A + aorg + (long)cur.pm * atstep; const char* cB = (const char*)g.Bt + (size_t)cur.pn * tstep;
    if constexpr (SP2) {
        PG8_STAGE(PG8_SB(0, 0), cB, voffB); PG8_STAGE(PG8_SB(0, 1), cB + hstep, voffB); PG8_STAGE(PG8_SA(0, 0), cA, voffA); PG8_STAGE(PG8_SA(0, 1), cA + hstep, voffA);
        if (wr == 1) PG8_BAR;
        PG8_WAIT_V(2); PG8_BAR;
        PG8_STAGE(PG8_SB(1, 0), cB + kstep, voffB); PG8_STAGE(PG8_SA(1, 0), cA + kstep, voffA); PG8_STAGE(PG8_SB(1, 1), cB + hstep + kstep, voffB);
        PG8_WAIT_V(6); PG8_BAR;
    } else {
        PG8_STAGE(PG8_SB(0, 0), cB, voffB); PG8_STAGE(PG8_SA(0, 0), cA, voffA); PG8_STAGE(PG8_SB(0, 1), cB + hstep, voffB); PG8_STAGE(PG8_SA(0, 1), cA + hstep, voffA);
        if (wr == 1) PG8_BAR;
        PG8_WAIT_V(4); PG8_BAR;
        PG8_STAGE(PG8_SB(1, 0), cB + kstep, voffB); PG8_STAGE(PG8_SA(1, 0), cA + kstep, voffA); PG8_STAGE(PG8_SB(1, 1), cB + hstep + kstep, voffB);
        PG8_WAIT_V(6); PG8_BAR;
    }
    for (;;) {
        const bool has_next = S.next(ui + 1, nxt);
        const char* nA = has_next ? (const char*)g.A + aorg + (long)nxt.pm * atstep : cA; const char* nB = has_next ? (const char*)g.Bt + (size_t)nxt.pn * tstep : cB;
        for (int t = 0; t < nt; t += 2) {
            const bool last = (t == nt - 2);
            const char* a1 = cA + (size_t)(t + 1) * kstep;
            const char* a2 = last ? nA : cA + (size_t)(t + 2) * kstep; const char* b2 = last ? nB : cB + (size_t)(t + 2) * kstep;
            const char* a3 = a2 + kstep; const char* b3 = b2 + kstep;
            if constexpr (SP2) {
            PG8_LDB(B0, 0, 0); PG8_LDB(B1, 0, 1); PG8_SCHED; PG8_LDA(At, 0, 0); PG8_STAGE(PG8_SA(1, 1), a1 + hstep, voffA);
            PG8_WAIT_V(8); PG8_WAIT_L(0); PG8_BAR; PG8_MMA(0, 0, At, B0); PG8_MMA(0, 1, At, B1); PG8_BAR; PG8_SCHED;
            PG8_LDA(At, 0, 1); PG8_STAGE(PG8_SB(0, 0), b2, voffB); PG8_STAGE(PG8_SB(0, 1), b2 + hstep, voffB); PG8_STAGE(PG8_SA(0, 0), a2, voffA);
            PG8_WAIT_V(8); PG8_WAIT_L(0); PG8_BAR; PG8_MMA(1, 0, At, B0); PG8_MMA(1, 1, At, B1); PG8_BAR; PG8_SCHED;
            PG8_LDB(B0, 1, 0); PG8_LDB(B1, 1, 1); PG8_SCHED; PG8_LDA(At, 1, 0); PG8_STAGE(PG8_SA(0, 1), a2 + hstep, voffA);
            PG8_WAIT_V(8); PG8_WAIT_L(0); PG8_BAR; PG8_MMA(0, 0, At, B0); PG8_MMA(0, 1, At, B1); PG8_BAR; PG8_SCHED;
            PG8_LDA(At, 1, 1); PG8_STAGE(PG8_SB(1, 0), b3, voffB); PG8_STAGE(PG8_SB(1, 1), b3 + hstep, voffB); PG8_STAGE(PG8_SA(1, 0), a3, voffA);
            PG8_WAIT_V(8); PG8_WAIT_L(0); PG8_BAR; PG8_MMA(1, 0, At, B0); PG8_MMA(1, 1, At, B1); PG8_BAR; PG8_SCHED;
            } else {
            PG8_LDB(B0, 0, 0); PG8_SCHED; PG8_LDA(At, 0, 0); PG8_STAGE(PG8_SA(1, 1), a1 + hstep, voffA);
            PG8_WAIT_L(8); PG8_BAR; PG8_WAIT_L(0); PG8_MMA(0, 0, At, B0); PG8_BAR; PG8_SCHED;
            PG8_LDB(B1, 0, 1); PG8_STAGE(PG8_SB(0, 0), b2, voffB);
            PG8_BAR; PG8_WAIT_L(0); PG8_MMA(0, 1, At, B1); PG8_BAR;
            PG8_LDA(At, 0, 1); PG8_STAGE(PG8_SA(0, 0), a2, voffA);
            PG8_BAR; PG8_WAIT_L(0); PG8_MMA(1, 0, At, B0); PG8_BAR; PG8_SCHED;
            PG8_STAGE(PG8_SB(0, 1), b2 + hstep, voffB);
            PG8_WAIT_V(6); PG8_BAR; PG8_MMA(1, 1, At, B1); PG8_BAR;
            PG8_LDB(B0, 1, 0); PG8_SCHED; PG8_LDA(At, 1, 0); PG8_STAGE(PG8_SA(0, 1), a2 + hstep, voffA);
            PG8_WAIT_L(8); PG8_BAR; PG8_WAIT_L(0); PG8_MMA(0, 0, At, B0); PG8_BAR; PG8_SCHED;
            PG8_LDB(B1, 1, 1); PG8_STAGE(PG8_SB(1, 0), b3, voffB);
            PG8_BAR; PG8_WAIT_L(0); PG8_MMA(0, 1, At, B1); PG8_BAR;
            PG8_LDA(At, 1, 1); PG8_STAGE(PG8_SA(1, 0), a3, voffA);
            PG8_BAR; PG8_WAIT_L(0); PG8_MMA(1, 0, At, B0); PG8_BAR; PG8_SCHED;
            PG8_STAGE(PG8_SB(1, 1), b3 + hstep, voffB);
            PG8_WAIT_V(6); PG8_BAR; PG8_MMA(1, 1, At, B1); PG8_BAR;
            }
        }
        if constexpr (ALIGN_EPI) { if (wr == 0) PG8_BAR; }
        { int fr_ = fr, fq_ = fq; asm volatile("" : "+v"(fr_), "+v"(fq_)); E(acc, cur, wr, wc, fr_, fq_); }
        if (!has_next) break;
#pragma unroll
        for (int a = 0; a < 2; ++a)
#pragma unroll
            for (int b = 0; b < 2; ++b)
#pragma unroll
                for (int m = 0; m < 4; ++m)
#pragma unroll
                    for (int n = 0; n < 2; ++n) acc[a][b][m][n] = (f32x4){0.f, 0.f, 0.f, 0.f};
        cur = nxt; cA = nA; cB = nB; ++ui;
        if constexpr (ALIGN_EPI) { if (wr == 1) PG8_BAR; }
    }
    PG8_WAIT_V(0);
    if constexpr (!ALIGN_EPI) { if (wr == 0) PG8_BAR; }
    PG8_BAR;
#undef PG8_SA
#undef PG8_SB
#undef PG8_STAGE
#undef PG8_LDA
#undef PG8_LDB
#undef PG8_MMA
#undef PG8_WAIT_V
#undef PG8_WAIT_L
#undef PG8_BAR
#undef PG8_SCHED
}
}
using pg8::Unit;
typedef f32x4 AccT[2][2][4][2];

struct EpiQKV {
    static constexpr bool PERM = true;
    unsigned char* ws;
    __device__ __forceinline__ void operator()(const AccT& acc, const Unit& u, int wr, int wc, int fr, int fq) const {
        const int row0 = u.pm * 256 + wr * 64 + fr, kind = u.pn >> 3, colt = (u.pn & 7) * 256 + wc * 32 + 8 * fq;
        if (kind == 0) {
            bf16_t* base = (bf16_t*)(ws + WS_Q);
#pragma unroll
            for (int ai = 0; ai < 2; ++ai)
#pragma unroll
                for (int m = 0; m < 4; ++m) { bf16_t* rowp = base + (size_t)(row0 + ai * 128 + m * 16) * DM + colt;
#pragma unroll
                    for (int bj = 0; bj < 2; ++bj) { const f32x4 v0 = acc[ai][bj][m][0] * QSCALE, v1 = acc[ai][bj][m][1] * QSCALE;
                        u32x4 w; w.x = pk2(v0[0], v0[1]); w.y = pk2(v0[2], v0[3]); w.z = pk2(v1[0], v1[1]); w.w = pk2(v1[2], v1[3]);
                        *(u32x4*)(rowp + bj * 128) = w; } }
        } else if (kind == 1) {
            bf16_t* KF = (bf16_t*)(ws + WS_K);
#pragma unroll
            for (int ai = 0; ai < 2; ++ai)
#pragma unroll
                for (int m = 0; m < 4; ++m) { const int row = row0 + ai * 128 + m * 16, b = row >> 11, st = row & 2047;
#pragma unroll
                    for (int bj = 0; bj < 2; ++bj) { const int c0 = colt + bj * 128, h = c0 >> 7, d0 = c0 & 127;
                        const size_t idx = ((((size_t)(b * NH + h) * 64 + (st >> 5)) * 8 + (d0 >> 4)) * 64 + (st & 31) + 32 * ((d0 >> 3) & 1)) * 8;
                        const f32x4 v0 = acc[ai][bj][m][0], v1 = acc[ai][bj][m][1];
                        u32x4 w; w.x = pk2(v0[0], v0[1]); w.y = pk2(v0[2], v0[3]); w.z = pk2(v1[0], v1[1]); w.w = pk2(v1[2], v1[3]);
                        *(u32x4*)(KF + idx) = w; } }
        } else {
            bf16_t* VF = (bf16_t*)(ws + WS_VT);
#pragma unroll
            for (int ai = 0; ai < 2; ++ai)
#pragma unroll
                for (int m = 0; m < 4; ++m) { const int row = row0 + ai * 128 + m * 16, b = row >> 11, st = row & 2047, k32 = st & 31, kk = k32 & 15;
                    const int slot = 4 * (kk >> 3) + (kk & 3), lhi = 32 * ((kk >> 2) & 1), s2 = k32 >> 4;
#pragma unroll
                    for (int bj = 0; bj < 2; ++bj) { const int c0 = colt + bj * 128, h = c0 >> 7, d0 = c0 & 127;
                        bf16_t* p = VF + (((((size_t)(b * NH + h) * 64 + (st >> 5)) * 4 + (d0 >> 5)) * 2 + s2) * 64 + (d0 & 31) + lhi) * 8 + slot;
#pragma unroll
                        for (int n = 0; n < 2; ++n)
#pragma unroll
                            for (int j = 0; j < 4; ++j) p[(4 * n + j) * 8] = f2bf(acc[ai][bj][m][n][j]); } }
        }
    }
};
template <bool RES_F32, bool OUT_F32>
struct EpiRes {
    static constexpr bool PERM = true;
    const void* res; void* out; float* part;
    __device__ __forceinline__ void operator()(const AccT& acc, const Unit& u, int wr, int wc, int fr, int fq) const {
        const int row0 = u.pm * 256 + wr * 64 + fr, col0 = u.pn * 256 + wc * 32 + 8 * fq;
        f32x4 rf[2][4]; u32x4 rh[2][2];
#define ER_LOAD(buf, g) do { const size_t off_ = (size_t)(row0 + ((g) >> 2) * 128 + ((g) & 3) * 16) * DM + col0; \
            if (RES_F32) { const float* r_ = (const float*)res; rf[buf][0] = *(const f32x4*)(r_ + off_); rf[buf][1] = *(const f32x4*)(r_ + off_ + 4); rf[buf][2] = *(const f32x4*)(r_ + off_ + 128); rf[buf][3] = *(const f32x4*)(r_ + off_ + 132); } \
            else { const bf16_t* r_ = (const bf16_t*)res; rh[buf][0] = *(const u32x4*)(r_ + off_); rh[buf][1] = *(const u32x4*)(r_ + off_ + 128); } } while (0)
        ER_LOAD(0, 0);
#pragma unroll
        for (int g = 0; g < 8; ++g) {
            const int ai = g >> 2, m = g & 3, cur = g & 1;
            if (g + 1 < 8) ER_LOAD(cur ^ 1, g + 1);
            const int row = row0 + ai * 128 + m * 16; const size_t off = (size_t)row * DM + col0; float ss = 0.f;
#pragma unroll
            for (int bj = 0; bj < 2; ++bj) {
                f32x4 r0, r1;
                if (RES_F32) { r0 = rf[cur][2 * bj]; r1 = rf[cur][2 * bj + 1]; }
                else { const u32x4 h = rh[cur][bj];
                    r0 = (f32x4){__uint_as_float(h.x << 16), __uint_as_float(h.x & 0xffff0000u), __uint_as_float(h.y << 16), __uint_as_float(h.y & 0xffff0000u)};
                    r1 = (f32x4){__uint_as_float(h.z << 16), __uint_as_float(h.z & 0xffff0000u), __uint_as_float(h.w << 16), __uint_as_float(h.w & 0xffff0000u)}; }
                const f32x4 v0 = acc[ai][bj][m][0] + r0, v1 = acc[ai][bj][m][1] + r1;
                if (OUT_F32) { float* o_ = (float*)out; *(f32x4*)(o_ + off + bj * 128) = v0; *(f32x4*)(o_ + off + bj * 128 + 4) = v1; }
                else { bf16_t* o_ = (bf16_t*)out; u32x4 w; w.x = pk2(v0[0], v0[1]); w.y = pk2(v0[2], v0[3]); w.z = pk2(v1[0], v1[1]); w.w = pk2(v1[2], v1[3]); *(u32x4*)(o_ + off + bj * 128) = w; }
                ss += (v0[0] * v0[0] + v0[1] * v0[1]) + (v0[2] * v0[2] + v0[3] * v0[3]) + (v1[0] * v1[0] + v1[1] * v1[1]) + (v1[2] * v1[2] + v1[3] * v1[3]); }
            if (part) { ss += __shfl_xor(ss, 16); ss += __shfl_xor(ss, 32); if (fq == 0) part[(size_t)row * 32 + u.pn * 4 + wc] = ss; }
        }
#undef ER_LOAD
    }
};
struct EpiUp {
    static constexpr bool PERM = true;
    bf16_t* U; const float* part;
    __device__ __forceinline__ void operator()(const AccT& acc, const Unit& u, int wr, int wc, int fr, int fq) const {
        const int row0 = u.pm * 256 + wr * 64 + fr, col0 = u.pn * 256 + wc * 32 + 8 * fq;
#pragma unroll
        for (int ai = 0; ai < 2; ++ai)
#pragma unroll
            for (int m = 0; m < 4; ++m) { const int row = row0 + ai * 128 + m * 16; const float rs = row_rstd(part, row, fq); bf16_t* rowp = U + (size_t)row * NUP + col0;
#pragma unroll
                for (int bj = 0; bj < 2; ++bj) { const f32x4 v0 = acc[ai][bj][m][0] * rs, v1 = acc[ai][bj][m][1] * rs;
                    u32x4 w; w.x = pk2(v0[0], v0[1]); w.y = pk2(v0[2], v0[3]); w.z = pk2(v1[0], v1[1]); w.w = pk2(v1[2], v1[3]);
                    *(u32x4*)(rowp + bj * 128) = w; } }
    }
};
__device__ __forceinline__ float dpp_ror1(float v) { return __int_as_float(__builtin_amdgcn_update_dpp(0, __float_as_int(v), 0x121, 0xf, 0xf, false)); }
__device__ __forceinline__ float dpp_ror2(float v) { return __int_as_float(__builtin_amdgcn_update_dpp(0, __float_as_int(v), 0x122, 0xf, 0xf, false)); }
struct EpiUpConv {
    static constexpr bool PERM = true;
    bf16_t* ACT; const float* part; const float* cw; const float* cb; LAS float* hal;
    __device__ __forceinline__ void operator()(AccT& acc, const Unit& u, int wr, int wc, int fr, int fq) const {
        const int grow0 = 254 * u.pm - 2 + wr * 64 + fr;
#pragma unroll
        for (int ai = 0; ai < 2; ++ai)
#pragma unroll
            for (int m = 0; m < 4; ++m) { const int grow = grow0 + ai * 128 + m * 16; const int rowc = grow < 0 ? 0 : (grow >= MTOK ? MTOK - 1 : grow);
                const float rs = row_rstd(part, rowc, fq);
#pragma unroll
                for (int bj = 0; bj < 2; ++bj) { acc[ai][bj][m][0] *= rs; acc[ai][bj][m][1] *= rs; } }
        const int colw = wc * 32 + 8 * fq;
        if (fr >= 14) {
#pragma unroll
            for (int ai = 0; ai < 2; ++ai)
#pragma unroll
                for (int bj = 0; bj < 2; ++bj)
#pragma unroll
                    for (int n = 0; n < 2; ++n) *(LAS f32x4*)(hal + ((ai * 2 + wr) * 2 + (fr - 14)) * 256 + bj * 128 + colw + 4 * n) = acc[ai][bj][3][n];
        }
        asm volatile("s_waitcnt lgkmcnt(0)" ::: "memory"); __builtin_amdgcn_s_barrier(); asm volatile("" ::: "memory");
#pragma unroll
        for (int n = 0; n < 2; ++n) {
            const int ch = u.pn * 128 + colw + 4 * n;
            f32x4 w[2][3], bb[2];
#pragma unroll
            for (int bj = 0; bj < 2; ++bj) { bb[bj] = *(const f32x4*)(cb + bj * FF + ch);
#pragma unroll
                for (int t = 0; t < 3; ++t) w[bj][t] = *(const f32x4*)(cw + (size_t)t * NUP + bj * FF + ch); }
#pragma unroll
            for (int ai = 0; ai < 2; ++ai)
#pragma unroll
                for (int m = 0; m < 4; ++m) {
                    const int lrow = ai * 128 + wr * 64 + m * 16 + fr, grow = 254 * u.pm - 2 + lrow, pos = grow & 2047;
                    f32x4 cv[2];
#pragma unroll
                    for (int bj = 0; bj < 2; ++bj) {
                        const f32x4 cur = acc[ai][bj][m][n];
                        f32x4 q1, q2;
                        if (m > 0) { const f32x4 pv = acc[ai][bj][m - 1][n];
#pragma unroll
                            for (int e = 0; e < 4; ++e) { q1[e] = dpp_ror1(pv[e]); q2[e] = dpp_ror2(pv[e]); } }
                        else { const int slab = ai * 2 + wr - 1; f32x4 h1 = (f32x4){0.f, 0.f, 0.f, 0.f}, h2 = h1;
                            if (slab >= 0) { h1 = *(const LAS f32x4*)(hal + (slab * 2 + 1) * 256 + bj * 128 + colw + 4 * n); h2 = *(const LAS f32x4*)(hal + (slab * 2) * 256 + bj * 128 + colw + 4 * n); }
                            q1 = h1; q2 = (fr == 1) ? h1 : h2; }
                        f32x4 c = bb[bj];
#pragma unroll
                        for (int e = 0; e < 4; ++e) { const float r1 = dpp_ror1(cur[e]), r2 = dpp_ror2(cur[e]);
                            const float p1 = fr >= 1 ? r1 : q1[e], p2 = fr >= 2 ? r2 : q2[e];
                            float v = c[e] + w[bj][2][e] * cur[e];
                            if (pos >= 1) v += w[bj][1][e] * p1;
                            if (pos >= 2) v += w[bj][0][e] * p2;
                            c[e] = v; }
                        cv[bj] = c;
                    }
                    float a4[4];
#pragma unroll
                    for (int e = 0; e < 4; ++e) { const float gx = cv[0][e]; a4[e] = gx * __builtin_amdgcn_rcpf(1.0f + __expf(-gx)) * cv[1][e]; }
                    if (lrow >= 2 && grow < MTOK) { u32x2 o; o.x = pk2(a4[0], a4[1]); o.y = pk2(a4[2], a4[3]); *(u32x2*)(ACT + (size_t)grow * FF + ch) = o; }
                }
        }
    }
};
struct EpiDsaIn {
    static constexpr bool PERM = false;
    unsigned char* ws; LAS float* scr;
    __device__ __forceinline__ void operator()(const AccT& acc_in, const Unit& u, int wr, int wc, int fr, int fq) const {
        const int row0 = u.pm * 256 + wr * 64 + fr;
        const float* part = (const float*)(ws + WS_PART); const float* ropeC = (const float*)(ws + WS_ROPE); const float* ropeS = ropeC + SEQ * 64;
        bf16_t* VTD = (bf16_t*)(ws + WS_VTD); float* WI = (float*)(ws + WS_WI);
        const bool need_norm = (u.pn < 10) || (u.pn == 20);
        float rs[2][4];
#pragma unroll
        for (int ai = 0; ai < 2; ++ai)
#pragma unroll
            for (int m = 0; m < 4; ++m) rs[ai][m] = row_rstd(part, row0 + ai * 128 + m * 16, fq);
        if (need_norm) {
#pragma unroll
            for (int ai = 0; ai < 2; ++ai)
#pragma unroll
                for (int m = 0; m < 4; ++m)
#pragma unroll
                    for (int bj = 0; bj < 2; ++bj) { const f32x4 a = acc_in[ai][bj][m][0], b = acc_in[ai][bj][m][1];
                        float ss = ((a[0] * a[0] + a[1] * a[1]) + (a[2] * a[2] + a[3] * a[3])) + ((b[0] * b[0] + b[1] * b[1]) + (b[2] * b[2] + b[3] * b[3]));
                        ss += __shfl_xor(ss, 16); ss += __shfl_xor(ss, 32);
                        if (fq == 0) scr[(ai * 128 + wr * 64 + m * 16 + fr) * 8 + bj * 4 + wc] = ss * rs[ai][m] * rs[ai][m]; }
            asm volatile("s_waitcnt lgkmcnt(0)" ::: "memory"); __builtin_amdgcn_s_barrier(); asm volatile("" ::: "memory");
        }
        const int dl = 16 * wc + 4 * fq;
#pragma unroll
        for (int bj = 0; bj < 2; ++bj) {
            const int hh = 2 * u.pn + bj;
            if (hh >= 20 && hh < 24) {
#pragma unroll
                for (int ai = 0; ai < 2; ++ai)
#pragma unroll
                    for (int m = 0; m < 4; ++m) { const int row = row0 + ai * 128 + m * 16, b = row >> 11, s = row & 2047; const float r = rs[ai][m];
                        bf16_t* p = VTD + ((size_t)(b * KVH + (hh - 20)) * HD + dl) * SEQ + s;
#pragma unroll
                        for (int n = 0; n < 2; ++n)
#pragma unroll
                            for (int e = 0; e < 4; ++e) p[(size_t)(64 * n + e) * SEQ] = f2bf(acc_in[ai][bj][m][n][e] * r); }
            } else if (hh == 41) {
                if (wc == 0) {
#pragma unroll
                    for (int ai = 0; ai < 2; ++ai)
#pragma unroll
                        for (int m = 0; m < 4; ++m) { const int row = row0 + ai * 128 + m * 16; *(f32x4*)(WI + (size_t)row * 16 + 4 * fq) = acc_in[ai][bj][m][0] * rs[ai][m]; } }
            } else {
                const bool norm = (hh < 20) || (hh == 40);
                const float* g = (const float*)(ws + WS_GAIN) + (hh < 16 ? 0 : (hh < 20 ? 128 : 256));
                f32x4 g0 = (f32x4){1.f, 1.f, 1.f, 1.f}, g1 = g0;
                if (norm) { g0 = *(const f32x4*)(g + dl); g1 = *(const f32x4*)(g + dl + 64); }
                size_t boff; int ld, cb;
                if (hh < 16) { boff = WS_Q; ld = DM; cb = hh * HD; } else if (hh < 20) { boff = WS_KD; ld = KVH * HD; cb = (hh - 16) * HD; }
                else if (hh < 40) { boff = WS_QI; ld = DM; cb = (hh - 24) * HD; } else { boff = WS_KI; ld = HD; cb = 0; }
                bf16_t* base = (bf16_t*)(ws + boff);
                const float osc = hh < 16 ? QSCALE : 1.0f;
#pragma unroll
                for (int ai = 0; ai < 2; ++ai)
#pragma unroll
                    for (int m = 0; m < 4; ++m) { const int lrow = ai * 128 + wr * 64 + m * 16 + fr, row = u.pm * 256 + lrow, pos = row & 2047;
                        float sc = rs[ai][m];
                        if (norm) { const f32x4 t = *(const LAS f32x4*)(scr + lrow * 8 + bj * 4); sc *= 1.0f / sqrtf(((t[0] + t[1]) + (t[2] + t[3])) * (1.0f / HD) + NORM_EPS); }
                        sc *= osc;
                        const f32x4 c = *(const f32x4*)(ropeC + pos * 64 + dl), sn = *(const f32x4*)(ropeS + pos * 64 + dl);
                        const f32x4 y0 = acc_in[ai][bj][m][0] * g0 * sc, y1 = acc_in[ai][bj][m][1] * g1 * sc;
                        const f32x4 o0 = y0 * c - y1 * sn, o1 = y1 * c + y0 * sn;
                        bf16_t* rp = base + (size_t)row * ld + cb + dl;
                        u32x2 w0, w1; w0.x = pk2(o0[0], o0[1]); w0.y = pk2(o0[2], o0[3]); w1.x = pk2(o1[0], o1[1]); w1.y = pk2(o1[2], o1[3]);
                        *(u32x2*)rp = w0; *(u32x2*)(rp + 64) = w1; }
            }
        }
    }
};

enum { WM_PLAIN = 0, WM_UP = 1, WM_IN = 2 };
__device__ __forceinline__ int colmap(int kind, int np) {
    if (kind == WM_UP) { const int pn = np >> 8, bj = (np >> 7) & 1, q = np & 127; return bj * FF + 128 * pn + q; }
    if (kind == WM_IN) { const int hh = np >> 7, p = np & 127, d = 16 * (p >> 5) + (p & 15) + 64 * ((p >> 4) & 1);
        if (hh < 41) return hh * 128 + d; return (p < 16) ? (5248 + p) : -1; }
    return np;
}
struct WJ { const float* W; const float* gain; bf16_t* WT; int K, N, NP, kind, local; };
__device__ __forceinline__ void tr_load(const WJ& j, int lane, f32x4 (&v)[16]) {
    const int nblk = j.NP / 64, kb = j.local / nblk, nb = j.local - kb * nblk, k0 = 64 * kb, n0 = 64 * nb;
    const int src = colmap(j.kind, n0 + 4 * (lane & 15)), rg = lane >> 4;
    const float* p = j.W + (size_t)(k0 + rg) * j.N + (src >= 0 ? src : 0);
#pragma unroll
    for (int i = 0; i < 16; ++i) { v[i] = *(const f32x4*)(p + (size_t)(4 * i) * j.N); if (src < 0) v[i] = (f32x4){0.f, 0.f, 0.f, 0.f}; }
}
__device__ __forceinline__ void tr_process(const WJ& j, int lane, const f32x4 (&v)[16], LAS float* scr) {
    const int nblk = j.NP / 64, kb = j.local / nblk, nb = j.local - kb * nblk, k0 = 64 * kb, n0 = 64 * nb;
    const int rg = lane >> 4, cg = lane & 15;
    float gl = 1.0f; if (j.gain) gl = j.gain[k0 + lane];
#pragma unroll
    for (int i = 0; i < 16; ++i) { const int kk = 4 * i + rg; const float g = __shfl(gl, kk); LAS float* d = scr + kk * 65 + 4 * cg;
        d[0] = v[i][0] * g; d[1] = v[i][1] * g; d[2] = v[i][2] * g; d[3] = v[i][3] * g; }
    asm volatile("s_waitcnt lgkmcnt(0)" ::: "memory");
    const int c = lane & 7;
#pragma unroll
    for (int jj = 0; jj < 8; ++jj) { const int n = (lane >> 3) + 8 * jj; const LAS float* s = scr + (8 * c) * 65 + n;
        u32x4 o; o.x = pk2(s[0 * 65], s[1 * 65]); o.y = pk2(s[2 * 65], s[3 * 65]); o.z = pk2(s[4 * 65], s[5 * 65]); o.w = pk2(s[6 * 65], s[7 * 65]);
        *(u32x4*)(j.WT + (size_t)(n0 + n) * j.K + k0 + 8 * c) = o; }
    asm volatile("s_waitcnt lgkmcnt(0)" ::: "memory");
}

struct Args {
    const float* x; const float* attn_g; const float* ffn_g; const float* w_qkv; const float* w_o0; const float* w_in;
    const float* qn_g; const float* kn_g; const float* ikn_g; const float* w_o1; const float* w_up; const float* conv_w; const float* conv_b; const float* w_down;
    float* out; unsigned char* ws; int ph_lo, ph_hi;
};

constexpr int WI0 = 32 * 96, WI1 = WI0 + 32 * 32, WI2 = WI1 + 32 * 84, WI3 = WI2 + 32 * 32, WI4 = WI3 + 32 * 176, WI5 = WI4 + 32 * 176, WI6 = WI5 + 88 * 32, WI7 = WI6 + 88 * 32;
__device__ __forceinline__ WJ wj_decode(const Args& a, int it) {
    unsigned char* ws = a.ws; WJ j;
    if (it < WI0)      j = WJ{a.w_qkv, nullptr, (bf16_t*)(ws + WS_WQKV), DM, NQKV, NQKV, WM_PLAIN, it};
    else if (it < WI1) j = WJ{a.w_o0, nullptr, (bf16_t*)(ws + WS_WO0), DM, DM, DM, WM_PLAIN, it - WI0};
    else if (it < WI2) j = WJ{a.w_in, a.attn_g + DM, (bf16_t*)(ws + WS_WIN), DM, NIN, NINP, WM_IN, it - WI1};
    else if (it < WI3) j = WJ{a.w_o1, nullptr, (bf16_t*)(ws + WS_WO1), DM, DM, DM, WM_PLAIN, it - WI2};
    else if (it < WI4) j = WJ{a.w_up, a.ffn_g, (bf16_t*)(ws + WS_WUP), DM, NUP, NUP, WM_UP, it - WI3};
    else if (it < WI5) j = WJ{a.w_up + (size_t)DM * NUP, a.ffn_g + DM, (bf16_t*)(ws + WS_WUP + 44 * MiB), DM, NUP, NUP, WM_UP, it - WI4};
    else if (it < WI6) j = WJ{a.w_down, nullptr, (bf16_t*)(ws + WS_WDN), FF, DM, DM, WM_PLAIN, it - WI5};
    else               j = WJ{a.w_down + (size_t)FF * DM, nullptr, (bf16_t*)(ws + WS_WDN + 22 * MiB), FF, DM, DM, WM_PLAIN, it - WI6};
    return j;
}
__device__ __forceinline__ void convert_items(const Args& a, LAS float* scr, int lo1, int hi1, int lo2, int hi2, int vw, int nvw, int lane) {
    const int n1 = hi1 - lo1, hi = n1 + (hi2 - lo2);
#define CV_ITEM(v) wj_decode(a, (v) < n1 ? lo1 + (v) : lo2 + ((v) - n1))
    int it = vw;
    if (it >= hi) return;
    f32x4 va[16], vb[16];
    WJ ja = CV_ITEM(it), jb = ja;
    tr_load(ja, lane, va);
#pragma nounroll
    for (;;) {
        int nx = it + nvw; bool hn = nx < hi;
        if (hn) { jb = CV_ITEM(nx); tr_load(jb, lane, vb); }
        tr_process(ja, lane, va, scr);
        if (!hn) break;
        it = nx; nx = it + nvw; hn = nx < hi;
        if (hn) { ja = CV_ITEM(nx); tr_load(ja, lane, va); }
        tr_process(jb, lane, vb, scr);
        if (!hn) break;
        it = nx;
    }
#undef CV_ITEM
}
struct Offload { int g_up, g_in; bool up0, in1, up1; };
__device__ __forceinline__ Offload make_offload(int G) {
    Offload o; const int u_up = 33 * (NUP / 256), u_in = (MTOK / 256) * (NINP / 256);
    const int r_up = (u_up + G - 1) / G, r_in = (u_in + G - 1) / G;
    o.g_up = (u_up + r_up - 1) / r_up; o.g_in = (u_in + r_in - 1) / r_in;
    o.up0 = (G - o.g_up) >= 8; o.up1 = o.up0; o.in1 = (G - o.g_in) >= 16;
    return o;
}
__device__ __forceinline__ void prologue_phase(const Args& a, LAS unsigned char* lds, int gw, int ngw, int wave, int lane, const Offload& offl) {
    unsigned char* ws = a.ws;
    LAS float* scr = (LAS float*)(lds + wave * 16640);
    convert_items(a, scr, 0, WI0, 0, 0, gw, ngw, lane);
    if (!offl.up0 || !offl.in1 || !offl.up1) {
        if (!offl.up0) convert_items(a, scr, WI5, WI6, WI2, WI3, gw, ngw, lane);
        if (!offl.in1) convert_items(a, scr, WI4, WI5, 0, 0, gw, ngw, lane);
        if (!offl.up1) convert_items(a, scr, WI6, WI7, 0, 0, gw, ngw, lane);
    }
    bf16_t* XB = (bf16_t*)(ws + WS_XB);
    for (int m = gw; m < MTOK; m += ngw) {
        const f32x4* xr = (const f32x4*)(a.x + (size_t)m * DM) + lane;
        f32x4 v[8]; float s = 0.f;
#pragma unroll
        for (int j = 0; j < 8; ++j) { v[j] = xr[64 * j]; s += (v[j].x * v[j].x + v[j].y * v[j].y) + (v[j].z * v[j].z + v[j].w * v[j].w); }
        const float rstd = 1.0f / sqrtf(wave_sum(s) * (1.0f / DM) + NORM_EPS);
        u32x2* o8 = (u32x2*)(XB + (size_t)m * DM) + lane;
#pragma unroll
        for (int j = 0; j < 8; ++j) { const f32x4 g = ((const f32x4*)a.attn_g)[lane + 64 * j]; u32x2 w; w.x = pk2(v[j].x * rstd * g.x, v[j].y * rstd * g.y); w.y = pk2(v[j].z * rstd * g.z, v[j].w * rstd * g.w); o8[64 * j] = w; }
    }
    if (gw == 0) { float* gn = (float*)(ws + WS_GAIN); for (int i = lane; i < 128; i += 64) { gn[i] = a.qn_g[i]; gn[128 + i] = a.kn_g[i]; gn[256 + i] = a.ikn_g[i]; } }
    float* rc = (float*)(ws + WS_ROPE); float* rsn = rc + SEQ * 64;
    for (int i = gw * 64 + lane; i < SEQ * 64; i += ngw * 64) {
        const int pos = i >> 6, fi = i & 63;
        const float inv_freq = (float)(1.0 / exp2((double)fi * (2.0 / 128.0) * 13.287712379549449));
        const float ang = (float)pos * inv_freq;
        const double x = (double)ang; const double kq = rint(x * 0.63661977236758134308);
        double r = __builtin_fma(-kq, 1.57079632679489655800e+00, x); r = __builtin_fma(-kq, 6.12323399573676603587e-17, r);
        const double r2 = r * r;
        double sp = -1.0 / 6227020800.0; sp = sp * r2 + 1.0 / 39916800.0; sp = sp * r2 - 1.0 / 362880.0; sp = sp * r2 + 1.0 / 5040.0; sp = sp * r2 - 1.0 / 120.0; sp = sp * r2 + 1.0 / 6.0; const double sv = r - r * r2 * sp;
        double cp = 1.0 / 87178291200.0; cp = cp * r2 - 1.0 / 479001600.0; cp = cp * r2 + 1.0 / 3628800.0; cp = cp * r2 - 1.0 / 40320.0; cp = cp * r2 + 1.0 / 720.0; cp = cp * r2 - 1.0 / 24.0; cp = cp * r2 + 0.5; const double cv = 1.0 - r2 * cp;
        const int q = ((int)kq) & 3;
        const double cs = (q == 0) ? cv : (q == 1) ? -sv : (q == 2) ? -cv : sv;
        const double sn = (q == 0) ? sv : (q == 1) ? cv : (q == 2) ? -sv : -cv;
        rc[i] = (float)cs; rsn[i] = (float)sn;
    }
}

constexpr float SB_EXIT = 220.0f;
__device__ __forceinline__ void sb_attn_phase(const bf16_t* __restrict__ Q, const bf16_t* __restrict__ K, const bf16_t* __restrict__ Vt, bf16_t* __restrict__ O, int gw, int ngw, int lane) {
    const int r = lane & 31, hh = lane >> 5;
    bf16x8 uf[2];
#pragma unroll
    for (int s2 = 0; s2 < 2; ++s2) { u32x4 w;
        unsigned e[8];
#pragma unroll
        for (int j = 0; j < 8; ++j) { const int key = 16 * s2 + 8 * (j >> 2) + 4 * hh + (j & 3); e[j] = (key >= r) ? 0x3f80u : 0u; }
        w.x = e[0] | (e[1] << 16); w.y = e[2] | (e[3] << 16); w.z = e[4] | (e[5] << 16); w.w = e[6] | (e[7] << 16); uf[s2] = __builtin_bit_cast(bf16x8, w); }
    for (int unit = gw; unit < BATCH * NH * 64; unit += ngw) {
        const int bh = unit >> 6, qt = 63 - (unit & 63), b = bh >> 4, h = bh & 15, q0 = qt * 32;
        const bf16_t* qp = Q + (size_t)(b * SEQ + q0 + r) * DM + h * HD + 8 * hh;
        bf16x8 qf[8];
#pragma unroll
        for (int s = 0; s < 8; ++s) qf[s] = *(const bf16x8*)(qp + 16 * s);
        f32x16 o[4];
#pragma unroll
        for (int d = 0; d < 4; ++d) o[d] = f32x16{};
        float carry = 0.f;
        const bf16_t* kbase = K + (size_t)(b * SEQ + r) * DM + h * HD + 8 * hh;
        const bf16_t* vbase = Vt + ((size_t)bh * HD + r) * SEQ + 4 * hh;
        for (int kt = qt; kt >= 0; --kt) {
            const int key0 = kt * 32;
            const bf16_t* kp = kbase + (size_t)key0 * DM;
            bf16x8 kf[8];
#pragma unroll
            for (int s = 0; s < 8; ++s) kf[s] = *(const bf16x8*)(kp + 16 * s);
            bf16x8 vf[4][2];
#pragma unroll
            for (int d = 0; d < 4; ++d)
#pragma unroll
                for (int s2 = 0; s2 < 2; ++s2) { const bf16_t* vp = vbase + (size_t)(32 * d) * SEQ + key0 + 16 * s2;
                    const s16x4 lo = *(const s16x4*)vp, hi = *(const s16x4*)(vp + 8);
                    vf[d][s2] = (bf16x8){lo[0], lo[1], lo[2], lo[3], hi[0], hi[1], hi[2], hi[3]}; }
            f32x16 p = f32x16{};
#pragma unroll
            for (int s = 0; s < 8; ++s) p = __builtin_amdgcn_mfma_f32_32x32x16_bf16(kf[s], qf[s], p, 0, 0, 0);
            const bool diag = (kt == qt);
            f32x16 sp;
#pragma unroll
            for (int i = 0; i < 16; ++i) { const float z = p[i]; float v = fmaxf(z, 0.f) + __builtin_amdgcn_logf(1.0f + __builtin_amdgcn_exp2f(-fabsf(z)));
                if (diag && crow(i, hh) >= r) v = 0.f; sp[i] = v; }
            f32x16 c;
#pragma unroll
            for (int i = 0; i < 16; ++i) c[i] = carry;
            c = __builtin_amdgcn_mfma_f32_32x32x16_bf16(uf[0], pack8(sp, 0), c, 0, 0, 0);
            c = __builtin_amdgcn_mfma_f32_32x32x16_bf16(uf[1], pack8(sp, 8), c, 0, 0, 0);
            f32x16 av;
#pragma unroll
            for (int i = 0; i < 16; ++i) { float v = __builtin_amdgcn_exp2f(p[i] - c[i]); if (diag && crow(i, hh) >= r) v = 0.f; av[i] = v; }
            carry = swap_max(c[0]);
            const bf16x8 pa0 = pack8(av, 0), pa1 = pack8(av, 8);
#pragma unroll
            for (int d = 0; d < 4; ++d) { o[d] = __builtin_amdgcn_mfma_f32_32x32x16_bf16(vf[d][0], pa0, o[d], 0, 0, 0); o[d] = __builtin_amdgcn_mfma_f32_32x32x16_bf16(vf[d][1], pa1, o[d], 0, 0, 0); }
            if (__all(carry > SB_EXIT)) break;
        }
        bf16_t* op = O + (size_t)(b * SEQ + q0 + r) * DM + h * HD + 4 * hh;
#pragma unroll
        for (int d = 0; d < 4; ++d)
#pragma unroll
            for (int g = 0; g < 4; ++g) { u32x2 w; w.x = pk2(o[d][4 * g], o[d][4 * g + 1]); w.y = pk2(o[d][4 * g + 2], o[d][4 * g + 3]); *(u32x2*)(op + 32 * d + 8 * g) = w; }
    }
}

__device__ __forceinline__ void conv_phase(const bf16_t* __restrict__ U, const float* __restrict__ cw, const float* __restrict__ cb, bf16_t* __restrict__ ACT, int gtid, int nthreads) {
    constexpr int C8 = FF / 8;
    for (int it = gtid; it < MTOK * C8; it += nthreads) {
        const int row = it / C8, c8 = it - row * C8, j0 = c8 * 8, pn = j0 >> 7, q = j0 & 127, s = row & 2047;
        const bf16_t* ug = U + (size_t)row * NUP + 256 * pn + q;
        float cgv[2][8];
#pragma unroll
        for (int half = 0; half < 2; ++half) {
            const bf16_t* up = ug + half * 128; const int cc = half * FF + j0;
            const f32x4 b0 = *(const f32x4*)(cb + cc), b1 = *(const f32x4*)(cb + cc + 4);
            float accv[8] = {b0[0], b0[1], b0[2], b0[3], b1[0], b1[1], b1[2], b1[3]};
#pragma unroll
            for (int tap = 0; tap < 3; ++tap) { const int back = 2 - tap;
                if (s >= back) { const u32x4 w = *(const u32x4*)(up - (size_t)back * NUP);
                    const f32x4 w0 = *(const f32x4*)(cw + (size_t)tap * NUP + cc), w1 = *(const f32x4*)(cw + (size_t)tap * NUP + cc + 4);
                    accv[0] += __uint_as_float(w.x << 16) * w0[0]; accv[1] += __uint_as_float(w.x & 0xffff0000u) * w0[1];
                    accv[2] += __uint_as_float(w.y << 16) * w0[2]; accv[3] += __uint_as_float(w.y & 0xffff0000u) * w0[3];
                    accv[4] += __uint_as_float(w.z << 16) * w1[0]; accv[5] += __uint_as_float(w.z & 0xffff0000u) * w1[1];
                    accv[6] += __uint_as_float(w.w << 16) * w1[2]; accv[7] += __uint_as_float(w.w & 0xffff0000u) * w1[3]; } }
#pragma unroll
            for (int e = 0; e < 8; ++e) cgv[half][e] = accv[e];
        }
        float a8[8];
#pragma unroll
        for (int e = 0; e < 8; ++e) { const float gx = cgv[0][e]; a8[e] = gx / (1.0f + __expf(-gx)) * cgv[1][e]; }
        u32x4 w; w.x = pk2(a8[0], a8[1]); w.y = pk2(a8[2], a8[3]); w.z = pk2(a8[4], a8[5]); w.w = pk2(a8[6], a8[7]);
        *(u32x4*)(ACT + (size_t)row * FF + j0) = w;
    }
}

__device__ __forceinline__ unsigned fmap(float f) { const unsigned u = __float_as_uint(f); return (u & 0x80000000u) ? ~u : (u | 0x80000000u); }
__device__ __forceinline__ void indexer_unit(const bf16_t* __restrict__ QI, const bf16_t* __restrict__ KI, const float* __restrict__ WI, unsigned* __restrict__ MASK, LAS float* sc, int b, int t0, int wave, int lane) {
    const int r = lane & 31, hh = lane >> 5, ql_r = r >> 4, head_r = r & 15;
    const int tw = t0 + 2 * wave;
    const bf16_t* ap = QI + (size_t)(b * SEQ + tw + ql_r) * DM + head_r * HD + 8 * hh;
    bf16x8 af[8];
#pragma unroll
    for (int s = 0; s < 8; ++s) af[s] = *(const bf16x8*)(ap + 16 * s);
    float wv[16];
#pragma unroll
    for (int i = 0; i < 16; ++i) { const int rw = crow(i, hh); wv[i] = WI[(size_t)(b * SEQ + tw + (rw >> 4)) * 16 + (rw & 15)]; }
    const int nkt = (t0 + 16 + 31) >> 5;
    const bf16_t* kb = KI + (size_t)(b * SEQ + r) * HD + 8 * hh;
    LAS float* myrow = sc + (2 * wave + hh) * SEQ;
    const int tq = tw + hh;
    for (int kt = 0; kt < nkt; ++kt) {
        const bf16_t* kp = kb + (size_t)kt * 32 * HD;
        bf16x8 bfr[8];
#pragma unroll
        for (int s = 0; s < 8; ++s) bfr[s] = *(const bf16x8*)(kp + 16 * s);
        f32x16 c = f32x16{};
#pragma unroll
        for (int s = 0; s < 8; ++s) c = __builtin_amdgcn_mfma_f32_32x32x16_bf16(af[s], bfr[s], c, 0, 0, 0);
        float s0 = 0.f, s1 = 0.f;
#pragma unroll
        for (int i = 0; i < 8; ++i) { s0 += wv[i] * relu_i(c[i]); s1 += wv[i + 8] * relu_i(c[i + 8]); }
        const float t0s = swap_sum(s0), t1s = swap_sum(s1);
        const int key = kt * 32 + r;
        float v = (hh ? t1s : t0s) + 0.0f;
        if (key > tq) v = -INFINITY;
        myrow[key] = v;
    }
    asm volatile("s_waitcnt lgkmcnt(0)" ::: "memory");
    for (int ql = 0; ql < 2; ++ql) {
        const int t = tw + ql, n = t + 1;
        unsigned* mrow = MASK + (size_t)(b * SEQ + t) * 64;
        if (n <= TOPK) {
            const int key0 = 32 * lane; unsigned w;
            if (key0 + 31 <= t) w = 0xffffffffu; else if (key0 > t) w = 0u; else w = (1u << (t - key0 + 1)) - 1u;
            mrow[lane] = w;
        } else {
            const LAS float* row = sc + (2 * wave + ql) * SEQ;
            unsigned uv[32];
#pragma unroll
            for (int e = 0; e < 32; ++e) { const int key = e * 64 + lane; uv[e] = (key < n) ? fmap(row[key]) : 0x007fffffu; }
            unsigned prefix = 0u;
            for (int bit = 31; bit >= 0; --bit) {
                const unsigned cand = prefix | (1u << bit); int cnt = 0;
#pragma unroll
                for (int e = 0; e < 32; ++e) cnt += __popcll(__ballot(uv[e] >= cand));
                if (cnt >= TOPK) prefix = cand;
            }
            int cgt = 0;
#pragma unroll
            for (int e = 0; e < 32; ++e) cgt += __popcll(__ballot(uv[e] > prefix));
            const int need = TOPK - cgt; int running = 0;
            const unsigned long long ltm = (1ull << lane) - 1ull;
            unsigned long long keep = 0ull;
#pragma unroll
            for (int e = 0; e < 32; ++e) {
                const unsigned long long eq = __ballot(uv[e] == prefix);
                const bool sel = (uv[e] > prefix) || (uv[e] == prefix && (running + __popcll(eq & ltm)) < need);
                const unsigned long long m64 = __ballot(sel);
                running += __popcll(eq);
                if (lane == e) keep = m64;
            }
            if (lane < 32) *(unsigned long long*)(mrow + 2 * lane) = keep;
        }
    }
    asm volatile("s_waitcnt lgkmcnt(0)" ::: "memory");
}

__device__ __forceinline__ void dsa_attn_unit(const bf16_t* __restrict__ QD, const bf16_t* __restrict__ KD, const bf16_t* __restrict__ VTD, const unsigned* __restrict__ MASK, bf16_t* __restrict__ O,
                                              int b, int g, int h, int q0, int lane) {
    const int r = lane & 31, hh = lane >> 5;
    const bf16_t* qp = QD + (size_t)(b * SEQ + q0 + r) * DM + h * HD + 8 * hh;
    bf16x8 qf[8];
#pragma unroll
    for (int s = 0; s < 8; ++s) qf[s] = *(const bf16x8*)(qp + 16 * s);
    f32x16 o[4];
#pragma unroll
    for (int d = 0; d < 4; ++d) o[d] = f32x16{};
    float mrun = -1e30f, lrun = 0.f;
    const bf16_t* kbase = KD + (size_t)(b * SEQ + r) * (KVH * HD) + g * HD + 8 * hh;
    const bf16_t* vbase = VTD + ((size_t)(b * KVH + g) * HD + r) * SEQ + 4 * hh;
    const unsigned* mrow = MASK + (size_t)(b * SEQ + q0 + r) * 64;
    const int nkt = (q0 + 32) >> 5;
    for (int kt = 0; kt < nkt; ++kt) {
        const int key0 = kt * 32;
        const bf16_t* kp = kbase + (size_t)key0 * (KVH * HD);
        bf16x8 kf[8];
#pragma unroll
        for (int s = 0; s < 8; ++s) kf[s] = *(const bf16x8*)(kp + 16 * s);
        const unsigned mw = mrow[kt];
        bf16x8 vf[4][2];
#pragma unroll
        for (int d = 0; d < 4; ++d)
#pragma unroll
            for (int s2 = 0; s2 < 2; ++s2) { const bf16_t* vp = vbase + (size_t)(32 * d) * SEQ + key0 + 16 * s2;
                const s16x4 lo = *(const s16x4*)vp, hi = *(const s16x4*)(vp + 8);
                vf[d][s2] = (bf16x8){lo[0], lo[1], lo[2], lo[3], hi[0], hi[1], hi[2], hi[3]}; }
        f32x16 p = f32x16{};
#pragma unroll
        for (int s = 0; s < 8; ++s) p = __builtin_amdgcn_mfma_f32_32x32x16_bf16(kf[s], qf[s], p, 0, 0, 0);
        float tmax = -1e30f;
#pragma unroll
        for (int i = 0; i < 16; ++i) { const bool valid = (mw >> crow(i, hh)) & 1u; tmax = fmaxf(tmax, valid ? p[i] : -1e30f); }
        tmax = swap_max(tmax);
        const float mnew = fmaxf(mrun, tmax), alpha = __builtin_amdgcn_exp2f(mrun - mnew);
        float ls = 0.f; f32x16 pe;
#pragma unroll
        for (int i = 0; i < 16; ++i) { const bool valid = (mw >> crow(i, hh)) & 1u; const float e = valid ? __builtin_amdgcn_exp2f(p[i] - mnew) : 0.f; pe[i] = e; ls += e; }
        lrun = lrun * alpha + ls; mrun = mnew;
#pragma unroll
        for (int d = 0; d < 4; ++d)
#pragma unroll
            for (int i = 0; i < 16; ++i) o[d][i] *= alpha;
        const bf16x8 pa0 = pack8(pe, 0), pa1 = pack8(pe, 8);
#pragma unroll
        for (int d = 0; d < 4; ++d) { o[d] = __builtin_amdgcn_mfma_f32_32x32x16_bf16(vf[d][0], pa0, o[d], 0, 0, 0); o[d] = __builtin_amdgcn_mfma_f32_32x32x16_bf16(vf[d][1], pa1, o[d], 0, 0, 0); }
    }
    const float linv = 1.0f / swap_sum(lrun);
    bf16_t* op = O + (size_t)(b * SEQ + q0 + r) * DM + h * HD + 4 * hh;
#pragma unroll
    for (int d = 0; d < 4; ++d)
#pragma unroll
        for (int gq = 0; gq < 4; ++gq) { u32x2 w; w.x = pk2(o[d][4 * gq] * linv, o[d][4 * gq + 1] * linv); w.y = pk2(o[d][4 * gq + 2] * linv, o[d][4 * gq + 3] * linv); *(u32x2*)(op + 32 * d + 8 * gq) = w; }
}


constexpr int KSTR = 272, VSTR = 136, KTILE_B = 64 * KSTR, VTILE_B = 128 * VSTR, KVBUF_B = KTILE_B + VTILE_B;
struct KVStage {
    u32x4 k[2], v[2];
    __device__ __forceinline__ void load(const unsigned char* kg, size_t kstride, const unsigned char* vg, size_t vstride, int tid) {
#pragma unroll
        for (int i = 0; i < 2; ++i) { const int c = tid + 512 * i; k[i] = *(const u32x4*)(kg + (size_t)(c >> 4) * kstride + (c & 15) * 16); v[i] = *(const u32x4*)(vg + (size_t)(c >> 3) * vstride + (c & 7) * 16); }
    }
    __device__ __forceinline__ void store(LAS unsigned char* buf, int tid) const {
#pragma unroll
        for (int i = 0; i < 2; ++i) { const int c = tid + 512 * i;
            *(LAS u32x4*)(buf + (c >> 4) * KSTR + (c & 15) * 16) = k[i];
            LAS unsigned char* vp = buf + KTILE_B + (c >> 3) * VSTR + (c & 7) * 16;
            *(LAS u32x2*)vp = (u32x2){v[i].x, v[i].y}; *(LAS u32x2*)(vp + 8) = (u32x2){v[i].z, v[i].w}; }
    }
};

__device__ __forceinline__ void dsa_attn_block(const bf16_t* __restrict__ QD, const bf16_t* __restrict__ KD, const bf16_t* __restrict__ VTD, const unsigned* __restrict__ MASK, bf16_t* __restrict__ O,
                                               LAS unsigned char* lds, int b, int g, int qb64, int wave, int lane, int tid) {
    const int r = lane & 31, hh = lane >> 5, h = 4 * g + (wave & 3), q0 = 64 * qb64 + 32 * (wave >> 2);
    LAS unsigned char* qlds = lds + 2 * KVBUF_B + wave * (32 * KSTR);
    { const unsigned char* qg = (const unsigned char*)(QD + (size_t)(b * SEQ + q0) * DM + h * HD);
        u32x4 t[8];
#pragma unroll
        for (int i = 0; i < 8; ++i) { const int c = lane + 64 * i; t[i] = *(const u32x4*)(qg + (size_t)(c >> 4) * (DM * 2) + (c & 15) * 16); }
#pragma unroll
        for (int i = 0; i < 8; ++i) { const int c = lane + 64 * i; *(LAS u32x4*)(qlds + (c >> 4) * KSTR + (c & 15) * 16) = t[i]; }
        asm volatile("s_waitcnt lgkmcnt(0)" ::: "memory"); }
    const LAS unsigned char* qfp = qlds + r * KSTR + 16 * hh;
    f32x16 o[4];
#pragma unroll
    for (int d = 0; d < 4; ++d) o[d] = f32x16{};
    float mrun = -1e29f, lrun = 0.f;
    const unsigned char* kg = (const unsigned char*)(KD + (size_t)(b * SEQ) * (KVH * HD) + g * HD);
    const unsigned char* vg = (const unsigned char*)(VTD + (size_t)(b * KVH + g) * HD * SEQ);
    const unsigned long long* mrow = (const unsigned long long*)(MASK + (size_t)(b * SEQ + q0 + r) * 64);
    KVStage sA, sB;
#define MA_LOAD(ST, t) ST.load(kg + (size_t)(t) * 64 * (KVH * HD * 2), KVH * HD * 2, vg + (size_t)(t) * 64 * 2, SEQ * 2, tid)
    MA_LOAD(sA, 0);
    sA.store(lds, tid);
    asm volatile("s_waitcnt lgkmcnt(0)" ::: "memory"); __builtin_amdgcn_s_barrier(); asm volatile("" ::: "memory");
    if (qb64 >= 1) MA_LOAD(sA, 1);
    if (qb64 >= 2) MA_LOAD(sB, 2);
    unsigned long long mw_next = mrow[0];
    for (int kt = 0; kt <= qb64; ++kt) {
        LAS unsigned char* buf = lds + (kt & 1) * KVBUF_B;
        const unsigned long long mw = mw_next;
        if (kt < qb64) mw_next = mrow[kt + 1];
        const bool two = (64 * kt + 32) <= q0 + 31;
        f32x16 p0 = f32x16{}, p1 = f32x16{};
        { const LAS unsigned char* kp = buf + r * KSTR + 16 * hh;
            bf16x8 qf[8];
#pragma unroll
            for (int s = 0; s < 8; ++s) qf[s] = *(const LAS bf16x8*)(qfp + 32 * s);
#pragma unroll
            for (int s = 0; s < 8; ++s) p0 = __builtin_amdgcn_mfma_f32_32x32x16_bf16(*(const LAS bf16x8*)(kp + 32 * s), qf[s], p0, 0, 0, 0);
            if (two) {
#pragma unroll
                for (int s = 0; s < 8; ++s) p1 = __builtin_amdgcn_mfma_f32_32x32x16_bf16(*(const LAS bf16x8*)(kp + 32 * KSTR + 32 * s), qf[s], p1, 0, 0, 0); } }
        const int m0 = (int)(((unsigned)mw) >> (4 * hh)), m1 = two ? (int)(((unsigned)(mw >> 32)) >> (4 * hh)) : 0;
        const unsigned NEGB = 0xf149f2cau;
#pragma unroll
        for (int i = 0; i < 16; ++i) { const int kb = crow(i, 0);
            const unsigned t0 = (unsigned)((m0 << (31 - kb)) >> 31), t1 = (unsigned)((m1 << (31 - kb)) >> 31);
            p0[i] = __uint_as_float((__float_as_uint(p0[i]) & t0) | (NEGB & ~t0)); p1[i] = __uint_as_float((__float_as_uint(p1[i]) & t1) | (NEGB & ~t1)); }
        float tmax = fmaxf(p0[0], p1[0]);
#pragma unroll
        for (int i = 1; i < 16; ++i) tmax = fmaxf(fmaxf(tmax, p0[i]), p1[i]);
        tmax = swap_max(tmax);
        const float mnew = fmaxf(mrun, tmax);
        if (__any(mnew > mrun)) {
            const float alpha = __builtin_amdgcn_exp2f(mrun - mnew);
            lrun *= alpha;
#pragma unroll
            for (int d = 0; d < 4; ++d)
#pragma unroll
                for (int i = 0; i < 16; ++i) o[d][i] *= alpha;
        }
        float ls = 0.f;
#pragma unroll
        for (int i = 0; i < 16; ++i) { const float e0 = __builtin_amdgcn_exp2f(p0[i] - mnew), e1 = __builtin_amdgcn_exp2f(p1[i] - mnew); p0[i] = e0; p1[i] = e1; ls += e0 + e1; }
        lrun += ls; mrun = mnew;
        const bf16x8 pa0 = pack8(p0, 0), pa1 = pack8(p0, 8), pa2 = pack8(p1, 0), pa3 = pack8(p1, 8);
        const LAS unsigned char* vb = buf + KTILE_B + r * VSTR + 8 * hh;
#pragma unroll
        for (int d = 0; d < 4; ++d) {
            const LAS unsigned char* vp = vb + 32 * d * VSTR;
#define VFRAG(ks) ({ const s16x4 lo_ = *(const LAS s16x4*)(vp + 32 * (ks)), hi_ = *(const LAS s16x4*)(vp + 32 * (ks) + 16); (bf16x8){lo_[0], lo_[1], lo_[2], lo_[3], hi_[0], hi_[1], hi_[2], hi_[3]}; })
            o[d] = __builtin_amdgcn_mfma_f32_32x32x16_bf16(VFRAG(0), pa0, o[d], 0, 0, 0);
            o[d] = __builtin_amdgcn_mfma_f32_32x32x16_bf16(VFRAG(1), pa1, o[d], 0, 0, 0);
            if (two) { o[d] = __builtin_amdgcn_mfma_f32_32x32x16_bf16(VFRAG(2), pa2, o[d], 0, 0, 0);
                       o[d] = __builtin_amdgcn_mfma_f32_32x32x16_bf16(VFRAG(3), pa3, o[d], 0, 0, 0); }
#undef VFRAG
        }
        if (kt & 1) { if (kt + 1 <= qb64) sB.store(lds + ((kt + 1) & 1) * KVBUF_B, tid); if (kt + 3 <= qb64) MA_LOAD(sB, kt + 3); }
        else        { if (kt + 1 <= qb64) sA.store(lds + ((kt + 1) & 1) * KVBUF_B, tid); if (kt + 3 <= qb64) MA_LOAD(sA, kt + 3); }
        asm volatile("s_waitcnt lgkmcnt(0)" ::: "memory"); __builtin_amdgcn_s_barrier(); asm volatile("" ::: "memory");
    }
#undef MA_LOAD
    asm volatile("s_waitcnt vmcnt(0)" ::: "memory");
    const float linv = 1.0f / swap_sum(lrun);
    bf16_t* op = O + (size_t)(b * SEQ + q0 + r) * DM + h * HD + 4 * hh;
#pragma unroll
    for (int d = 0; d < 4; ++d)
#pragma unroll
        for (int gq = 0; gq < 4; ++gq) { u32x2 w; w.x = pk2(o[d][4 * gq] * linv, o[d][4 * gq + 1] * linv); w.y = pk2(o[d][4 * gq + 2] * linv, o[d][4 * gq + 3] * linv); *(u32x2*)(op + 32 * d + 8 * gq) = w; }
}


__device__ __forceinline__ void sb_subtile(const LAS unsigned char* kp, const LAS unsigned char* vb, const bf16x8 (&qf)[8], const bf16x8 (&uf)[2], f32x16 (&o)[4], float& carry, bool diag, int rm) {
    f32x16 p = f32x16{};
#pragma unroll
    for (int s = 0; s < 8; ++s) p = __builtin_amdgcn_mfma_f32_32x32x16_bf16(*(const LAS bf16x8*)(kp + 32 * s), qf[s], p, 0, 0, 0);
    f32x16 sp;
#pragma unroll
    for (int i = 0; i < 16; ++i) sp[i] = __builtin_amdgcn_logf(1.0f + __builtin_amdgcn_exp2f(fminf(p[i], 120.0f)));
    if (diag) {
#pragma unroll
        for (int i = 0; i < 16; ++i) if (crow(i, 0) >= rm) { sp[i] = 0.f; p[i] = -1e30f; } }
    f32x16 c;
#pragma unroll
    for (int i = 0; i < 16; ++i) c[i] = carry;
    c = __builtin_amdgcn_mfma_f32_32x32x16_bf16(uf[0], pack8(sp, 0), c, 0, 0, 0);
    c = __builtin_amdgcn_mfma_f32_32x32x16_bf16(uf[1], pack8(sp, 8), c, 0, 0, 0);
#pragma unroll
    for (int i = 0; i < 16; ++i) p[i] = __builtin_amdgcn_exp2f(p[i] - c[i]);
    carry = swap_max(c[0]);
    const bf16x8 pa0 = pack8(p, 0), pa1 = pack8(p, 8);
#pragma unroll
    for (int d = 0; d < 4; ++d) { const LAS unsigned char* vp = vb + 32 * d * VSTR;
        const s16x4 l0 = *(const LAS s16x4*)vp, h0 = *(const LAS s16x4*)(vp + 16), l1 = *(const LAS s16x4*)(vp + 32), h1 = *(const LAS s16x4*)(vp + 48);
        o[d] = __builtin_amdgcn_mfma_f32_32x32x16_bf16((bf16x8){l0[0], l0[1], l0[2], l0[3], h0[0], h0[1], h0[2], h0[3]}, pa0, o[d], 0, 0, 0);
        o[d] = __builtin_amdgcn_mfma_f32_32x32x16_bf16((bf16x8){l1[0], l1[1], l1[2], l1[3], h1[0], h1[1], h1[2], h1[3]}, pa1, o[d], 0, 0, 0); }
}
__device__ __forceinline__ void sb_attn_block(const bf16_t* __restrict__ Q, const bf16_t* __restrict__ K, const bf16_t* __restrict__ Vt, bf16_t* __restrict__ O, LAS unsigned char* lds,
                                              int bh, int qblk, int wave, int lane, int tid) {
    const int r = lane & 31, hh = lane >> 5, b = bh >> 4, h = bh & 15, q0 = qblk * 256 + wave * 32, rm = r - 4 * hh;
    bf16x8 uf[2];
#pragma unroll
    for (int s2 = 0; s2 < 2; ++s2) { u32x4 w; unsigned e[8];
#pragma unroll
        for (int j = 0; j < 8; ++j) { const int key = 16 * s2 + 8 * (j >> 2) + 4 * hh + (j & 3); e[j] = (key >= r) ? 0x3f80u : 0u; }
        w.x = e[0] | (e[1] << 16); w.y = e[2] | (e[3] << 16); w.z = e[4] | (e[5] << 16); w.w = e[6] | (e[7] << 16); uf[s2] = __builtin_bit_cast(bf16x8, w); }
    const bf16_t* qp = Q + (size_t)(b * SEQ + q0 + r) * DM + h * HD + 8 * hh;
    bf16x8 qf[8];
#pragma unroll
    for (int s = 0; s < 8; ++s) qf[s] = *(const bf16x8*)(qp + 16 * s);
    f32x16 o[4];
#pragma unroll
    for (int d = 0; d < 4; ++d) o[d] = f32x16{};
    float carry = 0.f; bool done = false;
    const unsigned char* kg = (const unsigned char*)(K + (size_t)(b * SEQ) * DM + h * HD);
    const unsigned char* vg = (const unsigned char*)(Vt + (size_t)bh * HD * SEQ);
    volatile LAS unsigned* flags = (volatile LAS unsigned*)(lds + 2 * KVBUF_B);
    const int ktop = qblk * 4 + 3;
    KVStage sA, sB;
#define SB_LOAD(ST, t) ST.load(kg + (size_t)(t) * 64 * (DM * 2), DM * 2, vg + (size_t)(t) * 64 * 2, SEQ * 2, tid)
    SB_LOAD(sA, ktop);
    sA.store(lds, tid);
    asm volatile("s_waitcnt lgkmcnt(0)" ::: "memory"); __builtin_amdgcn_s_barrier(); asm volatile("" ::: "memory");
    if (ktop >= 1) SB_LOAD(sA, ktop - 1);
    if (ktop >= 2) SB_LOAD(sB, ktop - 2);
    int kt = ktop, it = 0; bool fin = false;
#define SB_STEP(ST) do { \
        const LAS unsigned char* buf = lds + (it & 1) * KVBUF_B; \
        if (!done) { \
            _Pragma("unroll") for (int j = 1; j >= 0; --j) { const int key0 = 64 * kt + 32 * j; \
                if (!done && key0 <= q0) { \
                    sb_subtile(buf + (32 * j + r) * KSTR + 16 * hh, buf + KTILE_B + r * VSTR + 64 * j + 8 * hh, qf, uf, o, carry, key0 == q0, rm); \
                    if (__all(carry > SB_EXIT)) done = true; } } } \
        if (kt >= 1) ST.store(lds + ((it + 1) & 1) * KVBUF_B, tid); \
        if (kt >= 3) SB_LOAD(ST, kt - 3); \
        if (lane == 0) flags[wave] = done ? 1u : 0u; \
        asm volatile("s_waitcnt lgkmcnt(0)" ::: "memory"); __builtin_amdgcn_s_barrier(); asm volatile("" ::: "memory"); \
        if (kt == 0) fin = true; \
        else { unsigned nd = 0; _Pragma("unroll") for (int w = 0; w < 8; ++w) nd += flags[w]; if (nd == 8u) fin = true; } \
        --kt; ++it; } while (0)
    for (;;) { SB_STEP(sA); if (fin) break; SB_STEP(sB); if (fin) break; }
#undef SB_STEP
#undef SB_LOAD
    asm volatile("s_waitcnt vmcnt(0)" ::: "memory");
    bf16_t* op = O + (size_t)(b * SEQ + q0 + r) * DM + h * HD + 4 * hh;
#pragma unroll
    for (int d = 0; d < 4; ++d)
#pragma unroll
        for (int g = 0; g < 4; ++g) { u32x2 w; w.x = pk2(o[d][4 * g], o[d][4 * g + 1]); w.y = pk2(o[d][4 * g + 2], o[d][4 * g + 3]); *(u32x2*)(op + 32 * d + 8 * g) = w; }
}


__device__ __forceinline__ unsigned wave_total_u32(unsigned v) {
    v += (unsigned)__builtin_amdgcn_update_dpp(0, (int)v, 0x111, 0xf, 0xf, true);
    v += (unsigned)__builtin_amdgcn_update_dpp(0, (int)v, 0x112, 0xf, 0xf, true);
    v += (unsigned)__builtin_amdgcn_update_dpp(0, (int)v, 0x114, 0xf, 0xf, true);
    v += (unsigned)__builtin_amdgcn_update_dpp(0, (int)v, 0x118, 0xf, 0xf, true);
    v += (unsigned)__builtin_amdgcn_update_dpp(0, (int)v, 0x142, 0xa, 0xf, false);
    v += (unsigned)__builtin_amdgcn_update_dpp(0, (int)v, 0x143, 0xc, 0xf, false);
    return (unsigned)__builtin_amdgcn_readlane((int)v, 63);
}
__device__ __forceinline__ void causal_mask_row(unsigned* mrow, int t, int lane) {
    const int key0 = 32 * lane; unsigned w;
    if (key0 + 31 <= t) w = 0xffffffffu; else if (key0 > t) w = 0u; else w = (1u << (t - key0 + 1)) - 1u;
    mrow[lane] = w;
}
__device__ __forceinline__ void write_topk_mask(const unsigned (&uv)[32], unsigned prefix, unsigned* mrow, int lane) {
    int cgt = 0;
#pragma unroll
    for (int e = 0; e < 32; ++e) cgt += __popcll(__ballot(uv[e] > prefix));
    const int need = TOPK - cgt; int running = 0;
    const unsigned long long ltm = (1ull << lane) - 1ull;
    unsigned long long keep = 0ull;
#pragma unroll
    for (int e = 0; e < 32; ++e) {
        const unsigned long long eq = __ballot(uv[e] == prefix);
        const bool sel = (uv[e] > prefix) || (uv[e] == prefix && (running + __popcll(eq & ltm)) < need);
        const unsigned long long m64 = __ballot(sel);
        running += __popcll(eq);
        if (lane == e) keep = m64;
    }
    if (lane < 32) *(unsigned long long*)(mrow + 2 * lane) = keep;
}
__device__ __forceinline__ void select_two(const float* rowa, const float* rowb, int ta, unsigned* mrowa, unsigned* mrowb, int lane) {
    const int tb = ta + 1, na = ta + 1, nb = tb + 1;
    if (nb <= TOPK) { causal_mask_row(mrowa, ta, lane); causal_mask_row(mrowb, tb, lane); return; }
    float fa[32], fb[32];
#pragma unroll
    for (int e = 0; e < 32; ++e) { fa[e] = __builtin_nontemporal_load(rowa + e * 64 + lane); fb[e] = __builtin_nontemporal_load(rowb + e * 64 + lane); }
    unsigned ua[32], ub[32];
#pragma unroll
    for (int e = 0; e < 32; ++e) { const int key = e * 64 + lane; const unsigned ma = fmap(fa[e]), mb = fmap(fb[e]); ua[e] = (key < na) ? ma : 0x007fffffu; ub[e] = (key < nb) ? mb : 0x007fffffu; }
    unsigned pa = 0u, pb = 0u; bool da = false, db = false;
    for (int bit = 31; bit >= 0; --bit) {
        const unsigned ca = pa | (1u << bit), cb = pb | (1u << bit);
        unsigned na_ = 0u, nb_ = 0u;
#pragma unroll
        for (int e = 0; e < 32; ++e) { na_ += (ua[e] >= ca) ? 1u : 0u; nb_ += (ub[e] >= cb) ? 1u : 0u; }
        const unsigned tota = wave_total_u32(na_), totb = wave_total_u32(nb_);
        if (!da && tota >= (unsigned)TOPK) { pa = ca; if (tota == (unsigned)TOPK) da = true; }
        if (!db && totb >= (unsigned)TOPK) { pb = cb; if (totb == (unsigned)TOPK) db = true; }
        if (da && db) break;
    }
    if (na <= TOPK) causal_mask_row(mrowa, ta, lane); else write_topk_mask(ua, pa, mrowa, lane);
    write_topk_mask(ub, pb, mrowb, lane);
}

struct KiStage {
    u32x4 k[4];
    __device__ __forceinline__ void load(const unsigned char* kg, int tid) {
#pragma unroll
        for (int i = 0; i < 4; ++i) { const int c = tid + 512 * i; k[i] = *(const u32x4*)(kg + (size_t)(c >> 4) * (HD * 2) + (c & 15) * 16); }
    }
    __device__ __forceinline__ void store(LAS unsigned char* buf, int tid) const {
#pragma unroll
        for (int i = 0; i < 4; ++i) { const int c = tid + 512 * i; *(LAS u32x4*)(buf + (c >> 4) * KSTR + (c & 15) * 16) = k[i]; }
    }
};
constexpr int KIBUF_B = 128 * KSTR;
__device__ __forceinline__ void indexer_block(const bf16_t* __restrict__ QI, const bf16_t* __restrict__ KI, const float* __restrict__ WI, unsigned* __restrict__ MASK, float* __restrict__ SC,
                                              LAS unsigned char* lds, int b, int qb16, int wave, int lane, int tid) {
    const int r = lane & 31, hh = lane >> 5, t0 = 16 * qb16, tw = t0 + 2 * wave;
    const bf16_t* ap = QI + (size_t)(b * SEQ + tw + (r >> 4)) * DM + (r & 15) * HD + 8 * hh;
    bf16x8 af[8];
#pragma unroll
    for (int s = 0; s < 8; ++s) af[s] = *(const bf16x8*)(ap + 16 * s);
    float wv[16];
#pragma unroll
    for (int i = 0; i < 16; ++i) { const int rw = crow(i, hh); wv[i] = WI[(size_t)(b * SEQ + tw + (rw >> 4)) * 16 + (rw & 15)]; }
    float* myrow = SC + ((size_t)(b * 128 + qb16) * 16 + 2 * wave + hh) * SEQ;
    const int tq = tw + hh, ntile = (t0 + 16 + 127) >> 7;
    const unsigned char* kg = (const unsigned char*)(KI + (size_t)(b * SEQ) * HD);
    KiStage sA, sB;
    sA.load(kg, tid);
    sA.store(lds, tid);
    asm volatile("s_waitcnt lgkmcnt(0)" ::: "memory"); __builtin_amdgcn_s_barrier(); asm volatile("" ::: "memory");
    if (ntile > 1) sA.load(kg + (size_t)1 * 128 * (HD * 2), tid);
    if (ntile > 2) sB.load(kg + (size_t)2 * 128 * (HD * 2), tid);
    for (int kt = 0; kt < ntile; ++kt) {
        const LAS unsigned char* buf = lds + (kt & 1) * KIBUF_B;
#pragma unroll
        for (int j = 0; j < 4; ++j) { const int key0 = 128 * kt + 32 * j;
            if (key0 <= t0 + 15) {
                const LAS unsigned char* kp = buf + (32 * j + r) * KSTR + 16 * hh;
                f32x16 c = f32x16{};
#pragma unroll
                for (int s = 0; s < 8; ++s) c = __builtin_amdgcn_mfma_f32_32x32x16_bf16(af[s], *(const LAS bf16x8*)(kp + 32 * s), c, 0, 0, 0);
                float s0 = 0.f, s1 = 0.f;
#pragma unroll
                for (int i = 0; i < 8; ++i) { s0 += wv[i] * relu_i(c[i]); s1 += wv[i + 8] * relu_i(c[i + 8]); }
                const float t0s = swap_sum(s0), t1s = swap_sum(s1);
                const int key = key0 + r;
                float v = (hh ? t1s : t0s) + 0.0f;
                if (key > tq) v = -INFINITY;
                myrow[key] = v; } }
        if (kt & 1) { if (kt + 1 < ntile) sB.store(lds + ((kt + 1) & 1) * KIBUF_B, tid); if (kt + 3 < ntile) sB.load(kg + (size_t)(kt + 3) * 128 * (HD * 2), tid); }
        else        { if (kt + 1 < ntile) sA.store(lds + ((kt + 1) & 1) * KIBUF_B, tid); if (kt + 3 < ntile) sA.load(kg + (size_t)(kt + 3) * 128 * (HD * 2), tid); }
        asm volatile("s_waitcnt lgkmcnt(0)" ::: "memory"); __builtin_amdgcn_s_barrier(); asm volatile("" ::: "memory");
    }
    asm volatile("s_waitcnt vmcnt(0)" ::: "memory");
    { const float* rowa = SC + ((size_t)(b * 128 + qb16) * 16 + 2 * wave) * SEQ;
      unsigned* mrowa = MASK + (size_t)(b * SEQ + tw) * 64;
      select_two(rowa, rowa + SEQ, tw, mrowa, mrowa + 64, lane); }
}


__device__ __forceinline__ void sb_attn_waves(const bf16_t* __restrict__ Q, const bf16_t* __restrict__ KF, const bf16_t* __restrict__ VF, bf16_t* __restrict__ O, int gw, int ngw, int lane) {
    const int r = lane & 31, hh = lane >> 5, rm = r - 4 * hh;
    bf16x8 uf[2];
#pragma unroll
    for (int s2 = 0; s2 < 2; ++s2) { u32x4 w; unsigned e[8];
#pragma unroll
        for (int j = 0; j < 8; ++j) { const int key = 16 * s2 + 8 * (j >> 2) + 4 * hh + (j & 3); e[j] = (key >= r) ? 0x3f80u : 0u; }
        w.x = e[0] | (e[1] << 16); w.y = e[2] | (e[3] << 16); w.z = e[4] | (e[5] << 16); w.w = e[6] | (e[7] << 16); uf[s2] = __builtin_bit_cast(bf16x8, w); }
    for (int unit = gw; unit < BATCH * NH * 64; unit += ngw) {
        const int bh = unit >> 6, qt = 63 - (unit & 63), b = bh >> 4, h = bh & 15, q0 = qt * 32;
        const bf16_t* qp = Q + (size_t)(b * SEQ + q0 + r) * DM + h * HD + 8 * hh;
        bf16x8 qf[8];
#pragma unroll
        for (int s = 0; s < 8; ++s) qf[s] = *(const bf16x8*)(qp + 16 * s);
        f32x16 o[4];
#pragma unroll
        for (int d = 0; d < 4; ++d) o[d] = f32x16{};
        float carry = 0.f;
        const bf16x8* kbase = (const bf16x8*)KF + (size_t)bh * 64 * 8 * 64 + lane;
        const bf16x8* vbase = (const bf16x8*)VF + (size_t)bh * 64 * 8 * 64 + lane;
        bf16x8 kf[8];
#pragma unroll
        for (int s = 0; s < 8; ++s) kf[s] = kbase[(size_t)(qt * 8 + s) * 64];
        for (int kt = qt; kt >= 0; --kt) {
            bf16x8 vf[8], kn[8];
#pragma unroll
            for (int i = 0; i < 8; ++i) vf[i] = vbase[(size_t)(kt * 8 + i) * 64];
            const int ktn = kt > 0 ? kt - 1 : 0;
#pragma unroll
            for (int s = 0; s < 8; ++s) kn[s] = kbase[(size_t)(ktn * 8 + s) * 64];
            f32x16 p = f32x16{};
#pragma unroll
            for (int s = 0; s < 8; ++s) p = __builtin_amdgcn_mfma_f32_32x32x16_bf16(kf[s], qf[s], p, 0, 0, 0);
            f32x16 sp;
#pragma unroll
            for (int i = 0; i < 16; ++i) sp[i] = __builtin_amdgcn_logf(1.0f + __builtin_amdgcn_exp2f(fminf(p[i], 120.0f)));
            if (kt == qt) {
#pragma unroll
                for (int i = 0; i < 16; ++i) if (crow(i, 0) >= rm) { sp[i] = 0.f; p[i] = -1e30f; } }
            f32x16 c;
#pragma unroll
            for (int i = 0; i < 16; ++i) c[i] = carry;
            c = __builtin_amdgcn_mfma_f32_32x32x16_bf16(uf[0], pack8(sp, 0), c, 0, 0, 0);
            c = __builtin_amdgcn_mfma_f32_32x32x16_bf16(uf[1], pack8(sp, 8), c, 0, 0, 0);
#pragma unroll
            for (int i = 0; i < 16; ++i) p[i] = __builtin_amdgcn_exp2f(p[i] - c[i]);
            carry = swap_max(c[0]);
            const bf16x8 pa0 = pack8(p, 0), pa1 = pack8(p, 8);
#pragma unroll
            for (int d = 0; d < 4; ++d) { o[d] = __builtin_amdgcn_mfma_f32_32x32x16_bf16(vf[2 * d], pa0, o[d], 0, 0, 0); o[d] = __builtin_amdgcn_mfma_f32_32x32x16_bf16(vf[2 * d + 1], pa1, o[d], 0, 0, 0); }
            if (__all(carry > SB_EXIT)) break;
#pragma unroll
            for (int s = 0; s < 8; ++s) kf[s] = kn[s];
        }
        bf16_t* op = O + (size_t)(b * SEQ + q0 + r) * DM + h * HD + 4 * hh;
#pragma unroll
        for (int d = 0; d < 4; ++d)
#pragma unroll
            for (int g = 0; g < 4; ++g) { u32x2 w; w.x = pk2(o[d][4 * g], o[d][4 * g + 1]); w.y = pk2(o[d][4 * g + 2], o[d][4 * g + 3]); *(u32x2*)(op + 32 * d + 8 * g) = w; }
    }
}

constexpr int N_PHASES = 12;
__global__ void __launch_bounds__(512, 2) fwd_kernel(Args a) {
    extern __shared__ __attribute__((aligned(16))) unsigned char lds_raw[];
    LAS unsigned char* lds = (LAS unsigned char*)lds_raw;
    cg::grid_group grid = cg::this_grid();
    const int tid = threadIdx.x, lane = tid & 63, wave = __builtin_amdgcn_readfirstlane(tid >> 6);
    const int G = gridDim.x, bx = blockIdx.x;
    const int gw = bx * 8 + wave, ngw = G * 8;
    unsigned char* ws = a.ws;
    const int lo = a.ph_lo, hi = a.ph_hi;
#ifndef REP_PHASE
#define REP_PHASE -1
#endif
#ifndef REP_COUNT
#define REP_COUNT 1
#endif
#define IN(k) (lo <= (k) && (k) < hi)
#define GSYNC(k) do { if ((k) == 0 && a.ph_hi > 1000) grid.sync(); xcd_barrier(xbar); } while (0)
#define SEAM(k) do { if (IN(k) && IN((k) + 1)) GSYNC(k); } while (0)
#define REPS(k) for (int rep_ = 0; rep_ < ((k) == REP_PHASE ? REP_COUNT : 1); ++rep_, (void)(((k) == REP_PHASE && rep_ < REP_COUNT) ? (xcd_barrier(xbar), 0) : 0))
    bf16_t* XB = (bf16_t*)(ws + WS_XB); float* PART = (float*)(ws + WS_PART);
    bf16_t* Qb = (bf16_t*)(ws + WS_Q); bf16_t* Kb = (bf16_t*)(ws + WS_K); bf16_t* Vtb = (bf16_t*)(ws + WS_VT); bf16_t* Ob = (bf16_t*)(ws + WS_O);
    bf16_t* QIb = (bf16_t*)(ws + WS_QI); bf16_t* KDb = (bf16_t*)(ws + WS_KD); bf16_t* VTDb = (bf16_t*)(ws + WS_VTD); bf16_t* KIb = (bf16_t*)(ws + WS_KI);
    float* WIb = (float*)(ws + WS_WI); unsigned* MASKb = (unsigned*)(ws + WS_MASK);
    bf16_t* ACTb = (bf16_t*)(ws + WS_ACT);
    const float* ropeC = (const float*)(ws + WS_ROPE); const float* ropeS = ropeC + SEQ * 64;

    if (tid < 16) ((volatile LAS unsigned*)(lds + LDS_MISC))[tid] = 0u;
    __syncthreads();
    XcdBarrier xbar = xcd_barrier_post((unsigned*)(ws + WS_CTL), (volatile LAS unsigned*)(lds + LDS_MISC) + 8);
    const Offload offl = make_offload(G);
    if (IN(0)) REPS(0) { prologue_phase(a, lds, gw, ngw, wave, lane, offl); }
    SEAM(0);
    if (IN(1)) REPS(1) {
        pg8::Gemm g{XB, (const bf16_t*)(ws + WS_WQKV), MTOK, NQKV, DM}; pg8::StaticOrder S; S.init(MTOK, NQKV, G, bx);
        EpiQKV E{ws};
        pg8::gemm_phase<EpiQKV, pg8::StaticOrder, true, true>(lds, g, S, E);
    }
    SEAM(1);
    if (IN(2)) REPS(2) {
        LAS float* scr = (LAS float*)(lds + wave * 16640);
#pragma nounroll
        for (int step = 0; step < 2; ++step) {
            if ((step == 0) == (wave < 4)) sb_attn_waves(Qb, Kb, Vtb, Ob, gw, ngw, lane);
            else { convert_items(a, scr, WI0, WI1, WI3, WI4, gw, ngw, lane); convert_items(a, scr, WI1, WI2, 0, 0, gw, ngw, lane); }
        }
    }
    SEAM(2);
    if (IN(3)) REPS(3) {
        pg8::Gemm g{Ob, (const bf16_t*)(ws + WS_WO0), MTOK, DM, DM}; pg8::StaticOrder S; S.init(MTOK, DM, G, bx);
        EpiRes<true, false> E{a.x, XB, PART};
        pg8::gemm_phase<EpiRes<true, false>, pg8::StaticOrder, true, true>(lds, g, S, E);
    }
    SEAM(3);
    if (IN(4)) REPS(4) {
        const int Gg = offl.up0 ? offl.g_up : G;
        if (bx < Gg) {
        pg8::Gemm g{XB, (const bf16_t*)(ws + WS_WUP), MTOK, NUP, DM, 254, -2}; pg8::StaticOrder S; S.init_tiles(33, NUP / 256, Gg, bx);
        EpiUpConv E{ACTb, PART, a.conv_w, a.conv_b, (LAS float*)(lds + LDS_EPI)};
        pg8::gemm_phase<EpiUpConv, pg8::StaticOrder, true, true>(lds, g, S, E);
        } else { LAS float* scr = (LAS float*)(lds + wave * 16640); const int vw = (bx - Gg) * 8 + wave, nvw = (G - Gg) * 8;
            convert_items(a, scr, WI5, WI6, WI2, WI3, vw, nvw, lane); }
    }
    SEAM(4);
    if (IN(5)) REPS(5) {
        pg8::Gemm g{ACTb, (const bf16_t*)(ws + WS_WDN), MTOK, DM, FF}; pg8::StaticOrder S; S.init(MTOK, DM, G, bx);
        EpiRes<false, false> E{XB, XB, PART};
        pg8::gemm_phase<EpiRes<false, false>, pg8::StaticOrder, true, true>(lds, g, S, E);
    }
    SEAM(5);
    if (IN(6)) REPS(6) {
        const int Gg = offl.in1 ? offl.g_in : G;
        if (bx < Gg) {
        pg8::Gemm g{XB, (const bf16_t*)(ws + WS_WIN), MTOK, NINP, DM}; pg8::StaticOrder S; S.init(MTOK, NINP, Gg, bx);
        EpiDsaIn E{ws, (LAS float*)(lds + LDS_EPI)};
        pg8::gemm_phase<EpiDsaIn, pg8::StaticOrder, true, true>(lds, g, S, E);
        } else { LAS float* scr = (LAS float*)(lds + wave * 16640); const int vw = (bx - Gg) * 8 + wave, nvw = (G - Gg) * 8;
            convert_items(a, scr, WI4, WI5, 0, 0, vw, nvw, lane); }
    }
    SEAM(6);
    if (IN(7)) REPS(7) {
        for (int pr = bx; pr < 256; pr += G) { const int b = pr >> 6, p = pr & 63;
            for (int half = 0; half < 2; ++half) indexer_block(QIb, KIb, WIb, MASKb, (float*)(ws + WS_ACT), lds, b, half ? p : 127 - p, wave, lane, tid); }
    }
    SEAM(7);
    if (IN(8)) REPS(8) {
        for (int pr = bx; pr < 256; pr += G) { const int b = pr >> 6, g = (pr >> 4) & 3, p = pr & 15;
            for (int half = 0; half < 2; ++half) dsa_attn_block(Qb, KDb, VTDb, MASKb, Ob, lds, b, g, half ? p : 31 - p, wave, lane, tid); }
    }
    SEAM(8);
    if (IN(9)) REPS(9) {
        pg8::Gemm g{Ob, (const bf16_t*)(ws + WS_WO1), MTOK, DM, DM}; pg8::StaticOrder S; S.init(MTOK, DM, G, bx);
        EpiRes<false, false> E{XB, XB, PART};
        pg8::gemm_phase<EpiRes<false, false>, pg8::StaticOrder, true, true>(lds, g, S, E);
    }
    SEAM(9);
    if (IN(10)) REPS(10) {
        const int Gg = offl.up1 ? offl.g_up : G;
        if (bx < Gg) {
        pg8::Gemm g{XB, (const bf16_t*)(ws + WS_WUP + 44 * MiB), MTOK, NUP, DM, 254, -2}; pg8::StaticOrder S; S.init_tiles(33, NUP / 256, Gg, bx);
        EpiUpConv E{ACTb, PART, a.conv_w + 3 * NUP, a.conv_b + NUP, (LAS float*)(lds + LDS_EPI)};
        pg8::gemm_phase<EpiUpConv, pg8::StaticOrder, true, true>(lds, g, S, E);
        } else { LAS float* scr = (LAS float*)(lds + wave * 16640); const int vw = (bx - Gg) * 8 + wave, nvw = (G - Gg) * 8;
            convert_items(a, scr, WI6, WI7, 0, 0, vw, nvw, lane); }
    }
    SEAM(10);
    if (IN(11)) REPS(11) {
        pg8::Gemm g{ACTb, (const bf16_t*)(ws + WS_WDN + 22 * MiB), MTOK, DM, FF}; pg8::StaticOrder S; S.init(MTOK, DM, G, bx);
        EpiRes<false, true> E{XB, a.out, nullptr};
        pg8::gemm_phase<EpiRes<false, true>, pg8::StaticOrder, true, true>(lds, g, S, E);
    }
#undef IN
#undef SEAM
}

extern "C" void kernel_launch(void* const* d_in, const int* in_sizes, int n_in, void* d_out, int out_size, void* d_ws, size_t ws_size, hipStream_t stream) {
    static int grid = 0;
    if (grid == 0) {
        if (n_in != 14 || out_size != MTOK * DM || ws_size < WS_END) { fprintf(stderr, "kernel_launch: unexpected shapes (n_in %d out %d ws %zu)\n", n_in, out_size, ws_size); grid = -1; return; }
        int dev = 0, cus = 0, per_cu = 0;
        hipGetDevice(&dev); hipDeviceGetAttribute(&cus, hipDeviceAttributeMultiprocessorCount, dev);
        if (hipFuncSetAttribute((const void*)fwd_kernel, hipFuncAttributeMaxDynamicSharedMemorySize, LDS_BYTES) != hipSuccess) { fprintf(stderr, "kernel_launch: hipFuncSetAttribute failed\n"); grid = -1; return; }
        if (hipOccupancyMaxActiveBlocksPerMultiprocessor(&per_cu, (const void*)fwd_kernel, 512, LDS_BYTES) != hipSuccess || per_cu < 1) { fprintf(stderr, "kernel_launch: occupancy query says %d\n", per_cu); per_cu = 1; }
        (void)hipGetLastError();
        grid = cus;
    }
    if (grid < 0) return;
    Args a{};
    a.x = (const float*)d_in[0]; a.attn_g = (const float*)d_in[1]; a.ffn_g = (const float*)d_in[2]; a.w_qkv = (const float*)d_in[3]; a.w_o0 = (const float*)d_in[4]; a.w_in = (const float*)d_in[5];
    a.qn_g = (const float*)d_in[6]; a.kn_g = (const float*)d_in[7]; a.ikn_g = (const float*)d_in[8]; a.w_o1 = (const float*)d_in[9]; a.w_up = (const float*)d_in[10]; a.conv_w = (const float*)d_in[11];
    a.conv_b = (const float*)d_in[12]; a.w_down = (const float*)d_in[13]; a.out = (float*)d_out; a.ws = (unsigned char*)d_ws;
    if (hipMemsetAsync((char*)d_ws + WS_CTL, 0, CTL_BYTES, stream) != hipSuccess) { fprintf(stderr, "kernel_launch: hipMemsetAsync failed\n"); return; }
#if MK_ONE_LAUNCH
    a.ph_lo = 0; a.ph_hi = N_PHASES;
    void* args[] = {&a};
    hipError_t e = hipLaunchCooperativeKernel((const void*)fwd_kernel, dim3(grid), dim3(512), args, LDS_BYTES, stream);
    if (e != hipSuccess) fprintf(stderr, "cooperative launch failed: %s (grid %d)\n", hipGetErrorString(e), grid);
#else
    for (int pp = 0; pp < N_PHASES + HOST_REP_EXTRA; ++pp) {
        const int p = pp < N_PHASES ? pp : -1;
        if (p < 0) continue;
        for (int hr = 0; hr < ((p == HOST_REP_PHASE) ? 1 + HOST_REP_EXTRA : 1); ++hr) {
        a.ph_lo = p; a.ph_hi = p + 1;
        void* args[] = {&a};
        hipError_t e = hipLaunchCooperativeKernel((const void*)fwd_kernel, dim3(grid), dim3(512), args, LDS_BYTES, stream);
        if (e != hipSuccess) { fprintf(stderr, "launch %d failed: %s (grid %d)\n", p, hipGetErrorString(e), grid); break; }
        }
    }
#endif
}
```

```cpp
#include <hip/hip_runtime.h>
#include <hip/hip_cooperative_groups.h>
#include <cstdio>
#include <cstdint>
namespace cg = cooperative_groups;

#ifndef HOST_REP_PHASE
#define HOST_REP_PHASE -1
#endif
#ifndef HOST_REP_EXTRA
#define HOST_REP_EXTRA 0
#endif
#ifndef MK_ONE_LAUNCH
#define MK_ONE_LAUNCH 1
#endif

#define LAS __attribute__((address_space(3)))
typedef unsigned short bf16_t;
typedef short bf16x8 __attribute__((ext_vector_type(8)));
typedef short s16x4 __attribute__((ext_vector_type(4)));
typedef float f32x4 __attribute__((ext_vector_type(4)));
typedef float f32x2 __attribute__((ext_vector_type(2)));
typedef float f32x16 __attribute__((ext_vector_type(16)));
typedef unsigned u32x4 __attribute__((ext_vector_type(4)));
typedef unsigned u32x2 __attribute__((ext_vector_type(2)));
typedef __bf16 bf16x2_t __attribute__((ext_vector_type(2)));

constexpr int BATCH = 4, SEQ = 2048, DM = 2048, NH = 16, HD = 128, MTOK = BATCH * SEQ;
constexpr int FF = 5632, NUP = 2 * FF, NQKV = 3 * DM;
constexpr int KVH = 4, NIN = 5264, NINP = 5376;
constexpr int TOPK = 256;
constexpr float NORM_EPS = 1e-6f;
constexpr float LOG2E = 1.4426950408889634f;
constexpr float QSCALE = 0.08838834764831845f * LOG2E;

constexpr size_t MiB = 1u << 20;
constexpr size_t WS_WQKV = 0, WS_WO0 = 24 * MiB, WS_WIN = 32 * MiB, WS_WO1 = 53 * MiB, WS_WUP = 61 * MiB  , WS_WDN = 149 * MiB  ;
constexpr size_t WS_GAIN = 197 * MiB + 512 * 1024  ;
constexpr size_t WS_ROPE = 193 * MiB  , WS_PART = 194 * MiB, WS_MASK = 195 * MiB, WS_WI = 197 * MiB, WS_KI = 198 * MiB;
constexpr size_t WS_XB = 200 * MiB;
constexpr size_t WS_SCR = 360 * MiB;
constexpr size_t WS_ACT = WS_SCR + 176 * MiB;
constexpr size_t WS_Q = WS_SCR, WS_K = WS_SCR + 32 * MiB, WS_VT = WS_SCR + 64 * MiB, WS_O = WS_SCR + 96 * MiB, WS_QI = WS_SCR + 128 * MiB, WS_KD = WS_SCR + 160 * MiB, WS_VTD = WS_SCR + 168 * MiB;
constexpr size_t WS_CTL = WS_ACT + 88 * MiB, CTL_BYTES = 65536;
constexpr size_t WS_END = WS_CTL + CTL_BYTES;

constexpr int LDS_EPI = 131072;
constexpr int LDS_BYTES = 159744;
constexpr int LDS_MISC = LDS_BYTES - 256;
constexpr int LDS_RSTD = LDS_EPI + 8192 + 256;
constexpr int LDS_CONVW = LDS_RSTD + 8192;

static_assert(LDS_CONVW + 8192 <= LDS_MISC, "LDS map");
__device__ __forceinline__ unsigned pk2(float lo, float hi) { f32x2 v = {lo, hi}; bf16x2_t b = __builtin_convertvector(v, bf16x2_t); return __builtin_bit_cast(unsigned, b); }
__device__ __forceinline__ bf16_t f2bf(float f) { return (bf16_t)(pk2(f, 0.f) & 0xffffu); }
__device__ __forceinline__ float relu_i(float x) { const int b = __float_as_int(x); return __int_as_float(b > 0 ? b : 0); }
__device__ __forceinline__ int crow(int r, int hi) { return (r & 3) + 8 * (r >> 2) + 4 * hi; }
__device__ __forceinline__ bf16x8 pack8(const f32x16& p, int b) {
    u32x4 w; w.x = pk2(p[b], p[b + 1]); w.y = pk2(p[b + 2], p[b + 3]); w.z = pk2(p[b + 4], p[b + 5]); w.w = pk2(p[b + 6], p[b + 7]);
    return __builtin_bit_cast(bf16x8, w);
}
__device__ __forceinline__ float swap_sum(float v) { auto rr = __builtin_amdgcn_permlane32_swap(__float_as_uint(v), __float_as_uint(v), false, false); return __uint_as_float(rr[0]) + __uint_as_float(rr[1]); }
__device__ __forceinline__ float swap_max(float v) { auto rr = __builtin_amdgcn_permlane32_swap(__float_as_uint(v), __float_as_uint(v), false, false); return fmaxf(__uint_as_float(rr[0]), __uint_as_float(rr[1])); }
__device__ __forceinline__ float wave_sum(float v) {
#pragma unroll
    for (int o = 1; o < 64; o <<= 1) v += __shfl_xor(v, o);
    return v;
}
__device__ __forceinline__ float row_rstd(const float* part, int row, int fq) {
    const f32x4* p = (const f32x4*)(part + (size_t)row * 32 + 8 * fq);
    const f32x4 a = p[0], b = p[1]; float s = ((a.x + a.y) + (a.z + a.w)) + ((b.x + b.y) + (b.z + b.w));
    s += __shfl_xor(s, 16); s += __shfl_xor(s, 32);
    return __builtin_amdgcn_rsqf(s * (1.0f / DM) + NORM_EPS);
}


#define XB_TMO      128
#define XB_XCNT(j)  (256  + 64 * (j))
#define XB_XSUB(j)  (1280 + 64 * (j))
#define XB_XGEN(j)  (2304 + 64 * (j))
#define XB_TOP      3328
#define XB_TOPGEN   3392
#define XCD_BAR_WORDS 3456
#define XB_SPIN_CAP (1u << 18)
__device__ __forceinline__ unsigned xb_ld(unsigned* p)              { return __hip_atomic_load(p, __ATOMIC_RELAXED, __HIP_MEMORY_SCOPE_AGENT); }
__device__ __forceinline__ unsigned xb_add(unsigned* p, unsigned v) { return __hip_atomic_fetch_add(p, v, __ATOMIC_RELAXED, __HIP_MEMORY_SCOPE_AGENT); }
__device__ __forceinline__ unsigned xb_xcc_id() { return (unsigned)__builtin_amdgcn_s_getreg((3 << 11) | 20) & 0xFu; }
#define XB_SPIN(cond, bar) do { unsigned _sp = 0; while (cond) { __builtin_amdgcn_s_sleep(1); \
    if ((++_sp & 255u) == 0u) { if (xb_ld(&(bar)[XB_TMO])) break; if (_sp > XB_SPIN_CAP) { atomicAdd(&(bar)[XB_TMO], 1u); break; } } } } while (0)
struct XcdBarrier { unsigned* bar; unsigned x; volatile LAS unsigned* st; };
__device__ __forceinline__ XcdBarrier xcd_barrier_post(unsigned* bar, volatile LAS unsigned* st) {
    XcdBarrier b; b.bar = bar; b.x = xb_xcc_id(); b.st = st;
    if (threadIdx.x == 0) (void)xb_add(&bar[XB_XCNT(b.x)], 1u);
    return b;
}
__device__ __forceinline__ void xcd_barrier_complete(unsigned* bar, unsigned x, unsigned& nloc, unsigned& nx) {
    const unsigned G = gridDim.x * gridDim.y * gridDim.z;
    unsigned sum, cnt, mine, sp = 0u;
    for (;;) {
        sum = 0u; cnt = 0u; mine = 0u;
#pragma unroll
        for (unsigned j = 0; j < 16; ++j) { const unsigned c = xb_ld(&bar[XB_XCNT(j)]); sum += c; cnt += (c > 0u) ? 1u : 0u; mine = (j == x) ? c : mine; }
        if (sum == G) break;
        __builtin_amdgcn_s_sleep(1);
        if ((++sp & 255u) == 0u) { if (xb_ld(&bar[XB_TMO])) break; if (sp > XB_SPIN_CAP) { atomicAdd(&bar[XB_TMO], 1u); break; } }
    }
    nloc = mine > 0u ? mine : 1u; nx = cnt > 0u ? cnt : 1u;
}
__device__ __forceinline__ void xcd_barrier(const XcdBarrier& b) {
    asm volatile("s_waitcnt vmcnt(0)" ::: "memory");
    __syncthreads();
    if (threadIdx.x == 0) {
        unsigned* bar = b.bar;
        __builtin_amdgcn_s_waitcnt(0);
        unsigned nloc = b.st[0], nx = b.st[1];
        if (nloc == 0u) { xcd_barrier_complete(bar, b.x, nloc, nx); b.st[0] = nloc; b.st[1] = nx; }
        const unsigned old = xb_add(&bar[XB_XSUB(b.x)], 1u);
        const unsigned gen = old / nloc;
        if (old + 1u == (gen + 1u) * nloc) {
            __builtin_amdgcn_fence(__ATOMIC_RELEASE, "agent");
            asm volatile("s_waitcnt vmcnt(0)" ::: "memory");
            const unsigned og = xb_add(&bar[XB_TOP], 1u);
            const unsigned tg = og / nx;
            if (og + 1u == (tg + 1u) * nx) xb_add(&bar[XB_TOPGEN], 1u);
            else XB_SPIN(xb_ld(&bar[XB_TOPGEN]) == tg, bar);
            __builtin_amdgcn_fence(__ATOMIC_ACQUIRE, "agent");
            xb_add(&bar[XB_XGEN(b.x)], 1u);
            asm volatile("s_waitcnt vmcnt(0)" ::: "memory");
        } else {
            XB_SPIN(xb_ld(&bar[XB_XGEN(b.x)]) == gen, bar);
            __builtin_amdgcn_fence(__ATOMIC_ACQUIRE, "agent");
            asm volatile("s_waitcnt vmcnt(0)" ::: "memory");
        }
    }
    __syncthreads();
}

namespace pg8 {
constexpr int BM = 256, BK = 64, HALF = 128, HTB = HALF * BK * 2, STAGE_BYTES = 8 * HTB, NXCD = 8, WGM = 2;
__host__ __device__ __forceinline__ int lds_byte(int r, int c) { const int st = (r >> 4) * 2 + (c >> 5), rr = r & 15, cc = c & 31, ob = rr * 64 + cc * 2; return st * 1024 + (ob ^ (((ob >> 9) & 1) << 5)); }
__host__ __device__ __forceinline__ void stage_rc(int b, int& R, int& C) { const int st = b / 1024, sb = b % 1024, swz = sb ^ (((sb >> 9) & 1) << 5); R = (st >> 1) * 16 + swz / 64; C = (st & 1) * 32 + (swz % 64) / 2; }
__host__ __device__ __forceinline__ int perm32(int rho) { const int n = rho >> 4, i = rho & 15; return 8 * (i >> 2) + 4 * n + (i & 3); }
struct Unit { int pm, pn; };
struct Gemm { const bf16_t* A; const bf16_t* Bt; int M, N, K; int a_rows = 256, a_row0 = 0; };
struct StaticOrder {
    int nM, nN, nwg, G, c;
    __host__ __device__ void init(int M, int N, int G_, int c_) { nM = M / BM; nN = N / BM; nwg = nM * nN; G = G_; c = c_; }
    __host__ __device__ void init_tiles(int nM_, int nN_, int G_, int c_) { nM = nM_; nN = nN_; nwg = nM * nN; G = G_; c = c_; }
    __host__ __device__ bool next(int i, Unit& u) const {
        const long L = (long)i * G + c; if (L >= nwg) return false;
        int wgid = (int)L; { const int q = nwg / NXCD, r = nwg % NXCD, xcd = wgid % NXCD, off = wgid / NXCD; wgid = (xcd < r ? xcd * (q + 1) : r * (q + 1) + (xcd - r) * q) + off; }
        const int nig = WGM * nN, gid = wgid / nig, fm = gid * WGM, gsz = (nM - fm) < WGM ? (nM - fm) : WGM;
        u.pm = fm + ((wgid % nig) % gsz); u.pn = (wgid % nig) / gsz; return true;
    }
};
template <class Epi, class Sched, bool ALIGN_EPI, bool SP2>
__device__ __forceinline__ void gemm_phase(LAS unsigned char* lds, const Gemm g, const Sched& S, const Epi& E) {
    const int tid = threadIdx.x, wid = __builtin_amdgcn_readfirstlane(tid >> 6), lane = tid & 63, wr = wid >> 2, wc = wid & 3, fr = lane & 15, fq = lane >> 4;
    const int K = g.K, nt = K / BK;
    unsigned voffA[2], voffB[2];
#pragma unroll
    for (int i = 0; i < 2; ++i) { int R, C; stage_rc(tid * 16 + i * 8192, R, C); const int Rb = Epi::PERM ? ((R & ~31) + perm32(R & 31)) : R;
        voffA[i] = (unsigned)(R * K + C) * 2u; voffB[i] = (unsigned)(Rb * K + C) * 2u; }
    const size_t kstep = (size_t)(BK * 2);
    const size_t hstep = (size_t)HALF * K * 2;
    const size_t tstep = 2 * hstep;
    const unsigned ldsw = (unsigned)wid * 1024u;
    const int aoff = lds_byte(wr * 64 + fr, fq * 8), boff = lds_byte(wc * 32 + fr, fq * 8);
#define PG8_SA(b, h) (((b) * 2 + (h)) * HTB)
#define PG8_SB(b, h) ((4 + (b) * 2 + (h)) * HTB)
#define PG8_STAGE(bufoff, gbase, voff) do { _Pragma("unroll") for (int _i = 0; _i < 2; ++_i) \
        __builtin_amdgcn_global_load_lds((const unsigned*)((const char*)(gbase) + (voff)[_i]), (LAS unsigned*)(lds + (bufoff) + ldsw + _i * 8192), 16, 0, 0); } while (0)
#define PG8_LDA(dst, b, h) do { _Pragma("unroll") for (int m = 0; m < 4; ++m) _Pragma("unroll") for (int k = 0; k < 2; ++k) dst[m][k] = *(const LAS bf16x8*)(lds + PG8_SA(b, h) + aoff + m * 2048 + k * 1024); } while (0)
#define PG8_LDB(dst, b, h) do { _Pragma("unroll") for (int n = 0; n < 2; ++n) _Pragma("unroll") for (int k = 0; k < 2; ++k) dst[n][k] = *(const LAS bf16x8*)(lds + PG8_SB(b, h) + boff + n * 2048 + k * 1024); } while (0)
#define PG8_MMA(ai, bj, At, Bt) do { __builtin_amdgcn_s_setprio(1); _Pragma("unroll") for (int m = 0; m < 4; ++m) _Pragma("unroll") for (int n = 0; n < 2; ++n) _Pragma("unroll") for (int k = 0; k < 2; ++k) \
        acc[ai][bj][m][n] = __builtin_amdgcn_mfma_f32_16x16x32_bf16(Bt[n][k], At[m][k], acc[ai][bj][m][n], 0, 0, 0); __builtin_amdgcn_s_setprio(0); } while (0)
#define PG8_WAIT_V(n) asm volatile("s_waitcnt vmcnt(" #n ")" ::: "memory")
#define PG8_WAIT_L(n) asm volatile("s_waitcnt lgkmcnt(" #n ")" ::: "memory")
#define PG8_BAR __builtin_amdgcn_s_barrier()
#define PG8_SCHED __builtin_amdgcn_sched_barrier(0)
    Unit cur, nxt; int ui = 0;
    if (!S.next(0, cur)) return;
    E.prefetch(cur, 0, tid, wid);
    f32x4 acc[2][2][4][2];
#pragma unroll
    for (int a = 0; a < 2; ++a)
#pragma unroll
        for (int b = 0; b < 2; ++b)
#pragma unroll
            for (int m = 0; m < 4; ++m)
#pragma unroll
                for (int n = 0; n < 2; ++n) acc[a][b][m][n] = (f32x4){0.f, 0.f, 0.f, 0.f};
    bf16x8 At[4][2], B0[2][2], B1[2][2];
    const long atstep = (long)g.a_rows * K * 2, aorg = (long)g.a_row0 * K * 2;
    const char* cA = (const char*)g.A + aorg + (long)cur.pm * atstep; const char* cB = (const char*)g.Bt + (size_t)cur.pn * tstep;
    if constexpr (SP2) {
        PG8_STAGE(PG8_SB(0, 0), cB, voffB); PG8_STAGE(PG8_SB(0, 1), cB + hstep, voffB); PG8_STAGE(PG8_SA(0, 0), cA, voffA); PG8_STAGE(PG8_SA(0, 1), cA + hstep, voffA);
        if (wr == 1) PG8_BAR;
        PG8_WAIT_V(2); PG8_BAR;
        PG8_STAGE(PG8_SB(1, 0), cB + kstep, voffB); PG8_STAGE(PG8_SA(1, 0), cA + kstep, voffA); PG8_STAGE(PG8_SB(1, 1), cB + hstep + kstep, voffB);
        PG8_WAIT_V(6); PG8_BAR;
    } else {
        PG8_STAGE(PG8_SB(0, 0), cB, voffB); PG8_STAGE(PG8_SA(0, 0), cA, voffA); PG8_STAGE(PG8_SB(0, 1), cB + hstep, voffB); PG8_STAGE(PG8_SA(0, 1), cA + hstep, voffA);
        if (wr == 1) PG8_BAR;
        PG8_WAIT_V(4); PG8_BAR;
        PG8_STAGE(PG8_SB(1, 0), cB + kstep, voffB); PG8_STAGE(PG8_SA(1, 0), cA + kstep, voffA); PG8_STAGE(PG8_SB(1, 1), cB + hstep + kstep, voffB);
        PG8_WAIT_V(6); PG8_BAR;
    }
    for (;;) {
        const bool has_next = S.next(ui + 1, nxt);
        const char* nA = has_next ? (const char*)g.A + aorg + (long)nxt.pm * atstep : cA; const char* nB = has_next ? (const char*)g.Bt + (size_t)nxt.pn * tstep : cB;
        for (int t = 0; t < nt; t += 2) {
            const bool last = (t == nt - 2);
            const char* a1 = cA + (size_t)(t + 1) * kstep;
            const char* a2 = last ? nA : cA + (size_t)(t + 2) * kstep; const char* b2 = last ? nB : cB + (size_t)(t + 2) * kstep;
            const char* a3 = a2 + kstep; const char* b3 = b2 + kstep;
            if constexpr (SP2) {
            PG8_LDB(B0, 0, 0); PG8_LDB(B1, 0, 1); PG8_SCHED; PG8_LDA(At, 0, 0); PG8_STAGE(PG8_SA(1, 1), a1 + hstep, voffA);
            PG8_WAIT_V(8); PG8_WAIT_L(0); PG8_BAR; PG8_MMA(0, 0, At, B0); PG8_MMA(0, 1, At, B1); PG8_BAR; PG8_SCHED;
            PG8_LDA(At, 0, 1); PG8_STAGE(PG8_SB(0, 0), b2, voffB); PG8_STAGE(PG8_SB(0, 1), b2 + hstep, voffB); PG8_STAGE(PG8_SA(0, 0), a2, voffA);
            PG8_WAIT_V(8); PG8_WAIT_L(0); PG8_BAR; PG8_MMA(1, 0, At, B0); PG8_MMA(1, 1, At, B1); PG8_BAR; PG8_SCHED;
            PG8_LDB(B0, 1, 0); PG8_LDB(B1, 1, 1); PG8_SCHED; PG8_LDA(At, 1, 0); PG8_STAGE(PG8_SA(0, 1), a2 + hstep, voffA);
            PG8_WAIT_V(8); PG8_WAIT_L(0); PG8_BAR; PG8_MMA(0, 0, At, B0); PG8_MMA(0, 1, At, B1); PG8_BAR; PG8_SCHED;
            PG8_LDA(At, 1, 1); PG8_STAGE(PG8_SB(1, 0), b3, voffB); PG8_STAGE(PG8_SB(1, 1), b3 + hstep, voffB); PG8_STAGE(PG8_SA(1, 0), a3, voffA);
            PG8_WAIT_V(8); PG8_WAIT_L(0); PG8_BAR; PG8_MMA(1, 0, At, B0); PG8_MMA(1, 1, At, B1); PG8_BAR; PG8_SCHED;
            } else {
            PG8_LDB(B0, 0, 0); PG8_SCHED; PG8_LDA(At, 0, 0); PG8_STAGE(PG8_SA(1, 1), a1 + hstep, voffA);
            PG8_WAIT_L(8); PG8_BAR; PG8_WAIT_L(0); PG8_MMA(0, 0, At, B0); PG8_BAR; PG8_SCHED;
            PG8_LDB(B1, 0, 1); PG8_STAGE(PG8_SB(0, 0), b2, voffB);
            PG8_BAR; PG8_WAIT_L(0); PG8_MMA(0, 1, At, B1); PG8_BAR;
            PG8_LDA(At, 0, 1); PG8_STAGE(PG8_SA(0, 0), a2, voffA);
            PG8_BAR; PG8_WAIT_L(0); PG8_MMA(1, 0, At, B0); PG8_BAR; PG8_SCHED;
            PG8_STAGE(PG8_SB(0, 1), b2 + hstep, voffB);
            PG8_WAIT_V(6); PG8_BAR; PG8_MMA(1, 1, At, B1); PG8_BAR;
            PG8_LDB(B0, 1, 0); PG8_SCHED; PG8_LDA(At, 1, 0); PG8_STAGE(PG8_SA(0, 1), a2 + hstep, voffA);
            PG8_WAIT_L(8); PG8_BAR; PG8_WAIT_L(0); PG8_MMA(0, 0, At, B0); PG8_BAR; PG8_SCHED;
            PG8_LDB(B1, 1, 1); PG8_STAGE(PG8_SB(1, 0), b3, voffB);
            PG8_BAR; PG8_WAIT_L(0); PG8_MMA(0, 1, At, B1); PG8_BAR;
            PG8_LDA(At, 1, 1); PG8_STAGE(PG8_SA(1, 0), a3, voffA);
            PG8_BAR; PG8_WAIT_L(0); PG8_MMA(1, 0, At, B0); PG8_BAR; PG8_SCHED;
            PG8_STAGE(PG8_SB(1, 1), b3 + hstep, voffB);
            PG8_WAIT_V(6); PG8_BAR; PG8_MMA(1, 1, At, B1); PG8_BAR;
            }
        }
        if constexpr (ALIGN_EPI) { if (wr == 0) PG8_BAR; }
        { int fr_ = fr, fq_ = fq; asm volatile("" : "+v"(fr_), "+v"(fq_)); E(acc, cur, wr, wc, fr_, fq_, ui); if (has_next) E.prefetch(nxt, ui + 1, (wr * 4 + wc) * 64 + fq_ * 16 + fr_, wr * 4 + wc); }
        if (!has_next) break;
#pragma unroll
        for (int a = 0; a < 2; ++a)
#pragma unroll
            for (int b = 0; b < 2; ++b)
#pragma unroll
                for (int m = 0; m < 4; ++m)
#pragma unroll
                    for (int n = 0; n < 2; ++n) acc[a][b][m][n] = (f32x4){0.f, 0.f, 0.f, 0.f};
        cur = nxt; cA = nA; cB = nB; ++ui;
        if constexpr (ALIGN_EPI) { if (wr == 1) PG8_BAR; }
    }
    PG8_WAIT_V(0);
    if constexpr (!ALIGN_EPI) { if (wr == 0) PG8_BAR; }
    PG8_BAR;
#undef PG8_SA
#undef PG8_SB
#undef PG8_STAGE
#undef PG8_LDA
#undef PG8_LDB
#undef PG8_MMA
#undef PG8_WAIT_V
#undef PG8_WAIT_L
#undef PG8_BAR
#undef PG8_SCHED
}
}
using pg8::Unit;
typedef f32x4 AccT[2][2][4][2];


template <class Sched>
__device__ __forceinline__ void rstd_table_build(LAS unsigned char* lds, const float* part, const Sched& S, int a_rows, int a_row0, int tid) {
    LAS float* tab = (LAS float*)(lds + LDS_RSTD);
    for (int i0 = 0; i0 < 8; i0 += 2) {
        pg8::Unit u; const int i = i0 + (tid >> 8);
        if (S.next(i, u)) {
            int row = a_rows * u.pm + a_row0 + (tid & 255); row = row < 0 ? 0 : (row >= MTOK ? MTOK - 1 : row);
            const f32x4* p = (const f32x4*)(part + (size_t)row * 32);
            f32x4 acc4 = p[0];
#pragma unroll
            for (int k = 1; k < 8; ++k) acc4 += p[k];
            tab[i * 256 + (tid & 255)] = __builtin_amdgcn_rsqf(((acc4.x + acc4.y) + (acc4.z + acc4.w)) * (1.0f / DM) + NORM_EPS);
        }
    }
    asm volatile("s_waitcnt lgkmcnt(0)" ::: "memory"); __syncthreads();
}
struct EpiQKV {
    static constexpr bool PERM = true;
    unsigned char* ws;
    __device__ __forceinline__ void prefetch(const Unit&, int, int, int) const {}
    __device__ __forceinline__ void operator()(const AccT& acc, const Unit& u, int wr, int wc, int fr, int fq, int) const {
        const int row0 = u.pm * 256 + wr * 64 + fr, kind = u.pn >> 3, colt = (u.pn & 7) * 256 + wc * 32 + 8 * fq;
        if (kind == 0) {
            bf16_t* base = (bf16_t*)(ws + WS_Q);
#pragma unroll
            for (int ai = 0; ai < 2; ++ai)
#pragma unroll
                for (int m = 0; m < 4; ++m) { bf16_t* rowp = base + (size_t)(row0 + ai * 128 + m * 16) * DM + colt;
#pragma unroll
                    for (int bj = 0; bj < 2; ++bj) { const f32x4 v0 = acc[ai][bj][m][0] * QSCALE, v1 = acc[ai][bj][m][1] * QSCALE;
                        u32x4 w; w.x = pk2(v0[0], v0[1]); w.y = pk2(v0[2], v0[3]); w.z = pk2(v1[0], v1[1]); w.w = pk2(v1[2], v1[3]);
                        *(u32x4*)(rowp + bj * 128) = w; } }
        } else if (kind == 1) {
            bf16_t* KF = (bf16_t*)(ws + WS_K);
#pragma unroll
            for (int ai = 0; ai < 2; ++ai)
#pragma unroll
                for (int m = 0; m < 4; ++m) { const int row = row0 + ai * 128 + m * 16, b = row >> 11, st = row & 2047;
#pragma unroll
                    for (int bj = 0; bj < 2; ++bj) { const int c0 = colt + bj * 128, h = c0 >> 7, d0 = c0 & 127;
                        const size_t idx = ((((size_t)(b * NH + h) * 64 + (st >> 5)) * 8 + (d0 >> 4)) * 64 + (st & 31) + 32 * ((d0 >> 3) & 1)) * 8;
                        const f32x4 v0 = acc[ai][bj][m][0], v1 = acc[ai][bj][m][1];
                        u32x4 w; w.x = pk2(v0[0], v0[1]); w.y = pk2(v0[2], v0[3]); w.z = pk2(v1[0], v1[1]); w.w = pk2(v1[2], v1[3]);
                        *(u32x4*)(KF + idx) = w; } }
        } else {
            bf16_t* VF = (bf16_t*)(ws + WS_VT);
#pragma unroll
            for (int ai = 0; ai < 2; ++ai)
#pragma unroll
                for (int m = 0; m < 4; ++m) { const int row = row0 + ai * 128 + m * 16, b = row >> 11, st = row & 2047, k32 = st & 31, kk = k32 & 15;
                    const int slot = 4 * (kk >> 3) + (kk & 3), lhi = 32 * ((kk >> 2) & 1), s2 = k32 >> 4;
#pragma unroll
                    for (int bj = 0; bj < 2; ++bj) { const int c0 = colt + bj * 128, h = c0 >> 7, d0 = c0 & 127;
                        bf16_t* p = VF + (((((size_t)(b * NH + h) * 64 + (st >> 5)) * 4 + (d0 >> 5)) * 2 + s2) * 64 + (d0 & 31) + lhi) * 8 + slot;
#pragma unroll
                        for (int n = 0; n < 2; ++n)
#pragma unroll
                            for (int j = 0; j < 4; ++j) p[(4 * n + j) * 8] = f2bf(acc[ai][bj][m][n][j]); } }
        }
    }
};
template <bool RES_F32, bool OUT_F32>
struct EpiRes {
    static constexpr bool PERM = true;
    const void* res; void* out; float* part;
    __device__ __forceinline__ void prefetch(const Unit&, int, int, int) const {}
    __device__ __forceinline__ void operator()(const AccT& acc, const Unit& u, int wr, int wc, int fr, int fq, int) const {
        const int row0 = u.pm * 256 + wr * 64 + fr, col0 = u.pn * 256 + wc * 32 + 8 * fq;
        constexpr int NB = RES_F32 ? 4 : 8;
        f32x4 rf[RES_F32 ? 4 : 1][4]; u32x4 rh[RES_F32 ? 1 : 8][2];
#pragma unroll
        for (int g0 = 0; g0 < 8; g0 += NB) {
#pragma unroll
            for (int gi = 0; gi < NB; ++gi) { const int g = g0 + gi; const size_t off_ = (size_t)(row0 + (g >> 2) * 128 + (g & 3) * 16) * DM + col0;
                if (RES_F32) { const float* r_ = (const float*)res; rf[gi][0] = *(const f32x4*)(r_ + off_); rf[gi][1] = *(const f32x4*)(r_ + off_ + 4); rf[gi][2] = *(const f32x4*)(r_ + off_ + 128); rf[gi][3] = *(const f32x4*)(r_ + off_ + 132); }
                else { const bf16_t* r_ = (const bf16_t*)res; rh[gi][0] = *(const u32x4*)(r_ + off_); rh[gi][1] = *(const u32x4*)(r_ + off_ + 128); } }
#pragma unroll
            for (int gi = 0; gi < NB; ++gi) {
                const int g = g0 + gi, ai = g >> 2, m = g & 3;
                const int row = row0 + ai * 128 + m * 16; const size_t off = (size_t)row * DM + col0; float ss = 0.f;
#pragma unroll
                for (int bj = 0; bj < 2; ++bj) {
                    f32x4 r0, r1;
                    if (RES_F32) { r0 = rf[gi][2 * bj]; r1 = rf[gi][2 * bj + 1]; }
                    else { const u32x4 h = rh[gi][bj];
                        r0 = (f32x4){__uint_as_float(h.x << 16), __uint_as_float(h.x & 0xffff0000u), __uint_as_float(h.y << 16), __uint_as_float(h.y & 0xffff0000u)};
                        r1 = (f32x4){__uint_as_float(h.z << 16), __uint_as_float(h.z & 0xffff0000u), __uint_as_float(h.w << 16), __uint_as_float(h.w & 0xffff0000u)}; }
                    const f32x4 v0 = acc[ai][bj][m][0] + r0, v1 = acc[ai][bj][m][1] + r1;
                    if (OUT_F32) { float* o_ = (float*)out; *(f32x4*)(o_ + off + bj * 128) = v0; *(f32x4*)(o_ + off + bj * 128 + 4) = v1; }
                    else { bf16_t* o_ = (bf16_t*)out; u32x4 w; w.x = pk2(v0[0], v0[1]); w.y = pk2(v0[2], v0[3]); w.z = pk2(v1[0], v1[1]); w.w = pk2(v1[2], v1[3]); *(u32x4*)(o_ + off + bj * 128) = w; }
                    ss += (v0[0] * v0[0] + v0[1] * v0[1]) + (v0[2] * v0[2] + v0[3] * v0[3]) + (v1[0] * v1[0] + v1[1] * v1[1]) + (v1[2] * v1[2] + v1[3] * v1[3]); }
                if (part) { ss += __shfl_xor(ss, 16); ss += __shfl_xor(ss, 32); if (fq == 0) part[(size_t)row * 32 + u.pn * 4 + wc] = ss; }
            }
        }
    }
};
#define CONV_DPP4(C, X, W, CTRL) asm volatile("s_nop 1\n\t" \
        "v_fmac_f32_dpp %0, %4, %8 " CTRL " row_mask:0xf bank_mask:0xf bound_ctrl:1\n\t" \
        "v_fmac_f32_dpp %1, %5, %9 " CTRL " row_mask:0xf bank_mask:0xf bound_ctrl:1\n\t" \
        "v_fmac_f32_dpp %2, %6, %10 " CTRL " row_mask:0xf bank_mask:0xf bound_ctrl:1\n\t" \
        "v_fmac_f32_dpp %3, %7, %11 " CTRL " row_mask:0xf bank_mask:0xf bound_ctrl:1" \
        : "+v"(C[0]), "+v"(C[1]), "+v"(C[2]), "+v"(C[3]) : "v"(X[0]), "v"(X[1]), "v"(X[2]), "v"(X[3]), "v"(W[0]), "v"(W[1]), "v"(W[2]), "v"(W[3]))
struct EpiUpConv {
    static constexpr bool PERM = true;
    bf16_t* ACT; const float* cw; const float* cb; LAS float* hal; const LAS float* rtab;
    __device__ __forceinline__ void prefetch(const Unit& u, int ui, int tid, int wid) const {
        if (wid < 4) { const int q = tid >> 5, bj = q >> 2, t = q & 3, col = 4 * (tid & 31);
            const float* src = (t < 3 ? cw + (size_t)t * NUP : cb) + bj * FF + u.pn * 128 + col;
            __builtin_amdgcn_global_load_lds((const unsigned*)src, (LAS unsigned*)((LAS unsigned char*)rtab + 8192 + (ui & 1) * 4096 + wid * 1024), 16, 0, 0); }
    }
    __device__ __forceinline__ void operator()(AccT& acc, const Unit& u, int wr, int wc, int fr, int fq, int ui) const {
#pragma unroll
        for (int ai = 0; ai < 2; ++ai)
#pragma unroll
            for (int m = 0; m < 4; ++m) { const float rs = rtab[ui * 256 + ai * 128 + wr * 64 + m * 16 + fr];
#pragma unroll
                for (int bj = 0; bj < 2; ++bj) { acc[ai][bj][m][0] *= rs; acc[ai][bj][m][1] *= rs; } }
        const int colw = wc * 32 + 8 * fq;
        if (fr >= 14) {
#pragma unroll
            for (int ai = 0; ai < 2; ++ai)
#pragma unroll
                for (int bj = 0; bj < 2; ++bj)
#pragma unroll
                    for (int n = 0; n < 2; ++n) *(LAS f32x4*)(hal + ((ai * 2 + wr) * 2 + (fr - 14)) * 256 + bj * 128 + colw + 4 * n) = acc[ai][bj][3][n];
        }
        asm volatile("s_waitcnt lgkmcnt(0)" ::: "memory"); __builtin_amdgcn_s_barrier(); asm volatile("" ::: "memory");
        const int r_lo = 254 * u.pm - 2, r_first = r_lo < 0 ? 0 : r_lo, r_hi = r_lo + 255;
        const bool has_bnd = ((r_first & 2047) <= 1) || ((r_hi >> 11) != (r_first >> 11));
        u32x2 pk0[2][4];
#pragma unroll
        for (int n = 0; n < 2; ++n) {
            const int ch = u.pn * 128 + colw + 4 * n;
            f32x4 w[2][3], bb[2];
            { const LAS float* wl = (const LAS float*)((const LAS unsigned char*)rtab + 8192 + (ui & 1) * 4096) + colw + 4 * n;
#pragma unroll
                for (int bj = 0; bj < 2; ++bj) { bb[bj] = *(const LAS f32x4*)(wl + (bj * 4 + 3) * 128);
#pragma unroll
                    for (int t = 0; t < 3; ++t) w[bj][t] = *(const LAS f32x4*)(wl + (bj * 4 + t) * 128); } }
#pragma unroll
            for (int ai = 0; ai < 2; ++ai)
#pragma unroll
                for (int m = 0; m < 4; ++m) {
                    const int lrow = ai * 128 + wr * 64 + m * 16 + fr, grow = 254 * u.pm - 2 + lrow;
                    f32x4 cv[2];
#pragma unroll
                    for (int bj = 0; bj < 2; ++bj) {
                        f32x4 w0 = w[bj][0], w1 = w[bj][1];
                        if (has_bnd) { const int pos = grow & 2047; if (pos < 2) w0 = (f32x4){0.f, 0.f, 0.f, 0.f}; if (pos < 1) w1 = (f32x4){0.f, 0.f, 0.f, 0.f}; }
                        const f32x4 cur = acc[ai][bj][m][n];
                        f32x4 c = bb[bj] + w[bj][2] * cur;
                        CONV_DPP4(c, cur, w1, "row_shr:1"); CONV_DPP4(c, cur, w0, "row_shr:2");
                        if (m > 0) { const f32x4 pv = acc[ai][bj][m - 1][n]; CONV_DPP4(c, pv, w1, "row_shl:15"); CONV_DPP4(c, pv, w0, "row_shl:14"); }
                        else { const int slab = ai * 2 + wr - 1;
                            if (slab >= 0) { const f32x4 h1 = *(const LAS f32x4*)(hal + (slab * 2 + 1) * 256 + bj * 128 + colw + 4 * n), h2 = *(const LAS f32x4*)(hal + (slab * 2) * 256 + bj * 128 + colw + 4 * n);
                                if (fr == 0) c += w1 * h1 + w0 * h2; else if (fr == 1) c += w0 * h1; } }
                        cv[bj] = c;
                    }
                    float a4[4];
#pragma unroll
                    for (int e = 0; e < 4; ++e) { const float gx = cv[0][e]; a4[e] = gx * __builtin_amdgcn_rcpf(1.0f + __expf(-gx)) * cv[1][e]; }
                    if (n == 0) { pk0[ai][m].x = pk2(a4[0], a4[1]); pk0[ai][m].y = pk2(a4[2], a4[3]); }
                    else if (lrow >= 2 && grow < MTOK) { u32x4 o; o.x = pk0[ai][m].x; o.y = pk0[ai][m].y; o.z = pk2(a4[0], a4[1]); o.w = pk2(a4[2], a4[3]); *(u32x4*)(ACT + (size_t)grow * FF + ch - 4) = o; }
                }
        }
    }
};
struct EpiDsaIn {
    static constexpr bool PERM = false;
    unsigned char* ws; LAS float* scr; const LAS float* rtab;
    __device__ __forceinline__ void prefetch(const Unit&, int, int, int) const {}
    __device__ __forceinline__ void operator()(const AccT& acc_in, const Unit& u, int wr, int wc, int fr, int fq, int ui) const {
        const int row0 = u.pm * 256 + wr * 64 + fr;
        const float* ropeC = (const float*)(ws + WS_ROPE); const float* ropeS = ropeC + SEQ * 64;
        bf16_t* VTD = (bf16_t*)(ws + WS_VTD); float* WI = (float*)(ws + WS_WI);
        const bool need_norm = (u.pn < 10) || (u.pn == 20);
        float rs[2][4];
#pragma unroll
        for (int ai = 0; ai < 2; ++ai)
#pragma unroll
            for (int m = 0; m < 4; ++m) rs[ai][m] = rtab[ui * 256 + ai * 128 + wr * 64 + m * 16 + fr];
        if (need_norm) {
#pragma unroll
            for (int ai = 0; ai < 2; ++ai)
#pragma unroll
                for (int m = 0; m < 4; ++m)
#pragma unroll
                    for (int bj = 0; bj < 2; ++bj) { const f32x4 a = acc_in[ai][bj][m][0], b = acc_in[ai][bj][m][1];
                        float ss = ((a[0] * a[0] + a[1] * a[1]) + (a[2] * a[2] + a[3] * a[3])) + ((b[0] * b[0] + b[1] * b[1]) + (b[2] * b[2] + b[3] * b[3]));
                        ss += __shfl_xor(ss, 16); ss += __shfl_xor(ss, 32);
                        if (fq == 0) scr[(ai * 128 + wr * 64 + m * 16 + fr) * 8 + bj * 4 + wc] = ss * rs[ai][m] * rs[ai][m]; }
            asm volatile("s_waitcnt lgkmcnt(0)" ::: "memory"); __builtin_amdgcn_s_barrier(); asm volatile("" ::: "memory");
        }
        const int dl = 16 * wc + 8 * (fq & 1) + 4 * (fq >> 1);
#pragma unroll
        for (int bj = 0; bj < 2; ++bj) {
            const int hh = 2 * u.pn + bj;
            if (hh >= 20 && hh < 24) {
#pragma unroll
                for (int ai = 0; ai < 2; ++ai)
#pragma unroll
                    for (int m = 0; m < 4; ++m) { const int row = row0 + ai * 128 + m * 16, b = row >> 11, s0 = row & 2047, s = (s0 & ~12) | ((s0 & 4) << 1) | ((s0 & 8) >> 1); const float r = rs[ai][m];
                        bf16_t* p = VTD + ((size_t)(b * KVH + (hh - 20)) * HD + dl) * SEQ + s;
#pragma unroll
                        for (int n = 0; n < 2; ++n)
#pragma unroll
                            for (int e = 0; e < 4; ++e) p[(size_t)(64 * n + e) * SEQ] = f2bf(acc_in[ai][bj][m][n][e] * r); }
            } else if (hh == 41) {
                if (wc == 0) {
#pragma unroll
                    for (int ai = 0; ai < 2; ++ai)
#pragma unroll
                        for (int m = 0; m < 4; ++m) { const int row = row0 + ai * 128 + m * 16; *(f32x4*)(WI + (size_t)row * 16 + dl) = acc_in[ai][bj][m][0] * rs[ai][m]; } }
            } else {
                const bool norm = (hh < 20) || (hh == 40);
                const float* g = (const float*)(ws + WS_GAIN) + (hh < 16 ? 0 : (hh < 20 ? 128 : 256));
                f32x4 g0 = (f32x4){1.f, 1.f, 1.f, 1.f}, g1 = g0;
                if (norm) { g0 = *(const f32x4*)(g + dl); g1 = *(const f32x4*)(g + dl + 64); }
                size_t boff; int ld, cb;
                if (hh < 16) { boff = WS_Q; ld = DM; cb = hh * HD; } else if (hh < 20) { boff = WS_KD; ld = KVH * HD; cb = (hh - 16) * HD; }
                else if (hh < 40) { boff = WS_QI; ld = DM; cb = (hh - 24) * HD; } else { boff = WS_KI; ld = HD; cb = 0; }
                bf16_t* base = (bf16_t*)(ws + boff);
                const float osc = hh < 16 ? QSCALE : 1.0f;
#pragma unroll
                for (int ai = 0; ai < 2; ++ai)
#pragma unroll
                    for (int m = 0; m < 4; ++m) { const int lrow = ai * 128 + wr * 64 + m * 16 + fr, row = u.pm * 256 + lrow, pos = row & 2047;
                        float sc = rs[ai][m];
                        if (norm) { const f32x4 t = *(const LAS f32x4*)(scr + lrow * 8 + bj * 4); sc *= __builtin_amdgcn_rsqf(((t[0] + t[1]) + (t[2] + t[3])) * (1.0f / HD) + NORM_EPS); }
                        sc *= osc;
                        const f32x4 c = *(const f32x4*)(ropeC + pos * 64 + dl), sn = *(const f32x4*)(ropeS + pos * 64 + dl);
                        const f32x4 y0 = acc_in[ai][bj][m][0] * g0 * sc, y1 = acc_in[ai][bj][m][1] * g1 * sc;
                        const f32x4 o0 = y0 * c - y1 * sn, o1 = y1 * c + y0 * sn;
                        unsigned ax = pk2(o0[0], o0[1]), ay = pk2(o0[2], o0[3]), bx = pk2(o1[0], o1[1]), by = pk2(o1[2], o1[3]);
                        { auto rr = __builtin_amdgcn_permlane32_swap(ax, bx, false, false); ax = rr[0]; bx = rr[1]; }
                        { auto rr = __builtin_amdgcn_permlane32_swap(ay, by, false, false); ay = rr[0]; by = rr[1]; }
                        bf16_t* rp = base + (size_t)row * ld + cb + dl + 60 * (fq >> 1);
                        *(u32x4*)rp = (u32x4){ax, ay, bx, by}; }
            }
        }
    }
};

enum { WM_PLAIN = 0, WM_UP = 1, WM_IN = 2 };
__device__ __forceinline__ int colmap(int kind, int np) {
    if (kind == WM_UP) { const int pn = np >> 8, bj = (np >> 7) & 1, q = np & 127; return bj * FF + 128 * pn + q; }
    if (kind == WM_IN) { const int hh = np >> 7, p = np & 127, fq = (p >> 2) & 3, d = 16 * (p >> 5) + 8 * (fq & 1) + 4 * (fq >> 1) + (p & 3) + 64 * ((p >> 4) & 1);
        if (hh < 41) return hh * 128 + d; return (d < 16) ? (5248 + d) : -1; }
    return np;
}
struct WJ { const float* W; const float* gain; bf16_t* WT; int K, N, NP, kind, local; };
__device__ __forceinline__ void tr_load(const WJ& j, int lane, f32x4 (&v)[16]) {
    const int nblk = j.NP / 64, kb = j.local / nblk, nb = j.local - kb * nblk, k0 = 64 * kb, n0 = 64 * nb;
    int ln = lane; asm volatile("" : "+v"(ln));
    const int src = colmap(j.kind, n0 + 4 * (ln & 15)), rg = lane >> 4;
    const float* p = j.W + (size_t)(k0 + rg) * j.N + (src >= 0 ? src : 0);
#pragma unroll
    for (int i = 0; i < 16; ++i) { v[i] = __builtin_nontemporal_load((const f32x4*)(p + (size_t)(4 * i) * j.N)); if (src < 0) v[i] = (f32x4){0.f, 0.f, 0.f, 0.f}; }
}
__device__ __forceinline__ void tr_process(const WJ& j, int lane, const f32x4 (&v)[16], LAS float* scr) {
    const int nblk = j.NP / 64, kb = j.local / nblk, nb = j.local - kb * nblk, k0 = 64 * kb, n0 = 64 * nb;
    const int rg = lane >> 4, cg = lane & 15;
    float gl = 1.0f; if (j.gain) gl = j.gain[k0 + lane];
#pragma unroll
    for (int i = 0; i < 16; ++i) { const int kk = 4 * i + rg; const float g = __shfl(gl, kk); LAS float* d = scr + kk * 65 + 4 * cg;
        d[0] = v[i][0] * g; d[1] = v[i][1] * g; d[2] = v[i][2] * g; d[3] = v[i][3] * g; }
    asm volatile("s_waitcnt lgkmcnt(0)" ::: "memory");
    const int c = lane & 7;
#pragma unroll
    for (int jj = 0; jj < 8; ++jj) { const int n = (lane >> 3) + 8 * jj; const LAS float* s = scr + (8 * c) * 65 + n;
        u32x4 o; o.x = pk2(s[0 * 65], s[1 * 65]); o.y = pk2(s[2 * 65], s[3 * 65]); o.z = pk2(s[4 * 65], s[5 * 65]); o.w = pk2(s[6 * 65], s[7 * 65]);
        *(u32x4*)(j.WT + (size_t)(n0 + n) * j.K + k0 + 8 * c) = o; }
    asm volatile("s_waitcnt lgkmcnt(0)" ::: "memory");
}

struct Args {
    const float* x; const float* attn_g; const float* ffn_g; const float* w_qkv; const float* w_o0; const float* w_in;
    const float* qn_g; const float* kn_g; const float* ikn_g; const float* w_o1; const float* w_up; const float* conv_w; const float* conv_b; const float* w_down;
    float* out; unsigned char* ws; int ph_lo, ph_hi;
};

constexpr int WI0 = 32 * 96, WI1 = WI0 + 32 * 32, WI2 = WI1 + 32 * 84, WI3 = WI2 + 32 * 32, WI4 = WI3 + 32 * 176, WI5 = WI4 + 32 * 176, WI6 = WI5 + 88 * 32, WI7 = WI6 + 88 * 32;
__device__ __forceinline__ WJ wj_decode(const Args& a, int it) {
    unsigned char* ws = a.ws; WJ j;
    if (it < WI0)      j = WJ{a.w_qkv, nullptr, (bf16_t*)(ws + WS_WQKV), DM, NQKV, NQKV, WM_PLAIN, it};
    else if (it < WI1) j = WJ{a.w_o0, nullptr, (bf16_t*)(ws + WS_WO0), DM, DM, DM, WM_PLAIN, it - WI0};
    else if (it < WI2) j = WJ{a.w_in, a.attn_g + DM, (bf16_t*)(ws + WS_WIN), DM, NIN, NINP, WM_IN, it - WI1};
    else if (it < WI3) j = WJ{a.w_o1, nullptr, (bf16_t*)(ws + WS_WO1), DM, DM, DM, WM_PLAIN, it - WI2};
    else if (it < WI4) j = WJ{a.w_up, a.ffn_g, (bf16_t*)(ws + WS_WUP), DM, NUP, NUP, WM_UP, it - WI3};
    else if (it < WI5) j = WJ{a.w_up + (size_t)DM * NUP, a.ffn_g + DM, (bf16_t*)(ws + WS_WUP + 44 * MiB), DM, NUP, NUP, WM_UP, it - WI4};
    else if (it < WI6) j = WJ{a.w_down, nullptr, (bf16_t*)(ws + WS_WDN), FF, DM, DM, WM_PLAIN, it - WI5};
    else               j = WJ{a.w_down + (size_t)FF * DM, nullptr, (bf16_t*)(ws + WS_WDN + 22 * MiB), FF, DM, DM, WM_PLAIN, it - WI6};
    return j;
}
__device__ __forceinline__ void convert_items(const Args& a, LAS float* scr, int lo1, int hi1, int lo2, int hi2, int vw, int nvw, int lane) {
    const int n1 = hi1 - lo1, hi = n1 + (hi2 - lo2);
#define CV_ITEM(v) wj_decode(a, (v) < n1 ? lo1 + (v) : lo2 + ((v) - n1))
    int it = vw;
    if (it >= hi) return;
    f32x4 va[16], vb[16];
    WJ ja = CV_ITEM(it), jb = ja;
    tr_load(ja, lane, va);
#pragma nounroll
    for (;;) {
        int nx = it + nvw; bool hn = nx < hi;
        if (hn) { jb = CV_ITEM(nx); tr_load(jb, lane, vb); }
        tr_process(ja, lane, va, scr);
        if (!hn) break;
        it = nx; nx = it + nvw; hn = nx < hi;
        if (hn) { ja = CV_ITEM(nx); tr_load(ja, lane, va); }
        tr_process(jb, lane, vb, scr);
        if (!hn) break;
        it = nx;
    }
#undef CV_ITEM
}
struct Offload { int g_up, g_in; bool up0, in1, up1; };
__device__ __forceinline__ Offload make_offload(int G) {
    Offload o; const int u_up = 33 * (NUP / 256), u_in = (MTOK / 256) * (NINP / 256);
    const int r_up = (u_up + G - 1) / G, r_in = (u_in + G - 1) / G;
    o.g_up = (u_up + r_up - 1) / r_up; o.g_in = (u_in + r_in - 1) / r_in;
    o.up0 = (G - o.g_up) >= 8; o.up1 = o.up0; o.in1 = (G - o.g_in) >= 16;
    return o;
}
__device__ __forceinline__ void prologue_phase(const Args& a, LAS unsigned char* lds, int gw, int ngw, int wave, int lane, const Offload& offl) {
    unsigned char* ws = a.ws;
    LAS float* scr = (LAS float*)(lds + wave * 16640);
    convert_items(a, scr, 0, WI0, 0, 0, gw, ngw, lane);
    if (!offl.up0 || !offl.in1 || !offl.up1) {
        if (!offl.up0) convert_items(a, scr, WI5, WI6, WI2, WI3, gw, ngw, lane);
        if (!offl.in1) convert_items(a, scr, WI4, WI5, 0, 0, gw, ngw, lane);
        if (!offl.up1) convert_items(a, scr, WI6, WI7, 0, 0, gw, ngw, lane);
    }
    bf16_t* XB = (bf16_t*)(ws + WS_XB);
    for (int m = gw; m < MTOK; m += 2 * ngw) {
        const int m2 = m + ngw; const bool has2 = m2 < MTOK;
        const f32x4* xr = (const f32x4*)(a.x + (size_t)m * DM) + lane; const f32x4* xr2 = (const f32x4*)(a.x + (size_t)(has2 ? m2 : m) * DM) + lane;
        f32x4 v[8], v2[8]; float s = 0.f, s2 = 0.f;
#pragma unroll
        for (int j = 0; j < 8; ++j) { v[j] = xr[64 * j]; v2[j] = xr2[64 * j]; }
#pragma unroll
        for (int j = 0; j < 8; ++j) { s += (v[j].x * v[j].x + v[j].y * v[j].y) + (v[j].z * v[j].z + v[j].w * v[j].w); s2 += (v2[j].x * v2[j].x + v2[j].y * v2[j].y) + (v2[j].z * v2[j].z + v2[j].w * v2[j].w); }
        const float rstd = 1.0f / sqrtf(wave_sum(s) * (1.0f / DM) + NORM_EPS), rstd2 = 1.0f / sqrtf(wave_sum(s2) * (1.0f / DM) + NORM_EPS);
        u32x2* o8 = (u32x2*)(XB + (size_t)m * DM) + lane; u32x2* o82 = (u32x2*)(XB + (size_t)m2 * DM) + lane;
#pragma unroll
        for (int j = 0; j < 8; ++j) { const f32x4 g = ((const f32x4*)a.attn_g)[lane + 64 * j];
            u32x2 w; w.x = pk2(v[j].x * rstd * g.x, v[j].y * rstd * g.y); w.y = pk2(v[j].z * rstd * g.z, v[j].w * rstd * g.w); o8[64 * j] = w;
            if (has2) { u32x2 w2; w2.x = pk2(v2[j].x * rstd2 * g.x, v2[j].y * rstd2 * g.y); w2.y = pk2(v2[j].z * rstd2 * g.z, v2[j].w * rstd2 * g.w); o82[64 * j] = w2; } }
    }
    if (gw == 0) { float* gn = (float*)(ws + WS_GAIN); for (int i = lane; i < 128; i += 64) { gn[i] = a.qn_g[i]; gn[128 + i] = a.kn_g[i]; gn[256 + i] = a.ikn_g[i]; } }
    float* rc = (float*)(ws + WS_ROPE); float* rsn = rc + SEQ * 64;
    for (int i = gw * 64 + lane; i < SEQ * 64; i += ngw * 64) {
        const int pos = i >> 6, fi = i & 63;
        const float inv_freq = (float)(1.0 / exp2((double)fi * (2.0 / 128.0) * 13.287712379549449));
        const float ang = (float)pos * inv_freq;
        const double x = (double)ang; const double kq = rint(x * 0.63661977236758134308);
        double r = __builtin_fma(-kq, 1.57079632679489655800e+00, x); r = __builtin_fma(-kq, 6.12323399573676603587e-17, r);
        const double r2 = r * r;
        double sp = -1.0 / 6227020800.0; sp = sp * r2 + 1.0 / 39916800.0; sp = sp * r2 - 1.0 / 362880.0; sp = sp * r2 + 1.0 / 5040.0; sp = sp * r2 - 1.0 / 120.0; sp = sp * r2 + 1.0 / 6.0; const double sv = r - r * r2 * sp;
        double cp = 1.0 / 87178291200.0; cp = cp * r2 - 1.0 / 479001600.0; cp = cp * r2 + 1.0 / 3628800.0; cp = cp * r2 - 1.0 / 40320.0; cp = cp * r2 + 1.0 / 720.0; cp = cp * r2 - 1.0 / 24.0; cp = cp * r2 + 0.5; const double cv = 1.0 - r2 * cp;
        const int q = ((int)kq) & 3;
        const double cs = (q == 0) ? cv : (q == 1) ? -sv : (q == 2) ? -cv : sv;
        const double sn = (q == 0) ? sv : (q == 1) ? cv : (q == 2) ? -sv : -cv;
        rc[i] = (float)cs; rsn[i] = (float)sn;
    }
}

constexpr float SB_EXIT = 220.0f;
__device__ __forceinline__ unsigned fmap(float f) { const unsigned u = __float_as_uint(f); return (u & 0x80000000u) ? ~u : (u | 0x80000000u); }


__device__ __forceinline__ void store_o_rows16(bf16_t* row_base  , const f32x16 (&o)[4], float scale, int hh) {
    unsigned char* bp = (unsigned char*)row_base + (hh ? 16 : 0);
#pragma unroll
    for (int d = 0; d < 4; ++d)
#pragma unroll
        for (int g = 0; g < 4; g += 2) {
            unsigned ax = pk2(o[d][4 * g] * scale, o[d][4 * g + 1] * scale), ay = pk2(o[d][4 * g + 2] * scale, o[d][4 * g + 3] * scale);
            unsigned bx = pk2(o[d][4 * g + 4] * scale, o[d][4 * g + 5] * scale), by = pk2(o[d][4 * g + 6] * scale, o[d][4 * g + 7] * scale);
            { auto rr = __builtin_amdgcn_permlane32_swap(ax, bx, false, false); ax = rr[0]; bx = rr[1]; }
            { auto rr = __builtin_amdgcn_permlane32_swap(ay, by, false, false); ay = rr[0]; by = rr[1]; }
            *(u32x4*)(bp + 16 * (4 * d + g)) = (u32x4){ax, ay, bx, by};
        }
}

constexpr int KSTR = 272, VSTR = 144, KTILE_B = 64 * KSTR, VTILE_B = 128 * VSTR, KVBUF_B = KTILE_B + VTILE_B;
struct KVStage {
    u32x4 k[2], v[2];
    __device__ __forceinline__ void load(const unsigned char* kg, size_t kstride, const unsigned char* vg, size_t vstride, int tid) {
#pragma unroll
        for (int i = 0; i < 2; ++i) { const int c = tid + 512 * i; k[i] = *(const u32x4*)(kg + (size_t)(c >> 4) * kstride + (c & 15) * 16); v[i] = *(const u32x4*)(vg + (size_t)(c >> 3) * vstride + (c & 7) * 16); }
    }
    __device__ __forceinline__ void store(LAS unsigned char* buf, int tid) const {
#pragma unroll
        for (int i = 0; i < 2; ++i) { const int c = tid + 512 * i;
            *(LAS u32x4*)(buf + (c >> 4) * KSTR + (c & 15) * 16) = k[i];
            *(LAS u32x4*)(buf + KTILE_B + (c >> 3) * VSTR + (c & 7) * 16) = v[i]; }
    }
};

__device__ __forceinline__ void dsa_attn_block(const bf16_t* __restrict__ QD, const bf16_t* __restrict__ KD, const bf16_t* __restrict__ VTD, const unsigned* __restrict__ MASK, bf16_t* __restrict__ O,
                                               LAS unsigned char* lds, int b, int g, int qb64, int wave, int lane, int tid) {
    const int r = lane & 31, hh = lane >> 5, h = 4 * g + (wave & 3), q0 = 64 * qb64 + 32 * (wave >> 2);
    LAS unsigned char* qlds = lds + 2 * KVBUF_B + wave * (32 * KSTR);
    { const unsigned char* qg = (const unsigned char*)(QD + (size_t)(b * SEQ + q0) * DM + h * HD);
        u32x4 t[8];
#pragma unroll
        for (int i = 0; i < 8; ++i) { const int c = lane + 64 * i; t[i] = *(const u32x4*)(qg + (size_t)(c >> 4) * (DM * 2) + (c & 15) * 16); }
#pragma unroll
        for (int i = 0; i < 8; ++i) { const int c = lane + 64 * i; *(LAS u32x4*)(qlds + (c >> 4) * KSTR + (c & 15) * 16) = t[i]; }
        asm volatile("s_waitcnt lgkmcnt(0)" ::: "memory"); }
    const LAS unsigned char* qfp = qlds + r * KSTR + 16 * hh;
    f32x16 o[4];
#pragma unroll
    for (int d = 0; d < 4; ++d) o[d] = f32x16{};
    float mrun = -1e29f, lrun = 0.f;
    const unsigned char* kg = (const unsigned char*)(KD + (size_t)(b * SEQ) * (KVH * HD) + g * HD);
    const unsigned char* vg = (const unsigned char*)(VTD + (size_t)(b * KVH + g) * HD * SEQ);
    const unsigned long long* mrow = (const unsigned long long*)(MASK + (size_t)(b * SEQ + q0 + r) * 64);
    KVStage sA, sB;
#define MA_LOAD(ST, t) ST.load(kg + (size_t)(t) * 64 * (KVH * HD * 2), KVH * HD * 2, vg + (size_t)(t) * 64 * 2, SEQ * 2, tid)
    MA_LOAD(sA, 0);
    sA.store(lds, tid);
    asm volatile("s_waitcnt lgkmcnt(0)" ::: "memory"); __builtin_amdgcn_s_barrier(); asm volatile("" ::: "memory");
    if (qb64 >= 1) MA_LOAD(sA, 1);
    if (qb64 >= 2) MA_LOAD(sB, 2);
    unsigned long long mw_next = mrow[0];
    for (int kt = 0; kt <= qb64; ++kt) {
        LAS unsigned char* buf = lds + (kt & 1) * KVBUF_B;
        const unsigned long long mw = mw_next;
        if (kt < qb64) mw_next = mrow[kt + 1];
        const bool two = (64 * kt + 32) <= q0 + 31;
        f32x16 p0 = f32x16{}, p1 = f32x16{};
        { const LAS unsigned char* kp = buf + r * KSTR + 16 * hh;
            bf16x8 qf[8];
#pragma unroll
            for (int s = 0; s < 8; ++s) qf[s] = *(const LAS bf16x8*)(qfp + 32 * s);
#pragma unroll
            for (int s = 0; s < 8; ++s) p0 = __builtin_amdgcn_mfma_f32_32x32x16_bf16(*(const LAS bf16x8*)(kp + 32 * s), qf[s], p0, 0, 0, 0);
            if (two) {
#pragma unroll
                for (int s = 0; s < 8; ++s) p1 = __builtin_amdgcn_mfma_f32_32x32x16_bf16(*(const LAS bf16x8*)(kp + 32 * KSTR + 32 * s), qf[s], p1, 0, 0, 0); } }
        const int m0 = (int)(((unsigned)mw) >> (4 * hh)), m1 = two ? (int)(((unsigned)(mw >> 32)) >> (4 * hh)) : 0;
        const unsigned NEGB = 0xf149f2cau;
#pragma unroll
        for (int i = 0; i < 16; ++i) { const int kb = crow(i, 0);
            const unsigned t0 = (unsigned)((m0 << (31 - kb)) >> 31), t1 = (unsigned)((m1 << (31 - kb)) >> 31);
            p0[i] = __uint_as_float((__float_as_uint(p0[i]) & t0) | (NEGB & ~t0)); p1[i] = __uint_as_float((__float_as_uint(p1[i]) & t1) | (NEGB & ~t1)); }
        float tmax = fmaxf(p0[0], p1[0]);
#pragma unroll
        for (int i = 1; i < 16; ++i) tmax = fmaxf(fmaxf(tmax, p0[i]), p1[i]);
        tmax = swap_max(tmax);
        const bool grow = __any(tmax > mrun + 8.0f);
        const float mnew = grow ? fmaxf(mrun, tmax) : mrun;
        if (grow) {
            const float alpha = __builtin_amdgcn_exp2f(mrun - mnew);
            lrun *= alpha;
#pragma unroll
            for (int d = 0; d < 4; ++d)
#pragma unroll
                for (int i = 0; i < 16; ++i) o[d][i] *= alpha;
        }
        float ls = 0.f;
#pragma unroll
        for (int i = 0; i < 16; ++i) { const float e0 = __builtin_amdgcn_exp2f(p0[i] - mnew), e1 = __builtin_amdgcn_exp2f(p1[i] - mnew); p0[i] = e0; p1[i] = e1; ls += e0 + e1; }
        lrun += ls; mrun = mnew;
        const bf16x8 pa0 = pack8(p0, 0), pa1 = pack8(p0, 8), pa2 = pack8(p1, 0), pa3 = pack8(p1, 8);
        const LAS unsigned char* vb = buf + KTILE_B + r * VSTR + 16 * hh;
#pragma unroll
        for (int d = 0; d < 4; ++d) {
            const LAS unsigned char* vp = vb + 32 * d * VSTR;
#define VFRAG(ks) (*(const LAS bf16x8*)(vp + 32 * (ks)))
            o[d] = __builtin_amdgcn_mfma_f32_32x32x16_bf16(VFRAG(0), pa0, o[d], 0, 0, 0);
            o[d] = __builtin_amdgcn_mfma_f32_32x32x16_bf16(VFRAG(1), pa1, o[d], 0, 0, 0);
            if (two) { o[d] = __builtin_amdgcn_mfma_f32_32x32x16_bf16(VFRAG(2), pa2, o[d], 0, 0, 0);
                       o[d] = __builtin_amdgcn_mfma_f32_32x32x16_bf16(VFRAG(3), pa3, o[d], 0, 0, 0); }
#undef VFRAG
        }
        if (kt & 1) { if (kt + 1 <= qb64) sB.store(lds + ((kt + 1) & 1) * KVBUF_B, tid); if (kt + 3 <= qb64) MA_LOAD(sB, kt + 3); }
        else        { if (kt + 1 <= qb64) sA.store(lds + ((kt + 1) & 1) * KVBUF_B, tid); if (kt + 3 <= qb64) MA_LOAD(sA, kt + 3); }
        asm volatile("s_waitcnt lgkmcnt(0)" ::: "memory"); __builtin_amdgcn_s_barrier(); asm volatile("" ::: "memory");
    }
#undef MA_LOAD
    asm volatile("s_waitcnt vmcnt(0)" ::: "memory");
    const float linv = 1.0f / swap_sum(lrun);
    store_o_rows16(O + (size_t)(b * SEQ + q0 + r) * DM + h * HD, o, linv, hh);
}


__device__ __forceinline__ unsigned wave_total_u32(unsigned v) {
    v += (unsigned)__builtin_amdgcn_update_dpp(0, (int)v, 0x111, 0xf, 0xf, true);
    v += (unsigned)__builtin_amdgcn_update_dpp(0, (int)v, 0x112, 0xf, 0xf, true);
    v += (unsigned)__builtin_amdgcn_update_dpp(0, (int)v, 0x114, 0xf, 0xf, true);
    v += (unsigned)__builtin_amdgcn_update_dpp(0, (int)v, 0x118, 0xf, 0xf, true);
    v += (unsigned)__builtin_amdgcn_update_dpp(0, (int)v, 0x142, 0xa, 0xf, false);
    v += (unsigned)__builtin_amdgcn_update_dpp(0, (int)v, 0x143, 0xc, 0xf, false);
    return (unsigned)__builtin_amdgcn_readlane((int)v, 63);
}
__device__ __forceinline__ void causal_mask_row(unsigned* mrow, int t, int lane) {
    const int key0 = 32 * lane; unsigned w;
    if (key0 + 31 <= t) w = 0xffffffffu; else if (key0 > t) w = 0u; else w = (1u << (t - key0 + 1)) - 1u;
    mrow[lane] = w;
}
__device__ __forceinline__ void write_topk_mask(const unsigned (&uv)[32], unsigned prefix, unsigned* mrow, int lane) {
    int cgt = 0;
#pragma unroll
    for (int e = 0; e < 32; ++e) cgt += __popcll(__ballot(uv[e] > prefix));
    const int need = TOPK - cgt; int running = 0;
    const unsigned long long ltm = (1ull << lane) - 1ull;
    unsigned long long keep = 0ull;
#pragma unroll
    for (int e = 0; e < 32; ++e) {
        const unsigned long long eq = __ballot(uv[e] == prefix);
        const bool sel = (uv[e] > prefix) || (uv[e] == prefix && (running + __popcll(eq & ltm)) < need);
        const unsigned long long m64 = __ballot(sel);
        running += __popcll(eq);
        if (lane == e) keep = m64;
    }
    if (lane < 32) *(unsigned long long*)(mrow + 2 * lane) = keep;
}
__device__ __forceinline__ void select_two(const float* rowa, const float* rowb, int ta, unsigned* mrowa, unsigned* mrowb, int lane) {
    const int tb = ta + 1, na = ta + 1, nb = tb + 1;
    if (nb <= TOPK) { causal_mask_row(mrowa, ta, lane); causal_mask_row(mrowb, tb, lane); return; }
    float fa[32], fb[32];
#pragma unroll
    for (int e = 0; e < 32; ++e) { fa[e] = __builtin_nontemporal_load(rowa + e * 64 + lane); fb[e] = __builtin_nontemporal_load(rowb + e * 64 + lane); }
    unsigned ua[32], ub[32];
#pragma unroll
    for (int e = 0; e < 32; ++e) { const int key = e * 64 + lane; const unsigned ma = fmap(fa[e]), mb = fmap(fb[e]); ua[e] = (key < na) ? ma : 0x007fffffu; ub[e] = (key < nb) ? mb : 0x007fffffu; }
    unsigned pa = 0u, pb = 0u; bool da = false, db = false;
    for (int bit = 31; bit >= 0; --bit) {
        const unsigned ca = pa | (1u << bit), cb = pb | (1u << bit);
        unsigned na_ = 0u, nb_ = 0u;
#pragma unroll
        for (int e = 0; e < 32; ++e) { na_ += (ua[e] >= ca) ? 1u : 0u; nb_ += (ub[e] >= cb) ? 1u : 0u; }
        const unsigned tota = wave_total_u32(na_), totb = wave_total_u32(nb_);
        if (!da && tota >= (unsigned)TOPK) { pa = ca; if (tota == (unsigned)TOPK) da = true; }
        if (!db && totb >= (unsigned)TOPK) { pb = cb; if (totb == (unsigned)TOPK) db = true; }
        if (da && db) break;
    }
    if (na <= TOPK) causal_mask_row(mrowa, ta, lane); else write_topk_mask(ua, pa, mrowa, lane);
    write_topk_mask(ub, pb, mrowb, lane);
}

struct KiStage {
    u32x4 k[4];
    __device__ __forceinline__ void load(const unsigned char* kg, int tid) {
#pragma unroll
        for (int i = 0; i < 4; ++i) { const int c = tid + 512 * i; k[i] = *(const u32x4*)(kg + (size_t)(c >> 4) * (HD * 2) + (c & 15) * 16); }
    }
    __device__ __forceinline__ void store(LAS unsigned char* buf, int tid) const {
#pragma unroll
        for (int i = 0; i < 4; ++i) { const int c = tid + 512 * i; *(LAS u32x4*)(buf + (c >> 4) * KSTR + (c & 15) * 16) = k[i]; }
    }
};
constexpr int KIBUF_B = 128 * KSTR;
__device__ __forceinline__ void indexer_block(const bf16_t* __restrict__ QI, const bf16_t* __restrict__ KI, const float* __restrict__ WI, unsigned* __restrict__ MASK, float* __restrict__ SC,
                                              LAS unsigned char* lds, int b, int qb16, int wave, int lane, int tid) {
    const int r = lane & 31, hh = lane >> 5, t0 = 16 * qb16, tw = t0 + 2 * wave;
    const bf16_t* ap = QI + (size_t)(b * SEQ + tw + (r >> 4)) * DM + (r & 15) * HD + 8 * hh;
    bf16x8 af[8];
#pragma unroll
    for (int s = 0; s < 8; ++s) af[s] = *(const bf16x8*)(ap + 16 * s);
    float wv[16];
#pragma unroll
    for (int i = 0; i < 16; ++i) { const int rw = crow(i, hh); wv[i] = WI[(size_t)(b * SEQ + tw + (rw >> 4)) * 16 + (rw & 15)]; }
    float* myrow = SC + ((size_t)(b * 128 + qb16) * 16 + 2 * wave + hh) * SEQ;
    const int tq = tw + hh, ntile = (t0 + 16 + 127) >> 7;
    const unsigned char* kg = (const unsigned char*)(KI + (size_t)(b * SEQ) * HD);
    KiStage sA, sB;
    sA.load(kg, tid);
    sA.store(lds, tid);
    asm volatile("s_waitcnt lgkmcnt(0)" ::: "memory"); __builtin_amdgcn_s_barrier(); asm volatile("" ::: "memory");
    if (ntile > 1) sA.load(kg + (size_t)1 * 128 * (HD * 2), tid);
    if (ntile > 2) sB.load(kg + (size_t)2 * 128 * (HD * 2), tid);
    for (int kt = 0; kt < ntile; ++kt) {
        const LAS unsigned char* buf = lds + (kt & 1) * KIBUF_B;
#pragma unroll
        for (int j = 0; j < 4; ++j) { const int key0 = 128 * kt + 32 * j;
            if (key0 <= t0 + 15) {
                const LAS unsigned char* kp = buf + (32 * j + r) * KSTR + 16 * hh;
                f32x16 c = f32x16{};
#pragma unroll
                for (int s = 0; s < 8; ++s) c = __builtin_amdgcn_mfma_f32_32x32x16_bf16(af[s], *(const LAS bf16x8*)(kp + 32 * s), c, 0, 0, 0);
                float s0 = 0.f, s1 = 0.f;
#pragma unroll
                for (int i = 0; i < 8; ++i) { s0 += wv[i] * relu_i(c[i]); s1 += wv[i + 8] * relu_i(c[i + 8]); }
                const float t0s = swap_sum(s0), t1s = swap_sum(s1);
                const int key = key0 + r;
                float v = (hh ? t1s : t0s) + 0.0f;
                if (key > tq) v = -INFINITY;
                myrow[key] = v; } }
        if (kt & 1) { if (kt + 1 < ntile) sB.store(lds + ((kt + 1) & 1) * KIBUF_B, tid); if (kt + 3 < ntile) sB.load(kg + (size_t)(kt + 3) * 128 * (HD * 2), tid); }
        else        { if (kt + 1 < ntile) sA.store(lds + ((kt + 1) & 1) * KIBUF_B, tid); if (kt + 3 < ntile) sA.load(kg + (size_t)(kt + 3) * 128 * (HD * 2), tid); }
        asm volatile("s_waitcnt lgkmcnt(0)" ::: "memory"); __builtin_amdgcn_s_barrier(); asm volatile("" ::: "memory");
    }
    asm volatile("s_waitcnt vmcnt(0)" ::: "memory");
    { const float* rowa = SC + ((size_t)(b * 128 + qb16) * 16 + 2 * wave) * SEQ;
      unsigned* mrowa = MASK + (size_t)(b * SEQ + tw) * 64;
      select_two(rowa, rowa + SEQ, tw, mrowa, mrowa + 64, lane); }
}


__device__ __forceinline__ void sb_attn_waves(const bf16_t* __restrict__ Q, const bf16_t* __restrict__ KF, const bf16_t* __restrict__ VF, bf16_t* __restrict__ O, int gw, int ngw, int lane) {
    const int r = lane & 31, hh = lane >> 5, rm = r - 4 * hh;
    bf16x8 uf[2];
#pragma unroll
    for (int s2 = 0; s2 < 2; ++s2) { u32x4 w; unsigned e[8];
#pragma unroll
        for (int j = 0; j < 8; ++j) { const int key = 16 * s2 + 8 * (j >> 2) + 4 * hh + (j & 3); e[j] = (key >= r) ? 0x3f80u : 0u; }
        w.x = e[0] | (e[1] << 16); w.y = e[2] | (e[3] << 16); w.z = e[4] | (e[5] << 16); w.w = e[6] | (e[7] << 16); uf[s2] = __builtin_bit_cast(bf16x8, w); }
    for (int unit = gw; unit < BATCH * NH * 64; unit += ngw) {
        const int bh = unit >> 6, qt = 63 - (unit & 63), b = bh >> 4, h = bh & 15, q0 = qt * 32;
        const bf16_t* qp = Q + (size_t)(b * SEQ + q0 + r) * DM + h * HD + 8 * hh;
        bf16x8 qf[8];
#pragma unroll
        for (int s = 0; s < 8; ++s) qf[s] = *(const bf16x8*)(qp + 16 * s);
        f32x16 o[4];
#pragma unroll
        for (int d = 0; d < 4; ++d) o[d] = f32x16{};
        float carry = 0.f;
        const bf16x8* kbase = (const bf16x8*)KF + (size_t)bh * 64 * 8 * 64 + lane;
        const bf16x8* vbase = (const bf16x8*)VF + (size_t)bh * 64 * 8 * 64 + lane;
        bf16x8 kf[8], vf[8];
#pragma unroll
        for (int s = 0; s < 8; ++s) kf[s] = kbase[(size_t)(qt * 8 + s) * 64];
#pragma unroll
        for (int i = 0; i < 8; ++i) vf[i] = vbase[(size_t)(qt * 8 + i) * 64];
        for (int kt = qt; kt >= 0; --kt) {
            bf16x8 kn[8], vn[8];
            const int ktn = kt > 0 ? kt - 1 : 0;
#pragma unroll
            for (int s = 0; s < 8; ++s) kn[s] = kbase[(size_t)(ktn * 8 + s) * 64];
            f32x16 p = f32x16{};
#pragma unroll
            for (int s = 0; s < 8; ++s) p = __builtin_amdgcn_mfma_f32_32x32x16_bf16(kf[s], qf[s], p, 0, 0, 0);
#pragma unroll
            for (int i = 0; i < 8; ++i) vn[i] = vbase[(size_t)(ktn * 8 + i) * 64];
            f32x16 sp;
#pragma unroll
            for (int i = 0; i < 16; ++i) sp[i] = __builtin_amdgcn_logf(1.0f + __builtin_amdgcn_exp2f(fminf(p[i], 120.0f)));
            if (kt == qt) {
#pragma unroll
                for (int i = 0; i < 16; ++i) if (crow(i, 0) >= rm) { sp[i] = 0.f; p[i] = -1e30f; } }
            f32x16 c;
#pragma unroll
            for (int i = 0; i < 16; ++i) c[i] = carry;
            c = __builtin_amdgcn_mfma_f32_32x32x16_bf16(uf[0], pack8(sp, 0), c, 0, 0, 0);
            c = __builtin_amdgcn_mfma_f32_32x32x16_bf16(uf[1], pack8(sp, 8), c, 0, 0, 0);
#pragma unroll
            for (int i = 0; i < 16; ++i) p[i] = __builtin_amdgcn_exp2f(p[i] - c[i]);
            carry = swap_max(c[0]);
            const bf16x8 pa0 = pack8(p, 0), pa1 = pack8(p, 8);
#pragma unroll
            for (int d = 0; d < 4; ++d) { o[d] = __builtin_amdgcn_mfma_f32_32x32x16_bf16(vf[2 * d], pa0, o[d], 0, 0, 0); o[d] = __builtin_amdgcn_mfma_f32_32x32x16_bf16(vf[2 * d + 1], pa1, o[d], 0, 0, 0); }
            if (__all(carry > SB_EXIT)) break;
#pragma unroll
            for (int s = 0; s < 8; ++s) { kf[s] = kn[s]; vf[s] = vn[s]; }
        }
        store_o_rows16(O + (size_t)(b * SEQ + q0 + r) * DM + h * HD, o, 1.0f, hh);
    }
}

constexpr int N_PHASES = 12;
__global__ void __launch_bounds__(512, 2) fwd_kernel(Args a) {
    extern __shared__ __attribute__((aligned(16))) unsigned char lds_raw[];
    LAS unsigned char* lds = (LAS unsigned char*)lds_raw;
    cg::grid_group grid = cg::this_grid();
    const int tid = threadIdx.x, lane = tid & 63, wave = __builtin_amdgcn_readfirstlane(tid >> 6);
    const int G = gridDim.x, bx = blockIdx.x;
    const int gw = bx * 8 + wave, ngw = G * 8;
    unsigned char* ws = a.ws;
    const int lo = a.ph_lo, hi = a.ph_hi;
#ifndef REP_PHASE
#define REP_PHASE -1
#endif
#ifndef REP_COUNT
#define REP_COUNT 1
#endif
#define IN(k) (lo <= (k) && (k) < hi)
#define GSYNC(k) do { if ((k) == 0 && a.ph_hi > 1000) grid.sync(); xcd_barrier(xbar); } while (0)
#define SEAM(k) do { if (IN(k) && IN((k) + 1)) GSYNC(k); } while (0)
#define REPS(k) for (int rep_ = 0; rep_ < ((k) == REP_PHASE ? REP_COUNT : 1); ++rep_, (void)(((k) == REP_PHASE && rep_ < REP_COUNT) ? (xcd_barrier(xbar), 0) : 0))
    bf16_t* XB = (bf16_t*)(ws + WS_XB); float* PART = (float*)(ws + WS_PART);
    bf16_t* Qb = (bf16_t*)(ws + WS_Q); bf16_t* Kb = (bf16_t*)(ws + WS_K); bf16_t* Vtb = (bf16_t*)(ws + WS_VT); bf16_t* Ob = (bf16_t*)(ws + WS_O);
    bf16_t* QIb = (bf16_t*)(ws + WS_QI); bf16_t* KDb = (bf16_t*)(ws + WS_KD); bf16_t* VTDb = (bf16_t*)(ws + WS_VTD); bf16_t* KIb = (bf16_t*)(ws + WS_KI);
    float* WIb = (float*)(ws + WS_WI); unsigned* MASKb = (unsigned*)(ws + WS_MASK);
    bf16_t* ACTb = (bf16_t*)(ws + WS_ACT);
    const float* ropeC = (const float*)(ws + WS_ROPE); const float* ropeS = ropeC + SEQ * 64;

    if (tid < 16) ((volatile LAS unsigned*)(lds + LDS_MISC))[tid] = 0u;
    __syncthreads();
    XcdBarrier xbar = xcd_barrier_post((unsigned*)(ws + WS_CTL), (volatile LAS unsigned*)(lds + LDS_MISC) + 8);
    const Offload offl = make_offload(G);
    if (IN(0)) REPS(0) { prologue_phase(a, lds, gw, ngw, wave, lane, offl); }
    SEAM(0);
    if (IN(1)) REPS(1) {
        pg8::Gemm g{XB, (const bf16_t*)(ws + WS_WQKV), MTOK, NQKV, DM}; pg8::StaticOrder S; S.init(MTOK, NQKV, G, bx);
        EpiQKV E{ws};
        pg8::gemm_phase<EpiQKV, pg8::StaticOrder, true, true>(lds, g, S, E);
    }
    SEAM(1);
    if (IN(2)) REPS(2) {
        LAS float* scr = (LAS float*)(lds + wave * 16640);
#pragma nounroll
        for (int step = 0; step < 2; ++step) {
            if ((step == 0) == (wave < 4)) sb_attn_waves(Qb, Kb, Vtb, Ob, gw, ngw, lane);
            else { convert_items(a, scr, WI0, WI1, WI3, WI4, gw, ngw, lane); convert_items(a, scr, WI1, WI2, 0, 0, gw, ngw, lane); }
        }
    }
    SEAM(2);
    if (IN(3)) REPS(3) {
        pg8::Gemm g{Ob, (const bf16_t*)(ws + WS_WO0), MTOK, DM, DM}; pg8::StaticOrder S; S.init(MTOK, DM, G, bx);
        EpiRes<true, false> E{a.x, XB, PART};
        pg8::gemm_phase<EpiRes<true, false>, pg8::StaticOrder, true, true>(lds, g, S, E);
    }
    SEAM(3);
    if (IN(4)) REPS(4) {
        const int Gg = offl.up0 ? offl.g_up : G;
        if (bx < Gg) {
        pg8::Gemm g{XB, (const bf16_t*)(ws + WS_WUP), MTOK, NUP, DM, 254, -2}; pg8::StaticOrder S; S.init_tiles(33, NUP / 256, Gg, bx);
        rstd_table_build(lds, PART, S, 254, -2, tid);
        EpiUpConv E{ACTb, a.conv_w, a.conv_b, (LAS float*)(lds + LDS_EPI), (const LAS float*)(lds + LDS_RSTD)};
        pg8::gemm_phase<EpiUpConv, pg8::StaticOrder, true, true>(lds, g, S, E);
        } else { LAS float* scr = (LAS float*)(lds + wave * 16640); const int vw = (bx - Gg) * 8 + wave, nvw = (G - Gg) * 8;
            convert_items(a, scr, WI5, WI6, WI2, WI3, vw, nvw, lane); }
    }
    SEAM(4);
    if (IN(5)) REPS(5) {
        pg8::Gemm g{ACTb, (const bf16_t*)(ws + WS_WDN), MTOK, DM, FF}; pg8::StaticOrder S; S.init(MTOK, DM, G, bx);
        EpiRes<false, false> E{XB, XB, PART};
        pg8::gemm_phase<EpiRes<false, false>, pg8::StaticOrder, true, true>(lds, g, S, E);
    }
    SEAM(5);
    if (IN(6)) REPS(6) {
        const int Gg = offl.in1 ? offl.g_in : G;
        if (bx < Gg) {
        pg8::Gemm g{XB, (const bf16_t*)(ws + WS_WIN), MTOK, NINP, DM}; pg8::StaticOrder S; S.init(MTOK, NINP, Gg, bx);
        rstd_table_build(lds, PART, S, 256, 0, tid);
        EpiDsaIn E{ws, (LAS float*)(lds + LDS_EPI), (const LAS float*)(lds + LDS_RSTD)};
        pg8::gemm_phase<EpiDsaIn, pg8::StaticOrder, true, true>(lds, g, S, E);
        } else { LAS float* scr = (LAS float*)(lds + wave * 16640); const int vw = (bx - Gg) * 8 + wave, nvw = (G - Gg) * 8;
            convert_items(a, scr, WI4, WI5, 0, 0, vw, nvw, lane); }
    }
    SEAM(6);
    if (IN(7)) REPS(7) {
        for (int pr = bx; pr < 256; pr += G) { const int b = pr >> 6, p = pr & 63;
            for (int half = 0; half < 2; ++half) indexer_block(QIb, KIb, WIb, MASKb, (float*)(ws + WS_ACT), lds, b, half ? p : 127 - p, wave, lane, tid); }
    }
    SEAM(7);
    if (IN(8)) REPS(8) {
        for (int pr = bx; pr < 256; pr += G) { const int b = pr >> 6, g = (pr >> 4) & 3, p = pr & 15;
            for (int half = 0; half < 2; ++half) dsa_attn_block(Qb, KDb, VTDb, MASKb, Ob, lds, b, g, half ? p : 31 - p, wave, lane, tid); }
    }
    SEAM(8);
    if (IN(9)) REPS(9) {
        pg8::Gemm g{Ob, (const bf16_t*)(ws + WS_WO1), MTOK, DM, DM}; pg8::StaticOrder S; S.init(MTOK, DM, G, bx);
        EpiRes<false, false> E{XB, XB, PART};
        pg8::gemm_phase<EpiRes<false, false>, pg8::StaticOrder, true, true>(lds, g, S, E);
    }
    SEAM(9);
    if (IN(10)) REPS(10) {
        const int Gg = offl.up1 ? offl.g_up : G;
        if (bx < Gg) {
        pg8::Gemm g{XB, (const bf16_t*)(ws + WS_WUP + 44 * MiB), MTOK, NUP, DM, 254, -2}; pg8::StaticOrder S; S.init_tiles(33, NUP / 256, Gg, bx);
        rstd_table_build(lds, PART, S, 254, -2, tid);
        EpiUpConv E{ACTb, a.conv_w + 3 * NUP, a.conv_b + NUP, (LAS float*)(lds + LDS_EPI), (const LAS float*)(lds + LDS_RSTD)};
        pg8::gemm_phase<EpiUpConv, pg8::StaticOrder, true, true>(lds, g, S, E);
        } else { LAS float* scr = (LAS float*)(lds + wave * 16640); const int vw = (bx - Gg) * 8 + wave, nvw = (G - Gg) * 8;
            convert_items(a, scr, WI6, WI7, 0, 0, vw, nvw, lane); }
    }
    SEAM(10);
    if (IN(11)) REPS(11) {
        pg8::Gemm g{ACTb, (const bf16_t*)(ws + WS_WDN + 22 * MiB), MTOK, DM, FF}; pg8::StaticOrder S; S.init(MTOK, DM, G, bx);
        EpiRes<false, true> E{XB, a.out, nullptr};
        pg8::gemm_phase<EpiRes<false, true>, pg8::StaticOrder, true, true>(lds, g, S, E);
    }
#undef IN
#undef SEAM
}

extern "C" void kernel_launch(void* const* d_in, const int* in_sizes, int n_in, void* d_out, int out_size, void* d_ws, size_t ws_size, hipStream_t stream) {
    static int grid = 0;
    if (grid == 0) {
        if (n_in != 14 || out_size != MTOK * DM || ws_size < WS_END) { fprintf(stderr, "kernel_launch: unexpected shapes (n_in %d out %d ws %zu)\n", n_in, out_size, ws_size); grid = -1; return; }
        int dev = 0, cus = 0, per_cu = 0;
        hipGetDevice(&dev); hipDeviceGetAttribute(&cus, hipDeviceAttributeMultiprocessorCount, dev);
        if (hipFuncSetAttribute((const void*)fwd_kernel, hipFuncAttributeMaxDynamicSharedMemorySize, LDS_BYTES) != hipSuccess) { fprintf(stderr, "kernel_launch: hipFuncSetAttribute failed\n"); grid = -1; return; }
        if (hipOccupancyMaxActiveBlocksPerMultiprocessor(&per_cu, (const void*)fwd_kernel, 512, LDS_BYTES) != hipSuccess || per_cu < 1) { fprintf(stderr, "kernel_launch: occupancy query says %d\n", per_cu); per_cu = 1; }
        (void)hipGetLastError();
        grid = cus;
    }
    if (grid < 0) return;
    Args a{};
    a.x = (const float*)d_in[0]; a.attn_g = (const float*)d_in[1]; a.ffn_g = (const float*)d_in[2]; a.w_qkv = (const float*)d_in[3]; a.w_o0 = (const float*)d_in[4]; a.w_in = (const float*)d_in[5];
    a.qn_g = (const float*)d_in[6]; a.kn_g = (const float*)d_in[7]; a.ikn_g = (const float*)d_in[8]; a.w_o1 = (const float*)d_in[9]; a.w_up = (const float*)d_in[10]; a.conv_w = (const float*)d_in[11];
    a.conv_b = (const float*)d_in[12]; a.w_down = (const float*)d_in[13]; a.out = (float*)d_out; a.ws = (unsigned char*)d_ws;
    if (hipMemsetAsync((char*)d_ws + WS_CTL, 0, CTL_BYTES, stream) != hipSuccess) { fprintf(stderr, "kernel_launch: hipMemsetAsync failed\n"); return; }
#if MK_ONE_LAUNCH
    a.ph_lo = 0; a.ph_hi = N_PHASES;
    void* args[] = {&a};
    hipError_t e = hipLaunchCooperativeKernel((const void*)fwd_kernel, dim3(grid), dim3(512), args, LDS_BYTES, stream);
    if (e != hipSuccess) fprintf(stderr, "cooperative launch failed: %s (grid %d)\n", hipGetErrorString(e), grid);
#else
    for (int pp = 0; pp < N_PHASES + HOST_REP_EXTRA; ++pp) {
        const int p = pp < N_PHASES ? pp : -1;
        if (p < 0) continue;
        for (int hr = 0; hr < ((p == HOST_REP_PHASE) ? 1 + HOST_REP_EXTRA : 1); ++hr) {
        a.ph_lo = p; a.ph_hi = p + 1;
        void* args[] = {&a};
        hipError_t e = hipLaunchCooperativeKernel((const void*)fwd_kernel, dim3(grid), dim3(512), args, LDS_BYTES, stream);
        if (e != hipSuccess) { fprintf(stderr, "launch %d failed: %s (grid %d)\n", p, hipGetErrorString(e), grid); break; }
        }
    }
#endif
}
```

```cpp
#include <hip/hip_runtime.h>
#include <hip/hip_cooperative_groups.h>
#include <cstdio>
#include <cstdint>
namespace cg = cooperative_groups;

#ifndef HOST_REP_PHASE
#define HOST_REP_PHASE -1
#endif
#ifndef HOST_REP_EXTRA
#define HOST_REP_EXTRA 0
#endif
#ifndef MK_ONE_LAUNCH
#define MK_ONE_LAUNCH 1
#endif

#define LAS __attribute__((address_space(3)))
typedef unsigned short bf16_t;
typedef short bf16x8 __attribute__((ext_vector_type(8)));
typedef short s16x4 __attribute__((ext_vector_type(4)));
typedef float f32x4 __attribute__((ext_vector_type(4)));
typedef float f32x2 __attribute__((ext_vector_type(2)));
typedef float f32x16 __attribute__((ext_vector_type(16)));
typedef unsigned u32x4 __attribute__((ext_vector_type(4)));
typedef unsigned u32x2 __attribute__((ext_vector_type(2)));
typedef __bf16 bf16x2_t __attribute__((ext_vector_type(2)));

constexpr int BATCH = 4, SEQ = 2048, DM = 2048, NH = 16, HD = 128, MTOK = BATCH * SEQ;
constexpr int FF = 5632, NUP = 2 * FF, NQKV = 3 * DM;
constexpr int KVH = 4, NIN = 5264, NINP = 5376;
constexpr int TOPK = 256;
constexpr float NORM_EPS = 1e-6f;
constexpr float LOG2E = 1.4426950408889634f;
constexpr float QSCALE = 0.08838834764831845f * LOG2E;

constexpr size_t MiB = 1u << 20;
constexpr size_t WS_WQKV = 0, WS_WO0 = 24 * MiB, WS_WIN = 32 * MiB, WS_WO1 = 53 * MiB, WS_WUP = 61 * MiB  , WS_WDN = 149 * MiB  ;
constexpr size_t WS_GAIN = 197 * MiB + 512 * 1024  ;
constexpr size_t WS_ROPE = 193 * MiB  , WS_PART = 194 * MiB, WS_MASK = 195 * MiB, WS_WI = 197 * MiB, WS_KI = 198 * MiB;
constexpr size_t WS_XB = 200 * MiB;
constexpr size_t WS_SCR = 360 * MiB;
constexpr size_t WS_ACT = WS_SCR + 176 * MiB;
constexpr size_t WS_Q = WS_SCR, WS_K = WS_SCR + 32 * MiB, WS_VT = WS_SCR + 64 * MiB, WS_O = WS_SCR + 96 * MiB, WS_QI = WS_SCR + 128 * MiB, WS_KD = WS_SCR + 160 * MiB, WS_VTD = WS_SCR + 168 * MiB;
constexpr size_t WS_CTL = WS_ACT + 88 * MiB, CTL_BYTES = 65536;
constexpr size_t WS_END = WS_CTL + CTL_BYTES;

constexpr int LDS_EPI = 131072;
constexpr int LDS_BYTES = 159744;
constexpr int LDS_MISC = LDS_BYTES - 256;
constexpr int LDS_RSTD = LDS_EPI + 8192 + 256;
constexpr int LDS_CONVW = LDS_RSTD + 8192;

static_assert(LDS_CONVW + 8192 <= LDS_MISC, "LDS map");
__device__ __forceinline__ unsigned pk2(float lo, float hi) { f32x2 v = {lo, hi}; bf16x2_t b = __builtin_convertvector(v, bf16x2_t); return __builtin_bit_cast(unsigned, b); }
__device__ __forceinline__ bf16_t f2bf(float f) { return (bf16_t)(pk2(f, 0.f) & 0xffffu); }
__device__ __forceinline__ float relu_i(float x) { const int b = __float_as_int(x); return __int_as_float(b > 0 ? b : 0); }
__device__ __forceinline__ int crow(int r, int hi) { return (r & 3) + 8 * (r >> 2) + 4 * hi; }
__device__ __forceinline__ bf16x8 pack8(const f32x16& p, int b) {
    u32x4 w; w.x = pk2(p[b], p[b + 1]); w.y = pk2(p[b + 2], p[b + 3]); w.z = pk2(p[b + 4], p[b + 5]); w.w = pk2(p[b + 6], p[b + 7]);
    return __builtin_bit_cast(bf16x8, w);
}
__device__ __forceinline__ float swap_sum(float v) { auto rr = __builtin_amdgcn_permlane32_swap(__float_as_uint(v), __float_as_uint(v), false, false); return __uint_as_float(rr[0]) + __uint_as_float(rr[1]); }
__device__ __forceinline__ float swap_max(float v) { auto rr = __builtin_amdgcn_permlane32_swap(__float_as_uint(v), __float_as_uint(v), false, false); return fmaxf(__uint_as_float(rr[0]), __uint_as_float(rr[1])); }
__device__ __forceinline__ float wave_sum(float v) {
#pragma unroll
    for (int o = 1; o < 64; o <<= 1) v += __shfl_xor(v, o);
    return v;
}
__device__ __forceinline__ float row_rstd(const float* part, int row, int fq) {
    const f32x4* p = (const f32x4*)(part + (size_t)row * 32 + 8 * fq);
    const f32x4 a = p[0], b = p[1]; float s = ((a.x + a.y) + (a.z + a.w)) + ((b.x + b.y) + (b.z + b.w));
    s += __shfl_xor(s, 16); s += __shfl_xor(s, 32);
    return __builtin_amdgcn_rsqf(s * (1.0f / DM) + NORM_EPS);
}


#define XB_TMO      128
#define XB_XCNT(j)  (256  + 64 * (j))
#define XB_XSUB(j)  (1280 + 64 * (j))
#define XB_XGEN(j)  (2304 + 64 * (j))
#define XB_TOP      3328
#define XB_TOPGEN   3392
#define XCD_BAR_WORDS 3456
#define XB_SPIN_CAP (1u << 18)
__device__ __forceinline__ unsigned xb_ld(unsigned* p)              { return __hip_atomic_load(p, __ATOMIC_RELAXED, __HIP_MEMORY_SCOPE_AGENT); }
__device__ __forceinline__ unsigned xb_add(unsigned* p, unsigned v) { return __hip_atomic_fetch_add(p, v, __ATOMIC_RELAXED, __HIP_MEMORY_SCOPE_AGENT); }
__device__ __forceinline__ unsigned xb_xcc_id() { return (unsigned)__builtin_amdgcn_s_getreg((3 << 11) | 20) & 0xFu; }
#define XB_SPIN(cond, bar) do { unsigned _sp = 0; while (cond) { __builtin_amdgcn_s_sleep(1); \
    if ((++_sp & 255u) == 0u) { if (xb_ld(&(bar)[XB_TMO])) break; if (_sp > XB_SPIN_CAP) { atomicAdd(&(bar)[XB_TMO], 1u); break; } } } } while (0)
struct XcdBarrier { unsigned* bar; unsigned x; volatile LAS unsigned* st; };
__device__ __forceinline__ XcdBarrier xcd_barrier_post(unsigned* bar, volatile LAS unsigned* st) {
    XcdBarrier b; b.bar = bar; b.x = xb_xcc_id(); b.st = st;
    if (threadIdx.x == 0) (void)xb_add(&bar[XB_XCNT(b.x)], 1u);
    return b;
}
__device__ __forceinline__ void xcd_barrier_complete(unsigned* bar, unsigned x, unsigned& nloc, unsigned& nx) {
    const unsigned G = gridDim.x * gridDim.y * gridDim.z;
    unsigned sum, cnt, mine, sp = 0u;
    for (;;) {
        sum = 0u; cnt = 0u; mine = 0u;
#pragma unroll
        for (unsigned j = 0; j < 16; ++j) { const unsigned c = xb_ld(&bar[XB_XCNT(j)]); sum += c; cnt += (c > 0u) ? 1u : 0u; mine = (j == x) ? c : mine; }
        if (sum == G) break;
        __builtin_amdgcn_s_sleep(1);
        if ((++sp & 255u) == 0u) { if (xb_ld(&bar[XB_TMO])) break; if (sp > XB_SPIN_CAP) { atomicAdd(&bar[XB_TMO], 1u); break; } }
    }
    nloc = mine > 0u ? mine : 1u; nx = cnt > 0u ? cnt : 1u;
}
__device__ __forceinline__ void xcd_barrier(const XcdBarrier& b) {
    asm volatile("s_waitcnt vmcnt(0)" ::: "memory");
    __syncthreads();
    if (threadIdx.x == 0) {
        unsigned* bar = b.bar;
        __builtin_amdgcn_s_waitcnt(0);
        unsigned nloc = b.st[0], nx = b.st[1];
        if (nloc == 0u) { xcd_barrier_complete(bar, b.x, nloc, nx); b.st[0] = nloc; b.st[1] = nx; }
        const unsigned old = xb_add(&bar[XB_XSUB(b.x)], 1u);
        const unsigned gen = old / nloc;
        if (old + 1u == (gen + 1u) * nloc) {
            __builtin_amdgcn_fence(__ATOMIC_RELEASE, "agent");
            asm volatile("s_waitcnt vmcnt(0)" ::: "memory");
            const unsigned og = xb_add(&bar[XB_TOP], 1u);
            const unsigned tg = og / nx;
            if (og + 1u == (tg + 1u) * nx) xb_add(&bar[XB_TOPGEN], 1u);
            else XB_SPIN(xb_ld(&bar[XB_TOPGEN]) == tg, bar);
            __builtin_amdgcn_fence(__ATOMIC_ACQUIRE, "agent");
            xb_add(&bar[XB_XGEN(b.x)], 1u);
            asm volatile("s_waitcnt vmcnt(0)" ::: "memory");
        } else {
            XB_SPIN(xb_ld(&bar[XB_XGEN(b.x)]) == gen, bar);
            __builtin_amdgcn_fence(__ATOMIC_ACQUIRE, "agent");
            asm volatile("s_waitcnt vmcnt(0)" ::: "memory");
        }
    }
    __syncthreads();
}

namespace pg8 {
constexpr int BM = 256, BK = 64, HALF = 128, HTB = HALF * BK * 2, STAGE_BYTES = 8 * HTB, NXCD = 8, WGM = 2;
__host__ __device__ __forceinline__ int lds_byte(int r, int c) { const int st = (r >> 4) * 2 + (c >> 5), rr = r & 15, cc = c & 31, ob = rr * 64 + cc * 2; return st * 1024 + (ob ^ (((ob >> 9) & 1) << 5)); }
__host__ __device__ __forceinline__ void stage_rc(int b, int& R, int& C) { const int st = b / 1024, sb = b % 1024, swz = sb ^ (((sb >> 9) & 1) << 5); R = (st >> 1) * 16 + swz / 64; C = (st & 1) * 32 + (swz % 64) / 2; }
__host__ __device__ __forceinline__ int perm32(int rho) { const int n = rho >> 4, i = rho & 15; return 8 * (i >> 2) + 4 * n + (i & 3); }
struct Unit { int pm, pn; };
struct Gemm { const bf16_t* A; const bf16_t* Bt; int M, N, K; int a_rows = 256, a_row0 = 0; };
struct StaticOrder {
    int nM, nN, nwg, G, c;
    __host__ __device__ void init(int M, int N, int G_, int c_) { nM = M / BM; nN = N / BM; nwg = nM * nN; G = G_; c = c_; }
    __host__ __device__ void init_tiles(int nM_, int nN_, int G_, int c_) { nM = nM_; nN = nN_; nwg = nM * nN; G = G_; c = c_; }
    __host__ __device__ bool next(int i, Unit& u) const {
        const long L = (long)i * G + c; if (L >= nwg) return false;
        int wgid = (int)L; { const int q = nwg / NXCD, r = nwg % NXCD, xcd = wgid % NXCD, off = wgid / NXCD; wgid = (xcd < r ? xcd * (q + 1) : r * (q + 1) + (xcd - r) * q) + off; }
        const int nig = WGM * nN, gid = wgid / nig, fm = gid * WGM, gsz = (nM - fm) < WGM ? (nM - fm) : WGM;
        u.pm = fm + ((wgid % nig) % gsz); u.pn = (wgid % nig) / gsz; return true;
    }
};
template <class Epi, class Sched, bool ALIGN_EPI, bool SP2>
__device__ __forceinline__ void gemm_phase(LAS unsigned char* lds, const Gemm g, const Sched& S, const Epi& E) {
    const int tid = threadIdx.x, wid = __builtin_amdgcn_readfirstlane(tid >> 6), lane = tid & 63, wr = wid >> 2, wc = wid & 3, fr = lane & 15, fq = lane >> 4;
    const int K = g.K, nt = K / BK;
    unsigned voffA[2], voffB[2];
#pragma unroll
    for (int i = 0; i < 2; ++i) { int R, C; stage_rc(tid * 16 + i * 8192, R, C); const int Rb = Epi::PERM ? ((R & ~31) + perm32(R & 31)) : R;
        voffA[i] = (unsigned)(R * K + C) * 2u; voffB[i] = (unsigned)(Rb * K + C) * 2u; }
    const size_t kstep = (size_t)(BK * 2);
    const size_t hstep = (size_t)HALF * K * 2;
    const size_t tstep = 2 * hstep;
    const unsigned ldsw = (unsigned)wid * 1024u;
    const int aoff = lds_byte(wr * 64 + fr, fq * 8), boff = lds_byte(wc * 32 + fr, fq * 8);
#define PG8_SA(b, h) (((b) * 2 + (h)) * HTB)
#define PG8_SB(b, h) ((4 + (b) * 2 + (h)) * HTB)
#define PG8_STAGE(bufoff, gbase, voff) do { _Pragma("unroll") for (int _i = 0; _i < 2; ++_i) \
        __builtin_amdgcn_global_load_lds((const unsigned*)((const char*)(gbase) + (voff)[_i]), (LAS unsigned*)(lds + (bufoff) + ldsw + _i * 8192), 16, 0, 0); } while (0)
#define PG8_LDA(dst, b, h) do { _Pragma("unroll") for (int m = 0; m < 4; ++m) _Pragma("unroll") for (int k = 0; k < 2; ++k) dst[m][k] = *(const LAS bf16x8*)(lds + PG8_SA(b, h) + aoff + m * 2048 + k * 1024); } while (0)
#define PG8_LDB(dst, b, h) do { _Pragma("unroll") for (int n = 0; n < 2; ++n) _Pragma("unroll") for (int k = 0; k < 2; ++k) dst[n][k] = *(const LAS bf16x8*)(lds + PG8_SB(b, h) + boff + n * 2048 + k * 1024); } while (0)
#define PG8_MMA(ai, bj, At, Bt) do { __builtin_amdgcn_s_setprio(1); _Pragma("unroll") for (int m = 0; m < 4; ++m) _Pragma("unroll") for (int n = 0; n < 2; ++n) _Pragma("unroll") for (int k = 0; k < 2; ++k) \
        acc[ai][bj][m][n] = __builtin_amdgcn_mfma_f32_16x16x32_bf16(Bt[n][k], At[m][k], acc[ai][bj][m][n], 0, 0, 0); __builtin_amdgcn_s_setprio(0); } while (0)
#define PG8_WAIT_V(n) asm volatile("s_waitcnt vmcnt(" #n ")" ::: "memory")
#define PG8_WAIT_L(n) asm volatile("s_waitcnt lgkmcnt(" #n ")" ::: "memory")
#define PG8_BAR __builtin_amdgcn_s_barrier()
#define PG8_SCHED __builtin_amdgcn_sched_barrier(0)
    Unit cur, nxt; int ui = 0;
    if (!S.next(0, cur)) return;
    E.prefetch(cur, 0, tid, wid);
    f32x4 acc[2][2][4][2];
#pragma unroll
    for (int a = 0; a < 2; ++a)
#pragma unroll
        for (int b = 0; b < 2; ++b)
#pragma unroll
            for (int m = 0; m < 4; ++m)
#pragma unroll
                for (int n = 0; n < 2; ++n) acc[a][b][m][n] = (f32x4){0.f, 0.f, 0.f, 0.f};
    bf16x8 At[4][2], B0[2][2], B1[2][2];
    const long atstep = (long)g.a_rows * K * 2, aorg = (long)g.a_row0 * K * 2;
    const char* cA = (const char*)g.A + aorg + (long)cur.pm * atstep; const char* cB = (const char*)g.Bt + (size_t)cur.pn * tstep;
    if constexpr (SP2) {
        PG8_STAGE(PG8_SB(0, 0), cB, voffB); PG8_STAGE(PG8_SB(0, 1), cB + hstep, voffB); PG8_STAGE(PG8_SA(0, 0), cA, voffA); PG8_STAGE(PG8_SA(0, 1), cA + hstep, voffA);
        if (wr == 1) PG8_BAR;
        PG8_WAIT_V(2); PG8_BAR;
        PG8_STAGE(PG8_SB(1, 0), cB + kstep, voffB); PG8_STAGE(PG8_SA(1, 0), cA + kstep, voffA); PG8_STAGE(PG8_SB(1, 1), cB + hstep + kstep, voffB);
        PG8_WAIT_V(6); PG8_BAR;
    } else {
        PG8_STAGE(PG8_SB(0, 0), cB, voffB); PG8_STAGE(PG8_SA(0, 0), cA, voffA); PG8_STAGE(PG8_SB(0, 1), cB + hstep, voffB); PG8_STAGE(PG8_SA(0, 1), cA + hstep, voffA);
        if (wr == 1) PG8_BAR;
        PG8_WAIT_V(4); PG8_BAR;
        PG8_STAGE(PG8_SB(1, 0), cB + kstep, voffB); PG8_STAGE(PG8_SA(1, 0), cA + kstep, voffA); PG8_STAGE(PG8_SB(1, 1), cB + hstep + kstep, voffB);
        PG8_WAIT_V(6); PG8_BAR;
    }
    for (;;) {
        const bool has_next = S.next(ui + 1, nxt);
        const char* nA = has_next ? (const char*)g.A + aorg + (long)nxt.pm * atstep : cA; const char* nB = has_next ? (const char*)g.Bt + (size_t)nxt.pn * tstep : cB;
        for (int t = 0; t < nt; t += 2) {
            const bool last = (t == nt - 2);
            const char* a1 = cA + (size_t)(t + 1) * kstep;
            const char* a2 = last ? nA : cA + (size_t)(t + 2) * kstep; const char* b2 = last ? nB : cB + (size_t)(t + 2) * kstep;
            const char* a3 = a2 + kstep; const char* b3 = b2 + kstep;
            if constexpr (SP2) {
            PG8_LDB(B0, 0, 0); PG8_LDB(B1, 0, 1); PG8_SCHED; PG8_LDA(At, 0, 0); PG8_STAGE(PG8_SA(1, 1), a1 + hstep, voffA);
            PG8_WAIT_V(8); PG8_WAIT_L(0); PG8_BAR; PG8_MMA(0, 0, At, B0); PG8_MMA(0, 1, At, B1); PG8_BAR; PG8_SCHED;
            PG8_LDA(At, 0, 1); PG8_STAGE(PG8_SB(0, 0), b2, voffB); PG8_STAGE(PG8_SB(0, 1), b2 + hstep, voffB); PG8_STAGE(PG8_SA(0, 0), a2, voffA);
            PG8_WAIT_V(8); PG8_WAIT_L(0); PG8_BAR; PG8_MMA(1, 0, At, B0); PG8_MMA(1, 1, At, B1); PG8_BAR; PG8_SCHED;
            PG8_LDB(B0, 1, 0); PG8_LDB(B1, 1, 1); PG8_SCHED; PG8_LDA(At, 1, 0); PG8_STAGE(PG8_SA(0, 1), a2 + hstep, voffA);
            PG8_WAIT_V(8); PG8_WAIT_L(0); PG8_BAR; PG8_MMA(0, 0, At, B0); PG8_MMA(0, 1, At, B1); PG8_BAR; PG8_SCHED;
            PG8_LDA(At, 1, 1); PG8_STAGE(PG8_SB(1, 0), b3, voffB); PG8_STAGE(PG8_SB(1, 1), b3 + hstep, voffB); PG8_STAGE(PG8_SA(1, 0), a3, voffA);
            PG8_WAIT_V(8); PG8_WAIT_L(0); PG8_BAR; PG8_MMA(1, 0, At, B0); PG8_MMA(1, 1, At, B1); PG8_BAR; PG8_SCHED;
            } else {
            PG8_LDB(B0, 0, 0); PG8_SCHED; PG8_LDA(At, 0, 0); PG8_STAGE(PG8_SA(1, 1), a1 + hstep, voffA);
            PG8_WAIT_L(8); PG8_BAR; PG8_WAIT_L(0); PG8_MMA(0, 0, At, B0); PG8_BAR; PG8_SCHED;
            PG8_LDB(B1, 0, 1); PG8_STAGE(PG8_SB(0, 0), b2, voffB);
            PG8_BAR; PG8_WAIT_L(0); PG8_MMA(0, 1, At, B1); PG8_BAR;
            PG8_LDA(At, 0, 1); PG8_STAGE(PG8_SA(0, 0), a2, voffA);
            PG8_BAR; PG8_WAIT_L(0); PG8_MMA(1, 0, At, B0); PG8_BAR; PG8_SCHED;
            PG8_STAGE(PG8_SB(0, 1), b2 + hstep, voffB);
            PG8_WAIT_V(6); PG8_BAR; PG8_MMA(1, 1, At, B1); PG8_BAR;
            PG8_LDB(B0, 1, 0); PG8_SCHED; PG8_LDA(At, 1, 0); PG8_STAGE(PG8_SA(0, 1), a2 + hstep, voffA);
            PG8_WAIT_L(8); PG8_BAR; PG8_WAIT_L(0); PG8_MMA(0, 0, At, B0); PG8_BAR; PG8_SCHED;
            PG8_LDB(B1, 1, 1); PG8_STAGE(PG8_SB(1, 0), b3, voffB);
            PG8_BAR; PG8_WAIT_L(0); PG8_MMA(0, 1, At, B1); PG8_BAR;
            PG8_LDA(At, 1, 1); PG8_STAGE(PG8_SA(1, 0), a3, voffA);
            PG8_BAR; PG8_WAIT_L(0); PG8_MMA(1, 0, At, B0); PG8_BAR; PG8_SCHED;
            PG8_STAGE(PG8_SB(1, 1), b3 + hstep, voffB);
            PG8_WAIT_V(6); PG8_BAR; PG8_MMA(1, 1, At, B1); PG8_BAR;
            }
        }
        if constexpr (ALIGN_EPI) { if (wr == 0) PG8_BAR; }
        { int fr_ = fr, fq_ = fq; asm volatile("" : "+v"(fr_), "+v"(fq_)); E(acc, cur, wr, wc, fr_, fq_, ui); if (has_next) E.prefetch(nxt, ui + 1, (wr * 4 + wc) * 64 + fq_ * 16 + fr_, wr * 4 + wc); }
        if (!has_next) break;
#pragma unroll
        for (int a = 0; a < 2; ++a)
#pragma unroll
            for (int b = 0; b < 2; ++b)
#pragma unroll
                for (int m = 0; m < 4; ++m)
#pragma unroll
                    for (int n = 0; n < 2; ++n) acc[a][b][m][n] = (f32x4){0.f, 0.f, 0.f, 0.f};
        cur = nxt; cA = nA; cB = nB; ++ui;
        if constexpr (ALIGN_EPI) { if (wr == 1) PG8_BAR; }
    }
    PG8_WAIT_V(0);
    if constexpr (!ALIGN_EPI) { if (wr == 0) PG8_BAR; }
    PG8_BAR;
#undef PG8_SA
#undef PG8_SB
#undef PG8_STAGE
#undef PG8_LDA
#undef PG8_LDB
#undef PG8_MMA
#undef PG8_WAIT_V
#undef PG8_WAIT_L
#undef PG8_BAR
#undef PG8_SCHED
}
}
using pg8::Unit;
typedef f32x4 AccT[2][2][4][2];


template <class Sched>
__device__ __forceinline__ void rstd_table_build(LAS unsigned char* lds, const float* part, const Sched& S, int a_rows, int a_row0, int tid) {
    LAS float* tab = (LAS float*)(lds + LDS_RSTD);
    for (int i0 = 0; i0 < 8; i0 += 2) {
        pg8::Unit u; const int i = i0 + (tid >> 8);
        if (S.next(i, u)) {
            int row = a_rows * u.pm + a_row0 + (tid & 255); row = row < 0 ? 0 : (row >= MTOK ? MTOK - 1 : row);
            const f32x4* p = (const f32x4*)(part + (size_t)row * 32);
            f32x4 acc4 = p[0];
#pragma unroll
            for (int k = 1; k < 8; ++k) acc4 += p[k];
            tab[i * 256 + (tid & 255)] = __builtin_amdgcn_rsqf(((acc4.x + acc4.y) + (acc4.z + acc4.w)) * (1.0f / DM) + NORM_EPS);
        }
    }
    asm volatile("s_waitcnt lgkmcnt(0)" ::: "memory"); __syncthreads();
}
struct EpiQKV {
    static constexpr bool PERM = true;
    unsigned char* ws;
    __device__ __forceinline__ void prefetch(const Unit&, int, int, int) const {}
    __device__ __forceinline__ void operator()(const AccT& acc, const Unit& u, int wr, int wc, int fr, int fq, int) const {
        const int row0 = u.pm * 256 + wr * 64 + fr, kind = u.pn >> 3, colt = (u.pn & 7) * 256 + wc * 32 + 8 * fq;
        if (kind == 0) {
            bf16_t* base = (bf16_t*)(ws + WS_Q);
#pragma unroll
            for (int ai = 0; ai < 2; ++ai)
#pragma unroll
                for (int m = 0; m < 4; ++m) { bf16_t* rowp = base + (size_t)(row0 + ai * 128 + m * 16) * DM + colt;
#pragma unroll
                    for (int bj = 0; bj < 2; ++bj) { const f32x4 v0 = acc[ai][bj][m][0] * QSCALE, v1 = acc[ai][bj][m][1] * QSCALE;
                        u32x4 w; w.x = pk2(v0[0], v0[1]); w.y = pk2(v0[2], v0[3]); w.z = pk2(v1[0], v1[1]); w.w = pk2(v1[2], v1[3]);
                        *(u32x4*)(rowp + bj * 128) = w; } }
        } else if (kind == 1) {
            bf16_t* KF = (bf16_t*)(ws + WS_K);
#pragma unroll
            for (int ai = 0; ai < 2; ++ai)
#pragma unroll
                for (int m = 0; m < 4; ++m) { const int row = row0 + ai * 128 + m * 16, b = row >> 11, st = row & 2047;
#pragma unroll
                    for (int bj = 0; bj < 2; ++bj) { const int c0 = colt + bj * 128, h = c0 >> 7, d0 = c0 & 127;
                        const size_t idx = ((((size_t)(b * NH + h) * 64 + (st >> 5)) * 8 + (d0 >> 4)) * 64 + (st & 31) + 32 * ((d0 >> 3) & 1)) * 8;
                        const f32x4 v0 = acc[ai][bj][m][0], v1 = acc[ai][bj][m][1];
                        u32x4 w; w.x = pk2(v0[0], v0[1]); w.y = pk2(v0[2], v0[3]); w.z = pk2(v1[0], v1[1]); w.w = pk2(v1[2], v1[3]);
                        *(u32x4*)(KF + idx) = w; } }
        } else {
            bf16_t* VF = (bf16_t*)(ws + WS_VT);
#pragma unroll
            for (int ai = 0; ai < 2; ++ai)
#pragma unroll
                for (int m = 0; m < 4; ++m) { const int row = row0 + ai * 128 + m * 16, b = row >> 11, st = row & 2047, k32 = st & 31, kk = k32 & 15;
                    const int slot = 4 * (kk >> 3) + (kk & 3), lhi = 32 * ((kk >> 2) & 1), s2 = k32 >> 4;
#pragma unroll
                    for (int bj = 0; bj < 2; ++bj) { const int c0 = colt + bj * 128, h = c0 >> 7, d0 = c0 & 127;
                        bf16_t* p = VF + (((((size_t)(b * NH + h) * 64 + (st >> 5)) * 4 + (d0 >> 5)) * 2 + s2) * 64 + (d0 & 31) + lhi) * 8 + slot;
#pragma unroll
                        for (int n = 0; n < 2; ++n)
#pragma unroll
                            for (int j = 0; j < 4; ++j) p[(4 * n + j) * 8] = f2bf(acc[ai][bj][m][n][j]); } }
        }
    }
};
template <bool RES_F32, bool OUT_F32>
struct EpiRes {
    static constexpr bool PERM = true;
    const void* res; void* out; float* part;
    __device__ __forceinline__ void prefetch(const Unit&, int, int, int) const {}
    __device__ __forceinline__ void operator()(const AccT& acc, const Unit& u, int wr, int wc, int fr, int fq, int) const {
        const int row0 = u.pm * 256 + wr * 64 + fr, col0 = u.pn * 256 + wc * 32 + 8 * fq;
        constexpr int NB = RES_F32 ? 4 : 8;
        f32x4 rf[RES_F32 ? 4 : 1][4]; u32x4 rh[RES_F32 ? 1 : 8][2];
#pragma unroll
        for (int g0 = 0; g0 < 8; g0 += NB) {
#pragma unroll
            for (int gi = 0; gi < NB; ++gi) { const int g = g0 + gi; const size_t off_ = (size_t)(row0 + (g >> 2) * 128 + (g & 3) * 16) * DM + col0;
                if (RES_F32) { const float* r_ = (const float*)res; rf[gi][0] = *(const f32x4*)(r_ + off_); rf[gi][1] = *(const f32x4*)(r_ + off_ + 4); rf[gi][2] = *(const f32x4*)(r_ + off_ + 128); rf[gi][3] = *(const f32x4*)(r_ + off_ + 132); }
                else { const bf16_t* r_ = (const bf16_t*)res; rh[gi][0] = *(const u32x4*)(r_ + off_); rh[gi][1] = *(const u32x4*)(r_ + off_ + 128); } }
#pragma unroll
            for (int gi = 0; gi < NB; ++gi) {
                const int g = g0 + gi, ai = g >> 2, m = g & 3;
                const int row = row0 + ai * 128 + m * 16; const size_t off = (size_t)row * DM + col0; float ss = 0.f;
#pragma unroll
                for (int bj = 0; bj < 2; ++bj) {
                    f32x4 r0, r1;
                    if (RES_F32) { r0 = rf[gi][2 * bj]; r1 = rf[gi][2 * bj + 1]; }
                    else { const u32x4 h = rh[gi][bj];
                        r0 = (f32x4){__uint_as_float(h.x << 16), __uint_as_float(h.x & 0xffff0000u), __uint_as_float(h.y << 16), __uint_as_float(h.y & 0xffff0000u)};
                        r1 = (f32x4){__uint_as_float(h.z << 16), __uint_as_float(h.z & 0xffff0000u), __uint_as_float(h.w << 16), __uint_as_float(h.w & 0xffff0000u)}; }
                    const f32x4 v0 = acc[ai][bj][m][0] + r0, v1 = acc[ai][bj][m][1] + r1;
                    if (OUT_F32) { float* o_ = (float*)out; *(f32x4*)(o_ + off + bj * 128) = v0; *(f32x4*)(o_ + off + bj * 128 + 4) = v1; }
                    else { bf16_t* o_ = (bf16_t*)out; u32x4 w; w.x = pk2(v0[0], v0[1]); w.y = pk2(v0[2], v0[3]); w.z = pk2(v1[0], v1[1]); w.w = pk2(v1[2], v1[3]); *(u32x4*)(o_ + off + bj * 128) = w; }
                    ss += (v0[0] * v0[0] + v0[1] * v0[1]) + (v0[2] * v0[2] + v0[3] * v0[3]) + (v1[0] * v1[0] + v1[1] * v1[1]) + (v1[2] * v1[2] + v1[3] * v1[3]); }
                if (part) { ss += __shfl_xor(ss, 16); ss += __shfl_xor(ss, 32); if (fq == 0) part[(size_t)row * 32 + u.pn * 4 + wc] = ss; }
            }
        }
    }
};
#define CONV_DPP4(C, X, W, CTRL) asm volatile("s_nop 1\n\t" \
        "v_fmac_f32_dpp %0, %4, %8 " CTRL " row_mask:0xf bank_mask:0xf bound_ctrl:1\n\t" \
        "v_fmac_f32_dpp %1, %5, %9 " CTRL " row_mask:0xf bank_mask:0xf bound_ctrl:1\n\t" \
        "v_fmac_f32_dpp %2, %6, %10 " CTRL " row_mask:0xf bank_mask:0xf bound_ctrl:1\n\t" \
        "v_fmac_f32_dpp %3, %7, %11 " CTRL " row_mask:0xf bank_mask:0xf bound_ctrl:1" \
        : "+v"(C[0]), "+v"(C[1]), "+v"(C[2]), "+v"(C[3]) : "v"(X[0]), "v"(X[1]), "v"(X[2]), "v"(X[3]), "v"(W[0]), "v"(W[1]), "v"(W[2]), "v"(W[3]))
struct EpiUpConv {
    static constexpr bool PERM = true;
    bf16_t* ACT; const float* cw; const float* cb; LAS float* hal; const LAS float* rtab;
    __device__ __forceinline__ void prefetch(const Unit& u, int ui, int tid, int wid) const {
        if (wid < 4) { const int q = tid >> 5, bj = q >> 2, t = q & 3, col = 4 * (tid & 31);
            const float* src = (t < 3 ? cw + (size_t)t * NUP : cb) + bj * FF + u.pn * 128 + col;
            __builtin_amdgcn_global_load_lds((const unsigned*)src, (LAS unsigned*)((LAS unsigned char*)rtab + 8192 + (ui & 1) * 4096 + wid * 1024), 16, 0, 0); }
    }
    __device__ __forceinline__ void operator()(AccT& acc, const Unit& u, int wr, int wc, int fr, int fq, int ui) const {
#pragma unroll
        for (int ai = 0; ai < 2; ++ai)
#pragma unroll
            for (int m = 0; m < 4; ++m) { const float rs = rtab[ui * 256 + ai * 128 + wr * 64 + m * 16 + fr];
#pragma unroll
                for (int bj = 0; bj < 2; ++bj) { acc[ai][bj][m][0] *= rs; acc[ai][bj][m][1] *= rs; } }
        const int colw = wc * 32 + 8 * fq;
        if (fr >= 14) {
#pragma unroll
            for (int ai = 0; ai < 2; ++ai)
#pragma unroll
                for (int bj = 0; bj < 2; ++bj)
#pragma unroll
                    for (int n = 0; n < 2; ++n) *(LAS f32x4*)(hal + ((ai * 2 + wr) * 2 + (fr - 14)) * 256 + bj * 128 + colw + 4 * n) = acc[ai][bj][3][n];
        }
        asm volatile("s_waitcnt lgkmcnt(0)" ::: "memory"); __builtin_amdgcn_s_barrier(); asm volatile("" ::: "memory");
        const int r_lo = 254 * u.pm - 2, r_first = r_lo < 0 ? 0 : r_lo, r_hi = r_lo + 255;
        const bool has_bnd = ((r_first & 2047) <= 1) || ((r_hi >> 11) != (r_first >> 11));
        u32x2 pk0[2][4];
#pragma unroll
        for (int n = 0; n < 2; ++n) {
            const int ch = u.pn * 128 + colw + 4 * n;
            f32x4 w[2][3], bb[2];
            { const LAS float* wl = (const LAS float*)((const LAS unsigned char*)rtab + 8192 + (ui & 1) * 4096) + colw + 4 * n;
#pragma unroll
                for (int bj = 0; bj < 2; ++bj) { bb[bj] = *(const LAS f32x4*)(wl + (bj * 4 + 3) * 128);
#pragma unroll
                    for (int t = 0; t < 3; ++t) w[bj][t] = *(const LAS f32x4*)(wl + (bj * 4 + t) * 128); } }
#pragma unroll
            for (int ai = 0; ai < 2; ++ai)
#pragma unroll
                for (int m = 0; m < 4; ++m) {
                    const int lrow = ai * 128 + wr * 64 + m * 16 + fr, grow = 254 * u.pm - 2 + lrow;
                    f32x4 cv[2];
#pragma unroll
                    for (int bj = 0; bj < 2; ++bj) {
                        f32x4 w0 = w[bj][0], w1 = w[bj][1];
                        if (has_bnd) { const int pos = grow & 2047; if (pos < 2) w0 = (f32x4){0.f, 0.f, 0.f, 0.f}; if (pos < 1) w1 = (f32x4){0.f, 0.f, 0.f, 0.f}; }
                        const f32x4 cur = acc[ai][bj][m][n];
                        f32x4 c = bb[bj] + w[bj][2] * cur;
                        CONV_DPP4(c, cur, w1, "row_shr:1"); CONV_DPP4(c, cur, w0, "row_shr:2");
                        if (m > 0) { const f32x4 pv = acc[ai][bj][m - 1][n]; CONV_DPP4(c, pv, w1, "row_shl:15"); CONV_DPP4(c, pv, w0, "row_shl:14"); }
                        else { const int slab = ai * 2 + wr - 1;
                            if (slab >= 0) { const f32x4 h1 = *(const LAS f32x4*)(hal + (slab * 2 + 1) * 256 + bj * 128 + colw + 4 * n), h2 = *(const LAS f32x4*)(hal + (slab * 2) * 256 + bj * 128 + colw + 4 * n);
                                if (fr == 0) c += w1 * h1 + w0 * h2; else if (fr == 1) c += w0 * h1; } }
                        cv[bj] = c;
                    }
                    float a4[4];
#pragma unroll
                    for (int e = 0; e < 4; ++e) { const float gx = cv[0][e]; a4[e] = gx * __builtin_amdgcn_rcpf(1.0f + __expf(-gx)) * cv[1][e]; }
                    if (n == 0) { pk0[ai][m].x = pk2(a4[0], a4[1]); pk0[ai][m].y = pk2(a4[2], a4[3]); }
                    else if (lrow >= 2 && grow < MTOK) { u32x4 o; o.x = pk0[ai][m].x; o.y = pk0[ai][m].y; o.z = pk2(a4[0], a4[1]); o.w = pk2(a4[2], a4[3]); *(u32x4*)(ACT + (size_t)grow * FF + ch - 4) = o; }
                }
        }
    }
};
struct EpiDsaIn {
    static constexpr bool PERM = false;
    unsigned char* ws; LAS float* scr; const LAS float* rtab;
    __device__ __forceinline__ void prefetch(const Unit&, int, int, int) const {}
    __device__ __forceinline__ void operator()(const AccT& acc_in, const Unit& u, int wr, int wc, int fr, int fq, int ui) const {
        const int row0 = u.pm * 256 + wr * 64 + fr;
        const float* ropeC = (const float*)(ws + WS_ROPE); const float* ropeS = ropeC + SEQ * 64;
        bf16_t* VTD = (bf16_t*)(ws + WS_VTD); float* WI = (float*)(ws + WS_WI);
        const bool need_norm = (u.pn < 10) || (u.pn == 20);
        float rs[2][4];
#pragma unroll
        for (int ai = 0; ai < 2; ++ai)
#pragma unroll
            for (int m = 0; m < 4; ++m) rs[ai][m] = rtab[ui * 256 + ai * 128 + wr * 64 + m * 16 + fr];
        if (need_norm) {
#pragma unroll
            for (int ai = 0; ai < 2; ++ai)
#pragma unroll
                for (int m = 0; m < 4; ++m)
#pragma unroll
                    for (int bj = 0; bj < 2; ++bj) { const f32x4 a = acc_in[ai][bj][m][0], b = acc_in[ai][bj][m][1];
                        float ss = ((a[0] * a[0] + a[1] * a[1]) + (a[2] * a[2] + a[3] * a[3])) + ((b[0] * b[0] + b[1] * b[1]) + (b[2] * b[2] + b[3] * b[3]));
                        ss += __shfl_xor(ss, 16); ss += __shfl_xor(ss, 32);
                        if (fq == 0) scr[(ai * 128 + wr * 64 + m * 16 + fr) * 8 + bj * 4 + wc] = ss * rs[ai][m] * rs[ai][m]; }
            asm volatile("s_waitcnt lgkmcnt(0)" ::: "memory"); __builtin_amdgcn_s_barrier(); asm volatile("" ::: "memory");
        }
        const int dl = 16 * wc + 8 * (fq & 1) + 4 * (fq >> 1);
#pragma unroll
        for (int bj = 0; bj < 2; ++bj) {
            const int hh = 2 * u.pn + bj;
            if (hh >= 20 && hh < 24) {
#pragma unroll
                for (int ai = 0; ai < 2; ++ai)
#pragma unroll
                    for (int m = 0; m < 4; ++m) { const int row = row0 + ai * 128 + m * 16, b = row >> 11, s0 = row & 2047, s = (s0 & ~12) | ((s0 & 4) << 1) | ((s0 & 8) >> 1); const float r = rs[ai][m];
                        bf16_t* p = VTD + ((size_t)(b * KVH + (hh - 20)) * HD + dl) * SEQ + s;
#pragma unroll
                        for (int n = 0; n < 2; ++n)
#pragma unroll
                            for (int e = 0; e < 4; ++e) p[(size_t)(64 * n + e) * SEQ] = f2bf(acc_in[ai][bj][m][n][e] * r); }
            } else if (hh == 41) {
                if (wc == 0) {
#pragma unroll
                    for (int ai = 0; ai < 2; ++ai)
#pragma unroll
                        for (int m = 0; m < 4; ++m) { const int row = row0 + ai * 128 + m * 16; *(f32x4*)(WI + (size_t)row * 16 + dl) = acc_in[ai][bj][m][0] * rs[ai][m]; } }
            } else {
                const bool norm = (hh < 20) || (hh == 40);
                const float* g = (const float*)(ws + WS_GAIN) + (hh < 16 ? 0 : (hh < 20 ? 128 : 256));
                f32x4 g0 = (f32x4){1.f, 1.f, 1.f, 1.f}, g1 = g0;
                if (norm) { g0 = *(const f32x4*)(g + dl); g1 = *(const f32x4*)(g + dl + 64); }
                size_t boff; int ld, cb;
                if (hh < 16) { boff = WS_Q; ld = DM; cb = hh * HD; } else if (hh < 20) { boff = WS_KD; ld = KVH * HD; cb = (hh - 16) * HD; }
                else if (hh < 40) { boff = WS_QI; ld = DM; cb = (hh - 24) * HD; } else { boff = WS_KI; ld = HD; cb = 0; }
                bf16_t* base = (bf16_t*)(ws + boff);
                const float osc = hh < 16 ? QSCALE : 1.0f;
#pragma unroll
                for (int ai = 0; ai < 2; ++ai)
#pragma unroll
                    for (int m = 0; m < 4; ++m) { const int lrow = ai * 128 + wr * 64 + m * 16 + fr, row = u.pm * 256 + lrow, pos = row & 2047;
                        float sc = rs[ai][m];
                        if (norm) { const f32x4 t = *(const LAS f32x4*)(scr + lrow * 8 + bj * 4); sc *= __builtin_amdgcn_rsqf(((t[0] + t[1]) + (t[2] + t[3])) * (1.0f / HD) + NORM_EPS); }
                        sc *= osc;
                        const f32x4 c = *(const f32x4*)(ropeC + pos * 64 + dl), sn = *(const f32x4*)(ropeS + pos * 64 + dl);
                        const f32x4 y0 = acc_in[ai][bj][m][0] * g0 * sc, y1 = acc_in[ai][bj][m][1] * g1 * sc;
                        const f32x4 o0 = y0 * c - y1 * sn, o1 = y1 * c + y0 * sn;
                        unsigned ax = pk2(o0[0], o0[1]), ay = pk2(o0[2], o0[3]), bx = pk2(o1[0], o1[1]), by = pk2(o1[2], o1[3]);
                        { auto rr = __builtin_amdgcn_permlane32_swap(ax, bx, false, false); ax = rr[0]; bx = rr[1]; }
                        { auto rr = __builtin_amdgcn_permlane32_swap(ay, by, false, false); ay = rr[0]; by = rr[1]; }
                        bf16_t* rp = base + (size_t)row * ld + cb + dl + 60 * (fq >> 1);
                        *(u32x4*)rp = (u32x4){ax, ay, bx, by}; }
            }
        }
    }
};

enum { WM_PLAIN = 0, WM_UP = 1, WM_IN = 2 };
__device__ __forceinline__ int colmap(int kind, int np) {
    if (kind == WM_UP) { const int pn = np >> 8, bj = (np >> 7) & 1, q = np & 127; return bj * FF + 128 * pn + q; }
    if (kind == WM_IN) { const int hh = np >> 7, p = np & 127, fq = (p >> 2) & 3, d = 16 * (p >> 5) + 8 * (fq & 1) + 4 * (fq >> 1) + (p & 3) + 64 * ((p >> 4) & 1);
        if (hh < 41) return hh * 128 + d; return (d < 16) ? (5248 + d) : -1; }
    return np;
}
struct WJ { const float* W; const float* gain; bf16_t* WT; int K, N, NP, kind, local; };
__device__ __forceinline__ void tr_load(const WJ& j, int lane, f32x4 (&v)[16]) {
    const int nblk = j.NP / 64, kb = j.local / nblk, nb = j.local - kb * nblk, k0 = 64 * kb, n0 = 64 * nb;
    int ln = lane; asm volatile("" : "+v"(ln));
    const int src = colmap(j.kind, n0 + 4 * (ln & 15)), rg = lane >> 4;
    const float* p = j.W + (size_t)(k0 + rg) * j.N + (src >= 0 ? src : 0);
#pragma unroll
    for (int i = 0; i < 16; ++i) { v[i] = __builtin_nontemporal_load((const f32x4*)(p + (size_t)(4 * i) * j.N)); if (src < 0) v[i] = (f32x4){0.f, 0.f, 0.f, 0.f}; }
}
__device__ __forceinline__ void tr_process(const WJ& j, int lane, const f32x4 (&v)[16], LAS float* scr) {
    const int nblk = j.NP / 64, kb = j.local / nblk, nb = j.local - kb * nblk, k0 = 64 * kb, n0 = 64 * nb;
    const int rg = lane >> 4, cg = lane & 15;
    float gl = 1.0f; if (j.gain) gl = j.gain[k0 + lane];
#pragma unroll
    for (int i = 0; i < 16; ++i) { const int kk = 4 * i + rg; const float g = __shfl(gl, kk); LAS float* d = scr + kk * 65 + 4 * cg;
        d[0] = v[i][0] * g; d[1] = v[i][1] * g; d[2] = v[i][2] * g; d[3] = v[i][3] * g; }
    asm volatile("s_waitcnt lgkmcnt(0)" ::: "memory");
    const int c = lane & 7;
#pragma unroll
    for (int jj = 0; jj < 8; ++jj) { const int n = (lane >> 3) + 8 * jj; const LAS float* s = scr + (8 * c) * 65 + n;
        u32x4 o; o.x = pk2(s[0 * 65], s[1 * 65]); o.y = pk2(s[2 * 65], s[3 * 65]); o.z = pk2(s[4 * 65], s[5 * 65]); o.w = pk2(s[6 * 65], s[7 * 65]);
        *(u32x4*)(j.WT + (size_t)(n0 + n) * j.K + k0 + 8 * c) = o; }
    asm volatile("s_waitcnt lgkmcnt(0)" ::: "memory");
}

struct Args {
    const float* x; const float* attn_g; const float* ffn_g; const float* w_qkv; const float* w_o0; const float* w_in;
    const float* qn_g; const float* kn_g; const float* ikn_g; const float* w_o1; const float* w_up; const float* conv_w; const float* conv_b; const float* w_down;
    float* out; unsigned char* ws; int ph_lo, ph_hi;
};

constexpr int WI0 = 32 * 96, WI1 = WI0 + 32 * 32, WI2 = WI1 + 32 * 84, WI3 = WI2 + 32 * 32, WI4 = WI3 + 32 * 176, WI5 = WI4 + 32 * 176, WI6 = WI5 + 88 * 32, WI7 = WI6 + 88 * 32;
__device__ __forceinline__ WJ wj_decode(const Args& a, int it) {
    unsigned char* ws = a.ws; WJ j;
    if (it < WI0)      j = WJ{a.w_qkv, nullptr, (bf16_t*)(ws + WS_WQKV), DM, NQKV, NQKV, WM_PLAIN, it};
    else if (it < WI1) j = WJ{a.w_o0, nullptr, (bf16_t*)(ws + WS_WO0), DM, DM, DM, WM_PLAIN, it - WI0};
    else if (it < WI2) j = WJ{a.w_in, a.attn_g + DM, (bf16_t*)(ws + WS_WIN), DM, NIN, NINP, WM_IN, it - WI1};
    else if (it < WI3) j = WJ{a.w_o1, nullptr, (bf16_t*)(ws + WS_WO1), DM, DM, DM, WM_PLAIN, it - WI2};
    else if (it < WI4) j = WJ{a.w_up, a.ffn_g, (bf16_t*)(ws + WS_WUP), DM, NUP, NUP, WM_UP, it - WI3};
    else if (it < WI5) j = WJ{a.w_up + (size_t)DM * NUP, a.ffn_g + DM, (bf16_t*)(ws + WS_WUP + 44 * MiB), DM, NUP, NUP, WM_UP, it - WI4};
    else if (it < WI6) j = WJ{a.w_down, nullptr, (bf16_t*)(ws + WS_WDN), FF, DM, DM, WM_PLAIN, it - WI5};
    else               j = WJ{a.w_down + (size_t)FF * DM, nullptr, (bf16_t*)(ws + WS_WDN + 22 * MiB), FF, DM, DM, WM_PLAIN, it - WI6};
    return j;
}
__device__ __forceinline__ void convert_items(const Args& a, LAS float* scr, int lo1, int hi1, int lo2, int hi2, int vw, int nvw, int lane) {
    const int n1 = hi1 - lo1, hi = n1 + (hi2 - lo2);
#define CV_ITEM(v) wj_decode(a, (v) < n1 ? lo1 + (v) : lo2 + ((v) - n1))
    int it = vw;
    if (it >= hi) return;
    f32x4 va[16], vb[16];
    WJ ja = CV_ITEM(it), jb = ja;
    tr_load(ja, lane, va);
#pragma nounroll
    for (;;) {
        int nx = it + nvw; bool hn = nx < hi;
        if (hn) { jb = CV_ITEM(nx); tr_load(jb, lane, vb); }
        tr_process(ja, lane, va, scr);
        if (!hn) break;
        it = nx; nx = it + nvw; hn = nx < hi;
        if (hn) { ja = CV_ITEM(nx); tr_load(ja, lane, va); }
        tr_process(jb, lane, vb, scr);
        if (!hn) break;
        it = nx;
    }
#undef CV_ITEM
}
struct Offload { int g_up, g_in; bool up0, in1, up1; };
__device__ __forceinline__ Offload make_offload(int G) {
    Offload o; const int u_up = 33 * (NUP / 256), u_in = (MTOK / 256) * (NINP / 256);
    const int r_up = (u_up + G - 1) / G, r_in = (u_in + G - 1) / G;
    o.g_up = (u_up + r_up - 1) / r_up; o.g_in = (u_in + r_in - 1) / r_in;
    o.up0 = (G - o.g_up) >= 8; o.up1 = o.up0; o.in1 = (G - o.g_in) >= 16;
    return o;
}
__device__ __forceinline__ void prologue_phase(const Args& a, LAS unsigned char* lds, int gw, int ngw, int wave, int lane, const Offload& offl) {
    unsigned char* ws = a.ws;
    LAS float* scr = (LAS float*)(lds + wave * 16640);
    convert_items(a, scr, 0, WI0, 0, 0, gw, ngw, lane);
    if (!offl.up0 || !offl.in1 || !offl.up1) {
        if (!offl.up0) convert_items(a, scr, WI5, WI6, WI2, WI3, gw, ngw, lane);
        if (!offl.in1) convert_items(a, scr, WI4, WI5, 0, 0, gw, ngw, lane);
        if (!offl.up1) convert_items(a, scr, WI6, WI7, 0, 0, gw, ngw, lane);
    }
    bf16_t* XB = (bf16_t*)(ws + WS_XB);
    for (int m = gw; m < MTOK; m += 2 * ngw) {
        const int m2 = m + ngw; const bool has2 = m2 < MTOK;
        const f32x4* xr = (const f32x4*)(a.x + (size_t)m * DM) + lane; const f32x4* xr2 = (const f32x4*)(a.x + (size_t)(has2 ? m2 : m) * DM) + lane;
        f32x4 v[8], v2[8]; float s = 0.f, s2 = 0.f;
#pragma unroll
        for (int j = 0; j < 8; ++j) { v[j] = xr[64 * j]; v2[j] = xr2[64 * j]; }
#pragma unroll
        for (int j = 0; j < 8; ++j) { s += (v[j].x * v[j].x + v[j].y * v[j].y) + (v[j].z * v[j].z + v[j].w * v[j].w); s2 += (v2[j].x * v2[j].x + v2[j].y * v2[j].y) + (v2[j].z * v2[j].z + v2[j].w * v2[j].w); }
        const float rstd = 1.0f / sqrtf(wave_sum(s) * (1.0f / DM) + NORM_EPS), rstd2 = 1.0f / sqrtf(wave_sum(s2) * (1.0f / DM) + NORM_EPS);
        u32x2* o8 = (u32x2*)(XB + (size_t)m * DM) + lane; u32x2* o82 = (u32x2*)(XB + (size_t)m2 * DM) + lane;
#pragma unroll
        for (int j = 0; j < 8; ++j) { const f32x4 g = ((const f32x4*)a.attn_g)[lane + 64 * j];
            u32x2 w; w.x = pk2(v[j].x * rstd * g.x, v[j].y * rstd * g.y); w.y = pk2(v[j].z * rstd * g.z, v[j].w * rstd * g.w); o8[64 * j] = w;
            if (has2) { u32x2 w2; w2.x = pk2(v2[j].x * rstd2 * g.x, v2[j].y * rstd2 * g.y); w2.y = pk2(v2[j].z * rstd2 * g.z, v2[j].w * rstd2 * g.w); o82[64 * j] = w2; } }
    }
    if (gw == 0) { float* gn = (float*)(ws + WS_GAIN); for (int i = lane; i < 128; i += 64) { gn[i] = a.qn_g[i]; gn[128 + i] = a.kn_g[i]; gn[256 + i] = a.ikn_g[i]; } }
    float* rc = (float*)(ws + WS_ROPE); float* rsn = rc + SEQ * 64;
    for (int i = gw * 64 + lane; i < SEQ * 64; i += ngw * 64) {
        const int pos = i >> 6, fi = i & 63;
        const float inv_freq = (float)(1.0 / exp2((double)fi * (2.0 / 128.0) * 13.287712379549449));
        const float ang = (float)pos * inv_freq;
        const double x = (double)ang; const double kq = rint(x * 0.63661977236758134308);
        double r = __builtin_fma(-kq, 1.57079632679489655800e+00, x); r = __builtin_fma(-kq, 6.12323399573676603587e-17, r);
        const double r2 = r * r;
        double sp = -1.0 / 6227020800.0; sp = sp * r2 + 1.0 / 39916800.0; sp = sp * r2 - 1.0 / 362880.0; sp = sp * r2 + 1.0 / 5040.0; sp = sp * r2 - 1.0 / 120.0; sp = sp * r2 + 1.0 / 6.0; const double sv = r - r * r2 * sp;
        double cp = 1.0 / 87178291200.0; cp = cp * r2 - 1.0 / 479001600.0; cp = cp * r2 + 1.0 / 3628800.0; cp = cp * r2 - 1.0 / 40320.0; cp = cp * r2 + 1.0 / 720.0; cp = cp * r2 - 1.0 / 24.0; cp = cp * r2 + 0.5; const double cv = 1.0 - r2 * cp;
        const int q = ((int)kq) & 3;
        const double cs = (q == 0) ? cv : (q == 1) ? -sv : (q == 2) ? -cv : sv;
        const double sn = (q == 0) ? sv : (q == 1) ? cv : (q == 2) ? -sv : -cv;
        rc[i] = (float)cs; rsn[i] = (float)sn;
    }
}

constexpr float SB_EXIT = 220.0f;
__device__ __forceinline__ unsigned fmap(float f) { const unsigned u = __float_as_uint(f); return (u & 0x80000000u) ? ~u : (u | 0x80000000u); }


__device__ __forceinline__ void store_o_rows16(bf16_t* row_base  , const f32x16 (&o)[4], float scale, int hh) {
    unsigned char* bp = (unsigned char*)row_base + (hh ? 16 : 0);
#pragma unroll
    for (int d = 0; d < 4; ++d)
#pragma unroll
        for (int g = 0; g < 4; g += 2) {
            unsigned ax = pk2(o[d][4 * g] * scale, o[d][4 * g + 1] * scale), ay = pk2(o[d][4 * g + 2] * scale, o[d][4 * g + 3] * scale);
            unsigned bx = pk2(o[d][4 * g + 4] * scale, o[d][4 * g + 5] * scale), by = pk2(o[d][4 * g + 6] * scale, o[d][4 * g + 7] * scale);
            { auto rr = __builtin_amdgcn_permlane32_swap(ax, bx, false, false); ax = rr[0]; bx = rr[1]; }
            { auto rr = __builtin_amdgcn_permlane32_swap(ay, by, false, false); ay = rr[0]; by = rr[1]; }
            *(u32x4*)(bp + 16 * (4 * d + g)) = (u32x4){ax, ay, bx, by};
        }
}

constexpr int KSTR = 272, VSTR = 144, KTILE_B = 64 * KSTR, VTILE_B = 128 * VSTR, KVBUF_B = KTILE_B + VTILE_B;
struct KVStage {
    u32x4 k[2], v[2];
    __device__ __forceinline__ void load(const unsigned char* kg, size_t kstride, const unsigned char* vg, size_t vstride, int tid) {
#pragma unroll
        for (int i = 0; i < 2; ++i) { const int c = tid + 512 * i; k[i] = *(const u32x4*)(kg + (size_t)(c >> 4) * kstride + (c & 15) * 16); v[i] = *(const u32x4*)(vg + (size_t)(c >> 3) * vstride + (c & 7) * 16); }
    }
    __device__ __forceinline__ void store(LAS unsigned char* buf, int tid) const {
#pragma unroll
        for (int i = 0; i < 2; ++i) { const int c = tid + 512 * i;
            *(LAS u32x4*)(buf + (c >> 4) * KSTR + (c & 15) * 16) = k[i];
            *(LAS u32x4*)(buf + KTILE_B + (c >> 3) * VSTR + (c & 7) * 16) = v[i]; }
    }
};

__device__ __forceinline__ void dsa_attn_block(const bf16_t* __restrict__ QD, const bf16_t* __restrict__ KD, const bf16_t* __restrict__ VTD, const unsigned* __restrict__ MASK, bf16_t* __restrict__ O,
                                               LAS unsigned char* lds, int b, int g, int qb64, int wave, int lane, int tid) {
    const int r = lane & 31, hh = lane >> 5, h = 4 * g + (wave & 3), q0 = 64 * qb64 + 32 * (wave >> 2);
    LAS unsigned char* qlds = lds + 2 * KVBUF_B + wave * (32 * KSTR);
    { const unsigned char* qg = (const unsigned char*)(QD + (size_t)(b * SEQ + q0) * DM + h * HD);
        u32x4 t[8];
#pragma unroll
        for (int i = 0; i < 8; ++i) { const int c = lane + 64 * i; t[i] = *(const u32x4*)(qg + (size_t)(c >> 4) * (DM * 2) + (c & 15) * 16); }
#pragma unroll
        for (int i = 0; i < 8; ++i) { const int c = lane + 64 * i; *(LAS u32x4*)(qlds + (c >> 4) * KSTR + (c & 15) * 16) = t[i]; }
        asm volatile("s_waitcnt lgkmcnt(0)" ::: "memory"); }
    const LAS unsigned char* qfp = qlds + r * KSTR + 16 * hh;
    f32x16 o[4];
#pragma unroll
    for (int d = 0; d < 4; ++d) o[d] = f32x16{};
    float mrun = -1e29f, lrun = 0.f;
    const unsigned char* kg = (const unsigned char*)(KD + (size_t)(b * SEQ) * (KVH * HD) + g * HD);
    const unsigned char* vg = (const unsigned char*)(VTD + (size_t)(b * KVH + g) * HD * SEQ);
    const unsigned long long* mrow = (const unsigned long long*)(MASK + (size_t)(b * SEQ + q0 + r) * 64);
    KVStage sA, sB;
#define MA_LOAD(ST, t) ST.load(kg + (size_t)(t) * 64 * (KVH * HD * 2), KVH * HD * 2, vg + (size_t)(t) * 64 * 2, SEQ * 2, tid)
    MA_LOAD(sA, 0);
    sA.store(lds, tid);
    asm volatile("s_waitcnt lgkmcnt(0)" ::: "memory"); __builtin_amdgcn_s_barrier(); asm volatile("" ::: "memory");
    if (qb64 >= 1) MA_LOAD(sA, 1);
    if (qb64 >= 2) MA_LOAD(sB, 2);
    unsigned long long mw_next = mrow[0];
    for (int kt = 0; kt <= qb64; ++kt) {
        LAS unsigned char* buf = lds + (kt & 1) * KVBUF_B;
        const unsigned long long mw = mw_next;
        if (kt < qb64) mw_next = mrow[kt + 1];
        const bool two = (64 * kt + 32) <= q0 + 31;
        f32x16 p0 = f32x16{}, p1 = f32x16{};
        { const LAS unsigned char* kp = buf + r * KSTR + 16 * hh;
            bf16x8 qf[8];
#pragma unroll
            for (int s = 0; s < 8; ++s) qf[s] = *(const LAS bf16x8*)(qfp + 32 * s);
#pragma unroll
            for (int s = 0; s < 8; ++s) p0 = __builtin_amdgcn_mfma_f32_32x32x16_bf16(*(const LAS bf16x8*)(kp + 32 * s), qf[s], p0, 0, 0, 0);
            if (two) {
#pragma unroll
                for (int s = 0; s < 8; ++s) p1 = __builtin_amdgcn_mfma_f32_32x32x16_bf16(*(const LAS bf16x8*)(kp + 32 * KSTR + 32 * s), qf[s], p1, 0, 0, 0); } }
        const int m0 = (int)(((unsigned)mw) >> (4 * hh)), m1 = two ? (int)(((unsigned)(mw >> 32)) >> (4 * hh)) : 0;
        const unsigned NEGB = 0xf149f2cau;
#pragma unroll
        for (int i = 0; i < 16; ++i) { const int kb = crow(i, 0);
            const unsigned t0 = (unsigned)((m0 << (31 - kb)) >> 31), t1 = (unsigned)((m1 << (31 - kb)) >> 31);
            p0[i] = __uint_as_float((__float_as_uint(p0[i]) & t0) | (NEGB & ~t0)); p1[i] = __uint_as_float((__float_as_uint(p1[i]) & t1) | (NEGB & ~t1)); }
        float tmax = fmaxf(p0[0], p1[0]);
#pragma unroll
        for (int i = 1; i < 16; ++i) tmax = fmaxf(fmaxf(tmax, p0[i]), p1[i]);
        tmax = swap_max(tmax);
        const bool grow = __any(tmax > mrun + 8.0f);
        const float mnew = grow ? fmaxf(mrun, tmax) : mrun;
        if (grow) {
            const float alpha = __builtin_amdgcn_exp2f(mrun - mnew);
            lrun *= alpha;
#pragma unroll
            for (int d = 0; d < 4; ++d)
#pragma unroll
                for (int i = 0; i < 16; ++i) o[d][i] *= alpha;
        }
        float ls = 0.f;
#pragma unroll
        for (int i = 0; i < 16; ++i) { const float e0 = __builtin_amdgcn_exp2f(p0[i] - mnew), e1 = __builtin_amdgcn_exp2f(p1[i] - mnew); p0[i] = e0; p1[i] = e1; ls += e0 + e1; }
        lrun += ls; mrun = mnew;
        const bf16x8 pa0 = pack8(p0, 0), pa1 = pack8(p0, 8), pa2 = pack8(p1, 0), pa3 = pack8(p1, 8);
        const LAS unsigned char* vb = buf + KTILE_B + r * VSTR + 16 * hh;
#pragma unroll
        for (int d = 0; d < 4; ++d) {
            const LAS unsigned char* vp = vb + 32 * d * VSTR;
#define VFRAG(ks) (*(const LAS bf16x8*)(vp + 32 * (ks)))
            o[d] = __builtin_amdgcn_mfma_f32_32x32x16_bf16(VFRAG(0), pa0, o[d], 0, 0, 0);
            o[d] = __builtin_amdgcn_mfma_f32_32x32x16_bf16(VFRAG(1), pa1, o[d], 0, 0, 0);
            if (two) { o[d] = __builtin_amdgcn_mfma_f32_32x32x16_bf16(VFRAG(2), pa2, o[d], 0, 0, 0);
                       o[d] = __builtin_amdgcn_mfma_f32_32x32x16_bf16(VFRAG(3), pa3, o[d], 0, 0, 0); }
#undef VFRAG
        }
        if (kt & 1) { if (kt + 1 <= qb64) sB.store(lds + ((kt + 1) & 1) * KVBUF_B, tid); if (kt + 3 <= qb64) MA_LOAD(sB, kt + 3); }
        else        { if (kt + 1 <= qb64) sA.store(lds + ((kt + 1) & 1) * KVBUF_B, tid); if (kt + 3 <= qb64) MA_LOAD(sA, kt + 3); }
        asm volatile("s_waitcnt lgkmcnt(0)" ::: "memory"); __builtin_amdgcn_s_barrier(); asm volatile("" ::: "memory");
    }
#undef MA_LOAD
    asm volatile("s_waitcnt vmcnt(0)" ::: "memory");
    const float linv = 1.0f / swap_sum(lrun);
    store_o_rows16(O + (size_t)(b * SEQ + q0 + r) * DM + h * HD, o, linv, hh);
}


__device__ __forceinline__ unsigned wave_total_u32(unsigned v) {
    v += (unsigned)__builtin_amdgcn_update_dpp(0, (int)v, 0x111, 0xf, 0xf, true);
    v += (unsigned)__builtin_amdgcn_update_dpp(0, (int)v, 0x112, 0xf, 0xf, true);
    v += (unsigned)__builtin_amdgcn_update_dpp(0, (int)v, 0x114, 0xf, 0xf, true);
    v += (unsigned)__builtin_amdgcn_update_dpp(0, (int)v, 0x118, 0xf, 0xf, true);
    v += (unsigned)__builtin_amdgcn_update_dpp(0, (int)v, 0x142, 0xa, 0xf, false);
    v += (unsigned)__builtin_amdgcn_update_dpp(0, (int)v, 0x143, 0xc, 0xf, false);
    return (unsigned)__builtin_amdgcn_readlane((int)v, 63);
}
__device__ __forceinline__ void causal_mask_row(unsigned* mrow, int t, int lane) {
    const int key0 = 32 * lane; unsigned w;
    if (key0 + 31 <= t) w = 0xffffffffu; else if (key0 > t) w = 0u; else w = (1u << (t - key0 + 1)) - 1u;
    mrow[lane] = w;
}
__device__ __forceinline__ void write_topk_mask(const unsigned (&uv)[32], unsigned prefix, unsigned* mrow, int lane) {
    int cgt = 0;
#pragma unroll
    for (int e = 0; e < 32; ++e) cgt += __popcll(__ballot(uv[e] > prefix));
    const int need = TOPK - cgt; int running = 0;
    const unsigned long long ltm = (1ull << lane) - 1ull;
    unsigned long long keep = 0ull;
#pragma unroll
    for (int e = 0; e < 32; ++e) {
        const unsigned long long eq = __ballot(uv[e] == prefix);
        const bool sel = (uv[e] > prefix) || (uv[e] == prefix && (running + __popcll(eq & ltm)) < need);
        const unsigned long long m64 = __ballot(sel);
        running += __popcll(eq);
        if (lane == e) keep = m64;
    }
    if (lane < 32) *(unsigned long long*)(mrow + 2 * lane) = keep;
}
__device__ __forceinline__ void select_two(const float* rowa, const float* rowb, int ta, unsigned* mrowa, unsigned* mrowb, int lane) {
    const int tb = ta + 1, na = ta + 1, nb = tb + 1;
    if (nb <= TOPK) { causal_mask_row(mrowa, ta, lane); causal_mask_row(mrowb, tb, lane); return; }
    float fa[32], fb[32];
#pragma unroll
    for (int e = 0; e < 32; ++e) { fa[e] = __builtin_nontemporal_load(rowa + e * 64 + lane); fb[e] = __builtin_nontemporal_load(rowb + e * 64 + lane); }
    unsigned ua[32], ub[32];
#pragma unroll
    for (int e = 0; e < 32; ++e) { const int key = e * 64 + lane; const unsigned ma = fmap(fa[e]), mb = fmap(fb[e]); ua[e] = (key < na) ? ma : 0x007fffffu; ub[e] = (key < nb) ? mb : 0x007fffffu; }
    unsigned pa = 0u, pb = 0u; bool da = false, db = false;
    for (int bit = 31; bit >= 0; --bit) {
        const unsigned ca = pa | (1u << bit), cb = pb | (1u << bit);
        unsigned na_ = 0u, nb_ = 0u;
#pragma unroll
        for (int e = 0; e < 32; ++e) { na_ += (ua[e] >= ca) ? 1u : 0u; nb_ += (ub[e] >= cb) ? 1u : 0u; }
        const unsigned tota = wave_total_u32(na_), totb = wave_total_u32(nb_);
        if (!da && tota >= (unsigned)TOPK) { pa = ca; if (tota == (unsigned)TOPK) da = true; }
        if (!db && totb >= (unsigned)TOPK) { pb = cb; if (totb == (unsigned)TOPK) db = true; }
        if (da && db) break;
    }
    if (na <= TOPK) causal_mask_row(mrowa, ta, lane); else write_topk_mask(ua, pa, mrowa, lane);
    write_topk_mask(ub, pb, mrowb, lane);
}

struct KiStage {
    u32x4 k[4];
    __device__ __forceinline__ void load(const unsigned char* kg, int tid) {
#pragma unroll
        for (int i = 0; i < 4; ++i) { const int c = tid + 512 * i; k[i] = *(const u32x4*)(kg + (size_t)(c >> 4) * (HD * 2) + (c & 15) * 16); }
    }
    __device__ __forceinline__ void store(LAS unsigned char* buf, int tid) const {
#pragma unroll
        for (int i = 0; i < 4; ++i) { const int c = tid + 512 * i; *(LAS u32x4*)(buf + (c >> 4) * KSTR + (c & 15) * 16) = k[i]; }
    }
};
constexpr int KIBUF_B = 128 * KSTR;
__device__ __forceinline__ void indexer_block(const bf16_t* __restrict__ QI, const bf16_t* __restrict__ KI, const float* __restrict__ WI, unsigned* __restrict__ MASK, float* __restrict__ SC,
                                              LAS unsigned char* lds, int b, int qb16, int wave, int lane, int tid) {
    const int r = lane & 31, hh = lane >> 5, t0 = 16 * qb16, tw = t0 + 2 * wave;
    const bf16_t* ap = QI + (size_t)(b * SEQ + tw + (r >> 4)) * DM + (r & 15) * HD + 8 * hh;
    bf16x8 af[8];
#pragma unroll
    for (int s = 0; s < 8; ++s) af[s] = *(const bf16x8*)(ap + 16 * s);
    float wv[16];
#pragma unroll
    for (int i = 0; i < 16; ++i) { const int rw = crow(i, hh); wv[i] = WI[(size_t)(b * SEQ + tw + (rw >> 4)) * 16 + (rw & 15)]; }
    float* myrow = SC + ((size_t)(b * 128 + qb16) * 16 + 2 * wave + hh) * SEQ;
    const int tq = tw + hh, ntile = (t0 + 16 + 127) >> 7;
    const unsigned char* kg = (const unsigned char*)(KI + (size_t)(b * SEQ) * HD);
    KiStage sA, sB;
    sA.load(kg, tid);
    sA.store(lds, tid);
    asm volatile("s_waitcnt lgkmcnt(0)" ::: "memory"); __builtin_amdgcn_s_barrier(); asm volatile("" ::: "memory");
    if (ntile > 1) sA.load(kg + (size_t)1 * 128 * (HD * 2), tid);
    if (ntile > 2) sB.load(kg + (size_t)2 * 128 * (HD * 2), tid);
    for (int kt = 0; kt < ntile; ++kt) {
        const LAS unsigned char* buf = lds + (kt & 1) * KIBUF_B;
#pragma unroll
        for (int j = 0; j < 4; ++j) { const int key0 = 128 * kt + 32 * j;
            if (key0 <= t0 + 15) {
                const LAS unsigned char* kp = buf + (32 * j + r) * KSTR + 16 * hh;
                f32x16 c = f32x16{};
#pragma unroll
                for (int s = 0; s < 8; ++s) c = __builtin_amdgcn_mfma_f32_32x32x16_bf16(af[s], *(const LAS bf16x8*)(kp + 32 * s), c, 0, 0, 0);
                float s0 = 0.f, s1 = 0.f;
#pragma unroll
                for (int i = 0; i < 8; ++i) { s0 += wv[i] * relu_i(c[i]); s1 += wv[i + 8] * relu_i(c[i + 8]); }
                const float t0s = swap_sum(s0), t1s = swap_sum(s1);
                const int key = key0 + r;
                float v = (hh ? t1s : t0s) + 0.0f;
                if (key > tq) v = -INFINITY;
                myrow[key] = v; } }
        if (kt & 1) { if (kt + 1 < ntile) sB.store(lds + ((kt + 1) & 1) * KIBUF_B, tid); if (kt + 3 < ntile) sB.load(kg + (size_t)(kt + 3) * 128 * (HD * 2), tid); }
        else        { if (kt + 1 < ntile) sA.store(lds + ((kt + 1) & 1) * KIBUF_B, tid); if (kt + 3 < ntile) sA.load(kg + (size_t)(kt + 3) * 128 * (HD * 2), tid); }
        asm volatile("s_waitcnt lgkmcnt(0)" ::: "memory"); __builtin_amdgcn_s_barrier(); asm volatile("" ::: "memory");
    }
    asm volatile("s_waitcnt vmcnt(0)" ::: "memory");
    { const float* rowa = SC + ((size_t)(b * 128 + qb16) * 16 + 2 * wave) * SEQ;
      unsigned* mrowa = MASK + (size_t)(b * SEQ + tw) * 64;
      select_two(rowa, rowa + SEQ, tw, mrowa, mrowa + 64, lane); }
}


__device__ __forceinline__ void sb_attn_waves(const bf16_t* __restrict__ Q, const bf16_t* __restrict__ KF, const bf16_t* __restrict__ VF, bf16_t* __restrict__ O, int gw, int ngw, int lane) {
    const int r = lane & 31, hh = lane >> 5, rm = r - 4 * hh;
    bf16x8 uf[2];
#pragma unroll
    for (int s2 = 0; s2 < 2; ++s2) { u32x4 w; unsigned e[8];
#pragma unroll
        for (int j = 0; j < 8; ++j) { const int key = 16 * s2 + 8 * (j >> 2) + 4 * hh + (j & 3); e[j] = (key >= r) ? 0x3f80u : 0u; }
        w.x = e[0] | (e[1] << 16); w.y = e[2] | (e[3] << 16); w.z = e[4] | (e[5] << 16); w.w = e[6] | (e[7] << 16); uf[s2] = __builtin_bit_cast(bf16x8, w); }
    for (int unit = gw; unit < BATCH * NH * 64; unit += ngw) {
        const int bh = unit >> 6, qt = 63 - (unit & 63), b = bh >> 4, h = bh & 15, q0 = qt * 32;
        const bf16_t* qp = Q + (size_t)(b * SEQ + q0 + r) * DM + h * HD + 8 * hh;
        bf16x8 qf[8];
#pragma unroll
        for (int s = 0; s < 8; ++s) qf[s] = *(const bf16x8*)(qp + 16 * s);
        f32x16 o[4];
#pragma unroll
        for (int d = 0; d < 4; ++d) o[d] = f32x16{};
        float carry = 0.f;
        const bf16x8* kbase = (const bf16x8*)KF + (size_t)bh * 64 * 8 * 64 + lane;
        const bf16x8* vbase = (const bf16x8*)VF + (size_t)bh * 64 * 8 * 64 + lane;
        bf16x8 kf[8], vf[8];
#pragma unroll
        for (int s = 0; s < 8; ++s) kf[s] = kbase[(size_t)(qt * 8 + s) * 64];
#pragma unroll
        for (int i = 0; i < 8; ++i) vf[i] = vbase[(size_t)(qt * 8 + i) * 64];
        for (int kt = qt; kt >= 0; --kt) {
            bf16x8 kn[8], vn[8];
            const int ktn = kt > 0 ? kt - 1 : 0;
#pragma unroll
            for (int s = 0; s < 8; ++s) kn[s] = kbase[(size_t)(ktn * 8 + s) * 64];
            f32x16 p = f32x16{};
#pragma unroll
            for (int s = 0; s < 8; ++s) p = __builtin_amdgcn_mfma_f32_32x32x16_bf16(kf[s], qf[s], p, 0, 0, 0);
#pragma unroll
            for (int i = 0; i < 8; ++i) vn[i] = vbase[(size_t)(ktn * 8 + i) * 64];
            f32x16 sp;
#pragma unroll
            for (int i = 0; i < 16; ++i) sp[i] = __builtin_amdgcn_logf(1.0f + __builtin_amdgcn_exp2f(__builtin_amdgcn_fmed3f(p[i], 120.0f, -3.0e38f)));
            if (kt == qt) {
#pragma unroll
                for (int i = 0; i < 16; ++i) if (crow(i, 0) >= rm) { sp[i] = 0.f; p[i] = -1e30f; } }
            f32x16 c;
#pragma unroll
            for (int i = 0; i < 16; ++i) c[i] = carry;
            c = __builtin_amdgcn_mfma_f32_32x32x16_bf16(uf[0], pack8(sp, 0), c, 0, 0, 0);
            c = __builtin_amdgcn_mfma_f32_32x32x16_bf16(uf[1], pack8(sp, 8), c, 0, 0, 0);
#pragma unroll
            for (int i = 0; i < 16; ++i) p[i] = __builtin_amdgcn_exp2f(p[i] - c[i]);
            carry = swap_max(c[0]);
            const bf16x8 pa0 = pack8(p, 0), pa1 = pack8(p, 8);
#pragma unroll
            for (int d = 0; d < 4; ++d) { o[d] = __builtin_amdgcn_mfma_f32_32x32x16_bf16(vf[2 * d], pa0, o[d], 0, 0, 0); o[d] = __builtin_amdgcn_mfma_f32_32x32x16_bf16(vf[2 * d + 1], pa1, o[d], 0, 0, 0); }
            if (__all(carry > SB_EXIT)) break;
#pragma unroll
            for (int s = 0; s < 8; ++s) { kf[s] = kn[s]; vf[s] = vn[s]; }
        }
        store_o_rows16(O + (size_t)(b * SEQ + q0 + r) * DM + h * HD, o, 1.0f, hh);
    }
}

constexpr int N_PHASES = 12;
__global__ void __launch_bounds__(512, 2) fwd_kernel(Args a) {
    extern __shared__ __attribute__((aligned(16))) unsigned char lds_raw[];
    LAS unsigned char* lds = (LAS unsigned char*)lds_raw;
    cg::grid_group grid = cg::this_grid();
    const int tid = threadIdx.x, lane = tid & 63, wave = __builtin_amdgcn_readfirstlane(tid >> 6);
    const int G = gridDim.x, bx = blockIdx.x;
    const int gw = bx * 8 + wave, ngw = G * 8;
    unsigned char* ws = a.ws;
    const int lo = a.ph_lo, hi = a.ph_hi;
#ifndef REP_PHASE
#define REP_PHASE -1
#endif
#ifndef REP_COUNT
#define REP_COUNT 1
#endif
#define IN(k) (lo <= (k) && (k) < hi)
#define GSYNC(k) do { if ((k) == 0 && a.ph_hi > 1000) grid.sync(); xcd_barrier(xbar); } while (0)
#define SEAM(k) do { if (IN(k) && IN((k) + 1)) GSYNC(k); } while (0)
#define REPS(k) for (int rep_ = 0; rep_ < ((k) == REP_PHASE ? REP_COUNT : 1); ++rep_, (void)(((k) == REP_PHASE && rep_ < REP_COUNT) ? (xcd_barrier(xbar), 0) : 0))
    bf16_t* XB = (bf16_t*)(ws + WS_XB); float* PART = (float*)(ws + WS_PART);
    bf16_t* Qb = (bf16_t*)(ws + WS_Q); bf16_t* Kb = (bf16_t*)(ws + WS_K); bf16_t* Vtb = (bf16_t*)(ws + WS_VT); bf16_t* Ob = (bf16_t*)(ws + WS_O);
    bf16_t* QIb = (bf16_t*)(ws + WS_QI); bf16_t* KDb = (bf16_t*)(ws + WS_KD); bf16_t* VTDb = (bf16_t*)(ws + WS_VTD); bf16_t* KIb = (bf16_t*)(ws + WS_KI);
    float* WIb = (float*)(ws + WS_WI); unsigned* MASKb = (unsigned*)(ws + WS_MASK);
    bf16_t* ACTb = (bf16_t*)(ws + WS_ACT);
    const float* ropeC = (const float*)(ws + WS_ROPE); const float* ropeS = ropeC + SEQ * 64;

    if (tid < 16) ((volatile LAS unsigned*)(lds + LDS_MISC))[tid] = 0u;
    __syncthreads();
    XcdBarrier xbar = xcd_barrier_post((unsigned*)(ws + WS_CTL), (volatile LAS unsigned*)(lds + LDS_MISC) + 8);
    const Offload offl = make_offload(G);
    if (IN(0)) REPS(0) { prologue_phase(a, lds, gw, ngw, wave, lane, offl); }
    SEAM(0);
    if (IN(1)) REPS(1) {
        pg8::Gemm g{XB, (const bf16_t*)(ws + WS_WQKV), MTOK, NQKV, DM}; pg8::StaticOrder S; S.init(MTOK, NQKV, G, bx);
        EpiQKV E{ws};
        pg8::gemm_phase<EpiQKV, pg8::StaticOrder, true, true>(lds, g, S, E);
    }
    SEAM(1);
    if (IN(2)) REPS(2) {
        LAS float* scr = (LAS float*)(lds + wave * 16640);
#pragma nounroll
        for (int step = 0; step < 2; ++step) {
            if ((step == 0) == (wave < 4)) sb_attn_waves(Qb, Kb, Vtb, Ob, gw, ngw, lane);
            else { convert_items(a, scr, WI0, WI1, WI3, WI4, gw, ngw, lane); convert_items(a, scr, WI1, WI2, 0, 0, gw, ngw, lane); }
        }
    }
    SEAM(2);
    if (IN(3)) REPS(3) {
        pg8::Gemm g{Ob, (const bf16_t*)(ws + WS_WO0), MTOK, DM, DM}; pg8::StaticOrder S; S.init(MTOK, DM, G, bx);
        EpiRes<true, false> E{a.x, XB, PART};
        pg8::gemm_phase<EpiRes<true, false>, pg8::StaticOrder, true, true>(lds, g, S, E);
    }
    SEAM(3);
    if (IN(4)) REPS(4) {
        const int Gg = offl.up0 ? offl.g_up : G;
        if (bx < Gg) {
        pg8::Gemm g{XB, (const bf16_t*)(ws + WS_WUP), MTOK, NUP, DM, 254, -2}; pg8::StaticOrder S; S.init_tiles(33, NUP / 256, Gg, bx);
        rstd_table_build(lds, PART, S, 254, -2, tid);
        EpiUpConv E{ACTb, a.conv_w, a.conv_b, (LAS float*)(lds + LDS_EPI), (const LAS float*)(lds + LDS_RSTD)};
        pg8::gemm_phase<EpiUpConv, pg8::StaticOrder, true, true>(lds, g, S, E);
        } else { LAS float* scr = (LAS float*)(lds + wave * 16640); const int vw = (bx - Gg) * 8 + wave, nvw = (G - Gg) * 8;
            convert_items(a, scr, WI5, WI6, WI2, WI3, vw, nvw, lane); }
    }
    SEAM(4);
    if (IN(5)) REPS(5) {
        pg8::Gemm g{ACTb, (const bf16_t*)(ws + WS_WDN), MTOK, DM, FF}; pg8::StaticOrder S; S.init(MTOK, DM, G, bx);
        EpiRes<false, false> E{XB, XB, PART};
        pg8::gemm_phase<EpiRes<false, false>, pg8::StaticOrder, true, true>(lds, g, S, E);
    }
    SEAM(5);
    if (IN(6)) REPS(6) {
        const int Gg = offl.in1 ? offl.g_in : G;
        if (bx < Gg) {
        pg8::Gemm g{XB, (const bf16_t*)(ws + WS_WIN), MTOK, NINP, DM}; pg8::StaticOrder S; S.init(MTOK, NINP, Gg, bx);
        rstd_table_build(lds, PART, S, 256, 0, tid);
        EpiDsaIn E{ws, (LAS float*)(lds + LDS_EPI), (const LAS float*)(lds + LDS_RSTD)};
        pg8::gemm_phase<EpiDsaIn, pg8::StaticOrder, true, true>(lds, g, S, E);
        } else { LAS float* scr = (LAS float*)(lds + wave * 16640); const int vw = (bx - Gg) * 8 + wave, nvw = (G - Gg) * 8;
            convert_items(a, scr, WI4, WI5, 0, 0, vw, nvw, lane); }
    }
    SEAM(6);
    if (IN(7)) REPS(7) {
        for (int pr = bx; pr < 256; pr += G) { const int b = pr >> 6, p = pr & 63;
            for (int half = 0; half < 2; ++half) indexer_block(QIb, KIb, WIb, MASKb, (float*)(ws + WS_ACT), lds, b, half ? p : 127 - p, wave, lane, tid); }
    }
    SEAM(7);
    if (IN(8)) REPS(8) {
        for (int pr = bx; pr < 256; pr += G) { const int b = pr >> 6, g = (pr >> 4) & 3, p = pr & 15;
            for (int half = 0; half < 2; ++half) dsa_attn_block(Qb, KDb, VTDb, MASKb, Ob, lds, b, g, half ? p : 31 - p, wave, lane, tid); }
    }
    SEAM(8);
    if (IN(9)) REPS(9) {
        pg8::Gemm g{Ob, (const bf16_t*)(ws + WS_WO1), MTOK, DM, DM}; pg8::StaticOrder S; S.init(MTOK, DM, G, bx);
        EpiRes<false, false> E{XB, XB, PART};
        pg8::gemm_phase<EpiRes<false, false>, pg8::StaticOrder, true, true>(lds, g, S, E);
    }
    SEAM(9);
    if (IN(10)) REPS(10) {
        const int Gg = offl.up1 ? offl.g_up : G;
        if (bx < Gg) {
        pg8::Gemm g{XB, (const bf16_t*)(ws + WS_WUP + 44 * MiB), MTOK, NUP, DM, 254, -2}; pg8::StaticOrder S; S.init_tiles(33, NUP / 256, Gg, bx);
        rstd_table_build(lds, PART, S, 254, -2, tid);
        EpiUpConv E{ACTb, a.conv_w + 3 * NUP, a.conv_b + NUP, (LAS float*)(lds + LDS_EPI), (const LAS float*)(lds + LDS_RSTD)};
        pg8::gemm_phase<EpiUpConv, pg8::StaticOrder, true, true>(lds, g, S, E);
        } else { LAS float* scr = (LAS float*)(lds + wave * 16640); const int vw = (bx - Gg) * 8 + wave, nvw = (G - Gg) * 8;
            convert_items(a, scr, WI6, WI7, 0, 0, vw, nvw, lane); }
    }
    SEAM(10);
    if (IN(11)) REPS(11) {
        pg8::Gemm g{ACTb, (const bf16_t*)(ws + WS_WDN + 22 * MiB), MTOK, DM, FF}; pg8::StaticOrder S; S.init(MTOK, DM, G, bx);
        EpiRes<false, true> E{XB, a.out, nullptr};
        pg8::gemm_phase<EpiRes<false, true>, pg8::StaticOrder, true, true>(lds, g, S, E);
    }
#undef IN
#undef SEAM
}

extern "C" void kernel_launch(void* const* d_in, const int* in_sizes, int n_in, void* d_out, int out_size, void* d_ws, size_t ws_size, hipStream_t stream) {
    static int grid = 0;
    if (grid == 0) {
        if (n_in != 14 || out_size != MTOK * DM || ws_size < WS_END) { fprintf(stderr, "kernel_launch: unexpected shapes (n_in %d out %d ws %zu)\n", n_in, out_size, ws_size); grid = -1; return; }
        int dev = 0, cus = 0, per_cu = 0;
        hipGetDevice(&dev); hipDeviceGetAttribute(&cus, hipDeviceAttributeMultiprocessorCount, dev);
        if (hipFuncSetAttribute((const void*)fwd_kernel, hipFuncAttributeMaxDynamicSharedMemorySize, LDS_BYTES) != hipSuccess) { fprintf(stderr, "kernel_launch: hipFuncSetAttribute failed\n"); grid = -1; return; }
        if (hipOccupancyMaxActiveBlocksPerMultiprocessor(&per_cu, (const void*)fwd_kernel, 512, LDS_BYTES) != hipSuccess || per_cu < 1) { fprintf(stderr, "kernel_launch: occupancy query says %d\n", per_cu); per_cu = 1; }
        (void)hipGetLastError();
        grid = cus;
    }
    if (grid < 0) return;
    Args a{};
    a.x = (const float*)d_in[0]; a.attn_g = (const float*)d_in[1]; a.ffn_g = (const float*)d_in[2]; a.w_qkv = (const float*)d_in[3]; a.w_o0 = (const float*)d_in[4]; a.w_in = (const float*)d_in[5];
    a.qn_g = (const float*)d_in[6]; a.kn_g = (const float*)d_in[7]; a.ikn_g = (const float*)d_in[8]; a.w_o1 = (const float*)d_in[9]; a.w_up = (const float*)d_in[10]; a.conv_w = (const float*)d_in[11];
    a.conv_b = (const float*)d_in[12]; a.w_down = (const float*)d_in[13]; a.out = (float*)d_out; a.ws = (unsigned char*)d_ws;
    if (hipMemsetAsync((char*)d_ws + WS_CTL, 0, CTL_BYTES, stream) != hipSuccess) { fprintf(stderr, "kernel_launch: hipMemsetAsync failed\n"); return; }
#if MK_ONE_LAUNCH
    a.ph_lo = 0; a.ph_hi = N_PHASES;
    void* args[] = {&a};
    hipError_t e = hipLaunchCooperativeKernel((const void*)fwd_kernel, dim3(grid), dim3(512), args, LDS_BYTES, stream);
    if (e != hipSuccess) fprintf(stderr, "cooperative launch failed: %s (grid %d)\n", hipGetErrorString(e), grid);
#else
    for (int pp = 0; pp < N_PHASES + HOST_REP_EXTRA; ++pp) {
        const int p = pp < N_PHASES ? pp : -1;
        if (p < 0) continue;
        for (int hr = 0; hr < ((p == HOST_REP_PHASE) ? 1 + HOST_REP_EXTRA : 1); ++hr) {
        a.ph_lo = p; a.ph_hi = p + 1;
        void* args[] = {&a};
        hipError_t e = hipLaunchCooperativeKernel((const void*)fwd_kernel, dim3(grid), dim3(512), args, LDS_BYTES, stream);
        if (e != hipSuccess) { fprintf(stderr, "launch %d failed: %s (grid %d)\n", p, hipGetErrorString(e), grid); break; }
        }
    }
#endif
}
```

```cpp
#include <hip/hip_runtime.h>
#include <hip/hip_cooperative_groups.h>
#include <cstdio>
#include <cstdint>
namespace cg = cooperative_groups;

#ifndef HOST_REP_PHASE
#define HOST_REP_PHASE -1
#endif
#ifndef HOST_REP_EXTRA
#define HOST_REP_EXTRA 0
#endif
#ifndef MK_ONE_LAUNCH
#define MK_ONE_LAUNCH 1
#endif

#define LAS __attribute__((address_space(3)))
typedef unsigned short bf16_t;
typedef short bf16x8 __attribute__((ext_vector_type(8)));
typedef short s16x4 __attribute__((ext_vector_type(4)));
typedef float f32x4 __attribute__((ext_vector_type(4)));
typedef float f32x2 __attribute__((ext_vector_type(2)));
typedef float f32x16 __attribute__((ext_vector_type(16)));
typedef unsigned u32x4 __attribute__((ext_vector_type(4)));
typedef unsigned u32x2 __attribute__((ext_vector_type(2)));
typedef __bf16 bf16x2_t __attribute__((ext_vector_type(2)));

constexpr int BATCH = 4, SEQ = 2048, DM = 2048, NH = 16, HD = 128, MTOK = BATCH * SEQ;
constexpr int FF = 5632, NUP = 2 * FF, NQKV = 3 * DM;
constexpr int KVH = 4, NIN = 5264, NINP = 5376;
constexpr int TOPK = 256;
constexpr float NORM_EPS = 1e-6f;
constexpr float LOG2E = 1.4426950408889634f;
constexpr float QSCALE = 0.08838834764831845f * LOG2E;

constexpr size_t MiB = 1u << 20;
constexpr size_t WS_WQKV = 0, WS_WO0 = 24 * MiB, WS_WIN = 32 * MiB, WS_WO1 = 53 * MiB, WS_WUP = 61 * MiB  , WS_WDN = 149 * MiB  ;
constexpr size_t WS_GAIN = 197 * MiB + 512 * 1024  ;
constexpr size_t WS_ROPE = 193 * MiB  , WS_PART = 194 * MiB, WS_MASK = 195 * MiB, WS_WI = 197 * MiB, WS_KI = 198 * MiB;
constexpr size_t WS_XB = 200 * MiB;
constexpr size_t WS_SCR = 360 * MiB;
constexpr size_t WS_ACT = WS_SCR + 176 * MiB;
constexpr size_t WS_Q = WS_SCR, WS_K = WS_SCR + 32 * MiB, WS_VT = WS_SCR + 64 * MiB, WS_O = WS_SCR + 96 * MiB, WS_QI = WS_SCR + 128 * MiB, WS_KD = WS_SCR + 160 * MiB, WS_VTD = WS_SCR + 168 * MiB;
constexpr size_t WS_CTL = WS_ACT + 88 * MiB, CTL_BYTES = 65536;
constexpr size_t CTL_KMAX = 24576;
constexpr size_t WS_END = WS_CTL + CTL_BYTES;

constexpr int LDS_EPI = 131072;
constexpr int LDS_BYTES = 159744;
constexpr int LDS_MISC = LDS_BYTES - 256;
constexpr int LDS_RSTD = LDS_EPI + 8192 + 256;
constexpr int LDS_CONVW = LDS_RSTD + 8192;

static_assert(LDS_CONVW + 8192 <= LDS_MISC, "LDS map");
__device__ __forceinline__ unsigned pk2(float lo, float hi) { f32x2 v = {lo, hi}; bf16x2_t b = __builtin_convertvector(v, bf16x2_t); return __builtin_bit_cast(unsigned, b); }
__device__ __forceinline__ bf16_t f2bf(float f) { return (bf16_t)(pk2(f, 0.f) & 0xffffu); }
__device__ __forceinline__ float relu_i(float x) { const int b = __float_as_int(x); return __int_as_float(b > 0 ? b : 0); }
__device__ __forceinline__ int crow(int r, int hi) { return (r & 3) + 8 * (r >> 2) + 4 * hi; }
__device__ __forceinline__ bf16x8 pack8(const f32x16& p, int b) {
    u32x4 w; w.x = pk2(p[b], p[b + 1]); w.y = pk2(p[b + 2], p[b + 3]); w.z = pk2(p[b + 4], p[b + 5]); w.w = pk2(p[b + 6], p[b + 7]);
    return __builtin_bit_cast(bf16x8, w);
}
__device__ __forceinline__ float swap_sum16(float v) { auto rr = __builtin_amdgcn_permlane16_swap(__float_as_uint(v), __float_as_uint(v), false, false); return __uint_as_float(rr[0]) + __uint_as_float(rr[1]); }
__device__ __forceinline__ float swap_sum(float v) { auto rr = __builtin_amdgcn_permlane32_swap(__float_as_uint(v), __float_as_uint(v), false, false); return __uint_as_float(rr[0]) + __uint_as_float(rr[1]); }
__device__ __forceinline__ float swap_max(float v) { auto rr = __builtin_amdgcn_permlane32_swap(__float_as_uint(v), __float_as_uint(v), false, false); return fmaxf(__uint_as_float(rr[0]), __uint_as_float(rr[1])); }
__device__ __forceinline__ float wave_sum(float v) {
#define WS_DPP(ctrl, rmask, bc) __int_as_float(__builtin_amdgcn_update_dpp(0, __float_as_int(v), ctrl, rmask, 0xf, bc))
    v += WS_DPP(0x111, 0xf, true); v += WS_DPP(0x112, 0xf, true); v += WS_DPP(0x114, 0xf, true); v += WS_DPP(0x118, 0xf, true);
    v += WS_DPP(0x142, 0xa, false); v += WS_DPP(0x143, 0xc, false);
#undef WS_DPP
    return __int_as_float(__builtin_amdgcn_readlane(__float_as_int(v), 63));
}
__device__ __forceinline__ float row_rstd(const float* part, int row, int fq) {
    const f32x4* p = (const f32x4*)(part + (size_t)row * 32 + 8 * fq);
    const f32x4 a = p[0], b = p[1]; float s = ((a.x + a.y) + (a.z + a.w)) + ((b.x + b.y) + (b.z + b.w));
    s += __shfl_xor(s, 16); s += __shfl_xor(s, 32);
    return __builtin_amdgcn_rsqf(s * (1.0f / DM) + NORM_EPS);
}


#define XB_TMO      128
#define XB_XCNT(j)  (256  + 64 * (j))
#define XB_XSUB(j)  (1280 + 64 * (j))
#define XB_XGEN(j)  (2304 + 64 * (j))
#define XB_TOP      3328
#define XB_TOPGEN   3392
#define XCD_BAR_WORDS 3456
#define XB_SPIN_CAP (1u << 18)
__device__ __forceinline__ unsigned xb_ld(unsigned* p)              { return __hip_atomic_load(p, __ATOMIC_RELAXED, __HIP_MEMORY_SCOPE_AGENT); }
__device__ __forceinline__ unsigned xb_add(unsigned* p, unsigned v) { return __hip_atomic_fetch_add(p, v, __ATOMIC_RELAXED, __HIP_MEMORY_SCOPE_AGENT); }
__device__ __forceinline__ unsigned xb_xcc_id() { return (unsigned)__builtin_amdgcn_s_getreg((3 << 11) | 20) & 0xFu; }
#define XB_SPIN(cond, bar) do { unsigned _sp = 0; while (cond) { __builtin_amdgcn_s_sleep(1); \
    if ((++_sp & 255u) == 0u) { if (xb_ld(&(bar)[XB_TMO])) break; if (_sp > XB_SPIN_CAP) { atomicAdd(&(bar)[XB_TMO], 1u); break; } } } } while (0)
struct XcdBarrier { unsigned* bar; unsigned x; volatile LAS unsigned* st; };
__device__ __forceinline__ XcdBarrier xcd_barrier_post(unsigned* bar, volatile LAS unsigned* st) {
    XcdBarrier b; b.bar = bar; b.x = xb_xcc_id(); b.st = st;
    if (threadIdx.x == 0) (void)xb_add(&bar[XB_XCNT(b.x)], 1u);
    return b;
}
__device__ __forceinline__ void xcd_barrier_complete(unsigned* bar, unsigned x, unsigned& nloc, unsigned& nx) {
    const unsigned G = gridDim.x * gridDim.y * gridDim.z;
    unsigned sum, cnt, mine, sp = 0u;
    for (;;) {
        sum = 0u; cnt = 0u; mine = 0u;
#pragma unroll
        for (unsigned j = 0; j < 16; ++j) { const unsigned c = xb_ld(&bar[XB_XCNT(j)]); sum += c; cnt += (c > 0u) ? 1u : 0u; mine = (j == x) ? c : mine; }
        if (sum == G) break;
        __builtin_amdgcn_s_sleep(1);
        if ((++sp & 255u) == 0u) { if (xb_ld(&bar[XB_TMO])) break; if (sp > XB_SPIN_CAP) { atomicAdd(&bar[XB_TMO], 1u); break; } }
    }
    nloc = mine > 0u ? mine : 1u; nx = cnt > 0u ? cnt : 1u;
}
__device__ __forceinline__ void xcd_barrier(const XcdBarrier& b) {
    asm volatile("s_waitcnt vmcnt(0)" ::: "memory");
    __syncthreads();
    if (threadIdx.x == 0) {
        unsigned* bar = b.bar;
        __builtin_amdgcn_s_waitcnt(0);
        unsigned nloc = b.st[0], nx = b.st[1];
        if (nloc == 0u) { xcd_barrier_complete(bar, b.x, nloc, nx); b.st[0] = nloc; b.st[1] = nx; }
        const unsigned old = xb_add(&bar[XB_XSUB(b.x)], 1u);
        const unsigned gen = old / nloc;
        if (old + 1u == (gen + 1u) * nloc) {
            __builtin_amdgcn_fence(__ATOMIC_RELEASE, "agent");
            asm volatile("s_waitcnt vmcnt(0)" ::: "memory");
            const unsigned og = xb_add(&bar[XB_TOP], 1u);
            const unsigned tg = og / nx;
            if (og + 1u == (tg + 1u) * nx) xb_add(&bar[XB_TOPGEN], 1u);
            else XB_SPIN(xb_ld(&bar[XB_TOPGEN]) == tg, bar);
            __builtin_amdgcn_fence(__ATOMIC_ACQUIRE, "agent");
        } else {
            XB_SPIN(xb_ld(&bar[XB_TOPGEN]) == gen, bar);
            __builtin_amdgcn_fence(__ATOMIC_ACQUIRE, "agent");
            asm volatile("s_waitcnt vmcnt(0)" ::: "memory");
        }
    }
    __syncthreads();
}

namespace pg8 {
constexpr int BM = 256, BK = 64, HALF = 128, HTB = HALF * BK * 2, STAGE_BYTES = 8 * HTB, NXCD = 8, WGM = 2;
__host__ __device__ __forceinline__ int lds_byte(int r, int c) { const int st = (r >> 4) * 2 + (c >> 5), rr = r & 15, cc = c & 31, ob = rr * 64 + cc * 2; return st * 1024 + (ob ^ (((ob >> 9) & 1) << 5)); }
__host__ __device__ __forceinline__ void stage_rc(int b, int& R, int& C) { const int st = b / 1024, sb = b % 1024, swz = sb ^ (((sb >> 9) & 1) << 5); R = (st >> 1) * 16 + swz / 64; C = (st & 1) * 32 + (swz % 64) / 2; }
__host__ __device__ __forceinline__ int perm32(int rho) { const int n = rho >> 4, i = rho & 15; return 8 * (i >> 2) + 4 * n + (i & 3); }
struct Unit { int pm, pn; };
struct Gemm { const bf16_t* A; const bf16_t* Bt; int M, N, K; int a_rows = 256, a_row0 = 0; };
struct StaticOrder {
    int nM, nN, nwg, G, c;
    __host__ __device__ void init(int M, int N, int G_, int c_) { nM = M / BM; nN = N / BM; nwg = nM * nN; G = G_; c = c_; }
    __host__ __device__ void init_tiles(int nM_, int nN_, int G_, int c_) { nM = nM_; nN = nN_; nwg = nM * nN; G = G_; c = c_; }
    __host__ __device__ bool next(int i, Unit& u) const {
        const long L = (long)i * G + c; if (L >= nwg) return false;
        int wgid = (int)L; { const int q = nwg / NXCD, r = nwg % NXCD, xcd = wgid % NXCD, off = wgid / NXCD; wgid = (xcd < r ? xcd * (q + 1) : r * (q + 1) + (xcd - r) * q) + off; }
        const int nig = WGM * nN, gid = wgid / nig, fm = gid * WGM, gsz = (nM - fm) < WGM ? (nM - fm) : WGM;
        u.pm = fm + ((wgid % nig) % gsz); u.pn = (wgid % nig) / gsz; return true;
    }
};
template <class Epi, class Sched, bool ALIGN_EPI, bool SP2>
__device__ __forceinline__ void gemm_phase(LAS unsigned char* lds, const Gemm g, const Sched& S, const Epi& E) {
    const int tid = threadIdx.x, wid = __builtin_amdgcn_readfirstlane(tid >> 6), lane = tid & 63, wr = wid >> 2, wc = wid & 3, fr = lane & 15, fq = lane >> 4;
    const int K = g.K, nt = K / BK;
    unsigned voffA[2], voffB[2];
#pragma unroll
    for (int i = 0; i < 2; ++i) { int R, C; stage_rc(tid * 16 + i * 8192, R, C); const int Rb = Epi::PERM ? ((R & ~31) + perm32(R & 31)) : R;
        voffA[i] = (unsigned)(R * K + C) * 2u; voffB[i] = (unsigned)(Rb * K + C) * 2u; }
    const size_t kstep = (size_t)(BK * 2);
    const size_t hstep = (size_t)HALF * K * 2;
    const size_t tstep = 2 * hstep;
    const unsigned ldsw = (unsigned)wid * 1024u;
    const int aoff = lds_byte(wr * 64 + fr, fq * 8), boff = lds_byte(wc * 32 + fr, fq * 8);
#define PG8_SA(b, h) (((b) * 2 + (h)) * HTB)
#define PG8_SB(b, h) ((4 + (b) * 2 + (h)) * HTB)
#define PG8_STAGE(bufoff, gbase, voff) do { _Pragma("unroll") for (int _i = 0; _i < 2; ++_i) \
        __builtin_amdgcn_global_load_lds((const unsigned*)((const char*)(gbase) + (voff)[_i]), (LAS unsigned*)(lds + (bufoff) + ldsw + _i * 8192), 16, 0, 0); } while (0)
#define PG8_LDA(dst, b, h) do { _Pragma("unroll") for (int m = 0; m < 4; ++m) _Pragma("unroll") for (int k = 0; k < 2; ++k) dst[m][k] = *(const LAS bf16x8*)(lds + PG8_SA(b, h) + aoff + m * 2048 + k * 1024); } while (0)
#define PG8_LDB(dst, b, h) do { _Pragma("unroll") for (int n = 0; n < 2; ++n) _Pragma("unroll") for (int k = 0; k < 2; ++k) dst[n][k] = *(const LAS bf16x8*)(lds + PG8_SB(b, h) + boff + n * 2048 + k * 1024); } while (0)
#define PG8_MMA(ai, bj, At, Bt) do { __builtin_amdgcn_s_setprio(1); _Pragma("unroll") for (int m = 0; m < 4; ++m) _Pragma("unroll") for (int n = 0; n < 2; ++n) _Pragma("unroll") for (int k = 0; k < 2; ++k) \
        acc[ai][bj][m][n] = __builtin_amdgcn_mfma_f32_16x16x32_bf16(Bt[n][k], At[m][k], acc[ai][bj][m][n], 0, 0, 0); __builtin_amdgcn_s_setprio(0); } while (0)
#define PG8_WAIT_V(n) asm volatile("s_waitcnt vmcnt(" #n ")" ::: "memory")
#define PG8_WAIT_L(n) asm volatile("s_waitcnt lgkmcnt(" #n ")" ::: "memory")
#define PG8_BAR __builtin_amdgcn_s_barrier()
#define PG8_SCHED __builtin_amdgcn_sched_barrier(0)
    Unit cur, nxt; int ui = 0;
    if (!S.next(0, cur)) return;
    E.prefetch(cur, 0, tid, wid);
    f32x4 acc[2][2][4][2];
#pragma unroll
    for (int a = 0; a < 2; ++a)
#pragma unroll
        for (int b = 0; b < 2; ++b)
#pragma unroll
            for (int m = 0; m < 4; ++m)
#pragma unroll
                for (int n = 0; n < 2; ++n) acc[a][b][m][n] = (f32x4){0.f, 0.f, 0.f, 0.f};
    bf16x8 At[4][2], B0[2][2], B1[2][2];
    const long atstep = (long)g.a_rows * K * 2, aorg = (long)g.a_row0 * K * 2;
    const char* cA = (const char*)g.A + aorg + (long)cur.pm * atstep; const char* cB = (const char*)g.Bt + (size_t)cur.pn * tstep;
    if constexpr (SP2) {
        PG8_STAGE(PG8_SB(0, 0), cB, voffB); PG8_STAGE(PG8_SB(0, 1), cB + hstep, voffB); PG8_STAGE(PG8_SA(0, 0), cA, voffA); PG8_STAGE(PG8_SA(0, 1), cA + hstep, voffA);
        if (wr == 1) PG8_BAR;
        PG8_WAIT_V(2); PG8_BAR;
        PG8_STAGE(PG8_SB(1, 0), cB + kstep, voffB); PG8_STAGE(PG8_SA(1, 0), cA + kstep, voffA); PG8_STAGE(PG8_SB(1, 1), cB + hstep + kstep, voffB);
        PG8_WAIT_V(6); PG8_BAR;
    } else {
        PG8_STAGE(PG8_SB(0, 0), cB, voffB); PG8_STAGE(PG8_SA(0, 0), cA, voffA); PG8_STAGE(PG8_SB(0, 1), cB + hstep, voffB); PG8_STAGE(PG8_SA(0, 1), cA + hstep, voffA);
        if (wr == 1) PG8_BAR;
        PG8_WAIT_V(4); PG8_BAR;
        PG8_STAGE(PG8_SB(1, 0), cB + kstep, voffB); PG8_STAGE(PG8_SA(1, 0), cA + kstep, voffA); PG8_STAGE(PG8_SB(1, 1), cB + hstep + kstep, voffB);
        PG8_WAIT_V(6); PG8_BAR;
    }
    for (;;) {
        const bool has_next = S.next(ui + 1, nxt);
        const char* nA = has_next ? (const char*)g.A + aorg + (long)nxt.pm * atstep : cA; const char* nB = has_next ? (const char*)g.Bt + (size_t)nxt.pn * tstep : cB;
        for (int t = 0; t < nt; t += 2) {
            const bool last = (t == nt - 2);
            const char* a1 = cA + (size_t)(t + 1) * kstep;
            const char* a2 = last ? nA : cA + (size_t)(t + 2) * kstep; const char* b2 = last ? nB : cB + (size_t)(t + 2) * kstep;
            const char* a3 = a2 + kstep; const char* b3 = b2 + kstep;
            if constexpr (SP2) {
            PG8_LDB(B0, 0, 0); PG8_LDB(B1, 0, 1); PG8_SCHED; PG8_LDA(At, 0, 0); PG8_STAGE(PG8_SA(1, 1), a1 + hstep, voffA);
            PG8_WAIT_V(8); PG8_WAIT_L(0); PG8_BAR; PG8_MMA(0, 0, At, B0); PG8_MMA(0, 1, At, B1); PG8_BAR; PG8_SCHED;
            PG8_LDA(At, 0, 1); PG8_STAGE(PG8_SB(0, 0), b2, voffB); PG8_STAGE(PG8_SB(0, 1), b2 + hstep, voffB); PG8_STAGE(PG8_SA(0, 0), a2, voffA);
            PG8_WAIT_V(8); PG8_WAIT_L(0); PG8_BAR; PG8_MMA(1, 0, At, B0); PG8_MMA(1, 1, At, B1); PG8_BAR; PG8_SCHED;
            PG8_LDB(B0, 1, 0); PG8_LDB(B1, 1, 1); PG8_SCHED; PG8_LDA(At, 1, 0); PG8_STAGE(PG8_SA(0, 1), a2 + hstep, voffA);
            PG8_WAIT_V(8); PG8_WAIT_L(0); PG8_BAR; PG8_MMA(0, 0, At, B0); PG8_MMA(0, 1, At, B1); PG8_BAR; PG8_SCHED;
            PG8_LDA(At, 1, 1); PG8_STAGE(PG8_SB(1, 0), b3, voffB); PG8_STAGE(PG8_SB(1, 1), b3 + hstep, voffB); PG8_STAGE(PG8_SA(1, 0), a3, voffA);
            PG8_WAIT_V(8); PG8_WAIT_L(0); PG8_BAR; PG8_MMA(1, 0, At, B0); PG8_MMA(1, 1, At, B1); PG8_BAR; PG8_SCHED;
            } else {
            PG8_LDB(B0, 0, 0); PG8_SCHED; PG8_LDA(At, 0, 0); PG8_STAGE(PG8_SA(1, 1), a1 + hstep, voffA);
            PG8_WAIT_L(8); PG8_BAR; PG8_WAIT_L(0); PG8_MMA(0, 0, At, B0); PG8_BAR; PG8_SCHED;
            PG8_LDB(B1, 0, 1); PG8_STAGE(PG8_SB(0, 0), b2, voffB);
            PG8_BAR; PG8_WAIT_L(0); PG8_MMA(0, 1, At, B1); PG8_BAR;
            PG8_LDA(At, 0, 1); PG8_STAGE(PG8_SA(0, 0), a2, voffA);
            PG8_BAR; PG8_WAIT_L(0); PG8_MMA(1, 0, At, B0); PG8_BAR; PG8_SCHED;
            PG8_STAGE(PG8_SB(0, 1), b2 + hstep, voffB);
            PG8_WAIT_V(6); PG8_BAR; PG8_MMA(1, 1, At, B1); PG8_BAR;
            PG8_LDB(B0, 1, 0); PG8_SCHED; PG8_LDA(At, 1, 0); PG8_STAGE(PG8_SA(0, 1), a2 + hstep, voffA);
            PG8_WAIT_L(8); PG8_BAR; PG8_WAIT_L(0); PG8_MMA(0, 0, At, B0); PG8_BAR; PG8_SCHED;
            PG8_LDB(B1, 1, 1); PG8_STAGE(PG8_SB(1, 0), b3, voffB);
            PG8_BAR; PG8_WAIT_L(0); PG8_MMA(0, 1, At, B1); PG8_BAR;
            PG8_LDA(At, 1, 1); PG8_STAGE(PG8_SA(1, 0), a3, voffA);
            PG8_BAR; PG8_WAIT_L(0); PG8_MMA(1, 0, At, B0); PG8_BAR; PG8_SCHED;
            PG8_STAGE(PG8_SB(1, 1), b3 + hstep, voffB);
            PG8_WAIT_V(6); PG8_BAR; PG8_MMA(1, 1, At, B1); PG8_BAR;
            }
        }
        if constexpr (ALIGN_EPI) { if (wr == 0) PG8_BAR; }
        { int fr_ = fr, fq_ = fq; asm volatile("" : "+v"(fr_), "+v"(fq_)); E(acc, cur, wr, wc, fr_, fq_, ui); if (has_next) E.prefetch(nxt, ui + 1, (wr * 4 + wc) * 64 + fq_ * 16 + fr_, wr * 4 + wc); }
        if (!has_next) break;
#pragma unroll
        for (int a = 0; a < 2; ++a)
#pragma unroll
            for (int b = 0; b < 2; ++b)
#pragma unroll
                for (int m = 0; m < 4; ++m)
#pragma unroll
                    for (int n = 0; n < 2; ++n) acc[a][b][m][n] = (f32x4){0.f, 0.f, 0.f, 0.f};
        cur = nxt; cA = nA; cB = nB; ++ui;
        if constexpr (ALIGN_EPI) { if (wr == 1) PG8_BAR; }
    }
    PG8_WAIT_V(0);
    if constexpr (!ALIGN_EPI) { if (wr == 0) PG8_BAR; }
    PG8_BAR;
#undef PG8_SA
#undef PG8_SB
#undef PG8_STAGE
#undef PG8_LDA
#undef PG8_LDB
#undef PG8_MMA
#undef PG8_WAIT_V
#undef PG8_WAIT_L
#undef PG8_BAR
#undef PG8_SCHED
}
}
using pg8::Unit;
typedef f32x4 AccT[2][2][4][2];


template <class Sched>
__device__ __forceinline__ void rstd_table_build(LAS unsigned char* lds, const float* part, const Sched& S, int a_rows, int a_row0, int tid) {
    LAS float* tab = (LAS float*)(lds + LDS_RSTD);
    for (int i0 = 0; i0 < 8; i0 += 2) {
        pg8::Unit u; const int i = i0 + (tid >> 8);
        if (S.next(i, u)) {
            int row = a_rows * u.pm + a_row0 + (tid & 255); row = row < 0 ? 0 : (row >= MTOK ? MTOK - 1 : row);
            const f32x4* p = (const f32x4*)(part + (size_t)row * 32);
            f32x4 acc4 = p[0];
#pragma unroll
            for (int k = 1; k < 8; ++k) acc4 += p[k];
            tab[i * 256 + (tid & 255)] = __builtin_amdgcn_rsqf(((acc4.x + acc4.y) + (acc4.z + acc4.w)) * (1.0f / DM) + NORM_EPS);
        }
    }
    asm volatile("s_waitcnt lgkmcnt(0)" ::: "memory"); __syncthreads();
}
struct EpiQKV {
    static constexpr bool PERM = true;
    unsigned char* ws; const LAS float* rtab;
    __device__ __forceinline__ void prefetch(const Unit&, int, int, int) const {}
    __device__ __forceinline__ void operator()(const AccT& acc, const Unit& u, int wr, int wc, int fr, int fq, int ui) const {
        const int row0 = u.pm * 256 + wr * 64 + fr, kind = u.pn >> 3, colt = (u.pn & 7) * 256 + wc * 32 + 8 * fq;
        float rs[2][4];
#pragma unroll
        for (int ai = 0; ai < 2; ++ai)
#pragma unroll
            for (int m = 0; m < 4; ++m) rs[ai][m] = rtab[ui * 256 + ai * 128 + wr * 64 + m * 16 + fr];
        if (kind < 2) {
            float km[2] = {0.f, 0.f};
#pragma unroll
            for (int ai = 0; ai < 2; ++ai)
#pragma unroll
                for (int m = 0; m < 4; ++m)
#pragma unroll
                    for (int bj = 0; bj < 2; ++bj) { const f32x4 v0 = acc[ai][bj][m][0], v1 = acc[ai][bj][m][1];
                        float ss = ((v0[0] * v0[0] + v0[1] * v0[1]) + (v0[2] * v0[2] + v0[3] * v0[3])) + ((v1[0] * v1[0] + v1[1] * v1[1]) + (v1[2] * v1[2] + v1[3] * v1[3]));
                        ss = swap_sum(ss);
                        ss = swap_sum16(ss);
                        km[bj] = fmaxf(km[bj], ss * rs[ai][m] * rs[ai][m]); }
#pragma unroll
            for (int bj = 0; bj < 2; ++bj) { float v = km[bj];
#pragma unroll
                for (int o = 8; o >= 1; o >>= 1) v = fmaxf(v, __int_as_float(o == 8 ? __builtin_amdgcn_update_dpp(0, __float_as_int(v), 0x128, 0xf, 0xf, false) : o == 4 ? __builtin_amdgcn_update_dpp(0, __float_as_int(v), 0x124, 0xf, 0xf, false)
                                                                            : o == 2 ? __builtin_amdgcn_update_dpp(0, __float_as_int(v), 0x122, 0xf, 0xf, false) : __builtin_amdgcn_update_dpp(0, __float_as_int(v), 0x121, 0xf, 0xf, false)));
                if (fr == 0 && fq == 0) __hip_atomic_fetch_max((unsigned*)(ws + WS_CTL + CTL_KMAX) + (((kind * BATCH + ((u.pm * 256) >> 11)) * NH + (u.pn & 7) * 2 + bj) * 4 + wc), __float_as_uint(v), __ATOMIC_RELAXED, __HIP_MEMORY_SCOPE_AGENT); }
        }
        if (kind == 0) {
            bf16_t* base = (bf16_t*)(ws + WS_Q);
#pragma unroll
            for (int ai = 0; ai < 2; ++ai)
#pragma unroll
                for (int m = 0; m < 4; ++m) { bf16_t* rowp = base + (size_t)(row0 + ai * 128 + m * 16) * DM + colt;
#pragma unroll
                    for (int bj = 0; bj < 2; ++bj) { const float qs = QSCALE * rs[ai][m]; const f32x4 v0 = acc[ai][bj][m][0] * qs, v1 = acc[ai][bj][m][1] * qs;
                        u32x4 w; w.x = pk2(v0[0], v0[1]); w.y = pk2(v0[2], v0[3]); w.z = pk2(v1[0], v1[1]); w.w = pk2(v1[2], v1[3]);
                        *(u32x4*)(rowp + bj * 128) = w; } }
        } else if (kind == 1) {
            bf16_t* KF = (bf16_t*)(ws + WS_K);
#pragma unroll
            for (int ai = 0; ai < 2; ++ai)
#pragma unroll
                for (int m = 0; m < 4; ++m) { const int row = row0 + ai * 128 + m * 16, b = row >> 11, st = row & 2047;
#pragma unroll
                    for (int bj = 0; bj < 2; ++bj) { const int c0 = colt + bj * 128, h = c0 >> 7, d0 = c0 & 127;
                        const size_t idx = ((((size_t)(b * NH + h) * 64 + (st >> 5)) * 8 + (d0 >> 4)) * 64 + (st & 31) + 32 * ((d0 >> 3) & 1)) * 8;
                        const f32x4 v0 = acc[ai][bj][m][0] * rs[ai][m], v1 = acc[ai][bj][m][1] * rs[ai][m];
                        u32x4 w; w.x = pk2(v0[0], v0[1]); w.y = pk2(v0[2], v0[3]); w.z = pk2(v1[0], v1[1]); w.w = pk2(v1[2], v1[3]);
                        *(u32x4*)(KF + idx) = w; } }
        } else {
            bf16_t* VF = (bf16_t*)(ws + WS_VT);
#pragma unroll
            for (int ai = 0; ai < 2; ++ai)
#pragma unroll
                for (int m = 0; m < 4; ++m) { const int row = row0 + ai * 128 + m * 16, b = row >> 11, st = row & 2047, k32 = st & 31, kk = k32 & 15;
                    const int slot = 4 * (kk >> 3) + (kk & 3), lhi = 32 * ((kk >> 2) & 1), s2 = k32 >> 4;
#pragma unroll
                    for (int bj = 0; bj < 2; ++bj) { const int c0 = colt + bj * 128, h = c0 >> 7, d0 = c0 & 127;
                        bf16_t* p = VF + (((((size_t)(b * NH + h) * 64 + (st >> 5)) * 4 + (d0 >> 5)) * 2 + s2) * 64 + (d0 & 31) + lhi) * 8 + slot;
#pragma unroll
                        for (int n = 0; n < 2; ++n)
#pragma unroll
                            for (int j = 0; j < 4; ++j) p[(4 * n + j) * 8] = f2bf(acc[ai][bj][m][n][j] * rs[ai][m]); } }
        }
    }
};
template <bool RES_F32, bool OUT_F32>
struct EpiRes {
    static constexpr bool PERM = true;
    const void* res; void* out; float* part;
    __device__ __forceinline__ void prefetch(const Unit&, int, int, int) const {}
    __device__ __forceinline__ void operator()(const AccT& acc, const Unit& u, int wr, int wc, int fr, int fq, int) const {
        const int row0 = u.pm * 256 + wr * 64 + fr, col0 = u.pn * 256 + wc * 32 + 8 * fq;
        constexpr int NB = RES_F32 ? 4 : 8;
        f32x4 rf[RES_F32 ? 4 : 1][4]; u32x4 rh[RES_F32 ? 1 : 8][2];
#pragma unroll
        for (int g0 = 0; g0 < 8; g0 += NB) {
#pragma unroll
            for (int gi = 0; gi < NB; ++gi) { const int g = g0 + gi; const size_t off_ = (size_t)(row0 + (g >> 2) * 128 + (g & 3) * 16) * DM + col0;
                if (RES_F32) { const float* r_ = (const float*)res; rf[gi][0] = *(const f32x4*)(r_ + off_); rf[gi][1] = *(const f32x4*)(r_ + off_ + 4); rf[gi][2] = *(const f32x4*)(r_ + off_ + 128); rf[gi][3] = *(const f32x4*)(r_ + off_ + 132); }
                else { const bf16_t* r_ = (const bf16_t*)res; rh[gi][0] = *(const u32x4*)(r_ + off_); rh[gi][1] = *(const u32x4*)(r_ + off_ + 128); } }
#pragma unroll
            for (int gi = 0; gi < NB; ++gi) {
                const int g = g0 + gi, ai = g >> 2, m = g & 3;
                const int row = row0 + ai * 128 + m * 16; const size_t off = (size_t)row * DM + col0; float ss = 0.f;
#pragma unroll
                for (int bj = 0; bj < 2; ++bj) {
                    f32x4 r0, r1;
                    if (RES_F32) { r0 = rf[gi][2 * bj]; r1 = rf[gi][2 * bj + 1]; }
                    else { const u32x4 h = rh[gi][bj];
                        r0 = (f32x4){__uint_as_float(h.x << 16), __uint_as_float(h.x & 0xffff0000u), __uint_as_float(h.y << 16), __uint_as_float(h.y & 0xffff0000u)};
                        r1 = (f32x4){__uint_as_float(h.z << 16), __uint_as_float(h.z & 0xffff0000u), __uint_as_float(h.w << 16), __uint_as_float(h.w & 0xffff0000u)}; }
                    const f32x4 v0 = acc[ai][bj][m][0] + r0, v1 = acc[ai][bj][m][1] + r1;
                    if (OUT_F32) { float* o_ = (float*)out; *(f32x4*)(o_ + off + bj * 128) = v0; *(f32x4*)(o_ + off + bj * 128 + 4) = v1; }
                    else { bf16_t* o_ = (bf16_t*)out; u32x4 w; w.x = pk2(v0[0], v0[1]); w.y = pk2(v0[2], v0[3]); w.z = pk2(v1[0], v1[1]); w.w = pk2(v1[2], v1[3]); *(u32x4*)(o_ + off + bj * 128) = w; }
                    ss += (v0[0] * v0[0] + v0[1] * v0[1]) + (v0[2] * v0[2] + v0[3] * v0[3]) + (v1[0] * v1[0] + v1[1] * v1[1]) + (v1[2] * v1[2] + v1[3] * v1[3]); }
                if (part) { ss = swap_sum16(ss); ss = swap_sum(ss); if (fq == 0) part[(size_t)row * 32 + u.pn * 4 + wc] = ss; }
            }
        }
    }
};
#define CONV_DPP4(C, X, W, CTRL) asm volatile("s_nop 1\n\t" \
        "v_fmac_f32_dpp %0, %4, %8 " CTRL " row_mask:0xf bank_mask:0xf bound_ctrl:1\n\t" \
        "v_fmac_f32_dpp %1, %5, %9 " CTRL " row_mask:0xf bank_mask:0xf bound_ctrl:1\n\t" \
        "v_fmac_f32_dpp %2, %6, %10 " CTRL " row_mask:0xf bank_mask:0xf bound_ctrl:1\n\t" \
        "v_fmac_f32_dpp %3, %7, %11 " CTRL " row_mask:0xf bank_mask:0xf bound_ctrl:1" \
        : "+v"(C[0]), "+v"(C[1]), "+v"(C[2]), "+v"(C[3]) : "v"(X[0]), "v"(X[1]), "v"(X[2]), "v"(X[3]), "v"(W[0]), "v"(W[1]), "v"(W[2]), "v"(W[3]))
#define CONV_DPP8(C, X, WA, CTRLA, WB, CTRLB) asm volatile("s_nop 1\n\t" \
        "v_fmac_f32_dpp %0, %4, %8 " CTRLA " row_mask:0xf bank_mask:0xf bound_ctrl:1\n\t" \
        "v_fmac_f32_dpp %1, %5, %9 " CTRLA " row_mask:0xf bank_mask:0xf bound_ctrl:1\n\t" \
        "v_fmac_f32_dpp %2, %6, %10 " CTRLA " row_mask:0xf bank_mask:0xf bound_ctrl:1\n\t" \
        "v_fmac_f32_dpp %3, %7, %11 " CTRLA " row_mask:0xf bank_mask:0xf bound_ctrl:1\n\t" \
        "v_fmac_f32_dpp %0, %4, %12 " CTRLB " row_mask:0xf bank_mask:0xf bound_ctrl:1\n\t" \
        "v_fmac_f32_dpp %1, %5, %13 " CTRLB " row_mask:0xf bank_mask:0xf bound_ctrl:1\n\t" \
        "v_fmac_f32_dpp %2, %6, %14 " CTRLB " row_mask:0xf bank_mask:0xf bound_ctrl:1\n\t" \
        "v_fmac_f32_dpp %3, %7, %15 " CTRLB " row_mask:0xf bank_mask:0xf bound_ctrl:1" \
        : "+v"(C[0]), "+v"(C[1]), "+v"(C[2]), "+v"(C[3]) : "v"(X[0]), "v"(X[1]), "v"(X[2]), "v"(X[3]), "v"(WA[0]), "v"(WA[1]), "v"(WA[2]), "v"(WA[3]), "v"(WB[0]), "v"(WB[1]), "v"(WB[2]), "v"(WB[3]))
struct EpiUpConv {
    static constexpr bool PERM = true;
    bf16_t* ACT; const float* cw; const float* cb; LAS float* hal; const LAS float* rtab;
    __device__ __forceinline__ void prefetch(const Unit& u, int ui, int tid, int wid) const {
        if (wid < 4) { const int q = tid >> 5, bj = q >> 2, t = q & 3, col = 4 * (tid & 31);
            const float* src = (t < 3 ? cw + (size_t)t * NUP : cb) + bj * FF + u.pn * 128 + col;
            __builtin_amdgcn_global_load_lds((const unsigned*)src, (LAS unsigned*)((LAS unsigned char*)rtab + 8192 + (ui & 1) * 4096 + wid * 1024), 16, 0, 0); }
    }
    __device__ __forceinline__ void operator()(AccT& acc, const Unit& u, int wr, int wc, int fr, int fq, int ui) const {
#pragma unroll
        for (int ai = 0; ai < 2; ++ai)
#pragma unroll
            for (int m = 0; m < 4; ++m) { const float rs = rtab[ui * 256 + ai * 128 + wr * 64 + m * 16 + fr];
#pragma unroll
                for (int bj = 0; bj < 2; ++bj) { acc[ai][bj][m][0] *= rs; acc[ai][bj][m][1] *= rs; } }
        const int colw = wc * 32 + 8 * fq;
        if (fr >= 14) {
#pragma unroll
            for (int ai = 0; ai < 2; ++ai)
#pragma unroll
                for (int bj = 0; bj < 2; ++bj)
#pragma unroll
                    for (int n = 0; n < 2; ++n) *(LAS f32x4*)(hal + ((ai * 2 + wr) * 2 + (fr - 14)) * 256 + bj * 128 + colw + 4 * n) = acc[ai][bj][3][n];
        }
        asm volatile("s_waitcnt lgkmcnt(0)" ::: "memory"); __builtin_amdgcn_s_barrier(); asm volatile("" ::: "memory");
        const int r_lo = 254 * u.pm - 2, r_first = r_lo < 0 ? 0 : r_lo, r_hi = r_lo + 255;
        const bool has_bnd = ((r_first & 2047) <= 1) || ((r_hi >> 11) != (r_first >> 11));
        u32x2 pk0[2][4];
#pragma unroll
        for (int n = 0; n < 2; ++n) {
            const int ch = u.pn * 128 + colw + 4 * n;
            f32x4 w[2][3], bb[2];
            { const LAS float* wl = (const LAS float*)((const LAS unsigned char*)rtab + 8192 + (ui & 1) * 4096) + colw + 4 * n;
#pragma unroll
                for (int bj = 0; bj < 2; ++bj) { bb[bj] = *(const LAS f32x4*)(wl + (bj * 4 + 3) * 128);
#pragma unroll
                    for (int t = 0; t < 3; ++t) w[bj][t] = *(const LAS f32x4*)(wl + (bj * 4 + t) * 128); } }
#pragma unroll
            for (int ai = 0; ai < 2; ++ai)
#pragma unroll
                for (int m = 0; m < 4; ++m) {
                    const int lrow = ai * 128 + wr * 64 + m * 16 + fr, grow = 254 * u.pm - 2 + lrow;
                    f32x4 cv[2];
#pragma unroll
                    for (int bj = 0; bj < 2; ++bj) {
                        f32x4 w0 = w[bj][0], w1 = w[bj][1];
                        if (has_bnd) { const int pos = grow & 2047; if (pos < 2) w0 = (f32x4){0.f, 0.f, 0.f, 0.f}; if (pos < 1) w1 = (f32x4){0.f, 0.f, 0.f, 0.f}; }
                        const f32x4 cur = acc[ai][bj][m][n];
                        f32x4 c = bb[bj] + w[bj][2] * cur;
                        CONV_DPP8(c, cur, w1, "row_shr:1", w0, "row_shr:2");
                        if (m > 0) { const f32x4 pv = acc[ai][bj][m - 1][n]; CONV_DPP8(c, pv, w1, "row_shl:15", w0, "row_shl:14"); }
                        else { const int slab = ai * 2 + wr - 1;
                            if (slab >= 0) { const f32x4 h1 = *(const LAS f32x4*)(hal + (slab * 2 + 1) * 256 + bj * 128 + colw + 4 * n), h2 = *(const LAS f32x4*)(hal + (slab * 2) * 256 + bj * 128 + colw + 4 * n);
                                if (fr == 0) c += w1 * h1 + w0 * h2; else if (fr == 1) c += w0 * h1; } }
                        cv[bj] = c;
                    }
                    float a4[4];
#pragma unroll
                    for (int e = 0; e < 4; ++e) { const float gx = cv[0][e]; a4[e] = gx * __builtin_amdgcn_rcpf(1.0f + __expf(-gx)) * cv[1][e]; }
                    if (n == 0) { pk0[ai][m].x = pk2(a4[0], a4[1]); pk0[ai][m].y = pk2(a4[2], a4[3]); }
                    else if (lrow >= 2 && grow < MTOK) { u32x4 o; o.x = pk0[ai][m].x; o.y = pk0[ai][m].y; o.z = pk2(a4[0], a4[1]); o.w = pk2(a4[2], a4[3]); *(u32x4*)(ACT + (size_t)grow * FF + ch - 4) = o; }
                }
        }
    }
};
struct EpiDsaIn {
    static constexpr bool PERM = false;
    unsigned char* ws; LAS float* scr; const LAS float* rtab;
    __device__ __forceinline__ void prefetch(const Unit&, int, int, int) const {}
    __device__ __forceinline__ void operator()(const AccT& acc_in, const Unit& u, int wr, int wc, int fr, int fq, int ui) const {
        const int row0 = u.pm * 256 + wr * 64 + fr;
        const float* ropeC = (const float*)(ws + WS_ROPE); const float* ropeS = ropeC + SEQ * 64;
        bf16_t* VTD = (bf16_t*)(ws + WS_VTD); float* WI = (float*)(ws + WS_WI);
        const bool need_norm = (u.pn < 10) || (u.pn == 20);
        float rs[2][4];
#pragma unroll
        for (int ai = 0; ai < 2; ++ai)
#pragma unroll
            for (int m = 0; m < 4; ++m) rs[ai][m] = rtab[ui * 256 + ai * 128 + wr * 64 + m * 16 + fr];
        if (need_norm) {
#pragma unroll
            for (int ai = 0; ai < 2; ++ai)
#pragma unroll
                for (int m = 0; m < 4; ++m)
#pragma unroll
                    for (int bj = 0; bj < 2; ++bj) { const f32x4 a = acc_in[ai][bj][m][0], b = acc_in[ai][bj][m][1];
                        float ss = ((a[0] * a[0] + a[1] * a[1]) + (a[2] * a[2] + a[3] * a[3])) + ((b[0] * b[0] + b[1] * b[1]) + (b[2] * b[2] + b[3] * b[3]));
                        ss = swap_sum16(ss); ss = swap_sum(ss);
                        if (fq == 0) scr[(ai * 128 + wr * 64 + m * 16 + fr) * 8 + bj * 4 + wc] = ss * rs[ai][m] * rs[ai][m]; }
            asm volatile("s_waitcnt lgkmcnt(0)" ::: "memory"); __builtin_amdgcn_s_barrier(); asm volatile("" ::: "memory");
        }
        const int dl = 16 * wc + 8 * (fq & 1) + 4 * (fq >> 1);
#pragma unroll
        for (int bj = 0; bj < 2; ++bj) {
            const int hh = 2 * u.pn + bj;
            if (hh >= 20 && hh < 24) {
#pragma unroll
                for (int ai = 0; ai < 2; ++ai)
#pragma unroll
                    for (int m = 0; m < 4; ++m) { const int row = row0 + ai * 128 + m * 16, b = row >> 11, s0 = row & 2047, s = (s0 & ~12) | ((s0 & 4) << 1) | ((s0 & 8) >> 1); const float r = rs[ai][m];
                        bf16_t* p = VTD + ((size_t)(b * KVH + (hh - 20)) * HD + dl) * SEQ + s;
#pragma unroll
                        for (int n = 0; n < 2; ++n)
#pragma unroll
                            for (int e = 0; e < 4; ++e) p[(size_t)(64 * n + e) * SEQ] = f2bf(acc_in[ai][bj][m][n][e] * r); }
            } else if (hh == 41) {
                if (wc == 0) {
#pragma unroll
                    for (int ai = 0; ai < 2; ++ai)
#pragma unroll
                        for (int m = 0; m < 4; ++m) { const int row = row0 + ai * 128 + m * 16; *(f32x4*)(WI + (size_t)row * 16 + dl) = acc_in[ai][bj][m][0] * rs[ai][m]; } }
            } else {
                const bool norm = (hh < 20) || (hh == 40);
                const float* g = (const float*)(ws + WS_GAIN) + (hh < 16 ? 0 : (hh < 20 ? 128 : 256));
                f32x4 g0 = (f32x4){1.f, 1.f, 1.f, 1.f}, g1 = g0;
                if (norm) { g0 = *(const f32x4*)(g + dl); g1 = *(const f32x4*)(g + dl + 64); }
                size_t boff; int ld, cbo;
                if (hh < 16) { boff = WS_Q; ld = DM; cbo = hh * HD; } else if (hh < 20) { boff = WS_KD; ld = KVH * HD; cbo = (hh - 16) * HD; }
                else if (hh < 40) { boff = WS_QI; ld = DM; cbo = (hh - 24) * HD; } else { boff = WS_KI; ld = HD; cbo = 0; }
                bf16_t* base = (bf16_t*)(ws + boff);
                const float osc = hh < 16 ? QSCALE : 1.0f;
                const int pos0 = row0 & 2047;
                const f32x4 c16 = *(const f32x4*)(ropeC + 16 * 64 + dl), s16 = *(const f32x4*)(ropeS + 16 * 64 + dl);
                f32x4 cb[2], sb[2];
#pragma unroll
                for (int ai = 0; ai < 2; ++ai) { cb[ai] = *(const f32x4*)(ropeC + (pos0 + ai * 128) * 64 + dl); sb[ai] = *(const f32x4*)(ropeS + (pos0 + ai * 128) * 64 + dl); }
#pragma unroll
                for (int ai = 0; ai < 2; ++ai) {
                    f32x4 c = cb[ai], sn = sb[ai];
#pragma unroll
                    for (int m = 0; m < 4; ++m) { const int lrow = ai * 128 + wr * 64 + m * 16 + fr, row = u.pm * 256 + lrow;
                        if (m > 0) { const f32x4 c2 = c * c16 - sn * s16; sn = sn * c16 + c * s16; c = c2; }
                        float sc = rs[ai][m];
                        if (norm) { const f32x4 t = *(const LAS f32x4*)(scr + lrow * 8 + bj * 4); sc *= __builtin_amdgcn_rsqf(((t[0] + t[1]) + (t[2] + t[3])) * (1.0f / HD) + NORM_EPS); }
                        sc *= osc;
                        const f32x4 y0 = acc_in[ai][bj][m][0] * g0 * sc, y1 = acc_in[ai][bj][m][1] * g1 * sc;
                        const f32x4 o0 = y0 * c - y1 * sn, o1 = y1 * c + y0 * sn;
                        unsigned ax = pk2(o0[0], o0[1]), ay = pk2(o0[2], o0[3]), bx = pk2(o1[0], o1[1]), by = pk2(o1[2], o1[3]);
                        { auto rr = __builtin_amdgcn_permlane32_swap(ax, bx, false, false); ax = rr[0]; bx = rr[1]; }
                        { auto rr = __builtin_amdgcn_permlane32_swap(ay, by, false, false); ay = rr[0]; by = rr[1]; }
                        bf16_t* rp = base + (size_t)row * ld + cbo + dl + 60 * (fq >> 1);
                        *(u32x4*)rp = (u32x4){ax, ay, bx, by}; }
                }
            }
        }
    }
};

enum { WM_PLAIN = 0, WM_UP = 1, WM_IN = 2 };
__device__ __forceinline__ int colmap(int kind, int np) {
    if (kind == WM_UP) { const int pn = np >> 8, bj = (np >> 7) & 1, q = np & 127; return bj * FF + 128 * pn + q; }
    if (kind == WM_IN) { const int hh = np >> 7, p = np & 127, fq = (p >> 2) & 3, d = 16 * (p >> 5) + 8 * (fq & 1) + 4 * (fq >> 1) + (p & 3) + 64 * ((p >> 4) & 1);
        if (hh < 41) return hh * 128 + d; return (d < 16) ? (5248 + d) : -1; }
    return np;
}
struct WJ { const float* W; const float* gain; bf16_t* WT; int K, N, NP, kind, local; };
__device__ __forceinline__ void tr_load(const WJ& j, int lane, f32x4 (&v)[16]) {
    const int nblk = j.NP / 64, kb = j.local / nblk, nb = j.local - kb * nblk, k0 = 64 * kb, n0 = 64 * nb;
    int ln = lane; asm volatile("" : "+v"(ln));
    const int src = colmap(j.kind, n0 + 4 * (ln & 15)), rg = lane >> 4;
    const float* p = j.W + (size_t)(k0 + rg) * j.N + (src >= 0 ? src : 0);
#pragma unroll
    for (int i = 0; i < 16; ++i) { v[i] = __builtin_nontemporal_load((const f32x4*)(p + (size_t)(4 * i) * j.N)); if (src < 0) v[i] = (f32x4){0.f, 0.f, 0.f, 0.f}; }
}
__device__ __forceinline__ void tr_process(const WJ& j, int lane, const f32x4 (&v)[16], LAS float* scr) {
    const int nblk = j.NP / 64, kb = j.local / nblk, nb = j.local - kb * nblk, k0 = 64 * kb, n0 = 64 * nb;
    const int rg = lane >> 4, cg = lane & 15;
    float gl = 1.0f; if (j.gain) gl = j.gain[k0 + lane];
#pragma unroll
    for (int i = 0; i < 16; ++i) { const int kk = 4 * i + rg; const float g = __shfl(gl, kk); LAS float* d = scr + kk * 65 + 4 * cg;
        d[0] = v[i][0] * g; d[1] = v[i][1] * g; d[2] = v[i][2] * g; d[3] = v[i][3] * g; }
    asm volatile("s_waitcnt lgkmcnt(0)" ::: "memory");
    const int c = lane & 7;
#pragma unroll
    for (int jj = 0; jj < 8; ++jj) { const int n = (lane >> 3) + 8 * jj; const LAS float* s = scr + (8 * c) * 65 + n;
        u32x4 o; o.x = pk2(s[0 * 65], s[1 * 65]); o.y = pk2(s[2 * 65], s[3 * 65]); o.z = pk2(s[4 * 65], s[5 * 65]); o.w = pk2(s[6 * 65], s[7 * 65]);
        *(u32x4*)(j.WT + (size_t)(n0 + n) * j.K + k0 + 8 * c) = o; }
    asm volatile("s_waitcnt lgkmcnt(0)" ::: "memory");
}

struct Args {
    const float* x; const float* attn_g; const float* ffn_g; const float* w_qkv; const float* w_o0; const float* w_in;
    const float* qn_g; const float* kn_g; const float* ikn_g; const float* w_o1; const float* w_up; const float* conv_w; const float* conv_b; const float* w_down;
    float* out; unsigned char* ws; int ph_lo, ph_hi;
};

constexpr int WI2H = 32 * 96 + 32 * 32 + 32 * 84 + 16 * 32;
constexpr int WI0 = 32 * 96, WI1 = WI0 + 32 * 32, WI2 = WI1 + 32 * 84, WI3 = WI2 + 32 * 32, WI4 = WI3 + 32 * 176, WI5 = WI4 + 32 * 176, WI6 = WI5 + 88 * 32, WI7 = WI6 + 88 * 32;
__device__ __forceinline__ WJ wj_decode(const Args& a, int it) {
    unsigned char* ws = a.ws; WJ j;
    if (it < WI0)      j = WJ{a.w_qkv, a.attn_g, (bf16_t*)(ws + WS_WQKV), DM, NQKV, NQKV, WM_PLAIN, it};
    else if (it < WI1) j = WJ{a.w_o0, nullptr, (bf16_t*)(ws + WS_WO0), DM, DM, DM, WM_PLAIN, it - WI0};
    else if (it < WI2) j = WJ{a.w_in, a.attn_g + DM, (bf16_t*)(ws + WS_WIN), DM, NIN, NINP, WM_IN, it - WI1};
    else if (it < WI3) j = WJ{a.w_o1, nullptr, (bf16_t*)(ws + WS_WO1), DM, DM, DM, WM_PLAIN, it - WI2};
    else if (it < WI4) j = WJ{a.w_up, a.ffn_g, (bf16_t*)(ws + WS_WUP), DM, NUP, NUP, WM_UP, it - WI3};
    else if (it < WI5) j = WJ{a.w_up + (size_t)DM * NUP, a.ffn_g + DM, (bf16_t*)(ws + WS_WUP + 44 * MiB), DM, NUP, NUP, WM_UP, it - WI4};
    else if (it < WI6) j = WJ{a.w_down, nullptr, (bf16_t*)(ws + WS_WDN), FF, DM, DM, WM_PLAIN, it - WI5};
    else               j = WJ{a.w_down + (size_t)FF * DM, nullptr, (bf16_t*)(ws + WS_WDN + 22 * MiB), FF, DM, DM, WM_PLAIN, it - WI6};
    return j;
}
__device__ __forceinline__ int q_grab(unsigned* ctr, int lane) { unsigned v = 0; if (lane == 0) v = xb_add(ctr, 1u); return (int)__builtin_amdgcn_readfirstlane(v); }
template <bool DYN>
__device__ __forceinline__ void convert_items_t(const Args& a, LAS float* scr, int lo1, int hi1, int lo2, int hi2, int flo, int fhi, int vw, int nvw, int lane, unsigned* ctr) {
    const int n1 = hi1 - lo1;
#define CV_ITEM(v) wj_decode(a, (v) < n1 ? lo1 + (v) : lo2 + ((v) - n1))
#define CV_NEXT(cur) (DYN ? flo + vw + nvw * q_grab(ctr, lane) : (cur) + nvw)
    int it = DYN ? flo + vw + nvw * q_grab(ctr, lane) : flo + vw;
    if (it >= fhi) return;
    f32x4 va[16], vb[16];
    WJ ja = CV_ITEM(it), jb = ja;
    tr_load(ja, lane, va);
#pragma nounroll
    for (;;) {
        int nx = CV_NEXT(it); bool hn = nx < fhi;
        if (hn) { jb = CV_ITEM(nx); tr_load(jb, lane, vb); }
        tr_process(ja, lane, va, scr);
        if (!hn) break;
        it = nx; nx = CV_NEXT(it); hn = nx < fhi;
        if (hn) { ja = CV_ITEM(nx); tr_load(ja, lane, va); }
        tr_process(jb, lane, vb, scr);
        if (!hn) break;
        it = nx;
    }
#undef CV_ITEM
#undef CV_NEXT
}
__device__ __forceinline__ void convert_items(const Args& a, LAS float* scr, int lo1, int hi1, int lo2, int hi2, int vw, int nvw, int lane) {
    convert_items_t<false>(a, scr, lo1, hi1, lo2, hi2, 0, (hi1 - lo1) + (hi2 - lo2), vw, nvw, lane, nullptr);
}
struct Offload { int g_up, g_in; bool up0, in1, up1; };
__device__ __forceinline__ Offload make_offload(int G) {
    Offload o; const int u_up = 33 * (NUP / 256), u_in = (MTOK / 256) * (NINP / 256);
    const int r_up = (u_up + G - 1) / G, r_in = (u_in + G - 1) / G;
    o.g_up = (u_up + r_up - 1) / r_up; o.g_in = (u_in + r_in - 1) / r_in;
    o.up0 = (G - o.g_up) >= 8; o.up1 = o.up0; o.in1 = (G - o.g_in) >= 16;
    return o;
}
__device__ __forceinline__ void prologue_phase(const Args& a, LAS unsigned char* lds, int gw, int ngw, int wave, int lane, const Offload& offl) {
    unsigned char* ws = a.ws;
    LAS float* scr = (LAS float*)(lds + wave * 16640);
    convert_items(a, scr, 0, WI0, 0, 0, gw, ngw, lane);
    if (!offl.up0 || !offl.in1 || !offl.up1) {
        if (!offl.up0) convert_items(a, scr, WI5, WI6, WI1, WI2H, gw, ngw, lane);
        if (!offl.in1) convert_items(a, scr, WI4, WI5, WI2H, WI3, gw, ngw, lane);
        if (!offl.up1) convert_items(a, scr, WI6, WI7, 0, 0, gw, ngw, lane);
    }
    bf16_t* XB = (bf16_t*)(ws + WS_XB); float* PART = (float*)(ws + WS_PART);
    for (int m = gw; m < MTOK; m += 2 * ngw) {
        const int m2 = m + ngw; const bool has2 = m2 < MTOK;
        const f32x4* xr = (const f32x4*)(a.x + (size_t)m * DM) + lane; const f32x4* xr2 = (const f32x4*)(a.x + (size_t)(has2 ? m2 : m) * DM) + lane;
        f32x4 v[8], v2[8]; float s = 0.f, s2 = 0.f;
#pragma unroll
        for (int j = 0; j < 8; ++j) { v[j] = __builtin_nontemporal_load(xr + 64 * j); v2[j] = __builtin_nontemporal_load(xr2 + 64 * j); }
        u32x2* o8 = (u32x2*)(XB + (size_t)m * DM) + lane; u32x2* o82 = (u32x2*)(XB + (size_t)m2 * DM) + lane;
#pragma unroll
        for (int j = 0; j < 8; ++j) { s += (v[j].x * v[j].x + v[j].y * v[j].y) + (v[j].z * v[j].z + v[j].w * v[j].w); s2 += (v2[j].x * v2[j].x + v2[j].y * v2[j].y) + (v2[j].z * v2[j].z + v2[j].w * v2[j].w);
            u32x2 w; w.x = pk2(v[j].x, v[j].y); w.y = pk2(v[j].z, v[j].w); o8[64 * j] = w;
            if (has2) { u32x2 w2; w2.x = pk2(v2[j].x, v2[j].y); w2.y = pk2(v2[j].z, v2[j].w); o82[64 * j] = w2; } }
        const float t = wave_sum(s), t2 = wave_sum(s2);
        if (lane < 32) { PART[(size_t)m * 32 + lane] = lane == 0 ? t : 0.f; if (has2) PART[(size_t)m2 * 32 + lane] = lane == 0 ? t2 : 0.f; }
    }
    if (gw == 0) { float* gn = (float*)(ws + WS_GAIN); for (int i = lane; i < 128; i += 64) { gn[i] = a.qn_g[i]; gn[128 + i] = a.kn_g[i]; gn[256 + i] = a.ikn_g[i]; } }
    float* rc = (float*)(ws + WS_ROPE); float* rsn = rc + SEQ * 64;
    for (int i = gw * 64 + lane; i < SEQ * 64; i += ngw * 64) {
        const int pos = i >> 6, fi = i & 63;
        const float inv_freq = (float)(1.0 / exp2((double)fi * (2.0 / 128.0) * 13.287712379549449));
        const float ang = (float)pos * inv_freq;
        const double x = (double)ang; const double kq = rint(x * 0.63661977236758134308);
        double r = __builtin_fma(-kq, 1.57079632679489655800e+00, x); r = __builtin_fma(-kq, 6.12323399573676603587e-17, r);
        const double r2 = r * r;
        double sp = -1.0 / 6227020800.0; sp = sp * r2 + 1.0 / 39916800.0; sp = sp * r2 - 1.0 / 362880.0; sp = sp * r2 + 1.0 / 5040.0; sp = sp * r2 - 1.0 / 120.0; sp = sp * r2 + 1.0 / 6.0; const double sv = r - r * r2 * sp;
        double cp = 1.0 / 87178291200.0; cp = cp * r2 - 1.0 / 479001600.0; cp = cp * r2 + 1.0 / 3628800.0; cp = cp * r2 - 1.0 / 40320.0; cp = cp * r2 + 1.0 / 720.0; cp = cp * r2 - 1.0 / 24.0; cp = cp * r2 + 0.5; const double cv = 1.0 - r2 * cp;
        const int q = ((int)kq) & 3;
        const double cs = (q == 0) ? cv : (q == 1) ? -sv : (q == 2) ? -cv : sv;
        const double sn = (q == 0) ? sv : (q == 1) ? cv : (q == 2) ? -sv : -cv;
        rc[i] = (float)cs; rsn[i] = (float)sn;
    }
}

constexpr float SB_EXIT = 220.0f;
constexpr float SB_MARGIN = 32.0f;
__device__ __forceinline__ unsigned fmap(float f) { const unsigned u = __float_as_uint(f); return (u & 0x80000000u) ? ~u : (u | 0x80000000u); }


__device__ __forceinline__ void store_o_rows16(bf16_t* row_base  , const f32x16 (&o)[4], float scale, int hh) {
    unsigned char* bp = (unsigned char*)row_base + (hh ? 16 : 0);
#pragma unroll
    for (int d = 0; d < 4; ++d)
#pragma unroll
        for (int g = 0; g < 4; g += 2) {
            unsigned ax = pk2(o[d][4 * g] * scale, o[d][4 * g + 1] * scale), ay = pk2(o[d][4 * g + 2] * scale, o[d][4 * g + 3] * scale);
            unsigned bx = pk2(o[d][4 * g + 4] * scale, o[d][4 * g + 5] * scale), by = pk2(o[d][4 * g + 6] * scale, o[d][4 * g + 7] * scale);
            { auto rr = __builtin_amdgcn_permlane32_swap(ax, bx, false, false); ax = rr[0]; bx = rr[1]; }
            { auto rr = __builtin_amdgcn_permlane32_swap(ay, by, false, false); ay = rr[0]; by = rr[1]; }
            *(u32x4*)(bp + 16 * (4 * d + g)) = (u32x4){ax, ay, bx, by};
        }
}

constexpr int KSTR = 272, VSTR = 144, KTILE_B = 64 * KSTR, VTILE_B = 128 * VSTR, KVBUF_B = KTILE_B + VTILE_B;
struct KVStage {
    u32x4 k[2], v[2];
    __device__ __forceinline__ void load(const unsigned char* kg, size_t kstride, const unsigned char* vg, size_t vstride, int tid) {
#pragma unroll
        for (int i = 0; i < 2; ++i) { const int c = tid + 512 * i; k[i] = *(const u32x4*)(kg + (size_t)(c >> 4) * kstride + (c & 15) * 16); v[i] = *(const u32x4*)(vg + (size_t)(c >> 3) * vstride + (c & 7) * 16); }
    }
    __device__ __forceinline__ void store(LAS unsigned char* buf, int tid) const {
#pragma unroll
        for (int i = 0; i < 2; ++i) { const int c = tid + 512 * i;
            *(LAS u32x4*)(buf + (c >> 4) * KSTR + (c & 15) * 16) = k[i];
            *(LAS u32x4*)(buf + KTILE_B + (c >> 3) * VSTR + (c & 7) * 16) = v[i]; }
    }
};

__device__ __forceinline__ void dsa_attn_block(const bf16_t* __restrict__ QD, const bf16_t* __restrict__ KD, const bf16_t* __restrict__ VTD, const unsigned* __restrict__ MASK, bf16_t* __restrict__ O,
                                               LAS unsigned char* lds, int b, int g, int qb64, int wave, int lane, int tid) {
    const int r = lane & 31, hh = lane >> 5, h = 4 * g + (wave & 3), q0 = 64 * qb64 + 32 * (wave >> 2);
    LAS unsigned char* qlds = lds + 2 * KVBUF_B + wave * (32 * KSTR);
    { const unsigned char* qg = (const unsigned char*)(QD + (size_t)(b * SEQ + q0) * DM + h * HD);
        u32x4 t[8];
#pragma unroll
        for (int i = 0; i < 8; ++i) { const int c = lane + 64 * i; t[i] = *(const u32x4*)(qg + (size_t)(c >> 4) * (DM * 2) + (c & 15) * 16); }
#pragma unroll
        for (int i = 0; i < 8; ++i) { const int c = lane + 64 * i; *(LAS u32x4*)(qlds + (c >> 4) * KSTR + (c & 15) * 16) = t[i]; }
        asm volatile("s_waitcnt lgkmcnt(0)" ::: "memory"); }
    const LAS unsigned char* qfp = qlds + r * KSTR + 16 * hh;
    f32x16 o[4];
#pragma unroll
    for (int d = 0; d < 4; ++d) o[d] = f32x16{};
    float mrun = -1e29f, lrun = 0.f;
    const unsigned char* kg = (const unsigned char*)(KD + (size_t)(b * SEQ) * (KVH * HD) + g * HD);
    const unsigned char* vg = (const unsigned char*)(VTD + (size_t)(b * KVH + g) * HD * SEQ);
    const unsigned long long* mrow = (const unsigned long long*)(MASK + (size_t)(b * SEQ + q0 + r) * 64);
    KVStage sA, sB;
#define MA_LOAD(ST, t) ST.load(kg + (size_t)(t) * 64 * (KVH * HD * 2), KVH * HD * 2, vg + (size_t)(t) * 64 * 2, SEQ * 2, tid)
    MA_LOAD(sA, 0);
    sA.store(lds, tid);
    asm volatile("s_waitcnt lgkmcnt(0)" ::: "memory"); __builtin_amdgcn_s_barrier(); asm volatile("" ::: "memory");
    if (qb64 >= 1) MA_LOAD(sA, 1);
    if (qb64 >= 2) MA_LOAD(sB, 2);
    unsigned long long mw_next = mrow[0];
    bf16x8 qf[8];
#pragma unroll
    for (int s = 0; s < 8; ++s) qf[s] = *(const LAS bf16x8*)(qfp + 32 * s);
    auto ma_tile = [&](const int kt, LAS unsigned char* buf) __attribute__((always_inline)) {
        const unsigned long long mw = mw_next;
        if (kt < qb64) mw_next = mrow[kt + 1];
        const bool two = (64 * kt + 32) <= q0 + 31;
        f32x16 p0 = f32x16{}, p1 = f32x16{};
        { const LAS unsigned char* kp = buf + r * KSTR + 16 * hh;
            __builtin_amdgcn_s_setprio(1);
#pragma unroll
            for (int s = 0; s < 8; ++s) p0 = __builtin_amdgcn_mfma_f32_32x32x16_bf16(*(const LAS bf16x8*)(kp + 32 * s), qf[s], p0, 0, 0, 0);
            if (two) {
#pragma unroll
                for (int s = 0; s < 8; ++s) p1 = __builtin_amdgcn_mfma_f32_32x32x16_bf16(*(const LAS bf16x8*)(kp + 32 * KSTR + 32 * s), qf[s], p1, 0, 0, 0); }
            __builtin_amdgcn_s_setprio(0); }
        const int m0 = (int)(((unsigned)mw) >> (4 * hh)), m1 = two ? (int)(((unsigned)(mw >> 32)) >> (4 * hh)) : 0;
        const unsigned NEGB = 0xf149f2cau;
#pragma unroll
        for (int i = 0; i < 16; ++i) { const int kb = crow(i, 0);
            const unsigned t0 = (unsigned)((m0 << (31 - kb)) >> 31), t1 = (unsigned)((m1 << (31 - kb)) >> 31);
            p0[i] = __uint_as_float((__float_as_uint(p0[i]) & t0) | (NEGB & ~t0)); p1[i] = __uint_as_float((__float_as_uint(p1[i]) & t1) | (NEGB & ~t1)); }
        float tmax = fmaxf(p0[0], p1[0]);
#pragma unroll
        for (int i = 1; i < 16; ++i) tmax = fmaxf(fmaxf(tmax, p0[i]), p1[i]);
        tmax = swap_max(tmax);
        const bool grow = __any(tmax > mrun + 8.0f);
        const float mnew = grow ? fmaxf(mrun, tmax) : mrun;
        if (grow) {
            const float alpha = __builtin_amdgcn_exp2f(mrun - mnew);
            lrun *= alpha;
#pragma unroll
            for (int d = 0; d < 4; ++d)
#pragma unroll
                for (int i = 0; i < 16; ++i) o[d][i] *= alpha;
        }
        float ls = 0.f;
#pragma unroll
        for (int i = 0; i < 16; ++i) { const float e0 = __builtin_amdgcn_exp2f(p0[i] - mnew), e1 = __builtin_amdgcn_exp2f(p1[i] - mnew); p0[i] = e0; p1[i] = e1; ls += e0 + e1; }
        lrun += ls; mrun = mnew;
        const bf16x8 pa0 = pack8(p0, 0), pa1 = pack8(p0, 8), pa2 = pack8(p1, 0), pa3 = pack8(p1, 8);
        const LAS unsigned char* vb = buf + KTILE_B + r * VSTR + 16 * hh;
        __builtin_amdgcn_s_setprio(1);
#pragma unroll
        for (int d = 0; d < 4; ++d) {
            const LAS unsigned char* vp = vb + 32 * d * VSTR;
#define VFRAG(ks) (*(const LAS bf16x8*)(vp + 32 * (ks)))
            o[d] = __builtin_amdgcn_mfma_f32_32x32x16_bf16(VFRAG(0), pa0, o[d], 0, 0, 0);
            o[d] = __builtin_amdgcn_mfma_f32_32x32x16_bf16(VFRAG(1), pa1, o[d], 0, 0, 0);
            if (two) { o[d] = __builtin_amdgcn_mfma_f32_32x32x16_bf16(VFRAG(2), pa2, o[d], 0, 0, 0);
                       o[d] = __builtin_amdgcn_mfma_f32_32x32x16_bf16(VFRAG(3), pa3, o[d], 0, 0, 0); }
#undef VFRAG
        }
        __builtin_amdgcn_s_setprio(0);
    };
#define MA_SYNC() do { asm volatile("s_waitcnt lgkmcnt(0)" ::: "memory"); __builtin_amdgcn_s_barrier(); asm volatile("" ::: "memory"); } while (0)
    for (int kt = 0; kt <= qb64; kt += 2) {
        ma_tile(kt, lds);
        if (kt + 1 <= qb64) sA.store(lds + KVBUF_B, tid);
        MA_LOAD(sA, (kt + 3 <= qb64 ? kt + 3 : qb64));
        MA_SYNC();
        if (kt + 1 <= qb64) {
            ma_tile(kt + 1, lds + KVBUF_B);
            if (kt + 2 <= qb64) sB.store(lds, tid);
            MA_LOAD(sB, (kt + 4 <= qb64 ? kt + 4 : qb64));
            MA_SYNC();
        }
    }
#undef MA_SYNC
#undef MA_LOAD
    asm volatile("s_waitcnt vmcnt(0)" ::: "memory");
    const float linv = 1.0f / swap_sum(lrun);
    store_o_rows16(O + (size_t)(b * SEQ + q0 + r) * DM + h * HD, o, linv, hh);
}


__device__ __forceinline__ unsigned wave_total_u32(unsigned v) {
    v += (unsigned)__builtin_amdgcn_update_dpp(0, (int)v, 0x111, 0xf, 0xf, true);
    v += (unsigned)__builtin_amdgcn_update_dpp(0, (int)v, 0x112, 0xf, 0xf, true);
    v += (unsigned)__builtin_amdgcn_update_dpp(0, (int)v, 0x114, 0xf, 0xf, true);
    v += (unsigned)__builtin_amdgcn_update_dpp(0, (int)v, 0x118, 0xf, 0xf, true);
    v += (unsigned)__builtin_amdgcn_update_dpp(0, (int)v, 0x142, 0xa, 0xf, false);
    v += (unsigned)__builtin_amdgcn_update_dpp(0, (int)v, 0x143, 0xc, 0xf, false);
    return (unsigned)__builtin_amdgcn_readlane((int)v, 63);
}
__device__ __forceinline__ void causal_mask_row(unsigned* mrow, int t, int lane) {
    const int key0 = 32 * lane; unsigned w;
    if (key0 + 31 <= t) w = 0xffffffffu; else if (key0 > t) w = 0u; else w = (1u << (t - key0 + 1)) - 1u;
    mrow[lane] = w;
}
__device__ __forceinline__ void write_topk_mask(const unsigned (&uv)[32], unsigned prefix, unsigned* mrow, int lane) {
    int cgt = 0;
#pragma unroll
    for (int e = 0; e < 32; ++e) cgt += __popcll(__ballot(uv[e] > prefix));
    const int need = TOPK - cgt; int running = 0;
    const unsigned long long ltm = (1ull << lane) - 1ull;
    unsigned long long keep = 0ull;
#pragma unroll
    for (int e = 0; e < 32; ++e) {
        const unsigned long long eq = __ballot(uv[e] == prefix);
        const bool sel = (uv[e] > prefix) || (uv[e] == prefix && (running + __popcll(eq & ltm)) < need);
        const unsigned long long m64 = __ballot(sel);
        running += __popcll(eq);
        if (lane == e) keep = m64;
    }
    if (lane < 32) *(unsigned long long*)(mrow + 2 * lane) = keep;
}
__device__ __forceinline__ void select_two(const float* rowa, const float* rowb, int ta, unsigned* mrowa, unsigned* mrowb, int lane) {
    const int tb = ta + 1, na = ta + 1, nb = tb + 1;
    if (nb <= TOPK) { causal_mask_row(mrowa, ta, lane); causal_mask_row(mrowb, tb, lane); return; }
    float fa[32], fb[32];
#pragma unroll
    for (int e = 0; e < 32; ++e) { fa[e] = __builtin_nontemporal_load(rowa + e * 64 + lane); fb[e] = __builtin_nontemporal_load(rowb + e * 64 + lane); }
    unsigned ua[32], ub[32];
#pragma unroll
    for (int e = 0; e < 32; ++e) { const int key = e * 64 + lane; const unsigned ma = fmap(fa[e]), mb = fmap(fb[e]); ua[e] = (key < na) ? ma : 0x007fffffu; ub[e] = (key < nb) ? mb : 0x007fffffu; }
    unsigned pa = 0u, pb = 0u; bool da = false, db = false;
    for (int bit = 31; bit >= 0; --bit) {
        const unsigned ca = pa | (1u << bit), cb = pb | (1u << bit);
        unsigned na_ = 0u, nb_ = 0u;
#pragma unroll
        for (int e = 0; e < 32; ++e) { na_ += (ua[e] >= ca) ? 1u : 0u; nb_ += (ub[e] >= cb) ? 1u : 0u; }
        const unsigned tota = wave_total_u32(na_), totb = wave_total_u32(nb_);
        if (!da && tota >= (unsigned)TOPK) { pa = ca; if (tota == (unsigned)TOPK) da = true; }
        if (!db && totb >= (unsigned)TOPK) { pb = cb; if (totb == (unsigned)TOPK) db = true; }
        if (da && db) break;
    }
    if (na <= TOPK) causal_mask_row(mrowa, ta, lane); else write_topk_mask(ua, pa, mrowa, lane);
    write_topk_mask(ub, pb, mrowb, lane);
}

struct KiStage {
    u32x4 k[4];
    __device__ __forceinline__ void load(const unsigned char* kg, int tid) {
#pragma unroll
        for (int i = 0; i < 4; ++i) { const int c = tid + 512 * i; k[i] = *(const u32x4*)(kg + (size_t)(c >> 4) * (HD * 2) + (c & 15) * 16); }
    }
    __device__ __forceinline__ void store(LAS unsigned char* buf, int tid) const {
#pragma unroll
        for (int i = 0; i < 4; ++i) { const int c = tid + 512 * i; *(LAS u32x4*)(buf + (c >> 4) * KSTR + (c & 15) * 16) = k[i]; }
    }
};
constexpr int KIBUF_B = 128 * KSTR;
__device__ __forceinline__ void indexer_block(const bf16_t* __restrict__ QI, const bf16_t* __restrict__ KI, const float* __restrict__ WI, unsigned* __restrict__ MASK, float* __restrict__ SC,
                                              LAS unsigned char* lds, int b, int qb16, int wave, int lane, int tid) {
    const int r = lane & 31, hh = lane >> 5, t0 = 16 * qb16, tw = t0 + 2 * wave;
    const bf16_t* ap = QI + (size_t)(b * SEQ + tw + (r >> 4)) * DM + (r & 15) * HD + 8 * hh;
    bf16x8 af[8];
#pragma unroll
    for (int s = 0; s < 8; ++s) af[s] = *(const bf16x8*)(ap + 16 * s);
    float wv[16];
    { const f32x4* wp = (const f32x4*)(WI + (size_t)(b * SEQ + tw) * 16 + 4 * hh);
#pragma unroll
      for (int g4 = 0; g4 < 4; ++g4) { const f32x4 t = wp[2 * g4];
#pragma unroll
          for (int e = 0; e < 4; ++e) wv[4 * g4 + e] = t[e]; } }
    float* myrow = SC + ((size_t)(b * 128 + qb16) * 16 + 2 * wave + hh) * SEQ;
    const int tq = tw + hh, ntile = (t0 + 16 + 127) >> 7;
    const unsigned char* kg = (const unsigned char*)(KI + (size_t)(b * SEQ) * HD);
    KiStage sA, sB;
    sA.load(kg, tid);
    if (ntile > 1) sB.load(kg + (size_t)1 * 128 * (HD * 2), tid);
    sA.store(lds, tid);
    if (ntile > 1) sB.store(lds + KIBUF_B, tid);
    asm volatile("s_waitcnt lgkmcnt(0)" ::: "memory"); __builtin_amdgcn_s_barrier(); asm volatile("" ::: "memory");
    if (ntile > 2) sA.load(kg + (size_t)2 * 128 * (HD * 2), tid);
    if (ntile > 3) sB.load(kg + (size_t)3 * 128 * (HD * 2), tid);
    float sc4[4];
#define IDX_KLOAD(DST, J, BUF) do { const LAS unsigned char* kp_ = (BUF) + (32 * (J) + r) * KSTR + 16 * hh; _Pragma("unroll") for (int s = 0; s < 8; ++s) DST[s] = *(const LAS bf16x8*)(kp_ + 32 * s); } while (0)
#define IDX_STEP(KT, J, KF) do { const int key0 = 128 * (KT) + 32 * (J); \
            sc4[J] = -INFINITY; \
            if (key0 <= t0 + 15) { \
                f32x16 c = f32x16{}; \
                __builtin_amdgcn_s_setprio(1); \
                _Pragma("unroll") for (int s = 0; s < 8; ++s) c = __builtin_amdgcn_mfma_f32_32x32x16_bf16(af[s], KF[s], c, 0, 0, 0); \
                __builtin_amdgcn_s_setprio(0); \
                float s0 = 0.f, s1 = 0.f; \
                _Pragma("unroll") for (int i = 0; i < 8; ++i) { s0 += wv[i] * relu_i(c[i]); s1 += wv[i + 8] * relu_i(c[i + 8]); } \
                const float t0s = swap_sum(s0), t1s = swap_sum(s1); \
                float v = (hh ? t1s : t0s) + 0.0f; \
                if (key0 + r > tq) v = -INFINITY; \
                sc4[J] = v; } } while (0)
#define IDX_TILE(KT, BUF) do { bf16x8 kfa[8], kfb[8]; \
            IDX_KLOAD(kfa, 0, BUF); IDX_KLOAD(kfb, 1, BUF); __builtin_amdgcn_sched_barrier(0); \
            IDX_STEP(KT, 0, kfa); IDX_KLOAD(kfa, 2, BUF); __builtin_amdgcn_sched_barrier(0); \
            IDX_STEP(KT, 1, kfb); IDX_KLOAD(kfb, 3, BUF); __builtin_amdgcn_sched_barrier(0); \
            IDX_STEP(KT, 2, kfa); IDX_STEP(KT, 3, kfb); } while (0)
#define IDX_FLUSH(KT) do { _Pragma("unroll") for (int j = 0; j < 4; ++j) myrow[128 * (KT) + 32 * j + r] = sc4[j]; } while (0)
#define IDX_SYNC() do { asm volatile("s_waitcnt lgkmcnt(0)" ::: "memory"); __builtin_amdgcn_s_barrier(); asm volatile("" ::: "memory"); } while (0)
    for (int kt = 0; kt < ntile; kt += 2) {
        IDX_TILE(kt, lds);
        IDX_SYNC();
        if (kt + 2 < ntile) sA.store(lds, tid);
        if (kt + 4 < ntile) sA.load(kg + (size_t)(kt + 4) * 128 * (HD * 2), tid);
        IDX_FLUSH(kt);
        if (kt + 1 < ntile) {
            IDX_TILE(kt + 1, lds + KIBUF_B);
            IDX_SYNC();
            if (kt + 3 < ntile) sB.store(lds + KIBUF_B, tid);
            if (kt + 5 < ntile) sB.load(kg + (size_t)(kt + 5) * 128 * (HD * 2), tid);
            IDX_FLUSH(kt + 1);
        }
    }
#undef IDX_TILE
#undef IDX_STEP
#undef IDX_KLOAD
#undef IDX_FLUSH
#undef IDX_SYNC
    asm volatile("s_waitcnt vmcnt(0)" ::: "memory");
    { const float* rowa = SC + ((size_t)(b * 128 + qb16) * 16 + 2 * wave) * SEQ;
      unsigned* mrowa = MASK + (size_t)(b * SEQ + tw) * 64;
      select_two(rowa, rowa + SEQ, tw, mrowa, mrowa + 64, lane); }
}


__device__ __forceinline__ void sb_attn_waves(const bf16_t* __restrict__ Q, const bf16_t* __restrict__ KF, const bf16_t* __restrict__ VF, bf16_t* __restrict__ O, const LAS float* thr_tab, int gw, int ngw, int lane) {
    const int r = lane & 31, hh = lane >> 5, rm = r - 4 * hh;
    bf16x8 uf[2];
#pragma unroll
    for (int s2 = 0; s2 < 2; ++s2) { u32x4 w; unsigned e[8];
#pragma unroll
        for (int j = 0; j < 8; ++j) { const int key = 16 * s2 + 8 * (j >> 2) + 4 * hh + (j & 3); e[j] = (key >= r) ? 0x3f80u : 0u; }
        w.x = e[0] | (e[1] << 16); w.y = e[2] | (e[3] << 16); w.z = e[4] | (e[5] << 16); w.w = e[6] | (e[7] << 16); uf[s2] = __builtin_bit_cast(bf16x8, w); }
    for (int unit = gw; unit < BATCH * NH * 64; unit += ngw) {
        const int bh = unit >> 6, qt = 63 - ((unit + bh) & 63), b = bh >> 4, h = bh & 15, q0 = qt * 32;
        const float thr_u = __uint_as_float(__builtin_amdgcn_readfirstlane(__float_as_uint(thr_tab[bh])));
        const bf16_t* qp = Q + (size_t)(b * SEQ + q0 + r) * DM + h * HD + 8 * hh;
        bf16x8 qf[8];
#pragma unroll
        for (int s = 0; s < 8; ++s) qf[s] = *(const bf16x8*)(qp + 16 * s);
        f32x16 o[4];
#pragma unroll
        for (int d = 0; d < 4; ++d) o[d] = f32x16{};
        float carry = 0.f;
        const bf16x8* kbase = (const bf16x8*)KF + (size_t)bh * 64 * 8 * 64 + lane;
        const bf16x8* vbase = (const bf16x8*)VF + (size_t)bh * 64 * 8 * 64 + lane;
        bf16x8 kf[8], vf[8];
#pragma unroll
        for (int s = 0; s < 8; ++s) kf[s] = kbase[(size_t)(qt * 8 + s) * 64];
#pragma unroll
        for (int i = 0; i < 8; ++i) vf[i] = vbase[(size_t)(qt * 8 + i) * 64];
        for (int kt = qt; kt >= 0; --kt) {
            bf16x8 kn[8], vn[8];
            const int ktn = kt > 0 ? kt - 1 : 0;
#pragma unroll
            for (int s = 0; s < 8; ++s) kn[s] = kbase[(size_t)(ktn * 8 + s) * 64];
            f32x16 p = f32x16{};
#pragma unroll
            for (int s = 0; s < 8; ++s) p = __builtin_amdgcn_mfma_f32_32x32x16_bf16(kf[s], qf[s], p, 0, 0, 0);
#pragma unroll
            for (int i = 0; i < 8; ++i) vn[i] = vbase[(size_t)(ktn * 8 + i) * 64];
            f32x16 sp;
#pragma unroll
            for (int i = 0; i < 16; ++i) sp[i] = __builtin_amdgcn_logf(1.0f + __builtin_amdgcn_exp2f(__builtin_amdgcn_fmed3f(p[i], 120.0f, -3.0e38f)));
            if (kt == qt) {
#pragma unroll
                for (int i = 0; i < 16; ++i) if (crow(i, 0) >= rm) { sp[i] = 0.f; p[i] = -1e30f; } }
            f32x16 c;
#pragma unroll
            for (int i = 0; i < 16; ++i) c[i] = carry;
            c = __builtin_amdgcn_mfma_f32_32x32x16_bf16(uf[0], pack8(sp, 0), c, 0, 0, 0);
            c = __builtin_amdgcn_mfma_f32_32x32x16_bf16(uf[1], pack8(sp, 8), c, 0, 0, 0);
#pragma unroll
            for (int i = 0; i < 16; ++i) p[i] = __builtin_amdgcn_exp2f(p[i] - c[i]);
            carry = swap_max(c[0]);
            const bf16x8 pa0 = pack8(p, 0), pa1 = pack8(p, 8);
#pragma unroll
            for (int d = 0; d < 4; ++d) { o[d] = __builtin_amdgcn_mfma_f32_32x32x16_bf16(vf[2 * d], pa0, o[d], 0, 0, 0); o[d] = __builtin_amdgcn_mfma_f32_32x32x16_bf16(vf[2 * d + 1], pa1, o[d], 0, 0, 0); }
            if (__all(carry > thr_u)) break;
#pragma unroll
            for (int s = 0; s < 8; ++s) { kf[s] = kn[s]; vf[s] = vn[s]; }
        }
        store_o_rows16(O + (size_t)(b * SEQ + q0 + r) * DM + h * HD, o, 1.0f, hh);
    }
}

constexpr int N_PHASES = 12;
__global__ void __launch_bounds__(512, 2) fwd_kernel(Args a) {
    extern __shared__ __attribute__((aligned(16))) unsigned char lds_raw[];
    LAS unsigned char* lds = (LAS unsigned char*)lds_raw;
    cg::grid_group grid = cg::this_grid();
    const int tid = threadIdx.x, wave = __builtin_amdgcn_readfirstlane(tid >> 6);
#define LANE() ({ int l_ = tid & 63; asm volatile("" : "+v"(l_)); l_; })
    const int G = gridDim.x, bx = blockIdx.x;
    const int gw = bx * 8 + wave, ngw = G * 8;
    unsigned char* ws = a.ws;
    const int lo = a.ph_lo, hi = a.ph_hi;
#ifndef REP_PHASE
#define REP_PHASE -1
#endif
#ifndef REP_COUNT
#define REP_COUNT 1
#endif
#define IN(k) (lo <= (k) && (k) < hi)
#define GSYNC(k) do { if ((k) == 0 && a.ph_hi > 1000) grid.sync(); xcd_barrier(xbar); } while (0)
#define SEAM(k) do { if (IN(k) && IN((k) + 1)) GSYNC(k); } while (0)
#define REPS(k) for (int rep_ = 0; rep_ < ((k) == REP_PHASE ? REP_COUNT : 1); ++rep_, (void)(((k) == REP_PHASE && rep_ < REP_COUNT) ? (xcd_barrier(xbar), 0) : 0))
    bf16_t* XB = (bf16_t*)(ws + WS_XB); float* PART = (float*)(ws + WS_PART);
    bf16_t* Qb = (bf16_t*)(ws + WS_Q); bf16_t* Kb = (bf16_t*)(ws + WS_K); bf16_t* Vtb = (bf16_t*)(ws + WS_VT); bf16_t* Ob = (bf16_t*)(ws + WS_O);
    bf16_t* QIb = (bf16_t*)(ws + WS_QI); bf16_t* KDb = (bf16_t*)(ws + WS_KD); bf16_t* VTDb = (bf16_t*)(ws + WS_VTD); bf16_t* KIb = (bf16_t*)(ws + WS_KI);
    float* WIb = (float*)(ws + WS_WI); unsigned* MASKb = (unsigned*)(ws + WS_MASK);
    bf16_t* ACTb = (bf16_t*)(ws + WS_ACT);
    const float* ropeC = (const float*)(ws + WS_ROPE); const float* ropeS = ropeC + SEQ * 64;

    if (tid < 16) ((volatile LAS unsigned*)(lds + LDS_MISC))[tid] = 0u;
    __syncthreads();
    XcdBarrier xbar = xcd_barrier_post((unsigned*)(ws + WS_CTL), (volatile LAS unsigned*)(lds + LDS_MISC) + 8);
    const Offload offl = make_offload(G);
    if (IN(0)) REPS(0) { prologue_phase(a, lds, gw, ngw, wave, LANE(), offl); }
    SEAM(0);
    if (IN(1)) REPS(1) {
        pg8::Gemm g{XB, (const bf16_t*)(ws + WS_WQKV), MTOK, NQKV, DM}; pg8::StaticOrder S; S.init(MTOK, NQKV, G, bx);
        rstd_table_build(lds, PART, S, 256, 0, tid);
        EpiQKV E{ws, (const LAS float*)(lds + LDS_RSTD)};
        pg8::gemm_phase<EpiQKV, pg8::StaticOrder, true, true>(lds, g, S, E);
    }
    SEAM(1);
    if (IN(2)) REPS(2) {
        LAS float* scr = (LAS float*)(lds + wave * 16640);
        LAS float* thr_tab = (LAS float*)(lds + LDS_RSTD);
        if (tid < BATCH * NH) { unsigned* np = (unsigned*)(ws + WS_CTL + CTL_KMAX) + tid * 4;
#define SB_NRM(i) __uint_as_float(xb_ld(np + (i)))
            const float q2 = (SB_NRM(0) + SB_NRM(1)) + (SB_NRM(2) + SB_NRM(3)), k2 = (SB_NRM(BATCH * NH * 4) + SB_NRM(BATCH * NH * 4 + 1)) + (SB_NRM(BATCH * NH * 4 + 2) + SB_NRM(BATCH * NH * 4 + 3));
#undef SB_NRM
            thr_tab[tid] = fminf(SB_EXIT, sqrtf(q2 * k2) * (QSCALE * 1.01f) + SB_MARGIN); }
        __syncthreads();
        const int p2n = (WI1 - WI0) + (WI4 - WI3), p2s = 1 * ngw < p2n ? 1 * ngw : p2n, nq = G < 8 ? G : 8;
#pragma nounroll
        for (int step = 0; step < 2; ++step) {
            if ((step == 0) == (wave < 4)) sb_attn_waves(Qb, Kb, Vtb, Ob, thr_tab, gw, ngw, LANE());
            else convert_items_t<false>(a, scr, WI0, WI1, WI3, WI4, 0, p2s, gw, ngw, LANE(), nullptr);
        }
        convert_items_t<true>(a, scr, WI0, WI1, WI3, WI4, p2s, p2n, bx % nq, nq, LANE(), (unsigned*)(ws + WS_CTL + 16384) + (bx % nq) * 64);
    }
    SEAM(2);
    if (IN(3)) REPS(3) {
        pg8::Gemm g{Ob, (const bf16_t*)(ws + WS_WO0), MTOK, DM, DM}; pg8::StaticOrder S; S.init(MTOK, DM, G, bx);
        EpiRes<false, false> E{XB, XB, PART};
        pg8::gemm_phase<EpiRes<false, false>, pg8::StaticOrder, true, true>(lds, g, S, E);
    }
    SEAM(3);
    if (IN(4)) REPS(4) {
        const int Gg = offl.up0 ? offl.g_up : G;
        if (bx < Gg) {
        pg8::Gemm g{XB, (const bf16_t*)(ws + WS_WUP), MTOK, NUP, DM, 254, -2}; pg8::StaticOrder S; S.init_tiles(33, NUP / 256, Gg, bx);
        rstd_table_build(lds, PART, S, 254, -2, tid);
        EpiUpConv E{ACTb, a.conv_w, a.conv_b, (LAS float*)(lds + LDS_EPI), (const LAS float*)(lds + LDS_RSTD)};
        pg8::gemm_phase<EpiUpConv, pg8::StaticOrder, true, true>(lds, g, S, E);
        } else { LAS float* scr = (LAS float*)(lds + wave * 16640); const int vw = (bx - Gg) * 8 + wave, nvw = (G - Gg) * 8;
            convert_items(a, scr, WI5, WI6, WI1, WI2H, vw, nvw, LANE()); }
    }
    SEAM(4);
    if (IN(5)) REPS(5) {
        pg8::Gemm g{ACTb, (const bf16_t*)(ws + WS_WDN), MTOK, DM, FF}; pg8::StaticOrder S; S.init(MTOK, DM, G, bx);
        EpiRes<false, false> E{XB, XB, PART};
        pg8::gemm_phase<EpiRes<false, false>, pg8::StaticOrder, true, true>(lds, g, S, E);
    }
    SEAM(5);
    if (IN(6)) REPS(6) {
        const int Gg = offl.in1 ? offl.g_in : G;
        if (bx < Gg) {
        pg8::Gemm g{XB, (const bf16_t*)(ws + WS_WIN), MTOK, NINP, DM}; pg8::StaticOrder S; S.init(MTOK, NINP, Gg, bx);
        rstd_table_build(lds, PART, S, 256, 0, tid);
        EpiDsaIn E{ws, (LAS float*)(lds + LDS_EPI), (const LAS float*)(lds + LDS_RSTD)};
        pg8::gemm_phase<EpiDsaIn, pg8::StaticOrder, true, true>(lds, g, S, E);
        } else { LAS float* scr = (LAS float*)(lds + wave * 16640); const int vw = (bx - Gg) * 8 + wave, nvw = (G - Gg) * 8;
            convert_items(a, scr, WI4, WI5, WI2H, WI3, vw, nvw, LANE()); }
    }
    SEAM(6);
    if (IN(7)) REPS(7) {
        for (int pr = bx; pr < 256; pr += G) { const int b = pr >> 6, p = pr & 63;
            for (int half = 0; half < 2; ++half) indexer_block(QIb, KIb, WIb, MASKb, (float*)(ws + WS_ACT), lds, b, half ? p : 127 - p, wave, LANE(), tid); }
    }
    SEAM(7);
    if (IN(8)) REPS(8) {
        for (int pr = bx; pr < 256; pr += G) { const int b = pr >> 6, g = (pr >> 4) & 3, p = pr & 15;
            for (int half = 0; half < 2; ++half) dsa_attn_block(Qb, KDb, VTDb, MASKb, Ob, lds, b, g, half ? p : 31 - p, wave, LANE(), tid); }
    }
    SEAM(8);
    if (IN(9)) REPS(9) {
        pg8::Gemm g{Ob, (const bf16_t*)(ws + WS_WO1), MTOK, DM, DM}; pg8::StaticOrder S; S.init(MTOK, DM, G, bx);
        EpiRes<false, false> E{XB, XB, PART};
        pg8::gemm_phase<EpiRes<false, false>, pg8::StaticOrder, true, true>(lds, g, S, E);
    }
    SEAM(9);
    if (IN(10)) REPS(10) {
        const int Gg = offl.up1 ? offl.g_up : G;
        if (bx < Gg) {
        pg8::Gemm g{XB, (const bf16_t*)(ws + WS_WUP + 44 * MiB), MTOK, NUP, DM, 254, -2}; pg8::StaticOrder S; S.init_tiles(33, NUP / 256, Gg, bx);
        rstd_table_build(lds, PART, S, 254, -2, tid);
        EpiUpConv E{ACTb, a.conv_w + 3 * NUP, a.conv_b + NUP, (LAS float*)(lds + LDS_EPI), (const LAS float*)(lds + LDS_RSTD)};
        pg8::gemm_phase<EpiUpConv, pg8::StaticOrder, true, true>(lds, g, S, E);
        } else { LAS float* scr = (LAS float*)(lds + wave * 16640); const int vw = (bx - Gg) * 8 + wave, nvw = (G - Gg) * 8;
            convert_items(a, scr, WI6, WI7, 0, 0, vw, nvw, LANE()); }
    }
    SEAM(10);
    if (IN(11)) REPS(11) {
        pg8::Gemm g{ACTb, (const bf16_t*)(ws + WS_WDN + 22 * MiB), MTOK, DM, FF}; pg8::StaticOrder S; S.init(MTOK, DM, G, bx);
        EpiRes<false, true> E{XB, a.out, nullptr};
        pg8::gemm_phase<EpiRes<false, true>, pg8::StaticOrder, true, true>(lds, g, S, E);
    }
#undef IN
#undef SEAM
}

extern "C" void kernel_launch(void* const* d_in, const int* in_sizes, int n_in, void* d_out, int out_size, void* d_ws, size_t ws_size, hipStream_t stream) {
    static int grid = 0;
    if (grid == 0) {
        if (n_in != 14 || out_size != MTOK * DM || ws_size < WS_END) { fprintf(stderr, "kernel_launch: unexpected shapes (n_in %d out %d ws %zu)\n", n_in, out_size, ws_size); grid = -1; return; }
        int dev = 0, cus = 0, per_cu = 0;
        hipGetDevice(&dev); hipDeviceGetAttribute(&cus, hipDeviceAttributeMultiprocessorCount, dev);
        if (hipFuncSetAttribute((const void*)fwd_kernel, hipFuncAttributeMaxDynamicSharedMemorySize, LDS_BYTES) != hipSuccess) { fprintf(stderr, "kernel_launch: hipFuncSetAttribute failed\n"); grid = -1; return; }
        if (hipOccupancyMaxActiveBlocksPerMultiprocessor(&per_cu, (const void*)fwd_kernel, 512, LDS_BYTES) != hipSuccess || per_cu < 1) { fprintf(stderr, "kernel_launch: occupancy query says %d\n", per_cu); per_cu = 1; }
        (void)hipGetLastError();
        grid = cus;
    }
    if (grid < 0) return;
    Args a{};
    a.x = (const float*)d_in[0]; a.attn_g = (const float*)d_in[1]; a.ffn_g = (const float*)d_in[2]; a.w_qkv = (const float*)d_in[3]; a.w_o0 = (const float*)d_in[4]; a.w_in = (const float*)d_in[5];
    a.qn_g = (const float*)d_in[6]; a.kn_g = (const float*)d_in[7]; a.ikn_g = (const float*)d_in[8]; a.w_o1 = (const float*)d_in[9]; a.w_up = (const float*)d_in[10]; a.conv_w = (const float*)d_in[11];
    a.conv_b = (const float*)d_in[12]; a.w_down = (const float*)d_in[13]; a.out = (float*)d_out; a.ws = (unsigned char*)d_ws;
    if (hipMemsetAsync((char*)d_ws + WS_CTL, 0, CTL_BYTES, stream) != hipSuccess) { fprintf(stderr, "kernel_launch: hipMemsetAsync failed\n"); return; }
#if MK_ONE_LAUNCH
    a.ph_lo = 0; a.ph_hi = N_PHASES;
    void* args[] = {&a};
    hipError_t e = hipLaunchCooperativeKernel((const void*)fwd_kernel, dim3(grid), dim3(512), args, LDS_BYTES, stream);
    if (e != hipSuccess) fprintf(stderr, "cooperative launch failed: %s (grid %d)\n", hipGetErrorString(e), grid);
#else
    for (int pp = 0; pp < N_PHASES + HOST_REP_EXTRA; ++pp) {
        const int p = pp < N_PHASES ? pp : -1;
        if (p < 0) continue;
        for (int hr = 0; hr < ((p == HOST_REP_PHASE) ? 1 + HOST_REP_EXTRA : 1); ++hr) {
        a.ph_lo = p; a.ph_hi = p + 1;
        void* args[] = {&a};
        hipError_t e = hipLaunchCooperativeKernel((const void*)fwd_kernel, dim3(grid), dim3(512), args, LDS_BYTES, stream);
        if (e != hipSuccess) { fprintf(stderr, "launch %d failed: %s (grid %d)\n", p, hipGetErrorString(e), grid); break; }
        }
    }
#endif
}
```
